# Optimizing an MI355X kernel written in HIP

```python
import jax, jax.numpy as jnp
from jax import lax
import numpy as np

D_MODEL = 2048
BATCH = 4
SEQ = 2048
DEPTH = 1

GRID_W = 64
CTX_LEN = 256
M_HEADS = 8
QK_DIM = 128
V_DIM = 256
QK_WIDTH = M_HEADS * QK_DIM
V_WIDTH = M_HEADS * V_DIM
CONV_W = 5
MLSTM_CHUNK = 128
SGU_GROUPS = 8
SGU_CHUNK = 128
SGU_WIDTH = 2048
SGU_GDIM = SGU_WIDTH // SGU_GROUPS
ROWS_PER_CHUNK = SGU_CHUNK // GRID_W
N_EXPERTS = 32
TOP_K = 4
D_EXPERT = 2048
SWIGLU_ALPHA = 1.702
SWIGLU_LIMIT = 7.0
MOE_BLOCK = 256
EPS = 1e-6
N_MOD = 6

OFF_Q = 0
OFF_K = OFF_Q + QK_WIDTH
OFF_V = OFF_K + QK_WIDTH
OFF_GATES = OFF_V + V_WIDTH
OFF_O = OFF_GATES + 4 * M_HEADS
OFF_U = OFF_O + V_WIDTH
OFF_SV = OFF_U + SGU_WIDTH
OFF_MERGE = OFF_SV + SGU_WIDTH
IN_COLS = OFF_MERGE + 2 * D_MODEL

kernel_name = 'hybrid_mlstm_chunkmlp_moe_dit_block'


def rmsnorm(x, g):
    xf = x.astype(jnp.float32)
    y = xf * lax.rsqrt(jnp.mean(xf * xf, axis=-1, keepdims=True) + EPS)
    return (y * g).astype(x.dtype)


def modulate(h, shift, scale):
    return h * (1 + scale) + shift


def heads(a, d):
    B, T, _ = a.shape
    return a.reshape(B, T, M_HEADS, d).transpose(0, 2, 1, 3)


def centred_dwconv(x, w, b):
    C = x.shape[-1]
    y = lax.conv_general_dilated(x, w[:, None, :].astype(x.dtype), (1,), [(CONV_W // 2, CONV_W // 2)],
                                 dimension_numbers=('NWC', 'WIO', 'NWC'), feature_group_count=C)
    return y + b


def in_projection(h, w_in, gate_b, conv_w, conv_b, full):
    B, T, _ = h.shape
    z = h @ (w_in if full else w_in[:, :OFF_O])
    qk = jax.nn.silu(centred_dwconv(z[..., :OFF_V], conv_w, conv_b))
    q = heads(qk[..., :QK_WIDTH], QK_DIM) * (QK_DIM ** -0.5)
    k = heads(qk[..., QK_WIDTH:], QK_DIM)
    v = heads(z[..., OFF_V:OFF_GATES], V_DIM)
    gates = z[..., OFF_GATES:OFF_O].astype(jnp.float32).reshape(B, T, 4, M_HEADS) + gate_b
    gates = gates.transpose(0, 2, 3, 1)
    mix = (q, k, v, gates)
    if not full:
        return mix, None
    rest = (z[..., OFF_O:OFF_U], z[..., OFF_U:OFF_SV], z[..., OFF_SV:OFF_MERGE], z[..., OFF_MERGE:])
    return mix, rest


def to_chunks(a):
    B, H, T = a.shape[:3]
    a = a.reshape(B, H, T // MLSTM_CHUNK, MLSTM_CHUNK, *a.shape[3:])
    return jnp.moveaxis(a, 2, 0)


def mlstm_chunked(q, k, v, i_pre, f_pre):
    B, H, T, _ = q.shape
    L = MLSTM_CHUNK
    tri = jnp.tril(jnp.ones((L, L), dtype=bool))
    log_f = jax.nn.log_sigmoid(f_pre)

    def step(carry, blk):
        C, n, m = carry
        qb, kb, vb, ib, lfb = blk
        b = jnp.cumsum(lfb, axis=-1)
        d_log = jnp.where(tri, b[..., :, None] - b[..., None, :] + ib[..., None, :], -jnp.inf)
        inter = b + m[..., None]
        m_t = jnp.maximum(inter, jnp.max(d_log, axis=-1))
        w_inter = jnp.exp(inter - m_t)
        s = jnp.einsum('bhtd,bhsd->bhts', qb, kb).astype(jnp.float32) * jnp.exp(d_log - m_t[..., None])
        num = w_inter[..., None] * jnp.einsum('bhtd,bhde->bhte', qb, C) + jnp.einsum('bhts,bhse->bhte', s, vb)
        den = w_inter * jnp.einsum('bhtd,bhd->bht', qb, n) + jnp.sum(s, axis=-1)
        h = num / jnp.maximum(jnp.abs(den), jnp.exp(-m_t))[..., None]
        b_end = b[..., -1]
        log_w = b_end[..., None] - b + ib
        m_new = jnp.maximum(b_end + m, jnp.max(log_w, axis=-1))
        decay = jnp.exp(b_end + m - m_new)
        w = jnp.exp(log_w - m_new[..., None])
        C = decay[..., None, None] * C + jnp.einsum('bhs,bhsd,bhse->bhde', w, kb, vb)
        n = decay[..., None] * n + jnp.einsum('bhs,bhsd->bhd', w, kb)
        return (C, n, m_new), h

    state0 = (jnp.zeros((B, H, QK_DIM, V_DIM), jnp.float32),
              jnp.zeros((B, H, QK_DIM), jnp.float32),
              jnp.zeros((B, H), jnp.float32))
    blocks = (to_chunks(q), to_chunks(k), to_chunks(v), to_chunks(i_pre), to_chunks(log_f))
    _, hs = lax.scan(step, state0, blocks)
    return jnp.moveaxis(hs, 0, 2).reshape(B, H, T, V_DIM)


def mlstm_bidirectional(mix_ctx, mix_lat):
    qc, kc, vc, gc = mix_ctx
    ql, kl, vl, gl = mix_lat
    Tc = qc.shape[2]
    cat = lambda a, b: jnp.concatenate([a, b], axis=2)
    rev = lambda a: jnp.flip(a, axis=2)
    h_f = mlstm_chunked(cat(qc, ql), cat(kc, kl), cat(vc, vl), cat(gc[:, 0], gl[:, 0]), cat(gc[:, 1], gl[:, 1]))
    h_b = mlstm_chunked(cat(rev(qc), rev(ql)), cat(rev(kc), rev(kl)), cat(rev(vc), rev(vl)),
                        cat(rev(gc[:, 2]), rev(gl[:, 2])), cat(rev(gc[:, 3]), rev(gl[:, 3])))
    h_lat = h_f[:, :, Tc:] + rev(h_b[:, :, Tc:])
    h_ctx = h_f[:, :, :Tc] + rev(h_b[:, :, :Tc])
    return h_lat, h_ctx


def mlstm_readout(h, o, g):
    B, H, T, _ = h.shape
    h = rmsnorm(h.transpose(0, 2, 1, 3), g.reshape(H, V_DIM))
    return h.reshape(B, T, V_WIDTH) * jax.nn.sigmoid(o)


def chunk_mlp(u, sv, n_chunks, g, sgu_w, sgu_b):
    B, T, _ = u.shape
    u = jax.nn.gelu(u)
    sv = rmsnorm(jax.nn.gelu(sv), g)
    vc = sv.reshape(B, n_chunks, SGU_CHUNK, SGU_GROUPS, SGU_GDIM)
    z = jnp.einsum('gts,bnsgd->bntgd', sgu_w, vc) + sgu_b.T[None, None, :, :, None]
    return u * z.reshape(B, T, SGU_WIDTH)


def token_mixer(h_lat, h_ctx, n_lat_chunks, with_ctx_out, w_in, gate_b, conv_w, conv_b, mlstm_norm_g,
                sgu_norm_g, sgu_w, sgu_b, proj_a, proj_b, w_out):
    mix_lat, rest_lat = in_projection(h_lat, w_in, gate_b, conv_w, conv_b, True)
    mix_ctx, rest_ctx = in_projection(h_ctx, w_in, gate_b, conv_w, conv_b, with_ctx_out)
    hm_lat, hm_ctx = mlstm_bidirectional(mix_ctx, mix_lat)

    def merge(hm, rest, n_chunks, dtype):
        o, u, sv, mg = rest
        y_a = mlstm_readout(hm, o, mlstm_norm_g).astype(dtype) @ proj_a
        y_b = chunk_mlp(u, sv, n_chunks, sgu_norm_g, sgu_w, sgu_b) @ proj_b
        g_a = jax.nn.sigmoid(mg[..., :D_MODEL])
        g_b = jax.nn.sigmoid(mg[..., D_MODEL:])
        return (g_a * y_a + g_b * y_b) @ w_out

    out_lat = merge(hm_lat, rest_lat, n_lat_chunks, h_lat.dtype)
    out_ctx = merge(hm_ctx, rest_ctx, h_ctx.shape[1] // SGU_CHUNK, h_ctx.dtype) if with_ctx_out else None
    return out_lat, out_ctx


def clamped_swiglu(hb):
    glu = jnp.minimum(hb[..., :D_EXPERT], SWIGLU_LIMIT)
    lin = jnp.clip(hb[..., D_EXPERT:], -SWIGLU_LIMIT, SWIGLU_LIMIT)
    return glu * jax.nn.sigmoid(SWIGLU_ALPHA * glu) * (lin + 1)


def moe_ffn(xt, router_w, router_b, w1, b1, w2, b2):
    N = xt.shape[0]
    logits = (xt @ router_w).astype(jnp.float32) + router_b
    top_val, top_idx = lax.top_k(logits, TOP_K)
    gates = jax.nn.softmax(top_val, axis=-1)
    M = N * TOP_K
    eid = top_idx.reshape(M)
    tok = jnp.arange(M, dtype=jnp.int32) // TOP_K
    gate = gates.reshape(M)
    order = jnp.argsort(eid)
    e_sorted = eid[order]
    counts = jnp.zeros((N_EXPERTS,), jnp.int32).at[eid].add(1)
    padded = (counts + MOE_BLOCK - 1) // MOE_BLOCK * MOE_BLOCK
    start_sorted = jnp.cumsum(counts) - counts
    pad_end = jnp.cumsum(padded)
    start_pad = pad_end - padded
    dest = start_pad[e_sorted] + jnp.arange(M, dtype=jnp.int32) - start_sorted[e_sorted]
    n_blocks = -(-M // MOE_BLOCK) + N_EXPERTS
    P = n_blocks * MOE_BLOCK
    buf_tok = jnp.zeros((P,), jnp.int32).at[dest].set(tok[order])
    buf_gate = jnp.zeros((P,), jnp.float32).at[dest].set(gate[order])
    block_start = jnp.arange(n_blocks, dtype=jnp.int32) * MOE_BLOCK
    block_e = jnp.minimum(jnp.searchsorted(pad_end, block_start, side='right'), N_EXPERTS - 1)

    def body(acc, blk):
        tok_b, gate_b, e = blk
        hb = xt[tok_b] @ w1[e] + b1[e]
        y = clamped_swiglu(hb) @ w2[e] + b2[e]
        return acc.at[tok_b].add(gate_b[:, None] * y.astype(jnp.float32)), None

    acc, _ = lax.scan(body, jnp.zeros(xt.shape, jnp.float32),
                      (buf_tok.reshape(n_blocks, MOE_BLOCK), buf_gate.reshape(n_blocks, MOE_BLOCK), block_e))
    return acc.astype(xt.dtype)


def setup_inputs(seed: int = 0) -> dict:
    key = jax.random.key(seed)
    ks = jax.random.split(key, 28)
    nrm = lambda k, shape, s: jax.random.normal(k, shape, jnp.float32) * s
    f_bias = jnp.linspace(3.0, 6.0, M_HEADS)
    zh = jnp.zeros((M_HEADS,), jnp.float32)
    gate_base = jnp.stack([zh, f_bias, zh, f_bias])
    return {
        'x': nrm(ks[0], (BATCH, SEQ, D_MODEL), 1.0),
        'c': nrm(ks[1], (BATCH, D_MODEL), 1.0),
        'ctx': nrm(ks[2], (BATCH, CTX_LEN, D_MODEL), 1.0),
        'c_ctx': nrm(ks[3], (D_MODEL,), 1.0),
        'mod_w': nrm(ks[4], (DEPTH, D_MODEL, N_MOD * D_MODEL), 0.5 * D_MODEL ** -0.5),
        'mod_b': nrm(ks[5], (DEPTH, N_MOD * D_MODEL), 0.02),
        'norm1_g': 1.0 + nrm(ks[6], (DEPTH, D_MODEL), 0.1),
        'norm2_g': 1.0 + nrm(ks[7], (DEPTH, D_MODEL), 0.1),
        'w_in': nrm(ks[8], (DEPTH, D_MODEL, IN_COLS), D_MODEL ** -0.5),
        'gate_b': gate_base[None] + nrm(ks[9], (DEPTH, 4, M_HEADS), 0.1),
        'conv_w': nrm(ks[10], (DEPTH, CONV_W, 2 * QK_WIDTH), CONV_W ** -0.5),
        'conv_b': nrm(ks[11], (DEPTH, 2 * QK_WIDTH), 0.02),
        'mlstm_norm_g': 1.0 + nrm(ks[12], (DEPTH, V_WIDTH), 0.1),
        'sgu_norm_g': 1.0 + nrm(ks[13], (DEPTH, SGU_WIDTH), 0.1),
        'sgu_w': nrm(ks[14], (DEPTH, SGU_GROUPS, SGU_CHUNK, SGU_CHUNK), SGU_CHUNK ** -0.5),
        'sgu_b': 1.0 + nrm(ks[15], (DEPTH, SGU_GROUPS, SGU_CHUNK), 0.1),
        'proj_a': nrm(ks[16], (DEPTH, V_WIDTH, D_MODEL), V_WIDTH ** -0.5),
        'proj_b': nrm(ks[17], (DEPTH, SGU_WIDTH, D_MODEL), SGU_WIDTH ** -0.5),
        'w_out': nrm(ks[18], (DEPTH, D_MODEL, D_MODEL), D_MODEL ** -0.5),
        'router_w': nrm(ks[19], (DEPTH, D_MODEL, N_EXPERTS), D_MODEL ** -0.5),
        'router_b': nrm(ks[20], (DEPTH, N_EXPERTS), 0.01),
        'exp_w1': nrm(ks[21], (DEPTH, N_EXPERTS, D_MODEL, 2 * D_EXPERT), D_MODEL ** -0.5),
        'exp_b1': nrm(ks[22], (DEPTH, N_EXPERTS, 2 * D_EXPERT), 0.01),
        'exp_w2': nrm(ks[23], (DEPTH, N_EXPERTS, D_EXPERT, D_MODEL), D_EXPERT ** -0.5),
        'exp_b2': nrm(ks[24], (DEPTH, N_EXPERTS, D_MODEL), 0.01),
        'final_g': 1.0 + nrm(ks[25], (D_MODEL,), 0.1),
    }


def reference(x, c, ctx, c_ctx, mod_w, mod_b, norm1_g, norm2_g, w_in, gate_b, conv_w, conv_b,
              mlstm_norm_g, sgu_norm_g, sgu_w, sgu_b, proj_a, proj_b, w_out, router_w, router_b,
              exp_w1, exp_b1, exp_w2, exp_b2, final_g):
    B, T, _ = x.shape
    rows = T // GRID_W
    n_lat_chunks = rows // ROWS_PER_CHUNK
    for l in range(DEPTH):
        last = l == DEPTH - 1
        mod_lat = (jax.nn.silu(c) @ mod_w[l] + mod_b[l]).reshape(B, 1, N_MOD, D_MODEL)
        mod_ctx = (jax.nn.silu(c_ctx) @ mod_w[l] + mod_b[l]).reshape(1, 1, N_MOD, D_MODEL)
        h_lat = modulate(rmsnorm(x, norm1_g[l]), mod_lat[:, :, 0], mod_lat[:, :, 1])
        h_ctx = modulate(rmsnorm(ctx, norm1_g[l]), mod_ctx[:, :, 0], mod_ctx[:, :, 1])
        out_lat, out_ctx = token_mixer(h_lat, h_ctx, n_lat_chunks, not last, w_in[l], gate_b[l], conv_w[l],
                                       conv_b[l], mlstm_norm_g[l], sgu_norm_g[l], sgu_w[l], sgu_b[l],
                                       proj_a[l], proj_b[l], w_out[l])
        x = x + mod_lat[:, :, 2] * out_lat
        h2 = modulate(rmsnorm(x, norm2_g[l]), mod_lat[:, :, 3], mod_lat[:, :, 4])
        y2 = moe_ffn(h2.reshape(B * T, D_MODEL), router_w[l], router_b[l], exp_w1[l], exp_b1[l],
                     exp_w2[l], exp_b2[l]).reshape(B, T, D_MODEL)
        x = x + mod_lat[:, :, 5] * y2
        if not last:
            Tc = ctx.shape[1]
            ctx = ctx + mod_ctx[:, :, 2] * out_ctx
            h2c = modulate(rmsnorm(ctx, norm2_g[l]), mod_ctx[:, :, 3], mod_ctx[:, :, 4])
            y2c = moe_ffn(h2c.reshape(B * Tc, D_MODEL), router_w[l], router_b[l], exp_w1[l], exp_b1[l],
                          exp_w2[l], exp_b2[l]).reshape(B, Tc, D_MODEL)
            ctx = ctx + mod_ctx[:, :, 5] * y2c
    return rmsnorm(x, final_g)
```

```cpp
#include <hip/hip_runtime.h>
#include <cstdio>
#include <cstdint>
#ifndef MK_N_LAUNCHES
#define MK_N_LAUNCHES 1
#endif
namespace pg8 {
#define PG8_LAS __attribute__((address_space(3)))
typedef unsigned short bf16_t;
typedef short bf16x8 __attribute__((ext_vector_type(8)));
typedef float f32x4 __attribute__((ext_vector_type(4)));
typedef unsigned u32x4 __attribute__((ext_vector_type(4)));
constexpr int BM = 256, BK = 64, HALF = 128, HTB = HALF * BK * 2  , STAGE_BYTES = 8 * HTB, NXCD = 8, WGM = 8;

__host__ __device__ __forceinline__ int lds_byte(int r, int c) { const int st = (r >> 4) * 2 + (c >> 5), rr = r & 15, cc = c & 31, ob = rr * 64 + cc * 2; return st * 1024 + (ob ^ (((ob >> 9) & 1) << 5)); }
__host__ __device__ __forceinline__ void stage_rc(int b, int& R, int& C) { const int st = b / 1024, sb = b % 1024, swz = sb ^ (((sb >> 9) & 1) << 5); R = (st >> 1) * 16 + swz / 64; C = (st & 1) * 32 + (swz % 64) / 2; }
__host__ __device__ __forceinline__ int perm32(int rho) { const int n = rho >> 4, i = rho & 15; return 8 * (i >> 2) + 4 * n + (i & 3); }

struct Unit { int pm, pn, po, hf; };
struct Gemm { const bf16_t* A; const bf16_t* Bt; int M, N, K; };

struct StaticOrder {
    int nM, nN, nwg, G, c;
    __host__ __device__ void init(int M, int N, int G_, int c_) { nM = M / BM; nN = N / BM; nwg = nM * nN; G = G_; c = c_; }
    __host__ __device__ bool next(int i, Unit& u) const {
        const long L = (long)i * G + c; if (L >= nwg) return false;
        int wgid = (int)L; { const int q = nwg / NXCD, r = nwg % NXCD, xcd = wgid % NXCD, off = wgid / NXCD; wgid = (xcd < r ? xcd * (q + 1) : r * (q + 1) + (xcd - r) * q) + off; }
        const int nig = WGM * nN, gid = wgid / nig, fm = gid * WGM, gsz = (nM - fm) < WGM ? (nM - fm) : WGM;
        u.pm = fm + ((wgid % nig) % gsz); u.pn = (wgid % nig) / gsz; u.po = u.pm; u.hf = 0; return true;
    }
    __device__ __forceinline__ void a_ready(const Unit&) const {}
    __device__ __forceinline__ void done(const Unit&) const {}
};
struct DynOrder {
    unsigned* q; PG8_LAS int* slot; int xcd;
    __device__ __forceinline__ bool next(int i, Unit& u) const {
        if (threadIdx.x == 0) { int id = -1;
            unsigned v = __hip_atomic_fetch_add(q + 64 * xcd, 1u, __ATOMIC_RELAXED, __HIP_MEMORY_SCOPE_AGENT);
            if (v < 232u) id = xcd * 232 + (int)v;
            else { unsigned c[8];
#pragma unroll
                for (int k = 0; k < 8; ++k) c[k] = __hip_atomic_load(q + 64 * k, __ATOMIC_RELAXED, __HIP_MEMORY_SCOPE_AGENT);
#pragma unroll
                for (int k = 1; k < 8; ++k) { const int x = (xcd + k) & 7; if (id < 0 && c[x] < 232u) { v = __hip_atomic_fetch_add(q + 64 * x, 1u, __ATOMIC_RELAXED, __HIP_MEMORY_SCOPE_AGENT); if (v < 232u) id = x * 232 + (int)v; } } }
            slot[i & 1] = id; asm volatile("s_waitcnt lgkmcnt(0)" ::: "memory"); }
        asm volatile("" ::: "memory"); __builtin_amdgcn_s_barrier(); asm volatile("" ::: "memory");
        const int id = slot[i & 1]; if (id < 0) return false;
        const int x = id / 232, v = id - x * 232;
        if (v < 224) { const int wgid = x * 224 + v, nig = WGM * 56, gid = wgid / nig; u.pm = gid * WGM + ((wgid % nig) % WGM); u.pn = (wgid % nig) / WGM; }
        else { const int j = x * 8 + (v - 224); u.pm = 32 + (j & 3); u.pn = j >> 2; }
        u.po = u.pm; u.hf = 0; return true;
    }
    __device__ __forceinline__ void a_ready(const Unit&) const {}
    __device__ __forceinline__ void done(const Unit&) const {}
};
struct MoeOrder {
    const PG8_LAS int* pref; int nN, G, c, a_sparse;
    __device__ __forceinline__ bool next(int i, Unit& u) const {
        const int L = i * G + c, total = pref[32]; if (L >= total * nN) return false;
        const int mt = L / nN, nt = L - mt * nN; int e = 0;
        for (int k = 1; k < 32; ++k) e += (pref[k] <= mt) ? 1 : 0;
        u.pm = a_sparse ? e * 32 + (mt - pref[e]) : mt; u.pn = e * nN + nt; u.po = mt; u.hf = (pref[33 + e] - 256 * (mt - pref[e]) <= 128) ? 1 : 0; return true;
    }
    __device__ __forceinline__ void a_ready(const Unit&) const {}
    __device__ __forceinline__ void done(const Unit&) const {}
};

__device__ __forceinline__ unsigned cvt_pk_bf16(float lo, float hi) { unsigned r; asm volatile("v_cvt_pk_bf16_f32 %0, %1, %2" : "=v"(r) : "v"(lo), "v"(hi)); return r; }
__device__ __forceinline__ float bf_lo(unsigned w) { return __uint_as_float(w << 16); }
__device__ __forceinline__ float bf_hi(unsigned w) { return __uint_as_float(w & 0xffff0000u); }
__device__ __forceinline__ float sigmoidf_(float x) { return __builtin_amdgcn_rcpf(1.0f + __expf(-x)); }

struct EpiBf16 {
    static constexpr bool PERM = true, AFTER_DRAIN = false;
    bf16_t* O; int ldc; const float* bias; int ncolt;
    __device__ __forceinline__ void operator()(const f32x4 (&acc)[2][2][4][2], const Unit& u, int wr, int wc, int fr, int fq) const {
        const int row0 = u.po * BM + wr * 64 + fr; const int colt = (u.pn % ncolt) * BM;
        const int col0 = colt + wc * 32 + 8 * fq, bcol0 = u.pn * BM + wc * 32 + 8 * fq;
        f32x4 bv[2][2];
#pragma unroll
        for (int bj = 0; bj < 2; ++bj)
#pragma unroll
            for (int n = 0; n < 2; ++n) bv[bj][n] = bias ? *(const f32x4*)(bias + bcol0 + bj * HALF + 4 * n) : (f32x4){0.f, 0.f, 0.f, 0.f};
#pragma unroll
        for (int ai = 0; ai < 2; ++ai)
#pragma unroll
            for (int m = 0; m < 4; ++m) { bf16_t* rowp = O + (size_t)(row0 + ai * HALF + m * 16) * ldc + col0;
#pragma unroll
                for (int bj = 0; bj < 2; ++bj) { const f32x4 v0 = acc[ai][bj][m][0] + bv[bj][0], v1 = acc[ai][bj][m][1] + bv[bj][1];
                    u32x4 w; w.x = cvt_pk_bf16(v0[0], v0[1]); w.y = cvt_pk_bf16(v0[2], v0[3]); w.z = cvt_pk_bf16(v1[0], v1[1]); w.w = cvt_pk_bf16(v1[2], v1[3]);
                    *(u32x4*)(rowp + bj * HALF) = w; } }
    }
};
struct EpiF32 {
    static constexpr bool PERM = false, AFTER_DRAIN = false;
    float* C; int ldc;
    __device__ __forceinline__ void operator()(const f32x4 (&acc)[2][2][4][2], const Unit& u, int wr, int wc, int fr, int fq) const {
        const int row0 = u.po * BM + wr * 64 + fr, col0 = u.pn * BM + wc * 32 + 4 * fq;
#pragma unroll
        for (int ai = 0; ai < 2; ++ai)
#pragma unroll
            for (int m = 0; m < 4; ++m) { float* rowp = C + (size_t)(row0 + ai * HALF + m * 16) * ldc + col0;
#pragma unroll
                for (int bj = 0; bj < 2; ++bj)
#pragma unroll
                    for (int n = 0; n < 2; ++n) *(f32x4*)(rowp + bj * HALF + n * 16) = acc[ai][bj][m][n]; }
    }
};
struct EpiMerge {
    static constexpr bool PERM = true, AFTER_DRAIN = false;
    bf16_t* O; const bf16_t* Z; int ldz, ga_off, gb_off; const float* YB;
    __device__ __forceinline__ void operator()(const f32x4 (&acc)[2][2][4][2], const Unit& u, int wr, int wc, int fr, int fq) const {
        const int row0 = u.po * BM + wr * 64 + fr, col0 = u.pn * BM + wc * 32 + 8 * fq;
#pragma unroll
        for (int ai = 0; ai < 2; ++ai)
#pragma unroll
            for (int m = 0; m < 4; ++m) { const size_t row = (size_t)(row0 + ai * HALF + m * 16);
#pragma unroll
                for (int bj = 0; bj < 2; ++bj) { const int col = col0 + bj * HALF;
                    const u32x4 ga = *(const u32x4*)(Z + row * ldz + ga_off + col), gb = *(const u32x4*)(Z + row * ldz + gb_off + col);
                    const f32x4 y0 = *(const f32x4*)(YB + row * 2048 + col), y1 = *(const f32x4*)(YB + row * 2048 + col + 4);
                    const f32x4 a0 = acc[ai][bj][m][0], a1 = acc[ai][bj][m][1];
                    float o[8];
                    o[0] = sigmoidf_(bf_lo(ga.x)) * a0[0] + sigmoidf_(bf_lo(gb.x)) * y0[0]; o[1] = sigmoidf_(bf_hi(ga.x)) * a0[1] + sigmoidf_(bf_hi(gb.x)) * y0[1];
                    o[2] = sigmoidf_(bf_lo(ga.y)) * a0[2] + sigmoidf_(bf_lo(gb.y)) * y0[2]; o[3] = sigmoidf_(bf_hi(ga.y)) * a0[3] + sigmoidf_(bf_hi(gb.y)) * y0[3];
                    o[4] = sigmoidf_(bf_lo(ga.z)) * a1[0] + sigmoidf_(bf_lo(gb.z)) * y1[0]; o[5] = sigmoidf_(bf_hi(ga.z)) * a1[1] + sigmoidf_(bf_hi(gb.z)) * y1[1];
                    o[6] = sigmoidf_(bf_lo(ga.w)) * a1[2] + sigmoidf_(bf_lo(gb.w)) * y1[2]; o[7] = sigmoidf_(bf_hi(ga.w)) * a1[3] + sigmoidf_(bf_hi(gb.w)) * y1[3];
                    u32x4 w; w.x = cvt_pk_bf16(o[0], o[1]); w.y = cvt_pk_bf16(o[2], o[3]); w.z = cvt_pk_bf16(o[4], o[5]); w.w = cvt_pk_bf16(o[6], o[7]);
                    *(u32x4*)(O + row * 2048 + col) = w; } }
    }
};
struct EpiX1 {
    static constexpr bool PERM = false, AFTER_DRAIN = false;
    float* X1; const float* X; const float* mod;
    __device__ __forceinline__ void operator()(const f32x4 (&acc)[2][2][4][2], const Unit& u, int wr, int wc, int fr, int fq) const {
        const int row0 = u.po * BM + wr * 64 + fr, col0 = u.pn * BM + wc * 32 + 4 * fq;
        const float* mg = mod + (size_t)((u.po * BM) >> 11) * 12288 + 2 * 2048;
#pragma unroll
        for (int bj = 0; bj < 2; ++bj)
#pragma unroll
            for (int n = 0; n < 2; ++n) { const int col = col0 + bj * HALF + n * 16; const f32x4 g = *(const f32x4*)(mg + col);
#pragma unroll
                for (int ai = 0; ai < 2; ++ai)
#pragma unroll
                    for (int m = 0; m < 4; ++m) { const size_t off = (size_t)(row0 + ai * HALF + m * 16) * 2048 + col;
                        *(f32x4*)(X1 + off) = *(const f32x4*)(X + off) + g * acc[ai][bj][m][n]; } }
    }
};
struct EpiSwiglu {
    static constexpr bool PERM = true, AFTER_DRAIN = false;
    bf16_t* O; const float* b1;
    __device__ __forceinline__ void operator()(const f32x4 (&acc)[2][2][4][2], const Unit& u, int wr, int wc, int fr, int fq) const {
        const int e = u.pn >> 4, nt = u.pn & 15; const int row0 = u.po * BM + wr * 64 + fr, j0 = nt * 128 + wc * 32 + 8 * fq;
        const float* bg = b1 + (size_t)e * 4096 + j0; const float* bl = bg + 2048;
#pragma unroll
        for (int ai = 0; ai < 2; ++ai)
#pragma unroll
            for (int m = 0; m < 4; ++m) { const size_t row = (size_t)(row0 + ai * HALF + m * 16);
                asm volatile("" ::: "memory");
#pragma unroll
                for (int n = 0; n < 2; ++n) { const f32x4 gv = acc[ai][0][m][n] + *(const f32x4*)(bg + 4 * n), lv = acc[ai][1][m][n] + *(const f32x4*)(bl + 4 * n);
                    float o[4];
#pragma unroll
                    for (int i = 0; i < 4; ++i) { const float ga = fminf(gv[i], 7.0f), la = fminf(fmaxf(lv[i], -7.0f), 7.0f); o[i] = ga * sigmoidf_(1.702f * ga) * (la + 1.0f); }
                    typedef unsigned u32x2 __attribute__((ext_vector_type(2))); u32x2 w; w.x = cvt_pk_bf16(o[0], o[1]); w.y = cvt_pk_bf16(o[2], o[3]);
                    *(u32x2*)(O + row * 2048 + j0 + 4 * n) = w; } }
    }
};

template <class Epi, class Sched, bool ALIGN_EPI = false, bool SP2 = false, bool HALFSKIP = false>
__device__ __forceinline__ void gemm_phase(PG8_LAS unsigned char* lds, const Gemm g, const Sched& S, const Epi& E) {
    const int tid = threadIdx.x, wid = __builtin_amdgcn_readfirstlane(tid >> 6), lane = tid & 63, wr = wid >> 2, wc = wid & 3, fr = lane & 15, fq = lane >> 4;
    const int K = g.K, nt = K / BK;
    unsigned voffA[2], voffB[2];
#pragma unroll
    for (int i = 0; i < 2; ++i) { int R, C; stage_rc(tid * 16 + i * 8192, R, C); const int Rb = Epi::PERM ? ((R & ~31) + perm32(R & 31)) : R;
        voffA[i] = (unsigned)(R * K + C) * 2u; voffB[i] = (unsigned)(Rb * K + C) * 2u; }
    const size_t kstep = (size_t)(BK * 2);
    const size_t hstep = (size_t)HALF * K * 2;
    const size_t tstep = 2 * hstep;
    const unsigned ldsw = (unsigned)wid * 1024u;
    const int aoff = lds_byte(wr * 64 + fr, fq * 8), boff = lds_byte(wc * 32 + fr, fq * 8);
#define PG8_SA(b, h) (((b) * 2 + (h)) * HTB)
#define PG8_SB(b, h) ((4 + (b) * 2 + (h)) * HTB)
#define PG8_STAGE(bufoff, gbase, voff) do { _Pragma("unroll") for (int _i = 0; _i < 2; ++_i) \
        __builtin_amdgcn_global_load_lds((const unsigned*)((const char*)(gbase) + (voff)[_i]), (PG8_LAS unsigned*)(lds + (bufoff) + ldsw + _i * 8192), 16, 0, 0); } while (0)
#define PG8_LDA(dst, b, h) do { _Pragma("unroll") for (int m = 0; m < 4; ++m) _Pragma("unroll") for (int k = 0; k < 2; ++k) dst[m][k] = *(const PG8_LAS bf16x8*)(lds + PG8_SA(b, h) + aoff + m * 2048 + k * 1024); } while (0)
#define PG8_LDB(dst, b, h) do { _Pragma("unroll") for (int n = 0; n < 2; ++n) _Pragma("unroll") for (int k = 0; k < 2; ++k) dst[n][k] = *(const PG8_LAS bf16x8*)(lds + PG8_SB(b, h) + boff + n * 2048 + k * 1024); } while (0)
#define PG8_MMA(ai, bj, At, Bt) do { __builtin_amdgcn_s_setprio(1); _Pragma("unroll") for (int m = 0; m < 4; ++m) _Pragma("unroll") for (int n = 0; n < 2; ++n) _Pragma("unroll") for (int k = 0; k < 2; ++k) \
        acc[ai][bj][m][n] = __builtin_amdgcn_mfma_f32_16x16x32_bf16(Bt[n][k], At[m][k], acc[ai][bj][m][n], 0, 0, 0); __builtin_amdgcn_s_setprio(0); } while (0)
#define PG8_WAIT_V(n) asm volatile("s_waitcnt vmcnt(" #n ")" ::: "memory")
#define PG8_WAIT_L(n) asm volatile("s_waitcnt lgkmcnt(" #n ")" ::: "memory")
#define PG8_BAR __builtin_amdgcn_s_barrier()
#define PG8_SCHED __builtin_amdgcn_sched_barrier(0)
    Unit cur, nxt; int ui = 0;
    if (!S.next(0, cur)) return;
    f32x4 acc[2][2][4][2];
#pragma unroll
    for (int a = 0; a < 2; ++a)
#pragma unroll
        for (int b = 0; b < 2; ++b)
#pragma unroll
            for (int m = 0; m < 4; ++m)
#pragma unroll
                for (int n = 0; n < 2; ++n) acc[a][b][m][n] = (f32x4){0.f, 0.f, 0.f, 0.f};
    bf16x8 At[4][2], B0[2][2], B1[2][2];
    const char* cA = (const char*)g.A + (size_t)cur.pm * tstep; const char* cB = (const char*)g.Bt + (size_t)cur.pn * tstep;
    S.a_ready(cur);
    if constexpr (SP2) {
        PG8_STAGE(PG8_SB(0, 0), cB, voffB); PG8_STAGE(PG8_SB(0, 1), cB + hstep, voffB); PG8_STAGE(PG8_SA(0, 0), cA, voffA); PG8_STAGE(PG8_SA(0, 1), cA + hstep, voffA);
        if (wr == 1) PG8_BAR;
        PG8_WAIT_V(2); PG8_BAR;
        PG8_STAGE(PG8_SB(1, 0), cB + kstep, voffB); PG8_STAGE(PG8_SA(1, 0), cA + kstep, voffA); PG8_STAGE(PG8_SB(1, 1), cB + hstep + kstep, voffB);
        PG8_WAIT_V(6); PG8_BAR;
    } else {
        PG8_STAGE(PG8_SB(0, 0), cB, voffB); PG8_STAGE(PG8_SA(0, 0), cA, voffA); PG8_STAGE(PG8_SB(0, 1), cB + hstep, voffB); PG8_STAGE(PG8_SA(0, 1), cA + hstep, voffA);
        if (wr == 1) PG8_BAR;
        PG8_WAIT_V(4); PG8_BAR;
        PG8_STAGE(PG8_SB(1, 0), cB + kstep, voffB); PG8_STAGE(PG8_SA(1, 0), cA + kstep, voffA); PG8_STAGE(PG8_SB(1, 1), cB + hstep + kstep, voffB);
        PG8_WAIT_V(6); PG8_BAR;
    }
    for (;;) {
        const bool has_next = S.next(ui + 1, nxt);
        const char* nA = has_next ? (const char*)g.A + (size_t)nxt.pm * tstep : cA; const char* nB = has_next ? (const char*)g.Bt + (size_t)nxt.pn * tstep : cB;
        for (int t = 0; t < nt; t += 2) {
            const bool last = (t == nt - 2);
            const char* a1 = cA + (size_t)(t + 1) * kstep;
            const char* a2 = last ? nA : cA + (size_t)(t + 2) * kstep; const char* b2 = last ? nB : cB + (size_t)(t + 2) * kstep;
            const char* a3 = a2 + kstep; const char* b3 = b2 + kstep;
            if (last && has_next) S.a_ready(nxt);
            if constexpr (SP2) {
            PG8_LDB(B0, 0, 0); PG8_LDB(B1, 0, 1); PG8_SCHED; PG8_LDA(At, 0, 0); PG8_STAGE(PG8_SA(1, 1), a1 + hstep, voffA);
            PG8_WAIT_V(8); PG8_WAIT_L(0); PG8_BAR; PG8_MMA(0, 0, At, B0); PG8_MMA(0, 1, At, B1); PG8_BAR; PG8_SCHED;
            PG8_LDA(At, 0, 1); PG8_STAGE(PG8_SB(0, 0), b2, voffB); PG8_STAGE(PG8_SB(0, 1), b2 + hstep, voffB); PG8_STAGE(PG8_SA(0, 0), a2, voffA);
            PG8_WAIT_V(8); PG8_WAIT_L(0); PG8_BAR; if (!(HALFSKIP && cur.hf)) { PG8_MMA(1, 0, At, B0); PG8_MMA(1, 1, At, B1); } PG8_BAR; PG8_SCHED;
            PG8_LDB(B0, 1, 0); PG8_LDB(B1, 1, 1); PG8_SCHED; PG8_LDA(At, 1, 0); PG8_STAGE(PG8_SA(0, 1), a2 + hstep, voffA);
            PG8_WAIT_V(8); PG8_WAIT_L(0); PG8_BAR; PG8_MMA(0, 0, At, B0); PG8_MMA(0, 1, At, B1); PG8_BAR; PG8_SCHED;
            PG8_LDA(At, 1, 1); PG8_STAGE(PG8_SB(1, 0), b3, voffB); PG8_STAGE(PG8_SB(1, 1), b3 + hstep, voffB); PG8_STAGE(PG8_SA(1, 0), a3, voffA);
            PG8_WAIT_V(8); PG8_WAIT_L(0); PG8_BAR; if (!(HALFSKIP && cur.hf)) { PG8_MMA(1, 0, At, B0); PG8_MMA(1, 1, At, B1); } PG8_BAR; PG8_SCHED;
            } else {
            PG8_LDB(B0, 0, 0); PG8_SCHED; PG8_LDA(At, 0, 0); PG8_STAGE(PG8_SA(1, 1), a1 + hstep, voffA);
            PG8_WAIT_L(8); PG8_BAR; PG8_WAIT_L(0); PG8_MMA(0, 0, At, B0); PG8_BAR; PG8_SCHED;
            PG8_LDB(B1, 0, 1); PG8_STAGE(PG8_SB(0, 0), b2, voffB);
            PG8_BAR; PG8_WAIT_L(0); PG8_MMA(0, 1, At, B1); PG8_BAR;
            PG8_LDA(At, 0, 1); PG8_STAGE(PG8_SA(0, 0), a2, voffA);
            PG8_BAR; PG8_WAIT_L(0); PG8_MMA(1, 0, At, B0); PG8_BAR; PG8_SCHED;
            PG8_STAGE(PG8_SB(0, 1), b2 + hstep, voffB);
            PG8_WAIT_V(6); PG8_BAR; PG8_MMA(1, 1, At, B1); PG8_BAR;
            PG8_LDB(B0, 1, 0); PG8_SCHED; PG8_LDA(At, 1, 0); PG8_STAGE(PG8_SA(0, 1), a2 + hstep, voffA);
            PG8_WAIT_L(8); PG8_BAR; PG8_WAIT_L(0); PG8_MMA(0, 0, At, B0); PG8_BAR; PG8_SCHED;
            PG8_LDB(B1, 1, 1); PG8_STAGE(PG8_SB(1, 0), b3, voffB);
            PG8_BAR; PG8_WAIT_L(0); PG8_MMA(0, 1, At, B1); PG8_BAR;
            PG8_LDA(At, 1, 1); PG8_STAGE(PG8_SA(1, 0), a3, voffA);
            PG8_BAR; PG8_WAIT_L(0); PG8_MMA(1, 0, At, B0); PG8_BAR; PG8_SCHED;
            PG8_STAGE(PG8_SB(1, 1), b3 + hstep, voffB);
            PG8_WAIT_V(6); PG8_BAR; PG8_MMA(1, 1, At, B1); PG8_BAR;
            }
        }
        if constexpr (ALIGN_EPI) { if (wr == 0) PG8_BAR; }
        if constexpr (!Epi::AFTER_DRAIN) { E(acc, cur, wr, wc, fr, fq); S.done(cur); }
        if (!has_next) break;
#pragma unroll
        for (int a = 0; a < 2; ++a)
#pragma unroll
            for (int b = 0; b < 2; ++b)
#pragma unroll
                for (int m = 0; m < 4; ++m)
#pragma unroll
                    for (int n = 0; n < 2; ++n) acc[a][b][m][n] = (f32x4){0.f, 0.f, 0.f, 0.f};
        cur = nxt; cA = nA; cB = nB; ++ui;
        if constexpr (ALIGN_EPI) { if (wr == 1) PG8_BAR; }
    }
    PG8_WAIT_V(0);
    if constexpr (!ALIGN_EPI) { if (wr == 0) PG8_BAR; }
    PG8_BAR;
    if constexpr (Epi::AFTER_DRAIN) { E.fused(acc, cur, wr, wc, fr, fq, lds, wid, lane); S.done(cur); }
#undef PG8_SA
#undef PG8_SB
#undef PG8_STAGE
#undef PG8_LDA
#undef PG8_LDB
#undef PG8_MMA
#undef PG8_WAIT_V
#undef PG8_WAIT_L
#undef PG8_BAR
#undef PG8_SCHED
}
}

constexpr int NWAVES = 8, NTHR = 512;
constexpr int N_LAUNCHES = MK_N_LAUNCHES;
constexpr int N_PHASES = 13;
constexpr int DM = 2048, NB = 4, TL = 2048, NLAT = NB * TL, TCX = 256, NCTX = NB * TCX, NTOK = NLAT + NCTX;
constexpr int NH = 8, QKD = 128, VD = 256, INC = 14368, ZW = 14336;
constexpr int ZQ = 0, ZK = 1024, ZV = 2048, ZO = 4096, ZU = 6144, ZS = 8192, ZGA = 10240, ZGB = 12288;
constexpr int NEXP = 32, DEXP = 2048, NCH = 18  , CROWS = 272  ;
constexpr float EPS = 1e-6f;

constexpr size_t MiB = 1u << 20;
constexpr size_t WS_CTL = 0, CTL_ZERO_BYTES = 1 * MiB;
constexpr size_t WS_MOD = 1 * MiB;
constexpr size_t WS_GATES = 2 * MiB;
constexpr size_t WS_SCAL = 4 * MiB;
constexpr size_t WS_ROUTE = 5 * MiB;
constexpr size_t WS_SCN = 2996 * MiB;
constexpr size_t WS_SK = 6 * MiB;
constexpr size_t WS_WINT = 8 * MiB;
constexpr size_t WS_PAT = 64 * MiB, WS_PBT = 72 * MiB, WS_WOT = 80 * MiB;
constexpr size_t WS_W1T = 88 * MiB;
constexpr size_t WS_W2T = 600 * MiB;
constexpr size_t WS_HB = 856 * MiB;
constexpr size_t WS_Z = 892 * MiB;
constexpr size_t WS_QC = 1144 * MiB, WS_KC = 1162 * MiB;
constexpr size_t WS_SVN = 1180 * MiB;
constexpr size_t WS_DC = 1212 * MiB;
constexpr size_t WS_CS = 1360 * MiB;
constexpr size_t WS_RO = 1428 * MiB;
constexpr size_t WS_CM = 1460 * MiB;
constexpr size_t WS_YB = 1492 * MiB;
constexpr size_t WS_MRG = 1556 * MiB;
constexpr size_t WS_X1 = 1588 * MiB;
constexpr size_t WS_ACT = 1652 * MiB;
constexpr size_t WS_Y2 = 1812 * MiB;
constexpr size_t WS_XG = 1972 * MiB;
constexpr size_t WS_END = 2998 * MiB;
static_assert(WS_DC + (size_t)64 * 17 * CROWS * 128 * 2 <= WS_CS && WS_CS + (size_t)64 * 16 * CROWS * 128 * 2 <= WS_RO && WS_Z + (size_t)NTOK * ZW * 2 <= WS_QC, "ws map");
constexpr int CW_Q = 2048;
constexpr int CW_CNT = 64;
constexpr int CW_BAR = 4096;
constexpr int RING_BYTES = 131072;
constexpr int LDS_BYTES = 147456;
constexpr int LDSCTL_OFF = LDS_BYTES - 2048, MISC_OFF = LDSCTL_OFF + 320, PREF_OFF = LDSCTL_OFF + 1024;

#define GAS __attribute__((address_space(1)))
#define LAS __attribute__((address_space(3)))
typedef unsigned short bf16;
typedef unsigned v4u __attribute__((ext_vector_type(4)));
typedef unsigned v2u __attribute__((ext_vector_type(2)));
typedef float f32x4 __attribute__((ext_vector_type(4)));
typedef short bf16x8 __attribute__((ext_vector_type(8)));
typedef short s16x4 __attribute__((ext_vector_type(4)));
typedef GAS unsigned gu32;
#define RLX_AGENT __ATOMIC_RELAXED, __HIP_MEMORY_SCOPE_AGENT
#define LDS_WAIT() asm volatile("s_waitcnt lgkmcnt(0)" ::: "memory")
#define VM_WAIT() asm volatile("s_waitcnt vmcnt(0)" ::: "memory")
using pg8::cvt_pk_bf16; using pg8::bf_lo; using pg8::bf_hi; using pg8::sigmoidf_;


__device__ __forceinline__ float wave_sum(float v) {
#pragma unroll
    for (int o = 1; o < 64; o <<= 1) v += __shfl_xor(v, o);
    return v;
}
__device__ __forceinline__ float siluf_(float x) { return x * __builtin_amdgcn_rcpf(1.0f + __expf(-x)); }
__device__ __forceinline__ float gelu_tanh(float x) { const float u = 0.7978845608028654f * (x + 0.044715f * x * x * x); return x * __builtin_amdgcn_rcpf(1.0f + __expf(-2.0f * u)); }
__device__ __forceinline__ float logsigf_(float f) { return fminf(f, 0.f) - log1pf(expf(-fabsf(f))); }
__device__ __forceinline__ unsigned img_off(unsigned row, unsigned ch) { return 256u * row + 16u * (ch ^ (((row & 3u) << 2) | ((row >> 2) & 3u))); }
__device__ __forceinline__ s16x4 tr_read(LAS unsigned char* p) { return __builtin_amdgcn_ds_read_tr16_b64_v4i16((LAS s16x4*)p); }
__device__ __forceinline__ bf16x8 tr_frag(LAS unsigned char* img, unsigned r0, unsigned r1, unsigned c, int lane) {
    const unsigned q = (lane & 15) >> 2, p = lane & 3;
    const s16x4 lo = tr_read(img + img_off(r0 + q, 2 * c + (p >> 1)) + 8 * (p & 1));
    const s16x4 hi = tr_read(img + img_off(r1 + q, 2 * c + (p >> 1)) + 8 * (p & 1));
    bf16x8 r; r[0] = lo[0]; r[1] = lo[1]; r[2] = lo[2]; r[3] = lo[3]; r[4] = hi[0]; r[5] = hi[1]; r[6] = hi[2]; r[7] = hi[3]; return r;
}
__device__ __forceinline__ bf16x8 tr_frag2(LAS unsigned char* base, unsigned x0, unsigned x1) {
    const s16x4 lo = tr_read(base + x0), hi = tr_read(base + x1);
    bf16x8 r; r[0] = lo[0]; r[1] = lo[1]; r[2] = lo[2]; r[3] = lo[3]; r[4] = hi[0]; r[5] = hi[1]; r[6] = hi[2]; r[7] = hi[3]; return r;
}
#define TR_NAT_OFFS(xn0, xn1, lane) unsigned xn0[8], xn1[8]; { const unsigned g_ = (lane) >> 4, q_ = ((lane) & 15) >> 2, p_ = (lane) & 3; \
    _Pragma("unroll") for (int c_ = 0; c_ < 8; ++c_) { xn0[c_] = 256u * (8 * g_ + q_) + 16u * ((2 * c_ + (p_ >> 1)) ^ ((q_ << 2) | ((2 * g_) & 3))) + 8u * (p_ & 1); \
                                                       xn1[c_] = 256u * (8 * g_ + 4 + q_) + 16u * ((2 * c_ + (p_ >> 1)) ^ ((q_ << 2) | ((2 * g_ + 1) & 3))) + 8u * (p_ & 1); } }
#define TR_PERM_OFFS(xp, lane) unsigned xp[8]; { const unsigned g_ = (lane) >> 4, q_ = ((lane) & 15) >> 2, p_ = (lane) & 3; \
    _Pragma("unroll") for (int c_ = 0; c_ < 8; ++c_) xp[c_] = 256u * (4 * g_ + q_) + 16u * ((2 * c_ + (p_ >> 1)) ^ ((q_ << 2) | g_)) + 8u * (p_ & 1); }
__device__ __forceinline__ void load_tile128(LAS unsigned char* img, const bf16* src, size_t ld, int tid) {
#pragma unroll
    for (int i = 0; i < 4; ++i) { const int id = tid + NTHR * i, row = id >> 4, ch = id & 15;
        const v4u v = *(const v4u*)(src + (size_t)row * ld + 8 * ch); *(LAS v4u*)(img + img_off(row, ch)) = v; }
}
__device__ __forceinline__ void load_tile128_scaled(LAS unsigned char* img, const bf16* src, size_t ld, const LAS float* w, int tid) {
#pragma unroll
    for (int i = 0; i < 4; ++i) { const int id = tid + NTHR * i, row = id >> 4, ch = id & 15; const float s = w[row];
        const v4u v = *(const v4u*)(src + (size_t)row * ld + 8 * ch); v4u o;
        o.x = cvt_pk_bf16(bf_lo(v.x) * s, bf_hi(v.x) * s); o.y = cvt_pk_bf16(bf_lo(v.y) * s, bf_hi(v.y) * s); o.z = cvt_pk_bf16(bf_lo(v.z) * s, bf_hi(v.z) * s); o.w = cvt_pk_bf16(bf_lo(v.w) * s, bf_hi(v.w) * s);
        *(LAS v4u*)(img + img_off(row, ch)) = o; }
}
__device__ __forceinline__ void gate_scan(const float* G, size_t row0, int col_i, int col_f, int dir, int lane, float* bc, float* gg, float* pmx, float& b_end, float& gmax) {
    const int j0 = dir ? 127 - 2 * lane : 2 * lane, j1 = dir ? 126 - 2 * lane : 2 * lane + 1;
    const float f0 = G[(row0 + j0) * 32 + col_f], f1 = G[(row0 + j1) * 32 + col_f], i0 = G[(row0 + j0) * 32 + col_i], i1 = G[(row0 + j1) * 32 + col_i];
    const float lf0 = logsigf_(f0), lf1 = logsigf_(f1), s = lf0 + lf1; float incl = s;
#pragma unroll
    for (int o = 1; o < 64; o <<= 1) { const float t = __shfl_up(incl, o); if (lane >= o) incl += t; }
    const float b0 = (incl - s) + lf0, b1 = incl, g0 = i0 - b0, g1 = i1 - b1;
    float mincl = fmaxf(g0, g1);
#pragma unroll
    for (int o = 1; o < 64; o <<= 1) { const float t = __shfl_up(mincl, o); if (lane >= o) mincl = fmaxf(mincl, t); }
    float mexcl = __shfl_up(mincl, 1); if (lane == 0) mexcl = -3.0e38f;
    bc[j0] = b0; bc[j1] = b1; gg[j0] = g0; gg[j1] = g1; pmx[j0] = fmaxf(mexcl, g0); pmx[j1] = mincl;
    b_end = __shfl(incl, 63); gmax = __shfl(mincl, 63);
}
#define MFMA16(a, b, c) __builtin_amdgcn_mfma_f32_16x16x32_bf16((a), (b), (c), 0, 0, 0)

struct CvtItem { const float* src; size_t ldw; bf16* dst; };
constexpr int N_CONVERTERS = 112;
constexpr int N_CONV_DEFER = 1440;
constexpr int I_GEMV = 192, I_WIN = 16 * 56, I_P = 16 * 8, I_W1 = 32 * 16 * 16, I_W2 = 32 * 16 * 8, I_TOTAL = I_GEMV + I_WIN + 3 * I_P + I_W1 + I_W2;
__device__ __forceinline__ CvtItem cvt_decode(int r, int tid, const float* w_in, const float* proj_a, const float* proj_b, const float* w_out, const float* exp_w1, const float* exp_w2,
                                              bf16* WINT, bf16* PAT, bf16* PBT, bf16* WOT, bf16* W1T, bf16* W2T) {
    const int n4 = tid & 63, kg = tid >> 6; const float* W; size_t ldw, ca, cb, drow; int kt; bf16* WT;
    if (r < I_WIN) { kt = r / 56; const int nt = r % 56; W = w_in; ldw = INC; ca = (size_t)256 * nt + (nt >= 16 ? 32 : 0); cb = ca + 128; WT = WINT; drow = (size_t)256 * nt; }
    else if ((r -= I_WIN) < 3 * I_P) { const int m = r / I_P, q = r % I_P; kt = q / 8; const int nt = q % 8; W = m == 0 ? proj_a : (m == 1 ? proj_b : w_out); ldw = 2048; ca = (size_t)256 * nt; cb = ca + 128; WT = m == 0 ? PAT : (m == 1 ? PBT : WOT); drow = (size_t)256 * nt; }
    else if ((r -= 3 * I_P) < I_W1) { const int e = r / 256, q = r % 256; kt = q / 16; const int nt = q % 16; W = exp_w1 + (size_t)e * 2048 * 4096; ldw = 4096; ca = (size_t)128 * nt; cb = 2048 + ca; WT = W1T; drow = (size_t)e * 4096 + 256 * nt; }
    else { r -= I_W1; const int e = r / 128, q = r % 128; kt = q / 8; const int nt = q % 8; W = exp_w2 + (size_t)e * 2048 * 2048; ldw = 2048; ca = (size_t)256 * nt; cb = ca + 128; WT = W2T; drow = (size_t)e * 2048 + 256 * nt; }
    CvtItem it; it.ldw = ldw; it.src = W + (size_t)(128 * kt + 8 * kg) * ldw + (n4 < 32 ? ca + 4 * n4 : cb + 4 * (n4 - 32)); it.dst = WT + drow * 2048 + 128 * kt; return it;
}
__device__ __forceinline__ void cvt_run(LAS unsigned char* lds, int tid, int it, int stride, int end, const float* w_in, const float* proj_a, const float* proj_b, const float* w_out, const float* exp_w1, const float* exp_w2,
                                        bf16* WINT, bf16* PAT, bf16* PBT, bf16* WOT, bf16* W1T, bf16* W2T) {
    const int n4 = tid & 63, kg = tid >> 6;
    f32x4 v[16]; CvtItem cur;
    bool have = it < end;
    if (have) { cur = cvt_decode(it - I_GEMV, tid, w_in, proj_a, proj_b, w_out, exp_w1, exp_w2, WINT, PAT, PBT, WOT, W1T, W2T);
#pragma unroll
        for (int i = 0; i < 16; ++i) v[i] = __builtin_nontemporal_load((const f32x4*)(cur.src + (size_t)((i >> 3) * 64 + (i & 7)) * cur.ldw)); }
    while (have) {
#pragma unroll
        for (int hf = 0; hf < 2; ++hf)
#pragma unroll
            for (int j = 0; j < 4; ++j) { v4u o; o.x = cvt_pk_bf16(v[8 * hf + 0][j], v[8 * hf + 1][j]); o.y = cvt_pk_bf16(v[8 * hf + 2][j], v[8 * hf + 3][j]); o.z = cvt_pk_bf16(v[8 * hf + 4][j], v[8 * hf + 5][j]); o.w = cvt_pk_bf16(v[8 * hf + 6][j], v[8 * hf + 7][j]);
                *(LAS v4u*)(lds + img_off(4 * n4 + j, 8 * hf + kg)) = o; }
        __syncthreads();
        bf16* dst = cur.dst;
        it += stride; have = it < end;
        if (have) { cur = cvt_decode(it - I_GEMV, tid, w_in, proj_a, proj_b, w_out, exp_w1, exp_w2, WINT, PAT, PBT, WOT, W1T, W2T);
#pragma unroll
            for (int i = 0; i < 16; ++i) v[i] = __builtin_nontemporal_load((const f32x4*)(cur.src + (size_t)((i >> 3) * 64 + (i & 7)) * cur.ldw)); }
#pragma unroll
        for (int i = 0; i < 8; ++i) { const int id = tid + NTHR * i, row = id >> 4, ch = id & 15; const v4u o = *(const LAS v4u*)(lds + img_off(row, ch)); __builtin_nontemporal_store(o, (v4u*)(dst + (size_t)row * 2048 + 8 * ch)); }
        __syncthreads();
    }
}
__device__ __forceinline__ void p0_phase(LAS unsigned char* lds, int tid, int G, const float* c, const float* c_ctx, const float* mod_w, const float* mod_b, float* MOD,
                                         const float* w_in, const float* proj_a, const float* proj_b, const float* w_out, const float* exp_w1, const float* exp_w2, const float* router_w,
                                         bf16* WINT, bf16* PAT, bf16* PBT, bf16* WOT, bf16* W1T, bf16* W2T, bf16* SK, int n_conv_p0) {
    LAS float* sc = (LAS float*)lds;
    LAS float* red = (LAS float*)(lds + 40960);
    int it = blockIdx.x;
    if (it < I_GEMV) {
        for (int i = tid; i < 5 * 2048; i += NTHR) { const float x = i < 4 * 2048 ? c[i] : c_ctx[i - 4 * 2048]; sc[i] = siluf_(x); }
        __syncthreads();
        for (; it < I_GEMV; it += G) {
            const int j0 = 64 * it, c4 = tid & 15, kg = tid >> 4;
            f32x4 a0 = {0.f, 0.f, 0.f, 0.f}, a1 = a0, a2 = a0, a3 = a0, a4 = a0;
            const float* wp = mod_w + (size_t)kg * 12288 + j0 + 4 * c4;
#pragma unroll 8
            for (int k = kg; k < 2048; k += 32) { const f32x4 w = *(const f32x4*)wp; wp += (size_t)32 * 12288;
                a0 += w * sc[k]; a1 += w * sc[2048 + k]; a2 += w * sc[4096 + k]; a3 += w * sc[6144 + k]; a4 += w * sc[8192 + k]; }
            *(LAS f32x4*)(red + (kg * 5 + 0) * 64 + 4 * c4) = a0; *(LAS f32x4*)(red + (kg * 5 + 1) * 64 + 4 * c4) = a1; *(LAS f32x4*)(red + (kg * 5 + 2) * 64 + 4 * c4) = a2;
            *(LAS f32x4*)(red + (kg * 5 + 3) * 64 + 4 * c4) = a3; *(LAS f32x4*)(red + (kg * 5 + 4) * 64 + 4 * c4) = a4;
            __syncthreads();
            if (tid < 320) { const int rr = tid >> 6, j = tid & 63; float s = 0.f;
#pragma unroll 8
                for (int g = 0; g < 32; ++g) s += red[(g * 5 + rr) * 64 + j];
                MOD[rr * 12288 + j0 + j] = s + mod_b[j0 + j]; }
            __syncthreads();
        }
    } else {
        for (int i = (it - I_GEMV) * NTHR + tid; i < 2 * 32 * 2048; i += (G - I_GEMV) * NTHR) { const int m = i >> 16, n = (i >> 11) & 31, k = i & 2047;
            const float w = m == 0 ? w_in[(size_t)k * INC + 4096 + n] : router_w[k * 32 + n];
            const unsigned hi = cvt_pk_bf16(w, 0.f) & 0xffffu; const unsigned lo = cvt_pk_bf16(w - __uint_as_float(hi << 16), 0.f) & 0xffffu;
            SK[(size_t)(2 * m) * 65536 + n * 2048 + k] = (bf16)hi; SK[(size_t)(2 * m + 1) * 65536 + n * 2048 + k] = (bf16)lo; }
    }
    cvt_run(lds, tid, it, G, I_GEMV + n_conv_p0, w_in, proj_a, proj_b, w_out, exp_w1, exp_w2, WINT, PAT, PBT, WOT, W1T, W2T);
}

__device__ __forceinline__ void skinny_mfma(const LAS float* hrow, const bf16* WT_hi, const bf16* WT_lo, LAS float* part, int wave, int lane) {
    const int g = lane >> 4, l15 = lane & 15;
    f32x4 acc0 = {0.f, 0.f, 0.f, 0.f}, acc1 = acc0;
#pragma unroll
    for (int ks = 0; ks < 8; ++ks) { const int kb = 256 * wave + 32 * ks + 8 * g;
        f32x4 a0 = {0.f, 0.f, 0.f, 0.f}, a1 = a0;
        if (l15 < 8) { a0 = *(const LAS f32x4*)(hrow + l15 * 2048 + kb); a1 = *(const LAS f32x4*)(hrow + l15 * 2048 + kb + 4); }
        v4u hi, lo;
        hi.x = cvt_pk_bf16(a0[0], a0[1]); hi.y = cvt_pk_bf16(a0[2], a0[3]); hi.z = cvt_pk_bf16(a1[0], a1[1]); hi.w = cvt_pk_bf16(a1[2], a1[3]);
        lo.x = cvt_pk_bf16(a0[0] - bf_lo(hi.x), a0[1] - bf_hi(hi.x)); lo.y = cvt_pk_bf16(a0[2] - bf_lo(hi.y), a0[3] - bf_hi(hi.y));
        lo.z = cvt_pk_bf16(a1[0] - bf_lo(hi.z), a1[1] - bf_hi(hi.z)); lo.w = cvt_pk_bf16(a1[2] - bf_lo(hi.w), a1[3] - bf_hi(hi.w));
        const bf16x8 Ah = __builtin_bit_cast(bf16x8, hi), Al = __builtin_bit_cast(bf16x8, lo);
        const bf16x8 b0h = *(const bf16x8*)(WT_hi + (size_t)l15 * 2048 + kb), b0l = *(const bf16x8*)(WT_lo + (size_t)l15 * 2048 + kb);
        const bf16x8 b1h = *(const bf16x8*)(WT_hi + (size_t)(16 + l15) * 2048 + kb), b1l = *(const bf16x8*)(WT_lo + (size_t)(16 + l15) * 2048 + kb);
        acc0 = MFMA16(Ah, b0h, acc0); acc0 = MFMA16(Ah, b0l, acc0); acc0 = MFMA16(Al, b0h, acc0);
        acc1 = MFMA16(Ah, b1h, acc1); acc1 = MFMA16(Ah, b1l, acc1); acc1 = MFMA16(Al, b1h, acc1); }
    if (g < 2) {
#pragma unroll
        for (int r = 0; r < 4; ++r) { part[wave * 256 + (4 * g + r) * 32 + l15] = acc0[r]; part[wave * 256 + (4 * g + r) * 32 + 16 + l15] = acc1[r]; } }
}

__device__ __forceinline__ void p1_phase(LAS unsigned char* lds, int tid, int wave, int lane, int G, const float* x, const float* ctx, const float* MOD, const float* norm_g,
                                         const bf16* SK, const float* gate_b, bf16* HB, float* GATES) {
    LAS float* hrow = (LAS float*)(lds + wave * 8192); LAS float* part = (LAS float*)(lds + 65536);
    f32x4 v[8];
    { const int row = blockIdx.x * 8 + wave; const float* xr = row < NLAT ? x + (size_t)row * DM : ctx + (size_t)(row - NLAT) * DM;
#pragma unroll
      for (int j = 0; j < 8; ++j) v[j] = *(const f32x4*)(xr + 4 * (lane + 64 * j)); }
    for (int it = blockIdx.x; it < NTOK / 8; it += G) {
        const int row = it * 8 + wave;
        const float* shift = MOD + (size_t)(row < NLAT ? (row >> 11) : 4) * 12288; const float* scale = shift + 2048;
        float ss = 0.f;
#pragma unroll
        for (int j = 0; j < 8; ++j) ss += (v[j][0] * v[j][0] + v[j][1] * v[j][1]) + (v[j][2] * v[j][2] + v[j][3] * v[j][3]);
        const float rstd = 1.0f / sqrtf(wave_sum(ss) * (1.0f / DM) + EPS);
#pragma unroll
        for (int j = 0; j < 8; ++j) { const int col = 4 * (lane + 64 * j);
            const f32x4 g = *(const f32x4*)(norm_g + col), sc = *(const f32x4*)(scale + col), sh = *(const f32x4*)(shift + col);
            const f32x4 h = (v[j] * rstd) * g * (sc + 1.0f) + sh;
            v2u o; o.x = cvt_pk_bf16(h[0], h[1]); o.y = cvt_pk_bf16(h[2], h[3]); *(v2u*)(HB + (size_t)row * DM + col) = o;
            *(LAS f32x4*)(hrow + col) = h; }
        if (it + G < NTOK / 8) { const int rown = (it + G) * 8 + wave; const float* xr = rown < NLAT ? x + (size_t)rown * DM : ctx + (size_t)(rown - NLAT) * DM;
#pragma unroll
            for (int j = 0; j < 8; ++j) v[j] = *(const f32x4*)(xr + 4 * (lane + 64 * j)); }
        __syncthreads();
        skinny_mfma((const LAS float*)lds, SK, SK + 65536, part, wave, lane);
        __syncthreads();
        if (tid < 256) { float s = 0.f;
#pragma unroll
            for (int w = 0; w < 8; ++w) s += part[w * 256 + tid];
            GATES[(size_t)(it * 8) * 32 + tid] = s + gate_b[tid & 31]; }
    }
}

__device__ __forceinline__ void p3_phase(int wave, int lane, int G, const bf16* Z, const float* conv_w, const float* conv_b, const float* sgu_norm_g, bf16* QC, bf16* KC, bf16* SVN,
                                         const float* GATES, float* SCN, float* BEND, float* GMAX) {
    const int gw = blockIdx.x * NWAVES + wave, NGW = G * NWAVES;
    for (int task = gw; task < 64 * NCH; task += NGW) { const int bhd = task / NCH, bi = task - bhd * NCH, dir = bhd & 1, bh = bhd >> 1, b = bh >> 3, h = bh & 7;
        const size_t row0 = bi < 2 ? (size_t)NLAT + b * TCX + bi * 128 : (size_t)b * TL + (bi - 2) * 128;
        float* sp = SCN + (size_t)task * 384; float b_end, gmax;
        gate_scan(GATES, row0, (2 * dir) * 8 + h, (2 * dir + 1) * 8 + h, dir, lane, sp, sp + 128, sp + 256, b_end, gmax);
        const int c = dir == 0 ? bi : (bi < 2 ? 1 - bi : 19 - bi);
        if (lane == 0 && c < 17) { BEND[bhd * 17 + c] = b_end; GMAX[bhd * 17 + c] = gmax; } }
    for (int item = gw; item < NTOK; item += NGW) {
        const int rb = item >> 2, seg = item & 3, row0 = rb * 4, c0 = seg * 512 + lane * 8;
        const int t0 = row0 < NLAT ? (row0 & (TL - 1)) : ((row0 - NLAT) & (TCX - 1)), len = row0 < NLAT ? TL : TCX;
        v4u zr[8];
#pragma unroll
        for (int k = 0; k < 8; ++k) { const int tt = t0 + k - 2; zr[k] = (v4u){0u, 0u, 0u, 0u};
            if (tt >= 0 && tt < len) zr[k] = *(const v4u*)(Z + (size_t)(row0 + k - 2) * ZW + c0); }
        f32x4 w0[5], w1[5];
#pragma unroll
        for (int tau = 0; tau < 5; ++tau) { w0[tau] = *(const f32x4*)(conv_w + tau * 2048 + c0); w1[tau] = *(const f32x4*)(conv_w + tau * 2048 + c0 + 4); }
        const f32x4 b0 = *(const f32x4*)(conv_b + c0), b1 = *(const f32x4*)(conv_b + c0 + 4);
        const float qs = c0 < 1024 ? 0.08838834764831845f : 1.0f;
#pragma unroll
        for (int o = 0; o < 4; ++o) { float acc[8] = {b0[0], b0[1], b0[2], b0[3], b1[0], b1[1], b1[2], b1[3]};
#pragma unroll
            for (int tau = 0; tau < 5; ++tau) { const v4u z = zr[o + tau];
                acc[0] += w0[tau][0] * bf_lo(z.x); acc[1] += w0[tau][1] * bf_hi(z.x); acc[2] += w0[tau][2] * bf_lo(z.y); acc[3] += w0[tau][3] * bf_hi(z.y);
                acc[4] += w1[tau][0] * bf_lo(z.z); acc[5] += w1[tau][1] * bf_hi(z.z); acc[6] += w1[tau][2] * bf_lo(z.w); acc[7] += w1[tau][3] * bf_hi(z.w); }
#pragma unroll
            for (int i = 0; i < 8; ++i) acc[i] = siluf_(acc[i]) * qs;
            v4u ov; ov.x = cvt_pk_bf16(acc[0], acc[1]); ov.y = cvt_pk_bf16(acc[2], acc[3]); ov.z = cvt_pk_bf16(acc[4], acc[5]); ov.w = cvt_pk_bf16(acc[6], acc[7]);
            bf16* dst = c0 < 1024 ? QC + (size_t)(row0 + o) * 1024 + c0 : KC + (size_t)(row0 + o) * 1024 + (c0 - 1024);
            *(v4u*)dst = ov; }
    }
    for (int row = gw; row < NLAT; row += NGW) {
        float v[32]; float ss = 0.f;
#pragma unroll
        for (int j = 0; j < 4; ++j) { const v4u z = *(const v4u*)(Z + (size_t)row * ZW + ZS + 8 * lane + 512 * j);
            v[8 * j + 0] = gelu_tanh(bf_lo(z.x)); v[8 * j + 1] = gelu_tanh(bf_hi(z.x)); v[8 * j + 2] = gelu_tanh(bf_lo(z.y)); v[8 * j + 3] = gelu_tanh(bf_hi(z.y));
            v[8 * j + 4] = gelu_tanh(bf_lo(z.z)); v[8 * j + 5] = gelu_tanh(bf_hi(z.z)); v[8 * j + 6] = gelu_tanh(bf_lo(z.w)); v[8 * j + 7] = gelu_tanh(bf_hi(z.w)); }
#pragma unroll
        for (int i = 0; i < 32; ++i) ss += v[i] * v[i];
        const float rstd = 1.0f / sqrtf(wave_sum(ss) * (1.0f / DM) + EPS);
#pragma unroll
        for (int j = 0; j < 4; ++j) { const int col = 8 * lane + 512 * j; const f32x4 g0 = *(const f32x4*)(sgu_norm_g + col), g1 = *(const f32x4*)(sgu_norm_g + col + 4);
            v4u o; o.x = cvt_pk_bf16(v[8 * j] * rstd * g0[0], v[8 * j + 1] * rstd * g0[1]); o.y = cvt_pk_bf16(v[8 * j + 2] * rstd * g0[2], v[8 * j + 3] * rstd * g0[3]);
            o.z = cvt_pk_bf16(v[8 * j + 4] * rstd * g1[0], v[8 * j + 5] * rstd * g1[1]); o.w = cvt_pk_bf16(v[8 * j + 6] * rstd * g1[2], v[8 * j + 7] * rstd * g1[3]);
            *(v4u*)(SVN + (size_t)row * DM + col) = o; }
    }
}

constexpr int L_V0 = 0, L_V1 = 32768, L_K = 65536, L_SC = 98304, L_CB = 106496;
constexpr int N_M1 = 64 * 17, N_SGU = 512;
__device__ __forceinline__ void p4_phase(LAS unsigned char* lds, int tid_, int wave, int lane_, int G, const bf16* Z, const bf16* KC, const bf16* SVN, const float* SCN,
                                         const float* sgu_w, const float* sgu_b, bf16* DC, const float* GMAX, bf16* CM) {
    v4u pk[4], pv[8]; f32x4 pa[2];
#define P4_ISSUE(U) do { const int u_ = (U); int t_ = tid_; asm volatile("" : "+v"(t_)); \
        if (u_ < N_M1) { const int bhd_ = u_ / 17, c_ = u_ - bhd_ * 17, dir_ = bhd_ & 1, bh_ = bhd_ >> 1, b_ = bh_ >> 3, h_ = bh_ & 7; \
            const bool ic_ = c_ < 2; const int blk_ = dir_ == 0 ? (ic_ ? c_ : c_ - 2) : (ic_ ? 1 - c_ : 17 - c_); \
            const size_t r0_ = ic_ ? (size_t)NLAT + b_ * TCX + blk_ * 128 : (size_t)b_ * TL + blk_ * 128; \
            const float* sp_ = SCN + (size_t)(bhd_ * NCH + (ic_ ? blk_ : blk_ + 2)) * 384; \
            _Pragma("unroll") for (int i = 0; i < 4; ++i) { const int id = t_ + NTHR * i; pk[i] = *(const v4u*)(KC + (r0_ + (id >> 4)) * 1024 + h_ * QKD + 8 * (id & 15)); pa[0][i] = sp_[128 + (id >> 4)]; } \
            pa[1][0] = GMAX[bhd_ * 17 + c_]; \
            _Pragma("unroll") for (int i = 0; i < 8; ++i) { const int id = t_ + NTHR * (i & 3); pv[i] = *(const v4u*)(Z + (r0_ + (id >> 4)) * ZW + ZV + h_ * VD + 128 * (i >> 2) + 8 * (id & 15)); } \
        } else { const int u2_ = u_ - N_M1, b_ = u2_ >> 7, n_ = (u2_ >> 3) & 15, grp_ = u2_ & 7; const size_t r0_ = (size_t)b_ * TL + n_ * 128; \
            _Pragma("unroll") for (int i = 0; i < 8; ++i) { const int id = t_ + NTHR * (i & 3); pv[i] = *(const v4u*)(SVN + (r0_ + (id >> 4)) * DM + grp_ * 256 + 128 * (i >> 2) + 8 * (id & 15)); } \
            } } while (0)
    int u = blockIdx.x;
    if (u < N_M1 + N_SGU) P4_ISSUE(u);
    for (; u < N_M1 + N_SGU; u += G) {
        int tid = tid_; asm volatile("" : "+v"(tid)); const int lane = tid & 63; const unsigned g = lane >> 4, l15 = lane & 15;
        const bool m1 = u < N_M1;
        TR_NAT_OFFS(xn0, xn1, lane)
#pragma unroll
        for (int i = 0; i < 8; ++i) { const int id = tid + NTHR * (i & 3); *(LAS v4u*)(lds + ((i >> 2) ? L_V1 : L_V0) + img_off(id >> 4, id & 15)) = pv[i]; }
        bf16x8 Af[4]; v2u uw[16];
        if (m1) { const float gmax = pa[1][0];
#pragma unroll
            for (int i = 0; i < 4; ++i) { const int id = tid + NTHR * i, row = id >> 4, ch = id & 15; const float sw = __expf(pa[0][i] - gmax); const v4u v = pk[i]; v4u o;
                o.x = cvt_pk_bf16(bf_lo(v.x) * sw, bf_hi(v.x) * sw); o.y = cvt_pk_bf16(bf_lo(v.y) * sw, bf_hi(v.y) * sw); o.z = cvt_pk_bf16(bf_lo(v.z) * sw, bf_hi(v.z) * sw); o.w = cvt_pk_bf16(bf_lo(v.w) * sw, bf_hi(v.w) * sw);
                *(LAS v4u*)(lds + L_K + img_off(row, ch)) = o; }
        }
        __syncthreads();
        f32x4 af32[8];
        if (!m1) { const int u2 = u - N_M1, b = u2 >> 7, n = (u2 >> 3) & 15, grp = u2 & 7;
            const float* src = sgu_w + (size_t)grp * 16384 + (size_t)(16 * wave + l15) * 128 + 8 * g;
#pragma unroll
            for (int ks = 0; ks < 4; ++ks) { af32[2 * ks] = *(const f32x4*)(src + 32 * ks); af32[2 * ks + 1] = *(const f32x4*)(src + 32 * ks + 4); }
            const bf16* up = Z + ((size_t)b * TL + n * 128 + 16 * wave + l15) * ZW + ZU + grp * 256 + 4 * g;
#pragma unroll
            for (int et = 0; et < 16; ++et) uw[et] = *(const v2u*)(up + 16 * et); }
        if (u + G < N_M1 + N_SGU) P4_ISSUE(u + G);
        if (!m1) {
#pragma unroll
            for (int ks = 0; ks < 4; ++ks) { const f32x4 a = af32[2 * ks], b2 = af32[2 * ks + 1];
                const v4u p = {cvt_pk_bf16(a[0], a[1]), cvt_pk_bf16(a[2], a[3]), cvt_pk_bf16(b2[0], b2[1]), cvt_pk_bf16(b2[2], b2[3])}; Af[ks] = __builtin_bit_cast(bf16x8, p); } }
        if (m1) {
            const int bhd = u / 17, c = u - bhd * 17;
#pragma unroll
            for (int ks = 0; ks < 4; ++ks) Af[ks] = tr_frag(lds + L_K, 32 * ks + 8 * g, 32 * ks + 8 * g + 4, wave, lane);
            f32x4 acc[17];
#pragma unroll
            for (int et = 0; et < 17; ++et) acc[et] = (f32x4){0.f, 0.f, 0.f, 0.f};
#pragma unroll
            for (int et = 0; et < 16; ++et) { LAS unsigned char* img = lds + ((et >> 3) ? L_V1 : L_V0);
#pragma unroll
                for (int ks = 0; ks < 4; ++ks) { const bf16x8 Bf = tr_frag2(img + 8192 * ks, xn0[et & 7], xn1[et & 7]); acc[et] = MFMA16(Af[ks], Bf, acc[et]); } }
            { const short one = l15 == 0 ? (short)0x3F80 : (short)0; const bf16x8 Bo = {one, one, one, one, one, one, one, one};
#pragma unroll
                for (int ks = 0; ks < 4; ++ks) acc[16] = MFMA16(Af[ks], Bo, acc[16]); }
            bf16* dst = DC + ((size_t)bhd * 17 + c) * (CROWS * 128) + 16 * wave + 4 * g;
#pragma unroll
            for (int et = 0; et < 16; ++et) { v2u o; o.x = cvt_pk_bf16(acc[et][0], acc[et][1]); o.y = cvt_pk_bf16(acc[et][2], acc[et][3]); *(v2u*)(dst + (size_t)(16 * et + l15) * 128) = o; }
            if (l15 == 0) { v2u o; o.x = cvt_pk_bf16(acc[16][0], acc[16][1]); o.y = cvt_pk_bf16(acc[16][2], acc[16][3]); *(v2u*)(dst + (size_t)256 * 128) = o; }
        } else {
            const int u2 = u - N_M1, b = u2 >> 7, n = (u2 >> 3) & 15, grp = u2 & 7; const size_t row0 = (size_t)b * TL + n * 128;
            f32x4 acc[16];
#pragma unroll
            for (int et = 0; et < 16; ++et) { acc[et] = (f32x4){0.f, 0.f, 0.f, 0.f}; LAS unsigned char* img = lds + ((et >> 3) ? L_V1 : L_V0);
#pragma unroll
                for (int ks = 0; ks < 4; ++ks) { const bf16x8 Bf = tr_frag2(img + 8192 * ks, xn0[et & 7], xn1[et & 7]); acc[et] = MFMA16(Bf, Af[ks], acc[et]); } }
            { const int t = 16 * wave + l15; const float zb = sgu_b[grp * 128 + t]; const size_t row = row0 + t;
#pragma unroll
              for (int et = 0; et < 16; ++et) { const int col = grp * 256 + 16 * et + 4 * g; const v2u w2 = uw[et];
                  const float o0 = gelu_tanh(bf_lo(w2.x)) * (acc[et][0] + zb), o1 = gelu_tanh(bf_hi(w2.x)) * (acc[et][1] + zb), o2 = gelu_tanh(bf_lo(w2.y)) * (acc[et][2] + zb), o3 = gelu_tanh(bf_hi(w2.y)) * (acc[et][3] + zb);
                  v2u o; o.x = cvt_pk_bf16(o0, o1); o.y = cvt_pk_bf16(o2, o3); *(v2u*)(CM + row * DM + col) = o; } }
        }
        __syncthreads();
    }
#undef P4_ISSUE
}

__device__ __forceinline__ void p5_scan(int tid, int G, const bf16* DC, const float* BEND, const float* GMAX, bf16* CS, float* MST) {
    constexpr int QPB = 257 * 128 / 4;
    for (int idx = blockIdx.x * NTHR + tid; idx < 64 * QPB; idx += G * NTHR) {
        const int bhd = idx / QPB, q = idx - bhd * QPB;
        f32x4 C = {0.f, 0.f, 0.f, 0.f}; float m = 0.f;
#pragma unroll
        for (int c = 0; c < 17; ++c) {
            const float gm = GMAX[bhd * 17 + c], be = BEND[bhd * 17 + c], mx = fmaxf(m, gm), al = __expf(m - mx), bt = __expf(gm - mx);
            const v2u dw = *(const v2u*)(DC + ((size_t)bhd * 17 + c) * (CROWS * 128) + 4 * q); const f32x4 d = {bf_lo(dw.x), bf_hi(dw.x), bf_lo(dw.y), bf_hi(dw.y)};
            C = C * al + d * bt; m = be + mx;
            if (c >= 1) { v2u o; o.x = cvt_pk_bf16(C[0], C[1]); o.y = cvt_pk_bf16(C[2], C[3]);
                *(v2u*)(CS + ((size_t)bhd * 16 + (c - 1)) * (CROWS * 128) + 4 * q) = o; if (q == 0) MST[bhd * 18 + c + 1] = m; }
        }
    }
}

__device__ __forceinline__ void p6_phase(LAS unsigned char* lds, int tid, int wave, int lane_, int G, const bf16* Z, const bf16* QC, const bf16* KC, const float* SCN,
                                         const bf16* CS, const float* MST, const float* mnorm_g, bf16* RO) {
    for (int u = blockIdx.x; u < 512; u += G) {
        int lane = lane_; asm volatile("" : "+v"(lane)); const unsigned g = lane >> 4, l15 = lane & 15;
        const int bh = u >> 4, jb = u & 15, b = bh >> 3, h = bh & 7; const size_t row0 = (size_t)b * TL + jb * 128;
        load_tile128(lds + L_K, KC + row0 * 1024 + h * QKD, 1024, tid);
        load_tile128(lds + L_V0, Z + row0 * ZW + ZV + h * VD, ZW, tid);
        load_tile128(lds + L_V1, Z + row0 * ZW + ZV + h * VD + 128, ZW, tid);
        bf16x8 Qf[4];
#pragma unroll
        for (int ks = 0; ks < 4; ++ks) Qf[ks] = *(const bf16x8*)(QC + (row0 + 16 * wave + l15) * 1024 + h * QKD + 32 * ks + 8 * g);
        __syncthreads();
        f32x4 hsum[16];
#pragma unroll
        for (int et = 0; et < 16; ++et) hsum[et] = (f32x4){0.f, 0.f, 0.f, 0.f};
#pragma unroll 1
        for (int dir = 0; dir < 2; ++dir) {
            int lane = lane_; asm volatile("" : "+v"(lane));
            const unsigned g = lane >> 4, l15 = lane & 15;
            TR_PERM_OFFS(xp, lane)
            const int c = dir ? 17 - jb : 2 + jb; const bf16* cs = CS + ((size_t)(bh * 2 + dir) * 16 + (c - 2)) * (CROWS * 128);
            const float* sp = SCN + (size_t)((bh * 2 + dir) * NCH + 2 + jb) * 384; const float* gg = sp + 128; const float mc = MST[(bh * 2 + dir) * 18 + c];
            const int tS = 16 * wave + l15; const float MtS = fmaxf(mc, sp[256 + tS]);
            unsigned pw[16];
#pragma unroll
            for (int st = 0; st < 8; ++st) { f32x4 aS = {0.f, 0.f, 0.f, 0.f};
#pragma unroll
                for (int ks = 0; ks < 4; ++ks) { const bf16x8 Kf = *(const LAS bf16x8*)(lds + L_K + img_off(16 * st + l15, 4 * ks + g)); aS = MFMA16(Kf, Qf[ks], aS); }
                float pv[4]; const f32x4 gs = *(const f32x4*)(gg + 16 * st + 4 * g);
#pragma unroll
                for (int r = 0; r < 4; ++r) { const int s = 16 * st + 4 * g + r; const bool ok = dir ? (s >= tS) : (s <= tS); const float ev = __expf(fminf(gs[r] - MtS, 0.f)); pv[r] = ok ? aS[r] * ev : 0.f; }
                pw[2 * st] = cvt_pk_bf16(pv[0], pv[1]); pw[2 * st + 1] = cvt_pk_bf16(pv[2], pv[3]); asm volatile("" ::: "memory"); }
            bf16x8 Pf[4];
#pragma unroll
            for (int ks = 0; ks < 4; ++ks) { const v4u t4 = {pw[4 * ks], pw[4 * ks + 1], pw[4 * ks + 2], pw[4 * ks + 3]}; Pf[ks] = __builtin_bit_cast(bf16x8, t4); }
            const float wiT = __expf(mc - MtS), flT = __expf(-(sp[tS] + MtS));
            const short one = l15 == 0 ? (short)0x3F80 : (short)0; const bf16x8 Bo = {one, one, one, one, one, one, one, one};
            float inv;
            { f32x4 ad = {0.f, 0.f, 0.f, 0.f};
#pragma unroll
              for (int ks = 0; ks < 4; ++ks) { bf16x8 Cf = *(const bf16x8*)(cs + (size_t)256 * 128 + 32 * ks + 8 * g); if (l15 != 0) Cf = (bf16x8){0, 0, 0, 0, 0, 0, 0, 0}; ad = MFMA16(Cf, Qf[ks], ad); }
              ad[0] *= wiT;
#pragma unroll
              for (int ks = 0; ks < 4; ++ks) ad = MFMA16(Bo, Pf[ks], ad);
              const float den = __shfl(ad[0], lane & 15); inv = 1.0f / fmaxf(fabsf(den), flT); }
            { v4u cr[2];
#pragma unroll
              for (int i = 0; i < 2; ++i) { const int id = tid + NTHR * i; cr[i] = *(const v4u*)(cs + (size_t)(id >> 4) * 128 + 8 * (id & 15)); }
#pragma unroll
              for (int i = 0; i < 2; ++i) { const int id = tid + NTHR * i; *(LAS v4u*)(lds + L_CB + img_off(id >> 4, id & 15)) = cr[i]; }
#pragma unroll
              for (int gq = 0; gq < 4; ++gq) {
                LAS unsigned char* cb = lds + L_CB + (gq & 1) * 16384;
                __syncthreads();
                if (gq < 3) {
#pragma unroll
                    for (int i = 0; i < 2; ++i) { const int id = tid + NTHR * i; cr[i] = *(const v4u*)(cs + (size_t)(64 * (gq + 1) + (id >> 4)) * 128 + 8 * (id & 15)); } }
                f32x4 acc[4];
#pragma unroll
                for (int i = 0; i < 4; ++i) { acc[i] = (f32x4){0.f, 0.f, 0.f, 0.f};
#pragma unroll
                    for (int ks = 0; ks < 4; ++ks) { const bf16x8 Cf = *(const LAS bf16x8*)(cb + img_off(16 * i + l15, 4 * ks + g)); acc[i] = MFMA16(Cf, Qf[ks], acc[i]); } }
#pragma unroll
                for (int i = 0; i < 4; ++i) acc[i] = acc[i] * wiT;
                { LAS unsigned char* img = lds + ((gq >> 1) ? L_V1 : L_V0);
#pragma unroll
                  for (int i = 0; i < 4; ++i) {
#pragma unroll
                    for (int ks = 0; ks < 4; ++ks) { const bf16x8 Vf = tr_frag2(img + 8192 * ks, xp[4 * (gq & 1) + i], xp[4 * (gq & 1) + i] + 4096u); acc[i] = MFMA16(Vf, Pf[ks], acc[i]); } } }
#pragma unroll
                for (int i = 0; i < 4; ++i) hsum[4 * gq + i] += acc[i] * inv;
                if (gq < 3) {
#pragma unroll
                    for (int i = 0; i < 2; ++i) { const int id = tid + NTHR * i; *(LAS v4u*)(lds + L_CB + ((gq + 1) & 1) * 16384 + img_off(id >> 4, id & 15)) = cr[i]; } }
              } }
        }
        { float ss = 0.f;
#pragma unroll
          for (int et = 0; et < 16; ++et) ss += (hsum[et][0] * hsum[et][0] + hsum[et][1] * hsum[et][1]) + (hsum[et][2] * hsum[et][2] + hsum[et][3] * hsum[et][3]);
          ss += __shfl_xor(ss, 16); ss += __shfl_xor(ss, 32);
          const float rstd = 1.0f / sqrtf(ss * (1.0f / VD) + EPS); const size_t row = row0 + 16 * wave + l15;
#pragma unroll
          for (int et = 0; et < 16; ++et) { const int col = h * VD + 16 * et + 4 * g;
              const v2u ow = *(const v2u*)(Z + row * ZW + ZO + col); const f32x4 gn = *(const f32x4*)(mnorm_g + col);
              const float v0 = hsum[et][0] * rstd * gn[0] * sigmoidf_(bf_lo(ow.x)), v1 = hsum[et][1] * rstd * gn[1] * sigmoidf_(bf_hi(ow.x));
              const float v2 = hsum[et][2] * rstd * gn[2] * sigmoidf_(bf_lo(ow.y)), v3 = hsum[et][3] * rstd * gn[3] * sigmoidf_(bf_hi(ow.y));
              v2u o; o.x = cvt_pk_bf16(v0, v1); o.y = cvt_pk_bf16(v2, v3); *(v2u*)(RO + row * DM + col) = o; } }
        __syncthreads();
    }
}

__device__ __forceinline__ void p9_phase(LAS unsigned char* lds, int wave, int lane, int G, const float* X1, const float* MOD, const float* norm_g, const bf16* SK, const float* router_b,
                                         unsigned* cnt, bf16* XG, int* RE, int* RR, float* RG) {
    LAS float* hrow = (LAS float*)(lds + wave * 8192); LAS float* part = (LAS float*)(lds + 65536);
    f32x4 vn[8];
    { const float* xr = X1 + (size_t)(blockIdx.x * 8 + wave) * DM;
#pragma unroll
      for (int j = 0; j < 8; ++j) vn[j] = *(const f32x4*)(xr + 4 * (lane + 64 * j)); }
    for (int it = blockIdx.x; it < NLAT / 8; it += G) {
        const int row = it * 8 + wave;
        const float* shift = MOD + (size_t)(row >> 11) * 12288 + 3 * 2048; const float* scale = shift + 2048;
        f32x4 v[8]; float ss = 0.f;
#pragma unroll
        for (int j = 0; j < 8; ++j) { v[j] = vn[j]; ss += (v[j][0] * v[j][0] + v[j][1] * v[j][1]) + (v[j][2] * v[j][2] + v[j][3] * v[j][3]); }
        const float rstd = 1.0f / sqrtf(wave_sum(ss) * (1.0f / DM) + EPS);
#pragma unroll
        for (int j = 0; j < 8; ++j) { const int col = 4 * (lane + 64 * j);
            const f32x4 g = *(const f32x4*)(norm_g + col), sc = *(const f32x4*)(scale + col), sh = *(const f32x4*)(shift + col);
            v[j] = (v[j] * rstd) * g * (sc + 1.0f) + sh; *(LAS f32x4*)(hrow + col) = v[j]; }
        if (it + G < NLAT / 8) { const float* xr = X1 + (size_t)((it + G) * 8 + wave) * DM;
#pragma unroll
            for (int j = 0; j < 8; ++j) vn[j] = *(const f32x4*)(xr + 4 * (lane + 64 * j)); }
        __syncthreads();
        skinny_mfma((const LAS float*)lds, SK + 2 * 65536, SK + 3 * 65536, part, wave, lane);
        __syncthreads();
        float val = router_b[lane & 31];
#pragma unroll
        for (int w = 0; w < 8; ++w) val += part[w * 256 + wave * 32 + (lane & 31)];
        float sv[4]; int si[4];
#pragma unroll
        for (int k = 0; k < 4; ++k) { float bv = val; int bi = lane & 31;
#pragma unroll
            for (int o = 16; o >= 1; o >>= 1) { const float ov = __shfl_xor(bv, o); const int oi = __shfl_xor(bi, o); const bool take = (ov > bv) || (ov == bv && oi < bi); bv = take ? ov : bv; bi = take ? oi : bi; }
            sv[k] = bv; si[k] = __builtin_amdgcn_readfirstlane(bi); if ((lane & 31) == bi) val = -3.0e38f; }
        const float e1 = __expf(sv[1] - sv[0]), e2 = __expf(sv[2] - sv[0]), e3 = __expf(sv[3] - sv[0]), inv = 1.0f / (1.0f + e1 + e2 + e3);
        const float gk[4] = {inv, e1 * inv, e2 * inv, e3 * inv};
        unsigned rank = 0;
        if (lane < 4) rank = __hip_atomic_fetch_add(cnt + (lane == 0 ? si[0] : lane == 1 ? si[1] : lane == 2 ? si[2] : si[3]), 1u, RLX_AGENT);
#pragma unroll
        for (int k = 0; k < 4; ++k) { const unsigned rk = (unsigned)__builtin_amdgcn_readlane((int)rank, k);
            bf16* dst = XG + ((size_t)si[k] * 8192 + rk) * DM;
#pragma unroll
            for (int j = 0; j < 8; ++j) { v2u o; o.x = cvt_pk_bf16(v[j][0], v[j][1]); o.y = cvt_pk_bf16(v[j][2], v[j][3]); *(v2u*)(dst + 4 * (lane + 64 * j)) = o; }
            if (lane == 0) { RE[row * 4 + k] = si[k]; RR[row * 4 + k] = (int)rk; RG[row * 4 + k] = gk[k]; } }
    }
}
__device__ __forceinline__ void moe_prefix(LAS int* pref, const unsigned* cnt, int tid) {
    if (tid == 0) { int s = 0; for (int e = 0; e < 32; ++e) { const unsigned ce = __hip_atomic_load(cnt + e, RLX_AGENT); pref[e] = s; pref[33 + e] = (int)ce; s += (int)((ce + 255u) >> 8); } pref[32] = s; }
    __syncthreads();
}
__device__ __forceinline__ void p12_phase(const LAS int* pref, int wave, int lane_, int G, const float* X1, const float* MOD, const bf16* Y2, const int* RE, const int* RR, const float* RG, const float* final_g, float* out) {
    const int gw = blockIdx.x * NWAVES + wave, NGW = G * NWAVES;
    int en[4], rn[4]; float gn[4];
    if (gw < NLAT) {
#pragma unroll
        for (int k = 0; k < 4; ++k) { en[k] = RE[gw * 4 + k]; rn[k] = RR[gw * 4 + k]; gn[k] = RG[gw * 4 + k]; } }
    for (int row = gw; row < NLAT; row += NGW) {
        int lane = lane_; asm volatile("" : "+v"(lane));
        const float* xr = X1 + (size_t)row * DM + 4 * lane; f32x4 xv[8]; v2u yv[4][8]; float gt[4];
#pragma unroll
        for (int k = 0; k < 4; ++k) { gt[k] = gn[k]; const bf16* src = Y2 + ((size_t)pref[en[k]] * 256 + rn[k]) * DM + 4 * lane;
#pragma unroll
            for (int j = 0; j < 8; ++j) yv[k][j] = __builtin_nontemporal_load((const v2u*)(src + 256 * j)); }
#pragma unroll
        for (int j = 0; j < 8; ++j) xv[j] = __builtin_nontemporal_load((const f32x4*)(xr + 256 * j));
        if (row + NGW < NLAT) { const int r2 = row + NGW;
#pragma unroll
            for (int k = 0; k < 4; ++k) { en[k] = RE[r2 * 4 + k]; rn[k] = RR[r2 * 4 + k]; gn[k] = RG[r2 * 4 + k]; } }
        const float* g5 = MOD + (size_t)(row >> 11) * 12288 + 5 * 2048; float ss = 0.f;
#pragma unroll
        for (int j = 0; j < 8; ++j) { f32x4 ys = {0.f, 0.f, 0.f, 0.f};
#pragma unroll
            for (int k = 0; k < 4; ++k) { const v2u y = yv[k][j]; ys[0] += gt[k] * bf_lo(y.x); ys[1] += gt[k] * bf_hi(y.x); ys[2] += gt[k] * bf_lo(y.y); ys[3] += gt[k] * bf_hi(y.y); }
            const int col = 4 * (lane + 64 * j); const f32x4 x2 = xv[j] + *(const f32x4*)(g5 + col) * ys; xv[j] = x2;
            ss += (x2[0] * x2[0] + x2[1] * x2[1]) + (x2[2] * x2[2] + x2[3] * x2[3]); }
        const float rstd = 1.0f / sqrtf(wave_sum(ss) * (1.0f / DM) + EPS);
#pragma unroll
        for (int j = 0; j < 8; ++j) { const int col = 4 * (lane + 64 * j); __builtin_nontemporal_store(xv[j] * rstd * *(const f32x4*)(final_g + col), (f32x4*)(out + (size_t)row * DM + col)); }
    }
}

#define XB_TMO      128
#define XB_XCNT(j)  (256  + 64 * (j))
#define XB_XSUB(j)  (1280 + 64 * (j))
#define XB_XGEN(j)  (2304 + 64 * (j))
#define XB_TOP      3328
#define XB_TOPGEN   3392
#define XCD_BAR_WORDS 3456
#define XB_SPIN_CAP (1u << 18)

__device__ __forceinline__ unsigned xb_ld(unsigned* p)              { return __hip_atomic_load(p, __ATOMIC_RELAXED, __HIP_MEMORY_SCOPE_AGENT); }
__device__ __forceinline__ unsigned xb_add(unsigned* p, unsigned v) { return __hip_atomic_fetch_add(p, v, __ATOMIC_RELAXED, __HIP_MEMORY_SCOPE_AGENT); }
__device__ __forceinline__ unsigned xb_xcc_id() { return (unsigned)__builtin_amdgcn_s_getreg((3 << 11) | 20) & 0xFu; }
#define XB_SPIN(cond, bar) do { unsigned _sp = 0; while (cond) { __builtin_amdgcn_s_sleep(1); \
    if ((++_sp & 255u) == 0u) { if (xb_ld(&(bar)[XB_TMO])) break; if (_sp > XB_SPIN_CAP) { atomicAdd(&(bar)[XB_TMO], 1u); break; } } } } while (0)

struct XcdBarrier {
    unsigned* bar; unsigned x;
    volatile LAS unsigned* st;
};

__device__ __forceinline__ XcdBarrier xcd_barrier_post(unsigned* bar, volatile LAS unsigned* st) {
    XcdBarrier b; b.bar = bar; b.x = xb_xcc_id(); b.st = st;
    if (threadIdx.x == 0) (void)xb_add(&bar[XB_XCNT(b.x)], 1u);
    return b;
}
__device__ __forceinline__ void xcd_barrier_complete(unsigned* bar, unsigned x, unsigned& nloc, unsigned& nx) {
    const unsigned G = gridDim.x * gridDim.y * gridDim.z;
    unsigned sum, cnt, mine, sp = 0u;
    for (;;) {
        sum = 0u; cnt = 0u; mine = 0u;
#pragma unroll
        for (unsigned j = 0; j < 16; ++j) { const unsigned c = xb_ld(&bar[XB_XCNT(j)]); sum += c; cnt += (c > 0u) ? 1u : 0u; mine = (j == x) ? c : mine; }
        if (sum == G) break;
        __builtin_amdgcn_s_sleep(1);
        if ((++sp & 255u) == 0u) { if (xb_ld(&bar[XB_TMO])) break; if (sp > XB_SPIN_CAP) { atomicAdd(&bar[XB_TMO], 1u); break; } }
    }
    nloc = mine > 0u ? mine : 1u; nx = cnt > 0u ? cnt : 1u;
}

__device__ __forceinline__ void xcd_barrier(const XcdBarrier& b) {
    asm volatile("s_waitcnt vmcnt(0)" ::: "memory");
    __syncthreads();
    if (threadIdx.x == 0) {
        unsigned* bar = b.bar;
        __builtin_amdgcn_s_waitcnt(0);
        unsigned nloc = b.st[0], nx = b.st[1];
        if (nloc == 0u) { xcd_barrier_complete(bar, b.x, nloc, nx); b.st[0] = nloc; b.st[1] = nx; }
        const unsigned old = xb_add(&bar[XB_XSUB(b.x)], 1u);
        const unsigned gen = old / nloc;
        if (old + 1u == (gen + 1u) * nloc) {
            __builtin_amdgcn_fence(__ATOMIC_RELEASE, "agent");
            asm volatile("s_waitcnt vmcnt(0)" ::: "memory");
            const unsigned og = xb_add(&bar[XB_TOP], 1u);
            const unsigned tg = og / nx;
            if (og + 1u == (tg + 1u) * nx) xb_add(&bar[XB_TOPGEN], 1u);
            else XB_SPIN(xb_ld(&bar[XB_TOPGEN]) == tg, bar);
            __builtin_amdgcn_fence(__ATOMIC_ACQUIRE, "agent");
            xb_add(&bar[XB_XGEN(b.x)], 1u);
            asm volatile("s_waitcnt vmcnt(0)" ::: "memory");
        } else {
            XB_SPIN(xb_ld(&bar[XB_XGEN(b.x)]) == gen, bar);
            __builtin_amdgcn_fence(__ATOMIC_ACQUIRE, "agent");
            asm volatile("s_waitcnt vmcnt(0)" ::: "memory");
        }
    }
    __syncthreads();
}

struct Args { const float* in[26]; float* out; unsigned char* ws; int ph_lo, ph_hi; };
__global__ void __launch_bounds__(NTHR, 2) mk_fwd(Args args) {
    extern __shared__ __attribute__((aligned(16))) unsigned char lds_raw[];
    LAS unsigned char* lds = (LAS unsigned char*)lds_raw;
    const int tid = threadIdx.x, lane = tid & 63, wave = __builtin_amdgcn_readfirstlane(tid >> 6), G = gridDim.x;
    unsigned char* ws = args.ws;
    gu32* ctl = (gu32*)(ws + WS_CTL);
    for (int u = tid; u < (LDS_BYTES - LDSCTL_OFF) / 4; u += NTHR) ((LAS unsigned*)(lds + LDSCTL_OFF))[u] = 0u;
    __syncthreads();
    volatile LAS unsigned* MISC = (volatile LAS unsigned*)(lds + MISC_OFF);
    XcdBarrier bar; bar.bar = (unsigned*)(ctl + CW_BAR); bar.x = 0; bar.st = nullptr;
    if (N_LAUNCHES == 1) bar = xcd_barrier_post((unsigned*)(ctl + CW_BAR), MISC + 8);
#define GRID_BAR() do { if (N_LAUNCHES == 1) xcd_barrier(bar); } while (0)
    const int lo = args.ph_lo, hi = args.ph_hi;
#ifdef ONLY_PHASE
#define IN(k) ((k) == ONLY_PHASE && lo <= (k) && (k) < hi)
#else
#define IN(k) (lo <= (k) && (k) < hi)
#endif
#define BOTH(k) (IN(k) && IN((k) + 1))
#ifndef REP_MASK
#define REP_MASK 0
#endif
#define NREP(k) ((((REP_MASK) >> (k)) & 1) ? 2 : 1)
#define INP(i) (args.in[i])
#define WSF(off) ((float*)(ws + (off)))
#define WSB(off) ((bf16*)(ws + (off)))
#define WSI(off) ((int*)(ws + (off)))
    unsigned* cnt = (unsigned*)(ctl + CW_CNT);
    LAS int* pref = (LAS int*)(lds + PREF_OFF);
    const int n_conv_p0 = (G == 256) ? I_WIN + 3 * I_P : (I_TOTAL - I_GEMV);
#define x_in INP(0)
#define cvec INP(1)
#define ctx INP(2)
#define c_ctx INP(3)
#define mod_w INP(4)
#define mod_b INP(5)
#define norm1_g INP(6)
#define norm2_g INP(7)
#define w_in INP(8)
#define gate_b INP(9)
#define conv_w INP(10)
#define conv_b INP(11)
#define mnorm_g INP(12)
#define sgu_norm_g INP(13)
#define sgu_w INP(14)
#define sgu_b INP(15)
#define proj_a INP(16)
#define proj_b INP(17)
#define w_out INP(18)
#define router_w INP(19)
#define router_b INP(20)
#define exp_w1 INP(21)
#define exp_b1 INP(22)
#define exp_w2 INP(23)
#define exp_b2 INP(24)
#define final_g INP(25)
#define MOD WSF(WS_MOD)
#define GATES WSF(WS_GATES)
#define BEND WSF(WS_SCAL)
#define GMAX (WSF(WS_SCAL) + 64 * 17)
#define MST (WSF(WS_SCAL) + 2 * 64 * 17)
#define RE WSI(WS_ROUTE)
#define RR (WSI(WS_ROUTE) + NLAT * 4)
#define RG (WSF(WS_ROUTE) + 2 * NLAT * 4)
#define WINT WSB(WS_WINT)
#define SKW WSB(WS_SK)
#define SCN WSF(WS_SCN)
#define PAT WSB(WS_PAT)
#define PBT WSB(WS_PBT)
#define WOT WSB(WS_WOT)
#define W1T WSB(WS_W1T)
#define W2T WSB(WS_W2T)
#define HB WSB(WS_HB)
#define Z WSB(WS_Z)
#define QC WSB(WS_QC)
#define KC WSB(WS_KC)
#define SVN WSB(WS_SVN)
#define DC WSB(WS_DC)
#define CS WSB(WS_CS)
#define RO WSB(WS_RO)
#define CM WSB(WS_CM)
#define YB WSF(WS_YB)
#define MRG WSB(WS_MRG)
#define X1 WSF(WS_X1)
#define ACT WSB(WS_ACT)
#define Y2 WSB(WS_Y2)
#define XG WSB(WS_XG)

    if (IN(0)) for (int rep_ = 0; rep_ < NREP(0); ++rep_) { p0_phase(lds, tid, G, cvec, c_ctx, mod_w, mod_b, MOD, w_in, proj_a, proj_b, w_out, exp_w1, exp_w2, router_w, WINT, PAT, PBT, WOT, W1T, W2T, SKW, n_conv_p0); if (BOTH(0) || rep_ + 1 < NREP(0)) GRID_BAR(); }
    if (IN(1)) for (int rep_ = 0; rep_ < NREP(1); ++rep_) { p1_phase(lds, tid, wave, lane, G, x_in, ctx, MOD, norm1_g, SKW, gate_b, HB, GATES); if (BOTH(1) || rep_ + 1 < NREP(1)) GRID_BAR(); }
    if (IN(2)) for (int rep_ = 0; rep_ < NREP(2); ++rep_) {
        if (G == 256 && (int)blockIdx.x >= 256 - N_CONVERTERS)
            cvt_run(lds, tid, I_GEMV + n_conv_p0 + ((int)blockIdx.x - (256 - N_CONVERTERS)), N_CONVERTERS, I_TOTAL, w_in, proj_a, proj_b, w_out, exp_w1, exp_w2, WINT, PAT, PBT, WOT, W1T, W2T);
        { pg8::Gemm g{HB, WINT, NTOK, ZW, DM}; pg8::DynOrder S{(unsigned*)(ctl + CW_Q), (LAS int*)(lds + PREF_OFF + 800), (int)(blockIdx.x & 7)}; pg8::EpiBf16 E{Z, ZW, nullptr, ZW / 256};
          pg8::gemm_phase<pg8::EpiBf16, pg8::DynOrder, true, true>(lds, g, S, E); }
        if (BOTH(2) || rep_ + 1 < NREP(2)) GRID_BAR();
    }
    if (IN(3)) for (int rep_ = 0; rep_ < NREP(3); ++rep_) { p3_phase(wave, lane, G, Z, conv_w, conv_b, sgu_norm_g, QC, KC, SVN, GATES, SCN, BEND, GMAX); if (BOTH(3) || rep_ + 1 < NREP(3)) GRID_BAR(); }
    if (IN(4)) for (int rep_ = 0; rep_ < NREP(4); ++rep_) { p4_phase(lds, tid, wave, lane, G, Z, KC, SVN, SCN, sgu_w, sgu_b, DC, GMAX, CM); if (BOTH(4) || rep_ + 1 < NREP(4)) GRID_BAR(); }
    if (IN(5)) for (int rep_ = 0; rep_ < NREP(5); ++rep_) {
        { pg8::Gemm g{CM, PBT, NLAT, DM, DM}; pg8::StaticOrder S; S.init(NLAT, DM, G, (int)blockIdx.x); pg8::EpiF32 E{YB, DM};
          pg8::gemm_phase<pg8::EpiF32, pg8::StaticOrder, true, true>(lds, g, S, E); }
        p5_scan(tid, G, DC, BEND, GMAX, CS, MST);
        if (BOTH(5) || rep_ + 1 < NREP(5)) GRID_BAR();
    }
    if (IN(6)) for (int rep_ = 0; rep_ < NREP(6); ++rep_) { p6_phase(lds, tid, wave, lane, G, Z, QC, KC, SCN, CS, MST, mnorm_g, RO); if (BOTH(6) || rep_ + 1 < NREP(6)) GRID_BAR(); }
    if (IN(7)) for (int rep_ = 0; rep_ < NREP(7); ++rep_) {
        pg8::Gemm g{RO, PAT, NLAT, DM, DM}; pg8::StaticOrder S; S.init(NLAT, DM, G, (int)blockIdx.x); pg8::EpiMerge E{MRG, Z, ZW, ZGA, ZGB, YB};
        pg8::gemm_phase<pg8::EpiMerge, pg8::StaticOrder, true, true>(lds, g, S, E);
        if (BOTH(7) || rep_ + 1 < NREP(7)) GRID_BAR();
    }
    if (IN(8)) for (int rep_ = 0; rep_ < NREP(8); ++rep_) {
        pg8::Gemm g{MRG, WOT, NLAT, DM, DM}; pg8::StaticOrder S; S.init(NLAT, DM, G, (int)blockIdx.x); pg8::EpiX1 E{X1, x_in, MOD};
        pg8::gemm_phase<pg8::EpiX1, pg8::StaticOrder, true, true>(lds, g, S, E);
        if (BOTH(8) || rep_ + 1 < NREP(8)) GRID_BAR();
    }
    if (IN(9)) for (int rep_ = 0; rep_ < NREP(9); ++rep_) { p9_phase(lds, wave, lane, G, X1, MOD, norm2_g, SKW, router_b, cnt, XG, RE, RR, RG); if (BOTH(9) || rep_ + 1 < NREP(9)) GRID_BAR(); }
    if (IN(10)) for (int rep_ = 0; rep_ < NREP(10); ++rep_) {
        moe_prefix(pref, cnt, tid);
        pg8::Gemm g{XG, W1T, 0, 0, DM}; pg8::MoeOrder S{pref, 16, G, (int)blockIdx.x, 1}; pg8::EpiSwiglu E{ACT, exp_b1};
        pg8::gemm_phase<pg8::EpiSwiglu, pg8::MoeOrder, true, true, true>(lds, g, S, E);
        if (BOTH(10) || rep_ + 1 < NREP(10)) GRID_BAR();
    }
    if (IN(11)) for (int rep_ = 0; rep_ < NREP(11); ++rep_) {
        moe_prefix(pref, cnt, tid);
        pg8::Gemm g{ACT, W2T, 0, 0, DEXP}; pg8::MoeOrder S{pref, 8, G, (int)blockIdx.x, 0}; pg8::EpiBf16 E{Y2, DM, exp_b2, 8};
        pg8::gemm_phase<pg8::EpiBf16, pg8::MoeOrder, true, true, true>(lds, g, S, E);
        if (BOTH(11) || rep_ + 1 < NREP(11)) GRID_BAR();
    }
    if (IN(12)) for (int rep_ = 0; rep_ < NREP(12); ++rep_) { moe_prefix(pref, cnt, tid); p12_phase(pref, wave, lane, G, X1, MOD, Y2, RE, RR, RG, final_g, args.out); if (rep_ + 1 < NREP(12)) GRID_BAR(); }
#undef IN
#undef BOTH
}

extern "C" void kernel_launch(void* const* d_in, const int* in_sizes, int n_in, void* d_out, int out_size, void* d_ws, size_t ws_size, hipStream_t stream) {
    static int grid = 0;
    if (grid == 0) {
        if (n_in != 26 || out_size != NLAT * DM || ws_size < WS_END) { fprintf(stderr, "kernel_launch: unexpected shapes (n_in %d, out %d, ws %zu)\n", n_in, out_size, ws_size); grid = -1; return; }
        int dev = 0, cus = 0;
        if (hipGetDevice(&dev) != hipSuccess || hipDeviceGetAttribute(&cus, hipDeviceAttributeMultiprocessorCount, dev) != hipSuccess) { grid = -1; return; }
        if (hipFuncSetAttribute((const void*)mk_fwd, hipFuncAttributeMaxDynamicSharedMemorySize, LDS_BYTES) != hipSuccess) { fprintf(stderr, "kernel_launch: hipFuncSetAttribute failed\n"); grid = -1; return; }
        int per_cu = 0;
        if (hipOccupancyMaxActiveBlocksPerMultiprocessor(&per_cu, (const void*)mk_fwd, NTHR, LDS_BYTES) != hipSuccess || per_cu < 1) fprintf(stderr, "kernel_launch: occupancy query reports %d\n", per_cu);
        (void)hipGetLastError();
        grid = cus;
    }
    if (grid < 0) return;
    if (hipMemsetAsync((char*)d_ws + WS_CTL, 0, CTL_ZERO_BYTES, stream) != hipSuccess) return;
    Args a{};
    for (int i = 0; i < 26; ++i) a.in[i] = (const float*)d_in[i];
    a.out = (float*)d_out; a.ws = (unsigned char*)d_ws;
    for (int li = 0; li < N_LAUNCHES; ++li) {
        a.ph_lo = (N_LAUNCHES == 1) ? 0 : li; a.ph_hi = (N_LAUNCHES == 1) ? N_PHASES : li + 1;
        hipLaunchKernelGGL(mk_fwd, dim3(grid), dim3(NTHR), LDS_BYTES, stream, a);
        const hipError_t le = hipPeekAtLastError();
        if (le != hipSuccess) { fprintf(stderr, "kernel_launch: launch %d failed: %s\n", li, hipGetErrorName(le)); break; }
    }
}
```

```cpp
#include <hip/hip_runtime.h>
#include <cstdio>
#include <cstdint>
#ifndef MK_N_LAUNCHES
#define MK_N_LAUNCHES 1
#endif
namespace pg8 {
#define PG8_LAS __attribute__((address_space(3)))
typedef unsigned short bf16_t;
typedef short bf16x8 __attribute__((ext_vector_type(8)));
typedef float f32x4 __attribute__((ext_vector_type(4)));
typedef unsigned u32x4 __attribute__((ext_vector_type(4)));
constexpr int BM = 256, BK = 64, HALF = 128, HTB = HALF * BK * 2  , STAGE_BYTES = 8 * HTB, NXCD = 8, WGM = 8;

__host__ __device__ __forceinline__ int lds_byte(int r, int c) { const int st = (r >> 4) * 2 + (c >> 5), rr = r & 15, cc = c & 31, ob = rr * 64 + cc * 2; return st * 1024 + (ob ^ (((ob >> 9) & 1) << 5)); }
__host__ __device__ __forceinline__ void stage_rc(int b, int& R, int& C) { const int st = b / 1024, sb = b % 1024, swz = sb ^ (((sb >> 9) & 1) << 5); R = (st >> 1) * 16 + swz / 64; C = (st & 1) * 32 + (swz % 64) / 2; }
__host__ __device__ __forceinline__ int perm32(int rho) { const int n = rho >> 4, i = rho & 15; return 8 * (i >> 2) + 4 * n + (i & 3); }

struct Unit { int pm, pn, po, hf; };
struct Gemm { const bf16_t* A; const bf16_t* Bt; int M, N, K; };

struct StaticOrder {
    int nM, nN, nwg, G, c;
    __host__ __device__ void init(int M, int N, int G_, int c_) { nM = M / BM; nN = N / BM; nwg = nM * nN; G = G_; c = c_; }
    __host__ __device__ bool next(int i, Unit& u) const {
        const long L = (long)i * G + c; if (L >= nwg) return false;
        int wgid = (int)L; { const int q = nwg / NXCD, r = nwg % NXCD, xcd = wgid % NXCD, off = wgid / NXCD; wgid = (xcd < r ? xcd * (q + 1) : r * (q + 1) + (xcd - r) * q) + off; }
        const int nig = WGM * nN, gid = wgid / nig, fm = gid * WGM, gsz = (nM - fm) < WGM ? (nM - fm) : WGM;
        u.pm = fm + ((wgid % nig) % gsz); u.pn = (wgid % nig) / gsz; u.po = u.pm; u.hf = 0; return true;
    }
    __device__ __forceinline__ void a_ready(const Unit&) const {}
    __device__ __forceinline__ void done(const Unit&) const {}
};
struct DynOrder {
    unsigned* q; PG8_LAS int* slot; int xcd;
    __device__ __forceinline__ bool next(int i, Unit& u) const {
        if (threadIdx.x == 0) { int id = -1;
            unsigned v = __hip_atomic_fetch_add(q + 64 * xcd, 1u, __ATOMIC_RELAXED, __HIP_MEMORY_SCOPE_AGENT);
            if (v < 232u) id = xcd * 232 + (int)v;
            else { unsigned c[8];
#pragma unroll
                for (int k = 0; k < 8; ++k) c[k] = __hip_atomic_load(q + 64 * k, __ATOMIC_RELAXED, __HIP_MEMORY_SCOPE_AGENT);
#pragma unroll
                for (int k = 1; k < 8; ++k) { const int x = (xcd + k) & 7; if (id < 0 && c[x] < 232u) { v = __hip_atomic_fetch_add(q + 64 * x, 1u, __ATOMIC_RELAXED, __HIP_MEMORY_SCOPE_AGENT); if (v < 232u) id = x * 232 + (int)v; } } }
            slot[i & 1] = id; asm volatile("s_waitcnt lgkmcnt(0)" ::: "memory"); }
        asm volatile("" ::: "memory"); __builtin_amdgcn_s_barrier(); asm volatile("" ::: "memory");
        const int id = slot[i & 1]; if (id < 0) return false;
        const int x = id / 232, v = id - x * 232;
        if (v < 224) { const int wgid = x * 224 + v, nig = WGM * 56, gid = wgid / nig; u.pm = gid * WGM + ((wgid % nig) % WGM); u.pn = (wgid % nig) / WGM; }
        else { const int j = x * 8 + (v - 224); u.pm = 32 + (j & 3); u.pn = j >> 2; }
        u.po = u.pm; u.hf = 0; return true;
    }
    __device__ __forceinline__ void a_ready(const Unit&) const {}
    __device__ __forceinline__ void done(const Unit&) const {}
};
struct MoeOrder {
    const PG8_LAS int* pref; int nN, G, c, a_sparse;
    __device__ __forceinline__ bool next(int i, Unit& u) const {
        const int L = i * G + c, total = pref[32]; if (L >= total * nN) return false;
        const int mt = L / nN, nt = L - mt * nN; int e = 0;
        for (int k = 1; k < 32; ++k) e += (pref[k] <= mt) ? 1 : 0;
        u.pm = a_sparse ? e * 32 + (mt - pref[e]) : mt; u.pn = e * nN + nt; u.po = mt; u.hf = (pref[33 + e] - 256 * (mt - pref[e]) <= 128) ? 1 : 0; return true;
    }
    __device__ __forceinline__ void a_ready(const Unit&) const {}
    __device__ __forceinline__ void done(const Unit&) const {}
};

__device__ __forceinline__ unsigned cvt_pk_bf16(float lo, float hi) { unsigned r; asm volatile("v_cvt_pk_bf16_f32 %0, %1, %2" : "=v"(r) : "v"(lo), "v"(hi)); return r; }
__device__ __forceinline__ float bf_lo(unsigned w) { return __uint_as_float(w << 16); }
__device__ __forceinline__ float bf_hi(unsigned w) { return __uint_as_float(w & 0xffff0000u); }
__device__ __forceinline__ float sigmoidf_(float x) { return __builtin_amdgcn_rcpf(1.0f + __expf(-x)); }

struct EpiBf16 {
    static constexpr bool PERM = true, AFTER_DRAIN = false;
    bf16_t* O; int ldc; const float* bias; int ncolt;
    __device__ __forceinline__ void operator()(const f32x4 (&acc)[2][2][4][2], const Unit& u, int wr, int wc, int fr, int fq) const {
        const int row0 = u.po * BM + wr * 64 + fr; const int colt = (u.pn % ncolt) * BM;
        const int col0 = colt + wc * 32 + 8 * fq, bcol0 = u.pn * BM + wc * 32 + 8 * fq;
        f32x4 bv[2][2];
#pragma unroll
        for (int bj = 0; bj < 2; ++bj)
#pragma unroll
            for (int n = 0; n < 2; ++n) bv[bj][n] = bias ? *(const f32x4*)(bias + bcol0 + bj * HALF + 4 * n) : (f32x4){0.f, 0.f, 0.f, 0.f};
#pragma unroll
        for (int ai = 0; ai < 2; ++ai)
#pragma unroll
            for (int m = 0; m < 4; ++m) { bf16_t* rowp = O + (size_t)(row0 + ai * HALF + m * 16) * ldc + col0;
#pragma unroll
                for (int bj = 0; bj < 2; ++bj) { const f32x4 v0 = acc[ai][bj][m][0] + bv[bj][0], v1 = acc[ai][bj][m][1] + bv[bj][1];
                    u32x4 w; w.x = cvt_pk_bf16(v0[0], v0[1]); w.y = cvt_pk_bf16(v0[2], v0[3]); w.z = cvt_pk_bf16(v1[0], v1[1]); w.w = cvt_pk_bf16(v1[2], v1[3]);
                    __builtin_nontemporal_store(w, (u32x4*)(rowp + bj * HALF)); } }
    }
};
struct EpiF32 {
    static constexpr bool PERM = false, AFTER_DRAIN = false;
    float* C; int ldc;
    __device__ __forceinline__ void operator()(const f32x4 (&acc)[2][2][4][2], const Unit& u, int wr, int wc, int fr, int fq) const {
        const int row0 = u.po * BM + wr * 64 + fr, col0 = u.pn * BM + wc * 32 + 4 * fq;
#pragma unroll
        for (int ai = 0; ai < 2; ++ai)
#pragma unroll
            for (int m = 0; m < 4; ++m) { float* rowp = C + (size_t)(row0 + ai * HALF + m * 16) * ldc + col0;
#pragma unroll
                for (int bj = 0; bj < 2; ++bj)
#pragma unroll
                    for (int n = 0; n < 2; ++n) *(f32x4*)(rowp + bj * HALF + n * 16) = acc[ai][bj][m][n]; }
    }
};
struct EpiMerge {
    static constexpr bool PERM = true, AFTER_DRAIN = false;
    bf16_t* O; const bf16_t* Z; int ldz, ga_off, gb_off; const float* YB;
    __device__ __forceinline__ void operator()(const f32x4 (&acc)[2][2][4][2], const Unit& u, int wr, int wc, int fr, int fq) const {
        const int row0 = u.po * BM + wr * 64 + fr, col0 = u.pn * BM + wc * 32 + 8 * fq;
#pragma unroll
        for (int ai = 0; ai < 2; ++ai)
#pragma unroll
            for (int m = 0; m < 4; ++m) { const size_t row = (size_t)(row0 + ai * HALF + m * 16);
#pragma unroll
                for (int bj = 0; bj < 2; ++bj) { const int col = col0 + bj * HALF;
                    const u32x4 ga = *(const u32x4*)(Z + row * ldz + ga_off + col), gb = *(const u32x4*)(Z + row * ldz + gb_off + col);
                    const f32x4 y0 = *(const f32x4*)(YB + row * 2048 + col), y1 = *(const f32x4*)(YB + row * 2048 + col + 4);
                    const f32x4 a0 = acc[ai][bj][m][0], a1 = acc[ai][bj][m][1];
                    float o[8];
                    o[0] = sigmoidf_(bf_lo(ga.x)) * a0[0] + sigmoidf_(bf_lo(gb.x)) * y0[0]; o[1] = sigmoidf_(bf_hi(ga.x)) * a0[1] + sigmoidf_(bf_hi(gb.x)) * y0[1];
                    o[2] = sigmoidf_(bf_lo(ga.y)) * a0[2] + sigmoidf_(bf_lo(gb.y)) * y0[2]; o[3] = sigmoidf_(bf_hi(ga.y)) * a0[3] + sigmoidf_(bf_hi(gb.y)) * y0[3];
                    o[4] = sigmoidf_(bf_lo(ga.z)) * a1[0] + sigmoidf_(bf_lo(gb.z)) * y1[0]; o[5] = sigmoidf_(bf_hi(ga.z)) * a1[1] + sigmoidf_(bf_hi(gb.z)) * y1[1];
                    o[6] = sigmoidf_(bf_lo(ga.w)) * a1[2] + sigmoidf_(bf_lo(gb.w)) * y1[2]; o[7] = sigmoidf_(bf_hi(ga.w)) * a1[3] + sigmoidf_(bf_hi(gb.w)) * y1[3];
                    u32x4 w; w.x = cvt_pk_bf16(o[0], o[1]); w.y = cvt_pk_bf16(o[2], o[3]); w.z = cvt_pk_bf16(o[4], o[5]); w.w = cvt_pk_bf16(o[6], o[7]);
                    *(u32x4*)(O + row * 2048 + col) = w; } }
    }
};
struct EpiX1 {
    static constexpr bool PERM = false, AFTER_DRAIN = false;
    float* X1; const float* X; const float* mod;
    __device__ __forceinline__ void operator()(const f32x4 (&acc)[2][2][4][2], const Unit& u, int wr, int wc, int fr, int fq) const {
        const int row0 = u.po * BM + wr * 64 + fr, col0 = u.pn * BM + wc * 32 + 4 * fq;
        const float* mg = mod + (size_t)((u.po * BM) >> 11) * 12288 + 2 * 2048;
#pragma unroll
        for (int bj = 0; bj < 2; ++bj)
#pragma unroll
            for (int n = 0; n < 2; ++n) { const int col = col0 + bj * HALF + n * 16; const f32x4 g = *(const f32x4*)(mg + col);
#pragma unroll
                for (int ai = 0; ai < 2; ++ai)
#pragma unroll
                    for (int m = 0; m < 4; ++m) { const size_t off = (size_t)(row0 + ai * HALF + m * 16) * 2048 + col;
                        *(f32x4*)(X1 + off) = *(const f32x4*)(X + off) + g * acc[ai][bj][m][n]; } }
    }
};
struct EpiSwiglu {
    static constexpr bool PERM = true, AFTER_DRAIN = false;
    bf16_t* O; const float* b1;
    __device__ __forceinline__ void operator()(const f32x4 (&acc)[2][2][4][2], const Unit& u, int wr, int wc, int fr, int fq) const {
        const int e = u.pn >> 4, nt = u.pn & 15; const int row0 = u.po * BM + wr * 64 + fr, j0 = nt * 128 + wc * 32 + 8 * fq;
        const float* bg = b1 + (size_t)e * 4096 + j0; const float* bl = bg + 2048;
#pragma unroll
        for (int ai = 0; ai < 2; ++ai)
#pragma unroll
            for (int m = 0; m < 4; ++m) { const size_t row = (size_t)(row0 + ai * HALF + m * 16);
                asm volatile("" ::: "memory");
#pragma unroll
                for (int n = 0; n < 2; ++n) { const f32x4 gv = acc[ai][0][m][n] + *(const f32x4*)(bg + 4 * n), lv = acc[ai][1][m][n] + *(const f32x4*)(bl + 4 * n);
                    float o[4];
#pragma unroll
                    for (int i = 0; i < 4; ++i) { const float ga = fminf(gv[i], 7.0f), la = fminf(fmaxf(lv[i], -7.0f), 7.0f); o[i] = ga * sigmoidf_(1.702f * ga) * (la + 1.0f); }
                    typedef unsigned u32x2 __attribute__((ext_vector_type(2))); u32x2 w; w.x = cvt_pk_bf16(o[0], o[1]); w.y = cvt_pk_bf16(o[2], o[3]);
                    *(u32x2*)(O + row * 2048 + j0 + 4 * n) = w; } }
    }
};

template <class Epi, class Sched, bool ALIGN_EPI = false, bool SP2 = false, bool HALFSKIP = false>
__device__ __forceinline__ void gemm_phase(PG8_LAS unsigned char* lds, const Gemm g, const Sched& S, const Epi& E) {
    const int tid = threadIdx.x, wid = __builtin_amdgcn_readfirstlane(tid >> 6), lane = tid & 63, wr = wid >> 2, wc = wid & 3, fr = lane & 15, fq = lane >> 4;
    const int K = g.K, nt = K / BK;
    unsigned voffA[2], voffB[2];
#pragma unroll
    for (int i = 0; i < 2; ++i) { int R, C; stage_rc(tid * 16 + i * 8192, R, C); const int Rb = Epi::PERM ? ((R & ~31) + perm32(R & 31)) : R;
        voffA[i] = (unsigned)(R * K + C) * 2u; voffB[i] = (unsigned)(Rb * K + C) * 2u; }
    const size_t kstep = (size_t)(BK * 2);
    const size_t hstep = (size_t)HALF * K * 2;
    const size_t tstep = 2 * hstep;
    const unsigned ldsw = (unsigned)wid * 1024u;
    const int aoff = lds_byte(wr * 64 + fr, fq * 8), boff = lds_byte(wc * 32 + fr, fq * 8);
#define PG8_SA(b, h) (((b) * 2 + (h)) * HTB)
#define PG8_SB(b, h) ((4 + (b) * 2 + (h)) * HTB)
#define PG8_STAGE(bufoff, gbase, voff) do { _Pragma("unroll") for (int _i = 0; _i < 2; ++_i) \
        __builtin_amdgcn_global_load_lds((const unsigned*)((const char*)(gbase) + (voff)[_i]), (PG8_LAS unsigned*)(lds + (bufoff) + ldsw + _i * 8192), 16, 0, 0); } while (0)
#define PG8_LDA(dst, b, h) do { _Pragma("unroll") for (int m = 0; m < 4; ++m) _Pragma("unroll") for (int k = 0; k < 2; ++k) dst[m][k] = *(const PG8_LAS bf16x8*)(lds + PG8_SA(b, h) + aoff + m * 2048 + k * 1024); } while (0)
#define PG8_LDB(dst, b, h) do { _Pragma("unroll") for (int n = 0; n < 2; ++n) _Pragma("unroll") for (int k = 0; k < 2; ++k) dst[n][k] = *(const PG8_LAS bf16x8*)(lds + PG8_SB(b, h) + boff + n * 2048 + k * 1024); } while (0)
#define PG8_MMA(ai, bj, At, Bt) do { __builtin_amdgcn_s_setprio(1); _Pragma("unroll") for (int m = 0; m < 4; ++m) _Pragma("unroll") for (int n = 0; n < 2; ++n) _Pragma("unroll") for (int k = 0; k < 2; ++k) \
        acc[ai][bj][m][n] = __builtin_amdgcn_mfma_f32_16x16x32_bf16(Bt[n][k], At[m][k], acc[ai][bj][m][n], 0, 0, 0); __builtin_amdgcn_s_setprio(0); } while (0)
#define PG8_WAIT_V(n) asm volatile("s_waitcnt vmcnt(" #n ")" ::: "memory")
#define PG8_WAIT_L(n) asm volatile("s_waitcnt lgkmcnt(" #n ")" ::: "memory")
#define PG8_BAR __builtin_amdgcn_s_barrier()
#define PG8_SCHED __builtin_amdgcn_sched_barrier(0)
    Unit cur, nxt; int ui = 0;
    if (!S.next(0, cur)) return;
    f32x4 acc[2][2][4][2];
#pragma unroll
    for (int a = 0; a < 2; ++a)
#pragma unroll
        for (int b = 0; b < 2; ++b)
#pragma unroll
            for (int m = 0; m < 4; ++m)
#pragma unroll
                for (int n = 0; n < 2; ++n) acc[a][b][m][n] = (f32x4){0.f, 0.f, 0.f, 0.f};
    bf16x8 At[4][2], B0[2][2], B1[2][2];
    const char* cA = (const char*)g.A + (size_t)cur.pm * tstep; const char* cB = (const char*)g.Bt + (size_t)cur.pn * tstep;
    S.a_ready(cur);
    if constexpr (SP2) {
        PG8_STAGE(PG8_SB(0, 0), cB, voffB); PG8_STAGE(PG8_SB(0, 1), cB + hstep, voffB); PG8_STAGE(PG8_SA(0, 0), cA, voffA); PG8_STAGE(PG8_SA(0, 1), cA + hstep, voffA);
        if (wr == 1) PG8_BAR;
        PG8_WAIT_V(2); PG8_BAR;
        PG8_STAGE(PG8_SB(1, 0), cB + kstep, voffB); PG8_STAGE(PG8_SA(1, 0), cA + kstep, voffA); PG8_STAGE(PG8_SB(1, 1), cB + hstep + kstep, voffB);
        PG8_WAIT_V(6); PG8_BAR;
    } else {
        PG8_STAGE(PG8_SB(0, 0), cB, voffB); PG8_STAGE(PG8_SA(0, 0), cA, voffA); PG8_STAGE(PG8_SB(0, 1), cB + hstep, voffB); PG8_STAGE(PG8_SA(0, 1), cA + hstep, voffA);
        if (wr == 1) PG8_BAR;
        PG8_WAIT_V(4); PG8_BAR;
        PG8_STAGE(PG8_SB(1, 0), cB + kstep, voffB); PG8_STAGE(PG8_SA(1, 0), cA + kstep, voffA); PG8_STAGE(PG8_SB(1, 1), cB + hstep + kstep, voffB);
        PG8_WAIT_V(6); PG8_BAR;
    }
    for (;;) {
        const bool has_next = S.next(ui + 1, nxt);
        const char* nA = has_next ? (const char*)g.A + (size_t)nxt.pm * tstep : cA; const char* nB = has_next ? (const char*)g.Bt + (size_t)nxt.pn * tstep : cB;
        for (int t = 0; t < nt; t += 2) {
            const bool last = (t == nt - 2);
            const char* a1 = cA + (size_t)(t + 1) * kstep;
            const char* a2 = last ? nA : cA + (size_t)(t + 2) * kstep; const char* b2 = last ? nB : cB + (size_t)(t + 2) * kstep;
            const char* a3 = a2 + kstep; const char* b3 = b2 + kstep;
            if (last && has_next) S.a_ready(nxt);
            if constexpr (SP2) {
            PG8_LDB(B0, 0, 0); PG8_LDB(B1, 0, 1); PG8_SCHED; PG8_LDA(At, 0, 0); PG8_STAGE(PG8_SA(1, 1), a1 + hstep, voffA);
            PG8_WAIT_V(8); PG8_WAIT_L(0); PG8_BAR; PG8_MMA(0, 0, At, B0); PG8_MMA(0, 1, At, B1); PG8_BAR; PG8_SCHED;
            PG8_LDA(At, 0, 1); PG8_STAGE(PG8_SB(0, 0), b2, voffB); PG8_STAGE(PG8_SB(0, 1), b2 + hstep, voffB); PG8_STAGE(PG8_SA(0, 0), a2, voffA);
            PG8_WAIT_V(8); PG8_WAIT_L(0); PG8_BAR; if (!(HALFSKIP && cur.hf)) { PG8_MMA(1, 0, At, B0); PG8_MMA(1, 1, At, B1); } PG8_BAR; PG8_SCHED;
            PG8_LDB(B0, 1, 0); PG8_LDB(B1, 1, 1); PG8_SCHED; PG8_LDA(At, 1, 0); PG8_STAGE(PG8_SA(0, 1), a2 + hstep, voffA);
            PG8_WAIT_V(8); PG8_WAIT_L(0); PG8_BAR; PG8_MMA(0, 0, At, B0); PG8_MMA(0, 1, At, B1); PG8_BAR; PG8_SCHED;
            PG8_LDA(At, 1, 1); PG8_STAGE(PG8_SB(1, 0), b3, voffB); PG8_STAGE(PG8_SB(1, 1), b3 + hstep, voffB); PG8_STAGE(PG8_SA(1, 0), a3, voffA);
            PG8_WAIT_V(8); PG8_WAIT_L(0); PG8_BAR; if (!(HALFSKIP && cur.hf)) { PG8_MMA(1, 0, At, B0); PG8_MMA(1, 1, At, B1); } PG8_BAR; PG8_SCHED;
            } else {
            PG8_LDB(B0, 0, 0); PG8_SCHED; PG8_LDA(At, 0, 0); PG8_STAGE(PG8_SA(1, 1), a1 + hstep, voffA);
            PG8_WAIT_L(8); PG8_BAR; PG8_WAIT_L(0); PG8_MMA(0, 0, At, B0); PG8_BAR; PG8_SCHED;
            PG8_LDB(B1, 0, 1); PG8_STAGE(PG8_SB(0, 0), b2, voffB);
            PG8_BAR; PG8_WAIT_L(0); PG8_MMA(0, 1, At, B1); PG8_BAR;
            PG8_LDA(At, 0, 1); PG8_STAGE(PG8_SA(0, 0), a2, voffA);
            PG8_BAR; PG8_WAIT_L(0); PG8_MMA(1, 0, At, B0); PG8_BAR; PG8_SCHED;
            PG8_STAGE(PG8_SB(0, 1), b2 + hstep, voffB);
            PG8_WAIT_V(6); PG8_BAR; PG8_MMA(1, 1, At, B1); PG8_BAR;
            PG8_LDB(B0, 1, 0); PG8_SCHED; PG8_LDA(At, 1, 0); PG8_STAGE(PG8_SA(0, 1), a2 + hstep, voffA);
            PG8_WAIT_L(8); PG8_BAR; PG8_WAIT_L(0); PG8_MMA(0, 0, At, B0); PG8_BAR; PG8_SCHED;
            PG8_LDB(B1, 1, 1); PG8_STAGE(PG8_SB(1, 0), b3, voffB);
            PG8_BAR; PG8_WAIT_L(0); PG8_MMA(0, 1, At, B1); PG8_BAR;
            PG8_LDA(At, 1, 1); PG8_STAGE(PG8_SA(1, 0), a3, voffA);
            PG8_BAR; PG8_WAIT_L(0); PG8_MMA(1, 0, At, B0); PG8_BAR; PG8_SCHED;
            PG8_STAGE(PG8_SB(1, 1), b3 + hstep, voffB);
            PG8_WAIT_V(6); PG8_BAR; PG8_MMA(1, 1, At, B1); PG8_BAR;
            }
        }
        if constexpr (ALIGN_EPI) { if (wr == 0) PG8_BAR; }
        if constexpr (!Epi::AFTER_DRAIN) { E(acc, cur, wr, wc, fr, fq); S.done(cur); }
        if (!has_next) break;
#pragma unroll
        for (int a = 0; a < 2; ++a)
#pragma unroll
            for (int b = 0; b < 2; ++b)
#pragma unroll
                for (int m = 0; m < 4; ++m)
#pragma unroll
                    for (int n = 0; n < 2; ++n) acc[a][b][m][n] = (f32x4){0.f, 0.f, 0.f, 0.f};
        cur = nxt; cA = nA; cB = nB; ++ui;
        if constexpr (ALIGN_EPI) { if (wr == 1) PG8_BAR; }
    }
    PG8_WAIT_V(0);
    if constexpr (!ALIGN_EPI) { if (wr == 0) PG8_BAR; }
    PG8_BAR;
    if constexpr (Epi::AFTER_DRAIN) { E.fused(acc, cur, wr, wc, fr, fq, lds, wid, lane); S.done(cur); }
#undef PG8_SA
#undef PG8_SB
#undef PG8_STAGE
#undef PG8_LDA
#undef PG8_LDB
#undef PG8_MMA
#undef PG8_WAIT_V
#undef PG8_WAIT_L
#undef PG8_BAR
#undef PG8_SCHED
}
}

constexpr int NWAVES = 8, NTHR = 512;
constexpr int N_LAUNCHES = MK_N_LAUNCHES;
constexpr int N_PHASES = 13;
constexpr int DM = 2048, NB = 4, TL = 2048, NLAT = NB * TL, TCX = 256, NCTX = NB * TCX, NTOK = NLAT + NCTX;
constexpr int NH = 8, QKD = 128, VD = 256, INC = 14368, ZW = 14336;
constexpr int ZQ = 0, ZK = 1024, ZV = 2048, ZO = 4096, ZU = 6144, ZS = 8192, ZGA = 10240, ZGB = 12288;
constexpr int NEXP = 32, DEXP = 2048, NCH = 18  , CROWS = 272  ;
constexpr float EPS = 1e-6f;

constexpr size_t MiB = 1u << 20;
constexpr size_t WS_CTL = 0, CTL_ZERO_BYTES = 1 * MiB;
constexpr size_t WS_MOD = 1 * MiB;
constexpr size_t WS_GATES = 2 * MiB;
constexpr size_t WS_SCAL = 4 * MiB;
constexpr size_t WS_ROUTE = 5 * MiB;
constexpr size_t WS_SCN = 2996 * MiB;
constexpr size_t WS_SK = 6 * MiB;
constexpr size_t WS_WINT = 8 * MiB;
constexpr size_t WS_PAT = 64 * MiB, WS_PBT = 72 * MiB, WS_WOT = 80 * MiB;
constexpr size_t WS_W1T = 88 * MiB;
constexpr size_t WS_W2T = 600 * MiB;
constexpr size_t WS_HB = 856 * MiB;
constexpr size_t WS_Z = 892 * MiB;
constexpr size_t WS_QC = 1144 * MiB, WS_KC = 1162 * MiB;
constexpr size_t WS_SVN = 1180 * MiB;
constexpr size_t WS_DC = 1212 * MiB;
constexpr size_t WS_CS = 1360 * MiB;
constexpr size_t WS_RO = 1428 * MiB;
constexpr size_t WS_CM = 1460 * MiB;
constexpr size_t WS_YB = 1492 * MiB;
constexpr size_t WS_MRG = 1556 * MiB;
constexpr size_t WS_X1 = 1588 * MiB;
constexpr size_t WS_ACT = 1652 * MiB;
constexpr size_t WS_Y2 = 1812 * MiB;
constexpr size_t WS_XG = 1972 * MiB;
constexpr size_t WS_END = 2998 * MiB;
static_assert(WS_DC + (size_t)64 * 17 * CROWS * 128 * 2 <= WS_CS && WS_CS + (size_t)64 * 16 * CROWS * 128 * 2 <= WS_RO && WS_Z + (size_t)NTOK * ZW * 2 <= WS_QC, "ws map");
constexpr int CW_Q = 2048;
constexpr int CW_CNT = 64;
constexpr int CW_BAR = 4096;
constexpr int RING_BYTES = 131072;
constexpr int LDS_BYTES = 147456;
constexpr int LDSCTL_OFF = LDS_BYTES - 2048, MISC_OFF = LDSCTL_OFF + 320, PREF_OFF = LDSCTL_OFF + 1024;

#define GAS __attribute__((address_space(1)))
#define LAS __attribute__((address_space(3)))
typedef unsigned short bf16;
typedef unsigned v4u __attribute__((ext_vector_type(4)));
typedef unsigned v2u __attribute__((ext_vector_type(2)));
typedef float f32x4 __attribute__((ext_vector_type(4)));
typedef short bf16x8 __attribute__((ext_vector_type(8)));
typedef short s16x4 __attribute__((ext_vector_type(4)));
typedef GAS unsigned gu32;
#define RLX_AGENT __ATOMIC_RELAXED, __HIP_MEMORY_SCOPE_AGENT
#define LDS_WAIT() asm volatile("s_waitcnt lgkmcnt(0)" ::: "memory")
#define VM_WAIT() asm volatile("s_waitcnt vmcnt(0)" ::: "memory")
using pg8::cvt_pk_bf16; using pg8::bf_lo; using pg8::bf_hi; using pg8::sigmoidf_;


__device__ __forceinline__ float wave_sum(float v) {
#pragma unroll
    for (int o = 1; o < 64; o <<= 1) v += __shfl_xor(v, o);
    return v;
}
__device__ __forceinline__ float siluf_(float x) { return x * __builtin_amdgcn_rcpf(1.0f + __expf(-x)); }
__device__ __forceinline__ float gelu_tanh(float x) { const float u = 0.7978845608028654f * (x + 0.044715f * x * x * x); return x * __builtin_amdgcn_rcpf(1.0f + __expf(-2.0f * u)); }
__device__ __forceinline__ float logsigf_(float f) { return fminf(f, 0.f) - log1pf(expf(-fabsf(f))); }
__device__ __forceinline__ unsigned img_off(unsigned row, unsigned ch) { return 256u * row + 16u * (ch ^ (((row & 3u) << 2) | ((row >> 2) & 3u))); }
__device__ __forceinline__ s16x4 tr_read(LAS unsigned char* p) { return __builtin_amdgcn_ds_read_tr16_b64_v4i16((LAS s16x4*)p); }
__device__ __forceinline__ bf16x8 tr_frag(LAS unsigned char* img, unsigned r0, unsigned r1, unsigned c, int lane) {
    const unsigned q = (lane & 15) >> 2, p = lane & 3;
    const s16x4 lo = tr_read(img + img_off(r0 + q, 2 * c + (p >> 1)) + 8 * (p & 1));
    const s16x4 hi = tr_read(img + img_off(r1 + q, 2 * c + (p >> 1)) + 8 * (p & 1));
    bf16x8 r; r[0] = lo[0]; r[1] = lo[1]; r[2] = lo[2]; r[3] = lo[3]; r[4] = hi[0]; r[5] = hi[1]; r[6] = hi[2]; r[7] = hi[3]; return r;
}
__device__ __forceinline__ bf16x8 tr_frag2(LAS unsigned char* base, unsigned x0, unsigned x1) {
    const s16x4 lo = tr_read(base + x0), hi = tr_read(base + x1);
    bf16x8 r; r[0] = lo[0]; r[1] = lo[1]; r[2] = lo[2]; r[3] = lo[3]; r[4] = hi[0]; r[5] = hi[1]; r[6] = hi[2]; r[7] = hi[3]; return r;
}
#define TR_NAT_OFFS(xn0, xn1, lane) unsigned xn0[8], xn1[8]; { const unsigned g_ = (lane) >> 4, q_ = ((lane) & 15) >> 2, p_ = (lane) & 3; \
    _Pragma("unroll") for (int c_ = 0; c_ < 8; ++c_) { xn0[c_] = 256u * (8 * g_ + q_) + 16u * ((2 * c_ + (p_ >> 1)) ^ ((q_ << 2) | ((2 * g_) & 3))) + 8u * (p_ & 1); \
                                                       xn1[c_] = 256u * (8 * g_ + 4 + q_) + 16u * ((2 * c_ + (p_ >> 1)) ^ ((q_ << 2) | ((2 * g_ + 1) & 3))) + 8u * (p_ & 1); } }
#define TR_PERM_OFFS(xp, lane) unsigned xp[8]; { const unsigned g_ = (lane) >> 4, q_ = ((lane) & 15) >> 2, p_ = (lane) & 3; \
    _Pragma("unroll") for (int c_ = 0; c_ < 8; ++c_) xp[c_] = 256u * (4 * g_ + q_) + 16u * ((2 * c_ + (p_ >> 1)) ^ ((q_ << 2) | g_)) + 8u * (p_ & 1); }
__device__ __forceinline__ void load_tile128(LAS unsigned char* img, const bf16* src, size_t ld, int tid) {
#pragma unroll
    for (int i = 0; i < 4; ++i) { const int id = tid + NTHR * i, row = id >> 4, ch = id & 15;
        const v4u v = *(const v4u*)(src + (size_t)row * ld + 8 * ch); *(LAS v4u*)(img + img_off(row, ch)) = v; }
}
__device__ __forceinline__ void load_tile128_scaled(LAS unsigned char* img, const bf16* src, size_t ld, const LAS float* w, int tid) {
#pragma unroll
    for (int i = 0; i < 4; ++i) { const int id = tid + NTHR * i, row = id >> 4, ch = id & 15; const float s = w[row];
        const v4u v = *(const v4u*)(src + (size_t)row * ld + 8 * ch); v4u o;
        o.x = cvt_pk_bf16(bf_lo(v.x) * s, bf_hi(v.x) * s); o.y = cvt_pk_bf16(bf_lo(v.y) * s, bf_hi(v.y) * s); o.z = cvt_pk_bf16(bf_lo(v.z) * s, bf_hi(v.z) * s); o.w = cvt_pk_bf16(bf_lo(v.w) * s, bf_hi(v.w) * s);
        *(LAS v4u*)(img + img_off(row, ch)) = o; }
}
__device__ __forceinline__ void gate_scan(const float* G, size_t row0, int col_i, int col_f, int dir, int lane, float* bc, float* gg, float* pmx, float& b_end, float& gmax) {
    const int j0 = dir ? 127 - 2 * lane : 2 * lane, j1 = dir ? 126 - 2 * lane : 2 * lane + 1;
    const float f0 = G[(row0 + j0) * 32 + col_f], f1 = G[(row0 + j1) * 32 + col_f], i0 = G[(row0 + j0) * 32 + col_i], i1 = G[(row0 + j1) * 32 + col_i];
    const float lf0 = logsigf_(f0), lf1 = logsigf_(f1), s = lf0 + lf1; float incl = s;
#pragma unroll
    for (int o = 1; o < 64; o <<= 1) { const float t = __shfl_up(incl, o); if (lane >= o) incl += t; }
    const float b0 = (incl - s) + lf0, b1 = incl, g0 = i0 - b0, g1 = i1 - b1;
    float mincl = fmaxf(g0, g1);
#pragma unroll
    for (int o = 1; o < 64; o <<= 1) { const float t = __shfl_up(mincl, o); if (lane >= o) mincl = fmaxf(mincl, t); }
    float mexcl = __shfl_up(mincl, 1); if (lane == 0) mexcl = -3.0e38f;
    bc[j0] = b0; bc[j1] = b1; gg[j0] = g0; gg[j1] = g1; pmx[j0] = fmaxf(mexcl, g0); pmx[j1] = mincl;
    b_end = __shfl(incl, 63); gmax = __shfl(mincl, 63);
}
#define MFMA16(a, b, c) __builtin_amdgcn_mfma_f32_16x16x32_bf16((a), (b), (c), 0, 0, 0)

struct CvtItem { const float* src; size_t ldw; bf16* dst; };
constexpr int N_CONVERTERS = 112;
constexpr int N_CONV_DEFER = 1440;
constexpr int I_GEMV = 192, I_WIN = 16 * 56, I_P = 16 * 8, I_W1 = 32 * 16 * 16, I_W2 = 32 * 16 * 8, I_TOTAL = I_GEMV + I_WIN + 3 * I_P + I_W1 + I_W2;
__device__ __forceinline__ CvtItem cvt_decode(int r, int tid, const float* w_in, const float* proj_a, const float* proj_b, const float* w_out, const float* exp_w1, const float* exp_w2,
                                              bf16* WINT, bf16* PAT, bf16* PBT, bf16* WOT, bf16* W1T, bf16* W2T) {
    const int n4 = tid & 63, kg = tid >> 6; const float* W; size_t ldw, ca, cb, drow; int kt; bf16* WT;
    if (r < I_WIN) { kt = r / 56; const int nt = r % 56; W = w_in; ldw = INC; ca = (size_t)256 * nt + (nt >= 16 ? 32 : 0); cb = ca + 128; WT = WINT; drow = (size_t)256 * nt; }
    else if ((r -= I_WIN) < 3 * I_P) { const int m = r / I_P, q = r % I_P; kt = q / 8; const int nt = q % 8; W = m == 0 ? proj_a : (m == 1 ? proj_b : w_out); ldw = 2048; ca = (size_t)256 * nt; cb = ca + 128; WT = m == 0 ? PAT : (m == 1 ? PBT : WOT); drow = (size_t)256 * nt; }
    else if ((r -= 3 * I_P) < I_W1) { const int e = r / 256, q = r % 256; kt = q / 16; const int nt = q % 16; W = exp_w1 + (size_t)e * 2048 * 4096; ldw = 4096; ca = (size_t)128 * nt; cb = 2048 + ca; WT = W1T; drow = (size_t)e * 4096 + 256 * nt; }
    else { r -= I_W1; const int e = r / 128, q = r % 128; kt = q / 8; const int nt = q % 8; W = exp_w2 + (size_t)e * 2048 * 2048; ldw = 2048; ca = (size_t)256 * nt; cb = ca + 128; WT = W2T; drow = (size_t)e * 2048 + 256 * nt; }
    CvtItem it; it.ldw = ldw; it.src = W + (size_t)(128 * kt + 8 * kg) * ldw + (n4 < 32 ? ca + 4 * n4 : cb + 4 * (n4 - 32)); it.dst = WT + drow * 2048 + 128 * kt; return it;
}
__device__ __forceinline__ void cvt_run(LAS unsigned char* lds, int tid, int it, int stride, int end, const float* w_in, const float* proj_a, const float* proj_b, const float* w_out, const float* exp_w1, const float* exp_w2,
                                        bf16* WINT, bf16* PAT, bf16* PBT, bf16* WOT, bf16* W1T, bf16* W2T) {
    const int n4 = tid & 63, kg = tid >> 6;
    f32x4 v[16]; CvtItem cur;
    bool have = it < end;
    if (have) { cur = cvt_decode(it - I_GEMV, tid, w_in, proj_a, proj_b, w_out, exp_w1, exp_w2, WINT, PAT, PBT, WOT, W1T, W2T);
#pragma unroll
        for (int i = 0; i < 16; ++i) v[i] = __builtin_nontemporal_load((const f32x4*)(cur.src + (size_t)((i >> 3) * 64 + (i & 7)) * cur.ldw)); }
    while (have) {
#pragma unroll
        for (int hf = 0; hf < 2; ++hf)
#pragma unroll
            for (int j = 0; j < 4; ++j) { v4u o; o.x = cvt_pk_bf16(v[8 * hf + 0][j], v[8 * hf + 1][j]); o.y = cvt_pk_bf16(v[8 * hf + 2][j], v[8 * hf + 3][j]); o.z = cvt_pk_bf16(v[8 * hf + 4][j], v[8 * hf + 5][j]); o.w = cvt_pk_bf16(v[8 * hf + 6][j], v[8 * hf + 7][j]);
                *(LAS v4u*)(lds + img_off(4 * n4 + j, 8 * hf + kg)) = o; }
        __syncthreads();
        bf16* dst = cur.dst;
        it += stride; have = it < end;
        if (have) { cur = cvt_decode(it - I_GEMV, tid, w_in, proj_a, proj_b, w_out, exp_w1, exp_w2, WINT, PAT, PBT, WOT, W1T, W2T);
#pragma unroll
            for (int i = 0; i < 16; ++i) v[i] = __builtin_nontemporal_load((const f32x4*)(cur.src + (size_t)((i >> 3) * 64 + (i & 7)) * cur.ldw)); }
#pragma unroll
        for (int i = 0; i < 8; ++i) { const int id = tid + NTHR * i, row = id >> 4, ch = id & 15; const v4u o = *(const LAS v4u*)(lds + img_off(row, ch)); __builtin_nontemporal_store(o, (v4u*)(dst + (size_t)row * 2048 + 8 * ch)); }
        __syncthreads();
    }
}
__device__ __forceinline__ void p0_phase(LAS unsigned char* lds, int tid, int G, const float* c, const float* c_ctx, const float* mod_w, const float* mod_b, float* MOD,
                                         const float* w_in, const float* proj_a, const float* proj_b, const float* w_out, const float* exp_w1, const float* exp_w2, const float* router_w,
                                         bf16* WINT, bf16* PAT, bf16* PBT, bf16* WOT, bf16* W1T, bf16* W2T, bf16* SK, int n_conv_p0) {
    LAS float* sc = (LAS float*)lds;
    LAS float* red = (LAS float*)(lds + 40960);
    int it = blockIdx.x;
    if (it < I_GEMV) {
        for (int i = tid; i < 5 * 2048; i += NTHR) { const float x = i < 4 * 2048 ? c[i] : c_ctx[i - 4 * 2048]; sc[i] = siluf_(x); }
        __syncthreads();
        for (; it < I_GEMV; it += G) {
            const int j0 = 64 * it, c4 = tid & 15, kg = tid >> 4;
            f32x4 a0 = {0.f, 0.f, 0.f, 0.f}, a1 = a0, a2 = a0, a3 = a0, a4 = a0;
            const float* wp = mod_w + (size_t)kg * 12288 + j0 + 4 * c4;
#pragma unroll 8
            for (int k = kg; k < 2048; k += 32) { const f32x4 w = *(const f32x4*)wp; wp += (size_t)32 * 12288;
                a0 += w * sc[k]; a1 += w * sc[2048 + k]; a2 += w * sc[4096 + k]; a3 += w * sc[6144 + k]; a4 += w * sc[8192 + k]; }
            *(LAS f32x4*)(red + (kg * 5 + 0) * 64 + 4 * c4) = a0; *(LAS f32x4*)(red + (kg * 5 + 1) * 64 + 4 * c4) = a1; *(LAS f32x4*)(red + (kg * 5 + 2) * 64 + 4 * c4) = a2;
            *(LAS f32x4*)(red + (kg * 5 + 3) * 64 + 4 * c4) = a3; *(LAS f32x4*)(red + (kg * 5 + 4) * 64 + 4 * c4) = a4;
            __syncthreads();
            if (tid < 320) { const int rr = tid >> 6, j = tid & 63; float s = 0.f;
#pragma unroll 8
                for (int g = 0; g < 32; ++g) s += red[(g * 5 + rr) * 64 + j];
                MOD[rr * 12288 + j0 + j] = s + mod_b[j0 + j]; }
            __syncthreads();
        }
    } else {
        for (int i = (it - I_GEMV) * NTHR + tid; i < 2 * 32 * 2048; i += (G - I_GEMV) * NTHR) { const int m = i >> 16, n = (i >> 11) & 31, k = i & 2047;
            const float w = m == 0 ? w_in[(size_t)k * INC + 4096 + n] : router_w[k * 32 + n];
            const unsigned hi = cvt_pk_bf16(w, 0.f) & 0xffffu; const unsigned lo = cvt_pk_bf16(w - __uint_as_float(hi << 16), 0.f) & 0xffffu;
            SK[(size_t)(2 * m) * 65536 + n * 2048 + k] = (bf16)hi; SK[(size_t)(2 * m + 1) * 65536 + n * 2048 + k] = (bf16)lo; }
    }
    cvt_run(lds, tid, it, G, I_GEMV + n_conv_p0, w_in, proj_a, proj_b, w_out, exp_w1, exp_w2, WINT, PAT, PBT, WOT, W1T, W2T);
}

__device__ __forceinline__ void skinny_mfma(const LAS float* hrow, const bf16* WT_hi, const bf16* WT_lo, LAS float* part, int wave, int lane) {
    const int g = lane >> 4, l15 = lane & 15;
    f32x4 acc0 = {0.f, 0.f, 0.f, 0.f}, acc1 = acc0;
#pragma unroll
    for (int ks = 0; ks < 8; ++ks) { const int kb = 256 * wave + 32 * ks + 8 * g;
        f32x4 a0 = {0.f, 0.f, 0.f, 0.f}, a1 = a0;
        if (l15 < 8) { a0 = *(const LAS f32x4*)(hrow + l15 * 2048 + kb); a1 = *(const LAS f32x4*)(hrow + l15 * 2048 + kb + 4); }
        v4u hi, lo;
        hi.x = cvt_pk_bf16(a0[0], a0[1]); hi.y = cvt_pk_bf16(a0[2], a0[3]); hi.z = cvt_pk_bf16(a1[0], a1[1]); hi.w = cvt_pk_bf16(a1[2], a1[3]);
        lo.x = cvt_pk_bf16(a0[0] - bf_lo(hi.x), a0[1] - bf_hi(hi.x)); lo.y = cvt_pk_bf16(a0[2] - bf_lo(hi.y), a0[3] - bf_hi(hi.y));
        lo.z = cvt_pk_bf16(a1[0] - bf_lo(hi.z), a1[1] - bf_hi(hi.z)); lo.w = cvt_pk_bf16(a1[2] - bf_lo(hi.w), a1[3] - bf_hi(hi.w));
        const bf16x8 Ah = __builtin_bit_cast(bf16x8, hi), Al = __builtin_bit_cast(bf16x8, lo);
        const bf16x8 b0h = *(const bf16x8*)(WT_hi + (size_t)l15 * 2048 + kb), b0l = *(const bf16x8*)(WT_lo + (size_t)l15 * 2048 + kb);
        const bf16x8 b1h = *(const bf16x8*)(WT_hi + (size_t)(16 + l15) * 2048 + kb), b1l = *(const bf16x8*)(WT_lo + (size_t)(16 + l15) * 2048 + kb);
        acc0 = MFMA16(Ah, b0h, acc0); acc0 = MFMA16(Ah, b0l, acc0); acc0 = MFMA16(Al, b0h, acc0);
        acc1 = MFMA16(Ah, b1h, acc1); acc1 = MFMA16(Ah, b1l, acc1); acc1 = MFMA16(Al, b1h, acc1); }
    if (g < 2) {
#pragma unroll
        for (int r = 0; r < 4; ++r) { part[wave * 256 + (4 * g + r) * 32 + l15] = acc0[r]; part[wave * 256 + (4 * g + r) * 32 + 16 + l15] = acc1[r]; } }
}

__device__ __forceinline__ void p1_phase(LAS unsigned char* lds, int tid, int wave, int lane, int G, const float* x, const float* ctx, const float* MOD, const float* norm_g,
                                         const bf16* SK, const float* gate_b, bf16* HB, float* GATES) {
    LAS float* hrow = (LAS float*)(lds + wave * 8192); LAS float* part = (LAS float*)(lds + 65536);
    f32x4 v[8];
    { const int row = blockIdx.x * 8 + wave; const float* xr = row < NLAT ? x + (size_t)row * DM : ctx + (size_t)(row - NLAT) * DM;
#pragma unroll
      for (int j = 0; j < 8; ++j) v[j] = *(const f32x4*)(xr + 4 * (lane + 64 * j)); }
    for (int it = blockIdx.x; it < NTOK / 8; it += G) {
        const int row = it * 8 + wave;
        const float* shift = MOD + (size_t)(row < NLAT ? (row >> 11) : 4) * 12288; const float* scale = shift + 2048;
        float ss = 0.f;
#pragma unroll
        for (int j = 0; j < 8; ++j) ss += (v[j][0] * v[j][0] + v[j][1] * v[j][1]) + (v[j][2] * v[j][2] + v[j][3] * v[j][3]);
        const float rstd = 1.0f / sqrtf(wave_sum(ss) * (1.0f / DM) + EPS);
#pragma unroll
        for (int j = 0; j < 8; ++j) { const int col = 4 * (lane + 64 * j);
            const f32x4 g = *(const f32x4*)(norm_g + col), sc = *(const f32x4*)(scale + col), sh = *(const f32x4*)(shift + col);
            const f32x4 h = (v[j] * rstd) * g * (sc + 1.0f) + sh;
            v2u o; o.x = cvt_pk_bf16(h[0], h[1]); o.y = cvt_pk_bf16(h[2], h[3]); *(v2u*)(HB + (size_t)row * DM + col) = o;
            *(LAS f32x4*)(hrow + col) = h; }
        if (it + G < NTOK / 8) { const int rown = (it + G) * 8 + wave; const float* xr = rown < NLAT ? x + (size_t)rown * DM : ctx + (size_t)(rown - NLAT) * DM;
#pragma unroll
            for (int j = 0; j < 8; ++j) v[j] = *(const f32x4*)(xr + 4 * (lane + 64 * j)); }
        __syncthreads();
        skinny_mfma((const LAS float*)lds, SK, SK + 65536, part, wave, lane);
        __syncthreads();
        if (tid < 256) { float s = 0.f;
#pragma unroll
            for (int w = 0; w < 8; ++w) s += part[w * 256 + tid];
            GATES[(size_t)(it * 8) * 32 + tid] = s + gate_b[tid & 31]; }
    }
}

__device__ __forceinline__ void p3_phase(int wave, int lane, int G, const bf16* Z, const float* conv_w, const float* conv_b, const float* sgu_norm_g, bf16* QC, bf16* KC, bf16* SVN,
                                         const float* GATES, float* SCN, float* BEND, float* GMAX) {
    const int gw = blockIdx.x * NWAVES + wave, NGW = G * NWAVES;
    for (int task = gw; task < 64 * NCH; task += NGW) { const int bhd = task / NCH, bi = task - bhd * NCH, dir = bhd & 1, bh = bhd >> 1, b = bh >> 3, h = bh & 7;
        const size_t row0 = bi < 2 ? (size_t)NLAT + b * TCX + bi * 128 : (size_t)b * TL + (bi - 2) * 128;
        float* sp = SCN + (size_t)task * 384; float b_end, gmax;
        gate_scan(GATES, row0, (2 * dir) * 8 + h, (2 * dir + 1) * 8 + h, dir, lane, sp, sp + 128, sp + 256, b_end, gmax);
        const int c = dir == 0 ? bi : (bi < 2 ? 1 - bi : 19 - bi);
        if (lane == 0 && c < 17) { BEND[bhd * 17 + c] = b_end; GMAX[bhd * 17 + c] = gmax; } }
    for (int item = gw; item < NTOK; item += NGW) {
        const int rb = item >> 2, seg = item & 3, row0 = rb * 4, c0 = seg * 512 + lane * 8;
        const int t0 = row0 < NLAT ? (row0 & (TL - 1)) : ((row0 - NLAT) & (TCX - 1)), len = row0 < NLAT ? TL : TCX;
        v4u zr[8];
#pragma unroll
        for (int k = 0; k < 8; ++k) { const int tt = t0 + k - 2; zr[k] = (v4u){0u, 0u, 0u, 0u};
            if (tt >= 0 && tt < len) zr[k] = *(const v4u*)(Z + (size_t)(row0 + k - 2) * ZW + c0); }
        f32x4 w0[5], w1[5];
#pragma unroll
        for (int tau = 0; tau < 5; ++tau) { w0[tau] = *(const f32x4*)(conv_w + tau * 2048 + c0); w1[tau] = *(const f32x4*)(conv_w + tau * 2048 + c0 + 4); }
        const f32x4 b0 = *(const f32x4*)(conv_b + c0), b1 = *(const f32x4*)(conv_b + c0 + 4);
        const float qs = c0 < 1024 ? 0.08838834764831845f : 1.0f;
#pragma unroll
        for (int o = 0; o < 4; ++o) { float acc[8] = {b0[0], b0[1], b0[2], b0[3], b1[0], b1[1], b1[2], b1[3]};
#pragma unroll
            for (int tau = 0; tau < 5; ++tau) { const v4u z = zr[o + tau];
                acc[0] += w0[tau][0] * bf_lo(z.x); acc[1] += w0[tau][1] * bf_hi(z.x); acc[2] += w0[tau][2] * bf_lo(z.y); acc[3] += w0[tau][3] * bf_hi(z.y);
                acc[4] += w1[tau][0] * bf_lo(z.z); acc[5] += w1[tau][1] * bf_hi(z.z); acc[6] += w1[tau][2] * bf_lo(z.w); acc[7] += w1[tau][3] * bf_hi(z.w); }
#pragma unroll
            for (int i = 0; i < 8; ++i) acc[i] = siluf_(acc[i]) * qs;
            v4u ov; ov.x = cvt_pk_bf16(acc[0], acc[1]); ov.y = cvt_pk_bf16(acc[2], acc[3]); ov.z = cvt_pk_bf16(acc[4], acc[5]); ov.w = cvt_pk_bf16(acc[6], acc[7]);
            bf16* dst = c0 < 1024 ? QC + (size_t)(row0 + o) * 1024 + c0 : KC + (size_t)(row0 + o) * 1024 + (c0 - 1024);
            *(v4u*)dst = ov; }
    }
    for (int row = gw; row < NLAT; row += NGW) {
        float v[32]; float ss = 0.f;
#pragma unroll
        for (int j = 0; j < 4; ++j) { const v4u z = *(const v4u*)(Z + (size_t)row * ZW + ZS + 8 * lane + 512 * j);
            v[8 * j + 0] = gelu_tanh(bf_lo(z.x)); v[8 * j + 1] = gelu_tanh(bf_hi(z.x)); v[8 * j + 2] = gelu_tanh(bf_lo(z.y)); v[8 * j + 3] = gelu_tanh(bf_hi(z.y));
            v[8 * j + 4] = gelu_tanh(bf_lo(z.z)); v[8 * j + 5] = gelu_tanh(bf_hi(z.z)); v[8 * j + 6] = gelu_tanh(bf_lo(z.w)); v[8 * j + 7] = gelu_tanh(bf_hi(z.w)); }
#pragma unroll
        for (int i = 0; i < 32; ++i) ss += v[i] * v[i];
        const float rstd = 1.0f / sqrtf(wave_sum(ss) * (1.0f / DM) + EPS);
#pragma unroll
        for (int j = 0; j < 4; ++j) { const int col = 8 * lane + 512 * j; const f32x4 g0 = *(const f32x4*)(sgu_norm_g + col), g1 = *(const f32x4*)(sgu_norm_g + col + 4);
            v4u o; o.x = cvt_pk_bf16(v[8 * j] * rstd * g0[0], v[8 * j + 1] * rstd * g0[1]); o.y = cvt_pk_bf16(v[8 * j + 2] * rstd * g0[2], v[8 * j + 3] * rstd * g0[3]);
            o.z = cvt_pk_bf16(v[8 * j + 4] * rstd * g1[0], v[8 * j + 5] * rstd * g1[1]); o.w = cvt_pk_bf16(v[8 * j + 6] * rstd * g1[2], v[8 * j + 7] * rstd * g1[3]);
            *(v4u*)(SVN + (size_t)row * DM + col) = o; }
    }
}

constexpr int L_V0 = 0, L_V1 = 32768, L_K = 65536, L_SC = 98304, L_CB = 106496;
constexpr int N_M1 = 64 * 17, N_SGU = 512;
__device__ __forceinline__ void p4_phase(LAS unsigned char* lds, int tid_, int wave, int lane_, int G, const bf16* Z, const bf16* KC, const bf16* SVN, const float* SCN,
                                         const float* sgu_w, const float* sgu_b, bf16* DC, const float* GMAX, bf16* CM) {
    v4u pk[4], pv[8]; f32x4 pa[2];
#define P4_ISSUE(U) do { const int u_ = (U); int t_ = tid_; asm volatile("" : "+v"(t_)); \
        if (u_ < N_M1) { const int bhd_ = u_ / 17, c_ = u_ - bhd_ * 17, dir_ = bhd_ & 1, bh_ = bhd_ >> 1, b_ = bh_ >> 3, h_ = bh_ & 7; \
            const bool ic_ = c_ < 2; const int blk_ = dir_ == 0 ? (ic_ ? c_ : c_ - 2) : (ic_ ? 1 - c_ : 17 - c_); \
            const size_t r0_ = ic_ ? (size_t)NLAT + b_ * TCX + blk_ * 128 : (size_t)b_ * TL + blk_ * 128; \
            const float* sp_ = SCN + (size_t)(bhd_ * NCH + (ic_ ? blk_ : blk_ + 2)) * 384; \
            _Pragma("unroll") for (int i = 0; i < 4; ++i) { const int id = t_ + NTHR * i; pk[i] = *(const v4u*)(KC + (r0_ + (id >> 4)) * 1024 + h_ * QKD + 8 * (id & 15)); pa[0][i] = sp_[128 + (id >> 4)]; } \
            pa[1][0] = GMAX[bhd_ * 17 + c_]; \
            _Pragma("unroll") for (int i = 0; i < 8; ++i) { const int id = t_ + NTHR * (i & 3); pv[i] = *(const v4u*)(Z + (r0_ + (id >> 4)) * ZW + ZV + h_ * VD + 128 * (i >> 2) + 8 * (id & 15)); } \
        } else { const int u2_ = u_ - N_M1, b_ = u2_ >> 7, n_ = (u2_ >> 3) & 15, grp_ = u2_ & 7; const size_t r0_ = (size_t)b_ * TL + n_ * 128; \
            _Pragma("unroll") for (int i = 0; i < 8; ++i) { const int id = t_ + NTHR * (i & 3); pv[i] = *(const v4u*)(SVN + (r0_ + (id >> 4)) * DM + grp_ * 256 + 128 * (i >> 2) + 8 * (id & 15)); } \
            } } while (0)
    int u = blockIdx.x;
    if (u < N_M1 + N_SGU) P4_ISSUE(u);
    for (; u < N_M1 + N_SGU; u += G) {
        int tid = tid_; asm volatile("" : "+v"(tid)); const int lane = tid & 63; const unsigned g = lane >> 4, l15 = lane & 15;
        const bool m1 = u < N_M1;
        TR_NAT_OFFS(xn0, xn1, lane)
#pragma unroll
        for (int i = 0; i < 8; ++i) { const int id = tid + NTHR * (i & 3); *(LAS v4u*)(lds + ((i >> 2) ? L_V1 : L_V0) + img_off(id >> 4, id & 15)) = pv[i]; }
        bf16x8 Af[4]; v2u uw[16];
        if (m1) { const float gmax = pa[1][0];
#pragma unroll
            for (int i = 0; i < 4; ++i) { const int id = tid + NTHR * i, row = id >> 4, ch = id & 15; const float sw = __expf(pa[0][i] - gmax); const v4u v = pk[i]; v4u o;
                o.x = cvt_pk_bf16(bf_lo(v.x) * sw, bf_hi(v.x) * sw); o.y = cvt_pk_bf16(bf_lo(v.y) * sw, bf_hi(v.y) * sw); o.z = cvt_pk_bf16(bf_lo(v.z) * sw, bf_hi(v.z) * sw); o.w = cvt_pk_bf16(bf_lo(v.w) * sw, bf_hi(v.w) * sw);
                *(LAS v4u*)(lds + L_K + img_off(row, ch)) = o; }
        }
        __syncthreads();
        f32x4 af32[8];
        if (!m1) { const int u2 = u - N_M1, b = u2 >> 7, n = (u2 >> 3) & 15, grp = u2 & 7;
            const float* src = sgu_w + (size_t)grp * 16384 + (size_t)(16 * wave + l15) * 128 + 8 * g;
#pragma unroll
            for (int ks = 0; ks < 4; ++ks) { af32[2 * ks] = *(const f32x4*)(src + 32 * ks); af32[2 * ks + 1] = *(const f32x4*)(src + 32 * ks + 4); }
            const bf16* up = Z + ((size_t)b * TL + n * 128 + 16 * wave + l15) * ZW + ZU + grp * 256 + 4 * g;
#pragma unroll
            for (int et = 0; et < 16; ++et) uw[et] = *(const v2u*)(up + 16 * et); }
        if (u + G < N_M1 + N_SGU) P4_ISSUE(u + G);
        if (!m1) {
#pragma unroll
            for (int ks = 0; ks < 4; ++ks) { const f32x4 a = af32[2 * ks], b2 = af32[2 * ks + 1];
                const v4u p = {cvt_pk_bf16(a[0], a[1]), cvt_pk_bf16(a[2], a[3]), cvt_pk_bf16(b2[0], b2[1]), cvt_pk_bf16(b2[2], b2[3])}; Af[ks] = __builtin_bit_cast(bf16x8, p); } }
        if (m1) {
            const int bhd = u / 17, c = u - bhd * 17;
#pragma unroll
            for (int ks = 0; ks < 4; ++ks) Af[ks] = tr_frag(lds + L_K, 32 * ks + 8 * g, 32 * ks + 8 * g + 4, wave, lane);
            f32x4 acc[17];
#pragma unroll
            for (int et = 0; et < 17; ++et) acc[et] = (f32x4){0.f, 0.f, 0.f, 0.f};
#pragma unroll
            for (int et = 0; et < 16; ++et) { LAS unsigned char* img = lds + ((et >> 3) ? L_V1 : L_V0);
#pragma unroll
                for (int ks = 0; ks < 4; ++ks) { const bf16x8 Bf = tr_frag2(img + 8192 * ks, xn0[et & 7], xn1[et & 7]); acc[et] = MFMA16(Af[ks], Bf, acc[et]); } }
            { const short one = l15 == 0 ? (short)0x3F80 : (short)0; const bf16x8 Bo = {one, one, one, one, one, one, one, one};
#pragma unroll
                for (int ks = 0; ks < 4; ++ks) acc[16] = MFMA16(Af[ks], Bo, acc[16]); }
            bf16* dst = DC + ((size_t)bhd * 17 + c) * (CROWS * 128) + 16 * wave + 4 * g;
#pragma unroll
            for (int et = 0; et < 16; ++et) { v2u o; o.x = cvt_pk_bf16(acc[et][0], acc[et][1]); o.y = cvt_pk_bf16(acc[et][2], acc[et][3]); *(v2u*)(dst + (size_t)(16 * et + l15) * 128) = o; }
            if (l15 == 0) { v2u o; o.x = cvt_pk_bf16(acc[16][0], acc[16][1]); o.y = cvt_pk_bf16(acc[16][2], acc[16][3]); *(v2u*)(dst + (size_t)256 * 128) = o; }
        } else {
            const int u2 = u - N_M1, b = u2 >> 7, n = (u2 >> 3) & 15, grp = u2 & 7; const size_t row0 = (size_t)b * TL + n * 128;
            f32x4 acc[16];
#pragma unroll
            for (int et = 0; et < 16; ++et) { acc[et] = (f32x4){0.f, 0.f, 0.f, 0.f}; LAS unsigned char* img = lds + ((et >> 3) ? L_V1 : L_V0);
#pragma unroll
                for (int ks = 0; ks < 4; ++ks) { const bf16x8 Bf = tr_frag2(img + 8192 * ks, xn0[et & 7], xn1[et & 7]); acc[et] = MFMA16(Bf, Af[ks], acc[et]); } }
            { const int t = 16 * wave + l15; const float zb = sgu_b[grp * 128 + t]; const size_t row = row0 + t;
#pragma unroll
              for (int et = 0; et < 16; ++et) { const int col = grp * 256 + 16 * et + 4 * g; const v2u w2 = uw[et];
                  const float o0 = gelu_tanh(bf_lo(w2.x)) * (acc[et][0] + zb), o1 = gelu_tanh(bf_hi(w2.x)) * (acc[et][1] + zb), o2 = gelu_tanh(bf_lo(w2.y)) * (acc[et][2] + zb), o3 = gelu_tanh(bf_hi(w2.y)) * (acc[et][3] + zb);
                  v2u o; o.x = cvt_pk_bf16(o0, o1); o.y = cvt_pk_bf16(o2, o3); *(v2u*)(CM + row * DM + col) = o; } }
        }
        __syncthreads();
    }
#undef P4_ISSUE
}

__device__ __forceinline__ void p5_scan(int tid, int G, const bf16* DC, const float* BEND, const float* GMAX, bf16* CS, float* MST) {
    constexpr int QPB = 257 * 128 / 4;
    for (int idx = blockIdx.x * NTHR + tid; idx < 64 * QPB; idx += G * NTHR) {
        const int bhd = idx / QPB, q = idx - bhd * QPB;
        f32x4 C = {0.f, 0.f, 0.f, 0.f}; float m = 0.f;
#pragma unroll
        for (int c = 0; c < 17; ++c) {
            const float gm = GMAX[bhd * 17 + c], be = BEND[bhd * 17 + c], mx = fmaxf(m, gm), al = __expf(m - mx), bt = __expf(gm - mx);
            const v2u dw = *(const v2u*)(DC + ((size_t)bhd * 17 + c) * (CROWS * 128) + 4 * q); const f32x4 d = {bf_lo(dw.x), bf_hi(dw.x), bf_lo(dw.y), bf_hi(dw.y)};
            C = C * al + d * bt; m = be + mx;
            if (c >= 1) { v2u o; o.x = cvt_pk_bf16(C[0], C[1]); o.y = cvt_pk_bf16(C[2], C[3]);
                *(v2u*)(CS + ((size_t)bhd * 16 + (c - 1)) * (CROWS * 128) + 4 * q) = o; if (q == 0) MST[bhd * 18 + c + 1] = m; }
        }
    }
}

__device__ __forceinline__ void p6_phase(LAS unsigned char* lds, int tid, int wave, int lane_, int G, const bf16* Z, const bf16* QC, const bf16* KC, const float* SCN,
                                         const bf16* CS, const float* MST, const float* mnorm_g, bf16* RO) {
    for (int u = blockIdx.x; u < 512; u += G) {
        int lane = lane_; asm volatile("" : "+v"(lane)); const unsigned g = lane >> 4, l15 = lane & 15;
        const int bh = u >> 4, jb = u & 15, b = bh >> 3, h = bh & 7; const size_t row0 = (size_t)b * TL + jb * 128;
        load_tile128(lds + L_K, KC + row0 * 1024 + h * QKD, 1024, tid);
        load_tile128(lds + L_V0, Z + row0 * ZW + ZV + h * VD, ZW, tid);
        load_tile128(lds + L_V1, Z + row0 * ZW + ZV + h * VD + 128, ZW, tid);
        bf16x8 Qf[4];
#pragma unroll
        for (int ks = 0; ks < 4; ++ks) Qf[ks] = *(const bf16x8*)(QC + (row0 + 16 * wave + l15) * 1024 + h * QKD + 32 * ks + 8 * g);
        __syncthreads();
        f32x4 hsum[16];
#pragma unroll
        for (int et = 0; et < 16; ++et) hsum[et] = (f32x4){0.f, 0.f, 0.f, 0.f};
#pragma unroll 1
        for (int dir = 0; dir < 2; ++dir) {
            int lane = lane_; asm volatile("" : "+v"(lane));
            const unsigned g = lane >> 4, l15 = lane & 15;
            TR_PERM_OFFS(xp, lane)
            const int c = dir ? 17 - jb : 2 + jb; const bf16* cs = CS + ((size_t)(bh * 2 + dir) * 16 + (c - 2)) * (CROWS * 128);
            const float* sp = SCN + (size_t)((bh * 2 + dir) * NCH + 2 + jb) * 384; const float* gg = sp + 128; const float mc = MST[(bh * 2 + dir) * 18 + c];
            const int tS = 16 * wave + l15; const float MtS = fmaxf(mc, sp[256 + tS]);
            unsigned pw[16];
#pragma unroll
            for (int st = 0; st < 8; ++st) { f32x4 aS = {0.f, 0.f, 0.f, 0.f};
#pragma unroll
                for (int ks = 0; ks < 4; ++ks) { const bf16x8 Kf = *(const LAS bf16x8*)(lds + L_K + img_off(16 * st + l15, 4 * ks + g)); aS = MFMA16(Kf, Qf[ks], aS); }
                float pv[4]; const f32x4 gs = *(const f32x4*)(gg + 16 * st + 4 * g);
#pragma unroll
                for (int r = 0; r < 4; ++r) { const int s = 16 * st + 4 * g + r; const bool ok = dir ? (s >= tS) : (s <= tS); const float ev = __expf(fminf(gs[r] - MtS, 0.f)); pv[r] = ok ? aS[r] * ev : 0.f; }
                pw[2 * st] = cvt_pk_bf16(pv[0], pv[1]); pw[2 * st + 1] = cvt_pk_bf16(pv[2], pv[3]); asm volatile("" ::: "memory"); }
            bf16x8 Pf[4];
#pragma unroll
            for (int ks = 0; ks < 4; ++ks) { const v4u t4 = {pw[4 * ks], pw[4 * ks + 1], pw[4 * ks + 2], pw[4 * ks + 3]}; Pf[ks] = __builtin_bit_cast(bf16x8, t4); }
            const float wiT = __expf(mc - MtS), flT = __expf(-(sp[tS] + MtS));
            const short one = l15 == 0 ? (short)0x3F80 : (short)0; const bf16x8 Bo = {one, one, one, one, one, one, one, one};
            float inv;
            { f32x4 ad = {0.f, 0.f, 0.f, 0.f};
#pragma unroll
              for (int ks = 0; ks < 4; ++ks) { bf16x8 Cf = *(const bf16x8*)(cs + (size_t)256 * 128 + 32 * ks + 8 * g); if (l15 != 0) Cf = (bf16x8){0, 0, 0, 0, 0, 0, 0, 0}; ad = MFMA16(Cf, Qf[ks], ad); }
              ad[0] *= wiT;
#pragma unroll
              for (int ks = 0; ks < 4; ++ks) ad = MFMA16(Bo, Pf[ks], ad);
              const float den = __shfl(ad[0], lane & 15); inv = 1.0f / fmaxf(fabsf(den), flT); }
            { v4u cr[2];
#pragma unroll
              for (int i = 0; i < 2; ++i) { const int id = tid + NTHR * i; cr[i] = *(const v4u*)(cs + (size_t)(id >> 4) * 128 + 8 * (id & 15)); }
#pragma unroll
              for (int i = 0; i < 2; ++i) { const int id = tid + NTHR * i; *(LAS v4u*)(lds + L_CB + img_off(id >> 4, id & 15)) = cr[i]; }
#pragma unroll
              for (int gq = 0; gq < 4; ++gq) {
                LAS unsigned char* cb = lds + L_CB + (gq & 1) * 16384;
                __syncthreads();
                if (gq < 3) {
#pragma unroll
                    for (int i = 0; i < 2; ++i) { const int id = tid + NTHR * i; cr[i] = *(const v4u*)(cs + (size_t)(64 * (gq + 1) + (id >> 4)) * 128 + 8 * (id & 15)); } }
                f32x4 acc[4];
#pragma unroll
                for (int i = 0; i < 4; ++i) { acc[i] = (f32x4){0.f, 0.f, 0.f, 0.f};
#pragma unroll
                    for (int ks = 0; ks < 4; ++ks) { const bf16x8 Cf = *(const LAS bf16x8*)(cb + img_off(16 * i + l15, 4 * ks + g)); acc[i] = MFMA16(Cf, Qf[ks], acc[i]); } }
#pragma unroll
                for (int i = 0; i < 4; ++i) acc[i] = acc[i] * wiT;
                { LAS unsigned char* img = lds + ((gq >> 1) ? L_V1 : L_V0);
#pragma unroll
                  for (int i = 0; i < 4; ++i) {
#pragma unroll
                    for (int ks = 0; ks < 4; ++ks) { const bf16x8 Vf = tr_frag2(img + 8192 * ks, xp[4 * (gq & 1) + i], xp[4 * (gq & 1) + i] + 4096u); acc[i] = MFMA16(Vf, Pf[ks], acc[i]); } } }
#pragma unroll
                for (int i = 0; i < 4; ++i) hsum[4 * gq + i] += acc[i] * inv;
                if (gq < 3) {
#pragma unroll
                    for (int i = 0; i < 2; ++i) { const int id = tid + NTHR * i; *(LAS v4u*)(lds + L_CB + ((gq + 1) & 1) * 16384 + img_off(id >> 4, id & 15)) = cr[i]; } }
              } }
        }
        { float ss = 0.f;
#pragma unroll
          for (int et = 0; et < 16; ++et) ss += (hsum[et][0] * hsum[et][0] + hsum[et][1] * hsum[et][1]) + (hsum[et][2] * hsum[et][2] + hsum[et][3] * hsum[et][3]);
          ss += __shfl_xor(ss, 16); ss += __shfl_xor(ss, 32);
          const float rstd = 1.0f / sqrtf(ss * (1.0f / VD) + EPS); const size_t row = row0 + 16 * wave + l15;
#pragma unroll
          for (int et = 0; et < 16; ++et) { const int col = h * VD + 16 * et + 4 * g;
              const v2u ow = *(const v2u*)(Z + row * ZW + ZO + col); const f32x4 gn = *(const f32x4*)(mnorm_g + col);
              const float v0 = hsum[et][0] * rstd * gn[0] * sigmoidf_(bf_lo(ow.x)), v1 = hsum[et][1] * rstd * gn[1] * sigmoidf_(bf_hi(ow.x));
              const float v2 = hsum[et][2] * rstd * gn[2] * sigmoidf_(bf_lo(ow.y)), v3 = hsum[et][3] * rstd * gn[3] * sigmoidf_(bf_hi(ow.y));
              v2u o; o.x = cvt_pk_bf16(v0, v1); o.y = cvt_pk_bf16(v2, v3); *(v2u*)(RO + row * DM + col) = o; } }
        __syncthreads();
    }
}

__device__ __forceinline__ void p9_phase(LAS unsigned char* lds, int wave, int lane, int G, const float* X1, const float* MOD, const float* norm_g, const bf16* SK, const float* router_b,
                                         unsigned* cnt, bf16* XG, int* RE, int* RR, float* RG) {
    LAS float* hrow = (LAS float*)(lds + wave * 8192); LAS float* part = (LAS float*)(lds + 65536);
    f32x4 vn[8];
    { const float* xr = X1 + (size_t)(blockIdx.x * 8 + wave) * DM;
#pragma unroll
      for (int j = 0; j < 8; ++j) vn[j] = *(const f32x4*)(xr + 4 * (lane + 64 * j)); }
    for (int it = blockIdx.x; it < NLAT / 8; it += G) {
        const int row = it * 8 + wave;
        const float* shift = MOD + (size_t)(row >> 11) * 12288 + 3 * 2048; const float* scale = shift + 2048;
        f32x4 v[8]; float ss = 0.f;
#pragma unroll
        for (int j = 0; j < 8; ++j) { v[j] = vn[j]; ss += (v[j][0] * v[j][0] + v[j][1] * v[j][1]) + (v[j][2] * v[j][2] + v[j][3] * v[j][3]); }
        const float rstd = 1.0f / sqrtf(wave_sum(ss) * (1.0f / DM) + EPS);
#pragma unroll
        for (int j = 0; j < 8; ++j) { const int col = 4 * (lane + 64 * j);
            const f32x4 g = *(const f32x4*)(norm_g + col), sc = *(const f32x4*)(scale + col), sh = *(const f32x4*)(shift + col);
            v[j] = (v[j] * rstd) * g * (sc + 1.0f) + sh; *(LAS f32x4*)(hrow + col) = v[j]; }
        if (it + G < NLAT / 8) { const float* xr = X1 + (size_t)((it + G) * 8 + wave) * DM;
#pragma unroll
            for (int j = 0; j < 8; ++j) vn[j] = *(const f32x4*)(xr + 4 * (lane + 64 * j)); }
        __syncthreads();
        skinny_mfma((const LAS float*)lds, SK + 2 * 65536, SK + 3 * 65536, part, wave, lane);
        __syncthreads();
        float val = router_b[lane & 31];
#pragma unroll
        for (int w = 0; w < 8; ++w) val += part[w * 256 + wave * 32 + (lane & 31)];
        float sv[4]; int si[4];
#pragma unroll
        for (int k = 0; k < 4; ++k) { float bv = val; int bi = lane & 31;
#pragma unroll
            for (int o = 16; o >= 1; o >>= 1) { const float ov = __shfl_xor(bv, o); const int oi = __shfl_xor(bi, o); const bool take = (ov > bv) || (ov == bv && oi < bi); bv = take ? ov : bv; bi = take ? oi : bi; }
            sv[k] = bv; si[k] = __builtin_amdgcn_readfirstlane(bi); if ((lane & 31) == bi) val = -3.0e38f; }
        const float e1 = __expf(sv[1] - sv[0]), e2 = __expf(sv[2] - sv[0]), e3 = __expf(sv[3] - sv[0]), inv = 1.0f / (1.0f + e1 + e2 + e3);
        const float gk[4] = {inv, e1 * inv, e2 * inv, e3 * inv};
        unsigned rank = 0;
        if (lane < 4) rank = __hip_atomic_fetch_add(cnt + (lane == 0 ? si[0] : lane == 1 ? si[1] : lane == 2 ? si[2] : si[3]), 1u, RLX_AGENT);
#pragma unroll
        for (int k = 0; k < 4; ++k) { const unsigned rk = (unsigned)__builtin_amdgcn_readlane((int)rank, k);
            bf16* dst = XG + ((size_t)si[k] * 8192 + rk) * DM;
#pragma unroll
            for (int j = 0; j < 8; ++j) { v2u o; o.x = cvt_pk_bf16(v[j][0], v[j][1]); o.y = cvt_pk_bf16(v[j][2], v[j][3]); *(v2u*)(dst + 4 * (lane + 64 * j)) = o; }
            if (lane == 0) { RE[row * 4 + k] = si[k]; RR[row * 4 + k] = (int)rk; RG[row * 4 + k] = gk[k]; } }
    }
}
__device__ __forceinline__ void moe_prefix(LAS int* pref, const unsigned* cnt, int tid) {
    if (tid == 0) { int s = 0; for (int e = 0; e < 32; ++e) { const unsigned ce = __hip_atomic_load(cnt + e, RLX_AGENT); pref[e] = s; pref[33 + e] = (int)ce; s += (int)((ce + 255u) >> 8); } pref[32] = s; }
    __syncthreads();
}
__device__ __forceinline__ void p12_phase(const LAS int* pref, int wave, int lane_, int G, const float* X1, const float* MOD, const bf16* Y2, const int* RE, const int* RR, const float* RG, const float* final_g, float* out) {
    const int gw = blockIdx.x * NWAVES + wave, NGW = G * NWAVES;
    int en[4], rn[4]; float gn[4];
    if (gw < NLAT) {
#pragma unroll
        for (int k = 0; k < 4; ++k) { en[k] = RE[gw * 4 + k]; rn[k] = RR[gw * 4 + k]; gn[k] = RG[gw * 4 + k]; } }
    for (int row = gw; row < NLAT; row += NGW) {
        int lane = lane_; asm volatile("" : "+v"(lane));
        const float* xr = X1 + (size_t)row * DM + 4 * lane; f32x4 xv[8]; v2u yv[4][8]; float gt[4];
#pragma unroll
        for (int k = 0; k < 4; ++k) { gt[k] = gn[k]; const bf16* src = Y2 + ((size_t)pref[en[k]] * 256 + rn[k]) * DM + 4 * lane;
#pragma unroll
            for (int j = 0; j < 8; ++j) yv[k][j] = __builtin_nontemporal_load((const v2u*)(src + 256 * j)); }
#pragma unroll
        for (int j = 0; j < 8; ++j) xv[j] = __builtin_nontemporal_load((const f32x4*)(xr + 256 * j));
        if (row + NGW < NLAT) { const int r2 = row + NGW;
#pragma unroll
            for (int k = 0; k < 4; ++k) { en[k] = RE[r2 * 4 + k]; rn[k] = RR[r2 * 4 + k]; gn[k] = RG[r2 * 4 + k]; } }
        const float* g5 = MOD + (size_t)(row >> 11) * 12288 + 5 * 2048; float ss = 0.f;
#pragma unroll
        for (int j = 0; j < 8; ++j) { f32x4 ys = {0.f, 0.f, 0.f, 0.f};
#pragma unroll
            for (int k = 0; k < 4; ++k) { const v2u y = yv[k][j]; ys[0] += gt[k] * bf_lo(y.x); ys[1] += gt[k] * bf_hi(y.x); ys[2] += gt[k] * bf_lo(y.y); ys[3] += gt[k] * bf_hi(y.y); }
            const int col = 4 * (lane + 64 * j); const f32x4 x2 = xv[j] + *(const f32x4*)(g5 + col) * ys; xv[j] = x2;
            ss += (x2[0] * x2[0] + x2[1] * x2[1]) + (x2[2] * x2[2] + x2[3] * x2[3]); }
        const float rstd = 1.0f / sqrtf(wave_sum(ss) * (1.0f / DM) + EPS);
#pragma unroll
        for (int j = 0; j < 8; ++j) { const int col = 4 * (lane + 64 * j); __builtin_nontemporal_store(xv[j] * rstd * *(const f32x4*)(final_g + col), (f32x4*)(out + (size_t)row * DM + col)); }
    }
}

#define XB_TMO      128
#define XB_XCNT(j)  (256  + 64 * (j))
#define XB_XSUB(j)  (1280 + 64 * (j))
#define XB_XGEN(j)  (2304 + 64 * (j))
#define XB_TOP      3328
#define XB_TOPGEN   3392
#define XCD_BAR_WORDS 3456
#define XB_SPIN_CAP (1u << 18)

__device__ __forceinline__ unsigned xb_ld(unsigned* p)              { return __hip_atomic_load(p, __ATOMIC_RELAXED, __HIP_MEMORY_SCOPE_AGENT); }
__device__ __forceinline__ unsigned xb_add(unsigned* p, unsigned v) { return __hip_atomic_fetch_add(p, v, __ATOMIC_RELAXED, __HIP_MEMORY_SCOPE_AGENT); }
__device__ __forceinline__ unsigned xb_xcc_id() { return (unsigned)__builtin_amdgcn_s_getreg((3 << 11) | 20) & 0xFu; }
#define XB_SPIN(cond, bar) do { unsigned _sp = 0; while (cond) { __builtin_amdgcn_s_sleep(1); \
    if ((++_sp & 255u) == 0u) { if (xb_ld(&(bar)[XB_TMO])) break; if (_sp > XB_SPIN_CAP) { atomicAdd(&(bar)[XB_TMO], 1u); break; } } } } while (0)

struct XcdBarrier {
    unsigned* bar; unsigned x;
    volatile LAS unsigned* st;
};

__device__ __forceinline__ XcdBarrier xcd_barrier_post(unsigned* bar, volatile LAS unsigned* st) {
    XcdBarrier b; b.bar = bar; b.x = xb_xcc_id(); b.st = st;
    if (threadIdx.x == 0) (void)xb_add(&bar[XB_XCNT(b.x)], 1u);
    return b;
}
__device__ __forceinline__ void xcd_barrier_complete(unsigned* bar, unsigned x, unsigned& nloc, unsigned& nx) {
    const unsigned G = gridDim.x * gridDim.y * gridDim.z;
    unsigned sum, cnt, mine, sp = 0u;
    for (;;) {
        sum = 0u; cnt = 0u; mine = 0u;
#pragma unroll
        for (unsigned j = 0; j < 16; ++j) { const unsigned c = xb_ld(&bar[XB_XCNT(j)]); sum += c; cnt += (c > 0u) ? 1u : 0u; mine = (j == x) ? c : mine; }
        if (sum == G) break;
        __builtin_amdgcn_s_sleep(1);
        if ((++sp & 255u) == 0u) { if (xb_ld(&bar[XB_TMO])) break; if (sp > XB_SPIN_CAP) { atomicAdd(&bar[XB_TMO], 1u); break; } }
    }
    nloc = mine > 0u ? mine : 1u; nx = cnt > 0u ? cnt : 1u;
}

__device__ __forceinline__ void xcd_barrier(const XcdBarrier& b) {
    asm volatile("s_waitcnt vmcnt(0)" ::: "memory");
    __syncthreads();
    if (threadIdx.x == 0) {
        unsigned* bar = b.bar;
        __builtin_amdgcn_s_waitcnt(0);
        unsigned nloc = b.st[0], nx = b.st[1];
        if (nloc == 0u) { xcd_barrier_complete(bar, b.x, nloc, nx); b.st[0] = nloc; b.st[1] = nx; }
        const unsigned old = xb_add(&bar[XB_XSUB(b.x)], 1u);
        const unsigned gen = old / nloc;
        if (old + 1u == (gen + 1u) * nloc) {
            __builtin_amdgcn_fence(__ATOMIC_RELEASE, "agent");
            asm volatile("s_waitcnt vmcnt(0)" ::: "memory");
            const unsigned og = xb_add(&bar[XB_TOP], 1u);
            const unsigned tg = og / nx;
            if (og + 1u == (tg + 1u) * nx) xb_add(&bar[XB_TOPGEN], 1u);
            else XB_SPIN(xb_ld(&bar[XB_TOPGEN]) == tg, bar);
            __builtin_amdgcn_fence(__ATOMIC_ACQUIRE, "agent");
            xb_add(&bar[XB_XGEN(b.x)], 1u);
            asm volatile("s_waitcnt vmcnt(0)" ::: "memory");
        } else {
            XB_SPIN(xb_ld(&bar[XB_XGEN(b.x)]) == gen, bar);
            __builtin_amdgcn_fence(__ATOMIC_ACQUIRE, "agent");
            asm volatile("s_waitcnt vmcnt(0)" ::: "memory");
        }
    }
    __syncthreads();
}

struct Args { const float* in[26]; float* out; unsigned char* ws; int ph_lo, ph_hi; };
__global__ void __launch_bounds__(NTHR, 2) mk_fwd(Args args) {
    extern __shared__ __attribute__((aligned(16))) unsigned char lds_raw[];
    LAS unsigned char* lds = (LAS unsigned char*)lds_raw;
    const int tid = threadIdx.x, lane = tid & 63, wave = __builtin_amdgcn_readfirstlane(tid >> 6), G = gridDim.x;
    unsigned char* ws = args.ws;
    gu32* ctl = (gu32*)(ws + WS_CTL);
    for (int u = tid; u < (LDS_BYTES - LDSCTL_OFF) / 4; u += NTHR) ((LAS unsigned*)(lds + LDSCTL_OFF))[u] = 0u;
    __syncthreads();
    volatile LAS unsigned* MISC = (volatile LAS unsigned*)(lds + MISC_OFF);
    XcdBarrier bar; bar.bar = (unsigned*)(ctl + CW_BAR); bar.x = 0; bar.st = nullptr;
    if (N_LAUNCHES == 1) bar = xcd_barrier_post((unsigned*)(ctl + CW_BAR), MISC + 8);
#define GRID_BAR() do { if (N_LAUNCHES == 1) xcd_barrier(bar); } while (0)
    const int lo = args.ph_lo, hi = args.ph_hi;
#ifdef ONLY_PHASE
#define IN(k) ((k) == ONLY_PHASE && lo <= (k) && (k) < hi)
#else
#define IN(k) (lo <= (k) && (k) < hi)
#endif
#define BOTH(k) (IN(k) && IN((k) + 1))
#ifndef REP_MASK
#define REP_MASK 0
#endif
#define NREP(k) ((((REP_MASK) >> (k)) & 1) ? 2 : 1)
#define INP(i) (args.in[i])
#define WSF(off) ((float*)(ws + (off)))
#define WSB(off) ((bf16*)(ws + (off)))
#define WSI(off) ((int*)(ws + (off)))
    unsigned* cnt = (unsigned*)(ctl + CW_CNT);
    LAS int* pref = (LAS int*)(lds + PREF_OFF);
    const int n_conv_p0 = (G == 256) ? I_WIN + 3 * I_P : (I_TOTAL - I_GEMV);
#define x_in INP(0)
#define cvec INP(1)
#define ctx INP(2)
#define c_ctx INP(3)
#define mod_w INP(4)
#define mod_b INP(5)
#define norm1_g INP(6)
#define norm2_g INP(7)
#define w_in INP(8)
#define gate_b INP(9)
#define conv_w INP(10)
#define conv_b INP(11)
#define mnorm_g INP(12)
#define sgu_norm_g INP(13)
#define sgu_w INP(14)
#define sgu_b INP(15)
#define proj_a INP(16)
#define proj_b INP(17)
#define w_out INP(18)
#define router_w INP(19)
#define router_b INP(20)
#define exp_w1 INP(21)
#define exp_b1 INP(22)
#define exp_w2 INP(23)
#define exp_b2 INP(24)
#define final_g INP(25)
#define MOD WSF(WS_MOD)
#define GATES WSF(WS_GATES)
#define BEND WSF(WS_SCAL)
#define GMAX (WSF(WS_SCAL) + 64 * 17)
#define MST (WSF(WS_SCAL) + 2 * 64 * 17)
#define RE WSI(WS_ROUTE)
#define RR (WSI(WS_ROUTE) + NLAT * 4)
#define RG (WSF(WS_ROUTE) + 2 * NLAT * 4)
#define WINT WSB(WS_WINT)
#define SKW WSB(WS_SK)
#define SCN WSF(WS_SCN)
#define PAT WSB(WS_PAT)
#define PBT WSB(WS_PBT)
#define WOT WSB(WS_WOT)
#define W1T WSB(WS_W1T)
#define W2T WSB(WS_W2T)
#define HB WSB(WS_HB)
#define Z WSB(WS_Z)
#define QC WSB(WS_QC)
#define KC WSB(WS_KC)
#define SVN WSB(WS_SVN)
#define DC WSB(WS_DC)
#define CS WSB(WS_CS)
#define RO WSB(WS_RO)
#define CM WSB(WS_CM)
#define YB WSF(WS_YB)
#define MRG WSB(WS_MRG)
#define X1 WSF(WS_X1)
#define ACT WSB(WS_ACT)
#define Y2 WSB(WS_Y2)
#define XG WSB(WS_XG)

    if (IN(0)) for (int rep_ = 0; rep_ < NREP(0); ++rep_) { p0_phase(lds, tid, G, cvec, c_ctx, mod_w, mod_b, MOD, w_in, proj_a, proj_b, w_out, exp_w1, exp_w2, router_w, WINT, PAT, PBT, WOT, W1T, W2T, SKW, n_conv_p0); if (BOTH(0) || rep_ + 1 < NREP(0)) GRID_BAR(); }
    if (IN(1)) for (int rep_ = 0; rep_ < NREP(1); ++rep_) { p1_phase(lds, tid, wave, lane, G, x_in, ctx, MOD, norm1_g, SKW, gate_b, HB, GATES); if (BOTH(1) || rep_ + 1 < NREP(1)) GRID_BAR(); }
    if (IN(2)) for (int rep_ = 0; rep_ < NREP(2); ++rep_) {
        if (G == 256 && (int)blockIdx.x >= 256 - N_CONVERTERS)
            cvt_run(lds, tid, I_GEMV + n_conv_p0 + ((int)blockIdx.x - (256 - N_CONVERTERS)), N_CONVERTERS, I_TOTAL, w_in, proj_a, proj_b, w_out, exp_w1, exp_w2, WINT, PAT, PBT, WOT, W1T, W2T);
        { pg8::Gemm g{HB, WINT, NTOK, ZW, DM}; pg8::DynOrder S{(unsigned*)(ctl + CW_Q), (LAS int*)(lds + PREF_OFF + 800), (int)(blockIdx.x & 7)}; pg8::EpiBf16 E{Z, ZW, nullptr, ZW / 256};
          pg8::gemm_phase<pg8::EpiBf16, pg8::DynOrder, true, true>(lds, g, S, E); }
        if (BOTH(2) || rep_ + 1 < NREP(2)) GRID_BAR();
    }
    if (IN(3)) for (int rep_ = 0; rep_ < NREP(3); ++rep_) { p3_phase(wave, lane, G, Z, conv_w, conv_b, sgu_norm_g, QC, KC, SVN, GATES, SCN, BEND, GMAX); if (BOTH(3) || rep_ + 1 < NREP(3)) GRID_BAR(); }
    if (IN(4)) for (int rep_ = 0; rep_ < NREP(4); ++rep_) { p4_phase(lds, tid, wave, lane, G, Z, KC, SVN, SCN, sgu_w, sgu_b, DC, GMAX, CM); if (BOTH(4) || rep_ + 1 < NREP(4)) GRID_BAR(); }
    if (IN(5)) for (int rep_ = 0; rep_ < NREP(5); ++rep_) {
        { pg8::Gemm g{CM, PBT, NLAT, DM, DM}; pg8::StaticOrder S; S.init(NLAT, DM, G, (int)blockIdx.x); pg8::EpiF32 E{YB, DM};
          pg8::gemm_phase<pg8::EpiF32, pg8::StaticOrder, true, true>(lds, g, S, E); }
        p5_scan(tid, G, DC, BEND, GMAX, CS, MST);
        if (BOTH(5) || rep_ + 1 < NREP(5)) GRID_BAR();
    }
    if (IN(6)) for (int rep_ = 0; rep_ < NREP(6); ++rep_) { p6_phase(lds, tid, wave, lane, G, Z, QC, KC, SCN, CS, MST, mnorm_g, RO); if (BOTH(6) || rep_ + 1 < NREP(6)) GRID_BAR(); }
    if (IN(7)) for (int rep_ = 0; rep_ < NREP(7); ++rep_) {
        pg8::Gemm g{RO, PAT, NLAT, DM, DM}; pg8::StaticOrder S; S.init(NLAT, DM, G, (int)blockIdx.x); pg8::EpiMerge E{MRG, Z, ZW, ZGA, ZGB, YB};
        pg8::gemm_phase<pg8::EpiMerge, pg8::StaticOrder, true, true>(lds, g, S, E);
        if (BOTH(7) || rep_ + 1 < NREP(7)) GRID_BAR();
    }
    if (IN(8)) for (int rep_ = 0; rep_ < NREP(8); ++rep_) {
        pg8::Gemm g{MRG, WOT, NLAT, DM, DM}; pg8::StaticOrder S; S.init(NLAT, DM, G, (int)blockIdx.x); pg8::EpiX1 E{X1, x_in, MOD};
        pg8::gemm_phase<pg8::EpiX1, pg8::StaticOrder, true, true>(lds, g, S, E);
        if (BOTH(8) || rep_ + 1 < NREP(8)) GRID_BAR();
    }
    if (IN(9)) for (int rep_ = 0; rep_ < NREP(9); ++rep_) { p9_phase(lds, wave, lane, G, X1, MOD, norm2_g, SKW, router_b, cnt, XG, RE, RR, RG); if (BOTH(9) || rep_ + 1 < NREP(9)) GRID_BAR(); }
    if (IN(10)) for (int rep_ = 0; rep_ < NREP(10); ++rep_) {
        moe_prefix(pref, cnt, tid);
        pg8::Gemm g{XG, W1T, 0, 0, DM}; pg8::MoeOrder S{pref, 16, G, (int)blockIdx.x, 1}; pg8::EpiSwiglu E{ACT, exp_b1};
        pg8::gemm_phase<pg8::EpiSwiglu, pg8::MoeOrder, true, true, true>(lds, g, S, E);
        if (BOTH(10) || rep_ + 1 < NREP(10)) GRID_BAR();
    }
    if (IN(11)) for (int rep_ = 0; rep_ < NREP(11); ++rep_) {
        moe_prefix(pref, cnt, tid);
        pg8::Gemm g{ACT, W2T, 0, 0, DEXP}; pg8::MoeOrder S{pref, 8, G, (int)blockIdx.x, 0}; pg8::EpiBf16 E{Y2, DM, exp_b2, 8};
        pg8::gemm_phase<pg8::EpiBf16, pg8::MoeOrder, true, true, true>(lds, g, S, E);
        if (BOTH(11) || rep_ + 1 < NREP(11)) GRID_BAR();
    }
    if (IN(12)) for (int rep_ = 0; rep_ < NREP(12); ++rep_) { moe_prefix(pref, cnt, tid); p12_phase(pref, wave, lane, G, X1, MOD, Y2, RE, RR, RG, final_g, args.out); if (rep_ + 1 < NREP(12)) GRID_BAR(); }
#undef IN
#undef BOTH
}

extern "C" void kernel_launch(void* const* d_in, const int* in_sizes, int n_in, void* d_out, int out_size, void* d_ws, size_t ws_size, hipStream_t stream) {
    static int grid = 0;
    if (grid == 0) {
        if (n_in != 26 || out_size != NLAT * DM || ws_size < WS_END) { fprintf(stderr, "kernel_launch: unexpected shapes (n_in %d, out %d, ws %zu)\n", n_in, out_size, ws_size); grid = -1; return; }
        int dev = 0, cus = 0;
        if (hipGetDevice(&dev) != hipSuccess || hipDeviceGetAttribute(&cus, hipDeviceAttributeMultiprocessorCount, dev) != hipSuccess) { grid = -1; return; }
        if (hipFuncSetAttribute((const void*)mk_fwd, hipFuncAttributeMaxDynamicSharedMemorySize, LDS_BYTES) != hipSuccess) { fprintf(stderr, "kernel_launch: hipFuncSetAttribute failed\n"); grid = -1; return; }
        int per_cu = 0;
        if (hipOccupancyMaxActiveBlocksPerMultiprocessor(&per_cu, (const void*)mk_fwd, NTHR, LDS_BYTES) != hipSuccess || per_cu < 1) fprintf(stderr, "kernel_launch: occupancy query reports %d\n", per_cu);
        (void)hipGetLastError();
        grid = cus;
    }
    if (grid < 0) return;
    if (hipMemsetAsync((char*)d_ws + WS_CTL, 0, CTL_ZERO_BYTES, stream) != hipSuccess) return;
    Args a{};
    for (int i = 0; i < 26; ++i) a.in[i] = (const float*)d_in[i];
    a.out = (float*)d_out; a.ws = (unsigned char*)d_ws;
    for (int li = 0; li < N_LAUNCHES; ++li) {
        a.ph_lo = (N_LAUNCHES == 1) ? 0 : li; a.ph_hi = (N_LAUNCHES == 1) ? N_PHASES : li + 1;
        hipLaunchKernelGGL(mk_fwd, dim3(grid), dim3(NTHR), LDS_BYTES, stream, a);
        const hipError_t le = hipPeekAtLastError();
        if (le != hipSuccess) { fprintf(stderr, "kernel_launch: launch %d failed: %s\n", li, hipGetErrorName(le)); break; }
    }
}
```

```cpp
#include <hip/hip_runtime.h>
#include <cstdio>
#include <cstdint>
#ifndef MK_N_LAUNCHES
#define MK_N_LAUNCHES 1
#endif
namespace pg8 {
#define PG8_LAS __attribute__((address_space(3)))
typedef unsigned short bf16_t;
typedef short bf16x8 __attribute__((ext_vector_type(8)));
typedef float f32x4 __attribute__((ext_vector_type(4)));
typedef unsigned u32x4 __attribute__((ext_vector_type(4)));
typedef int i32x4 __attribute__((ext_vector_type(4)));
typedef int i32x8 __attribute__((ext_vector_type(8)));
constexpr int BM = 256, BK = 64, HALF = 128, HTB = HALF * BK * 2  , STAGE_BYTES = 8 * HTB, NXCD = 8, WGM = 8;

__host__ __device__ __forceinline__ int lds_byte(int r, int c) { const int st = (r >> 4) * 2 + (c >> 5), rr = r & 15, cc = c & 31, ob = rr * 64 + cc * 2; return st * 1024 + (ob ^ (((ob >> 9) & 1) << 5)); }
__host__ __device__ __forceinline__ void stage_rc(int b, int& R, int& C) { const int st = b / 1024, sb = b % 1024, swz = sb ^ (((sb >> 9) & 1) << 5); R = (st >> 1) * 16 + swz / 64; C = (st & 1) * 32 + (swz % 64) / 2; }
__host__ __device__ __forceinline__ int perm32(int rho) { const int n = rho >> 4, i = rho & 15; return 8 * (i >> 2) + 4 * n + (i & 3); }

struct Unit { int pm, pn, po, hf; };
struct Gemm { const bf16_t* A; const bf16_t* Bt; int M, N, K; };

struct StaticOrder {
    int nM, nN, nwg, G, c;
    __host__ __device__ void init(int M, int N, int G_, int c_) { nM = M / BM; nN = N / BM; nwg = nM * nN; G = G_; c = c_; }
    __host__ __device__ bool next(int i, Unit& u) const {
        const long L = (long)i * G + c; if (L >= nwg) return false;
        int wgid = (int)L; { const int q = nwg / NXCD, r = nwg % NXCD, xcd = wgid % NXCD, off = wgid / NXCD; wgid = (xcd < r ? xcd * (q + 1) : r * (q + 1) + (xcd - r) * q) + off; }
        const int nig = WGM * nN, gid = wgid / nig, fm = gid * WGM, gsz = (nM - fm) < WGM ? (nM - fm) : WGM;
        u.pm = fm + ((wgid % nig) % gsz); u.pn = (wgid % nig) / gsz; u.po = u.pm; u.hf = 0; return true;
    }
    __device__ __forceinline__ void a_ready(const Unit&) const {}
    __device__ __forceinline__ void done(const Unit&) const {}
};
struct DynOrder {
    unsigned* q; PG8_LAS int* slot; int xcd;
    __device__ __forceinline__ bool next(int i, Unit& u) const {
        if (threadIdx.x == 0) { int id = -1;
            unsigned v = __hip_atomic_fetch_add(q + 64 * xcd, 1u, __ATOMIC_RELAXED, __HIP_MEMORY_SCOPE_AGENT);
            if (v < 232u) id = xcd * 232 + (int)v;
            else { unsigned c[8];
#pragma unroll
                for (int k = 0; k < 8; ++k) c[k] = __hip_atomic_load(q + 64 * k, __ATOMIC_RELAXED, __HIP_MEMORY_SCOPE_AGENT);
#pragma unroll
                for (int k = 1; k < 8; ++k) { const int x = (xcd + k) & 7; if (id < 0 && c[x] < 232u) { v = __hip_atomic_fetch_add(q + 64 * x, 1u, __ATOMIC_RELAXED, __HIP_MEMORY_SCOPE_AGENT); if (v < 232u) id = x * 232 + (int)v; } } }
            slot[i & 1] = id; asm volatile("s_waitcnt lgkmcnt(0)" ::: "memory"); }
        asm volatile("" ::: "memory"); __builtin_amdgcn_s_barrier(); asm volatile("" ::: "memory");
        const int id = slot[i & 1]; if (id < 0) return false;
        const int x = id / 232, v = id - x * 232;
        if (v < 224) { const int wgid = x * 224 + v, nig = WGM * 56, gid = wgid / nig; u.pm = gid * WGM + ((wgid % nig) % WGM); u.pn = (wgid % nig) / WGM; }
        else { const int j = x * 8 + (v - 224); u.pm = 32 + (j & 3); u.pn = j >> 2; }
        u.po = u.pm; u.hf = 0; return true;
    }
    __device__ __forceinline__ void a_ready(const Unit&) const {}
    __device__ __forceinline__ void done(const Unit&) const {}
};
struct MoeOrder {
    const PG8_LAS int* pref; int nN, G, c, a_sparse;
    __device__ __forceinline__ bool next(int i, Unit& u) const {
        const int L = i * G + c, total = pref[32]; if (L >= total * nN) return false;
        const int mt = L / nN, nt = L - mt * nN; int e = 0;
        for (int k = 1; k < 32; ++k) e += (pref[k] <= mt) ? 1 : 0;
        u.pm = a_sparse ? e * 32 + (mt - pref[e]) : mt; u.pn = e * nN + nt; u.po = mt; u.hf = (pref[33 + e] - 256 * (mt - pref[e]) <= 128) ? 1 : 0; return true;
    }
    __device__ __forceinline__ void a_ready(const Unit&) const {}
    __device__ __forceinline__ void done(const Unit&) const {}
};

__device__ __forceinline__ unsigned cvt_pk_bf16(float lo, float hi) { unsigned r; asm volatile("v_cvt_pk_bf16_f32 %0, %1, %2" : "=v"(r) : "v"(lo), "v"(hi)); return r; }
__device__ __forceinline__ float bf_lo(unsigned w) { return __uint_as_float(w << 16); }
__device__ __forceinline__ float bf_hi(unsigned w) { return __uint_as_float(w & 0xffff0000u); }
__device__ __forceinline__ unsigned pk4_fp8(float a, float b, float c, float d) {
    a = fminf(fmaxf(a, -448.f), 448.f); b = fminf(fmaxf(b, -448.f), 448.f); c = fminf(fmaxf(c, -448.f), 448.f); d = fminf(fmaxf(d, -448.f), 448.f);
    int p = __builtin_amdgcn_cvt_pk_fp8_f32(a, b, 0, false); p = __builtin_amdgcn_cvt_pk_fp8_f32(c, d, p, true); return (unsigned)p; }
constexpr float F8_SA = 16.0f, F8_SW = 512.0f, F8_SC = 4.0f;
__device__ __forceinline__ float sigmoidf_(float x) { return __builtin_amdgcn_rcpf(1.0f + __expf(-x)); }

struct EpiBf16 {
    static constexpr bool PERM = true, AFTER_DRAIN = false;
    bf16_t* O; int ldc; const float* bias; int ncolt;
    __device__ __forceinline__ void operator()(const f32x4 (&acc)[2][2][4][2], const Unit& u, int wr, int wc, int fr, int fq) const {
        const int row0 = u.po * BM + wr * 64 + fr; const int colt = (u.pn % ncolt) * BM;
        const int col0 = colt + wc * 32 + 8 * fq, bcol0 = u.pn * BM + wc * 32 + 8 * fq;
        f32x4 bv[2][2];
#pragma unroll
        for (int bj = 0; bj < 2; ++bj)
#pragma unroll
            for (int n = 0; n < 2; ++n) bv[bj][n] = bias ? *(const f32x4*)(bias + bcol0 + bj * HALF + 4 * n) : (f32x4){0.f, 0.f, 0.f, 0.f};
#pragma unroll
        for (int ai = 0; ai < 2; ++ai)
#pragma unroll
            for (int m = 0; m < 4; ++m) { bf16_t* rowp = O + (size_t)(row0 + ai * HALF + m * 16) * ldc + col0;
#pragma unroll
                for (int bj = 0; bj < 2; ++bj) { const f32x4 v0 = acc[ai][bj][m][0] + bv[bj][0], v1 = acc[ai][bj][m][1] + bv[bj][1];
                    u32x4 w; w.x = cvt_pk_bf16(v0[0], v0[1]); w.y = cvt_pk_bf16(v0[2], v0[3]); w.z = cvt_pk_bf16(v1[0], v1[1]); w.w = cvt_pk_bf16(v1[2], v1[3]);
                    __builtin_nontemporal_store(w, (u32x4*)(rowp + bj * HALF)); } }
    }
};
struct EpiSwiglu8 {
    static constexpr bool PERM = true, AFTER_DRAIN = false;
    unsigned char* O; const float* b1;
    __device__ __forceinline__ void operator()(const f32x4 (&acc)[2][2][4][2], const Unit& u, int wr, int wc, int fr, int fq) const {
        const int e = u.pn >> 4, nt = u.pn & 15; const int row0 = u.po * BM + wr * 64 + fr, j0 = nt * 128 + wc * 32 + 8 * fq;
        const float* bg = b1 + (size_t)e * 4096 + j0; const float* bl = bg + 2048; constexpr float us = 1.0f / (F8_SA * F8_SW);
#pragma unroll
        for (int ai = 0; ai < 2; ++ai)
#pragma unroll
            for (int m = 0; m < 4; ++m) { const size_t row = (size_t)(row0 + ai * HALF + m * 16);
                asm volatile("" ::: "memory");
                unsigned w[2];
#pragma unroll
                for (int n = 0; n < 2; ++n) { const f32x4 gv = acc[ai][0][m][n] * us + *(const f32x4*)(bg + 4 * n), lv = acc[ai][1][m][n] * us + *(const f32x4*)(bl + 4 * n);
                    float o[4];
#pragma unroll
                    for (int i = 0; i < 4; ++i) { const float ga = fminf(gv[i], 7.0f), la = fminf(fmaxf(lv[i], -7.0f), 7.0f); o[i] = ga * sigmoidf_(1.702f * ga) * (la + 1.0f) * F8_SC; }
                    w[n] = pk4_fp8(o[0], o[1], o[2], o[3]); }
                typedef unsigned u32x2 __attribute__((ext_vector_type(2))); const u32x2 ww = {w[0], w[1]};
                *(u32x2*)(O + row * 2048 + j0) = ww; }
    }
};
struct EpiY2f8 {
    static constexpr bool PERM = true, AFTER_DRAIN = false;
    bf16_t* O; const float* bias;
    __device__ __forceinline__ void operator()(const f32x4 (&acc)[2][2][4][2], const Unit& u, int wr, int wc, int fr, int fq) const {
        const int row0 = u.po * BM + wr * 64 + fr; const int col0 = (u.pn & 7) * BM + wc * 32 + 8 * fq, bcol0 = u.pn * BM + wc * 32 + 8 * fq; constexpr float us = 1.0f / (F8_SC * F8_SW);
        f32x4 bv[2][2];
#pragma unroll
        for (int bj = 0; bj < 2; ++bj)
#pragma unroll
            for (int n = 0; n < 2; ++n) bv[bj][n] = *(const f32x4*)(bias + bcol0 + bj * HALF + 4 * n);
#pragma unroll
        for (int ai = 0; ai < 2; ++ai)
#pragma unroll
            for (int m = 0; m < 4; ++m) { bf16_t* rowp = O + (size_t)(row0 + ai * HALF + m * 16) * 2048 + col0;
#pragma unroll
                for (int bj = 0; bj < 2; ++bj) { const f32x4 v0 = acc[ai][bj][m][0] * us + bv[bj][0], v1 = acc[ai][bj][m][1] * us + bv[bj][1];
                    u32x4 w; w.x = cvt_pk_bf16(v0[0], v0[1]); w.y = cvt_pk_bf16(v0[2], v0[3]); w.z = cvt_pk_bf16(v1[0], v1[1]); w.w = cvt_pk_bf16(v1[2], v1[3]);
                    __builtin_nontemporal_store(w, (u32x4*)(rowp + bj * HALF)); } }
    }
};
struct EpiF32 {
    static constexpr bool PERM = false, AFTER_DRAIN = false;
    float* C; int ldc;
    __device__ __forceinline__ void operator()(const f32x4 (&acc)[2][2][4][2], const Unit& u, int wr, int wc, int fr, int fq) const {
        const int row0 = u.po * BM + wr * 64 + fr, col0 = u.pn * BM + wc * 32 + 4 * fq;
#pragma unroll
        for (int ai = 0; ai < 2; ++ai)
#pragma unroll
            for (int m = 0; m < 4; ++m) { float* rowp = C + (size_t)(row0 + ai * HALF + m * 16) * ldc + col0;
#pragma unroll
                for (int bj = 0; bj < 2; ++bj)
#pragma unroll
                    for (int n = 0; n < 2; ++n) *(f32x4*)(rowp + bj * HALF + n * 16) = acc[ai][bj][m][n]; }
    }
};
struct EpiMerge {
    static constexpr bool PERM = true, AFTER_DRAIN = false;
    bf16_t* O; const bf16_t* Z; int ldz, ga_off, gb_off; const float* YB;
    __device__ __forceinline__ void operator()(const f32x4 (&acc)[2][2][4][2], const Unit& u, int wr, int wc, int fr, int fq) const {
        const int row0 = u.po * BM + wr * 64 + fr, col0 = u.pn * BM + wc * 32 + 8 * fq;
#pragma unroll
        for (int ai = 0; ai < 2; ++ai)
#pragma unroll
            for (int m = 0; m < 4; ++m) { const size_t row = (size_t)(row0 + ai * HALF + m * 16);
#pragma unroll
                for (int bj = 0; bj < 2; ++bj) { const int col = col0 + bj * HALF;
                    const u32x4 ga = *(const u32x4*)(Z + row * ldz + ga_off + col), gb = *(const u32x4*)(Z + row * ldz + gb_off + col);
                    const f32x4 y0 = *(const f32x4*)(YB + row * 2048 + col), y1 = *(const f32x4*)(YB + row * 2048 + col + 4);
                    const f32x4 a0 = acc[ai][bj][m][0], a1 = acc[ai][bj][m][1];
                    float o[8];
                    o[0] = sigmoidf_(bf_lo(ga.x)) * a0[0] + sigmoidf_(bf_lo(gb.x)) * y0[0]; o[1] = sigmoidf_(bf_hi(ga.x)) * a0[1] + sigmoidf_(bf_hi(gb.x)) * y0[1];
                    o[2] = sigmoidf_(bf_lo(ga.y)) * a0[2] + sigmoidf_(bf_lo(gb.y)) * y0[2]; o[3] = sigmoidf_(bf_hi(ga.y)) * a0[3] + sigmoidf_(bf_hi(gb.y)) * y0[3];
                    o[4] = sigmoidf_(bf_lo(ga.z)) * a1[0] + sigmoidf_(bf_lo(gb.z)) * y1[0]; o[5] = sigmoidf_(bf_hi(ga.z)) * a1[1] + sigmoidf_(bf_hi(gb.z)) * y1[1];
                    o[6] = sigmoidf_(bf_lo(ga.w)) * a1[2] + sigmoidf_(bf_lo(gb.w)) * y1[2]; o[7] = sigmoidf_(bf_hi(ga.w)) * a1[3] + sigmoidf_(bf_hi(gb.w)) * y1[3];
                    u32x4 w; w.x = cvt_pk_bf16(o[0], o[1]); w.y = cvt_pk_bf16(o[2], o[3]); w.z = cvt_pk_bf16(o[4], o[5]); w.w = cvt_pk_bf16(o[6], o[7]);
                    *(u32x4*)(O + row * 2048 + col) = w; } }
    }
};
struct EpiX1 {
    static constexpr bool PERM = false, AFTER_DRAIN = false;
    float* X1; const float* X; const float* mod;
    __device__ __forceinline__ void operator()(const f32x4 (&acc)[2][2][4][2], const Unit& u, int wr, int wc, int fr, int fq) const {
        const int row0 = u.po * BM + wr * 64 + fr, col0 = u.pn * BM + wc * 32 + 4 * fq;
        const float* mg = mod + (size_t)((u.po * BM) >> 11) * 12288 + 2 * 2048;
#pragma unroll
        for (int bj = 0; bj < 2; ++bj)
#pragma unroll
            for (int n = 0; n < 2; ++n) { const int col = col0 + bj * HALF + n * 16; const f32x4 g = *(const f32x4*)(mg + col);
#pragma unroll
                for (int ai = 0; ai < 2; ++ai)
#pragma unroll
                    for (int m = 0; m < 4; ++m) { const size_t off = (size_t)(row0 + ai * HALF + m * 16) * 2048 + col;
                        *(f32x4*)(X1 + off) = *(const f32x4*)(X + off) + g * acc[ai][bj][m][n]; } }
    }
};
struct EpiSwiglu {
    static constexpr bool PERM = true, AFTER_DRAIN = false;
    bf16_t* O; const float* b1;
    __device__ __forceinline__ void operator()(const f32x4 (&acc)[2][2][4][2], const Unit& u, int wr, int wc, int fr, int fq) const {
        const int e = u.pn >> 4, nt = u.pn & 15; const int row0 = u.po * BM + wr * 64 + fr, j0 = nt * 128 + wc * 32 + 8 * fq;
        const float* bg = b1 + (size_t)e * 4096 + j0; const float* bl = bg + 2048;
#pragma unroll
        for (int ai = 0; ai < 2; ++ai)
#pragma unroll
            for (int m = 0; m < 4; ++m) { const size_t row = (size_t)(row0 + ai * HALF + m * 16);
                asm volatile("" ::: "memory");
#pragma unroll
                for (int n = 0; n < 2; ++n) { const f32x4 gv = acc[ai][0][m][n] + *(const f32x4*)(bg + 4 * n), lv = acc[ai][1][m][n] + *(const f32x4*)(bl + 4 * n);
                    float o[4];
#pragma unroll
                    for (int i = 0; i < 4; ++i) { const float ga = fminf(gv[i], 7.0f), la = fminf(fmaxf(lv[i], -7.0f), 7.0f); o[i] = ga * sigmoidf_(1.702f * ga) * (la + 1.0f); }
                    typedef unsigned u32x2 __attribute__((ext_vector_type(2))); u32x2 w; w.x = cvt_pk_bf16(o[0], o[1]); w.y = cvt_pk_bf16(o[2], o[3]);
                    *(u32x2*)(O + row * 2048 + j0 + 4 * n) = w; } }
    }
};

template <class Epi, class Sched, bool ALIGN_EPI = false, bool SP2 = false, bool HALFSKIP = false>
__device__ __forceinline__ void gemm_phase(PG8_LAS unsigned char* lds, const Gemm g, const Sched& S, const Epi& E) {
    const int tid = threadIdx.x, wid = __builtin_amdgcn_readfirstlane(tid >> 6), lane = tid & 63, wr = wid >> 2, wc = wid & 3, fr = lane & 15, fq = lane >> 4;
    const int K = g.K, nt = K / BK;
    unsigned voffA[2], voffB[2];
#pragma unroll
    for (int i = 0; i < 2; ++i) { int R, C; stage_rc(tid * 16 + i * 8192, R, C); const int Rb = Epi::PERM ? ((R & ~31) + perm32(R & 31)) : R;
        voffA[i] = (unsigned)(R * K + C) * 2u; voffB[i] = (unsigned)(Rb * K + C) * 2u; }
    const size_t kstep = (size_t)(BK * 2);
    const size_t hstep = (size_t)HALF * K * 2;
    const size_t tstep = 2 * hstep;
    const unsigned ldsw = (unsigned)wid * 1024u;
    const int aoff = lds_byte(wr * 64 + fr, fq * 8), boff = lds_byte(wc * 32 + fr, fq * 8);
#define PG8_SA(b, h) (((b) * 2 + (h)) * HTB)
#define PG8_SB(b, h) ((4 + (b) * 2 + (h)) * HTB)
#define PG8_STAGE(bufoff, gbase, voff) do { _Pragma("unroll") for (int _i = 0; _i < 2; ++_i) \
        __builtin_amdgcn_global_load_lds((const unsigned*)((const char*)(gbase) + (voff)[_i]), (PG8_LAS unsigned*)(lds + (bufoff) + ldsw + _i * 8192), 16, 0, 0); } while (0)
#define PG8_LDA(dst, b, h) do { _Pragma("unroll") for (int m = 0; m < 4; ++m) _Pragma("unroll") for (int k = 0; k < 2; ++k) dst[m][k] = *(const PG8_LAS bf16x8*)(lds + PG8_SA(b, h) + aoff + m * 2048 + k * 1024); } while (0)
#define PG8_LDB(dst, b, h) do { _Pragma("unroll") for (int n = 0; n < 2; ++n) _Pragma("unroll") for (int k = 0; k < 2; ++k) dst[n][k] = *(const PG8_LAS bf16x8*)(lds + PG8_SB(b, h) + boff + n * 2048 + k * 1024); } while (0)
#define PG8_MMA(ai, bj, At, Bt) do { __builtin_amdgcn_s_setprio(1); _Pragma("unroll") for (int m = 0; m < 4; ++m) _Pragma("unroll") for (int n = 0; n < 2; ++n) _Pragma("unroll") for (int k = 0; k < 2; ++k) \
        acc[ai][bj][m][n] = __builtin_amdgcn_mfma_f32_16x16x32_bf16(Bt[n][k], At[m][k], acc[ai][bj][m][n], 0, 0, 0); __builtin_amdgcn_s_setprio(0); } while (0)
#define PG8_WAIT_V(n) asm volatile("s_waitcnt vmcnt(" #n ")" ::: "memory")
#define PG8_WAIT_L(n) asm volatile("s_waitcnt lgkmcnt(" #n ")" ::: "memory")
#define PG8_BAR __builtin_amdgcn_s_barrier()
#define PG8_SCHED __builtin_amdgcn_sched_barrier(0)
    Unit cur, nxt; int ui = 0;
    if (!S.next(0, cur)) return;
    f32x4 acc[2][2][4][2];
#pragma unroll
    for (int a = 0; a < 2; ++a)
#pragma unroll
        for (int b = 0; b < 2; ++b)
#pragma unroll
            for (int m = 0; m < 4; ++m)
#pragma unroll
                for (int n = 0; n < 2; ++n) acc[a][b][m][n] = (f32x4){0.f, 0.f, 0.f, 0.f};
    bf16x8 At[4][2], B0[2][2], B1[2][2];
    const char* cA = (const char*)g.A + (size_t)cur.pm * tstep; const char* cB = (const char*)g.Bt + (size_t)cur.pn * tstep;
    S.a_ready(cur);
    if constexpr (SP2) {
        PG8_STAGE(PG8_SB(0, 0), cB, voffB); PG8_STAGE(PG8_SB(0, 1), cB + hstep, voffB); PG8_STAGE(PG8_SA(0, 0), cA, voffA); PG8_STAGE(PG8_SA(0, 1), cA + hstep, voffA);
        if (wr == 1) PG8_BAR;
        PG8_WAIT_V(2); PG8_BAR;
        PG8_STAGE(PG8_SB(1, 0), cB + kstep, voffB); PG8_STAGE(PG8_SA(1, 0), cA + kstep, voffA); PG8_STAGE(PG8_SB(1, 1), cB + hstep + kstep, voffB);
        PG8_WAIT_V(6); PG8_BAR;
    } else {
        PG8_STAGE(PG8_SB(0, 0), cB, voffB); PG8_STAGE(PG8_SA(0, 0), cA, voffA); PG8_STAGE(PG8_SB(0, 1), cB + hstep, voffB); PG8_STAGE(PG8_SA(0, 1), cA + hstep, voffA);
        if (wr == 1) PG8_BAR;
        PG8_WAIT_V(4); PG8_BAR;
        PG8_STAGE(PG8_SB(1, 0), cB + kstep, voffB); PG8_STAGE(PG8_SA(1, 0), cA + kstep, voffA); PG8_STAGE(PG8_SB(1, 1), cB + hstep + kstep, voffB);
        PG8_WAIT_V(6); PG8_BAR;
    }
    for (;;) {
        const bool has_next = S.next(ui + 1, nxt);
        const char* nA = has_next ? (const char*)g.A + (size_t)nxt.pm * tstep : cA; const char* nB = has_next ? (const char*)g.Bt + (size_t)nxt.pn * tstep : cB;
        for (int t = 0; t < nt; t += 2) {
            const bool last = (t == nt - 2);
            const char* a1 = cA + (size_t)(t + 1) * kstep;
            const char* a2 = last ? nA : cA + (size_t)(t + 2) * kstep; const char* b2 = last ? nB : cB + (size_t)(t + 2) * kstep;
            const char* a3 = a2 + kstep; const char* b3 = b2 + kstep;
            if (last && has_next) S.a_ready(nxt);
            if constexpr (SP2) {
            PG8_LDB(B0, 0, 0); PG8_LDB(B1, 0, 1); PG8_SCHED; PG8_LDA(At, 0, 0); PG8_STAGE(PG8_SA(1, 1), a1 + hstep, voffA);
            PG8_WAIT_V(8); PG8_WAIT_L(0); PG8_BAR; PG8_MMA(0, 0, At, B0); PG8_MMA(0, 1, At, B1); PG8_BAR; PG8_SCHED;
            PG8_LDA(At, 0, 1); PG8_STAGE(PG8_SB(0, 0), b2, voffB); PG8_STAGE(PG8_SB(0, 1), b2 + hstep, voffB); PG8_STAGE(PG8_SA(0, 0), a2, voffA);
            PG8_WAIT_V(8); PG8_WAIT_L(0); PG8_BAR; if (!(HALFSKIP && cur.hf)) { PG8_MMA(1, 0, At, B0); PG8_MMA(1, 1, At, B1); } PG8_BAR; PG8_SCHED;
            PG8_LDB(B0, 1, 0); PG8_LDB(B1, 1, 1); PG8_SCHED; PG8_LDA(At, 1, 0); PG8_STAGE(PG8_SA(0, 1), a2 + hstep, voffA);
            PG8_WAIT_V(8); PG8_WAIT_L(0); PG8_BAR; PG8_MMA(0, 0, At, B0); PG8_MMA(0, 1, At, B1); PG8_BAR; PG8_SCHED;
            PG8_LDA(At, 1, 1); PG8_STAGE(PG8_SB(1, 0), b3, voffB); PG8_STAGE(PG8_SB(1, 1), b3 + hstep, voffB); PG8_STAGE(PG8_SA(1, 0), a3, voffA);
            PG8_WAIT_V(8); PG8_WAIT_L(0); PG8_BAR; if (!(HALFSKIP && cur.hf)) { PG8_MMA(1, 0, At, B0); PG8_MMA(1, 1, At, B1); } PG8_BAR; PG8_SCHED;
            } else {
            PG8_LDB(B0, 0, 0); PG8_SCHED; PG8_LDA(At, 0, 0); PG8_STAGE(PG8_SA(1, 1), a1 + hstep, voffA);
            PG8_WAIT_L(8); PG8_BAR; PG8_WAIT_L(0); PG8_MMA(0, 0, At, B0); PG8_BAR; PG8_SCHED;
            PG8_LDB(B1, 0, 1); PG8_STAGE(PG8_SB(0, 0), b2, voffB);
            PG8_BAR; PG8_WAIT_L(0); PG8_MMA(0, 1, At, B1); PG8_BAR;
            PG8_LDA(At, 0, 1); PG8_STAGE(PG8_SA(0, 0), a2, voffA);
            PG8_BAR; PG8_WAIT_L(0); PG8_MMA(1, 0, At, B0); PG8_BAR; PG8_SCHED;
            PG8_STAGE(PG8_SB(0, 1), b2 + hstep, voffB);
            PG8_WAIT_V(6); PG8_BAR; PG8_MMA(1, 1, At, B1); PG8_BAR;
            PG8_LDB(B0, 1, 0); PG8_SCHED; PG8_LDA(At, 1, 0); PG8_STAGE(PG8_SA(0, 1), a2 + hstep, voffA);
            PG8_WAIT_L(8); PG8_BAR; PG8_WAIT_L(0); PG8_MMA(0, 0, At, B0); PG8_BAR; PG8_SCHED;
            PG8_LDB(B1, 1, 1); PG8_STAGE(PG8_SB(1, 0), b3, voffB);
            PG8_BAR; PG8_WAIT_L(0); PG8_MMA(0, 1, At, B1); PG8_BAR;
            PG8_LDA(At, 1, 1); PG8_STAGE(PG8_SA(1, 0), a3, voffA);
            PG8_BAR; PG8_WAIT_L(0); PG8_MMA(1, 0, At, B0); PG8_BAR; PG8_SCHED;
            PG8_STAGE(PG8_SB(1, 1), b3 + hstep, voffB);
            PG8_WAIT_V(6); PG8_BAR; PG8_MMA(1, 1, At, B1); PG8_BAR;
            }
        }
        if constexpr (ALIGN_EPI) { if (wr == 0) PG8_BAR; }
        if constexpr (!Epi::AFTER_DRAIN) { E(acc, cur, wr, wc, fr, fq); S.done(cur); }
        if (!has_next) break;
#pragma unroll
        for (int a = 0; a < 2; ++a)
#pragma unroll
            for (int b = 0; b < 2; ++b)
#pragma unroll
                for (int m = 0; m < 4; ++m)
#pragma unroll
                    for (int n = 0; n < 2; ++n) acc[a][b][m][n] = (f32x4){0.f, 0.f, 0.f, 0.f};
        cur = nxt; cA = nA; cB = nB; ++ui;
        if constexpr (ALIGN_EPI) { if (wr == 1) PG8_BAR; }
    }
    PG8_WAIT_V(0);
    if constexpr (!ALIGN_EPI) { if (wr == 0) PG8_BAR; }
    PG8_BAR;
    if constexpr (Epi::AFTER_DRAIN) { E.fused(acc, cur, wr, wc, fr, fq, lds, wid, lane); S.done(cur); }
#undef PG8_SA
#undef PG8_SB
#undef PG8_STAGE
#undef PG8_LDA
#undef PG8_LDB
#undef PG8_MMA
#undef PG8_WAIT_V
#undef PG8_WAIT_L
#undef PG8_BAR
#undef PG8_SCHED
}
template <class Epi, class Sched, bool ALIGN_EPI = false, bool SP2 = false, bool HALFSKIP = false>
__device__ __forceinline__ void gemm_phase8(PG8_LAS unsigned char* lds, const Gemm g, const Sched& S, const Epi& E) {
    const int tid = threadIdx.x, wid = __builtin_amdgcn_readfirstlane(tid >> 6), lane = tid & 63, wr = wid >> 2, wc = wid & 3, fr = lane & 15, fq = lane >> 4;
    const int K = g.K, nt = K / 128;
    unsigned voffA[2], voffB[2];
#pragma unroll
    for (int i = 0; i < 2; ++i) { int R, C; stage_rc(tid * 16 + i * 8192, R, C); const int Rb = Epi::PERM ? ((R & ~31) + perm32(R & 31)) : R;
        voffA[i] = (unsigned)(R * K + 2 * C); voffB[i] = (unsigned)(Rb * K + 2 * C); }
    const size_t kstep = (size_t)(BK * 2);
    const size_t hstep = (size_t)HALF * K;
    const size_t tstep = 2 * hstep;
    const unsigned ldsw = (unsigned)wid * 1024u;
    const int aoff = lds_byte(wr * 64 + fr, fq * 16), boff = lds_byte(wc * 32 + fr, fq * 16);
#define PG8_SA(b, h) (((b) * 2 + (h)) * HTB)
#define PG8_SB(b, h) ((4 + (b) * 2 + (h)) * HTB)
#define PG8_STAGE(bufoff, gbase, voff) do { _Pragma("unroll") for (int _i = 0; _i < 2; ++_i) \
        __builtin_amdgcn_global_load_lds((const unsigned*)((const char*)(gbase) + (voff)[_i]), (PG8_LAS unsigned*)(lds + (bufoff) + ldsw + _i * 8192), 16, 0, 0); } while (0)
#define PG8_LDA(dst, b, h) do { _Pragma("unroll") for (int m = 0; m < 4; ++m) { const i32x4 lo_ = *(const PG8_LAS i32x4*)(lds + PG8_SA(b, h) + aoff + m * 2048), hi_ = *(const PG8_LAS i32x4*)(lds + PG8_SA(b, h) + aoff + m * 2048 + 16); dst[m] = __builtin_shufflevector(lo_, hi_, 0, 1, 2, 3, 4, 5, 6, 7); } } while (0)
#define PG8_LDB(dst, b, h) do { _Pragma("unroll") for (int n = 0; n < 2; ++n) { const i32x4 lo_ = *(const PG8_LAS i32x4*)(lds + PG8_SB(b, h) + boff + n * 2048), hi_ = *(const PG8_LAS i32x4*)(lds + PG8_SB(b, h) + boff + n * 2048 + 16); dst[n] = __builtin_shufflevector(lo_, hi_, 0, 1, 2, 3, 4, 5, 6, 7); } } while (0)
#define PG8_MMA(ai, bj, At, Bt) do { __builtin_amdgcn_s_setprio(1); _Pragma("unroll") for (int m = 0; m < 4; ++m) _Pragma("unroll") for (int n = 0; n < 2; ++n) \
        asm volatile("v_mfma_scale_f32_16x16x128_f8f6f4 %0, %1, %2, %0, %3, %3 op_sel_hi:[0,0,0]" : "+v"(acc[ai][bj][m][n]) : "v"(Bt[n]), "v"(At[m]), "v"(sc127)); __builtin_amdgcn_s_setprio(0); } while (0)
#define PG8_WAIT_V(n) asm volatile("s_waitcnt vmcnt(" #n ")" ::: "memory")
#define PG8_WAIT_L(n) asm volatile("s_waitcnt lgkmcnt(" #n ")" ::: "memory")
#define PG8_BAR __builtin_amdgcn_s_barrier()
#define PG8_SCHED __builtin_amdgcn_sched_barrier(0)
    Unit cur, nxt; int ui = 0;
    if (!S.next(0, cur)) return;
    f32x4 acc[2][2][4][2];
#pragma unroll
    for (int a = 0; a < 2; ++a)
#pragma unroll
        for (int b = 0; b < 2; ++b)
#pragma unroll
            for (int m = 0; m < 4; ++m)
#pragma unroll
                for (int n = 0; n < 2; ++n) acc[a][b][m][n] = (f32x4){0.f, 0.f, 0.f, 0.f};
    i32x8 At[4], B0[2], B1[2]; const int sc127 = 127;
    const char* cA = (const char*)g.A + (size_t)cur.pm * tstep; const char* cB = (const char*)g.Bt + (size_t)cur.pn * tstep;
    S.a_ready(cur);
    if constexpr (SP2) {
        PG8_STAGE(PG8_SB(0, 0), cB, voffB); PG8_STAGE(PG8_SB(0, 1), cB + hstep, voffB); PG8_STAGE(PG8_SA(0, 0), cA, voffA); PG8_STAGE(PG8_SA(0, 1), cA + hstep, voffA);
        if (wr == 1) PG8_BAR;
        PG8_WAIT_V(2); PG8_BAR;
        PG8_STAGE(PG8_SB(1, 0), cB + kstep, voffB); PG8_STAGE(PG8_SA(1, 0), cA + kstep, voffA); PG8_STAGE(PG8_SB(1, 1), cB + hstep + kstep, voffB);
        PG8_WAIT_V(6); PG8_BAR;
    } else {
        PG8_STAGE(PG8_SB(0, 0), cB, voffB); PG8_STAGE(PG8_SA(0, 0), cA, voffA); PG8_STAGE(PG8_SB(0, 1), cB + hstep, voffB); PG8_STAGE(PG8_SA(0, 1), cA + hstep, voffA);
        if (wr == 1) PG8_BAR;
        PG8_WAIT_V(4); PG8_BAR;
        PG8_STAGE(PG8_SB(1, 0), cB + kstep, voffB); PG8_STAGE(PG8_SA(1, 0), cA + kstep, voffA); PG8_STAGE(PG8_SB(1, 1), cB + hstep + kstep, voffB);
        PG8_WAIT_V(6); PG8_BAR;
    }
    for (;;) {
        const bool has_next = S.next(ui + 1, nxt);
        const char* nA = has_next ? (const char*)g.A + (size_t)nxt.pm * tstep : cA; const char* nB = has_next ? (const char*)g.Bt + (size_t)nxt.pn * tstep : cB;
        for (int t = 0; t < nt; t += 2) {
            const bool last = (t == nt - 2);
            const char* a1 = cA + (size_t)(t + 1) * kstep;
            const char* a2 = last ? nA : cA + (size_t)(t + 2) * kstep; const char* b2 = last ? nB : cB + (size_t)(t + 2) * kstep;
            const char* a3 = a2 + kstep; const char* b3 = b2 + kstep;
            if (last && has_next) S.a_ready(nxt);
            if constexpr (SP2) {
            PG8_LDB(B0, 0, 0); PG8_LDB(B1, 0, 1); PG8_SCHED; PG8_LDA(At, 0, 0); PG8_STAGE(PG8_SA(1, 1), a1 + hstep, voffA);
            PG8_WAIT_V(8); PG8_WAIT_L(0); PG8_BAR; PG8_MMA(0, 0, At, B0); PG8_MMA(0, 1, At, B1); PG8_BAR; PG8_SCHED;
            PG8_LDA(At, 0, 1); PG8_STAGE(PG8_SB(0, 0), b2, voffB); PG8_STAGE(PG8_SB(0, 1), b2 + hstep, voffB); PG8_STAGE(PG8_SA(0, 0), a2, voffA);
            PG8_WAIT_V(8); PG8_WAIT_L(0); PG8_BAR; if (!(HALFSKIP && cur.hf)) { PG8_MMA(1, 0, At, B0); PG8_MMA(1, 1, At, B1); } PG8_BAR; PG8_SCHED;
            PG8_LDB(B0, 1, 0); PG8_LDB(B1, 1, 1); PG8_SCHED; PG8_LDA(At, 1, 0); PG8_STAGE(PG8_SA(0, 1), a2 + hstep, voffA);
            PG8_WAIT_V(8); PG8_WAIT_L(0); PG8_BAR; PG8_MMA(0, 0, At, B0); PG8_MMA(0, 1, At, B1); PG8_BAR; PG8_SCHED;
            PG8_LDA(At, 1, 1); PG8_STAGE(PG8_SB(1, 0), b3, voffB); PG8_STAGE(PG8_SB(1, 1), b3 + hstep, voffB); PG8_STAGE(PG8_SA(1, 0), a3, voffA);
            PG8_WAIT_V(8); PG8_WAIT_L(0); PG8_BAR; if (!(HALFSKIP && cur.hf)) { PG8_MMA(1, 0, At, B0); PG8_MMA(1, 1, At, B1); } PG8_BAR; PG8_SCHED;
            } else {
            PG8_LDB(B0, 0, 0); PG8_SCHED; PG8_LDA(At, 0, 0); PG8_STAGE(PG8_SA(1, 1), a1 + hstep, voffA);
            PG8_WAIT_L(8); PG8_BAR; PG8_WAIT_L(0); PG8_MMA(0, 0, At, B0); PG8_BAR; PG8_SCHED;
            PG8_LDB(B1, 0, 1); PG8_STAGE(PG8_SB(0, 0), b2, voffB);
            PG8_BAR; PG8_WAIT_L(0); PG8_MMA(0, 1, At, B1); PG8_BAR;
            PG8_LDA(At, 0, 1); PG8_STAGE(PG8_SA(0, 0), a2, voffA);
            PG8_BAR; PG8_WAIT_L(0); PG8_MMA(1, 0, At, B0); PG8_BAR; PG8_SCHED;
            PG8_STAGE(PG8_SB(0, 1), b2 + hstep, voffB);
            PG8_WAIT_V(6); PG8_BAR; PG8_MMA(1, 1, At, B1); PG8_BAR;
            PG8_LDB(B0, 1, 0); PG8_SCHED; PG8_LDA(At, 1, 0); PG8_STAGE(PG8_SA(0, 1), a2 + hstep, voffA);
            PG8_WAIT_L(8); PG8_BAR; PG8_WAIT_L(0); PG8_MMA(0, 0, At, B0); PG8_BAR; PG8_SCHED;
            PG8_LDB(B1, 1, 1); PG8_STAGE(PG8_SB(1, 0), b3, voffB);
            PG8_BAR; PG8_WAIT_L(0); PG8_MMA(0, 1, At, B1); PG8_BAR;
            PG8_LDA(At, 1, 1); PG8_STAGE(PG8_SA(1, 0), a3, voffA);
            PG8_BAR; PG8_WAIT_L(0); PG8_MMA(1, 0, At, B0); PG8_BAR; PG8_SCHED;
            PG8_STAGE(PG8_SB(1, 1), b3 + hstep, voffB);
            PG8_WAIT_V(6); PG8_BAR; PG8_MMA(1, 1, At, B1); PG8_BAR;
            }
        }
        if constexpr (ALIGN_EPI) { if (wr == 0) PG8_BAR; }
        if constexpr (!Epi::AFTER_DRAIN) { E(acc, cur, wr, wc, fr, fq); S.done(cur); }
        if (!has_next) break;
#pragma unroll
        for (int a = 0; a < 2; ++a)
#pragma unroll
            for (int b = 0; b < 2; ++b)
#pragma unroll
                for (int m = 0; m < 4; ++m)
#pragma unroll
                    for (int n = 0; n < 2; ++n) acc[a][b][m][n] = (f32x4){0.f, 0.f, 0.f, 0.f};
        cur = nxt; cA = nA; cB = nB; ++ui;
        if constexpr (ALIGN_EPI) { if (wr == 1) PG8_BAR; }
    }
    PG8_WAIT_V(0);
    if constexpr (!ALIGN_EPI) { if (wr == 0) PG8_BAR; }
    PG8_BAR;
    if constexpr (Epi::AFTER_DRAIN) { E.fused(acc, cur, wr, wc, fr, fq, lds, wid, lane); S.done(cur); }
#undef PG8_SA
#undef PG8_SB
#undef PG8_STAGE
#undef PG8_LDA
#undef PG8_LDB
#undef PG8_MMA
#undef PG8_WAIT_V
#undef PG8_WAIT_L
#undef PG8_BAR
#undef PG8_SCHED
}
}

constexpr int NWAVES = 8, NTHR = 512;
constexpr int N_LAUNCHES = MK_N_LAUNCHES;
constexpr int N_PHASES = 13;
constexpr int DM = 2048, NB = 4, TL = 2048, NLAT = NB * TL, TCX = 256, NCTX = NB * TCX, NTOK = NLAT + NCTX;
constexpr int NH = 8, QKD = 128, VD = 256, INC = 14368, ZW = 14336;
constexpr int ZQ = 0, ZK = 1024, ZV = 2048, ZO = 4096, ZU = 6144, ZS = 8192, ZGA = 10240, ZGB = 12288;
constexpr int NEXP = 32, DEXP = 2048, NCH = 18  , CROWS = 272  ;
constexpr float EPS = 1e-6f;

constexpr size_t MiB = 1u << 20;
constexpr size_t WS_CTL = 0, CTL_ZERO_BYTES = 1 * MiB;
constexpr size_t WS_MOD = 1 * MiB;
constexpr size_t WS_GATES = 2 * MiB;
constexpr size_t WS_SCAL = 4 * MiB;
constexpr size_t WS_ROUTE = 5 * MiB;
constexpr size_t WS_SCN = 2996 * MiB;
constexpr size_t WS_SK = 6 * MiB;
constexpr size_t WS_WINT = 8 * MiB;
constexpr size_t WS_PAT = 64 * MiB, WS_PBT = 72 * MiB, WS_WOT = 80 * MiB;
constexpr size_t WS_W1T = 88 * MiB;
constexpr size_t WS_W2T = 600 * MiB;
constexpr size_t WS_HB = 856 * MiB;
constexpr size_t WS_Z = 892 * MiB;
constexpr size_t WS_QC = 1144 * MiB, WS_KC = 1162 * MiB;
constexpr size_t WS_SVN = 1180 * MiB;
constexpr size_t WS_DC = 1212 * MiB;
constexpr size_t WS_CS = 1360 * MiB;
constexpr size_t WS_RO = 1428 * MiB;
constexpr size_t WS_CM = 1460 * MiB;
constexpr size_t WS_YB = 1492 * MiB;
constexpr size_t WS_MRG = 1556 * MiB;
constexpr size_t WS_X1 = 1588 * MiB;
constexpr size_t WS_ACT = 1652 * MiB;
constexpr size_t WS_Y2 = 1812 * MiB;
constexpr size_t WS_XG = 1972 * MiB;
constexpr size_t WS_END = 2998 * MiB;
static_assert(WS_DC + (size_t)64 * 17 * CROWS * 128 * 2 <= WS_CS && WS_CS + (size_t)64 * 16 * CROWS * 128 * 2 <= WS_RO && WS_Z + (size_t)NTOK * ZW * 2 <= WS_QC, "ws map");
constexpr int CW_Q = 2048;
constexpr int CW_CNT = 64;
constexpr int CW_BAR = 4096;
constexpr int RING_BYTES = 131072;
constexpr int LDS_BYTES = 147456;
constexpr int LDSCTL_OFF = LDS_BYTES - 2048, MISC_OFF = LDSCTL_OFF + 320, PREF_OFF = LDSCTL_OFF + 1024;

#define GAS __attribute__((address_space(1)))
#define LAS __attribute__((address_space(3)))
typedef unsigned short bf16;
typedef unsigned v4u __attribute__((ext_vector_type(4)));
typedef unsigned v2u __attribute__((ext_vector_type(2)));
typedef float f32x4 __attribute__((ext_vector_type(4)));
typedef short bf16x8 __attribute__((ext_vector_type(8)));
typedef short s16x4 __attribute__((ext_vector_type(4)));
typedef GAS unsigned gu32;
#define RLX_AGENT __ATOMIC_RELAXED, __HIP_MEMORY_SCOPE_AGENT
#define LDS_WAIT() asm volatile("s_waitcnt lgkmcnt(0)" ::: "memory")
#define VM_WAIT() asm volatile("s_waitcnt vmcnt(0)" ::: "memory")
using pg8::cvt_pk_bf16; using pg8::bf_lo; using pg8::bf_hi; using pg8::sigmoidf_;


__device__ __forceinline__ float wave_sum(float v) {
#pragma unroll
    for (int o = 1; o < 64; o <<= 1) v += __shfl_xor(v, o);
    return v;
}
__device__ __forceinline__ float siluf_(float x) { return x * __builtin_amdgcn_rcpf(1.0f + __expf(-x)); }
__device__ __forceinline__ float gelu_tanh(float x) { const float u = 0.7978845608028654f * (x + 0.044715f * x * x * x); return x * __builtin_amdgcn_rcpf(1.0f + __expf(-2.0f * u)); }
__device__ __forceinline__ float logsigf_(float f) { return fminf(f, 0.f) - log1pf(expf(-fabsf(f))); }
__device__ __forceinline__ unsigned img_off(unsigned row, unsigned ch) { return 256u * row + 16u * (ch ^ (((row & 3u) << 2) | ((row >> 2) & 3u))); }
__device__ __forceinline__ s16x4 tr_read(LAS unsigned char* p) { return __builtin_amdgcn_ds_read_tr16_b64_v4i16((LAS s16x4*)p); }
__device__ __forceinline__ bf16x8 tr_frag(LAS unsigned char* img, unsigned r0, unsigned r1, unsigned c, int lane) {
    const unsigned q = (lane & 15) >> 2, p = lane & 3;
    const s16x4 lo = tr_read(img + img_off(r0 + q, 2 * c + (p >> 1)) + 8 * (p & 1));
    const s16x4 hi = tr_read(img + img_off(r1 + q, 2 * c + (p >> 1)) + 8 * (p & 1));
    bf16x8 r; r[0] = lo[0]; r[1] = lo[1]; r[2] = lo[2]; r[3] = lo[3]; r[4] = hi[0]; r[5] = hi[1]; r[6] = hi[2]; r[7] = hi[3]; return r;
}
__device__ __forceinline__ bf16x8 tr_frag2(LAS unsigned char* base, unsigned x0, unsigned x1) {
    const s16x4 lo = tr_read(base + x0), hi = tr_read(base + x1);
    bf16x8 r; r[0] = lo[0]; r[1] = lo[1]; r[2] = lo[2]; r[3] = lo[3]; r[4] = hi[0]; r[5] = hi[1]; r[6] = hi[2]; r[7] = hi[3]; return r;
}
#define TR_NAT_OFFS(xn0, xn1, lane) unsigned xn0[8], xn1[8]; { const unsigned g_ = (lane) >> 4, q_ = ((lane) & 15) >> 2, p_ = (lane) & 3; \
    _Pragma("unroll") for (int c_ = 0; c_ < 8; ++c_) { xn0[c_] = 256u * (8 * g_ + q_) + 16u * ((2 * c_ + (p_ >> 1)) ^ ((q_ << 2) | ((2 * g_) & 3))) + 8u * (p_ & 1); \
                                                       xn1[c_] = 256u * (8 * g_ + 4 + q_) + 16u * ((2 * c_ + (p_ >> 1)) ^ ((q_ << 2) | ((2 * g_ + 1) & 3))) + 8u * (p_ & 1); } }
#define TR_PERM_OFFS(xp, lane) unsigned xp[8]; { const unsigned g_ = (lane) >> 4, q_ = ((lane) & 15) >> 2, p_ = (lane) & 3; \
    _Pragma("unroll") for (int c_ = 0; c_ < 8; ++c_) xp[c_] = 256u * (4 * g_ + q_) + 16u * ((2 * c_ + (p_ >> 1)) ^ ((q_ << 2) | g_)) + 8u * (p_ & 1); }
__device__ __forceinline__ void load_tile128(LAS unsigned char* img, const bf16* src, size_t ld, int tid) {
#pragma unroll
    for (int i = 0; i < 4; ++i) { const int id = tid + NTHR * i, row = id >> 4, ch = id & 15;
        const v4u v = *(const v4u*)(src + (size_t)row * ld + 8 * ch); *(LAS v4u*)(img + img_off(row, ch)) = v; }
}
__device__ __forceinline__ void load_tile128_scaled(LAS unsigned char* img, const bf16* src, size_t ld, const LAS float* w, int tid) {
#pragma unroll
    for (int i = 0; i < 4; ++i) { const int id = tid + NTHR * i, row = id >> 4, ch = id & 15; const float s = w[row];
        const v4u v = *(const v4u*)(src + (size_t)row * ld + 8 * ch); v4u o;
        o.x = cvt_pk_bf16(bf_lo(v.x) * s, bf_hi(v.x) * s); o.y = cvt_pk_bf16(bf_lo(v.y) * s, bf_hi(v.y) * s); o.z = cvt_pk_bf16(bf_lo(v.z) * s, bf_hi(v.z) * s); o.w = cvt_pk_bf16(bf_lo(v.w) * s, bf_hi(v.w) * s);
        *(LAS v4u*)(img + img_off(row, ch)) = o; }
}
__device__ __forceinline__ void gate_scan(const float* G, size_t row0, int col_i, int col_f, int dir, int lane, float* bc, float* gg, float* pmx, float& b_end, float& gmax) {
    const int j0 = dir ? 127 - 2 * lane : 2 * lane, j1 = dir ? 126 - 2 * lane : 2 * lane + 1;
    const float f0 = G[(row0 + j0) * 32 + col_f], f1 = G[(row0 + j1) * 32 + col_f], i0 = G[(row0 + j0) * 32 + col_i], i1 = G[(row0 + j1) * 32 + col_i];
    const float lf0 = logsigf_(f0), lf1 = logsigf_(f1), s = lf0 + lf1; float incl = s;
#pragma unroll
    for (int o = 1; o < 64; o <<= 1) { const float t = __shfl_up(incl, o); if (lane >= o) incl += t; }
    const float b0 = (incl - s) + lf0, b1 = incl, g0 = i0 - b0, g1 = i1 - b1;
    float mincl = fmaxf(g0, g1);
#pragma unroll
    for (int o = 1; o < 64; o <<= 1) { const float t = __shfl_up(mincl, o); if (lane >= o) mincl = fmaxf(mincl, t); }
    float mexcl = __shfl_up(mincl, 1); if (lane == 0) mexcl = -3.0e38f;
    bc[j0] = b0; bc[j1] = b1; gg[j0] = g0; gg[j1] = g1; pmx[j0] = fmaxf(mexcl, g0); pmx[j1] = mincl;
    b_end = __shfl(incl, 63); gmax = __shfl(mincl, 63);
}
#define MFMA16(a, b, c) __builtin_amdgcn_mfma_f32_16x16x32_bf16((a), (b), (c), 0, 0, 0)

struct CvtItem { const float* src; size_t ldw; bf16* dst; };
constexpr int N_CONVERTERS = 112;
constexpr int N_CONV_DEFER = 1440;
constexpr int I_GEMV = 192, I_WIN = 16 * 56, I_P = 16 * 8, I_W1 = 32 * 16 * 16, I_W2 = 32 * 16 * 8, I_TOTAL = I_GEMV + I_WIN + 3 * I_P + I_W1 + I_W2;
__device__ __forceinline__ CvtItem cvt_decode(int r, int tid, const float* w_in, const float* proj_a, const float* proj_b, const float* w_out, const float* exp_w1, const float* exp_w2,
                                              bf16* WINT, bf16* PAT, bf16* PBT, bf16* WOT, bf16* W1T, bf16* W2T) {
    const int n4 = tid & 63, kg = tid >> 6; const float* W; size_t ldw, ca, cb, drow; int kt; bf16* WT;
    if (r < I_WIN) { kt = r / 56; const int nt = r % 56; W = w_in; ldw = INC; ca = (size_t)256 * nt + (nt >= 16 ? 32 : 0); cb = ca + 128; WT = WINT; drow = (size_t)256 * nt; }
    else if ((r -= I_WIN) < 3 * I_P) { const int m = r / I_P, q = r % I_P; kt = q / 8; const int nt = q % 8; W = m == 0 ? proj_a : (m == 1 ? proj_b : w_out); ldw = 2048; ca = (size_t)256 * nt; cb = ca + 128; WT = m == 0 ? PAT : (m == 1 ? PBT : WOT); drow = (size_t)256 * nt; }
    else if ((r -= 3 * I_P) < I_W1) { const int e = r / 256, q = r % 256; kt = q / 16; const int nt = q % 16; W = exp_w1 + (size_t)e * 2048 * 4096; ldw = 4096; ca = (size_t)128 * nt; cb = 2048 + ca; WT = W1T; drow = (size_t)e * 4096 + 256 * nt; }
    else { r -= I_W1; const int e = r / 128, q = r % 128; kt = q / 8; const int nt = q % 8; W = exp_w2 + (size_t)e * 2048 * 2048; ldw = 2048; ca = (size_t)256 * nt; cb = ca + 128; WT = W2T; drow = (size_t)e * 2048 + 256 * nt; }
    CvtItem it; it.ldw = ldw; it.src = W + (size_t)(128 * kt + 8 * kg) * ldw + (n4 < 32 ? ca + 4 * n4 : cb + 4 * (n4 - 32)); it.dst = WT + drow * 2048 + 128 * kt; return it;
}
__device__ __forceinline__ void cvt_run(LAS unsigned char* lds, int tid, int it, int stride, int end, const float* w_in, const float* proj_a, const float* proj_b, const float* w_out, const float* exp_w1, const float* exp_w2,
                                        bf16* WINT, bf16* PAT, bf16* PBT, bf16* WOT, bf16* W1T, bf16* W2T) {
    const int n4 = tid & 63, kg = tid >> 6;
    f32x4 v[16]; CvtItem cur;
    bool have = it < end;
    if (have) { cur = cvt_decode(it - I_GEMV, tid, w_in, proj_a, proj_b, w_out, exp_w1, exp_w2, WINT, PAT, PBT, WOT, W1T, W2T);
#pragma unroll
        for (int i = 0; i < 16; ++i) v[i] = __builtin_nontemporal_load((const f32x4*)(cur.src + (size_t)((i >> 3) * 64 + (i & 7)) * cur.ldw)); }
    while (have) {
#pragma unroll
        for (int hf = 0; hf < 2; ++hf)
#pragma unroll
            for (int j = 0; j < 4; ++j) { v4u o; o.x = cvt_pk_bf16(v[8 * hf + 0][j], v[8 * hf + 1][j]); o.y = cvt_pk_bf16(v[8 * hf + 2][j], v[8 * hf + 3][j]); o.z = cvt_pk_bf16(v[8 * hf + 4][j], v[8 * hf + 5][j]); o.w = cvt_pk_bf16(v[8 * hf + 6][j], v[8 * hf + 7][j]);
                *(LAS v4u*)(lds + img_off(4 * n4 + j, 8 * hf + kg)) = o; }
        __syncthreads();
        bf16* dst = cur.dst;
        it += stride; have = it < end;
        if (have) { cur = cvt_decode(it - I_GEMV, tid, w_in, proj_a, proj_b, w_out, exp_w1, exp_w2, WINT, PAT, PBT, WOT, W1T, W2T);
#pragma unroll
            for (int i = 0; i < 16; ++i) v[i] = __builtin_nontemporal_load((const f32x4*)(cur.src + (size_t)((i >> 3) * 64 + (i & 7)) * cur.ldw)); }
#pragma unroll
        for (int i = 0; i < 8; ++i) { const int id = tid + NTHR * i, row = id >> 4, ch = id & 15; const v4u o = *(const LAS v4u*)(lds + img_off(row, ch)); __builtin_nontemporal_store(o, (v4u*)(dst + (size_t)row * 2048 + 8 * ch)); }
        __syncthreads();
    }
}
__device__ __forceinline__ void cvt_run8(LAS unsigned char* lds, int tid, int r, int stride, int end, const float* exp_w1, const float* exp_w2, unsigned char* W1T8, unsigned char* W2T8) {
    const int n4 = tid & 63, kg = tid >> 6;
    f32x4 v[16]; const float* src = nullptr; size_t ldw = 0; unsigned char* dst = nullptr;
#define CVT8_DECODE(R) do { int q_ = (R); const float* W_; size_t ca_, cb_, drow_; int kt_; unsigned char* WT_; \
        if (q_ < I_W1) { const int e = q_ / 256, qq = q_ % 256; kt_ = qq / 16; const int nt = qq % 16; W_ = exp_w1 + (size_t)e * 2048 * 4096; ldw = 4096; ca_ = (size_t)128 * nt; cb_ = 2048 + ca_; WT_ = W1T8; drow_ = (size_t)e * 4096 + 256 * nt; } \
        else { q_ -= I_W1; const int e = q_ / 128, qq = q_ % 128; kt_ = qq / 8; const int nt = qq % 8; W_ = exp_w2 + (size_t)e * 2048 * 2048; ldw = 2048; ca_ = (size_t)256 * nt; cb_ = ca_ + 128; WT_ = W2T8; drow_ = (size_t)e * 2048 + 256 * nt; } \
        src = W_ + (size_t)(128 * kt_ + 8 * kg) * ldw + (n4 < 32 ? ca_ + 4 * n4 : cb_ + 4 * (n4 - 32)); dst = WT_ + drow_ * 2048 + 128 * kt_; \
        _Pragma("unroll") for (int i = 0; i < 16; ++i) v[i] = __builtin_nontemporal_load((const f32x4*)(src + (size_t)((i >> 3) * 64 + (i & 7)) * ldw)); } while (0)
    bool have = r < end;
    if (have) CVT8_DECODE(r);
    while (have) {
#pragma unroll
        for (int hf = 0; hf < 2; ++hf)
#pragma unroll
            for (int j = 0; j < 4; ++j) { const int row = 4 * n4 + j, p8 = 8 * hf + kg; v2u o;
                o.x = pg8::pk4_fp8(v[8 * hf + 0][j] * pg8::F8_SW, v[8 * hf + 1][j] * pg8::F8_SW, v[8 * hf + 2][j] * pg8::F8_SW, v[8 * hf + 3][j] * pg8::F8_SW);
                o.y = pg8::pk4_fp8(v[8 * hf + 4][j] * pg8::F8_SW, v[8 * hf + 5][j] * pg8::F8_SW, v[8 * hf + 6][j] * pg8::F8_SW, v[8 * hf + 7][j] * pg8::F8_SW);
                *(LAS v2u*)(lds + row * 128 + 16 * ((p8 >> 1) ^ ((row >> 2) & 7)) + 8 * (p8 & 1)) = o; }
        __syncthreads();
        unsigned char* d0 = dst;
        r += stride; have = r < end;
        if (have) CVT8_DECODE(r);
#pragma unroll
        for (int i = 0; i < 4; ++i) { const int id = tid + NTHR * i, row = id >> 3, ch = id & 7; const v4u o = *(const LAS v4u*)(lds + row * 128 + 16 * (ch ^ ((row >> 2) & 7)));
            __builtin_nontemporal_store(o, (v4u*)(d0 + (size_t)row * 2048 + 16 * ch)); }
        __syncthreads();
    }
#undef CVT8_DECODE
}
__device__ __forceinline__ void p0_phase(LAS unsigned char* lds, int tid, int G, const float* c, const float* c_ctx, const float* mod_w, const float* mod_b, float* MOD,
                                         const float* w_in, const float* proj_a, const float* proj_b, const float* w_out, const float* exp_w1, const float* exp_w2, const float* router_w,
                                         bf16* WINT, bf16* PAT, bf16* PBT, bf16* WOT, bf16* W1T, bf16* W2T, bf16* SK, int n_conv_p0) {
    LAS float* sc = (LAS float*)lds;
    LAS float* red = (LAS float*)(lds + 40960);
    int it = blockIdx.x;
    if (it < I_GEMV) {
        for (int i = tid; i < 5 * 2048; i += NTHR) { const float x = i < 4 * 2048 ? c[i] : c_ctx[i - 4 * 2048]; sc[i] = siluf_(x); }
        __syncthreads();
        for (; it < I_GEMV; it += G) {
            const int j0 = 64 * it, c4 = tid & 15, kg = tid >> 4;
            f32x4 a0 = {0.f, 0.f, 0.f, 0.f}, a1 = a0, a2 = a0, a3 = a0, a4 = a0;
            const float* wp = mod_w + (size_t)kg * 12288 + j0 + 4 * c4;
#pragma unroll 8
            for (int k = kg; k < 2048; k += 32) { const f32x4 w = *(const f32x4*)wp; wp += (size_t)32 * 12288;
                a0 += w * sc[k]; a1 += w * sc[2048 + k]; a2 += w * sc[4096 + k]; a3 += w * sc[6144 + k]; a4 += w * sc[8192 + k]; }
            *(LAS f32x4*)(red + (kg * 5 + 0) * 64 + 4 * c4) = a0; *(LAS f32x4*)(red + (kg * 5 + 1) * 64 + 4 * c4) = a1; *(LAS f32x4*)(red + (kg * 5 + 2) * 64 + 4 * c4) = a2;
            *(LAS f32x4*)(red + (kg * 5 + 3) * 64 + 4 * c4) = a3; *(LAS f32x4*)(red + (kg * 5 + 4) * 64 + 4 * c4) = a4;
            __syncthreads();
            if (tid < 320) { const int rr = tid >> 6, j = tid & 63; float s = 0.f;
#pragma unroll 8
                for (int g = 0; g < 32; ++g) s += red[(g * 5 + rr) * 64 + j];
                MOD[rr * 12288 + j0 + j] = s + mod_b[j0 + j]; }
            __syncthreads();
        }
    } else {
        for (int i = (it - I_GEMV) * NTHR + tid; i < 2 * 32 * 2048; i += (G - I_GEMV) * NTHR) { const int m = i >> 16, n = (i >> 11) & 31, k = i & 2047;
            const float w = m == 0 ? w_in[(size_t)k * INC + 4096 + n] : router_w[k * 32 + n];
            const unsigned hi = cvt_pk_bf16(w, 0.f) & 0xffffu; const unsigned lo = cvt_pk_bf16(w - __uint_as_float(hi << 16), 0.f) & 0xffffu;
            SK[(size_t)(2 * m) * 65536 + n * 2048 + k] = (bf16)hi; SK[(size_t)(2 * m + 1) * 65536 + n * 2048 + k] = (bf16)lo; }
    }
    cvt_run(lds, tid, it, G, I_GEMV + n_conv_p0, w_in, proj_a, proj_b, w_out, exp_w1, exp_w2, WINT, PAT, PBT, WOT, W1T, W2T);
}

__device__ __forceinline__ void skinny_mfma(const LAS float* hrow, const bf16* WT_hi, const bf16* WT_lo, LAS float* part, int wave, int lane) {
    const int g = lane >> 4, l15 = lane & 15;
    f32x4 acc0 = {0.f, 0.f, 0.f, 0.f}, acc1 = acc0;
#pragma unroll
    for (int ks = 0; ks < 8; ++ks) { const int kb = 256 * wave + 32 * ks + 8 * g;
        f32x4 a0 = {0.f, 0.f, 0.f, 0.f}, a1 = a0;
        if (l15 < 8) { a0 = *(const LAS f32x4*)(hrow + l15 * 2048 + kb); a1 = *(const LAS f32x4*)(hrow + l15 * 2048 + kb + 4); }
        v4u hi, lo;
        hi.x = cvt_pk_bf16(a0[0], a0[1]); hi.y = cvt_pk_bf16(a0[2], a0[3]); hi.z = cvt_pk_bf16(a1[0], a1[1]); hi.w = cvt_pk_bf16(a1[2], a1[3]);
        lo.x = cvt_pk_bf16(a0[0] - bf_lo(hi.x), a0[1] - bf_hi(hi.x)); lo.y = cvt_pk_bf16(a0[2] - bf_lo(hi.y), a0[3] - bf_hi(hi.y));
        lo.z = cvt_pk_bf16(a1[0] - bf_lo(hi.z), a1[1] - bf_hi(hi.z)); lo.w = cvt_pk_bf16(a1[2] - bf_lo(hi.w), a1[3] - bf_hi(hi.w));
        const bf16x8 Ah = __builtin_bit_cast(bf16x8, hi), Al = __builtin_bit_cast(bf16x8, lo);
        const bf16x8 b0h = *(const bf16x8*)(WT_hi + (size_t)l15 * 2048 + kb), b0l = *(const bf16x8*)(WT_lo + (size_t)l15 * 2048 + kb);
        const bf16x8 b1h = *(const bf16x8*)(WT_hi + (size_t)(16 + l15) * 2048 + kb), b1l = *(const bf16x8*)(WT_lo + (size_t)(16 + l15) * 2048 + kb);
        acc0 = MFMA16(Ah, b0h, acc0); acc0 = MFMA16(Ah, b0l, acc0); acc0 = MFMA16(Al, b0h, acc0);
        acc1 = MFMA16(Ah, b1h, acc1); acc1 = MFMA16(Ah, b1l, acc1); acc1 = MFMA16(Al, b1h, acc1); }
    if (g < 2) {
#pragma unroll
        for (int r = 0; r < 4; ++r) { part[wave * 256 + (4 * g + r) * 32 + l15] = acc0[r]; part[wave * 256 + (4 * g + r) * 32 + 16 + l15] = acc1[r]; } }
}

__device__ __forceinline__ void p1_phase(LAS unsigned char* lds, int tid, int wave, int lane, int G, const float* x, const float* ctx, const float* MOD, const float* norm_g,
                                         const bf16* SK, const float* gate_b, bf16* HB, float* GATES) {
    LAS float* hrow = (LAS float*)(lds + wave * 8192); LAS float* part = (LAS float*)(lds + 65536);
    f32x4 v[8];
    { const int row = blockIdx.x * 8 + wave; const float* xr = row < NLAT ? x + (size_t)row * DM : ctx + (size_t)(row - NLAT) * DM;
#pragma unroll
      for (int j = 0; j < 8; ++j) v[j] = *(const f32x4*)(xr + 4 * (lane + 64 * j)); }
    for (int it = blockIdx.x; it < NTOK / 8; it += G) {
        const int row = it * 8 + wave;
        const float* shift = MOD + (size_t)(row < NLAT ? (row >> 11) : 4) * 12288; const float* scale = shift + 2048;
        float ss = 0.f;
#pragma unroll
        for (int j = 0; j < 8; ++j) ss += (v[j][0] * v[j][0] + v[j][1] * v[j][1]) + (v[j][2] * v[j][2] + v[j][3] * v[j][3]);
        const float rstd = 1.0f / sqrtf(wave_sum(ss) * (1.0f / DM) + EPS);
#pragma unroll
        for (int j = 0; j < 8; ++j) { const int col = 4 * (lane + 64 * j);
            const f32x4 g = *(const f32x4*)(norm_g + col), sc = *(const f32x4*)(scale + col), sh = *(const f32x4*)(shift + col);
            const f32x4 h = (v[j] * rstd) * g * (sc + 1.0f) + sh;
            v2u o; o.x = cvt_pk_bf16(h[0], h[1]); o.y = cvt_pk_bf16(h[2], h[3]); *(v2u*)(HB + (size_t)row * DM + col) = o;
            *(LAS f32x4*)(hrow + col) = h; }
        if (it + G < NTOK / 8) { const int rown = (it + G) * 8 + wave; const float* xr = rown < NLAT ? x + (size_t)rown * DM : ctx + (size_t)(rown - NLAT) * DM;
#pragma unroll
            for (int j = 0; j < 8; ++j) v[j] = *(const f32x4*)(xr + 4 * (lane + 64 * j)); }
        __syncthreads();
        skinny_mfma((const LAS float*)lds, SK, SK + 65536, part, wave, lane);
        __syncthreads();
        if (tid < 256) { float s = 0.f;
#pragma unroll
            for (int w = 0; w < 8; ++w) s += part[w * 256 + tid];
            GATES[(size_t)(it * 8) * 32 + tid] = s + gate_b[tid & 31]; }
    }
}

__device__ __forceinline__ void p3_phase(int wave, int lane, int G, const bf16* Z, const float* conv_w, const float* conv_b, const float* sgu_norm_g, bf16* QC, bf16* KC, bf16* SVN,
                                         const float* GATES, float* SCN, float* BEND, float* GMAX) {
    const int gw = blockIdx.x * NWAVES + wave, NGW = G * NWAVES;
    for (int task = gw; task < 64 * NCH; task += NGW) { const int bhd = task / NCH, bi = task - bhd * NCH, dir = bhd & 1, bh = bhd >> 1, b = bh >> 3, h = bh & 7;
        const size_t row0 = bi < 2 ? (size_t)NLAT + b * TCX + bi * 128 : (size_t)b * TL + (bi - 2) * 128;
        float* sp = SCN + (size_t)task * 384; float b_end, gmax;
        gate_scan(GATES, row0, (2 * dir) * 8 + h, (2 * dir + 1) * 8 + h, dir, lane, sp, sp + 128, sp + 256, b_end, gmax);
        const int c = dir == 0 ? bi : (bi < 2 ? 1 - bi : 19 - bi);
        if (lane == 0 && c < 17) { BEND[bhd * 17 + c] = b_end; GMAX[bhd * 17 + c] = gmax; } }
    for (int item = gw; item < NTOK; item += NGW) {
        const int rb = item >> 2, seg = item & 3, row0 = rb * 4, c0 = seg * 512 + lane * 8;
        const int t0 = row0 < NLAT ? (row0 & (TL - 1)) : ((row0 - NLAT) & (TCX - 1)), len = row0 < NLAT ? TL : TCX;
        v4u zr[8];
#pragma unroll
        for (int k = 0; k < 8; ++k) { const int tt = t0 + k - 2; zr[k] = (v4u){0u, 0u, 0u, 0u};
            if (tt >= 0 && tt < len) zr[k] = *(const v4u*)(Z + (size_t)(row0 + k - 2) * ZW + c0); }
        f32x4 w0[5], w1[5];
#pragma unroll
        for (int tau = 0; tau < 5; ++tau) { w0[tau] = *(const f32x4*)(conv_w + tau * 2048 + c0); w1[tau] = *(const f32x4*)(conv_w + tau * 2048 + c0 + 4); }
        const f32x4 b0 = *(const f32x4*)(conv_b + c0), b1 = *(const f32x4*)(conv_b + c0 + 4);
        const float qs = c0 < 1024 ? 0.08838834764831845f : 1.0f;
#pragma unroll
        for (int o = 0; o < 4; ++o) { float acc[8] = {b0[0], b0[1], b0[2], b0[3], b1[0], b1[1], b1[2], b1[3]};
#pragma unroll
            for (int tau = 0; tau < 5; ++tau) { const v4u z = zr[o + tau];
                acc[0] += w0[tau][0] * bf_lo(z.x); acc[1] += w0[tau][1] * bf_hi(z.x); acc[2] += w0[tau][2] * bf_lo(z.y); acc[3] += w0[tau][3] * bf_hi(z.y);
                acc[4] += w1[tau][0] * bf_lo(z.z); acc[5] += w1[tau][1] * bf_hi(z.z); acc[6] += w1[tau][2] * bf_lo(z.w); acc[7] += w1[tau][3] * bf_hi(z.w); }
#pragma unroll
            for (int i = 0; i < 8; ++i) acc[i] = siluf_(acc[i]) * qs;
            v4u ov; ov.x = cvt_pk_bf16(acc[0], acc[1]); ov.y = cvt_pk_bf16(acc[2], acc[3]); ov.z = cvt_pk_bf16(acc[4], acc[5]); ov.w = cvt_pk_bf16(acc[6], acc[7]);
            bf16* dst = c0 < 1024 ? QC + (size_t)(row0 + o) * 1024 + c0 : KC + (size_t)(row0 + o) * 1024 + (c0 - 1024);
            *(v4u*)dst = ov; }
    }
    for (int row = gw; row < NLAT; row += NGW) {
        float v[32]; float ss = 0.f;
#pragma unroll
        for (int j = 0; j < 4; ++j) { const v4u z = *(const v4u*)(Z + (size_t)row * ZW + ZS + 8 * lane + 512 * j);
            v[8 * j + 0] = gelu_tanh(bf_lo(z.x)); v[8 * j + 1] = gelu_tanh(bf_hi(z.x)); v[8 * j + 2] = gelu_tanh(bf_lo(z.y)); v[8 * j + 3] = gelu_tanh(bf_hi(z.y));
            v[8 * j + 4] = gelu_tanh(bf_lo(z.z)); v[8 * j + 5] = gelu_tanh(bf_hi(z.z)); v[8 * j + 6] = gelu_tanh(bf_lo(z.w)); v[8 * j + 7] = gelu_tanh(bf_hi(z.w)); }
#pragma unroll
        for (int i = 0; i < 32; ++i) ss += v[i] * v[i];
        const float rstd = 1.0f / sqrtf(wave_sum(ss) * (1.0f / DM) + EPS);
#pragma unroll
        for (int j = 0; j < 4; ++j) { const int col = 8 * lane + 512 * j; const f32x4 g0 = *(const f32x4*)(sgu_norm_g + col), g1 = *(const f32x4*)(sgu_norm_g + col + 4);
            v4u o; o.x = cvt_pk_bf16(v[8 * j] * rstd * g0[0], v[8 * j + 1] * rstd * g0[1]); o.y = cvt_pk_bf16(v[8 * j + 2] * rstd * g0[2], v[8 * j + 3] * rstd * g0[3]);
            o.z = cvt_pk_bf16(v[8 * j + 4] * rstd * g1[0], v[8 * j + 5] * rstd * g1[1]); o.w = cvt_pk_bf16(v[8 * j + 6] * rstd * g1[2], v[8 * j + 7] * rstd * g1[3]);
            *(v4u*)(SVN + (size_t)row * DM + col) = o; }
    }
}

constexpr int L_V0 = 0, L_V1 = 32768, L_K = 65536, L_SC = 98304, L_CB = 106496;
constexpr int N_M1 = 64 * 17, N_SGU = 512;
__device__ __forceinline__ void p4_phase(LAS unsigned char* lds, int tid_, int wave, int lane_, int G, const bf16* Z, const bf16* KC, const bf16* SVN, const float* SCN,
                                         const float* sgu_w, const float* sgu_b, bf16* DC, const float* GMAX, bf16* CM) {
    v4u pk[4], pv[8]; f32x4 pa[2];
#define P4_ISSUE(U) do { const int u_ = (U); int t_ = tid_; asm volatile("" : "+v"(t_)); \
        if (u_ < N_M1) { const int bhd_ = u_ / 17, c_ = u_ - bhd_ * 17, dir_ = bhd_ & 1, bh_ = bhd_ >> 1, b_ = bh_ >> 3, h_ = bh_ & 7; \
            const bool ic_ = c_ < 2; const int blk_ = dir_ == 0 ? (ic_ ? c_ : c_ - 2) : (ic_ ? 1 - c_ : 17 - c_); \
            const size_t r0_ = ic_ ? (size_t)NLAT + b_ * TCX + blk_ * 128 : (size_t)b_ * TL + blk_ * 128; \
            const float* sp_ = SCN + (size_t)(bhd_ * NCH + (ic_ ? blk_ : blk_ + 2)) * 384; \
            _Pragma("unroll") for (int i = 0; i < 4; ++i) { const int id = t_ + NTHR * i; pk[i] = *(const v4u*)(KC + (r0_ + (id >> 4)) * 1024 + h_ * QKD + 8 * (id & 15)); pa[0][i] = sp_[128 + (id >> 4)]; } \
            pa[1][0] = GMAX[bhd_ * 17 + c_]; \
            _Pragma("unroll") for (int i = 0; i < 8; ++i) { const int id = t_ + NTHR * (i & 3); pv[i] = *(const v4u*)(Z + (r0_ + (id >> 4)) * ZW + ZV + h_ * VD + 128 * (i >> 2) + 8 * (id & 15)); } \
        } else { const int u2_ = u_ - N_M1, b_ = u2_ >> 7, n_ = (u2_ >> 3) & 15, grp_ = u2_ & 7; const size_t r0_ = (size_t)b_ * TL + n_ * 128; \
            _Pragma("unroll") for (int i = 0; i < 8; ++i) { const int id = t_ + NTHR * (i & 3); pv[i] = *(const v4u*)(SVN + (r0_ + (id >> 4)) * DM + grp_ * 256 + 128 * (i >> 2) + 8 * (id & 15)); } \
            } } while (0)
    int u = blockIdx.x;
    if (u < N_M1 + N_SGU) P4_ISSUE(u);
    for (; u < N_M1 + N_SGU; u += G) {
        int tid = tid_; asm volatile("" : "+v"(tid)); const int lane = tid & 63; const unsigned g = lane >> 4, l15 = lane & 15;
        const bool m1 = u < N_M1;
        TR_NAT_OFFS(xn0, xn1, lane)
#pragma unroll
        for (int i = 0; i < 8; ++i) { const int id = tid + NTHR * (i & 3); *(LAS v4u*)(lds + ((i >> 2) ? L_V1 : L_V0) + img_off(id >> 4, id & 15)) = pv[i]; }
        bf16x8 Af[4]; v2u uw[16];
        if (m1) { const float gmax = pa[1][0];
#pragma unroll
            for (int i = 0; i < 4; ++i) { const int id = tid + NTHR * i, row = id >> 4, ch = id & 15; const float sw = __expf(pa[0][i] - gmax); const v4u v = pk[i]; v4u o;
                o.x = cvt_pk_bf16(bf_lo(v.x) * sw, bf_hi(v.x) * sw); o.y = cvt_pk_bf16(bf_lo(v.y) * sw, bf_hi(v.y) * sw); o.z = cvt_pk_bf16(bf_lo(v.z) * sw, bf_hi(v.z) * sw); o.w = cvt_pk_bf16(bf_lo(v.w) * sw, bf_hi(v.w) * sw);
                *(LAS v4u*)(lds + L_K + img_off(row, ch)) = o; }
        }
        __syncthreads();
        f32x4 af32[8];
        if (!m1) { const int u2 = u - N_M1, b = u2 >> 7, n = (u2 >> 3) & 15, grp = u2 & 7;
            const float* src = sgu_w + (size_t)grp * 16384 + (size_t)(16 * wave + l15) * 128 + 8 * g;
#pragma unroll
            for (int ks = 0; ks < 4; ++ks) { af32[2 * ks] = *(const f32x4*)(src + 32 * ks); af32[2 * ks + 1] = *(const f32x4*)(src + 32 * ks + 4); }
            const bf16* up = Z + ((size_t)b * TL + n * 128 + 16 * wave + l15) * ZW + ZU + grp * 256 + 4 * g;
#pragma unroll
            for (int et = 0; et < 16; ++et) uw[et] = *(const v2u*)(up + 16 * et); }
        if (u + G < N_M1 + N_SGU) P4_ISSUE(u + G);
        if (!m1) {
#pragma unroll
            for (int ks = 0; ks < 4; ++ks) { const f32x4 a = af32[2 * ks], b2 = af32[2 * ks + 1];
                const v4u p = {cvt_pk_bf16(a[0], a[1]), cvt_pk_bf16(a[2], a[3]), cvt_pk_bf16(b2[0], b2[1]), cvt_pk_bf16(b2[2], b2[3])}; Af[ks] = __builtin_bit_cast(bf16x8, p); } }
        if (m1) {
            const int bhd = u / 17, c = u - bhd * 17;
#pragma unroll
            for (int ks = 0; ks < 4; ++ks) Af[ks] = tr_frag(lds + L_K, 32 * ks + 8 * g, 32 * ks + 8 * g + 4, wave, lane);
            f32x4 acc[17];
#pragma unroll
            for (int et = 0; et < 17; ++et) acc[et] = (f32x4){0.f, 0.f, 0.f, 0.f};
#pragma unroll
            for (int et = 0; et < 16; ++et) { LAS unsigned char* img = lds + ((et >> 3) ? L_V1 : L_V0);
#pragma unroll
                for (int ks = 0; ks < 4; ++ks) { const bf16x8 Bf = tr_frag2(img + 8192 * ks, xn0[et & 7], xn1[et & 7]); acc[et] = MFMA16(Af[ks], Bf, acc[et]); } }
            { const short one = l15 == 0 ? (short)0x3F80 : (short)0; const bf16x8 Bo = {one, one, one, one, one, one, one, one};
#pragma unroll
                for (int ks = 0; ks < 4; ++ks) acc[16] = MFMA16(Af[ks], Bo, acc[16]); }
            bf16* dst = DC + ((size_t)bhd * 17 + c) * (CROWS * 128) + 16 * wave + 4 * g;
#pragma unroll
            for (int et = 0; et < 16; ++et) { v2u o; o.x = cvt_pk_bf16(acc[et][0], acc[et][1]); o.y = cvt_pk_bf16(acc[et][2], acc[et][3]); *(v2u*)(dst + (size_t)(16 * et + l15) * 128) = o; }
            if (l15 == 0) { v2u o; o.x = cvt_pk_bf16(acc[16][0], acc[16][1]); o.y = cvt_pk_bf16(acc[16][2], acc[16][3]); *(v2u*)(dst + (size_t)256 * 128) = o; }
        } else {
            const int u2 = u - N_M1, b = u2 >> 7, n = (u2 >> 3) & 15, grp = u2 & 7; const size_t row0 = (size_t)b * TL + n * 128;
            f32x4 acc[16];
#pragma unroll
            for (int et = 0; et < 16; ++et) { acc[et] = (f32x4){0.f, 0.f, 0.f, 0.f}; LAS unsigned char* img = lds + ((et >> 3) ? L_V1 : L_V0);
#pragma unroll
                for (int ks = 0; ks < 4; ++ks) { const bf16x8 Bf = tr_frag2(img + 8192 * ks, xn0[et & 7], xn1[et & 7]); acc[et] = MFMA16(Bf, Af[ks], acc[et]); } }
            { const int t = 16 * wave + l15; const float zb = sgu_b[grp * 128 + t]; const size_t row = row0 + t;
#pragma unroll
              for (int et = 0; et < 16; ++et) { const int col = grp * 256 + 16 * et + 4 * g; const v2u w2 = uw[et];
                  const float o0 = gelu_tanh(bf_lo(w2.x)) * (acc[et][0] + zb), o1 = gelu_tanh(bf_hi(w2.x)) * (acc[et][1] + zb), o2 = gelu_tanh(bf_lo(w2.y)) * (acc[et][2] + zb), o3 = gelu_tanh(bf_hi(w2.y)) * (acc[et][3] + zb);
                  v2u o; o.x = cvt_pk_bf16(o0, o1); o.y = cvt_pk_bf16(o2, o3); *(v2u*)(CM + row * DM + col) = o; } }
        }
        __syncthreads();
    }
#undef P4_ISSUE
}

__device__ __forceinline__ void p5_scan(int tid, int G, const bf16* DC, const float* BEND, const float* GMAX, bf16* CS, float* MST) {
    constexpr int QPB = 257 * 128 / 4;
    for (int idx = blockIdx.x * NTHR + tid; idx < 64 * QPB; idx += G * NTHR) {
        const int bhd = idx / QPB, q = idx - bhd * QPB;
        f32x4 C = {0.f, 0.f, 0.f, 0.f}; float m = 0.f;
#pragma unroll
        for (int c = 0; c < 17; ++c) {
            const float gm = GMAX[bhd * 17 + c], be = BEND[bhd * 17 + c], mx = fmaxf(m, gm), al = __expf(m - mx), bt = __expf(gm - mx);
            const v2u dw = *(const v2u*)(DC + ((size_t)bhd * 17 + c) * (CROWS * 128) + 4 * q); const f32x4 d = {bf_lo(dw.x), bf_hi(dw.x), bf_lo(dw.y), bf_hi(dw.y)};
            C = C * al + d * bt; m = be + mx;
            if (c >= 1) { v2u o; o.x = cvt_pk_bf16(C[0], C[1]); o.y = cvt_pk_bf16(C[2], C[3]);
                *(v2u*)(CS + ((size_t)bhd * 16 + (c - 1)) * (CROWS * 128) + 4 * q) = o; if (q == 0) MST[bhd * 18 + c + 1] = m; }
        }
    }
}

__device__ __forceinline__ void p6_phase(LAS unsigned char* lds, int tid, int wave, int lane_, int G, const bf16* Z, const bf16* QC, const bf16* KC, const float* SCN,
                                         const bf16* CS, const float* MST, const float* mnorm_g, bf16* RO) {
    for (int u = blockIdx.x; u < 512; u += G) {
        int lane = lane_; asm volatile("" : "+v"(lane)); const unsigned g = lane >> 4, l15 = lane & 15;
        const int bh = u >> 4, jb = u & 15, b = bh >> 3, h = bh & 7; const size_t row0 = (size_t)b * TL + jb * 128;
        load_tile128(lds + L_K, KC + row0 * 1024 + h * QKD, 1024, tid);
        load_tile128(lds + L_V0, Z + row0 * ZW + ZV + h * VD, ZW, tid);
        load_tile128(lds + L_V1, Z + row0 * ZW + ZV + h * VD + 128, ZW, tid);
        bf16x8 Qf[4];
#pragma unroll
        for (int ks = 0; ks < 4; ++ks) Qf[ks] = *(const bf16x8*)(QC + (row0 + 16 * wave + l15) * 1024 + h * QKD + 32 * ks + 8 * g);
        __syncthreads();
        f32x4 hsum[16];
#pragma unroll
        for (int et = 0; et < 16; ++et) hsum[et] = (f32x4){0.f, 0.f, 0.f, 0.f};
#pragma unroll 1
        for (int dir = 0; dir < 2; ++dir) {
            int lane = lane_; asm volatile("" : "+v"(lane));
            const unsigned g = lane >> 4, l15 = lane & 15;
            TR_PERM_OFFS(xp, lane)
            const int c = dir ? 17 - jb : 2 + jb; const bf16* cs = CS + ((size_t)(bh * 2 + dir) * 16 + (c - 2)) * (CROWS * 128);
            const float* sp = SCN + (size_t)((bh * 2 + dir) * NCH + 2 + jb) * 384; const float* gg = sp + 128; const float mc = MST[(bh * 2 + dir) * 18 + c];
            const int tS = 16 * wave + l15; const float MtS = fmaxf(mc, sp[256 + tS]);
            unsigned pw[16];
#pragma unroll
            for (int st = 0; st < 8; ++st) { f32x4 aS = {0.f, 0.f, 0.f, 0.f};
#pragma unroll
                for (int ks = 0; ks < 4; ++ks) { const bf16x8 Kf = *(const LAS bf16x8*)(lds + L_K + img_off(16 * st + l15, 4 * ks + g)); aS = MFMA16(Kf, Qf[ks], aS); }
                float pv[4]; const f32x4 gs = *(const f32x4*)(gg + 16 * st + 4 * g);
#pragma unroll
                for (int r = 0; r < 4; ++r) { const int s = 16 * st + 4 * g + r; const bool ok = dir ? (s >= tS) : (s <= tS); const float ev = __expf(fminf(gs[r] - MtS, 0.f)); pv[r] = ok ? aS[r] * ev : 0.f; }
                pw[2 * st] = cvt_pk_bf16(pv[0], pv[1]); pw[2 * st + 1] = cvt_pk_bf16(pv[2], pv[3]); asm volatile("" ::: "memory"); }
            bf16x8 Pf[4];
#pragma unroll
            for (int ks = 0; ks < 4; ++ks) { const v4u t4 = {pw[4 * ks], pw[4 * ks + 1], pw[4 * ks + 2], pw[4 * ks + 3]}; Pf[ks] = __builtin_bit_cast(bf16x8, t4); }
            const float wiT = __expf(mc - MtS), flT = __expf(-(sp[tS] + MtS));
            const short one = l15 == 0 ? (short)0x3F80 : (short)0; const bf16x8 Bo = {one, one, one, one, one, one, one, one};
            float inv;
            { f32x4 ad = {0.f, 0.f, 0.f, 0.f};
#pragma unroll
              for (int ks = 0; ks < 4; ++ks) { bf16x8 Cf = *(const bf16x8*)(cs + (size_t)256 * 128 + 32 * ks + 8 * g); if (l15 != 0) Cf = (bf16x8){0, 0, 0, 0, 0, 0, 0, 0}; ad = MFMA16(Cf, Qf[ks], ad); }
              ad[0] *= wiT;
#pragma unroll
              for (int ks = 0; ks < 4; ++ks) ad = MFMA16(Bo, Pf[ks], ad);
              const float den = __shfl(ad[0], lane & 15); inv = 1.0f / fmaxf(fabsf(den), flT); }
            { v4u cr[2];
#pragma unroll
              for (int i = 0; i < 2; ++i) { const int id = tid + NTHR * i; cr[i] = *(const v4u*)(cs + (size_t)(id >> 4) * 128 + 8 * (id & 15)); }
#pragma unroll
              for (int i = 0; i < 2; ++i) { const int id = tid + NTHR * i; *(LAS v4u*)(lds + L_CB + img_off(id >> 4, id & 15)) = cr[i]; }
#pragma unroll
              for (int gq = 0; gq < 4; ++gq) {
                LAS unsigned char* cb = lds + L_CB + (gq & 1) * 16384;
                __syncthreads();
                if (gq < 3) {
#pragma unroll
                    for (int i = 0; i < 2; ++i) { const int id = tid + NTHR * i; cr[i] = *(const v4u*)(cs + (size_t)(64 * (gq + 1) + (id >> 4)) * 128 + 8 * (id & 15)); } }
                f32x4 acc[4];
#pragma unroll
                for (int i = 0; i < 4; ++i) { acc[i] = (f32x4){0.f, 0.f, 0.f, 0.f};
#pragma unroll
                    for (int ks = 0; ks < 4; ++ks) { const bf16x8 Cf = *(const LAS bf16x8*)(cb + img_off(16 * i + l15, 4 * ks + g)); acc[i] = MFMA16(Cf, Qf[ks], acc[i]); } }
#pragma unroll
                for (int i = 0; i < 4; ++i) acc[i] = acc[i] * wiT;
                { LAS unsigned char* img = lds + ((gq >> 1) ? L_V1 : L_V0);
#pragma unroll
                  for (int i = 0; i < 4; ++i) {
#pragma unroll
                    for (int ks = 0; ks < 4; ++ks) { const bf16x8 Vf = tr_frag2(img + 8192 * ks, xp[4 * (gq & 1) + i], xp[4 * (gq & 1) + i] + 4096u); acc[i] = MFMA16(Vf, Pf[ks], acc[i]); } } }
#pragma unroll
                for (int i = 0; i < 4; ++i) hsum[4 * gq + i] += acc[i] * inv;
                if (gq < 3) {
#pragma unroll
                    for (int i = 0; i < 2; ++i) { const int id = tid + NTHR * i; *(LAS v4u*)(lds + L_CB + ((gq + 1) & 1) * 16384 + img_off(id >> 4, id & 15)) = cr[i]; } }
              } }
        }
        { float ss = 0.f;
#pragma unroll
          for (int et = 0; et < 16; ++et) ss += (hsum[et][0] * hsum[et][0] + hsum[et][1] * hsum[et][1]) + (hsum[et][2] * hsum[et][2] + hsum[et][3] * hsum[et][3]);
          ss += __shfl_xor(ss, 16); ss += __shfl_xor(ss, 32);
          const float rstd = 1.0f / sqrtf(ss * (1.0f / VD) + EPS); const size_t row = row0 + 16 * wave + l15;
#pragma unroll
          for (int et = 0; et < 16; ++et) { const int col = h * VD + 16 * et + 4 * g;
              const v2u ow = *(const v2u*)(Z + row * ZW + ZO + col); const f32x4 gn = *(const f32x4*)(mnorm_g + col);
              const float v0 = hsum[et][0] * rstd * gn[0] * sigmoidf_(bf_lo(ow.x)), v1 = hsum[et][1] * rstd * gn[1] * sigmoidf_(bf_hi(ow.x));
              const float v2 = hsum[et][2] * rstd * gn[2] * sigmoidf_(bf_lo(ow.y)), v3 = hsum[et][3] * rstd * gn[3] * sigmoidf_(bf_hi(ow.y));
              v2u o; o.x = cvt_pk_bf16(v0, v1); o.y = cvt_pk_bf16(v2, v3); *(v2u*)(RO + row * DM + col) = o; } }
        __syncthreads();
    }
}

__device__ __forceinline__ void p9_phase(LAS unsigned char* lds, int wave, int lane, int G, const float* X1, const float* MOD, const float* norm_g, const bf16* SK, const float* router_b,
                                         unsigned* cnt, unsigned char* XG, int* RE, int* RR, float* RG) {
    LAS float* hrow = (LAS float*)(lds + wave * 8192); LAS float* part = (LAS float*)(lds + 65536);
    f32x4 vn[8];
    { const float* xr = X1 + (size_t)(blockIdx.x * 8 + wave) * DM;
#pragma unroll
      for (int j = 0; j < 8; ++j) vn[j] = *(const f32x4*)(xr + 4 * (lane + 64 * j)); }
    for (int it = blockIdx.x; it < NLAT / 8; it += G) {
        const int row = it * 8 + wave;
        const float* shift = MOD + (size_t)(row >> 11) * 12288 + 3 * 2048; const float* scale = shift + 2048;
        f32x4 v[8]; float ss = 0.f;
#pragma unroll
        for (int j = 0; j < 8; ++j) { v[j] = vn[j]; ss += (v[j][0] * v[j][0] + v[j][1] * v[j][1]) + (v[j][2] * v[j][2] + v[j][3] * v[j][3]); }
        const float rstd = 1.0f / sqrtf(wave_sum(ss) * (1.0f / DM) + EPS);
#pragma unroll
        for (int j = 0; j < 8; ++j) { const int col = 4 * (lane + 64 * j);
            const f32x4 g = *(const f32x4*)(norm_g + col), sc = *(const f32x4*)(scale + col), sh = *(const f32x4*)(shift + col);
            v[j] = (v[j] * rstd) * g * (sc + 1.0f) + sh; *(LAS f32x4*)(hrow + col) = v[j]; }
        if (it + G < NLAT / 8) { const float* xr = X1 + (size_t)((it + G) * 8 + wave) * DM;
#pragma unroll
            for (int j = 0; j < 8; ++j) vn[j] = *(const f32x4*)(xr + 4 * (lane + 64 * j)); }
        __syncthreads();
        skinny_mfma((const LAS float*)lds, SK + 2 * 65536, SK + 3 * 65536, part, wave, lane);
        __syncthreads();
        float val = router_b[lane & 31];
#pragma unroll
        for (int w = 0; w < 8; ++w) val += part[w * 256 + wave * 32 + (lane & 31)];
        float sv[4]; int si[4];
#pragma unroll
        for (int k = 0; k < 4; ++k) { float bv = val; int bi = lane & 31;
#pragma unroll
            for (int o = 16; o >= 1; o >>= 1) { const float ov = __shfl_xor(bv, o); const int oi = __shfl_xor(bi, o); const bool take = (ov > bv) || (ov == bv && oi < bi); bv = take ? ov : bv; bi = take ? oi : bi; }
            sv[k] = bv; si[k] = __builtin_amdgcn_readfirstlane(bi); if ((lane & 31) == bi) val = -3.0e38f; }
        const float e1 = __expf(sv[1] - sv[0]), e2 = __expf(sv[2] - sv[0]), e3 = __expf(sv[3] - sv[0]), inv = 1.0f / (1.0f + e1 + e2 + e3);
        const float gk[4] = {inv, e1 * inv, e2 * inv, e3 * inv};
        unsigned rank = 0;
        if (lane < 4) rank = __hip_atomic_fetch_add(cnt + (lane == 0 ? si[0] : lane == 1 ? si[1] : lane == 2 ? si[2] : si[3]), 1u, RLX_AGENT);
#pragma unroll
        for (int k = 0; k < 4; ++k) { const unsigned rk = (unsigned)__builtin_amdgcn_readlane((int)rank, k);
            unsigned char* dst = XG + ((size_t)si[k] * 8192 + rk) * DM;
#pragma unroll
            for (int j = 0; j < 8; ++j) *(unsigned*)(dst + 4 * (lane + 64 * j)) = pg8::pk4_fp8(v[j][0] * pg8::F8_SA, v[j][1] * pg8::F8_SA, v[j][2] * pg8::F8_SA, v[j][3] * pg8::F8_SA);
            if (lane == 0) { RE[row * 4 + k] = si[k]; RR[row * 4 + k] = (int)rk; RG[row * 4 + k] = gk[k]; } }
    }
}
__device__ __forceinline__ void moe_prefix(LAS int* pref, const unsigned* cnt, int tid) {
    if (tid == 0) { int s = 0; for (int e = 0; e < 32; ++e) { const unsigned ce = __hip_atomic_load(cnt + e, RLX_AGENT); pref[e] = s; pref[33 + e] = (int)ce; s += (int)((ce + 255u) >> 8); } pref[32] = s; }
    __syncthreads();
}
__device__ __forceinline__ void p12_phase(const LAS int* pref, int wave, int lane_, int G, const float* X1, const float* MOD, const bf16* Y2, const int* RE, const int* RR, const float* RG, const float* final_g, float* out) {
    const int gw = blockIdx.x * NWAVES + wave, NGW = G * NWAVES;
    int en[4], rn[4]; float gn[4];
    if (gw < NLAT) {
#pragma unroll
        for (int k = 0; k < 4; ++k) { en[k] = RE[gw * 4 + k]; rn[k] = RR[gw * 4 + k]; gn[k] = RG[gw * 4 + k]; } }
    for (int row = gw; row < NLAT; row += NGW) {
        int lane = lane_; asm volatile("" : "+v"(lane));
        const float* xr = X1 + (size_t)row * DM + 4 * lane; f32x4 xv[8]; v2u yv[4][8]; float gt[4];
#pragma unroll
        for (int k = 0; k < 4; ++k) { gt[k] = gn[k]; const bf16* src = Y2 + ((size_t)pref[en[k]] * 256 + rn[k]) * DM + 4 * lane;
#pragma unroll
            for (int j = 0; j < 8; ++j) yv[k][j] = __builtin_nontemporal_load((const v2u*)(src + 256 * j)); }
#pragma unroll
        for (int j = 0; j < 8; ++j) xv[j] = __builtin_nontemporal_load((const f32x4*)(xr + 256 * j));
        if (row + NGW < NLAT) { const int r2 = row + NGW;
#pragma unroll
            for (int k = 0; k < 4; ++k) { en[k] = RE[r2 * 4 + k]; rn[k] = RR[r2 * 4 + k]; gn[k] = RG[r2 * 4 + k]; } }
        const float* g5 = MOD + (size_t)(row >> 11) * 12288 + 5 * 2048; float ss = 0.f;
#pragma unroll
        for (int j = 0; j < 8; ++j) { f32x4 ys = {0.f, 0.f, 0.f, 0.f};
#pragma unroll
            for (int k = 0; k < 4; ++k) { const v2u y = yv[k][j]; ys[0] += gt[k] * bf_lo(y.x); ys[1] += gt[k] * bf_hi(y.x); ys[2] += gt[k] * bf_lo(y.y); ys[3] += gt[k] * bf_hi(y.y); }
            const int col = 4 * (lane + 64 * j); const f32x4 x2 = xv[j] + *(const f32x4*)(g5 + col) * ys; xv[j] = x2;
            ss += (x2[0] * x2[0] + x2[1] * x2[1]) + (x2[2] * x2[2] + x2[3] * x2[3]); }
        const float rstd = 1.0f / sqrtf(wave_sum(ss) * (1.0f / DM) + EPS);
#pragma unroll
        for (int j = 0; j < 8; ++j) { const int col = 4 * (lane + 64 * j); __builtin_nontemporal_store(xv[j] * rstd * *(const f32x4*)(final_g + col), (f32x4*)(out + (size_t)row * DM + col)); }
    }
}

#define XB_TMO      128
#define XB_XCNT(j)  (256  + 64 * (j))
#define XB_XSUB(j)  (1280 + 64 * (j))
#define XB_XGEN(j)  (2304 + 64 * (j))
#define XB_TOP      3328
#define XB_TOPGEN   3392
#define XCD_BAR_WORDS 3456
#define XB_SPIN_CAP (1u << 18)

__device__ __forceinline__ unsigned xb_ld(unsigned* p)              { return __hip_atomic_load(p, __ATOMIC_RELAXED, __HIP_MEMORY_SCOPE_AGENT); }
__device__ __forceinline__ unsigned xb_add(unsigned* p, unsigned v) { return __hip_atomic_fetch_add(p, v, __ATOMIC_RELAXED, __HIP_MEMORY_SCOPE_AGENT); }
__device__ __forceinline__ unsigned xb_xcc_id() { return (unsigned)__builtin_amdgcn_s_getreg((3 << 11) | 20) & 0xFu; }
#define XB_SPIN(cond, bar) do { unsigned _sp = 0; while (cond) { __builtin_amdgcn_s_sleep(1); \
    if ((++_sp & 255u) == 0u) { if (xb_ld(&(bar)[XB_TMO])) break; if (_sp > XB_SPIN_CAP) { atomicAdd(&(bar)[XB_TMO], 1u); break; } } } } while (0)

struct XcdBarrier {
    unsigned* bar; unsigned x;
    volatile LAS unsigned* st;
};

__device__ __forceinline__ XcdBarrier xcd_barrier_post(unsigned* bar, volatile LAS unsigned* st) {
    XcdBarrier b; b.bar = bar; b.x = xb_xcc_id(); b.st = st;
    if (threadIdx.x == 0) (void)xb_add(&bar[XB_XCNT(b.x)], 1u);
    return b;
}
__device__ __forceinline__ void xcd_barrier_complete(unsigned* bar, unsigned x, unsigned& nloc, unsigned& nx) {
    const unsigned G = gridDim.x * gridDim.y * gridDim.z;
    unsigned sum, cnt, mine, sp = 0u;
    for (;;) {
        sum = 0u; cnt = 0u; mine = 0u;
#pragma unroll
        for (unsigned j = 0; j < 16; ++j) { const unsigned c = xb_ld(&bar[XB_XCNT(j)]); sum += c; cnt += (c > 0u) ? 1u : 0u; mine = (j == x) ? c : mine; }
        if (sum == G) break;
        __builtin_amdgcn_s_sleep(1);
        if ((++sp & 255u) == 0u) { if (xb_ld(&bar[XB_TMO])) break; if (sp > XB_SPIN_CAP) { atomicAdd(&bar[XB_TMO], 1u); break; } }
    }
    nloc = mine > 0u ? mine : 1u; nx = cnt > 0u ? cnt : 1u;
}

__device__ __forceinline__ void xcd_barrier(const XcdBarrier& b) {
    asm volatile("s_waitcnt vmcnt(0)" ::: "memory");
    __syncthreads();
    if (threadIdx.x == 0) {
        unsigned* bar = b.bar;
        __builtin_amdgcn_s_waitcnt(0);
        unsigned nloc = b.st[0], nx = b.st[1];
        if (nloc == 0u) { xcd_barrier_complete(bar, b.x, nloc, nx); b.st[0] = nloc; b.st[1] = nx; }
        const unsigned old = xb_add(&bar[XB_XSUB(b.x)], 1u);
        const unsigned gen = old / nloc;
        if (old + 1u == (gen + 1u) * nloc) {
            __builtin_amdgcn_fence(__ATOMIC_RELEASE, "agent");
            asm volatile("s_waitcnt vmcnt(0)" ::: "memory");
            const unsigned og = xb_add(&bar[XB_TOP], 1u);
            const unsigned tg = og / nx;
            if (og + 1u == (tg + 1u) * nx) xb_add(&bar[XB_TOPGEN], 1u);
            else XB_SPIN(xb_ld(&bar[XB_TOPGEN]) == tg, bar);
            __builtin_amdgcn_fence(__ATOMIC_ACQUIRE, "agent");
            xb_add(&bar[XB_XGEN(b.x)], 1u);
            asm volatile("s_waitcnt vmcnt(0)" ::: "memory");
        } else {
            XB_SPIN(xb_ld(&bar[XB_XGEN(b.x)]) == gen, bar);
            __builtin_amdgcn_fence(__ATOMIC_ACQUIRE, "agent");
            asm volatile("s_waitcnt vmcnt(0)" ::: "memory");
        }
    }
    __syncthreads();
}

struct Args { const float* in[26]; float* out; unsigned char* ws; int ph_lo, ph_hi; };
__global__ void __launch_bounds__(NTHR, 2) mk_fwd(Args args) {
    extern __shared__ __attribute__((aligned(16))) unsigned char lds_raw[];
    LAS unsigned char* lds = (LAS unsigned char*)lds_raw;
    const int tid = threadIdx.x, lane = tid & 63, wave = __builtin_amdgcn_readfirstlane(tid >> 6), G = gridDim.x;
    unsigned char* ws = args.ws;
    gu32* ctl = (gu32*)(ws + WS_CTL);
    for (int u = tid; u < (LDS_BYTES - LDSCTL_OFF) / 4; u += NTHR) ((LAS unsigned*)(lds + LDSCTL_OFF))[u] = 0u;
    __syncthreads();
    volatile LAS unsigned* MISC = (volatile LAS unsigned*)(lds + MISC_OFF);
    XcdBarrier bar; bar.bar = (unsigned*)(ctl + CW_BAR); bar.x = 0; bar.st = nullptr;
    if (N_LAUNCHES == 1) bar = xcd_barrier_post((unsigned*)(ctl + CW_BAR), MISC + 8);
#define GRID_BAR() do { if (N_LAUNCHES == 1) xcd_barrier(bar); } while (0)
    const int lo = args.ph_lo, hi = args.ph_hi;
#ifdef ONLY_PHASE
#define IN(k) ((k) == ONLY_PHASE && lo <= (k) && (k) < hi)
#else
#define IN(k) (lo <= (k) && (k) < hi)
#endif
#define BOTH(k) (IN(k) && IN((k) + 1))
#ifndef REP_MASK
#define REP_MASK 0
#endif
#define NREP(k) ((((REP_MASK) >> (k)) & 1) ? 2 : 1)
#define INP(i) (args.in[i])
#define WSF(off) ((float*)(ws + (off)))
#define WSB(off) ((bf16*)(ws + (off)))
#define WSI(off) ((int*)(ws + (off)))
    unsigned* cnt = (unsigned*)(ctl + CW_CNT);
    LAS int* pref = (LAS int*)(lds + PREF_OFF);
    const int n_conv_p0 = (G == 256) ? I_WIN + 3 * I_P : (I_TOTAL - I_GEMV);
#define x_in INP(0)
#define cvec INP(1)
#define ctx INP(2)
#define c_ctx INP(3)
#define mod_w INP(4)
#define mod_b INP(5)
#define norm1_g INP(6)
#define norm2_g INP(7)
#define w_in INP(8)
#define gate_b INP(9)
#define conv_w INP(10)
#define conv_b INP(11)
#define mnorm_g INP(12)
#define sgu_norm_g INP(13)
#define sgu_w INP(14)
#define sgu_b INP(15)
#define proj_a INP(16)
#define proj_b INP(17)
#define w_out INP(18)
#define router_w INP(19)
#define router_b INP(20)
#define exp_w1 INP(21)
#define exp_b1 INP(22)
#define exp_w2 INP(23)
#define exp_b2 INP(24)
#define final_g INP(25)
#define MOD WSF(WS_MOD)
#define GATES WSF(WS_GATES)
#define BEND WSF(WS_SCAL)
#define GMAX (WSF(WS_SCAL) + 64 * 17)
#define MST (WSF(WS_SCAL) + 2 * 64 * 17)
#define RE WSI(WS_ROUTE)
#define RR (WSI(WS_ROUTE) + NLAT * 4)
#define RG (WSF(WS_ROUTE) + 2 * NLAT * 4)
#define WINT WSB(WS_WINT)
#define SKW WSB(WS_SK)
#define SCN WSF(WS_SCN)
#define PAT WSB(WS_PAT)
#define PBT WSB(WS_PBT)
#define WOT WSB(WS_WOT)
#define W1T WSB(WS_W1T)
#define W1T8 ((unsigned char*)(ws + WS_W1T))
#define W2T8 ((unsigned char*)(ws + WS_W2T))
#define XG8 ((unsigned char*)(ws + WS_XG))
#define ACT8 ((unsigned char*)(ws + WS_ACT))
#define W2T WSB(WS_W2T)
#define HB WSB(WS_HB)
#define Z WSB(WS_Z)
#define QC WSB(WS_QC)
#define KC WSB(WS_KC)
#define SVN WSB(WS_SVN)
#define DC WSB(WS_DC)
#define CS WSB(WS_CS)
#define RO WSB(WS_RO)
#define CM WSB(WS_CM)
#define YB WSF(WS_YB)
#define MRG WSB(WS_MRG)
#define X1 WSF(WS_X1)
#define ACT WSB(WS_ACT)
#define Y2 WSB(WS_Y2)
#define XG WSB(WS_XG)

    if (IN(0)) for (int rep_ = 0; rep_ < NREP(0); ++rep_) { p0_phase(lds, tid, G, cvec, c_ctx, mod_w, mod_b, MOD, w_in, proj_a, proj_b, w_out, exp_w1, exp_w2, router_w, WINT, PAT, PBT, WOT, W1T, W2T, SKW, n_conv_p0); if (BOTH(0) || rep_ + 1 < NREP(0)) GRID_BAR(); }
    if (IN(1)) for (int rep_ = 0; rep_ < NREP(1); ++rep_) { p1_phase(lds, tid, wave, lane, G, x_in, ctx, MOD, norm1_g, SKW, gate_b, HB, GATES); if (BOTH(1) || rep_ + 1 < NREP(1)) GRID_BAR(); }
    if (IN(2)) for (int rep_ = 0; rep_ < NREP(2); ++rep_) {
        if (G == 256 && (int)blockIdx.x >= 256 - N_CONVERTERS)
            cvt_run8(lds, tid, (int)blockIdx.x - (256 - N_CONVERTERS), N_CONVERTERS, I_W1 + I_W2, exp_w1, exp_w2, W1T8, W2T8);
        { pg8::Gemm g{HB, WINT, NTOK, ZW, DM}; pg8::DynOrder S{(unsigned*)(ctl + CW_Q), (LAS int*)(lds + PREF_OFF + 800), (int)(blockIdx.x & 7)}; pg8::EpiBf16 E{Z, ZW, nullptr, ZW / 256};
          pg8::gemm_phase<pg8::EpiBf16, pg8::DynOrder, true, true>(lds, g, S, E); }
        if (BOTH(2) || rep_ + 1 < NREP(2)) GRID_BAR();
    }
    if (IN(3)) for (int rep_ = 0; rep_ < NREP(3); ++rep_) { p3_phase(wave, lane, G, Z, conv_w, conv_b, sgu_norm_g, QC, KC, SVN, GATES, SCN, BEND, GMAX); if (BOTH(3) || rep_ + 1 < NREP(3)) GRID_BAR(); }
    if (IN(4)) for (int rep_ = 0; rep_ < NREP(4); ++rep_) { p4_phase(lds, tid, wave, lane, G, Z, KC, SVN, SCN, sgu_w, sgu_b, DC, GMAX, CM); if (BOTH(4) || rep_ + 1 < NREP(4)) GRID_BAR(); }
    if (IN(5)) for (int rep_ = 0; rep_ < NREP(5); ++rep_) {
        { pg8::Gemm g{CM, PBT, NLAT, DM, DM}; pg8::StaticOrder S; S.init(NLAT, DM, G, (int)blockIdx.x); pg8::EpiF32 E{YB, DM};
          pg8::gemm_phase<pg8::EpiF32, pg8::StaticOrder, true, true>(lds, g, S, E); }
        p5_scan(tid, G, DC, BEND, GMAX, CS, MST);
        if (BOTH(5) || rep_ + 1 < NREP(5)) GRID_BAR();
    }
    if (IN(6)) for (int rep_ = 0; rep_ < NREP(6); ++rep_) { p6_phase(lds, tid, wave, lane, G, Z, QC, KC, SCN, CS, MST, mnorm_g, RO); if (BOTH(6) || rep_ + 1 < NREP(6)) GRID_BAR(); }
    if (IN(7)) for (int rep_ = 0; rep_ < NREP(7); ++rep_) {
        pg8::Gemm g{RO, PAT, NLAT, DM, DM}; pg8::StaticOrder S; S.init(NLAT, DM, G, (int)blockIdx.x); pg8::EpiMerge E{MRG, Z, ZW, ZGA, ZGB, YB};
        pg8::gemm_phase<pg8::EpiMerge, pg8::StaticOrder, true, true>(lds, g, S, E);
        if (BOTH(7) || rep_ + 1 < NREP(7)) GRID_BAR();
    }
    if (IN(8)) for (int rep_ = 0; rep_ < NREP(8); ++rep_) {
        pg8::Gemm g{MRG, WOT, NLAT, DM, DM}; pg8::StaticOrder S; S.init(NLAT, DM, G, (int)blockIdx.x); pg8::EpiX1 E{X1, x_in, MOD};
        pg8::gemm_phase<pg8::EpiX1, pg8::StaticOrder, true, true>(lds, g, S, E);
        if (BOTH(8) || rep_ + 1 < NREP(8)) GRID_BAR();
    }
    if (IN(9)) for (int rep_ = 0; rep_ < NREP(9); ++rep_) { p9_phase(lds, wave, lane, G, X1, MOD, norm2_g, SKW, router_b, cnt, XG8, RE, RR, RG); if (BOTH(9) || rep_ + 1 < NREP(9)) GRID_BAR(); }
    if (IN(10)) for (int rep_ = 0; rep_ < NREP(10); ++rep_) {
        moe_prefix(pref, cnt, tid);
        pg8::Gemm g{(const bf16*)XG8, (const bf16*)W1T8, 0, 0, DM}; pg8::MoeOrder S{pref, 16, G, (int)blockIdx.x, 1}; pg8::EpiSwiglu8 E{ACT8, exp_b1};
        pg8::gemm_phase8<pg8::EpiSwiglu8, pg8::MoeOrder, true, true, true>(lds, g, S, E);
        if (BOTH(10) || rep_ + 1 < NREP(10)) GRID_BAR();
    }
    if (IN(11)) for (int rep_ = 0; rep_ < NREP(11); ++rep_) {
        moe_prefix(pref, cnt, tid);
        pg8::Gemm g{(const bf16*)ACT8, (const bf16*)W2T8, 0, 0, DEXP}; pg8::MoeOrder S{pref, 8, G, (int)blockIdx.x, 0}; pg8::EpiY2f8 E{Y2, exp_b2};
        pg8::gemm_phase8<pg8::EpiY2f8, pg8::MoeOrder, true, true, true>(lds, g, S, E);
        if (BOTH(11) || rep_ + 1 < NREP(11)) GRID_BAR();
    }
    if (IN(12)) for (int rep_ = 0; rep_ < NREP(12); ++rep_) { moe_prefix(pref, cnt, tid); p12_phase(pref, wave, lane, G, X1, MOD, Y2, RE, RR, RG, final_g, args.out); if (rep_ + 1 < NREP(12)) GRID_BAR(); }
#undef IN
#undef BOTH
}

extern "C" void kernel_launch(void* const* d_in, const int* in_sizes, int n_in, void* d_out, int out_size, void* d_ws, size_t ws_size, hipStream_t stream) {
    static int grid = 0;
    if (grid == 0) {
        if (n_in != 26 || out_size != NLAT * DM || ws_size < WS_END) { fprintf(stderr, "kernel_launch: unexpected shapes (n_in %d, out %d, ws %zu)\n", n_in, out_size, ws_size); grid = -1; return; }
        int dev = 0, cus = 0;
        if (hipGetDevice(&dev) != hipSuccess || hipDeviceGetAttribute(&cus, hipDeviceAttributeMultiprocessorCount, dev) != hipSuccess) { grid = -1; return; }
        if (hipFuncSetAttribute((const void*)mk_fwd, hipFuncAttributeMaxDynamicSharedMemorySize, LDS_BYTES) != hipSuccess) { fprintf(stderr, "kernel_launch: hipFuncSetAttribute failed\n"); grid = -1; return; }
        int per_cu = 0;
        if (hipOccupancyMaxActiveBlocksPerMultiprocessor(&per_cu, (const void*)mk_fwd, NTHR, LDS_BYTES) != hipSuccess || per_cu < 1) fprintf(stderr, "kernel_launch: occupancy query reports %d\n", per_cu);
        (void)hipGetLastError();
        grid = cus;
    }
    if (grid < 0) return;
    if (hipMemsetAsync((char*)d_ws + WS_CTL, 0, CTL_ZERO_BYTES, stream) != hipSuccess) return;
    Args a{};
    for (int i = 0; i < 26; ++i) a.in[i] = (const float*)d_in[i];
    a.out = (float*)d_out; a.ws = (unsigned char*)d_ws;
    for (int li = 0; li < N_LAUNCHES; ++li) {
        a.ph_lo = (N_LAUNCHES == 1) ? 0 : li; a.ph_hi = (N_LAUNCHES == 1) ? N_PHASES : li + 1;
        hipLaunchKernelGGL(mk_fwd, dim3(grid), dim3(NTHR), LDS_BYTES, stream, a);
        const hipError_t le = hipPeekAtLastError();
        if (le != hipSuccess) { fprintf(stderr, "kernel_launch: launch %d failed: %s\n", li, hipGetErrorName(le)); break; }
    }
}
```

```cpp
#include <hip/hip_runtime.h>
#include <cstdio>
#include <cstdint>
#ifndef MK_N_LAUNCHES
#define MK_N_LAUNCHES 1
#endif
namespace pg8 {
#define PG8_LAS __attribute__((address_space(3)))
typedef unsigned short bf16_t;
typedef short bf16x8 __attribute__((ext_vector_type(8)));
typedef float f32x4 __attribute__((ext_vector_type(4)));
typedef unsigned u32x4 __attribute__((ext_vector_type(4)));
typedef int i32x4 __attribute__((ext_vector_type(4)));
typedef int i32x8 __attribute__((ext_vector_type(8)));
constexpr int BM = 256, BK = 64, HALF = 128, HTB = HALF * BK * 2  , STAGE_BYTES = 8 * HTB, NXCD = 8, WGM = 8;

__host__ __device__ __forceinline__ int lds_byte(int r, int c) { const int st = (r >> 4) * 2 + (c >> 5), rr = r & 15, cc = c & 31, ob = rr * 64 + cc * 2; return st * 1024 + (ob ^ (((ob >> 9) & 1) << 5)); }
__host__ __device__ __forceinline__ void stage_rc(int b, int& R, int& C) { const int st = b / 1024, sb = b % 1024, swz = sb ^ (((sb >> 9) & 1) << 5); R = (st >> 1) * 16 + swz / 64; C = (st & 1) * 32 + (swz % 64) / 2; }
__host__ __device__ __forceinline__ int perm32(int rho) { const int n = rho >> 4, i = rho & 15; return 8 * (i >> 2) + 4 * n + (i & 3); }

struct Unit { int pm, pn, po, hf; };
struct Gemm { const bf16_t* A; const bf16_t* Bt; int M, N, K; };

struct StaticOrder {
    int nM, nN, nwg, G, c;
    __host__ __device__ void init(int M, int N, int G_, int c_) { nM = M / BM; nN = N / BM; nwg = nM * nN; G = G_; c = c_; }
    __host__ __device__ bool next(int i, Unit& u) const {
        const long L = (long)i * G + c; if (L >= nwg) return false;
        int wgid = (int)L; { const int q = nwg / NXCD, r = nwg % NXCD, xcd = wgid % NXCD, off = wgid / NXCD; wgid = (xcd < r ? xcd * (q + 1) : r * (q + 1) + (xcd - r) * q) + off; }
        const int nig = WGM * nN, gid = wgid / nig, fm = gid * WGM, gsz = (nM - fm) < WGM ? (nM - fm) : WGM;
        u.pm = fm + ((wgid % nig) % gsz); u.pn = (wgid % nig) / gsz; u.po = u.pm; u.hf = 0; return true;
    }
    __device__ __forceinline__ void a_ready(const Unit&) const {}
    __device__ __forceinline__ void done(const Unit&) const {}
};
struct DynOrder {
    unsigned* q; PG8_LAS int* slot; int xcd, nN, ctx8;
    __device__ __forceinline__ bool next(int i, Unit& u) const {
        if (threadIdx.x == 0) { int id = -1;
            unsigned v = __hip_atomic_fetch_add(q + 64 * xcd, 1u, __ATOMIC_RELAXED, __HIP_MEMORY_SCOPE_AGENT);
            const unsigned per = (unsigned)(4 * nN + ctx8);
            if (v < per) id = xcd * (int)per + (int)v;
            else {
#pragma unroll 1
                for (int k = 1; k < 8 && id < 0; ++k) { const int x = (xcd + k) & 7;
                    if (__hip_atomic_load(q + 64 * x, __ATOMIC_RELAXED, __HIP_MEMORY_SCOPE_AGENT) < per) { v = __hip_atomic_fetch_add(q + 64 * x, 1u, __ATOMIC_RELAXED, __HIP_MEMORY_SCOPE_AGENT); if (v < per) id = x * (int)per + (int)v; } } }
            slot[i & 1] = id; asm volatile("s_waitcnt lgkmcnt(0)" ::: "memory"); }
        asm volatile("" ::: "memory"); __builtin_amdgcn_s_barrier(); asm volatile("" ::: "memory");
        const int id = slot[i & 1]; if (id < 0) return false;
        const int per = 4 * nN + ctx8, nl = 4 * nN, x = id / per, v = id - x * per;
        if (v < nl) { const int wgid = x * nl + v, nig = WGM * nN, gid = wgid / nig; u.pm = gid * WGM + ((wgid % nig) % WGM); u.pn = (wgid % nig) / WGM; }
        else { const int j = x * 8 + (v - nl); u.pm = 32 + (j & 3); u.pn = j >> 2; }
        u.po = u.pm; u.hf = 0; return true;
    }
    __device__ __forceinline__ void a_ready(const Unit&) const {}
    __device__ __forceinline__ void done(const Unit&) const {}
};
struct MoeOrder {
    const PG8_LAS int* pref; int nN, G, c, a_sparse;
    __device__ __forceinline__ bool next(int i, Unit& u) const {
        const int L = i * G + c, total = pref[32]; if (L >= total * nN) return false;
        const int mt = L / nN, nt = L - mt * nN; int e = 0;
        for (int k = 1; k < 32; ++k) e += (pref[k] <= mt) ? 1 : 0;
        u.pm = a_sparse ? e * 32 + (mt - pref[e]) : mt; u.pn = e * nN + nt; u.po = mt; u.hf = (pref[33 + e] - 256 * (mt - pref[e]) <= 128) ? 1 : 0; return true;
    }
    __device__ __forceinline__ void a_ready(const Unit&) const {}
    __device__ __forceinline__ void done(const Unit&) const {}
};

__device__ __forceinline__ unsigned cvt_pk_bf16(float lo, float hi) { unsigned r; asm volatile("v_cvt_pk_bf16_f32 %0, %1, %2" : "=v"(r) : "v"(lo), "v"(hi)); return r; }
__device__ __forceinline__ float bf_lo(unsigned w) { return __uint_as_float(w << 16); }
__device__ __forceinline__ float bf_hi(unsigned w) { return __uint_as_float(w & 0xffff0000u); }
__device__ __forceinline__ unsigned pk4_fp8(float a, float b, float c, float d) {
    a = fminf(fmaxf(a, -448.f), 448.f); b = fminf(fmaxf(b, -448.f), 448.f); c = fminf(fmaxf(c, -448.f), 448.f); d = fminf(fmaxf(d, -448.f), 448.f);
    int p = __builtin_amdgcn_cvt_pk_fp8_f32(a, b, 0, false); p = __builtin_amdgcn_cvt_pk_fp8_f32(c, d, p, true); return (unsigned)p; }
constexpr float F8_SA = 16.0f, F8_SW = 512.0f, F8_SC = 4.0f;
__device__ __forceinline__ float sigmoidf_(float x) { return __builtin_amdgcn_rcpf(1.0f + __expf(-x)); }

struct EpiBf16 {
    static constexpr bool PERM = true, AFTER_DRAIN = false;
    bf16_t* O; int ldc; const float* bias; int ncolt;
    __device__ __forceinline__ void operator()(const f32x4 (&acc)[2][2][4][2], const Unit& u, int wr, int wc, int fr, int fq) const {
        const int row0 = u.po * BM + wr * 64 + fr; const int colt = (u.pn % ncolt) * BM;
        const int col0 = colt + wc * 32 + 8 * fq, bcol0 = u.pn * BM + wc * 32 + 8 * fq;
        f32x4 bv[2][2];
#pragma unroll
        for (int bj = 0; bj < 2; ++bj)
#pragma unroll
            for (int n = 0; n < 2; ++n) bv[bj][n] = bias ? *(const f32x4*)(bias + bcol0 + bj * HALF + 4 * n) : (f32x4){0.f, 0.f, 0.f, 0.f};
#pragma unroll
        for (int ai = 0; ai < 2; ++ai)
#pragma unroll
            for (int m = 0; m < 4; ++m) { bf16_t* rowp = O + (size_t)(row0 + ai * HALF + m * 16) * ldc + col0;
#pragma unroll
                for (int bj = 0; bj < 2; ++bj) { const f32x4 v0 = acc[ai][bj][m][0] + bv[bj][0], v1 = acc[ai][bj][m][1] + bv[bj][1];
                    u32x4 w; w.x = cvt_pk_bf16(v0[0], v0[1]); w.y = cvt_pk_bf16(v0[2], v0[3]); w.z = cvt_pk_bf16(v1[0], v1[1]); w.w = cvt_pk_bf16(v1[2], v1[3]);
                    __builtin_nontemporal_store(w, (u32x4*)(rowp + bj * HALF)); } }
    }
};
struct EpiSwiglu8 {
    static constexpr bool PERM = true, AFTER_DRAIN = false;
    unsigned char* O; const float* b1;
    __device__ __forceinline__ void operator()(const f32x4 (&acc)[2][2][4][2], const Unit& u, int wr, int wc, int fr, int fq) const {
        const int e = u.pn >> 4, nt = u.pn & 15; const int row0 = u.po * BM + wr * 64 + fr, j0 = nt * 128 + wc * 32 + 8 * fq;
        const float* bg = b1 + (size_t)e * 4096 + j0; const float* bl = bg + 2048; constexpr float us = 1.0f / (F8_SA * F8_SW);
#pragma unroll
        for (int ai = 0; ai < 2; ++ai)
#pragma unroll
            for (int m = 0; m < 4; ++m) { const size_t row = (size_t)(row0 + ai * HALF + m * 16);
                asm volatile("" ::: "memory");
                unsigned w[2];
#pragma unroll
                for (int n = 0; n < 2; ++n) { const f32x4 gv = acc[ai][0][m][n] * us + *(const f32x4*)(bg + 4 * n), lv = acc[ai][1][m][n] * us + *(const f32x4*)(bl + 4 * n);
                    float o[4];
#pragma unroll
                    for (int i = 0; i < 4; ++i) { const float ga = fminf(gv[i], 7.0f), la = fminf(fmaxf(lv[i], -7.0f), 7.0f); o[i] = ga * sigmoidf_(1.702f * ga) * (la + 1.0f) * F8_SC; }
                    w[n] = pk4_fp8(o[0], o[1], o[2], o[3]); }
                typedef unsigned u32x2 __attribute__((ext_vector_type(2))); const u32x2 ww = {w[0], w[1]};
                *(u32x2*)(O + row * 2048 + j0) = ww; }
    }
};
struct EpiY2f8 {
    static constexpr bool PERM = true, AFTER_DRAIN = false;
    bf16_t* O; const float* bias;
    __device__ __forceinline__ void operator()(const f32x4 (&acc)[2][2][4][2], const Unit& u, int wr, int wc, int fr, int fq) const {
        const int row0 = u.po * BM + wr * 64 + fr; const int col0 = (u.pn & 7) * BM + wc * 32 + 8 * fq, bcol0 = u.pn * BM + wc * 32 + 8 * fq; constexpr float us = 1.0f / (F8_SC * F8_SW);
        f32x4 bv[2][2];
#pragma unroll
        for (int bj = 0; bj < 2; ++bj)
#pragma unroll
            for (int n = 0; n < 2; ++n) bv[bj][n] = *(const f32x4*)(bias + bcol0 + bj * HALF + 4 * n);
#pragma unroll
        for (int ai = 0; ai < 2; ++ai)
#pragma unroll
            for (int m = 0; m < 4; ++m) { bf16_t* rowp = O + (size_t)(row0 + ai * HALF + m * 16) * 2048 + col0;
#pragma unroll
                for (int bj = 0; bj < 2; ++bj) { const f32x4 v0 = acc[ai][bj][m][0] * us + bv[bj][0], v1 = acc[ai][bj][m][1] * us + bv[bj][1];
                    u32x4 w; w.x = cvt_pk_bf16(v0[0], v0[1]); w.y = cvt_pk_bf16(v0[2], v0[3]); w.z = cvt_pk_bf16(v1[0], v1[1]); w.w = cvt_pk_bf16(v1[2], v1[3]);
                    __builtin_nontemporal_store(w, (u32x4*)(rowp + bj * HALF)); } }
    }
};
struct EpiGate8 {
    static constexpr bool PERM = true, AFTER_DRAIN = false;
    bf16_t* O; int ldc;
    __device__ __forceinline__ void operator()(const f32x4 (&acc)[2][2][4][2], const Unit& u, int wr, int wc, int fr, int fq) const {
        const int row0 = u.po * BM + wr * 64 + fr, col0 = u.pn * BM + wc * 32 + 8 * fq; constexpr float us = 1.0f / (F8_SA * F8_SW);
#pragma unroll
        for (int ai = 0; ai < 2; ++ai)
#pragma unroll
            for (int m = 0; m < 4; ++m) { bf16_t* rowp = O + (size_t)(row0 + ai * HALF + m * 16) * ldc + col0;
#pragma unroll
                for (int bj = 0; bj < 2; ++bj) { const f32x4 v0 = acc[ai][bj][m][0] * us, v1 = acc[ai][bj][m][1] * us;
                    u32x4 w; w.x = cvt_pk_bf16(v0[0], v0[1]); w.y = cvt_pk_bf16(v0[2], v0[3]); w.z = cvt_pk_bf16(v1[0], v1[1]); w.w = cvt_pk_bf16(v1[2], v1[3]);
                    __builtin_nontemporal_store(w, (u32x4*)(rowp + bj * HALF)); } }
    }
};
struct EpiF32 {
    static constexpr bool PERM = false, AFTER_DRAIN = false;
    float* C; int ldc;
    __device__ __forceinline__ void operator()(const f32x4 (&acc)[2][2][4][2], const Unit& u, int wr, int wc, int fr, int fq) const {
        const int row0 = u.po * BM + wr * 64 + fr, col0 = u.pn * BM + wc * 32 + 4 * fq;
#pragma unroll
        for (int ai = 0; ai < 2; ++ai)
#pragma unroll
            for (int m = 0; m < 4; ++m) { float* rowp = C + (size_t)(row0 + ai * HALF + m * 16) * ldc + col0;
#pragma unroll
                for (int bj = 0; bj < 2; ++bj)
#pragma unroll
                    for (int n = 0; n < 2; ++n) *(f32x4*)(rowp + bj * HALF + n * 16) = acc[ai][bj][m][n]; }
    }
};
struct EpiMerge {
    static constexpr bool PERM = true, AFTER_DRAIN = false;
    bf16_t* O; const bf16_t* Z; int ldz, ga_off, gb_off; const float* YB;
    __device__ __forceinline__ void operator()(const f32x4 (&acc)[2][2][4][2], const Unit& u, int wr, int wc, int fr, int fq) const {
        const int row0 = u.po * BM + wr * 64 + fr, col0 = u.pn * BM + wc * 32 + 8 * fq;
#pragma unroll
        for (int ai = 0; ai < 2; ++ai)
#pragma unroll
            for (int m = 0; m < 4; ++m) { const size_t row = (size_t)(row0 + ai * HALF + m * 16);
#pragma unroll
                for (int bj = 0; bj < 2; ++bj) { const int col = col0 + bj * HALF;
                    const u32x4 ga = *(const u32x4*)(Z + row * ldz + ga_off + col), gb = *(const u32x4*)(Z + row * ldz + gb_off + col);
                    const f32x4 y0 = *(const f32x4*)(YB + row * 2048 + col), y1 = *(const f32x4*)(YB + row * 2048 + col + 4);
                    const f32x4 a0 = acc[ai][bj][m][0], a1 = acc[ai][bj][m][1];
                    float o[8];
                    o[0] = sigmoidf_(bf_lo(ga.x)) * a0[0] + sigmoidf_(bf_lo(gb.x)) * y0[0]; o[1] = sigmoidf_(bf_hi(ga.x)) * a0[1] + sigmoidf_(bf_hi(gb.x)) * y0[1];
                    o[2] = sigmoidf_(bf_lo(ga.y)) * a0[2] + sigmoidf_(bf_lo(gb.y)) * y0[2]; o[3] = sigmoidf_(bf_hi(ga.y)) * a0[3] + sigmoidf_(bf_hi(gb.y)) * y0[3];
                    o[4] = sigmoidf_(bf_lo(ga.z)) * a1[0] + sigmoidf_(bf_lo(gb.z)) * y1[0]; o[5] = sigmoidf_(bf_hi(ga.z)) * a1[1] + sigmoidf_(bf_hi(gb.z)) * y1[1];
                    o[6] = sigmoidf_(bf_lo(ga.w)) * a1[2] + sigmoidf_(bf_lo(gb.w)) * y1[2]; o[7] = sigmoidf_(bf_hi(ga.w)) * a1[3] + sigmoidf_(bf_hi(gb.w)) * y1[3];
                    u32x4 w; w.x = cvt_pk_bf16(o[0], o[1]); w.y = cvt_pk_bf16(o[2], o[3]); w.z = cvt_pk_bf16(o[4], o[5]); w.w = cvt_pk_bf16(o[6], o[7]);
                    *(u32x4*)(O + row * 2048 + col) = w; } }
    }
};
struct EpiX1 {
    static constexpr bool PERM = false, AFTER_DRAIN = false;
    float* X1; const float* X; const float* mod;
    __device__ __forceinline__ void operator()(const f32x4 (&acc)[2][2][4][2], const Unit& u, int wr, int wc, int fr, int fq) const {
        const int row0 = u.po * BM + wr * 64 + fr, col0 = u.pn * BM + wc * 32 + 4 * fq;
        const float* mg = mod + (size_t)((u.po * BM) >> 11) * 12288 + 2 * 2048;
#pragma unroll
        for (int bj = 0; bj < 2; ++bj)
#pragma unroll
            for (int n = 0; n < 2; ++n) { const int col = col0 + bj * HALF + n * 16; const f32x4 g = *(const f32x4*)(mg + col);
#pragma unroll
                for (int ai = 0; ai < 2; ++ai)
#pragma unroll
                    for (int m = 0; m < 4; ++m) { const size_t off = (size_t)(row0 + ai * HALF + m * 16) * 2048 + col;
                        *(f32x4*)(X1 + off) = *(const f32x4*)(X + off) + g * acc[ai][bj][m][n]; } }
    }
};
struct EpiSwiglu {
    static constexpr bool PERM = true, AFTER_DRAIN = false;
    bf16_t* O; const float* b1;
    __device__ __forceinline__ void operator()(const f32x4 (&acc)[2][2][4][2], const Unit& u, int wr, int wc, int fr, int fq) const {
        const int e = u.pn >> 4, nt = u.pn & 15; const int row0 = u.po * BM + wr * 64 + fr, j0 = nt * 128 + wc * 32 + 8 * fq;
        const float* bg = b1 + (size_t)e * 4096 + j0; const float* bl = bg + 2048;
#pragma unroll
        for (int ai = 0; ai < 2; ++ai)
#pragma unroll
            for (int m = 0; m < 4; ++m) { const size_t row = (size_t)(row0 + ai * HALF + m * 16);
                asm volatile("" ::: "memory");
#pragma unroll
                for (int n = 0; n < 2; ++n) { const f32x4 gv = acc[ai][0][m][n] + *(const f32x4*)(bg + 4 * n), lv = acc[ai][1][m][n] + *(const f32x4*)(bl + 4 * n);
                    float o[4];
#pragma unroll
                    for (int i = 0; i < 4; ++i) { const float ga = fminf(gv[i], 7.0f), la = fminf(fmaxf(lv[i], -7.0f), 7.0f); o[i] = ga * sigmoidf_(1.702f * ga) * (la + 1.0f); }
                    typedef unsigned u32x2 __attribute__((ext_vector_type(2))); u32x2 w; w.x = cvt_pk_bf16(o[0], o[1]); w.y = cvt_pk_bf16(o[2], o[3]);
                    *(u32x2*)(O + row * 2048 + j0 + 4 * n) = w; } }
    }
};

template <class Epi, class Sched, bool ALIGN_EPI = false, bool SP2 = false, bool HALFSKIP = false>
__device__ __forceinline__ void gemm_phase(PG8_LAS unsigned char* lds, const Gemm g, const Sched& S, const Epi& E) {
    const int tid = threadIdx.x, wid = __builtin_amdgcn_readfirstlane(tid >> 6), lane = tid & 63, wr = wid >> 2, wc = wid & 3, fr = lane & 15, fq = lane >> 4;
    const int K = g.K, nt = K / BK;
    unsigned voffA[2], voffB[2];
#pragma unroll
    for (int i = 0; i < 2; ++i) { int R, C; stage_rc(tid * 16 + i * 8192, R, C); const int Rb = Epi::PERM ? ((R & ~31) + perm32(R & 31)) : R;
        voffA[i] = (unsigned)(R * K + C) * 2u; voffB[i] = (unsigned)(Rb * K + C) * 2u; }
    const size_t kstep = (size_t)(BK * 2);
    const size_t hstep = (size_t)HALF * K * 2;
    const size_t tstep = 2 * hstep;
    const unsigned ldsw = (unsigned)wid * 1024u;
    const int aoff = lds_byte(wr * 64 + fr, fq * 8), boff = lds_byte(wc * 32 + fr, fq * 8);
#define PG8_SA(b, h) (((b) * 2 + (h)) * HTB)
#define PG8_SB(b, h) ((4 + (b) * 2 + (h)) * HTB)
#define PG8_STAGE(bufoff, gbase, voff) do { _Pragma("unroll") for (int _i = 0; _i < 2; ++_i) \
        __builtin_amdgcn_global_load_lds((const unsigned*)((const char*)(gbase) + (voff)[_i]), (PG8_LAS unsigned*)(lds + (bufoff) + ldsw + _i * 8192), 16, 0, 0); } while (0)
#define PG8_LDA(dst, b, h) do { _Pragma("unroll") for (int m = 0; m < 4; ++m) _Pragma("unroll") for (int k = 0; k < 2; ++k) dst[m][k] = *(const PG8_LAS bf16x8*)(lds + PG8_SA(b, h) + aoff + m * 2048 + k * 1024); } while (0)
#define PG8_LDB(dst, b, h) do { _Pragma("unroll") for (int n = 0; n < 2; ++n) _Pragma("unroll") for (int k = 0; k < 2; ++k) dst[n][k] = *(const PG8_LAS bf16x8*)(lds + PG8_SB(b, h) + boff + n * 2048 + k * 1024); } while (0)
#define PG8_MMA(ai, bj, At, Bt) do { __builtin_amdgcn_s_setprio(1); _Pragma("unroll") for (int m = 0; m < 4; ++m) _Pragma("unroll") for (int n = 0; n < 2; ++n) _Pragma("unroll") for (int k = 0; k < 2; ++k) \
        acc[ai][bj][m][n] = __builtin_amdgcn_mfma_f32_16x16x32_bf16(Bt[n][k], At[m][k], acc[ai][bj][m][n], 0, 0, 0); __builtin_amdgcn_s_setprio(0); } while (0)
#define PG8_WAIT_V(n) asm volatile("s_waitcnt vmcnt(" #n ")" ::: "memory")
#define PG8_WAIT_L(n) asm volatile("s_waitcnt lgkmcnt(" #n ")" ::: "memory")
#define PG8_BAR __builtin_amdgcn_s_barrier()
#define PG8_SCHED __builtin_amdgcn_sched_barrier(0)
    Unit cur, nxt; int ui = 0;
    if (!S.next(0, cur)) return;
    f32x4 acc[2][2][4][2];
#pragma unroll
    for (int a = 0; a < 2; ++a)
#pragma unroll
        for (int b = 0; b < 2; ++b)
#pragma unroll
            for (int m = 0; m < 4; ++m)
#pragma unroll
                for (int n = 0; n < 2; ++n) acc[a][b][m][n] = (f32x4){0.f, 0.f, 0.f, 0.f};
    bf16x8 At[4][2], B0[2][2], B1[2][2];
    const char* cA = (const char*)g.A + (size_t)cur.pm * tstep; const char* cB = (const char*)g.Bt + (size_t)cur.pn * tstep;
    S.a_ready(cur);
    if constexpr (SP2) {
        PG8_STAGE(PG8_SB(0, 0), cB, voffB); PG8_STAGE(PG8_SB(0, 1), cB + hstep, voffB); PG8_STAGE(PG8_SA(0, 0), cA, voffA); PG8_STAGE(PG8_SA(0, 1), cA + hstep, voffA);
        if (wr == 1) PG8_BAR;
        PG8_WAIT_V(2); PG8_BAR;
        PG8_STAGE(PG8_SB(1, 0), cB + kstep, voffB); PG8_STAGE(PG8_SA(1, 0), cA + kstep, voffA); PG8_STAGE(PG8_SB(1, 1), cB + hstep + kstep, voffB);
        PG8_WAIT_V(6); PG8_BAR;
    } else {
        PG8_STAGE(PG8_SB(0, 0), cB, voffB); PG8_STAGE(PG8_SA(0, 0), cA, voffA); PG8_STAGE(PG8_SB(0, 1), cB + hstep, voffB); PG8_STAGE(PG8_SA(0, 1), cA + hstep, voffA);
        if (wr == 1) PG8_BAR;
        PG8_WAIT_V(4); PG8_BAR;
        PG8_STAGE(PG8_SB(1, 0), cB + kstep, voffB); PG8_STAGE(PG8_SA(1, 0), cA + kstep, voffA); PG8_STAGE(PG8_SB(1, 1), cB + hstep + kstep, voffB);
        PG8_WAIT_V(6); PG8_BAR;
    }
    for (;;) {
        const bool has_next = S.next(ui + 1, nxt);
        const char* nA = has_next ? (const char*)g.A + (size_t)nxt.pm * tstep : cA; const char* nB = has_next ? (const char*)g.Bt + (size_t)nxt.pn * tstep : cB;
        for (int t = 0; t < nt; t += 2) {
            const bool last = (t == nt - 2);
            const char* a1 = cA + (size_t)(t + 1) * kstep;
            const char* a2 = last ? nA : cA + (size_t)(t + 2) * kstep; const char* b2 = last ? nB : cB + (size_t)(t + 2) * kstep;
            const char* a3 = a2 + kstep; const char* b3 = b2 + kstep;
            if (last && has_next) S.a_ready(nxt);
            if constexpr (SP2) {
            PG8_LDB(B0, 0, 0); PG8_LDB(B1, 0, 1); PG8_SCHED; PG8_LDA(At, 0, 0); PG8_STAGE(PG8_SA(1, 1), a1 + hstep, voffA);
            PG8_WAIT_V(8); PG8_WAIT_L(0); PG8_BAR; PG8_MMA(0, 0, At, B0); PG8_MMA(0, 1, At, B1); PG8_BAR; PG8_SCHED;
            PG8_LDA(At, 0, 1); PG8_STAGE(PG8_SB(0, 0), b2, voffB); PG8_STAGE(PG8_SB(0, 1), b2 + hstep, voffB); PG8_STAGE(PG8_SA(0, 0), a2, voffA);
            PG8_WAIT_V(8); PG8_WAIT_L(0); PG8_BAR; if (!(HALFSKIP && cur.hf)) { PG8_MMA(1, 0, At, B0); PG8_MMA(1, 1, At, B1); } PG8_BAR; PG8_SCHED;
            PG8_LDB(B0, 1, 0); PG8_LDB(B1, 1, 1); PG8_SCHED; PG8_LDA(At, 1, 0); PG8_STAGE(PG8_SA(0, 1), a2 + hstep, voffA);
            PG8_WAIT_V(8); PG8_WAIT_L(0); PG8_BAR; PG8_MMA(0, 0, At, B0); PG8_MMA(0, 1, At, B1); PG8_BAR; PG8_SCHED;
            PG8_LDA(At, 1, 1); PG8_STAGE(PG8_SB(1, 0), b3, voffB); PG8_STAGE(PG8_SB(1, 1), b3 + hstep, voffB); PG8_STAGE(PG8_SA(1, 0), a3, voffA);
            PG8_WAIT_V(8); PG8_WAIT_L(0); PG8_BAR; if (!(HALFSKIP && cur.hf)) { PG8_MMA(1, 0, At, B0); PG8_MMA(1, 1, At, B1); } PG8_BAR; PG8_SCHED;
            } else {
            PG8_LDB(B0, 0, 0); PG8_SCHED; PG8_LDA(At, 0, 0); PG8_STAGE(PG8_SA(1, 1), a1 + hstep, voffA);
            PG8_WAIT_L(8); PG8_BAR; PG8_WAIT_L(0); PG8_MMA(0, 0, At, B0); PG8_BAR; PG8_SCHED;
            PG8_LDB(B1, 0, 1); PG8_STAGE(PG8_SB(0, 0), b2, voffB);
            PG8_BAR; PG8_WAIT_L(0); PG8_MMA(0, 1, At, B1); PG8_BAR;
            PG8_LDA(At, 0, 1); PG8_STAGE(PG8_SA(0, 0), a2, voffA);
            PG8_BAR; PG8_WAIT_L(0); PG8_MMA(1, 0, At, B0); PG8_BAR; PG8_SCHED;
            PG8_STAGE(PG8_SB(0, 1), b2 + hstep, voffB);
            PG8_WAIT_V(6); PG8_BAR; PG8_MMA(1, 1, At, B1); PG8_BAR;
            PG8_LDB(B0, 1, 0); PG8_SCHED; PG8_LDA(At, 1, 0); PG8_STAGE(PG8_SA(0, 1), a2 + hstep, voffA);
            PG8_WAIT_L(8); PG8_BAR; PG8_WAIT_L(0); PG8_MMA(0, 0, At, B0); PG8_BAR; PG8_SCHED;
            PG8_LDB(B1, 1, 1); PG8_STAGE(PG8_SB(1, 0), b3, voffB);
            PG8_BAR; PG8_WAIT_L(0); PG8_MMA(0, 1, At, B1); PG8_BAR;
            PG8_LDA(At, 1, 1); PG8_STAGE(PG8_SA(1, 0), a3, voffA);
            PG8_BAR; PG8_WAIT_L(0); PG8_MMA(1, 0, At, B0); PG8_BAR; PG8_SCHED;
            PG8_STAGE(PG8_SB(1, 1), b3 + hstep, voffB);
            PG8_WAIT_V(6); PG8_BAR; PG8_MMA(1, 1, At, B1); PG8_BAR;
            }
        }
        if constexpr (ALIGN_EPI) { if (wr == 0) PG8_BAR; }
        if constexpr (!Epi::AFTER_DRAIN) { E(acc, cur, wr, wc, fr, fq); S.done(cur); }
        if (!has_next) break;
#pragma unroll
        for (int a = 0; a < 2; ++a)
#pragma unroll
            for (int b = 0; b < 2; ++b)
#pragma unroll
                for (int m = 0; m < 4; ++m)
#pragma unroll
                    for (int n = 0; n < 2; ++n) acc[a][b][m][n] = (f32x4){0.f, 0.f, 0.f, 0.f};
        cur = nxt; cA = nA; cB = nB; ++ui;
        if constexpr (ALIGN_EPI) { if (wr == 1) PG8_BAR; }
    }
    PG8_WAIT_V(0);
    if constexpr (!ALIGN_EPI) { if (wr == 0) PG8_BAR; }
    PG8_BAR;
    if constexpr (Epi::AFTER_DRAIN) { E.fused(acc, cur, wr, wc, fr, fq, lds, wid, lane); S.done(cur); }
#undef PG8_SA
#undef PG8_SB
#undef PG8_STAGE
#undef PG8_LDA
#undef PG8_LDB
#undef PG8_MMA
#undef PG8_WAIT_V
#undef PG8_WAIT_L
#undef PG8_BAR
#undef PG8_SCHED
}
template <class Epi, class Sched, bool ALIGN_EPI = false, bool SP2 = false, bool HALFSKIP = false>
__device__ __forceinline__ void gemm_phase8(PG8_LAS unsigned char* lds, const Gemm g, const Sched& S, const Epi& E) {
    const int tid = threadIdx.x, wid = __builtin_amdgcn_readfirstlane(tid >> 6), lane = tid & 63, wr = wid >> 2, wc = wid & 3, fr = lane & 15, fq = lane >> 4;
    const int K = g.K, nt = K / 128;
    unsigned voffA[2], voffB[2];
#pragma unroll
    for (int i = 0; i < 2; ++i) { int R, C; stage_rc(tid * 16 + i * 8192, R, C); const int Rb = Epi::PERM ? ((R & ~31) + perm32(R & 31)) : R;
        voffA[i] = (unsigned)(R * K + 2 * C); voffB[i] = (unsigned)(Rb * K + 2 * C); }
    const size_t kstep = (size_t)(BK * 2);
    const size_t hstep = (size_t)HALF * K;
    const size_t tstep = 2 * hstep;
    const unsigned ldsw = (unsigned)wid * 1024u;
    const int aoff = lds_byte(wr * 64 + fr, fq * 16), boff = lds_byte(wc * 32 + fr, fq * 16);
#define PG8_SA(b, h) (((b) * 2 + (h)) * HTB)
#define PG8_SB(b, h) ((4 + (b) * 2 + (h)) * HTB)
#define PG8_STAGE(bufoff, gbase, voff) do { _Pragma("unroll") for (int _i = 0; _i < 2; ++_i) \
        __builtin_amdgcn_global_load_lds((const unsigned*)((const char*)(gbase) + (voff)[_i]), (PG8_LAS unsigned*)(lds + (bufoff) + ldsw + _i * 8192), 16, 0, 0); } while (0)
#define PG8_LDA(dst, b, h) do { _Pragma("unroll") for (int m = 0; m < 4; ++m) { const i32x4 lo_ = *(const PG8_LAS i32x4*)(lds + PG8_SA(b, h) + aoff + m * 2048), hi_ = *(const PG8_LAS i32x4*)(lds + PG8_SA(b, h) + aoff + m * 2048 + 16); dst[m] = __builtin_shufflevector(lo_, hi_, 0, 1, 2, 3, 4, 5, 6, 7); } } while (0)
#define PG8_LDB(dst, b, h) do { _Pragma("unroll") for (int n = 0; n < 2; ++n) { const i32x4 lo_ = *(const PG8_LAS i32x4*)(lds + PG8_SB(b, h) + boff + n * 2048), hi_ = *(const PG8_LAS i32x4*)(lds + PG8_SB(b, h) + boff + n * 2048 + 16); dst[n] = __builtin_shufflevector(lo_, hi_, 0, 1, 2, 3, 4, 5, 6, 7); } } while (0)
#define PG8_MMA(ai, bj, At, Bt) do { __builtin_amdgcn_s_setprio(1); _Pragma("unroll") for (int m = 0; m < 4; ++m) _Pragma("unroll") for (int n = 0; n < 2; ++n) \
        asm volatile("v_mfma_scale_f32_16x16x128_f8f6f4 %0, %1, %2, %0, %3, %3 op_sel_hi:[0,0,0]" : "+v"(acc[ai][bj][m][n]) : "v"(Bt[n]), "v"(At[m]), "v"(sc127)); __builtin_amdgcn_s_setprio(0); } while (0)
#define PG8_WAIT_V(n) asm volatile("s_waitcnt vmcnt(" #n ")" ::: "memory")
#define PG8_WAIT_L(n) asm volatile("s_waitcnt lgkmcnt(" #n ")" ::: "memory")
#define PG8_BAR __builtin_amdgcn_s_barrier()
#define PG8_SCHED __builtin_amdgcn_sched_barrier(0)
    Unit cur, nxt; int ui = 0;
    if (!S.next(0, cur)) return;
    f32x4 acc[2][2][4][2];
#pragma unroll
    for (int a = 0; a < 2; ++a)
#pragma unroll
        for (int b = 0; b < 2; ++b)
#pragma unroll
            for (int m = 0; m < 4; ++m)
#pragma unroll
                for (int n = 0; n < 2; ++n) acc[a][b][m][n] = (f32x4){0.f, 0.f, 0.f, 0.f};
    i32x8 At[4], B0[2], B1[2]; const int sc127 = 127;
    const char* cA = (const char*)g.A + (size_t)cur.pm * tstep; const char* cB = (const char*)g.Bt + (size_t)cur.pn * tstep;
    S.a_ready(cur);
    if constexpr (SP2) {
        PG8_STAGE(PG8_SB(0, 0), cB, voffB); PG8_STAGE(PG8_SB(0, 1), cB + hstep, voffB); PG8_STAGE(PG8_SA(0, 0), cA, voffA); PG8_STAGE(PG8_SA(0, 1), cA + hstep, voffA);
        if (wr == 1) PG8_BAR;
        PG8_WAIT_V(2); PG8_BAR;
        PG8_STAGE(PG8_SB(1, 0), cB + kstep, voffB); PG8_STAGE(PG8_SA(1, 0), cA + kstep, voffA); PG8_STAGE(PG8_SB(1, 1), cB + hstep + kstep, voffB);
        PG8_WAIT_V(6); PG8_BAR;
    } else {
        PG8_STAGE(PG8_SB(0, 0), cB, voffB); PG8_STAGE(PG8_SA(0, 0), cA, voffA); PG8_STAGE(PG8_SB(0, 1), cB + hstep, voffB); PG8_STAGE(PG8_SA(0, 1), cA + hstep, voffA);
        if (wr == 1) PG8_BAR;
        PG8_WAIT_V(4); PG8_BAR;
        PG8_STAGE(PG8_SB(1, 0), cB + kstep, voffB); PG8_STAGE(PG8_SA(1, 0), cA + kstep, voffA); PG8_STAGE(PG8_SB(1, 1), cB + hstep + kstep, voffB);
        PG8_WAIT_V(6); PG8_BAR;
    }
    for (;;) {
        const bool has_next = S.next(ui + 1, nxt);
        const char* nA = has_next ? (const char*)g.A + (size_t)nxt.pm * tstep : cA; const char* nB = has_next ? (const char*)g.Bt + (size_t)nxt.pn * tstep : cB;
        for (int t = 0; t < nt; t += 2) {
            const bool last = (t == nt - 2);
            const char* a1 = cA + (size_t)(t + 1) * kstep;
            const char* a2 = last ? nA : cA + (size_t)(t + 2) * kstep; const char* b2 = last ? nB : cB + (size_t)(t + 2) * kstep;
            const char* a3 = a2 + kstep; const char* b3 = b2 + kstep;
            if (last && has_next) S.a_ready(nxt);
            if constexpr (SP2) {
            PG8_LDB(B0, 0, 0); PG8_LDB(B1, 0, 1); PG8_SCHED; PG8_LDA(At, 0, 0); PG8_STAGE(PG8_SA(1, 1), a1 + hstep, voffA);
            PG8_WAIT_V(8); PG8_WAIT_L(0); PG8_BAR; PG8_MMA(0, 0, At, B0); PG8_MMA(0, 1, At, B1); PG8_BAR; PG8_SCHED;
            PG8_LDA(At, 0, 1); PG8_STAGE(PG8_SB(0, 0), b2, voffB); PG8_STAGE(PG8_SB(0, 1), b2 + hstep, voffB); PG8_STAGE(PG8_SA(0, 0), a2, voffA);
            PG8_WAIT_V(8); PG8_WAIT_L(0); PG8_BAR; if (!(HALFSKIP && cur.hf)) { PG8_MMA(1, 0, At, B0); PG8_MMA(1, 1, At, B1); } PG8_BAR; PG8_SCHED;
            PG8_LDB(B0, 1, 0); PG8_LDB(B1, 1, 1); PG8_SCHED; PG8_LDA(At, 1, 0); PG8_STAGE(PG8_SA(0, 1), a2 + hstep, voffA);
            PG8_WAIT_V(8); PG8_WAIT_L(0); PG8_BAR; PG8_MMA(0, 0, At, B0); PG8_MMA(0, 1, At, B1); PG8_BAR; PG8_SCHED;
            PG8_LDA(At, 1, 1); PG8_STAGE(PG8_SB(1, 0), b3, voffB); PG8_STAGE(PG8_SB(1, 1), b3 + hstep, voffB); PG8_STAGE(PG8_SA(1, 0), a3, voffA);
            PG8_WAIT_V(8); PG8_WAIT_L(0); PG8_BAR; if (!(HALFSKIP && cur.hf)) { PG8_MMA(1, 0, At, B0); PG8_MMA(1, 1, At, B1); } PG8_BAR; PG8_SCHED;
            } else {
            PG8_LDB(B0, 0, 0); PG8_SCHED; PG8_LDA(At, 0, 0); PG8_STAGE(PG8_SA(1, 1), a1 + hstep, voffA);
            PG8_WAIT_L(8); PG8_BAR; PG8_WAIT_L(0); PG8_MMA(0, 0, At, B0); PG8_BAR; PG8_SCHED;
            PG8_LDB(B1, 0, 1); PG8_STAGE(PG8_SB(0, 0), b2, voffB);
            PG8_BAR; PG8_WAIT_L(0); PG8_MMA(0, 1, At, B1); PG8_BAR;
            PG8_LDA(At, 0, 1); PG8_STAGE(PG8_SA(0, 0), a2, voffA);
            PG8_BAR; PG8_WAIT_L(0); PG8_MMA(1, 0, At, B0); PG8_BAR; PG8_SCHED;
            PG8_STAGE(PG8_SB(0, 1), b2 + hstep, voffB);
            PG8_WAIT_V(6); PG8_BAR; PG8_MMA(1, 1, At, B1); PG8_BAR;
            PG8_LDB(B0, 1, 0); PG8_SCHED; PG8_LDA(At, 1, 0); PG8_STAGE(PG8_SA(0, 1), a2 + hstep, voffA);
            PG8_WAIT_L(8); PG8_BAR; PG8_WAIT_L(0); PG8_MMA(0, 0, At, B0); PG8_BAR; PG8_SCHED;
            PG8_LDB(B1, 1, 1); PG8_STAGE(PG8_SB(1, 0), b3, voffB);
            PG8_BAR; PG8_WAIT_L(0); PG8_MMA(0, 1, At, B1); PG8_BAR;
            PG8_LDA(At, 1, 1); PG8_STAGE(PG8_SA(1, 0), a3, voffA);
            PG8_BAR; PG8_WAIT_L(0); PG8_MMA(1, 0, At, B0); PG8_BAR; PG8_SCHED;
            PG8_STAGE(PG8_SB(1, 1), b3 + hstep, voffB);
            PG8_WAIT_V(6); PG8_BAR; PG8_MMA(1, 1, At, B1); PG8_BAR;
            }
        }
        if constexpr (ALIGN_EPI) { if (wr == 0) PG8_BAR; }
        if constexpr (!Epi::AFTER_DRAIN) { E(acc, cur, wr, wc, fr, fq); S.done(cur); }
        if (!has_next) break;
#pragma unroll
        for (int a = 0; a < 2; ++a)
#pragma unroll
            for (int b = 0; b < 2; ++b)
#pragma unroll
                for (int m = 0; m < 4; ++m)
#pragma unroll
                    for (int n = 0; n < 2; ++n) acc[a][b][m][n] = (f32x4){0.f, 0.f, 0.f, 0.f};
        cur = nxt; cA = nA; cB = nB; ++ui;
        if constexpr (ALIGN_EPI) { if (wr == 1) PG8_BAR; }
    }
    PG8_WAIT_V(0);
    if constexpr (!ALIGN_EPI) { if (wr == 0) PG8_BAR; }
    PG8_BAR;
    if constexpr (Epi::AFTER_DRAIN) { E.fused(acc, cur, wr, wc, fr, fq, lds, wid, lane); S.done(cur); }
#undef PG8_SA
#undef PG8_SB
#undef PG8_STAGE
#undef PG8_LDA
#undef PG8_LDB
#undef PG8_MMA
#undef PG8_WAIT_V
#undef PG8_WAIT_L
#undef PG8_BAR
#undef PG8_SCHED
}
}

constexpr int NWAVES = 8, NTHR = 512;
constexpr int N_LAUNCHES = MK_N_LAUNCHES;
constexpr int N_PHASES = 13;
constexpr int DM = 2048, NB = 4, TL = 2048, NLAT = NB * TL, TCX = 256, NCTX = NB * TCX, NTOK = NLAT + NCTX;
constexpr int NH = 8, QKD = 128, VD = 256, INC = 14368, ZW = 14336;
constexpr int ZQ = 0, ZK = 1024, ZV = 2048, ZO = 4096, ZU = 6144, ZS = 8192, ZGA = 10240, ZGB = 12288;
constexpr int NEXP = 32, DEXP = 2048, NCH = 18  , CROWS = 272  ;
constexpr float EPS = 1e-6f;

constexpr size_t MiB = 1u << 20;
constexpr size_t WS_CTL = 0, CTL_ZERO_BYTES = 1 * MiB;
constexpr size_t WS_MOD = 1 * MiB;
constexpr size_t WS_GATES = 2 * MiB;
constexpr size_t WS_SCAL = 4 * MiB;
constexpr size_t WS_ROUTE = 5 * MiB;
constexpr size_t WS_SCN = 2996 * MiB;
constexpr size_t WS_SK = 6 * MiB;
constexpr size_t WS_WINT = 8 * MiB;
constexpr size_t WS_PAT = 64 * MiB, WS_PBT = 72 * MiB, WS_WOT = 80 * MiB;
constexpr size_t WS_W1T = 88 * MiB;
constexpr size_t WS_W2T = 600 * MiB;
constexpr size_t WS_HB = 856 * MiB;
constexpr size_t WS_Z = 892 * MiB;
constexpr size_t WS_QC = 1144 * MiB, WS_KC = 1162 * MiB;
constexpr size_t WS_SVN = 1180 * MiB;
constexpr size_t WS_DC = 1212 * MiB;
constexpr size_t WS_CS = 1360 * MiB;
constexpr size_t WS_RO = 1428 * MiB;
constexpr size_t WS_CM = 1460 * MiB;
constexpr size_t WS_YB = 1492 * MiB;
constexpr size_t WS_MRG = 1556 * MiB;
constexpr size_t WS_X1 = 1588 * MiB;
constexpr size_t WS_ACT = 1652 * MiB;
constexpr size_t WS_Y2 = 1812 * MiB;
constexpr size_t WS_XG = 1972 * MiB;
constexpr size_t WS_HB8 = 2998 * MiB;
constexpr size_t WS_WG8 = 3014 * MiB;
constexpr size_t WS_END = 3022 * MiB;
static_assert(WS_DC + (size_t)64 * 17 * CROWS * 128 * 2 <= WS_CS && WS_CS + (size_t)64 * 16 * CROWS * 128 * 2 <= WS_RO && WS_Z + (size_t)NTOK * ZW * 2 <= WS_QC, "ws map");
constexpr int CW_Q2 = 3072;
constexpr int CW_Q = 2048;
constexpr int CW_CNT = 64;
constexpr int CW_BAR = 4096;
constexpr int RING_BYTES = 131072;
constexpr int LDS_BYTES = 147456;
constexpr int LDSCTL_OFF = LDS_BYTES - 2048, MISC_OFF = LDSCTL_OFF + 320, PREF_OFF = LDSCTL_OFF + 1024;

#define GAS __attribute__((address_space(1)))
#define LAS __attribute__((address_space(3)))
typedef unsigned short bf16;
typedef unsigned v4u __attribute__((ext_vector_type(4)));
typedef unsigned v2u __attribute__((ext_vector_type(2)));
typedef float f32x4 __attribute__((ext_vector_type(4)));
typedef short bf16x8 __attribute__((ext_vector_type(8)));
typedef short s16x4 __attribute__((ext_vector_type(4)));
typedef GAS unsigned gu32;
#define RLX_AGENT __ATOMIC_RELAXED, __HIP_MEMORY_SCOPE_AGENT
#define LDS_WAIT() asm volatile("s_waitcnt lgkmcnt(0)" ::: "memory")
#define VM_WAIT() asm volatile("s_waitcnt vmcnt(0)" ::: "memory")
using pg8::cvt_pk_bf16; using pg8::bf_lo; using pg8::bf_hi; using pg8::sigmoidf_;


__device__ __forceinline__ float wave_sum(float v) {
#pragma unroll
    for (int o = 1; o < 64; o <<= 1) v += __shfl_xor(v, o);
    return v;
}
__device__ __forceinline__ float siluf_(float x) { return x * __builtin_amdgcn_rcpf(1.0f + __expf(-x)); }
__device__ __forceinline__ float gelu_tanh(float x) { const float u = 0.7978845608028654f * (x + 0.044715f * x * x * x); return x * __builtin_amdgcn_rcpf(1.0f + __expf(-2.0f * u)); }
__device__ __forceinline__ float logsigf_(float f) { return fminf(f, 0.f) - log1pf(expf(-fabsf(f))); }
__device__ __forceinline__ unsigned img_off(unsigned row, unsigned ch) { return 256u * row + 16u * (ch ^ (((row & 3u) << 2) | ((row >> 2) & 3u))); }
__device__ __forceinline__ s16x4 tr_read(LAS unsigned char* p) { return __builtin_amdgcn_ds_read_tr16_b64_v4i16((LAS s16x4*)p); }
__device__ __forceinline__ bf16x8 tr_frag(LAS unsigned char* img, unsigned r0, unsigned r1, unsigned c, int lane) {
    const unsigned q = (lane & 15) >> 2, p = lane & 3;
    const s16x4 lo = tr_read(img + img_off(r0 + q, 2 * c + (p >> 1)) + 8 * (p & 1));
    const s16x4 hi = tr_read(img + img_off(r1 + q, 2 * c + (p >> 1)) + 8 * (p & 1));
    bf16x8 r; r[0] = lo[0]; r[1] = lo[1]; r[2] = lo[2]; r[3] = lo[3]; r[4] = hi[0]; r[5] = hi[1]; r[6] = hi[2]; r[7] = hi[3]; return r;
}
__device__ __forceinline__ bf16x8 tr_frag2(LAS unsigned char* base, unsigned x0, unsigned x1) {
    const s16x4 lo = tr_read(base + x0), hi = tr_read(base + x1);
    bf16x8 r; r[0] = lo[0]; r[1] = lo[1]; r[2] = lo[2]; r[3] = lo[3]; r[4] = hi[0]; r[5] = hi[1]; r[6] = hi[2]; r[7] = hi[3]; return r;
}
#define TR_NAT_OFFS(xn0, xn1, lane) unsigned xn0[8], xn1[8]; { const unsigned g_ = (lane) >> 4, q_ = ((lane) & 15) >> 2, p_ = (lane) & 3; \
    _Pragma("unroll") for (int c_ = 0; c_ < 8; ++c_) { xn0[c_] = 256u * (8 * g_ + q_) + 16u * ((2 * c_ + (p_ >> 1)) ^ ((q_ << 2) | ((2 * g_) & 3))) + 8u * (p_ & 1); \
                                                       xn1[c_] = 256u * (8 * g_ + 4 + q_) + 16u * ((2 * c_ + (p_ >> 1)) ^ ((q_ << 2) | ((2 * g_ + 1) & 3))) + 8u * (p_ & 1); } }
#define TR_PERM_OFFS(xp, lane) unsigned xp[8]; { const unsigned g_ = (lane) >> 4, q_ = ((lane) & 15) >> 2, p_ = (lane) & 3; \
    _Pragma("unroll") for (int c_ = 0; c_ < 8; ++c_) xp[c_] = 256u * (4 * g_ + q_) + 16u * ((2 * c_ + (p_ >> 1)) ^ ((q_ << 2) | g_)) + 8u * (p_ & 1); }
__device__ __forceinline__ void load_tile128(LAS unsigned char* img, const bf16* src, size_t ld, int tid) {
#pragma unroll
    for (int i = 0; i < 4; ++i) { const int id = tid + NTHR * i, row = id >> 4, ch = id & 15;
        const v4u v = *(const v4u*)(src + (size_t)row * ld + 8 * ch); *(LAS v4u*)(img + img_off(row, ch)) = v; }
}
__device__ __forceinline__ void load_tile128_scaled(LAS unsigned char* img, const bf16* src, size_t ld, const LAS float* w, int tid) {
#pragma unroll
    for (int i = 0; i < 4; ++i) { const int id = tid + NTHR * i, row = id >> 4, ch = id & 15; const float s = w[row];
        const v4u v = *(const v4u*)(src + (size_t)row * ld + 8 * ch); v4u o;
        o.x = cvt_pk_bf16(bf_lo(v.x) * s, bf_hi(v.x) * s); o.y = cvt_pk_bf16(bf_lo(v.y) * s, bf_hi(v.y) * s); o.z = cvt_pk_bf16(bf_lo(v.z) * s, bf_hi(v.z) * s); o.w = cvt_pk_bf16(bf_lo(v.w) * s, bf_hi(v.w) * s);
        *(LAS v4u*)(img + img_off(row, ch)) = o; }
}
__device__ __forceinline__ void gate_scan(const float* G, size_t row0, int col_i, int col_f, int dir, int lane, float* bc, float* gg, float* pmx, float& b_end, float& gmax) {
    const int j0 = dir ? 127 - 2 * lane : 2 * lane, j1 = dir ? 126 - 2 * lane : 2 * lane + 1;
    const float f0 = G[(row0 + j0) * 32 + col_f], f1 = G[(row0 + j1) * 32 + col_f], i0 = G[(row0 + j0) * 32 + col_i], i1 = G[(row0 + j1) * 32 + col_i];
    const float lf0 = logsigf_(f0), lf1 = logsigf_(f1), s = lf0 + lf1; float incl = s;
#pragma unroll
    for (int o = 1; o < 64; o <<= 1) { const float t = __shfl_up(incl, o); if (lane >= o) incl += t; }
    const float b0 = (incl - s) + lf0, b1 = incl, g0 = i0 - b0, g1 = i1 - b1;
    float mincl = fmaxf(g0, g1);
#pragma unroll
    for (int o = 1; o < 64; o <<= 1) { const float t = __shfl_up(mincl, o); if (lane >= o) mincl = fmaxf(mincl, t); }
    float mexcl = __shfl_up(mincl, 1); if (lane == 0) mexcl = -3.0e38f;
    bc[j0] = b0; bc[j1] = b1; gg[j0] = g0; gg[j1] = g1; pmx[j0] = fmaxf(mexcl, g0); pmx[j1] = mincl;
    b_end = __shfl(incl, 63); gmax = __shfl(mincl, 63);
}
#define MFMA16(a, b, c) __builtin_amdgcn_mfma_f32_16x16x32_bf16((a), (b), (c), 0, 0, 0)

struct CvtItem { const float* src; size_t ldw; bf16* dst; };
constexpr int N_CONVERTERS = 128;
constexpr int N_CONV_DEFER = 1440;
constexpr int I_GEMV = 192, I_WIN = 16 * 40, I_GATE8 = 16 * 16, I_P = 16 * 8, I_W1 = 32 * 16 * 16, I_W2 = 32 * 16 * 8, I_TOTAL = I_GEMV + I_WIN + 3 * I_P + I_W1 + I_W2;
__device__ __forceinline__ CvtItem cvt_decode(int r, int tid, const float* w_in, const float* proj_a, const float* proj_b, const float* w_out, const float* exp_w1, const float* exp_w2,
                                              bf16* WINT, bf16* PAT, bf16* PBT, bf16* WOT, bf16* W1T, bf16* W2T) {
    const int n4 = tid & 63, kg = tid >> 6; const float* W; size_t ldw, ca, cb, drow; int kt; bf16* WT;
    if (r < I_WIN) { kt = r / 40; const int nt = r % 40; W = w_in; ldw = INC; ca = (size_t)256 * nt + (nt >= 16 ? 32 : 0); cb = ca + 128; WT = WINT; drow = (size_t)256 * nt; }
    else if ((r -= I_WIN) < 3 * I_P) { const int m = r / I_P, q = r % I_P; kt = q / 8; const int nt = q % 8; W = m == 0 ? proj_a : (m == 1 ? proj_b : w_out); ldw = 2048; ca = (size_t)256 * nt; cb = ca + 128; WT = m == 0 ? PAT : (m == 1 ? PBT : WOT); drow = (size_t)256 * nt; }
    else if ((r -= 3 * I_P) < I_W1) { const int e = r / 256, q = r % 256; kt = q / 16; const int nt = q % 16; W = exp_w1 + (size_t)e * 2048 * 4096; ldw = 4096; ca = (size_t)128 * nt; cb = 2048 + ca; WT = W1T; drow = (size_t)e * 4096 + 256 * nt; }
    else { r -= I_W1; const int e = r / 128, q = r % 128; kt = q / 8; const int nt = q % 8; W = exp_w2 + (size_t)e * 2048 * 2048; ldw = 2048; ca = (size_t)256 * nt; cb = ca + 128; WT = W2T; drow = (size_t)e * 2048 + 256 * nt; }
    CvtItem it; it.ldw = ldw; it.src = W + (size_t)(128 * kt + 8 * kg) * ldw + (n4 < 32 ? ca + 4 * n4 : cb + 4 * (n4 - 32)); it.dst = WT + drow * 2048 + 128 * kt; return it;
}
__device__ __forceinline__ void cvt_run(LAS unsigned char* lds, int tid, int it, int stride, int end, const float* w_in, const float* proj_a, const float* proj_b, const float* w_out, const float* exp_w1, const float* exp_w2,
                                        bf16* WINT, bf16* PAT, bf16* PBT, bf16* WOT, bf16* W1T, bf16* W2T) {
    const int n4 = tid & 63, kg = tid >> 6;
    f32x4 v[16]; CvtItem cur;
    bool have = it < end;
    if (have) { cur = cvt_decode(it - I_GEMV, tid, w_in, proj_a, proj_b, w_out, exp_w1, exp_w2, WINT, PAT, PBT, WOT, W1T, W2T);
#pragma unroll
        for (int i = 0; i < 16; ++i) v[i] = __builtin_nontemporal_load((const f32x4*)(cur.src + (size_t)((i >> 3) * 64 + (i & 7)) * cur.ldw)); }
    while (have) {
#pragma unroll
        for (int hf = 0; hf < 2; ++hf)
#pragma unroll
            for (int j = 0; j < 4; ++j) { v4u o; o.x = cvt_pk_bf16(v[8 * hf + 0][j], v[8 * hf + 1][j]); o.y = cvt_pk_bf16(v[8 * hf + 2][j], v[8 * hf + 3][j]); o.z = cvt_pk_bf16(v[8 * hf + 4][j], v[8 * hf + 5][j]); o.w = cvt_pk_bf16(v[8 * hf + 6][j], v[8 * hf + 7][j]);
                *(LAS v4u*)(lds + img_off(4 * n4 + j, 8 * hf + kg)) = o; }
        __syncthreads();
        bf16* dst = cur.dst;
        it += stride; have = it < end;
        if (have) { cur = cvt_decode(it - I_GEMV, tid, w_in, proj_a, proj_b, w_out, exp_w1, exp_w2, WINT, PAT, PBT, WOT, W1T, W2T);
#pragma unroll
            for (int i = 0; i < 16; ++i) v[i] = __builtin_nontemporal_load((const f32x4*)(cur.src + (size_t)((i >> 3) * 64 + (i & 7)) * cur.ldw)); }
#pragma unroll
        for (int i = 0; i < 8; ++i) { const int id = tid + NTHR * i, row = id >> 4, ch = id & 15; const v4u o = *(const LAS v4u*)(lds + img_off(row, ch)); __builtin_nontemporal_store(o, (v4u*)(dst + (size_t)row * 2048 + 8 * ch)); }
        __syncthreads();
    }
}
__device__ __forceinline__ void cvt_run8(LAS unsigned char* lds, int tid, int r, int stride, int end, const float* exp_w1, const float* exp_w2, const float* w_in, unsigned char* W1T8, unsigned char* W2T8, unsigned char* WG8) {
    const int n4 = tid & 63, kg = tid >> 6;
    f32x4 v[16]; const float* src = nullptr; size_t ldw = 0; unsigned char* dst = nullptr;
#define CVT8_DECODE(R) do { int q_ = (R); const float* W_; size_t ca_, cb_, drow_; int kt_; unsigned char* WT_; \
        if (q_ < I_W1) { const int e = q_ / 256, qq = q_ % 256; kt_ = qq / 16; const int nt = qq % 16; W_ = exp_w1 + (size_t)e * 2048 * 4096; ldw = 4096; ca_ = (size_t)128 * nt; cb_ = 2048 + ca_; WT_ = W1T8; drow_ = (size_t)e * 4096 + 256 * nt; } \
        else if (q_ < I_W1 + I_W2) { q_ -= I_W1; const int e = q_ / 128, qq = q_ % 128; kt_ = qq / 8; const int nt = qq % 8; W_ = exp_w2 + (size_t)e * 2048 * 2048; ldw = 2048; ca_ = (size_t)256 * nt; cb_ = ca_ + 128; WT_ = W2T8; drow_ = (size_t)e * 2048 + 256 * nt; } \
        else { q_ -= I_W1 + I_W2; kt_ = q_ / 16; const int nt = q_ % 16; W_ = w_in; ldw = INC; ca_ = (size_t)10272 + 256 * nt; cb_ = ca_ + 128; WT_ = WG8; drow_ = (size_t)256 * nt; } \
        src = W_ + (size_t)(128 * kt_ + 8 * kg) * ldw + (n4 < 32 ? ca_ + 4 * n4 : cb_ + 4 * (n4 - 32)); dst = WT_ + drow_ * 2048 + 128 * kt_; \
        _Pragma("unroll") for (int i = 0; i < 16; ++i) v[i] = __builtin_nontemporal_load((const f32x4*)(src + (size_t)((i >> 3) * 64 + (i & 7)) * ldw)); } while (0)
    bool have = r < end;
    if (have) CVT8_DECODE(r);
    while (have) {
#pragma unroll
        for (int hf = 0; hf < 2; ++hf)
#pragma unroll
            for (int j = 0; j < 4; ++j) { const int row = 4 * n4 + j, p8 = 8 * hf + kg; v2u o;
                o.x = pg8::pk4_fp8(v[8 * hf + 0][j] * pg8::F8_SW, v[8 * hf + 1][j] * pg8::F8_SW, v[8 * hf + 2][j] * pg8::F8_SW, v[8 * hf + 3][j] * pg8::F8_SW);
                o.y = pg8::pk4_fp8(v[8 * hf + 4][j] * pg8::F8_SW, v[8 * hf + 5][j] * pg8::F8_SW, v[8 * hf + 6][j] * pg8::F8_SW, v[8 * hf + 7][j] * pg8::F8_SW);
                *(LAS v2u*)(lds + row * 128 + 16 * ((p8 >> 1) ^ ((row >> 2) & 7)) + 8 * (p8 & 1)) = o; }
        __syncthreads();
        unsigned char* d0 = dst;
        r += stride; have = r < end;
        if (have) CVT8_DECODE(r);
#pragma unroll
        for (int i = 0; i < 4; ++i) { const int id = tid + NTHR * i, row = id >> 3, ch = id & 7; const v4u o = *(const LAS v4u*)(lds + row * 128 + 16 * (ch ^ ((row >> 2) & 7)));
            __builtin_nontemporal_store(o, (v4u*)(d0 + (size_t)row * 2048 + 16 * ch)); }
        __syncthreads();
    }
#undef CVT8_DECODE
}
__device__ __forceinline__ void p0_phase(LAS unsigned char* lds, int tid, int G, const float* c, const float* c_ctx, const float* mod_w, const float* mod_b, float* MOD,
                                         const float* w_in, const float* proj_a, const float* proj_b, const float* w_out, const float* exp_w1, const float* exp_w2, const float* router_w,
                                         bf16* WINT, bf16* PAT, bf16* PBT, bf16* WOT, bf16* W1T, bf16* W2T, bf16* SK, int n_conv_p0) {
    LAS float* sc = (LAS float*)lds;
    LAS float* red = (LAS float*)(lds + 40960);
    int it = blockIdx.x;
    if (it < I_GEMV) {
        for (int i = tid; i < 5 * 2048; i += NTHR) { const float x = i < 4 * 2048 ? c[i] : c_ctx[i - 4 * 2048]; sc[i] = siluf_(x); }
        __syncthreads();
        for (; it < I_GEMV; it += G) {
            const int j0 = 64 * it, c4 = tid & 15, kg = tid >> 4;
            f32x4 a0 = {0.f, 0.f, 0.f, 0.f}, a1 = a0, a2 = a0, a3 = a0, a4 = a0;
            const float* wp = mod_w + (size_t)kg * 12288 + j0 + 4 * c4;
#pragma unroll 8
            for (int k = kg; k < 2048; k += 32) { const f32x4 w = *(const f32x4*)wp; wp += (size_t)32 * 12288;
                a0 += w * sc[k]; a1 += w * sc[2048 + k]; a2 += w * sc[4096 + k]; a3 += w * sc[6144 + k]; a4 += w * sc[8192 + k]; }
            *(LAS f32x4*)(red + (kg * 5 + 0) * 64 + 4 * c4) = a0; *(LAS f32x4*)(red + (kg * 5 + 1) * 64 + 4 * c4) = a1; *(LAS f32x4*)(red + (kg * 5 + 2) * 64 + 4 * c4) = a2;
            *(LAS f32x4*)(red + (kg * 5 + 3) * 64 + 4 * c4) = a3; *(LAS f32x4*)(red + (kg * 5 + 4) * 64 + 4 * c4) = a4;
            __syncthreads();
            if (tid < 320) { const int rr = tid >> 6, j = tid & 63; float s = 0.f;
#pragma unroll 8
                for (int g = 0; g < 32; ++g) s += red[(g * 5 + rr) * 64 + j];
                MOD[rr * 12288 + j0 + j] = s + mod_b[j0 + j]; }
            __syncthreads();
        }
    } else {
        for (int i = (it - I_GEMV) * NTHR + tid; i < 2 * 32 * 2048; i += (G - I_GEMV) * NTHR) { const int m = i >> 16, n = (i >> 11) & 31, k = i & 2047;
            const float w = m == 0 ? w_in[(size_t)k * INC + 4096 + n] : router_w[k * 32 + n];
            const unsigned hi = cvt_pk_bf16(w, 0.f) & 0xffffu; const unsigned lo = cvt_pk_bf16(w - __uint_as_float(hi << 16), 0.f) & 0xffffu;
            SK[(size_t)(2 * m) * 65536 + n * 2048 + k] = (bf16)hi; SK[(size_t)(2 * m + 1) * 65536 + n * 2048 + k] = (bf16)lo; }
    }
    cvt_run(lds, tid, it, G, I_GEMV + n_conv_p0, w_in, proj_a, proj_b, w_out, exp_w1, exp_w2, WINT, PAT, PBT, WOT, W1T, W2T);
}

__device__ __forceinline__ void skinny_mfma(const LAS float* hrow, const bf16* WT_hi, const bf16* WT_lo, LAS float* part, int wave, int lane) {
    const int g = lane >> 4, l15 = lane & 15;
    f32x4 acc0 = {0.f, 0.f, 0.f, 0.f}, acc1 = acc0;
#pragma unroll
    for (int ks = 0; ks < 8; ++ks) { const int kb = 256 * wave + 32 * ks + 8 * g;
        f32x4 a0 = {0.f, 0.f, 0.f, 0.f}, a1 = a0;
        if (l15 < 8) { a0 = *(const LAS f32x4*)(hrow + l15 * 2048 + kb); a1 = *(const LAS f32x4*)(hrow + l15 * 2048 + kb + 4); }
        v4u hi, lo;
        hi.x = cvt_pk_bf16(a0[0], a0[1]); hi.y = cvt_pk_bf16(a0[2], a0[3]); hi.z = cvt_pk_bf16(a1[0], a1[1]); hi.w = cvt_pk_bf16(a1[2], a1[3]);
        lo.x = cvt_pk_bf16(a0[0] - bf_lo(hi.x), a0[1] - bf_hi(hi.x)); lo.y = cvt_pk_bf16(a0[2] - bf_lo(hi.y), a0[3] - bf_hi(hi.y));
        lo.z = cvt_pk_bf16(a1[0] - bf_lo(hi.z), a1[1] - bf_hi(hi.z)); lo.w = cvt_pk_bf16(a1[2] - bf_lo(hi.w), a1[3] - bf_hi(hi.w));
        const bf16x8 Ah = __builtin_bit_cast(bf16x8, hi), Al = __builtin_bit_cast(bf16x8, lo);
        const bf16x8 b0h = *(const bf16x8*)(WT_hi + (size_t)l15 * 2048 + kb), b0l = *(const bf16x8*)(WT_lo + (size_t)l15 * 2048 + kb);
        const bf16x8 b1h = *(const bf16x8*)(WT_hi + (size_t)(16 + l15) * 2048 + kb), b1l = *(const bf16x8*)(WT_lo + (size_t)(16 + l15) * 2048 + kb);
        acc0 = MFMA16(Ah, b0h, acc0); acc0 = MFMA16(Ah, b0l, acc0); acc0 = MFMA16(Al, b0h, acc0);
        acc1 = MFMA16(Ah, b1h, acc1); acc1 = MFMA16(Ah, b1l, acc1); acc1 = MFMA16(Al, b1h, acc1); }
    if (g < 2) {
#pragma unroll
        for (int r = 0; r < 4; ++r) { part[wave * 256 + (4 * g + r) * 32 + l15] = acc0[r]; part[wave * 256 + (4 * g + r) * 32 + 16 + l15] = acc1[r]; } }
}

__device__ __forceinline__ void p1_phase(LAS unsigned char* lds, int tid, int wave, int lane, int G, const float* x, const float* ctx, const float* MOD, const float* norm_g,
                                         const bf16* SK, const float* gate_b, bf16* HB, unsigned char* HB8, float* GATES) {
    LAS float* hrow = (LAS float*)(lds + wave * 8192); LAS float* part = (LAS float*)(lds + 65536);
    f32x4 v[8];
    { const int row = blockIdx.x * 8 + wave; const float* xr = row < NLAT ? x + (size_t)row * DM : ctx + (size_t)(row - NLAT) * DM;
#pragma unroll
      for (int j = 0; j < 8; ++j) v[j] = *(const f32x4*)(xr + 4 * (lane + 64 * j)); }
    for (int it = blockIdx.x; it < NTOK / 8; it += G) {
        const int row = it * 8 + wave;
        const float* shift = MOD + (size_t)(row < NLAT ? (row >> 11) : 4) * 12288; const float* scale = shift + 2048;
        float ss = 0.f;
#pragma unroll
        for (int j = 0; j < 8; ++j) ss += (v[j][0] * v[j][0] + v[j][1] * v[j][1]) + (v[j][2] * v[j][2] + v[j][3] * v[j][3]);
        const float rstd = 1.0f / sqrtf(wave_sum(ss) * (1.0f / DM) + EPS);
#pragma unroll
        for (int j = 0; j < 8; ++j) { const int col = 4 * (lane + 64 * j);
            const f32x4 g = *(const f32x4*)(norm_g + col), sc = *(const f32x4*)(scale + col), sh = *(const f32x4*)(shift + col);
            const f32x4 h = (v[j] * rstd) * g * (sc + 1.0f) + sh;
            v2u o; o.x = cvt_pk_bf16(h[0], h[1]); o.y = cvt_pk_bf16(h[2], h[3]); *(v2u*)(HB + (size_t)row * DM + col) = o;
            if (row < NLAT) *(unsigned*)(HB8 + (size_t)row * DM + col) = pg8::pk4_fp8(h[0] * pg8::F8_SA, h[1] * pg8::F8_SA, h[2] * pg8::F8_SA, h[3] * pg8::F8_SA);
            *(LAS f32x4*)(hrow + col) = h; }
        if (it + G < NTOK / 8) { const int rown = (it + G) * 8 + wave; const float* xr = rown < NLAT ? x + (size_t)rown * DM : ctx + (size_t)(rown - NLAT) * DM;
#pragma unroll
            for (int j = 0; j < 8; ++j) v[j] = *(const f32x4*)(xr + 4 * (lane + 64 * j)); }
        __syncthreads();
        skinny_mfma((const LAS float*)lds, SK, SK + 65536, part, wave, lane);
        __syncthreads();
        if (tid < 256) { float s = 0.f;
#pragma unroll
            for (int w = 0; w < 8; ++w) s += part[w * 256 + tid];
            GATES[(size_t)(it * 8) * 32 + tid] = s + gate_b[tid & 31]; }
    }
}

__device__ __forceinline__ void p3_phase(int wave, int lane, int G, const bf16* Z, const float* conv_w, const float* conv_b, const float* sgu_norm_g, bf16* QC, bf16* KC, bf16* SVN,
                                         const float* GATES, float* SCN, float* BEND, float* GMAX) {
    const int gw = blockIdx.x * NWAVES + wave, NGW = G * NWAVES;
    for (int task = gw; task < 64 * NCH; task += NGW) { const int bhd = task / NCH, bi = task - bhd * NCH, dir = bhd & 1, bh = bhd >> 1, b = bh >> 3, h = bh & 7;
        const size_t row0 = bi < 2 ? (size_t)NLAT + b * TCX + bi * 128 : (size_t)b * TL + (bi - 2) * 128;
        float* sp = SCN + (size_t)task * 384; float b_end, gmax;
        gate_scan(GATES, row0, (2 * dir) * 8 + h, (2 * dir + 1) * 8 + h, dir, lane, sp, sp + 128, sp + 256, b_end, gmax);
        const int c = dir == 0 ? bi : (bi < 2 ? 1 - bi : 19 - bi);
        if (lane == 0 && c < 17) { BEND[bhd * 17 + c] = b_end; GMAX[bhd * 17 + c] = gmax; } }
    for (int item = gw; item < NTOK; item += NGW) {
        const int rb = item >> 2, seg = item & 3, row0 = rb * 4, c0 = seg * 512 + lane * 8;
        const int t0 = row0 < NLAT ? (row0 & (TL - 1)) : ((row0 - NLAT) & (TCX - 1)), len = row0 < NLAT ? TL : TCX;
        v4u zr[8];
#pragma unroll
        for (int k = 0; k < 8; ++k) { const int tt = t0 + k - 2; zr[k] = (v4u){0u, 0u, 0u, 0u};
            if (tt >= 0 && tt < len) zr[k] = *(const v4u*)(Z + (size_t)(row0 + k - 2) * ZW + c0); }
        f32x4 w0[5], w1[5];
#pragma unroll
        for (int tau = 0; tau < 5; ++tau) { w0[tau] = *(const f32x4*)(conv_w + tau * 2048 + c0); w1[tau] = *(const f32x4*)(conv_w + tau * 2048 + c0 + 4); }
        const f32x4 b0 = *(const f32x4*)(conv_b + c0), b1 = *(const f32x4*)(conv_b + c0 + 4);
        const float qs = c0 < 1024 ? 0.08838834764831845f : 1.0f;
#pragma unroll
        for (int o = 0; o < 4; ++o) { float acc[8] = {b0[0], b0[1], b0[2], b0[3], b1[0], b1[1], b1[2], b1[3]};
#pragma unroll
            for (int tau = 0; tau < 5; ++tau) { const v4u z = zr[o + tau];
                acc[0] += w0[tau][0] * bf_lo(z.x); acc[1] += w0[tau][1] * bf_hi(z.x); acc[2] += w0[tau][2] * bf_lo(z.y); acc[3] += w0[tau][3] * bf_hi(z.y);
                acc[4] += w1[tau][0] * bf_lo(z.z); acc[5] += w1[tau][1] * bf_hi(z.z); acc[6] += w1[tau][2] * bf_lo(z.w); acc[7] += w1[tau][3] * bf_hi(z.w); }
#pragma unroll
            for (int i = 0; i < 8; ++i) acc[i] = siluf_(acc[i]) * qs;
            v4u ov; ov.x = cvt_pk_bf16(acc[0], acc[1]); ov.y = cvt_pk_bf16(acc[2], acc[3]); ov.z = cvt_pk_bf16(acc[4], acc[5]); ov.w = cvt_pk_bf16(acc[6], acc[7]);
            bf16* dst = c0 < 1024 ? QC + (size_t)(row0 + o) * 1024 + c0 : KC + (size_t)(row0 + o) * 1024 + (c0 - 1024);
            *(v4u*)dst = ov; }
    }
    for (int row = gw; row < NLAT; row += NGW) {
        float v[32]; float ss = 0.f;
#pragma unroll
        for (int j = 0; j < 4; ++j) { const v4u z = *(const v4u*)(Z + (size_t)row * ZW + ZS + 8 * lane + 512 * j);
            v[8 * j + 0] = gelu_tanh(bf_lo(z.x)); v[8 * j + 1] = gelu_tanh(bf_hi(z.x)); v[8 * j + 2] = gelu_tanh(bf_lo(z.y)); v[8 * j + 3] = gelu_tanh(bf_hi(z.y));
            v[8 * j + 4] = gelu_tanh(bf_lo(z.z)); v[8 * j + 5] = gelu_tanh(bf_hi(z.z)); v[8 * j + 6] = gelu_tanh(bf_lo(z.w)); v[8 * j + 7] = gelu_tanh(bf_hi(z.w)); }
#pragma unroll
        for (int i = 0; i < 32; ++i) ss += v[i] * v[i];
        const float rstd = 1.0f / sqrtf(wave_sum(ss) * (1.0f / DM) + EPS);
#pragma unroll
        for (int j = 0; j < 4; ++j) { const int col = 8 * lane + 512 * j; const f32x4 g0 = *(const f32x4*)(sgu_norm_g + col), g1 = *(const f32x4*)(sgu_norm_g + col + 4);
            v4u o; o.x = cvt_pk_bf16(v[8 * j] * rstd * g0[0], v[8 * j + 1] * rstd * g0[1]); o.y = cvt_pk_bf16(v[8 * j + 2] * rstd * g0[2], v[8 * j + 3] * rstd * g0[3]);
            o.z = cvt_pk_bf16(v[8 * j + 4] * rstd * g1[0], v[8 * j + 5] * rstd * g1[1]); o.w = cvt_pk_bf16(v[8 * j + 6] * rstd * g1[2], v[8 * j + 7] * rstd * g1[3]);
            *(v4u*)(SVN + (size_t)row * DM + col) = o; }
    }
}

constexpr int L_V0 = 0, L_V1 = 32768, L_K = 65536, L_SC = 98304, L_CB = 106496;
constexpr int N_M1 = 64 * 17, N_SGU = 512;
__device__ __forceinline__ void p4_phase(LAS unsigned char* lds, int tid_, int wave, int lane_, int G, const bf16* Z, const bf16* KC, const bf16* SVN, const float* SCN,
                                         const float* sgu_w, const float* sgu_b, bf16* DC, const float* GMAX, bf16* CM) {
    v4u pk[4], pv[8]; f32x4 pa[2];
#define P4_ISSUE(U) do { const int u_ = (U); int t_ = tid_; asm volatile("" : "+v"(t_)); \
        if (u_ < N_M1) { const int bhd_ = u_ / 17, c_ = u_ - bhd_ * 17, dir_ = bhd_ & 1, bh_ = bhd_ >> 1, b_ = bh_ >> 3, h_ = bh_ & 7; \
            const bool ic_ = c_ < 2; const int blk_ = dir_ == 0 ? (ic_ ? c_ : c_ - 2) : (ic_ ? 1 - c_ : 17 - c_); \
            const size_t r0_ = ic_ ? (size_t)NLAT + b_ * TCX + blk_ * 128 : (size_t)b_ * TL + blk_ * 128; \
            const float* sp_ = SCN + (size_t)(bhd_ * NCH + (ic_ ? blk_ : blk_ + 2)) * 384; \
            _Pragma("unroll") for (int i = 0; i < 4; ++i) { const int id = t_ + NTHR * i; pk[i] = *(const v4u*)(KC + (r0_ + (id >> 4)) * 1024 + h_ * QKD + 8 * (id & 15)); pa[0][i] = sp_[128 + (id >> 4)]; } \
            pa[1][0] = GMAX[bhd_ * 17 + c_]; \
            _Pragma("unroll") for (int i = 0; i < 8; ++i) { const int id = t_ + NTHR * (i & 3); pv[i] = *(const v4u*)(Z + (r0_ + (id >> 4)) * ZW + ZV + h_ * VD + 128 * (i >> 2) + 8 * (id & 15)); } \
        } else { const int u2_ = u_ - N_M1, b_ = u2_ >> 7, n_ = (u2_ >> 3) & 15, grp_ = u2_ & 7; const size_t r0_ = (size_t)b_ * TL + n_ * 128; \
            _Pragma("unroll") for (int i = 0; i < 8; ++i) { const int id = t_ + NTHR * (i & 3); pv[i] = *(const v4u*)(SVN + (r0_ + (id >> 4)) * DM + grp_ * 256 + 128 * (i >> 2) + 8 * (id & 15)); } \
            } } while (0)
    int u = blockIdx.x;
    if (u < N_M1 + N_SGU) P4_ISSUE(u);
    for (; u < N_M1 + N_SGU; u += G) {
        int tid = tid_; asm volatile("" : "+v"(tid)); const int lane = tid & 63; const unsigned g = lane >> 4, l15 = lane & 15;
        const bool m1 = u < N_M1;
        TR_NAT_OFFS(xn0, xn1, lane)
#pragma unroll
        for (int i = 0; i < 8; ++i) { const int id = tid + NTHR * (i & 3); *(LAS v4u*)(lds + ((i >> 2) ? L_V1 : L_V0) + img_off(id >> 4, id & 15)) = pv[i]; }
        bf16x8 Af[4]; v2u uw[16];
        if (m1) { const float gmax = pa[1][0];
#pragma unroll
            for (int i = 0; i < 4; ++i) { const int id = tid + NTHR * i, row = id >> 4, ch = id & 15; const float sw = __expf(pa[0][i] - gmax); const v4u v = pk[i]; v4u o;
                o.x = cvt_pk_bf16(bf_lo(v.x) * sw, bf_hi(v.x) * sw); o.y = cvt_pk_bf16(bf_lo(v.y) * sw, bf_hi(v.y) * sw); o.z = cvt_pk_bf16(bf_lo(v.z) * sw, bf_hi(v.z) * sw); o.w = cvt_pk_bf16(bf_lo(v.w) * sw, bf_hi(v.w) * sw);
                *(LAS v4u*)(lds + L_K + img_off(row, ch)) = o; }
        }
        __syncthreads();
        f32x4 af32[8];
        if (!m1) { const int u2 = u - N_M1, b = u2 >> 7, n = (u2 >> 3) & 15, grp = u2 & 7;
            const float* src = sgu_w + (size_t)grp * 16384 + (size_t)(16 * wave + l15) * 128 + 8 * g;
#pragma unroll
            for (int ks = 0; ks < 4; ++ks) { af32[2 * ks] = *(const f32x4*)(src + 32 * ks); af32[2 * ks + 1] = *(const f32x4*)(src + 32 * ks + 4); }
            const bf16* up = Z + ((size_t)b * TL + n * 128 + 16 * wave + l15) * ZW + ZU + grp * 256 + 4 * g;
#pragma unroll
            for (int et = 0; et < 16; ++et) uw[et] = *(const v2u*)(up + 16 * et); }
        if (u + G < N_M1 + N_SGU) P4_ISSUE(u + G);
        if (!m1) {
#pragma unroll
            for (int ks = 0; ks < 4; ++ks) { const f32x4 a = af32[2 * ks], b2 = af32[2 * ks + 1];
                const v4u p = {cvt_pk_bf16(a[0], a[1]), cvt_pk_bf16(a[2], a[3]), cvt_pk_bf16(b2[0], b2[1]), cvt_pk_bf16(b2[2], b2[3])}; Af[ks] = __builtin_bit_cast(bf16x8, p); } }
        if (m1) {
            const int bhd = u / 17, c = u - bhd * 17;
#pragma unroll
            for (int ks = 0; ks < 4; ++ks) Af[ks] = tr_frag(lds + L_K, 32 * ks + 8 * g, 32 * ks + 8 * g + 4, wave, lane);
            f32x4 acc[17];
#pragma unroll
            for (int et = 0; et < 17; ++et) acc[et] = (f32x4){0.f, 0.f, 0.f, 0.f};
#pragma unroll
            for (int et = 0; et < 16; ++et) { LAS unsigned char* img = lds + ((et >> 3) ? L_V1 : L_V0);
#pragma unroll
                for (int ks = 0; ks < 4; ++ks) { const bf16x8 Bf = tr_frag2(img + 8192 * ks, xn0[et & 7], xn1[et & 7]); acc[et] = MFMA16(Af[ks], Bf, acc[et]); } }
            { const short one = l15 == 0 ? (short)0x3F80 : (short)0; const bf16x8 Bo = {one, one, one, one, one, one, one, one};
#pragma unroll
                for (int ks = 0; ks < 4; ++ks) acc[16] = MFMA16(Af[ks], Bo, acc[16]); }
            bf16* dst = DC + ((size_t)bhd * 17 + c) * (CROWS * 128) + 16 * wave + 4 * g;
#pragma unroll
            for (int et = 0; et < 16; ++et) { v2u o; o.x = cvt_pk_bf16(acc[et][0], acc[et][1]); o.y = cvt_pk_bf16(acc[et][2], acc[et][3]); *(v2u*)(dst + (size_t)(16 * et + l15) * 128) = o; }
            if (l15 == 0) { v2u o; o.x = cvt_pk_bf16(acc[16][0], acc[16][1]); o.y = cvt_pk_bf16(acc[16][2], acc[16][3]); *(v2u*)(dst + (size_t)256 * 128) = o; }
        } else {
            const int u2 = u - N_M1, b = u2 >> 7, n = (u2 >> 3) & 15, grp = u2 & 7; const size_t row0 = (size_t)b * TL + n * 128;
            f32x4 acc[16];
#pragma unroll
            for (int et = 0; et < 16; ++et) { acc[et] = (f32x4){0.f, 0.f, 0.f, 0.f}; LAS unsigned char* img = lds + ((et >> 3) ? L_V1 : L_V0);
#pragma unroll
                for (int ks = 0; ks < 4; ++ks) { const bf16x8 Bf = tr_frag2(img + 8192 * ks, xn0[et & 7], xn1[et & 7]); acc[et] = MFMA16(Bf, Af[ks], acc[et]); } }
            { const int t = 16 * wave + l15; const float zb = sgu_b[grp * 128 + t]; const size_t row = row0 + t;
#pragma unroll
              for (int et = 0; et < 16; ++et) { const int col = grp * 256 + 16 * et + 4 * g; const v2u w2 = uw[et];
                  const float o0 = gelu_tanh(bf_lo(w2.x)) * (acc[et][0] + zb), o1 = gelu_tanh(bf_hi(w2.x)) * (acc[et][1] + zb), o2 = gelu_tanh(bf_lo(w2.y)) * (acc[et][2] + zb), o3 = gelu_tanh(bf_hi(w2.y)) * (acc[et][3] + zb);
                  v2u o; o.x = cvt_pk_bf16(o0, o1); o.y = cvt_pk_bf16(o2, o3); *(v2u*)(CM + row * DM + col) = o; } }
        }
        __syncthreads();
    }
#undef P4_ISSUE
}

__device__ __forceinline__ void p5_scan(int tid, int G, const bf16* DC, const float* BEND, const float* GMAX, bf16* CS, float* MST) {
    constexpr int QPB = 257 * 128 / 4;
    for (int idx = blockIdx.x * NTHR + tid; idx < 64 * QPB; idx += G * NTHR) {
        const int bhd = idx / QPB, q = idx - bhd * QPB;
        f32x4 C = {0.f, 0.f, 0.f, 0.f}; float m = 0.f;
#pragma unroll
        for (int c = 0; c < 17; ++c) {
            const float gm = GMAX[bhd * 17 + c], be = BEND[bhd * 17 + c], mx = fmaxf(m, gm), al = __expf(m - mx), bt = __expf(gm - mx);
            const v2u dw = *(const v2u*)(DC + ((size_t)bhd * 17 + c) * (CROWS * 128) + 4 * q); const f32x4 d = {bf_lo(dw.x), bf_hi(dw.x), bf_lo(dw.y), bf_hi(dw.y)};
            C = C * al + d * bt; m = be + mx;
            if (c >= 1) { v2u o; o.x = cvt_pk_bf16(C[0], C[1]); o.y = cvt_pk_bf16(C[2], C[3]);
                *(v2u*)(CS + ((size_t)bhd * 16 + (c - 1)) * (CROWS * 128) + 4 * q) = o; if (q == 0) MST[bhd * 18 + c + 1] = m; }
        }
    }
}

__device__ __forceinline__ void p6_phase(LAS unsigned char* lds, int tid, int wave, int lane_, int G, const bf16* Z, const bf16* QC, const bf16* KC, const float* SCN,
                                         const bf16* CS, const float* MST, const float* mnorm_g, bf16* RO) {
    for (int u = blockIdx.x; u < 512; u += G) {
        int lane = lane_; asm volatile("" : "+v"(lane)); const unsigned g = lane >> 4, l15 = lane & 15;
        const int bh = u >> 4, jb = u & 15, b = bh >> 3, h = bh & 7; const size_t row0 = (size_t)b * TL + jb * 128;
        load_tile128(lds + L_K, KC + row0 * 1024 + h * QKD, 1024, tid);
        load_tile128(lds + L_V0, Z + row0 * ZW + ZV + h * VD, ZW, tid);
        load_tile128(lds + L_V1, Z + row0 * ZW + ZV + h * VD + 128, ZW, tid);
        bf16x8 Qf[4];
#pragma unroll
        for (int ks = 0; ks < 4; ++ks) Qf[ks] = *(const bf16x8*)(QC + (row0 + 16 * wave + l15) * 1024 + h * QKD + 32 * ks + 8 * g);
        __syncthreads();
        f32x4 hsum[16];
#pragma unroll
        for (int et = 0; et < 16; ++et) hsum[et] = (f32x4){0.f, 0.f, 0.f, 0.f};
#pragma unroll 1
        for (int dir = 0; dir < 2; ++dir) {
            int lane = lane_; asm volatile("" : "+v"(lane));
            const unsigned g = lane >> 4, l15 = lane & 15;
            TR_PERM_OFFS(xp, lane)
            const int c = dir ? 17 - jb : 2 + jb; const bf16* cs = CS + ((size_t)(bh * 2 + dir) * 16 + (c - 2)) * (CROWS * 128);
            const float* sp = SCN + (size_t)((bh * 2 + dir) * NCH + 2 + jb) * 384; const float* gg = sp + 128; const float mc = MST[(bh * 2 + dir) * 18 + c];
            const int tS = 16 * wave + l15; const float MtS = fmaxf(mc, sp[256 + tS]);
            unsigned pw[16];
#pragma unroll
            for (int st = 0; st < 8; ++st) { f32x4 aS = {0.f, 0.f, 0.f, 0.f};
#pragma unroll
                for (int ks = 0; ks < 4; ++ks) { const bf16x8 Kf = *(const LAS bf16x8*)(lds + L_K + img_off(16 * st + l15, 4 * ks + g)); aS = MFMA16(Kf, Qf[ks], aS); }
                float pv[4]; const f32x4 gs = *(const f32x4*)(gg + 16 * st + 4 * g);
#pragma unroll
                for (int r = 0; r < 4; ++r) { const int s = 16 * st + 4 * g + r; const bool ok = dir ? (s >= tS) : (s <= tS); const float ev = __expf(fminf(gs[r] - MtS, 0.f)); pv[r] = ok ? aS[r] * ev : 0.f; }
                pw[2 * st] = cvt_pk_bf16(pv[0], pv[1]); pw[2 * st + 1] = cvt_pk_bf16(pv[2], pv[3]); asm volatile("" ::: "memory"); }
            bf16x8 Pf[4];
#pragma unroll
            for (int ks = 0; ks < 4; ++ks) { const v4u t4 = {pw[4 * ks], pw[4 * ks + 1], pw[4 * ks + 2], pw[4 * ks + 3]}; Pf[ks] = __builtin_bit_cast(bf16x8, t4); }
            const float wiT = __expf(mc - MtS), flT = __expf(-(sp[tS] + MtS));
            const short one = l15 == 0 ? (short)0x3F80 : (short)0; const bf16x8 Bo = {one, one, one, one, one, one, one, one};
            float inv;
            { f32x4 ad = {0.f, 0.f, 0.f, 0.f};
#pragma unroll
              for (int ks = 0; ks < 4; ++ks) { bf16x8 Cf = *(const bf16x8*)(cs + (size_t)256 * 128 + 32 * ks + 8 * g); if (l15 != 0) Cf = (bf16x8){0, 0, 0, 0, 0, 0, 0, 0}; ad = MFMA16(Cf, Qf[ks], ad); }
              ad[0] *= wiT;
#pragma unroll
              for (int ks = 0; ks < 4; ++ks) ad = MFMA16(Bo, Pf[ks], ad);
              const float den = __shfl(ad[0], lane & 15); inv = 1.0f / fmaxf(fabsf(den), flT); }
            { v4u cr[2];
#pragma unroll
              for (int i = 0; i < 2; ++i) { const int id = tid + NTHR * i; cr[i] = *(const v4u*)(cs + (size_t)(id >> 4) * 128 + 8 * (id & 15)); }
#pragma unroll
              for (int i = 0; i < 2; ++i) { const int id = tid + NTHR * i; *(LAS v4u*)(lds + L_CB + img_off(id >> 4, id & 15)) = cr[i]; }
#pragma unroll
              for (int gq = 0; gq < 4; ++gq) {
                LAS unsigned char* cb = lds + L_CB + (gq & 1) * 16384;
                __syncthreads();
                if (gq < 3) {
#pragma unroll
                    for (int i = 0; i < 2; ++i) { const int id = tid + NTHR * i; cr[i] = *(const v4u*)(cs + (size_t)(64 * (gq + 1) + (id >> 4)) * 128 + 8 * (id & 15)); } }
                f32x4 acc[4];
#pragma unroll
                for (int i = 0; i < 4; ++i) { acc[i] = (f32x4){0.f, 0.f, 0.f, 0.f};
#pragma unroll
                    for (int ks = 0; ks < 4; ++ks) { const bf16x8 Cf = *(const LAS bf16x8*)(cb + img_off(16 * i + l15, 4 * ks + g)); acc[i] = MFMA16(Cf, Qf[ks], acc[i]); } }
#pragma unroll
                for (int i = 0; i < 4; ++i) acc[i] = acc[i] * wiT;
                { LAS unsigned char* img = lds + ((gq >> 1) ? L_V1 : L_V0);
#pragma unroll
                  for (int i = 0; i < 4; ++i) {
#pragma unroll
                    for (int ks = 0; ks < 4; ++ks) { const bf16x8 Vf = tr_frag2(img + 8192 * ks, xp[4 * (gq & 1) + i], xp[4 * (gq & 1) + i] + 4096u); acc[i] = MFMA16(Vf, Pf[ks], acc[i]); } } }
#pragma unroll
                for (int i = 0; i < 4; ++i) hsum[4 * gq + i] += acc[i] * inv;
                if (gq < 3) {
#pragma unroll
                    for (int i = 0; i < 2; ++i) { const int id = tid + NTHR * i; *(LAS v4u*)(lds + L_CB + ((gq + 1) & 1) * 16384 + img_off(id >> 4, id & 15)) = cr[i]; } }
              } }
        }
        { float ss = 0.f;
#pragma unroll
          for (int et = 0; et < 16; ++et) ss += (hsum[et][0] * hsum[et][0] + hsum[et][1] * hsum[et][1]) + (hsum[et][2] * hsum[et][2] + hsum[et][3] * hsum[et][3]);
          ss += __shfl_xor(ss, 16); ss += __shfl_xor(ss, 32);
          const float rstd = 1.0f / sqrtf(ss * (1.0f / VD) + EPS); const size_t row = row0 + 16 * wave + l15;
#pragma unroll
          for (int et = 0; et < 16; ++et) { const int col = h * VD + 16 * et + 4 * g;
              const v2u ow = *(const v2u*)(Z + row * ZW + ZO + col); const f32x4 gn = *(const f32x4*)(mnorm_g + col);
              const float v0 = hsum[et][0] * rstd * gn[0] * sigmoidf_(bf_lo(ow.x)), v1 = hsum[et][1] * rstd * gn[1] * sigmoidf_(bf_hi(ow.x));
              const float v2 = hsum[et][2] * rstd * gn[2] * sigmoidf_(bf_lo(ow.y)), v3 = hsum[et][3] * rstd * gn[3] * sigmoidf_(bf_hi(ow.y));
              v2u o; o.x = cvt_pk_bf16(v0, v1); o.y = cvt_pk_bf16(v2, v3); *(v2u*)(RO + row * DM + col) = o; } }
        __syncthreads();
    }
}

__device__ __forceinline__ void p9_phase(LAS unsigned char* lds, int wave, int lane, int G, const float* X1, const float* MOD, const float* norm_g, const bf16* SK, const float* router_b,
                                         unsigned* cnt, unsigned char* XG, int* RE, int* RR, float* RG) {
    LAS float* hrow = (LAS float*)(lds + wave * 8192); LAS float* part = (LAS float*)(lds + 65536);
    f32x4 vn[8];
    { const float* xr = X1 + (size_t)(blockIdx.x * 8 + wave) * DM;
#pragma unroll
      for (int j = 0; j < 8; ++j) vn[j] = *(const f32x4*)(xr + 4 * (lane + 64 * j)); }
    for (int it = blockIdx.x; it < NLAT / 8; it += G) {
        const int row = it * 8 + wave;
        const float* shift = MOD + (size_t)(row >> 11) * 12288 + 3 * 2048; const float* scale = shift + 2048;
        f32x4 v[8]; float ss = 0.f;
#pragma unroll
        for (int j = 0; j < 8; ++j) { v[j] = vn[j]; ss += (v[j][0] * v[j][0] + v[j][1] * v[j][1]) + (v[j][2] * v[j][2] + v[j][3] * v[j][3]); }
        const float rstd = 1.0f / sqrtf(wave_sum(ss) * (1.0f / DM) + EPS);
#pragma unroll
        for (int j = 0; j < 8; ++j) { const int col = 4 * (lane + 64 * j);
            const f32x4 g = *(const f32x4*)(norm_g + col), sc = *(const f32x4*)(scale + col), sh = *(const f32x4*)(shift + col);
            v[j] = (v[j] * rstd) * g * (sc + 1.0f) + sh; *(LAS f32x4*)(hrow + col) = v[j]; }
        if (it + G < NLAT / 8) { const float* xr = X1 + (size_t)((it + G) * 8 + wave) * DM;
#pragma unroll
            for (int j = 0; j < 8; ++j) vn[j] = *(const f32x4*)(xr + 4 * (lane + 64 * j)); }
        __syncthreads();
        skinny_mfma((const LAS float*)lds, SK + 2 * 65536, SK + 3 * 65536, part, wave, lane);
        __syncthreads();
        float val = router_b[lane & 31];
#pragma unroll
        for (int w = 0; w < 8; ++w) val += part[w * 256 + wave * 32 + (lane & 31)];
        float sv[4]; int si[4];
#pragma unroll
        for (int k = 0; k < 4; ++k) { float bv = val; int bi = lane & 31;
#pragma unroll
            for (int o = 16; o >= 1; o >>= 1) { const float ov = __shfl_xor(bv, o); const int oi = __shfl_xor(bi, o); const bool take = (ov > bv) || (ov == bv && oi < bi); bv = take ? ov : bv; bi = take ? oi : bi; }
            sv[k] = bv; si[k] = __builtin_amdgcn_readfirstlane(bi); if ((lane & 31) == bi) val = -3.0e38f; }
        const float e1 = __expf(sv[1] - sv[0]), e2 = __expf(sv[2] - sv[0]), e3 = __expf(sv[3] - sv[0]), inv = 1.0f / (1.0f + e1 + e2 + e3);
        const float gk[4] = {inv, e1 * inv, e2 * inv, e3 * inv};
        unsigned rank = 0;
        if (lane < 4) rank = __hip_atomic_fetch_add(cnt + (lane == 0 ? si[0] : lane == 1 ? si[1] : lane == 2 ? si[2] : si[3]), 1u, RLX_AGENT);
#pragma unroll
        for (int k = 0; k < 4; ++k) { const unsigned rk = (unsigned)__builtin_amdgcn_readlane((int)rank, k);
            unsigned char* dst = XG + ((size_t)si[k] * 8192 + rk) * DM;
#pragma unroll
            for (int j = 0; j < 8; ++j) *(unsigned*)(dst + 4 * (lane + 64 * j)) = pg8::pk4_fp8(v[j][0] * pg8::F8_SA, v[j][1] * pg8::F8_SA, v[j][2] * pg8::F8_SA, v[j][3] * pg8::F8_SA);
            if (lane == 0) { RE[row * 4 + k] = si[k]; RR[row * 4 + k] = (int)rk; RG[row * 4 + k] = gk[k]; } }
    }
}
__device__ __forceinline__ void moe_prefix(LAS int* pref, const unsigned* cnt, int tid) {
    if (tid == 0) { int s = 0; for (int e = 0; e < 32; ++e) { const unsigned ce = __hip_atomic_load(cnt + e, RLX_AGENT); pref[e] = s; pref[33 + e] = (int)ce; s += (int)((ce + 255u) >> 8); } pref[32] = s; }
    __syncthreads();
}
__device__ __forceinline__ void p12_phase(const LAS int* pref, int wave, int lane_, int G, const float* X1, const float* MOD, const bf16* Y2, const int* RE, const int* RR, const float* RG, const float* final_g, float* out) {
    const int gw = blockIdx.x * NWAVES + wave, NGW = G * NWAVES;
    int en[4], rn[4]; float gn[4];
    if (gw < NLAT) {
#pragma unroll
        for (int k = 0; k < 4; ++k) { en[k] = RE[gw * 4 + k]; rn[k] = RR[gw * 4 + k]; gn[k] = RG[gw * 4 + k]; } }
    for (int row = gw; row < NLAT; row += NGW) {
        int lane = lane_; asm volatile("" : "+v"(lane));
        const float* xr = X1 + (size_t)row * DM + 4 * lane; f32x4 xv[8]; v2u yv[4][8]; float gt[4];
#pragma unroll
        for (int k = 0; k < 4; ++k) { gt[k] = gn[k]; const bf16* src = Y2 + ((size_t)pref[en[k]] * 256 + rn[k]) * DM + 4 * lane;
#pragma unroll
            for (int j = 0; j < 8; ++j) yv[k][j] = __builtin_nontemporal_load((const v2u*)(src + 256 * j)); }
#pragma unroll
        for (int j = 0; j < 8; ++j) xv[j] = __builtin_nontemporal_load((const f32x4*)(xr + 256 * j));
        if (row + NGW < NLAT) { const int r2 = row + NGW;
#pragma unroll
            for (int k = 0; k < 4; ++k) { en[k] = RE[r2 * 4 + k]; rn[k] = RR[r2 * 4 + k]; gn[k] = RG[r2 * 4 + k]; } }
        const float* g5 = MOD + (size_t)(row >> 11) * 12288 + 5 * 2048; float ss = 0.f;
#pragma unroll
        for (int j = 0; j < 8; ++j) { f32x4 ys = {0.f, 0.f, 0.f, 0.f};
#pragma unroll
            for (int k = 0; k < 4; ++k) { const v2u y = yv[k][j]; ys[0] += gt[k] * bf_lo(y.x); ys[1] += gt[k] * bf_hi(y.x); ys[2] += gt[k] * bf_lo(y.y); ys[3] += gt[k] * bf_hi(y.y); }
            const int col = 4 * (lane + 64 * j); const f32x4 x2 = xv[j] + *(const f32x4*)(g5 + col) * ys; xv[j] = x2;
            ss += (x2[0] * x2[0] + x2[1] * x2[1]) + (x2[2] * x2[2] + x2[3] * x2[3]); }
        const float rstd = 1.0f / sqrtf(wave_sum(ss) * (1.0f / DM) + EPS);
#pragma unroll
        for (int j = 0; j < 8; ++j) { const int col = 4 * (lane + 64 * j); __builtin_nontemporal_store(xv[j] * rstd * *(const f32x4*)(final_g + col), (f32x4*)(out + (size_t)row * DM + col)); }
    }
}

#define XB_TMO      128
#define XB_XCNT(j)  (256  + 64 * (j))
#define XB_XSUB(j)  (1280 + 64 * (j))
#define XB_XGEN(j)  (2304 + 64 * (j))
#define XB_TOP      3328
#define XB_TOPGEN   3392
#define XCD_BAR_WORDS 3456
#define XB_SPIN_CAP (1u << 18)

__device__ __forceinline__ unsigned xb_ld(unsigned* p)              { return __hip_atomic_load(p, __ATOMIC_RELAXED, __HIP_MEMORY_SCOPE_AGENT); }
__device__ __forceinline__ unsigned xb_add(unsigned* p, unsigned v) { return __hip_atomic_fetch_add(p, v, __ATOMIC_RELAXED, __HIP_MEMORY_SCOPE_AGENT); }
__device__ __forceinline__ unsigned xb_xcc_id() { return (unsigned)__builtin_amdgcn_s_getreg((3 << 11) | 20) & 0xFu; }
#define XB_SPIN(cond, bar) do { unsigned _sp = 0; while (cond) { __builtin_amdgcn_s_sleep(1); \
    if ((++_sp & 255u) == 0u) { if (xb_ld(&(bar)[XB_TMO])) break; if (_sp > XB_SPIN_CAP) { atomicAdd(&(bar)[XB_TMO], 1u); break; } } } } while (0)

struct XcdBarrier {
    unsigned* bar; unsigned x;
    volatile LAS unsigned* st;
};

__device__ __forceinline__ XcdBarrier xcd_barrier_post(unsigned* bar, volatile LAS unsigned* st) {
    XcdBarrier b; b.bar = bar; b.x = xb_xcc_id(); b.st = st;
    if (threadIdx.x == 0) (void)xb_add(&bar[XB_XCNT(b.x)], 1u);
    return b;
}
__device__ __forceinline__ void xcd_barrier_complete(unsigned* bar, unsigned x, unsigned& nloc, unsigned& nx) {
    const unsigned G = gridDim.x * gridDim.y * gridDim.z;
    unsigned sum, cnt, mine, sp = 0u;
    for (;;) {
        sum = 0u; cnt = 0u; mine = 0u;
#pragma unroll
        for (unsigned j = 0; j < 16; ++j) { const unsigned c = xb_ld(&bar[XB_XCNT(j)]); sum += c; cnt += (c > 0u) ? 1u : 0u; mine = (j == x) ? c : mine; }
        if (sum == G) break;
        __builtin_amdgcn_s_sleep(1);
        if ((++sp & 255u) == 0u) { if (xb_ld(&bar[XB_TMO])) break; if (sp > XB_SPIN_CAP) { atomicAdd(&bar[XB_TMO], 1u); break; } }
    }
    nloc = mine > 0u ? mine : 1u; nx = cnt > 0u ? cnt : 1u;
}

__device__ __forceinline__ void xcd_barrier(const XcdBarrier& b) {
    asm volatile("s_waitcnt vmcnt(0)" ::: "memory");
    __syncthreads();
    if (threadIdx.x == 0) {
        unsigned* bar = b.bar;
        __builtin_amdgcn_s_waitcnt(0);
        unsigned nloc = b.st[0], nx = b.st[1];
        if (nloc == 0u) { xcd_barrier_complete(bar, b.x, nloc, nx); b.st[0] = nloc; b.st[1] = nx; }
        const unsigned old = xb_add(&bar[XB_XSUB(b.x)], 1u);
        const unsigned gen = old / nloc;
        if (old + 1u == (gen + 1u) * nloc) {
            __builtin_amdgcn_fence(__ATOMIC_RELEASE, "agent");
            asm volatile("s_waitcnt vmcnt(0)" ::: "memory");
            const unsigned og = xb_add(&bar[XB_TOP], 1u);
            const unsigned tg = og / nx;
            if (og + 1u == (tg + 1u) * nx) xb_add(&bar[XB_TOPGEN], 1u);
            else XB_SPIN(xb_ld(&bar[XB_TOPGEN]) == tg, bar);
            __builtin_amdgcn_fence(__ATOMIC_ACQUIRE, "agent");
            xb_add(&bar[XB_XGEN(b.x)], 1u);
            asm volatile("s_waitcnt vmcnt(0)" ::: "memory");
        } else {
            XB_SPIN(xb_ld(&bar[XB_XGEN(b.x)]) == gen, bar);
            __builtin_amdgcn_fence(__ATOMIC_ACQUIRE, "agent");
            asm volatile("s_waitcnt vmcnt(0)" ::: "memory");
        }
    }
    __syncthreads();
}

struct Args { const float* in[26]; float* out; unsigned char* ws; int ph_lo, ph_hi; };
__global__ void __launch_bounds__(NTHR, 2) mk_fwd(Args args) {
    extern __shared__ __attribute__((aligned(16))) unsigned char lds_raw[];
    LAS unsigned char* lds = (LAS unsigned char*)lds_raw;
    const int tid = threadIdx.x, lane = tid & 63, wave = __builtin_amdgcn_readfirstlane(tid >> 6), G = gridDim.x;
    unsigned char* ws = args.ws;
    gu32* ctl = (gu32*)(ws + WS_CTL);
    for (int u = tid; u < (LDS_BYTES - LDSCTL_OFF) / 4; u += NTHR) ((LAS unsigned*)(lds + LDSCTL_OFF))[u] = 0u;
    __syncthreads();
    volatile LAS unsigned* MISC = (volatile LAS unsigned*)(lds + MISC_OFF);
    XcdBarrier bar; bar.bar = (unsigned*)(ctl + CW_BAR); bar.x = 0; bar.st = nullptr;
    if (N_LAUNCHES == 1) bar = xcd_barrier_post((unsigned*)(ctl + CW_BAR), MISC + 8);
#define GRID_BAR() do { if (N_LAUNCHES == 1) xcd_barrier(bar); } while (0)
    const int lo = args.ph_lo, hi = args.ph_hi;
#ifdef ONLY_PHASE
#define IN(k) ((k) == ONLY_PHASE && lo <= (k) && (k) < hi)
#else
#define IN(k) (lo <= (k) && (k) < hi)
#endif
#define BOTH(k) (IN(k) && IN((k) + 1))
#ifndef REP_MASK
#define REP_MASK 0
#endif
#define NREP(k) ((((REP_MASK) >> (k)) & 1) ? 2 : 1)
#define INP(i) (args.in[i])
#define WSF(off) ((float*)(ws + (off)))
#define WSB(off) ((bf16*)(ws + (off)))
#define WSI(off) ((int*)(ws + (off)))
    unsigned* cnt = (unsigned*)(ctl + CW_CNT);
    LAS int* pref = (LAS int*)(lds + PREF_OFF);
    const int n_conv_p0 = I_WIN + 3 * I_P;
#define x_in INP(0)
#define cvec INP(1)
#define ctx INP(2)
#define c_ctx INP(3)
#define mod_w INP(4)
#define mod_b INP(5)
#define norm1_g INP(6)
#define norm2_g INP(7)
#define w_in INP(8)
#define gate_b INP(9)
#define conv_w INP(10)
#define conv_b INP(11)
#define mnorm_g INP(12)
#define sgu_norm_g INP(13)
#define sgu_w INP(14)
#define sgu_b INP(15)
#define proj_a INP(16)
#define proj_b INP(17)
#define w_out INP(18)
#define router_w INP(19)
#define router_b INP(20)
#define exp_w1 INP(21)
#define exp_b1 INP(22)
#define exp_w2 INP(23)
#define exp_b2 INP(24)
#define final_g INP(25)
#define MOD WSF(WS_MOD)
#define GATES WSF(WS_GATES)
#define BEND WSF(WS_SCAL)
#define GMAX (WSF(WS_SCAL) + 64 * 17)
#define MST (WSF(WS_SCAL) + 2 * 64 * 17)
#define RE WSI(WS_ROUTE)
#define RR (WSI(WS_ROUTE) + NLAT * 4)
#define RG (WSF(WS_ROUTE) + 2 * NLAT * 4)
#define WINT WSB(WS_WINT)
#define SKW WSB(WS_SK)
#define SCN WSF(WS_SCN)
#define PAT WSB(WS_PAT)
#define PBT WSB(WS_PBT)
#define WOT WSB(WS_WOT)
#define W1T WSB(WS_W1T)
#define W1T8 ((unsigned char*)(ws + WS_W1T))
#define HB8M ((unsigned char*)(ws + WS_HB8))
#define WG8M ((unsigned char*)(ws + WS_WG8))
#define W2T8 ((unsigned char*)(ws + WS_W2T))
#define XG8 ((unsigned char*)(ws + WS_XG))
#define ACT8 ((unsigned char*)(ws + WS_ACT))
#define W2T WSB(WS_W2T)
#define HB WSB(WS_HB)
#define Z WSB(WS_Z)
#define QC WSB(WS_QC)
#define KC WSB(WS_KC)
#define SVN WSB(WS_SVN)
#define DC WSB(WS_DC)
#define CS WSB(WS_CS)
#define RO WSB(WS_RO)
#define CM WSB(WS_CM)
#define YB WSF(WS_YB)
#define MRG WSB(WS_MRG)
#define X1 WSF(WS_X1)
#define ACT WSB(WS_ACT)
#define Y2 WSB(WS_Y2)
#define XG WSB(WS_XG)

    if (IN(0)) for (int rep_ = 0; rep_ < NREP(0); ++rep_) { p0_phase(lds, tid, G, cvec, c_ctx, mod_w, mod_b, MOD, w_in, proj_a, proj_b, w_out, exp_w1, exp_w2, router_w, WINT, PAT, PBT, WOT, W1T, W2T, SKW, n_conv_p0);
        cvt_run8(lds, tid, I_W1 + I_W2 + (int)blockIdx.x, G, I_W1 + I_W2 + I_GATE8, exp_w1, exp_w2, w_in, W1T8, W2T8, WG8M); if (BOTH(0) || rep_ + 1 < NREP(0)) GRID_BAR(); }
    if (IN(1)) for (int rep_ = 0; rep_ < NREP(1); ++rep_) { p1_phase(lds, tid, wave, lane, G, x_in, ctx, MOD, norm1_g, SKW, gate_b, HB, HB8M, GATES); if (BOTH(1) || rep_ + 1 < NREP(1)) GRID_BAR(); }
    if (IN(2)) for (int rep_ = 0; rep_ < NREP(2); ++rep_) {
        if ((int)blockIdx.x >= G - (G == 256 ? N_CONVERTERS : G))
            cvt_run8(lds, tid, (int)blockIdx.x - (G - (G == 256 ? N_CONVERTERS : G)), (G == 256 ? N_CONVERTERS : G), I_W1 + I_W2, exp_w1, exp_w2, w_in, W1T8, W2T8, WG8M);
        { pg8::Gemm g{HB, WINT, NTOK, ZW, DM}; pg8::DynOrder S{(unsigned*)(ctl + CW_Q), (LAS int*)(lds + PREF_OFF + 800), (int)(blockIdx.x & 7), 40, 8}; pg8::EpiBf16 E{Z, ZW, nullptr, ZW / 256};
          pg8::gemm_phase<pg8::EpiBf16, pg8::DynOrder, true, true>(lds, g, S, E); }
        { pg8::Gemm g{(const bf16*)HB8M, (const bf16*)WG8M, NLAT, 4096, DM}; pg8::DynOrder S{(unsigned*)(ctl + CW_Q2), (LAS int*)(lds + PREF_OFF + 808), (int)(blockIdx.x & 7), 16, 0}; pg8::EpiGate8 E{Z + ZGA, ZW};
          pg8::gemm_phase8<pg8::EpiGate8, pg8::DynOrder, true, true>(lds, g, S, E); }
        if (BOTH(2) || rep_ + 1 < NREP(2)) GRID_BAR();
    }
    if (IN(3)) for (int rep_ = 0; rep_ < NREP(3); ++rep_) { p3_phase(wave, lane, G, Z, conv_w, conv_b, sgu_norm_g, QC, KC, SVN, GATES, SCN, BEND, GMAX); if (BOTH(3) || rep_ + 1 < NREP(3)) GRID_BAR(); }
    if (IN(4)) for (int rep_ = 0; rep_ < NREP(4); ++rep_) { p4_phase(lds, tid, wave, lane, G, Z, KC, SVN, SCN, sgu_w, sgu_b, DC, GMAX, CM); if (BOTH(4) || rep_ + 1 < NREP(4)) GRID_BAR(); }
    if (IN(5)) for (int rep_ = 0; rep_ < NREP(5); ++rep_) {
        { pg8::Gemm g{CM, PBT, NLAT, DM, DM}; pg8::StaticOrder S; S.init(NLAT, DM, G, (int)blockIdx.x); pg8::EpiF32 E{YB, DM};
          pg8::gemm_phase<pg8::EpiF32, pg8::StaticOrder, true, true>(lds, g, S, E); }
        p5_scan(tid, G, DC, BEND, GMAX, CS, MST);
        if (BOTH(5) || rep_ + 1 < NREP(5)) GRID_BAR();
    }
    if (IN(6)) for (int rep_ = 0; rep_ < NREP(6); ++rep_) { p6_phase(lds, tid, wave, lane, G, Z, QC, KC, SCN, CS, MST, mnorm_g, RO); if (BOTH(6) || rep_ + 1 < NREP(6)) GRID_BAR(); }
    if (IN(7)) for (int rep_ = 0; rep_ < NREP(7); ++rep_) {
        pg8::Gemm g{RO, PAT, NLAT, DM, DM}; pg8::StaticOrder S; S.init(NLAT, DM, G, (int)blockIdx.x); pg8::EpiMerge E{MRG, Z, ZW, ZGA, ZGB, YB};
        pg8::gemm_phase<pg8::EpiMerge, pg8::StaticOrder, true, true>(lds, g, S, E);
        if (BOTH(7) || rep_ + 1 < NREP(7)) GRID_BAR();
    }
    if (IN(8)) for (int rep_ = 0; rep_ < NREP(8); ++rep_) {
        pg8::Gemm g{MRG, WOT, NLAT, DM, DM}; pg8::StaticOrder S; S.init(NLAT, DM, G, (int)blockIdx.x); pg8::EpiX1 E{X1, x_in, MOD};
        pg8::gemm_phase<pg8::EpiX1, pg8::StaticOrder, true, true>(lds, g, S, E);
        if (BOTH(8) || rep_ + 1 < NREP(8)) GRID_BAR();
    }
    if (IN(9)) for (int rep_ = 0; rep_ < NREP(9); ++rep_) { p9_phase(lds, wave, lane, G, X1, MOD, norm2_g, SKW, router_b, cnt, XG8, RE, RR, RG); if (BOTH(9) || rep_ + 1 < NREP(9)) GRID_BAR(); }
    if (IN(10)) for (int rep_ = 0; rep_ < NREP(10); ++rep_) {
        moe_prefix(pref, cnt, tid);
        pg8::Gemm g{(const bf16*)XG8, (const bf16*)W1T8, 0, 0, DM}; pg8::MoeOrder S{pref, 16, G, (int)blockIdx.x, 1}; pg8::EpiSwiglu8 E{ACT8, exp_b1};
        pg8::gemm_phase8<pg8::EpiSwiglu8, pg8::MoeOrder, true, true, true>(lds, g, S, E);
        if (BOTH(10) || rep_ + 1 < NREP(10)) GRID_BAR();
    }
    if (IN(11)) for (int rep_ = 0; rep_ < NREP(11); ++rep_) {
        moe_prefix(pref, cnt, tid);
        pg8::Gemm g{(const bf16*)ACT8, (const bf16*)W2T8, 0, 0, DEXP}; pg8::MoeOrder S{pref, 8, G, (int)blockIdx.x, 0}; pg8::EpiY2f8 E{Y2, exp_b2};
        pg8::gemm_phase8<pg8::EpiY2f8, pg8::MoeOrder, true, true, true>(lds, g, S, E);
        if (BOTH(11) || rep_ + 1 < NREP(11)) GRID_BAR();
    }
    if (IN(12)) for (int rep_ = 0; rep_ < NREP(12); ++rep_) { moe_prefix(pref, cnt, tid); p12_phase(pref, wave, lane, G, X1, MOD, Y2, RE, RR, RG, final_g, args.out); if (rep_ + 1 < NREP(12)) GRID_BAR(); }
#undef IN
#undef BOTH
}

extern "C" void kernel_launch(void* const* d_in, const int* in_sizes, int n_in, void* d_out, int out_size, void* d_ws, size_t ws_size, hipStream_t stream) {
    static int grid = 0;
    if (grid == 0) {
        if (n_in != 26 || out_size != NLAT * DM || ws_size < WS_END) { fprintf(stderr, "kernel_launch: unexpected shapes (n_in %d, out %d, ws %zu)\n", n_in, out_size, ws_size); grid = -1; return; }
        int dev = 0, cus = 0;
        if (hipGetDevice(&dev) != hipSuccess || hipDeviceGetAttribute(&cus, hipDeviceAttributeMultiprocessorCount, dev) != hipSuccess) { grid = -1; return; }
        if (hipFuncSetAttribute((const void*)mk_fwd, hipFuncAttributeMaxDynamicSharedMemorySize, LDS_BYTES) != hipSuccess) { fprintf(stderr, "kernel_launch: hipFuncSetAttribute failed\n"); grid = -1; return; }
        int per_cu = 0;
        if (hipOccupancyMaxActiveBlocksPerMultiprocessor(&per_cu, (const void*)mk_fwd, NTHR, LDS_BYTES) != hipSuccess || per_cu < 1) fprintf(stderr, "kernel_launch: occupancy query reports %d\n", per_cu);
        (void)hipGetLastError();
        grid = cus;
    }
    if (grid < 0) return;
    if (hipMemsetAsync((char*)d_ws + WS_CTL, 0, CTL_ZERO_BYTES, stream) != hipSuccess) return;
    Args a{};
    for (int i = 0; i < 26; ++i) a.in[i] = (const float*)d_in[i];
    a.out = (float*)d_out; a.ws = (unsigned char*)d_ws;
    for (int li = 0; li < N_LAUNCHES; ++li) {
        a.ph_lo = (N_LAUNCHES == 1) ? 0 : li; a.ph_hi = (N_LAUNCHES == 1) ? N_PHASES : li + 1;
        hipLaunchKernelGGL(mk_fwd, dim3(grid), dim3(NTHR), LDS_BYTES, stream, a);
        const hipError_t le = hipPeekAtLastError();
        if (le != hipSuccess) { fprintf(stderr, "kernel_launch: launch %d failed: %s\n", li, hipGetErrorName(le)); break; }
    }
}
```

```cpp
#include <hip/hip_runtime.h>
#include <cstdio>
#include <cstdint>
#ifndef MK_N_LAUNCHES
#define MK_N_LAUNCHES 1
#endif
namespace pg8 {
#define PG8_LAS __attribute__((address_space(3)))
typedef unsigned short bf16_t;
typedef short bf16x8 __attribute__((ext_vector_type(8)));
typedef float f32x4 __attribute__((ext_vector_type(4)));
typedef unsigned u32x4 __attribute__((ext_vector_type(4)));
typedef int i32x4 __attribute__((ext_vector_type(4)));
typedef int i32x8 __attribute__((ext_vector_type(8)));
constexpr int BM = 256, BK = 64, HALF = 128, HTB = HALF * BK * 2  , STAGE_BYTES = 8 * HTB, NXCD = 8, WGM = 8;

__host__ __device__ __forceinline__ int lds_byte(int r, int c) { const int st = (r >> 4) * 2 + (c >> 5), rr = r & 15, cc = c & 31, ob = rr * 64 + cc * 2; return st * 1024 + (ob ^ (((ob >> 9) & 1) << 5)); }
__host__ __device__ __forceinline__ void stage_rc(int b, int& R, int& C) { const int st = b / 1024, sb = b % 1024, swz = sb ^ (((sb >> 9) & 1) << 5); R = (st >> 1) * 16 + swz / 64; C = (st & 1) * 32 + (swz % 64) / 2; }
__host__ __device__ __forceinline__ int perm32(int rho) { const int n = rho >> 4, i = rho & 15; return 8 * (i >> 2) + 4 * n + (i & 3); }

struct Unit { int pm, pn, po, hf; };
struct Gemm { const bf16_t* A; const bf16_t* Bt; int M, N, K; };

struct StaticOrder {
    int nM, nN, nwg, G, c;
    __host__ __device__ void init(int M, int N, int G_, int c_) { nM = M / BM; nN = N / BM; nwg = nM * nN; G = G_; c = c_; }
    __host__ __device__ bool next(int i, Unit& u) const {
        const long L = (long)i * G + c; if (L >= nwg) return false;
        int wgid = (int)L; { const int q = nwg / NXCD, r = nwg % NXCD, xcd = wgid % NXCD, off = wgid / NXCD; wgid = (xcd < r ? xcd * (q + 1) : r * (q + 1) + (xcd - r) * q) + off; }
        const int nig = WGM * nN, gid = wgid / nig, fm = gid * WGM, gsz = (nM - fm) < WGM ? (nM - fm) : WGM;
        u.pm = fm + ((wgid % nig) % gsz); u.pn = (wgid % nig) / gsz; u.po = u.pm; u.hf = 0; return true;
    }
    __device__ __forceinline__ void a_ready(const Unit&) const {}
    __device__ __forceinline__ void done(const Unit&) const {}
};
struct DynOrder {
    unsigned* q; PG8_LAS int* slot; int xcd, nN, ctx8, pn0;
    __device__ __forceinline__ bool next(int i, Unit& u) const {
        if (threadIdx.x == 0) { int id = -1;
            unsigned v = __hip_atomic_fetch_add(q + 64 * xcd, 1u, __ATOMIC_RELAXED, __HIP_MEMORY_SCOPE_AGENT);
            const unsigned per = (unsigned)(4 * nN + ctx8);
            if (v < per) id = xcd * (int)per + (int)v;
            else {
#pragma unroll 1
                for (int k = 1; k < 8 && id < 0; ++k) { const int x = (xcd + k) & 7;
                    if (__hip_atomic_load(q + 64 * x, __ATOMIC_RELAXED, __HIP_MEMORY_SCOPE_AGENT) < per) { v = __hip_atomic_fetch_add(q + 64 * x, 1u, __ATOMIC_RELAXED, __HIP_MEMORY_SCOPE_AGENT); if (v < per) id = x * (int)per + (int)v; } } }
            slot[i & 1] = id; asm volatile("s_waitcnt lgkmcnt(0)" ::: "memory"); }
        asm volatile("" ::: "memory"); __builtin_amdgcn_s_barrier(); asm volatile("" ::: "memory");
        const int id = slot[i & 1]; if (id < 0) return false;
        const int per = 4 * nN + ctx8, nl = 4 * nN, x = id / per, v = id - x * per;
        if (v < nl) { const int wgid = x * nl + v, nig = WGM * nN, gid = wgid / nig; u.pm = gid * WGM + ((wgid % nig) % WGM); u.pn = pn0 + (wgid % nig) / WGM; }
        else { const int j = x * 8 + (v - nl); u.pm = 32 + (j & 3); u.pn = j >> 2; }
        u.po = u.pm; u.hf = 0; return true;
    }
    __device__ __forceinline__ void a_ready(const Unit&) const {}
    __device__ __forceinline__ void done(const Unit&) const {}
};
struct MoeOrder {
    const PG8_LAS int* pref; int nN, G, c, a_sparse;
    __device__ __forceinline__ bool next(int i, Unit& u) const {
        const int L = i * G + c, total = pref[32]; if (L >= total * nN) return false;
        const int mt = L / nN, nt = L - mt * nN; int e = 0;
        for (int k = 1; k < 32; ++k) e += (pref[k] <= mt) ? 1 : 0;
        u.pm = a_sparse ? e * 32 + (mt - pref[e]) : mt; u.pn = e * nN + nt; u.po = mt; u.hf = (pref[33 + e] - 256 * (mt - pref[e]) <= 128) ? 1 : 0; return true;
    }
    __device__ __forceinline__ void a_ready(const Unit&) const {}
    __device__ __forceinline__ void done(const Unit&) const {}
};

__device__ __forceinline__ unsigned cvt_pk_bf16(float lo, float hi) { unsigned r; asm volatile("v_cvt_pk_bf16_f32 %0, %1, %2" : "=v"(r) : "v"(lo), "v"(hi)); return r; }
__device__ __forceinline__ float bf_lo(unsigned w) { return __uint_as_float(w << 16); }
__device__ __forceinline__ float bf_hi(unsigned w) { return __uint_as_float(w & 0xffff0000u); }
__device__ __forceinline__ unsigned pk4_fp8(float a, float b, float c, float d) {
    a = fminf(fmaxf(a, -448.f), 448.f); b = fminf(fmaxf(b, -448.f), 448.f); c = fminf(fmaxf(c, -448.f), 448.f); d = fminf(fmaxf(d, -448.f), 448.f);
    int p = __builtin_amdgcn_cvt_pk_fp8_f32(a, b, 0, false); p = __builtin_amdgcn_cvt_pk_fp8_f32(c, d, p, true); return (unsigned)p; }
constexpr float F8_SA = 16.0f, F8_SW = 512.0f, F8_SC = 4.0f;
__device__ __forceinline__ float sigmoidf_(float x) { return __builtin_amdgcn_rcpf(1.0f + __expf(-x)); }

struct EpiBf16 {
    static constexpr bool PERM = true, AFTER_DRAIN = false;
    bf16_t* O; int ldc; const float* bias; int ncolt;
    __device__ __forceinline__ void operator()(const f32x4 (&acc)[2][2][4][2], const Unit& u, int wr, int wc, int fr, int fq) const {
        const int row0 = u.po * BM + wr * 64 + fr; const int colt = (u.pn % ncolt) * BM;
        const int col0 = colt + wc * 32 + 8 * fq, bcol0 = u.pn * BM + wc * 32 + 8 * fq;
        f32x4 bv[2][2];
#pragma unroll
        for (int bj = 0; bj < 2; ++bj)
#pragma unroll
            for (int n = 0; n < 2; ++n) bv[bj][n] = bias ? *(const f32x4*)(bias + bcol0 + bj * HALF + 4 * n) : (f32x4){0.f, 0.f, 0.f, 0.f};
#pragma unroll
        for (int ai = 0; ai < 2; ++ai)
#pragma unroll
            for (int m = 0; m < 4; ++m) { bf16_t* rowp = O + (size_t)(row0 + ai * HALF + m * 16) * ldc + col0;
#pragma unroll
                for (int bj = 0; bj < 2; ++bj) { const f32x4 v0 = acc[ai][bj][m][0] + bv[bj][0], v1 = acc[ai][bj][m][1] + bv[bj][1];
                    u32x4 w; w.x = cvt_pk_bf16(v0[0], v0[1]); w.y = cvt_pk_bf16(v0[2], v0[3]); w.z = cvt_pk_bf16(v1[0], v1[1]); w.w = cvt_pk_bf16(v1[2], v1[3]);
                    __builtin_nontemporal_store(w, (u32x4*)(rowp + bj * HALF)); } }
    }
};
struct EpiSwiglu8 {
    static constexpr bool PERM = true, AFTER_DRAIN = false;
    unsigned char* O; const float* b1;
    __device__ __forceinline__ void operator()(const f32x4 (&acc)[2][2][4][2], const Unit& u, int wr, int wc, int fr, int fq) const {
        const int e = u.pn >> 4, nt = u.pn & 15; const int row0 = u.po * BM + wr * 64 + fr, j0 = nt * 128 + wc * 32 + 8 * fq;
        const float* bg = b1 + (size_t)e * 4096 + j0; const float* bl = bg + 2048; constexpr float us = 1.0f / (F8_SA * F8_SW);
#pragma unroll
        for (int ai = 0; ai < 2; ++ai)
#pragma unroll
            for (int m = 0; m < 4; ++m) { const size_t row = (size_t)(row0 + ai * HALF + m * 16);
                asm volatile("" ::: "memory");
                unsigned w[2];
#pragma unroll
                for (int n = 0; n < 2; ++n) { const f32x4 gv = acc[ai][0][m][n] * us + *(const f32x4*)(bg + 4 * n), lv = acc[ai][1][m][n] * us + *(const f32x4*)(bl + 4 * n);
                    float o[4];
#pragma unroll
                    for (int i = 0; i < 4; ++i) { const float ga = fminf(gv[i], 7.0f), la = fminf(fmaxf(lv[i], -7.0f), 7.0f); o[i] = ga * sigmoidf_(1.702f * ga) * (la + 1.0f) * F8_SC; }
                    w[n] = pk4_fp8(o[0], o[1], o[2], o[3]); }
                typedef unsigned u32x2 __attribute__((ext_vector_type(2))); const u32x2 ww = {w[0], w[1]};
                *(u32x2*)(O + row * 2048 + j0) = ww; }
    }
};
struct EpiY2f8 {
    static constexpr bool PERM = true, AFTER_DRAIN = false;
    bf16_t* O; const float* bias;
    __device__ __forceinline__ void operator()(const f32x4 (&acc)[2][2][4][2], const Unit& u, int wr, int wc, int fr, int fq) const {
        const int row0 = u.po * BM + wr * 64 + fr; const int col0 = (u.pn & 7) * BM + wc * 32 + 8 * fq, bcol0 = u.pn * BM + wc * 32 + 8 * fq; constexpr float us = 1.0f / (F8_SC * F8_SW);
        f32x4 bv[2][2];
#pragma unroll
        for (int bj = 0; bj < 2; ++bj)
#pragma unroll
            for (int n = 0; n < 2; ++n) bv[bj][n] = *(const f32x4*)(bias + bcol0 + bj * HALF + 4 * n);
#pragma unroll
        for (int ai = 0; ai < 2; ++ai)
#pragma unroll
            for (int m = 0; m < 4; ++m) { bf16_t* rowp = O + (size_t)(row0 + ai * HALF + m * 16) * 2048 + col0;
#pragma unroll
                for (int bj = 0; bj < 2; ++bj) { const f32x4 v0 = acc[ai][bj][m][0] * us + bv[bj][0], v1 = acc[ai][bj][m][1] * us + bv[bj][1];
                    u32x4 w; w.x = cvt_pk_bf16(v0[0], v0[1]); w.y = cvt_pk_bf16(v0[2], v0[3]); w.z = cvt_pk_bf16(v1[0], v1[1]); w.w = cvt_pk_bf16(v1[2], v1[3]);
                    __builtin_nontemporal_store(w, (u32x4*)(rowp + bj * HALF)); } }
    }
};
struct EpiGate8 {
    static constexpr bool PERM = true, AFTER_DRAIN = false;
    bf16_t* O; int ldc;
    __device__ __forceinline__ void operator()(const f32x4 (&acc)[2][2][4][2], const Unit& u, int wr, int wc, int fr, int fq) const {
        const int row0 = u.po * BM + wr * 64 + fr, col0 = (u.pn < 24 ? u.pn : u.pn + 8) * BM + wc * 32 + 8 * fq; constexpr float us = 1.0f / (F8_SA * F8_SW);
#pragma unroll
        for (int ai = 0; ai < 2; ++ai)
#pragma unroll
            for (int m = 0; m < 4; ++m) { bf16_t* rowp = O + (size_t)(row0 + ai * HALF + m * 16) * ldc + col0;
#pragma unroll
                for (int bj = 0; bj < 2; ++bj) { const f32x4 v0 = acc[ai][bj][m][0] * us, v1 = acc[ai][bj][m][1] * us;
                    u32x4 w; w.x = cvt_pk_bf16(v0[0], v0[1]); w.y = cvt_pk_bf16(v0[2], v0[3]); w.z = cvt_pk_bf16(v1[0], v1[1]); w.w = cvt_pk_bf16(v1[2], v1[3]);
                    __builtin_nontemporal_store(w, (u32x4*)(rowp + bj * HALF)); } }
    }
};
struct EpiF32 {
    static constexpr bool PERM = false, AFTER_DRAIN = false;
    float* C; int ldc;
    __device__ __forceinline__ void operator()(const f32x4 (&acc)[2][2][4][2], const Unit& u, int wr, int wc, int fr, int fq) const {
        const int row0 = u.po * BM + wr * 64 + fr, col0 = u.pn * BM + wc * 32 + 4 * fq;
#pragma unroll
        for (int ai = 0; ai < 2; ++ai)
#pragma unroll
            for (int m = 0; m < 4; ++m) { float* rowp = C + (size_t)(row0 + ai * HALF + m * 16) * ldc + col0;
#pragma unroll
                for (int bj = 0; bj < 2; ++bj)
#pragma unroll
                    for (int n = 0; n < 2; ++n) *(f32x4*)(rowp + bj * HALF + n * 16) = acc[ai][bj][m][n]; }
    }
};
struct EpiMerge {
    static constexpr bool PERM = true, AFTER_DRAIN = false;
    bf16_t* O; const bf16_t* Z; int ldz, ga_off, gb_off; const float* YB;
    __device__ __forceinline__ void operator()(const f32x4 (&acc)[2][2][4][2], const Unit& u, int wr, int wc, int fr, int fq) const {
        const int row0 = u.po * BM + wr * 64 + fr, col0 = u.pn * BM + wc * 32 + 8 * fq;
#pragma unroll
        for (int ai = 0; ai < 2; ++ai)
#pragma unroll
            for (int m = 0; m < 4; ++m) { const size_t row = (size_t)(row0 + ai * HALF + m * 16);
#pragma unroll
                for (int bj = 0; bj < 2; ++bj) { const int col = col0 + bj * HALF;
                    const u32x4 ga = *(const u32x4*)(Z + row * ldz + ga_off + col), gb = *(const u32x4*)(Z + row * ldz + gb_off + col);
                    const f32x4 y0 = *(const f32x4*)(YB + row * 2048 + col), y1 = *(const f32x4*)(YB + row * 2048 + col + 4);
                    const f32x4 a0 = acc[ai][bj][m][0], a1 = acc[ai][bj][m][1];
                    float o[8];
                    o[0] = sigmoidf_(bf_lo(ga.x)) * a0[0] + sigmoidf_(bf_lo(gb.x)) * y0[0]; o[1] = sigmoidf_(bf_hi(ga.x)) * a0[1] + sigmoidf_(bf_hi(gb.x)) * y0[1];
                    o[2] = sigmoidf_(bf_lo(ga.y)) * a0[2] + sigmoidf_(bf_lo(gb.y)) * y0[2]; o[3] = sigmoidf_(bf_hi(ga.y)) * a0[3] + sigmoidf_(bf_hi(gb.y)) * y0[3];
                    o[4] = sigmoidf_(bf_lo(ga.z)) * a1[0] + sigmoidf_(bf_lo(gb.z)) * y1[0]; o[5] = sigmoidf_(bf_hi(ga.z)) * a1[1] + sigmoidf_(bf_hi(gb.z)) * y1[1];
                    o[6] = sigmoidf_(bf_lo(ga.w)) * a1[2] + sigmoidf_(bf_lo(gb.w)) * y1[2]; o[7] = sigmoidf_(bf_hi(ga.w)) * a1[3] + sigmoidf_(bf_hi(gb.w)) * y1[3];
                    u32x4 w; w.x = cvt_pk_bf16(o[0], o[1]); w.y = cvt_pk_bf16(o[2], o[3]); w.z = cvt_pk_bf16(o[4], o[5]); w.w = cvt_pk_bf16(o[6], o[7]);
                    *(u32x4*)(O + row * 2048 + col) = w; } }
    }
};
struct EpiX1 {
    static constexpr bool PERM = false, AFTER_DRAIN = false;
    float* X1; const float* X; const float* mod;
    __device__ __forceinline__ void operator()(const f32x4 (&acc)[2][2][4][2], const Unit& u, int wr, int wc, int fr, int fq) const {
        const int row0 = u.po * BM + wr * 64 + fr, col0 = u.pn * BM + wc * 32 + 4 * fq;
        const float* mg = mod + (size_t)((u.po * BM) >> 11) * 12288 + 2 * 2048;
#pragma unroll
        for (int bj = 0; bj < 2; ++bj)
#pragma unroll
            for (int n = 0; n < 2; ++n) { const int col = col0 + bj * HALF + n * 16; const f32x4 g = *(const f32x4*)(mg + col);
#pragma unroll
                for (int ai = 0; ai < 2; ++ai)
#pragma unroll
                    for (int m = 0; m < 4; ++m) { const size_t off = (size_t)(row0 + ai * HALF + m * 16) * 2048 + col;
                        *(f32x4*)(X1 + off) = *(const f32x4*)(X + off) + g * acc[ai][bj][m][n]; } }
    }
};
struct EpiSwiglu {
    static constexpr bool PERM = true, AFTER_DRAIN = false;
    bf16_t* O; const float* b1;
    __device__ __forceinline__ void operator()(const f32x4 (&acc)[2][2][4][2], const Unit& u, int wr, int wc, int fr, int fq) const {
        const int e = u.pn >> 4, nt = u.pn & 15; const int row0 = u.po * BM + wr * 64 + fr, j0 = nt * 128 + wc * 32 + 8 * fq;
        const float* bg = b1 + (size_t)e * 4096 + j0; const float* bl = bg + 2048;
#pragma unroll
        for (int ai = 0; ai < 2; ++ai)
#pragma unroll
            for (int m = 0; m < 4; ++m) { const size_t row = (size_t)(row0 + ai * HALF + m * 16);
                asm volatile("" ::: "memory");
#pragma unroll
                for (int n = 0; n < 2; ++n) { const f32x4 gv = acc[ai][0][m][n] + *(const f32x4*)(bg + 4 * n), lv = acc[ai][1][m][n] + *(const f32x4*)(bl + 4 * n);
                    float o[4];
#pragma unroll
                    for (int i = 0; i < 4; ++i) { const float ga = fminf(gv[i], 7.0f), la = fminf(fmaxf(lv[i], -7.0f), 7.0f); o[i] = ga * sigmoidf_(1.702f * ga) * (la + 1.0f); }
                    typedef unsigned u32x2 __attribute__((ext_vector_type(2))); u32x2 w; w.x = cvt_pk_bf16(o[0], o[1]); w.y = cvt_pk_bf16(o[2], o[3]);
                    *(u32x2*)(O + row * 2048 + j0 + 4 * n) = w; } }
    }
};

template <class Epi, class Sched, bool ALIGN_EPI = false, bool SP2 = false, bool HALFSKIP = false>
__device__ __forceinline__ void gemm_phase(PG8_LAS unsigned char* lds, const Gemm g, const Sched& S, const Epi& E) {
    const int tid = threadIdx.x, wid = __builtin_amdgcn_readfirstlane(tid >> 6), lane = tid & 63, wr = wid >> 2, wc = wid & 3, fr = lane & 15, fq = lane >> 4;
    const int K = g.K, nt = K / BK;
    unsigned voffA[2], voffB[2];
#pragma unroll
    for (int i = 0; i < 2; ++i) { int R, C; stage_rc(tid * 16 + i * 8192, R, C); const int Rb = Epi::PERM ? ((R & ~31) + perm32(R & 31)) : R;
        voffA[i] = (unsigned)(R * K + C) * 2u; voffB[i] = (unsigned)(Rb * K + C) * 2u; }
    const size_t kstep = (size_t)(BK * 2);
    const size_t hstep = (size_t)HALF * K * 2;
    const size_t tstep = 2 * hstep;
    const unsigned ldsw = (unsigned)wid * 1024u;
    const int aoff = lds_byte(wr * 64 + fr, fq * 8), boff = lds_byte(wc * 32 + fr, fq * 8);
#define PG8_SA(b, h) (((b) * 2 + (h)) * HTB)
#define PG8_SB(b, h) ((4 + (b) * 2 + (h)) * HTB)
#define PG8_STAGE(bufoff, gbase, voff) do { _Pragma("unroll") for (int _i = 0; _i < 2; ++_i) \
        __builtin_amdgcn_global_load_lds((const unsigned*)((const char*)(gbase) + (voff)[_i]), (PG8_LAS unsigned*)(lds + (bufoff) + ldsw + _i * 8192), 16, 0, 0); } while (0)
#define PG8_LDA(dst, b, h) do { _Pragma("unroll") for (int m = 0; m < 4; ++m) _Pragma("unroll") for (int k = 0; k < 2; ++k) dst[m][k] = *(const PG8_LAS bf16x8*)(lds + PG8_SA(b, h) + aoff + m * 2048 + k * 1024); } while (0)
#define PG8_LDB(dst, b, h) do { _Pragma("unroll") for (int n = 0; n < 2; ++n) _Pragma("unroll") for (int k = 0; k < 2; ++k) dst[n][k] = *(const PG8_LAS bf16x8*)(lds + PG8_SB(b, h) + boff + n * 2048 + k * 1024); } while (0)
#define PG8_MMA(ai, bj, At, Bt) do { __builtin_amdgcn_s_setprio(1); _Pragma("unroll") for (int m = 0; m < 4; ++m) _Pragma("unroll") for (int n = 0; n < 2; ++n) _Pragma("unroll") for (int k = 0; k < 2; ++k) \
        acc[ai][bj][m][n] = __builtin_amdgcn_mfma_f32_16x16x32_bf16(Bt[n][k], At[m][k], acc[ai][bj][m][n], 0, 0, 0); __builtin_amdgcn_s_setprio(0); } while (0)
#define PG8_WAIT_V(n) asm volatile("s_waitcnt vmcnt(" #n ")" ::: "memory")
#define PG8_WAIT_L(n) asm volatile("s_waitcnt lgkmcnt(" #n ")" ::: "memory")
#define PG8_BAR __builtin_amdgcn_s_barrier()
#define PG8_SCHED __builtin_amdgcn_sched_barrier(0)
    Unit cur, nxt; int ui = 0;
    if (!S.next(0, cur)) return;
    f32x4 acc[2][2][4][2];
#pragma unroll
    for (int a = 0; a < 2; ++a)
#pragma unroll
        for (int b = 0; b < 2; ++b)
#pragma unroll
            for (int m = 0; m < 4; ++m)
#pragma unroll
                for (int n = 0; n < 2; ++n) acc[a][b][m][n] = (f32x4){0.f, 0.f, 0.f, 0.f};
    bf16x8 At[4][2], B0[2][2], B1[2][2];
    const char* cA = (const char*)g.A + (size_t)cur.pm * tstep; const char* cB = (const char*)g.Bt + (size_t)cur.pn * tstep;
    S.a_ready(cur);
    if constexpr (SP2) {
        PG8_STAGE(PG8_SB(0, 0), cB, voffB); PG8_STAGE(PG8_SB(0, 1), cB + hstep, voffB); PG8_STAGE(PG8_SA(0, 0), cA, voffA); PG8_STAGE(PG8_SA(0, 1), cA + hstep, voffA);
        if (wr == 1) PG8_BAR;
        PG8_WAIT_V(2); PG8_BAR;
        PG8_STAGE(PG8_SB(1, 0), cB + kstep, voffB); PG8_STAGE(PG8_SA(1, 0), cA + kstep, voffA); PG8_STAGE(PG8_SB(1, 1), cB + hstep + kstep, voffB);
        PG8_WAIT_V(6); PG8_BAR;
    } else {
        PG8_STAGE(PG8_SB(0, 0), cB, voffB); PG8_STAGE(PG8_SA(0, 0), cA, voffA); PG8_STAGE(PG8_SB(0, 1), cB + hstep, voffB); PG8_STAGE(PG8_SA(0, 1), cA + hstep, voffA);
        if (wr == 1) PG8_BAR;
        PG8_WAIT_V(4); PG8_BAR;
        PG8_STAGE(PG8_SB(1, 0), cB + kstep, voffB); PG8_STAGE(PG8_SA(1, 0), cA + kstep, voffA); PG8_STAGE(PG8_SB(1, 1), cB + hstep + kstep, voffB);
        PG8_WAIT_V(6); PG8_BAR;
    }
    for (;;) {
        const bool has_next = S.next(ui + 1, nxt);
        const char* nA = has_next ? (const char*)g.A + (size_t)nxt.pm * tstep : cA; const char* nB = has_next ? (const char*)g.Bt + (size_t)nxt.pn * tstep : cB;
        for (int t = 0; t < nt; t += 2) {
            const bool last = (t == nt - 2);
            const char* a1 = cA + (size_t)(t + 1) * kstep;
            const char* a2 = last ? nA : cA + (size_t)(t + 2) * kstep; const char* b2 = last ? nB : cB + (size_t)(t + 2) * kstep;
            const char* a3 = a2 + kstep; const char* b3 = b2 + kstep;
            if (last && has_next) S.a_ready(nxt);
            if constexpr (SP2) {
            PG8_LDB(B0, 0, 0); PG8_LDB(B1, 0, 1); PG8_SCHED; PG8_LDA(At, 0, 0); PG8_STAGE(PG8_SA(1, 1), a1 + hstep, voffA);
            PG8_WAIT_V(8); PG8_WAIT_L(0); PG8_BAR; PG8_MMA(0, 0, At, B0); PG8_MMA(0, 1, At, B1); PG8_BAR; PG8_SCHED;
            PG8_LDA(At, 0, 1); PG8_STAGE(PG8_SB(0, 0), b2, voffB); PG8_STAGE(PG8_SB(0, 1), b2 + hstep, voffB); PG8_STAGE(PG8_SA(0, 0), a2, voffA);
            PG8_WAIT_V(8); PG8_WAIT_L(0); PG8_BAR; if (!(HALFSKIP && cur.hf)) { PG8_MMA(1, 0, At, B0); PG8_MMA(1, 1, At, B1); } PG8_BAR; PG8_SCHED;
            PG8_LDB(B0, 1, 0); PG8_LDB(B1, 1, 1); PG8_SCHED; PG8_LDA(At, 1, 0); PG8_STAGE(PG8_SA(0, 1), a2 + hstep, voffA);
            PG8_WAIT_V(8); PG8_WAIT_L(0); PG8_BAR; PG8_MMA(0, 0, At, B0); PG8_MMA(0, 1, At, B1); PG8_BAR; PG8_SCHED;
            PG8_LDA(At, 1, 1); PG8_STAGE(PG8_SB(1, 0), b3, voffB); PG8_STAGE(PG8_SB(1, 1), b3 + hstep, voffB); PG8_STAGE(PG8_SA(1, 0), a3, voffA);
            PG8_WAIT_V(8); PG8_WAIT_L(0); PG8_BAR; if (!(HALFSKIP && cur.hf)) { PG8_MMA(1, 0, At, B0); PG8_MMA(1, 1, At, B1); } PG8_BAR; PG8_SCHED;
            } else {
            PG8_LDB(B0, 0, 0); PG8_SCHED; PG8_LDA(At, 0, 0); PG8_STAGE(PG8_SA(1, 1), a1 + hstep, voffA);
            PG8_WAIT_L(8); PG8_BAR; PG8_WAIT_L(0); PG8_MMA(0, 0, At, B0); PG8_BAR; PG8_SCHED;
            PG8_LDB(B1, 0, 1); PG8_STAGE(PG8_SB(0, 0), b2, voffB);
            PG8_BAR; PG8_WAIT_L(0); PG8_MMA(0, 1, At, B1); PG8_BAR;
            PG8_LDA(At, 0, 1); PG8_STAGE(PG8_SA(0, 0), a2, voffA);
            PG8_BAR; PG8_WAIT_L(0); PG8_MMA(1, 0, At, B0); PG8_BAR; PG8_SCHED;
            PG8_STAGE(PG8_SB(0, 1), b2 + hstep, voffB);
            PG8_WAIT_V(6); PG8_BAR; PG8_MMA(1, 1, At, B1); PG8_BAR;
            PG8_LDB(B0, 1, 0); PG8_SCHED; PG8_LDA(At, 1, 0); PG8_STAGE(PG8_SA(0, 1), a2 + hstep, voffA);
            PG8_WAIT_L(8); PG8_BAR; PG8_WAIT_L(0); PG8_MMA(0, 0, At, B0); PG8_BAR; PG8_SCHED;
            PG8_LDB(B1, 1, 1); PG8_STAGE(PG8_SB(1, 0), b3, voffB);
            PG8_BAR; PG8_WAIT_L(0); PG8_MMA(0, 1, At, B1); PG8_BAR;
            PG8_LDA(At, 1, 1); PG8_STAGE(PG8_SA(1, 0), a3, voffA);
            PG8_BAR; PG8_WAIT_L(0); PG8_MMA(1, 0, At, B0); PG8_BAR; PG8_SCHED;
            PG8_STAGE(PG8_SB(1, 1), b3 + hstep, voffB);
            PG8_WAIT_V(6); PG8_BAR; PG8_MMA(1, 1, At, B1); PG8_BAR;
            }
        }
        if constexpr (ALIGN_EPI) { if (wr == 0) PG8_BAR; }
        if constexpr (!Epi::AFTER_DRAIN) { E(acc, cur, wr, wc, fr, fq); S.done(cur); }
        if (!has_next) break;
#pragma unroll
        for (int a = 0; a < 2; ++a)
#pragma unroll
            for (int b = 0; b < 2; ++b)
#pragma unroll
                for (int m = 0; m < 4; ++m)
#pragma unroll
                    for (int n = 0; n < 2; ++n) acc[a][b][m][n] = (f32x4){0.f, 0.f, 0.f, 0.f};
        cur = nxt; cA = nA; cB = nB; ++ui;
        if constexpr (ALIGN_EPI) { if (wr == 1) PG8_BAR; }
    }
    PG8_WAIT_V(0);
    if constexpr (!ALIGN_EPI) { if (wr == 0) PG8_BAR; }
    PG8_BAR;
    if constexpr (Epi::AFTER_DRAIN) { E.fused(acc, cur, wr, wc, fr, fq, lds, wid, lane); S.done(cur); }
#undef PG8_SA
#undef PG8_SB
#undef PG8_STAGE
#undef PG8_LDA
#undef PG8_LDB
#undef PG8_MMA
#undef PG8_WAIT_V
#undef PG8_WAIT_L
#undef PG8_BAR
#undef PG8_SCHED
}
template <class Epi, class Sched, bool ALIGN_EPI = false, bool SP2 = false, bool HALFSKIP = false>
__device__ __forceinline__ void gemm_phase8(PG8_LAS unsigned char* lds, const Gemm g, const Sched& S, const Epi& E) {
    const int tid = threadIdx.x, wid = __builtin_amdgcn_readfirstlane(tid >> 6), lane = tid & 63, wr = wid >> 2, wc = wid & 3, fr = lane & 15, fq = lane >> 4;
    const int K = g.K, nt = K / 128;
    unsigned voffA[2], voffB[2];
#pragma unroll
    for (int i = 0; i < 2; ++i) { int R, C; stage_rc(tid * 16 + i * 8192, R, C); const int Rb = Epi::PERM ? ((R & ~31) + perm32(R & 31)) : R;
        voffA[i] = (unsigned)(R * K + 2 * C); voffB[i] = (unsigned)(Rb * K + 2 * C); }
    const size_t kstep = (size_t)(BK * 2);
    const size_t hstep = (size_t)HALF * K;
    const size_t tstep = 2 * hstep;
    const unsigned ldsw = (unsigned)wid * 1024u;
    const int aoff = lds_byte(wr * 64 + fr, fq * 16), boff = lds_byte(wc * 32 + fr, fq * 16);
#define PG8_SA(b, h) (((b) * 2 + (h)) * HTB)
#define PG8_SB(b, h) ((4 + (b) * 2 + (h)) * HTB)
#define PG8_STAGE(bufoff, gbase, voff) do { _Pragma("unroll") for (int _i = 0; _i < 2; ++_i) \
        __builtin_amdgcn_global_load_lds((const unsigned*)((const char*)(gbase) + (voff)[_i]), (PG8_LAS unsigned*)(lds + (bufoff) + ldsw + _i * 8192), 16, 0, 0); } while (0)
#define PG8_LDA(dst, b, h) do { _Pragma("unroll") for (int m = 0; m < 4; ++m) { const i32x4 lo_ = *(const PG8_LAS i32x4*)(lds + PG8_SA(b, h) + aoff + m * 2048), hi_ = *(const PG8_LAS i32x4*)(lds + PG8_SA(b, h) + aoff + m * 2048 + 16); dst[m] = __builtin_shufflevector(lo_, hi_, 0, 1, 2, 3, 4, 5, 6, 7); } } while (0)
#define PG8_LDB(dst, b, h) do { _Pragma("unroll") for (int n = 0; n < 2; ++n) { const i32x4 lo_ = *(const PG8_LAS i32x4*)(lds + PG8_SB(b, h) + boff + n * 2048), hi_ = *(const PG8_LAS i32x4*)(lds + PG8_SB(b, h) + boff + n * 2048 + 16); dst[n] = __builtin_shufflevector(lo_, hi_, 0, 1, 2, 3, 4, 5, 6, 7); } } while (0)
#define PG8_MMA(ai, bj, At, Bt) do { __builtin_amdgcn_s_setprio(1); _Pragma("unroll") for (int m = 0; m < 4; ++m) _Pragma("unroll") for (int n = 0; n < 2; ++n) \
        asm volatile("v_mfma_scale_f32_16x16x128_f8f6f4 %0, %1, %2, %0, %3, %3 op_sel_hi:[0,0,0]" : "+v"(acc[ai][bj][m][n]) : "v"(Bt[n]), "v"(At[m]), "v"(sc127)); __builtin_amdgcn_s_setprio(0); } while (0)
#define PG8_WAIT_V(n) asm volatile("s_waitcnt vmcnt(" #n ")" ::: "memory")
#define PG8_WAIT_L(n) asm volatile("s_waitcnt lgkmcnt(" #n ")" ::: "memory")
#define PG8_BAR __builtin_amdgcn_s_barrier()
#define PG8_SCHED __builtin_amdgcn_sched_barrier(0)
    Unit cur, nxt; int ui = 0;
    if (!S.next(0, cur)) return;
    f32x4 acc[2][2][4][2];
#pragma unroll
    for (int a = 0; a < 2; ++a)
#pragma unroll
        for (int b = 0; b < 2; ++b)
#pragma unroll
            for (int m = 0; m < 4; ++m)
#pragma unroll
                for (int n = 0; n < 2; ++n) acc[a][b][m][n] = (f32x4){0.f, 0.f, 0.f, 0.f};
    i32x8 At[4], B0[2], B1[2]; const int sc127 = 127;
    const char* cA = (const char*)g.A + (size_t)cur.pm * tstep; const char* cB = (const char*)g.Bt + (size_t)cur.pn * tstep;
    S.a_ready(cur);
    if constexpr (SP2) {
        PG8_STAGE(PG8_SB(0, 0), cB, voffB); PG8_STAGE(PG8_SB(0, 1), cB + hstep, voffB); PG8_STAGE(PG8_SA(0, 0), cA, voffA); PG8_STAGE(PG8_SA(0, 1), cA + hstep, voffA);
        if (wr == 1) PG8_BAR;
        PG8_WAIT_V(2); PG8_BAR;
        PG8_STAGE(PG8_SB(1, 0), cB + kstep, voffB); PG8_STAGE(PG8_SA(1, 0), cA + kstep, voffA); PG8_STAGE(PG8_SB(1, 1), cB + hstep + kstep, voffB);
        PG8_WAIT_V(6); PG8_BAR;
    } else {
        PG8_STAGE(PG8_SB(0, 0), cB, voffB); PG8_STAGE(PG8_SA(0, 0), cA, voffA); PG8_STAGE(PG8_SB(0, 1), cB + hstep, voffB); PG8_STAGE(PG8_SA(0, 1), cA + hstep, voffA);
        if (wr == 1) PG8_BAR;
        PG8_WAIT_V(4); PG8_BAR;
        PG8_STAGE(PG8_SB(1, 0), cB + kstep, voffB); PG8_STAGE(PG8_SA(1, 0), cA + kstep, voffA); PG8_STAGE(PG8_SB(1, 1), cB + hstep + kstep, voffB);
        PG8_WAIT_V(6); PG8_BAR;
    }
    for (;;) {
        const bool has_next = S.next(ui + 1, nxt);
        const char* nA = has_next ? (const char*)g.A + (size_t)nxt.pm * tstep : cA; const char* nB = has_next ? (const char*)g.Bt + (size_t)nxt.pn * tstep : cB;
        for (int t = 0; t < nt; t += 2) {
            const bool last = (t == nt - 2);
            const char* a1 = cA + (size_t)(t + 1) * kstep;
            const char* a2 = last ? nA : cA + (size_t)(t + 2) * kstep; const char* b2 = last ? nB : cB + (size_t)(t + 2) * kstep;
            const char* a3 = a2 + kstep; const char* b3 = b2 + kstep;
            if (last && has_next) S.a_ready(nxt);
            if constexpr (SP2) {
            PG8_LDB(B0, 0, 0); PG8_LDB(B1, 0, 1); PG8_SCHED; PG8_LDA(At, 0, 0); PG8_STAGE(PG8_SA(1, 1), a1 + hstep, voffA);
            PG8_WAIT_V(8); PG8_WAIT_L(0); PG8_BAR; PG8_MMA(0, 0, At, B0); PG8_MMA(0, 1, At, B1); PG8_BAR; PG8_SCHED;
            PG8_LDA(At, 0, 1); PG8_STAGE(PG8_SB(0, 0), b2, voffB); PG8_STAGE(PG8_SB(0, 1), b2 + hstep, voffB); PG8_STAGE(PG8_SA(0, 0), a2, voffA);
            PG8_WAIT_V(8); PG8_WAIT_L(0); PG8_BAR; if (!(HALFSKIP && cur.hf)) { PG8_MMA(1, 0, At, B0); PG8_MMA(1, 1, At, B1); } PG8_BAR; PG8_SCHED;
            PG8_LDB(B0, 1, 0); PG8_LDB(B1, 1, 1); PG8_SCHED; PG8_LDA(At, 1, 0); PG8_STAGE(PG8_SA(0, 1), a2 + hstep, voffA);
            PG8_WAIT_V(8); PG8_WAIT_L(0); PG8_BAR; PG8_MMA(0, 0, At, B0); PG8_MMA(0, 1, At, B1); PG8_BAR; PG8_SCHED;
            PG8_LDA(At, 1, 1); PG8_STAGE(PG8_SB(1, 0), b3, voffB); PG8_STAGE(PG8_SB(1, 1), b3 + hstep, voffB); PG8_STAGE(PG8_SA(1, 0), a3, voffA);
            PG8_WAIT_V(8); PG8_WAIT_L(0); PG8_BAR; if (!(HALFSKIP && cur.hf)) { PG8_MMA(1, 0, At, B0); PG8_MMA(1, 1, At, B1); } PG8_BAR; PG8_SCHED;
            } else {
            PG8_LDB(B0, 0, 0); PG8_SCHED; PG8_LDA(At, 0, 0); PG8_STAGE(PG8_SA(1, 1), a1 + hstep, voffA);
            PG8_WAIT_L(8); PG8_BAR; PG8_WAIT_L(0); PG8_MMA(0, 0, At, B0); PG8_BAR; PG8_SCHED;
            PG8_LDB(B1, 0, 1); PG8_STAGE(PG8_SB(0, 0), b2, voffB);
            PG8_BAR; PG8_WAIT_L(0); PG8_MMA(0, 1, At, B1); PG8_BAR;
            PG8_LDA(At, 0, 1); PG8_STAGE(PG8_SA(0, 0), a2, voffA);
            PG8_BAR; PG8_WAIT_L(0); PG8_MMA(1, 0, At, B0); PG8_BAR; PG8_SCHED;
            PG8_STAGE(PG8_SB(0, 1), b2 + hstep, voffB);
            PG8_WAIT_V(6); PG8_BAR; PG8_MMA(1, 1, At, B1); PG8_BAR;
            PG8_LDB(B0, 1, 0); PG8_SCHED; PG8_LDA(At, 1, 0); PG8_STAGE(PG8_SA(0, 1), a2 + hstep, voffA);
            PG8_WAIT_L(8); PG8_BAR; PG8_WAIT_L(0); PG8_MMA(0, 0, At, B0); PG8_BAR; PG8_SCHED;
            PG8_LDB(B1, 1, 1); PG8_STAGE(PG8_SB(1, 0), b3, voffB);
            PG8_BAR; PG8_WAIT_L(0); PG8_MMA(0, 1, At, B1); PG8_BAR;
            PG8_LDA(At, 1, 1); PG8_STAGE(PG8_SA(1, 0), a3, voffA);
            PG8_BAR; PG8_WAIT_L(0); PG8_MMA(1, 0, At, B0); PG8_BAR; PG8_SCHED;
            PG8_STAGE(PG8_SB(1, 1), b3 + hstep, voffB);
            PG8_WAIT_V(6); PG8_BAR; PG8_MMA(1, 1, At, B1); PG8_BAR;
            }
        }
        if constexpr (ALIGN_EPI) { if (wr == 0) PG8_BAR; }
        if constexpr (!Epi::AFTER_DRAIN) { E(acc, cur, wr, wc, fr, fq); S.done(cur); }
        if (!has_next) break;
#pragma unroll
        for (int a = 0; a < 2; ++a)
#pragma unroll
            for (int b = 0; b < 2; ++b)
#pragma unroll
                for (int m = 0; m < 4; ++m)
#pragma unroll
                    for (int n = 0; n < 2; ++n) acc[a][b][m][n] = (f32x4){0.f, 0.f, 0.f, 0.f};
        cur = nxt; cA = nA; cB = nB; ++ui;
        if constexpr (ALIGN_EPI) { if (wr == 1) PG8_BAR; }
    }
    PG8_WAIT_V(0);
    if constexpr (!ALIGN_EPI) { if (wr == 0) PG8_BAR; }
    PG8_BAR;
    if constexpr (Epi::AFTER_DRAIN) { E.fused(acc, cur, wr, wc, fr, fq, lds, wid, lane); S.done(cur); }
#undef PG8_SA
#undef PG8_SB
#undef PG8_STAGE
#undef PG8_LDA
#undef PG8_LDB
#undef PG8_MMA
#undef PG8_WAIT_V
#undef PG8_WAIT_L
#undef PG8_BAR
#undef PG8_SCHED
}
}

constexpr int NWAVES = 8, NTHR = 512;
constexpr int N_LAUNCHES = MK_N_LAUNCHES;
constexpr int N_PHASES = 13;
constexpr int DM = 2048, NB = 4, TL = 2048, NLAT = NB * TL, TCX = 256, NCTX = NB * TCX, NTOK = NLAT + NCTX;
constexpr int NH = 8, QKD = 128, VD = 256, INC = 14368, ZW = 14336;
constexpr int ZQ = 0, ZK = 1024, ZV = 2048, ZO = 4096, ZU = 6144, ZS = 8192, ZGA = 10240, ZGB = 12288;
constexpr int NEXP = 32, DEXP = 2048, NCH = 18  , CROWS = 272  ;
constexpr float EPS = 1e-6f;

constexpr size_t MiB = 1u << 20;
constexpr size_t WS_CTL = 0, CTL_ZERO_BYTES = 1 * MiB;
constexpr size_t WS_MOD = 1 * MiB;
constexpr size_t WS_GATES = 2 * MiB;
constexpr size_t WS_SCAL = 4 * MiB;
constexpr size_t WS_ROUTE = 5 * MiB;
constexpr size_t WS_SCN = 2996 * MiB;
constexpr size_t WS_SK = 6 * MiB;
constexpr size_t WS_WINT = 8 * MiB;
constexpr size_t WS_PAT = 64 * MiB, WS_PBT = 72 * MiB, WS_WOT = 80 * MiB;
constexpr size_t WS_W1T = 88 * MiB;
constexpr size_t WS_W2T = 600 * MiB;
constexpr size_t WS_HB = 856 * MiB;
constexpr size_t WS_Z = 892 * MiB;
constexpr size_t WS_QC = 1144 * MiB, WS_KC = 1162 * MiB;
constexpr size_t WS_SVN = 1180 * MiB;
constexpr size_t WS_DC = 1212 * MiB;
constexpr size_t WS_CS = 1360 * MiB;
constexpr size_t WS_RO = 1428 * MiB;
constexpr size_t WS_CM = 1460 * MiB;
constexpr size_t WS_YB = 1492 * MiB;
constexpr size_t WS_MRG = 1556 * MiB;
constexpr size_t WS_X1 = 1588 * MiB;
constexpr size_t WS_ACT = 1652 * MiB;
constexpr size_t WS_Y2 = 1812 * MiB;
constexpr size_t WS_XG = 1972 * MiB;
constexpr size_t WS_HB8 = 2998 * MiB;
constexpr size_t WS_WG8 = 3016 * MiB;
constexpr size_t WS_END = 3040 * MiB;
static_assert(WS_DC + (size_t)64 * 17 * CROWS * 128 * 2 <= WS_CS && WS_CS + (size_t)64 * 16 * CROWS * 128 * 2 <= WS_RO && WS_Z + (size_t)NTOK * ZW * 2 <= WS_QC, "ws map");
constexpr int CW_Q2 = 3072;
constexpr int CW_Q = 2048;
constexpr int CW_CNT = 64;
constexpr int CW_BAR = 4096;
constexpr int RING_BYTES = 131072;
constexpr int LDS_BYTES = 147456;
constexpr int LDSCTL_OFF = LDS_BYTES - 2048, MISC_OFF = LDSCTL_OFF + 320, PREF_OFF = LDSCTL_OFF + 1024;

#define GAS __attribute__((address_space(1)))
#define LAS __attribute__((address_space(3)))
typedef unsigned short bf16;
typedef unsigned v4u __attribute__((ext_vector_type(4)));
typedef unsigned v2u __attribute__((ext_vector_type(2)));
typedef float f32x4 __attribute__((ext_vector_type(4)));
typedef short bf16x8 __attribute__((ext_vector_type(8)));
typedef short s16x4 __attribute__((ext_vector_type(4)));
typedef GAS unsigned gu32;
#define RLX_AGENT __ATOMIC_RELAXED, __HIP_MEMORY_SCOPE_AGENT
#define LDS_WAIT() asm volatile("s_waitcnt lgkmcnt(0)" ::: "memory")
#define VM_WAIT() asm volatile("s_waitcnt vmcnt(0)" ::: "memory")
using pg8::cvt_pk_bf16; using pg8::bf_lo; using pg8::bf_hi; using pg8::sigmoidf_;


__device__ __forceinline__ float wave_sum(float v) {
#pragma unroll
    for (int o = 1; o < 64; o <<= 1) v += __shfl_xor(v, o);
    return v;
}
__device__ __forceinline__ float siluf_(float x) { return x * __builtin_amdgcn_rcpf(1.0f + __expf(-x)); }
__device__ __forceinline__ float gelu_tanh(float x) { const float u = 0.7978845608028654f * (x + 0.044715f * x * x * x); return x * __builtin_amdgcn_rcpf(1.0f + __expf(-2.0f * u)); }
__device__ __forceinline__ float logsigf_(float f) { return fminf(f, 0.f) - log1pf(expf(-fabsf(f))); }
__device__ __forceinline__ unsigned img_off(unsigned row, unsigned ch) { return 256u * row + 16u * (ch ^ (((row & 3u) << 2) | ((row >> 2) & 3u))); }
__device__ __forceinline__ s16x4 tr_read(LAS unsigned char* p) { return __builtin_amdgcn_ds_read_tr16_b64_v4i16((LAS s16x4*)p); }
__device__ __forceinline__ bf16x8 tr_frag(LAS unsigned char* img, unsigned r0, unsigned r1, unsigned c, int lane) {
    const unsigned q = (lane & 15) >> 2, p = lane & 3;
    const s16x4 lo = tr_read(img + img_off(r0 + q, 2 * c + (p >> 1)) + 8 * (p & 1));
    const s16x4 hi = tr_read(img + img_off(r1 + q, 2 * c + (p >> 1)) + 8 * (p & 1));
    bf16x8 r; r[0] = lo[0]; r[1] = lo[1]; r[2] = lo[2]; r[3] = lo[3]; r[4] = hi[0]; r[5] = hi[1]; r[6] = hi[2]; r[7] = hi[3]; return r;
}
__device__ __forceinline__ bf16x8 tr_frag2(LAS unsigned char* base, unsigned x0, unsigned x1) {
    const s16x4 lo = tr_read(base + x0), hi = tr_read(base + x1);
    bf16x8 r; r[0] = lo[0]; r[1] = lo[1]; r[2] = lo[2]; r[3] = lo[3]; r[4] = hi[0]; r[5] = hi[1]; r[6] = hi[2]; r[7] = hi[3]; return r;
}
#define TR_NAT_OFFS(xn0, xn1, lane) unsigned xn0[8], xn1[8]; { const unsigned g_ = (lane) >> 4, q_ = ((lane) & 15) >> 2, p_ = (lane) & 3; \
    _Pragma("unroll") for (int c_ = 0; c_ < 8; ++c_) { xn0[c_] = 256u * (8 * g_ + q_) + 16u * ((2 * c_ + (p_ >> 1)) ^ ((q_ << 2) | ((2 * g_) & 3))) + 8u * (p_ & 1); \
                                                       xn1[c_] = 256u * (8 * g_ + 4 + q_) + 16u * ((2 * c_ + (p_ >> 1)) ^ ((q_ << 2) | ((2 * g_ + 1) & 3))) + 8u * (p_ & 1); } }
#define TR_PERM_OFFS(xp, lane) unsigned xp[8]; { const unsigned g_ = (lane) >> 4, q_ = ((lane) & 15) >> 2, p_ = (lane) & 3; \
    _Pragma("unroll") for (int c_ = 0; c_ < 8; ++c_) xp[c_] = 256u * (4 * g_ + q_) + 16u * ((2 * c_ + (p_ >> 1)) ^ ((q_ << 2) | g_)) + 8u * (p_ & 1); }
__device__ __forceinline__ void load_tile128(LAS unsigned char* img, const bf16* src, size_t ld, int tid) {
#pragma unroll
    for (int i = 0; i < 4; ++i) { const int id = tid + NTHR * i, row = id >> 4, ch = id & 15;
        const v4u v = *(const v4u*)(src + (size_t)row * ld + 8 * ch); *(LAS v4u*)(img + img_off(row, ch)) = v; }
}
__device__ __forceinline__ void load_tile128_scaled(LAS unsigned char* img, const bf16* src, size_t ld, const LAS float* w, int tid) {
#pragma unroll
    for (int i = 0; i < 4; ++i) { const int id = tid + NTHR * i, row = id >> 4, ch = id & 15; const float s = w[row];
        const v4u v = *(const v4u*)(src + (size_t)row * ld + 8 * ch); v4u o;
        o.x = cvt_pk_bf16(bf_lo(v.x) * s, bf_hi(v.x) * s); o.y = cvt_pk_bf16(bf_lo(v.y) * s, bf_hi(v.y) * s); o.z = cvt_pk_bf16(bf_lo(v.z) * s, bf_hi(v.z) * s); o.w = cvt_pk_bf16(bf_lo(v.w) * s, bf_hi(v.w) * s);
        *(LAS v4u*)(img + img_off(row, ch)) = o; }
}
__device__ __forceinline__ void gate_scan(const float* G, size_t row0, int col_i, int col_f, int dir, int lane, float* bc, float* gg, float* pmx, float& b_end, float& gmax) {
    const int j0 = dir ? 127 - 2 * lane : 2 * lane, j1 = dir ? 126 - 2 * lane : 2 * lane + 1;
    const float f0 = G[(row0 + j0) * 32 + col_f], f1 = G[(row0 + j1) * 32 + col_f], i0 = G[(row0 + j0) * 32 + col_i], i1 = G[(row0 + j1) * 32 + col_i];
    const float lf0 = logsigf_(f0), lf1 = logsigf_(f1), s = lf0 + lf1; float incl = s;
#pragma unroll
    for (int o = 1; o < 64; o <<= 1) { const float t = __shfl_up(incl, o); if (lane >= o) incl += t; }
    const float b0 = (incl - s) + lf0, b1 = incl, g0 = i0 - b0, g1 = i1 - b1;
    float mincl = fmaxf(g0, g1);
#pragma unroll
    for (int o = 1; o < 64; o <<= 1) { const float t = __shfl_up(mincl, o); if (lane >= o) mincl = fmaxf(mincl, t); }
    float mexcl = __shfl_up(mincl, 1); if (lane == 0) mexcl = -3.0e38f;
    bc[j0] = b0; bc[j1] = b1; gg[j0] = g0; gg[j1] = g1; pmx[j0] = fmaxf(mexcl, g0); pmx[j1] = mincl;
    b_end = __shfl(incl, 63); gmax = __shfl(mincl, 63);
}
#define MFMA16(a, b, c) __builtin_amdgcn_mfma_f32_16x16x32_bf16((a), (b), (c), 0, 0, 0)

struct CvtItem { const float* src; size_t ldw; bf16* dst; };
constexpr int N_CONVERTERS = 128;
constexpr int N_CONV_DEFER = 1440;
constexpr int I_GEMV = 192, I_WIN = 16 * 8, I_GATE8 = 16 * 48, I_P = 16 * 8, I_W1 = 32 * 16 * 16, I_W2 = 32 * 16 * 8, I_TOTAL = I_GEMV + I_WIN + 3 * I_P + I_W1 + I_W2;
__device__ __forceinline__ CvtItem cvt_decode(int r, int tid, const float* w_in, const float* proj_a, const float* proj_b, const float* w_out, const float* exp_w1, const float* exp_w2,
                                              bf16* WINT, bf16* PAT, bf16* PBT, bf16* WOT, bf16* W1T, bf16* W2T) {
    const int n4 = tid & 63, kg = tid >> 6; const float* W; size_t ldw, ca, cb, drow; int kt; bf16* WT;
    if (r < I_WIN) { kt = r / 8; const int nt = 24 + r % 8; W = w_in; ldw = INC; ca = (size_t)256 * nt + 32; cb = ca + 128; WT = WINT; drow = (size_t)256 * nt; }
    else if ((r -= I_WIN) < 3 * I_P) { const int m = r / I_P, q = r % I_P; kt = q / 8; const int nt = q % 8; W = m == 0 ? proj_a : (m == 1 ? proj_b : w_out); ldw = 2048; ca = (size_t)256 * nt; cb = ca + 128; WT = m == 0 ? PAT : (m == 1 ? PBT : WOT); drow = (size_t)256 * nt; }
    else if ((r -= 3 * I_P) < I_W1) { const int e = r / 256, q = r % 256; kt = q / 16; const int nt = q % 16; W = exp_w1 + (size_t)e * 2048 * 4096; ldw = 4096; ca = (size_t)128 * nt; cb = 2048 + ca; WT = W1T; drow = (size_t)e * 4096 + 256 * nt; }
    else { r -= I_W1; const int e = r / 128, q = r % 128; kt = q / 8; const int nt = q % 8; W = exp_w2 + (size_t)e * 2048 * 2048; ldw = 2048; ca = (size_t)256 * nt; cb = ca + 128; WT = W2T; drow = (size_t)e * 2048 + 256 * nt; }
    CvtItem it; it.ldw = ldw; it.src = W + (size_t)(128 * kt + 8 * kg) * ldw + (n4 < 32 ? ca + 4 * n4 : cb + 4 * (n4 - 32)); it.dst = WT + drow * 2048 + 128 * kt; return it;
}
__device__ __forceinline__ void cvt_run(LAS unsigned char* lds, int tid, int it, int stride, int end, const float* w_in, const float* proj_a, const float* proj_b, const float* w_out, const float* exp_w1, const float* exp_w2,
                                        bf16* WINT, bf16* PAT, bf16* PBT, bf16* WOT, bf16* W1T, bf16* W2T) {
    const int n4 = tid & 63, kg = tid >> 6;
    f32x4 v[16]; CvtItem cur;
    bool have = it < end;
    if (have) { cur = cvt_decode(it - I_GEMV, tid, w_in, proj_a, proj_b, w_out, exp_w1, exp_w2, WINT, PAT, PBT, WOT, W1T, W2T);
#pragma unroll
        for (int i = 0; i < 16; ++i) v[i] = __builtin_nontemporal_load((const f32x4*)(cur.src + (size_t)((i >> 3) * 64 + (i & 7)) * cur.ldw)); }
    while (have) {
#pragma unroll
        for (int hf = 0; hf < 2; ++hf)
#pragma unroll
            for (int j = 0; j < 4; ++j) { v4u o; o.x = cvt_pk_bf16(v[8 * hf + 0][j], v[8 * hf + 1][j]); o.y = cvt_pk_bf16(v[8 * hf + 2][j], v[8 * hf + 3][j]); o.z = cvt_pk_bf16(v[8 * hf + 4][j], v[8 * hf + 5][j]); o.w = cvt_pk_bf16(v[8 * hf + 6][j], v[8 * hf + 7][j]);
                *(LAS v4u*)(lds + img_off(4 * n4 + j, 8 * hf + kg)) = o; }
        __syncthreads();
        bf16* dst = cur.dst;
        it += stride; have = it < end;
        if (have) { cur = cvt_decode(it - I_GEMV, tid, w_in, proj_a, proj_b, w_out, exp_w1, exp_w2, WINT, PAT, PBT, WOT, W1T, W2T);
#pragma unroll
            for (int i = 0; i < 16; ++i) v[i] = __builtin_nontemporal_load((const f32x4*)(cur.src + (size_t)((i >> 3) * 64 + (i & 7)) * cur.ldw)); }
#pragma unroll
        for (int i = 0; i < 8; ++i) { const int id = tid + NTHR * i, row = id >> 4, ch = id & 15; const v4u o = *(const LAS v4u*)(lds + img_off(row, ch)); __builtin_nontemporal_store(o, (v4u*)(dst + (size_t)row * 2048 + 8 * ch)); }
        __syncthreads();
    }
}
__device__ __forceinline__ void cvt_run8(LAS unsigned char* lds, int tid, int r, int stride, int end, const float* exp_w1, const float* exp_w2, const float* w_in, unsigned char* W1T8, unsigned char* W2T8, unsigned char* WG8) {
    const int n4 = tid & 63, kg = tid >> 6;
    f32x4 v[16]; const float* src = nullptr; size_t ldw = 0; unsigned char* dst = nullptr;
#define CVT8_DECODE(R) do { int q_ = (R); const float* W_; size_t ca_, cb_, drow_; int kt_; unsigned char* WT_; \
        if (q_ < I_W1) { const int e = q_ / 256, qq = q_ % 256; kt_ = qq / 16; const int nt = qq % 16; W_ = exp_w1 + (size_t)e * 2048 * 4096; ldw = 4096; ca_ = (size_t)128 * nt; cb_ = 2048 + ca_; WT_ = W1T8; drow_ = (size_t)e * 4096 + 256 * nt; } \
        else if (q_ < I_W1 + I_W2) { q_ -= I_W1; const int e = q_ / 128, qq = q_ % 128; kt_ = qq / 8; const int nt = qq % 8; W_ = exp_w2 + (size_t)e * 2048 * 2048; ldw = 2048; ca_ = (size_t)256 * nt; cb_ = ca_ + 128; WT_ = W2T8; drow_ = (size_t)e * 2048 + 256 * nt; } \
        else { q_ -= I_W1 + I_W2; kt_ = q_ / 48; const int ft = q_ % 48, zt = ft < 24 ? ft : ft + 8; W_ = w_in; ldw = INC; ca_ = (size_t)256 * zt + (zt >= 16 ? 32 : 0); cb_ = ca_ + 128; WT_ = WG8; drow_ = (size_t)256 * ft; } \
        src = W_ + (size_t)(128 * kt_ + 8 * kg) * ldw + (n4 < 32 ? ca_ + 4 * n4 : cb_ + 4 * (n4 - 32)); dst = WT_ + drow_ * 2048 + 128 * kt_; \
        _Pragma("unroll") for (int i = 0; i < 16; ++i) v[i] = __builtin_nontemporal_load((const f32x4*)(src + (size_t)((i >> 3) * 64 + (i & 7)) * ldw)); } while (0)
    bool have = r < end;
    if (have) CVT8_DECODE(r);
    while (have) {
#pragma unroll
        for (int hf = 0; hf < 2; ++hf)
#pragma unroll
            for (int j = 0; j < 4; ++j) { const int row = 4 * n4 + j, p8 = 8 * hf + kg; v2u o;
                o.x = pg8::pk4_fp8(v[8 * hf + 0][j] * pg8::F8_SW, v[8 * hf + 1][j] * pg8::F8_SW, v[8 * hf + 2][j] * pg8::F8_SW, v[8 * hf + 3][j] * pg8::F8_SW);
                o.y = pg8::pk4_fp8(v[8 * hf + 4][j] * pg8::F8_SW, v[8 * hf + 5][j] * pg8::F8_SW, v[8 * hf + 6][j] * pg8::F8_SW, v[8 * hf + 7][j] * pg8::F8_SW);
                *(LAS v2u*)(lds + row * 128 + 16 * ((p8 >> 1) ^ ((row >> 2) & 7)) + 8 * (p8 & 1)) = o; }
        __syncthreads();
        unsigned char* d0 = dst;
        r += stride; have = r < end;
        if (have) CVT8_DECODE(r);
#pragma unroll
        for (int i = 0; i < 4; ++i) { const int id = tid + NTHR * i, row = id >> 3, ch = id & 7; const v4u o = *(const LAS v4u*)(lds + row * 128 + 16 * (ch ^ ((row >> 2) & 7)));
            __builtin_nontemporal_store(o, (v4u*)(d0 + (size_t)row * 2048 + 16 * ch)); }
        __syncthreads();
    }
#undef CVT8_DECODE
}
__device__ __forceinline__ void p0_phase(LAS unsigned char* lds, int tid, int G, const float* c, const float* c_ctx, const float* mod_w, const float* mod_b, float* MOD,
                                         const float* w_in, const float* proj_a, const float* proj_b, const float* w_out, const float* exp_w1, const float* exp_w2, const float* router_w,
                                         bf16* WINT, bf16* PAT, bf16* PBT, bf16* WOT, bf16* W1T, bf16* W2T, bf16* SK, int n_conv_p0) {
    LAS float* sc = (LAS float*)lds;
    LAS float* red = (LAS float*)(lds + 40960);
    int it = blockIdx.x;
    if (it < I_GEMV) {
        for (int i = tid; i < 5 * 2048; i += NTHR) { const float x = i < 4 * 2048 ? c[i] : c_ctx[i - 4 * 2048]; sc[i] = siluf_(x); }
        __syncthreads();
        for (; it < I_GEMV; it += G) {
            const int j0 = 64 * it, c4 = tid & 15, kg = tid >> 4;
            f32x4 a0 = {0.f, 0.f, 0.f, 0.f}, a1 = a0, a2 = a0, a3 = a0, a4 = a0;
            const float* wp = mod_w + (size_t)kg * 12288 + j0 + 4 * c4;
#pragma unroll 8
            for (int k = kg; k < 2048; k += 32) { const f32x4 w = *(const f32x4*)wp; wp += (size_t)32 * 12288;
                a0 += w * sc[k]; a1 += w * sc[2048 + k]; a2 += w * sc[4096 + k]; a3 += w * sc[6144 + k]; a4 += w * sc[8192 + k]; }
            *(LAS f32x4*)(red + (kg * 5 + 0) * 64 + 4 * c4) = a0; *(LAS f32x4*)(red + (kg * 5 + 1) * 64 + 4 * c4) = a1; *(LAS f32x4*)(red + (kg * 5 + 2) * 64 + 4 * c4) = a2;
            *(LAS f32x4*)(red + (kg * 5 + 3) * 64 + 4 * c4) = a3; *(LAS f32x4*)(red + (kg * 5 + 4) * 64 + 4 * c4) = a4;
            __syncthreads();
            if (tid < 320) { const int rr = tid >> 6, j = tid & 63; float s = 0.f;
#pragma unroll 8
                for (int g = 0; g < 32; ++g) s += red[(g * 5 + rr) * 64 + j];
                MOD[rr * 12288 + j0 + j] = s + mod_b[j0 + j]; }
            __syncthreads();
        }
    } else {
        for (int i = (it - I_GEMV) * NTHR + tid; i < 2 * 32 * 2048; i += (G - I_GEMV) * NTHR) { const int m = i >> 16, n = (i >> 11) & 31, k = i & 2047;
            const float w = m == 0 ? w_in[(size_t)k * INC + 4096 + n] : router_w[k * 32 + n];
            const unsigned hi = cvt_pk_bf16(w, 0.f) & 0xffffu; const unsigned lo = cvt_pk_bf16(w - __uint_as_float(hi << 16), 0.f) & 0xffffu;
            SK[(size_t)(2 * m) * 65536 + n * 2048 + k] = (bf16)hi; SK[(size_t)(2 * m + 1) * 65536 + n * 2048 + k] = (bf16)lo; }
    }
    cvt_run(lds, tid, it, G, I_GEMV + n_conv_p0, w_in, proj_a, proj_b, w_out, exp_w1, exp_w2, WINT, PAT, PBT, WOT, W1T, W2T);
}

__device__ __forceinline__ void skinny_mfma(const LAS float* hrow, const bf16* WT_hi, const bf16* WT_lo, LAS float* part, int wave, int lane) {
    const int g = lane >> 4, l15 = lane & 15;
    f32x4 acc0 = {0.f, 0.f, 0.f, 0.f}, acc1 = acc0;
#pragma unroll
    for (int ks = 0; ks < 8; ++ks) { const int kb = 256 * wave + 32 * ks + 8 * g;
        f32x4 a0 = {0.f, 0.f, 0.f, 0.f}, a1 = a0;
        if (l15 < 8) { a0 = *(const LAS f32x4*)(hrow + l15 * 2048 + kb); a1 = *(const LAS f32x4*)(hrow + l15 * 2048 + kb + 4); }
        v4u hi, lo;
        hi.x = cvt_pk_bf16(a0[0], a0[1]); hi.y = cvt_pk_bf16(a0[2], a0[3]); hi.z = cvt_pk_bf16(a1[0], a1[1]); hi.w = cvt_pk_bf16(a1[2], a1[3]);
        lo.x = cvt_pk_bf16(a0[0] - bf_lo(hi.x), a0[1] - bf_hi(hi.x)); lo.y = cvt_pk_bf16(a0[2] - bf_lo(hi.y), a0[3] - bf_hi(hi.y));
        lo.z = cvt_pk_bf16(a1[0] - bf_lo(hi.z), a1[1] - bf_hi(hi.z)); lo.w = cvt_pk_bf16(a1[2] - bf_lo(hi.w), a1[3] - bf_hi(hi.w));
        const bf16x8 Ah = __builtin_bit_cast(bf16x8, hi), Al = __builtin_bit_cast(bf16x8, lo);
        const bf16x8 b0h = *(const bf16x8*)(WT_hi + (size_t)l15 * 2048 + kb), b0l = *(const bf16x8*)(WT_lo + (size_t)l15 * 2048 + kb);
        const bf16x8 b1h = *(const bf16x8*)(WT_hi + (size_t)(16 + l15) * 2048 + kb), b1l = *(const bf16x8*)(WT_lo + (size_t)(16 + l15) * 2048 + kb);
        acc0 = MFMA16(Ah, b0h, acc0); acc0 = MFMA16(Ah, b0l, acc0); acc0 = MFMA16(Al, b0h, acc0);
        acc1 = MFMA16(Ah, b1h, acc1); acc1 = MFMA16(Ah, b1l, acc1); acc1 = MFMA16(Al, b1h, acc1); }
    if (g < 2) {
#pragma unroll
        for (int r = 0; r < 4; ++r) { part[wave * 256 + (4 * g + r) * 32 + l15] = acc0[r]; part[wave * 256 + (4 * g + r) * 32 + 16 + l15] = acc1[r]; } }
}

__device__ __forceinline__ void p1_phase(LAS unsigned char* lds, int tid, int wave, int lane, int G, const float* x, const float* ctx, const float* MOD, const float* norm_g,
                                         const bf16* SK, const float* gate_b, bf16* HB, unsigned char* HB8, float* GATES) {
    LAS float* hrow = (LAS float*)(lds + wave * 8192); LAS float* part = (LAS float*)(lds + 65536);
    f32x4 v[8];
    { const int row = blockIdx.x * 8 + wave; const float* xr = row < NLAT ? x + (size_t)row * DM : ctx + (size_t)(row - NLAT) * DM;
#pragma unroll
      for (int j = 0; j < 8; ++j) v[j] = *(const f32x4*)(xr + 4 * (lane + 64 * j)); }
    for (int it = blockIdx.x; it < NTOK / 8; it += G) {
        const int row = it * 8 + wave;
        const float* shift = MOD + (size_t)(row < NLAT ? (row >> 11) : 4) * 12288; const float* scale = shift + 2048;
        float ss = 0.f;
#pragma unroll
        for (int j = 0; j < 8; ++j) ss += (v[j][0] * v[j][0] + v[j][1] * v[j][1]) + (v[j][2] * v[j][2] + v[j][3] * v[j][3]);
        const float rstd = 1.0f / sqrtf(wave_sum(ss) * (1.0f / DM) + EPS);
#pragma unroll
        for (int j = 0; j < 8; ++j) { const int col = 4 * (lane + 64 * j);
            const f32x4 g = *(const f32x4*)(norm_g + col), sc = *(const f32x4*)(scale + col), sh = *(const f32x4*)(shift + col);
            const f32x4 h = (v[j] * rstd) * g * (sc + 1.0f) + sh;
            v2u o; o.x = cvt_pk_bf16(h[0], h[1]); o.y = cvt_pk_bf16(h[2], h[3]); *(v2u*)(HB + (size_t)row * DM + col) = o;
            *(unsigned*)(HB8 + (size_t)row * DM + col) = pg8::pk4_fp8(h[0] * pg8::F8_SA, h[1] * pg8::F8_SA, h[2] * pg8::F8_SA, h[3] * pg8::F8_SA);
            *(LAS f32x4*)(hrow + col) = h; }
        if (it + G < NTOK / 8) { const int rown = (it + G) * 8 + wave; const float* xr = rown < NLAT ? x + (size_t)rown * DM : ctx + (size_t)(rown - NLAT) * DM;
#pragma unroll
            for (int j = 0; j < 8; ++j) v[j] = *(const f32x4*)(xr + 4 * (lane + 64 * j)); }
        __syncthreads();
        skinny_mfma((const LAS float*)lds, SK, SK + 65536, part, wave, lane);
        __syncthreads();
        if (tid < 256) { float s = 0.f;
#pragma unroll
            for (int w = 0; w < 8; ++w) s += part[w * 256 + tid];
            GATES[(size_t)(it * 8) * 32 + tid] = s + gate_b[tid & 31]; }
    }
}

__device__ __forceinline__ void p3_phase(int wave, int lane, int G, const bf16* Z, const float* conv_w, const float* conv_b, const float* sgu_norm_g, bf16* QC, bf16* KC, bf16* SVN,
                                         const float* GATES, float* SCN, float* BEND, float* GMAX) {
    const int gw = blockIdx.x * NWAVES + wave, NGW = G * NWAVES;
    for (int task = gw; task < 64 * NCH; task += NGW) { const int bhd = task / NCH, bi = task - bhd * NCH, dir = bhd & 1, bh = bhd >> 1, b = bh >> 3, h = bh & 7;
        const size_t row0 = bi < 2 ? (size_t)NLAT + b * TCX + bi * 128 : (size_t)b * TL + (bi - 2) * 128;
        float* sp = SCN + (size_t)task * 384; float b_end, gmax;
        gate_scan(GATES, row0, (2 * dir) * 8 + h, (2 * dir + 1) * 8 + h, dir, lane, sp, sp + 128, sp + 256, b_end, gmax);
        const int c = dir == 0 ? bi : (bi < 2 ? 1 - bi : 19 - bi);
        if (lane == 0 && c < 17) { BEND[bhd * 17 + c] = b_end; GMAX[bhd * 17 + c] = gmax; } }
    for (int item = gw; item < NTOK; item += NGW) {
        const int rb = item >> 2, seg = item & 3, row0 = rb * 4, c0 = seg * 512 + lane * 8;
        const int t0 = row0 < NLAT ? (row0 & (TL - 1)) : ((row0 - NLAT) & (TCX - 1)), len = row0 < NLAT ? TL : TCX;
        v4u zr[8];
#pragma unroll
        for (int k = 0; k < 8; ++k) { const int tt = t0 + k - 2; zr[k] = (v4u){0u, 0u, 0u, 0u};
            if (tt >= 0 && tt < len) zr[k] = *(const v4u*)(Z + (size_t)(row0 + k - 2) * ZW + c0); }
        f32x4 w0[5], w1[5];
#pragma unroll
        for (int tau = 0; tau < 5; ++tau) { w0[tau] = *(const f32x4*)(conv_w + tau * 2048 + c0); w1[tau] = *(const f32x4*)(conv_w + tau * 2048 + c0 + 4); }
        const f32x4 b0 = *(const f32x4*)(conv_b + c0), b1 = *(const f32x4*)(conv_b + c0 + 4);
        const float qs = c0 < 1024 ? 0.08838834764831845f : 1.0f;
#pragma unroll
        for (int o = 0; o < 4; ++o) { float acc[8] = {b0[0], b0[1], b0[2], b0[3], b1[0], b1[1], b1[2], b1[3]};
#pragma unroll
            for (int tau = 0; tau < 5; ++tau) { const v4u z = zr[o + tau];
                acc[0] += w0[tau][0] * bf_lo(z.x); acc[1] += w0[tau][1] * bf_hi(z.x); acc[2] += w0[tau][2] * bf_lo(z.y); acc[3] += w0[tau][3] * bf_hi(z.y);
                acc[4] += w1[tau][0] * bf_lo(z.z); acc[5] += w1[tau][1] * bf_hi(z.z); acc[6] += w1[tau][2] * bf_lo(z.w); acc[7] += w1[tau][3] * bf_hi(z.w); }
#pragma unroll
            for (int i = 0; i < 8; ++i) acc[i] = siluf_(acc[i]) * qs;
            v4u ov; ov.x = cvt_pk_bf16(acc[0], acc[1]); ov.y = cvt_pk_bf16(acc[2], acc[3]); ov.z = cvt_pk_bf16(acc[4], acc[5]); ov.w = cvt_pk_bf16(acc[6], acc[7]);
            bf16* dst = c0 < 1024 ? QC + (size_t)(row0 + o) * 1024 + c0 : KC + (size_t)(row0 + o) * 1024 + (c0 - 1024);
            *(v4u*)dst = ov; }
    }
    for (int row = gw; row < NLAT; row += NGW) {
        float v[32]; float ss = 0.f;
#pragma unroll
        for (int j = 0; j < 4; ++j) { const v4u z = *(const v4u*)(Z + (size_t)row * ZW + ZS + 8 * lane + 512 * j);
            v[8 * j + 0] = gelu_tanh(bf_lo(z.x)); v[8 * j + 1] = gelu_tanh(bf_hi(z.x)); v[8 * j + 2] = gelu_tanh(bf_lo(z.y)); v[8 * j + 3] = gelu_tanh(bf_hi(z.y));
            v[8 * j + 4] = gelu_tanh(bf_lo(z.z)); v[8 * j + 5] = gelu_tanh(bf_hi(z.z)); v[8 * j + 6] = gelu_tanh(bf_lo(z.w)); v[8 * j + 7] = gelu_tanh(bf_hi(z.w)); }
#pragma unroll
        for (int i = 0; i < 32; ++i) ss += v[i] * v[i];
        const float rstd = 1.0f / sqrtf(wave_sum(ss) * (1.0f / DM) + EPS);
#pragma unroll
        for (int j = 0; j < 4; ++j) { const int col = 8 * lane + 512 * j; const f32x4 g0 = *(const f32x4*)(sgu_norm_g + col), g1 = *(const f32x4*)(sgu_norm_g + col + 4);
            v4u o; o.x = cvt_pk_bf16(v[8 * j] * rstd * g0[0], v[8 * j + 1] * rstd * g0[1]); o.y = cvt_pk_bf16(v[8 * j + 2] * rstd * g0[2], v[8 * j + 3] * rstd * g0[3]);
            o.z = cvt_pk_bf16(v[8 * j + 4] * rstd * g1[0], v[8 * j + 5] * rstd * g1[1]); o.w = cvt_pk_bf16(v[8 * j + 6] * rstd * g1[2], v[8 * j + 7] * rstd * g1[3]);
            *(v4u*)(SVN + (size_t)row * DM + col) = o; }
    }
}

constexpr int L_V0 = 0, L_V1 = 32768, L_K = 65536, L_SC = 98304, L_CB = 106496;
constexpr int N_M1 = 64 * 17, N_SGU = 512;
__device__ __forceinline__ void p4_phase(LAS unsigned char* lds, int tid_, int wave, int lane_, int G, const bf16* Z, const bf16* KC, const bf16* SVN, const float* SCN,
                                         const float* sgu_w, const float* sgu_b, bf16* DC, const float* GMAX, bf16* CM) {
    v4u pk[4], pv[8]; f32x4 pa[2];
#define P4_ISSUE(U) do { const int u_ = (U); int t_ = tid_; asm volatile("" : "+v"(t_)); \
        if (u_ < N_M1) { const int bhd_ = u_ / 17, c_ = u_ - bhd_ * 17, dir_ = bhd_ & 1, bh_ = bhd_ >> 1, b_ = bh_ >> 3, h_ = bh_ & 7; \
            const bool ic_ = c_ < 2; const int blk_ = dir_ == 0 ? (ic_ ? c_ : c_ - 2) : (ic_ ? 1 - c_ : 17 - c_); \
            const size_t r0_ = ic_ ? (size_t)NLAT + b_ * TCX + blk_ * 128 : (size_t)b_ * TL + blk_ * 128; \
            const float* sp_ = SCN + (size_t)(bhd_ * NCH + (ic_ ? blk_ : blk_ + 2)) * 384; \
            _Pragma("unroll") for (int i = 0; i < 4; ++i) { const int id = t_ + NTHR * i; pk[i] = *(const v4u*)(KC + (r0_ + (id >> 4)) * 1024 + h_ * QKD + 8 * (id & 15)); pa[0][i] = sp_[128 + (id >> 4)]; } \
            pa[1][0] = GMAX[bhd_ * 17 + c_]; \
            _Pragma("unroll") for (int i = 0; i < 8; ++i) { const int id = t_ + NTHR * (i & 3); pv[i] = *(const v4u*)(Z + (r0_ + (id >> 4)) * ZW + ZV + h_ * VD + 128 * (i >> 2) + 8 * (id & 15)); } \
        } else { const int u2_ = u_ - N_M1, b_ = u2_ >> 7, n_ = (u2_ >> 3) & 15, grp_ = u2_ & 7; const size_t r0_ = (size_t)b_ * TL + n_ * 128; \
            _Pragma("unroll") for (int i = 0; i < 8; ++i) { const int id = t_ + NTHR * (i & 3); pv[i] = *(const v4u*)(SVN + (r0_ + (id >> 4)) * DM + grp_ * 256 + 128 * (i >> 2) + 8 * (id & 15)); } \
            } } while (0)
    int u = blockIdx.x;
    if (u < N_M1 + N_SGU) P4_ISSUE(u);
    for (; u < N_M1 + N_SGU; u += G) {
        int tid = tid_; asm volatile("" : "+v"(tid)); const int lane = tid & 63; const unsigned g = lane >> 4, l15 = lane & 15;
        const bool m1 = u < N_M1;
        TR_NAT_OFFS(xn0, xn1, lane)
#pragma unroll
        for (int i = 0; i < 8; ++i) { const int id = tid + NTHR * (i & 3); *(LAS v4u*)(lds + ((i >> 2) ? L_V1 : L_V0) + img_off(id >> 4, id & 15)) = pv[i]; }
        bf16x8 Af[4]; v2u uw[16];
        if (m1) { const float gmax = pa[1][0];
#pragma unroll
            for (int i = 0; i < 4; ++i) { const int id = tid + NTHR * i, row = id >> 4, ch = id & 15; const float sw = __expf(pa[0][i] - gmax); const v4u v = pk[i]; v4u o;
                o.x = cvt_pk_bf16(bf_lo(v.x) * sw, bf_hi(v.x) * sw); o.y = cvt_pk_bf16(bf_lo(v.y) * sw, bf_hi(v.y) * sw); o.z = cvt_pk_bf16(bf_lo(v.z) * sw, bf_hi(v.z) * sw); o.w = cvt_pk_bf16(bf_lo(v.w) * sw, bf_hi(v.w) * sw);
                *(LAS v4u*)(lds + L_K + img_off(row, ch)) = o; }
        }
        __syncthreads();
        f32x4 af32[8];
        if (!m1) { const int u2 = u - N_M1, b = u2 >> 7, n = (u2 >> 3) & 15, grp = u2 & 7;
            const float* src = sgu_w + (size_t)grp * 16384 + (size_t)(16 * wave + l15) * 128 + 8 * g;
#pragma unroll
            for (int ks = 0; ks < 4; ++ks) { af32[2 * ks] = *(const f32x4*)(src + 32 * ks); af32[2 * ks + 1] = *(const f32x4*)(src + 32 * ks + 4); }
            const bf16* up = Z + ((size_t)b * TL + n * 128 + 16 * wave + l15) * ZW + ZU + grp * 256 + 4 * g;
#pragma unroll
            for (int et = 0; et < 16; ++et) uw[et] = *(const v2u*)(up + 16 * et); }
        if (u + G < N_M1 + N_SGU) P4_ISSUE(u + G);
        if (!m1) {
#pragma unroll
            for (int ks = 0; ks < 4; ++ks) { const f32x4 a = af32[2 * ks], b2 = af32[2 * ks + 1];
                const v4u p = {cvt_pk_bf16(a[0], a[1]), cvt_pk_bf16(a[2], a[3]), cvt_pk_bf16(b2[0], b2[1]), cvt_pk_bf16(b2[2], b2[3])}; Af[ks] = __builtin_bit_cast(bf16x8, p); } }
        if (m1) {
            const int bhd = u / 17, c = u - bhd * 17;
#pragma unroll
            for (int ks = 0; ks < 4; ++ks) Af[ks] = tr_frag(lds + L_K, 32 * ks + 8 * g, 32 * ks + 8 * g + 4, wave, lane);
            f32x4 acc[17];
#pragma unroll
            for (int et = 0; et < 17; ++et) acc[et] = (f32x4){0.f, 0.f, 0.f, 0.f};
#pragma unroll
            for (int et = 0; et < 16; ++et) { LAS unsigned char* img = lds + ((et >> 3) ? L_V1 : L_V0);
#pragma unroll
                for (int ks = 0; ks < 4; ++ks) { const bf16x8 Bf = tr_frag2(img + 8192 * ks, xn0[et & 7], xn1[et & 7]); acc[et] = MFMA16(Af[ks], Bf, acc[et]); } }
            { const short one = l15 == 0 ? (short)0x3F80 : (short)0; const bf16x8 Bo = {one, one, one, one, one, one, one, one};
#pragma unroll
                for (int ks = 0; ks < 4; ++ks) acc[16] = MFMA16(Af[ks], Bo, acc[16]); }
            bf16* dst = DC + ((size_t)bhd * 17 + c) * (CROWS * 128) + 16 * wave + 4 * g;
#pragma unroll
            for (int et = 0; et < 16; ++et) { v2u o; o.x = cvt_pk_bf16(acc[et][0], acc[et][1]); o.y = cvt_pk_bf16(acc[et][2], acc[et][3]); *(v2u*)(dst + (size_t)(16 * et + l15) * 128) = o; }
            if (l15 == 0) { v2u o; o.x = cvt_pk_bf16(acc[16][0], acc[16][1]); o.y = cvt_pk_bf16(acc[16][2], acc[16][3]); *(v2u*)(dst + (size_t)256 * 128) = o; }
        } else {
            const int u2 = u - N_M1, b = u2 >> 7, n = (u2 >> 3) & 15, grp = u2 & 7; const size_t row0 = (size_t)b * TL + n * 128;
            f32x4 acc[16];
#pragma unroll
            for (int et = 0; et < 16; ++et) { acc[et] = (f32x4){0.f, 0.f, 0.f, 0.f}; LAS unsigned char* img = lds + ((et >> 3) ? L_V1 : L_V0);
#pragma unroll
                for (int ks = 0; ks < 4; ++ks) { const bf16x8 Bf = tr_frag2(img + 8192 * ks, xn0[et & 7], xn1[et & 7]); acc[et] = MFMA16(Bf, Af[ks], acc[et]); } }
            { const int t = 16 * wave + l15; const float zb = sgu_b[grp * 128 + t]; const size_t row = row0 + t;
#pragma unroll
              for (int et = 0; et < 16; ++et) { const int col = grp * 256 + 16 * et + 4 * g; const v2u w2 = uw[et];
                  const float o0 = gelu_tanh(bf_lo(w2.x)) * (acc[et][0] + zb), o1 = gelu_tanh(bf_hi(w2.x)) * (acc[et][1] + zb), o2 = gelu_tanh(bf_lo(w2.y)) * (acc[et][2] + zb), o3 = gelu_tanh(bf_hi(w2.y)) * (acc[et][3] + zb);
                  v2u o; o.x = cvt_pk_bf16(o0, o1); o.y = cvt_pk_bf16(o2, o3); *(v2u*)(CM + row * DM + col) = o; } }
        }
        __syncthreads();
    }
#undef P4_ISSUE
}

__device__ __forceinline__ void p5_scan(int tid, int G, const bf16* DC, const float* BEND, const float* GMAX, bf16* CS, float* MST) {
    constexpr int QPB = 257 * 128 / 4;
    for (int idx = blockIdx.x * NTHR + tid; idx < 64 * QPB; idx += G * NTHR) {
        const int bhd = idx / QPB, q = idx - bhd * QPB;
        f32x4 C = {0.f, 0.f, 0.f, 0.f}; float m = 0.f;
#pragma unroll
        for (int c = 0; c < 17; ++c) {
            const float gm = GMAX[bhd * 17 + c], be = BEND[bhd * 17 + c], mx = fmaxf(m, gm), al = __expf(m - mx), bt = __expf(gm - mx);
            const v2u dw = *(const v2u*)(DC + ((size_t)bhd * 17 + c) * (CROWS * 128) + 4 * q); const f32x4 d = {bf_lo(dw.x), bf_hi(dw.x), bf_lo(dw.y), bf_hi(dw.y)};
            C = C * al + d * bt; m = be + mx;
            if (c >= 1) { v2u o; o.x = cvt_pk_bf16(C[0], C[1]); o.y = cvt_pk_bf16(C[2], C[3]);
                *(v2u*)(CS + ((size_t)bhd * 16 + (c - 1)) * (CROWS * 128) + 4 * q) = o; if (q == 0) MST[bhd * 18 + c + 1] = m; }
        }
    }
}

__device__ __forceinline__ void p6_phase(LAS unsigned char* lds, int tid, int wave, int lane_, int G, const bf16* Z, const bf16* QC, const bf16* KC, const float* SCN,
                                         const bf16* CS, const float* MST, const float* mnorm_g, bf16* RO) {
    for (int u = blockIdx.x; u < 512; u += G) {
        int lane = lane_; asm volatile("" : "+v"(lane)); const unsigned g = lane >> 4, l15 = lane & 15;
        const int bh = u >> 4, jb = u & 15, b = bh >> 3, h = bh & 7; const size_t row0 = (size_t)b * TL + jb * 128;
        load_tile128(lds + L_K, KC + row0 * 1024 + h * QKD, 1024, tid);
        load_tile128(lds + L_V0, Z + row0 * ZW + ZV + h * VD, ZW, tid);
        load_tile128(lds + L_V1, Z + row0 * ZW + ZV + h * VD + 128, ZW, tid);
        bf16x8 Qf[4];
#pragma unroll
        for (int ks = 0; ks < 4; ++ks) Qf[ks] = *(const bf16x8*)(QC + (row0 + 16 * wave + l15) * 1024 + h * QKD + 32 * ks + 8 * g);
        __syncthreads();
        f32x4 hsum[16];
#pragma unroll
        for (int et = 0; et < 16; ++et) hsum[et] = (f32x4){0.f, 0.f, 0.f, 0.f};
#pragma unroll 1
        for (int dir = 0; dir < 2; ++dir) {
            int lane = lane_; asm volatile("" : "+v"(lane));
            const unsigned g = lane >> 4, l15 = lane & 15;
            TR_PERM_OFFS(xp, lane)
            const int c = dir ? 17 - jb : 2 + jb; const bf16* cs = CS + ((size_t)(bh * 2 + dir) * 16 + (c - 2)) * (CROWS * 128);
            const float* sp = SCN + (size_t)((bh * 2 + dir) * NCH + 2 + jb) * 384; const float* gg = sp + 128; const float mc = MST[(bh * 2 + dir) * 18 + c];
            const int tS = 16 * wave + l15; const float MtS = fmaxf(mc, sp[256 + tS]);
            unsigned pw[16];
#pragma unroll
            for (int st = 0; st < 8; ++st) { f32x4 aS = {0.f, 0.f, 0.f, 0.f};
#pragma unroll
                for (int ks = 0; ks < 4; ++ks) { const bf16x8 Kf = *(const LAS bf16x8*)(lds + L_K + img_off(16 * st + l15, 4 * ks + g)); aS = MFMA16(Kf, Qf[ks], aS); }
                float pv[4]; const f32x4 gs = *(const f32x4*)(gg + 16 * st + 4 * g);
#pragma unroll
                for (int r = 0; r < 4; ++r) { const int s = 16 * st + 4 * g + r; const bool ok = dir ? (s >= tS) : (s <= tS); const float ev = __expf(fminf(gs[r] - MtS, 0.f)); pv[r] = ok ? aS[r] * ev : 0.f; }
                pw[2 * st] = cvt_pk_bf16(pv[0], pv[1]); pw[2 * st + 1] = cvt_pk_bf16(pv[2], pv[3]); asm volatile("" ::: "memory"); }
            bf16x8 Pf[4];
#pragma unroll
            for (int ks = 0; ks < 4; ++ks) { const v4u t4 = {pw[4 * ks], pw[4 * ks + 1], pw[4 * ks + 2], pw[4 * ks + 3]}; Pf[ks] = __builtin_bit_cast(bf16x8, t4); }
            const float wiT = __expf(mc - MtS), flT = __expf(-(sp[tS] + MtS));
            const short one = l15 == 0 ? (short)0x3F80 : (short)0; const bf16x8 Bo = {one, one, one, one, one, one, one, one};
            float inv;
            { f32x4 ad = {0.f, 0.f, 0.f, 0.f};
#pragma unroll
              for (int ks = 0; ks < 4; ++ks) { bf16x8 Cf = *(const bf16x8*)(cs + (size_t)256 * 128 + 32 * ks + 8 * g); if (l15 != 0) Cf = (bf16x8){0, 0, 0, 0, 0, 0, 0, 0}; ad = MFMA16(Cf, Qf[ks], ad); }
              ad[0] *= wiT;
#pragma unroll
              for (int ks = 0; ks < 4; ++ks) ad = MFMA16(Bo, Pf[ks], ad);
              const float den = __shfl(ad[0], lane & 15); inv = 1.0f / fmaxf(fabsf(den), flT); }
            { v4u cr[2];
#pragma unroll
              for (int i = 0; i < 2; ++i) { const int id = tid + NTHR * i; cr[i] = *(const v4u*)(cs + (size_t)(id >> 4) * 128 + 8 * (id & 15)); }
#pragma unroll
              for (int i = 0; i < 2; ++i) { const int id = tid + NTHR * i; *(LAS v4u*)(lds + L_CB + img_off(id >> 4, id & 15)) = cr[i]; }
#pragma unroll
              for (int gq = 0; gq < 4; ++gq) {
                LAS unsigned char* cb = lds + L_CB + (gq & 1) * 16384;
                __syncthreads();
                if (gq < 3) {
#pragma unroll
                    for (int i = 0; i < 2; ++i) { const int id = tid + NTHR * i; cr[i] = *(const v4u*)(cs + (size_t)(64 * (gq + 1) + (id >> 4)) * 128 + 8 * (id & 15)); } }
                f32x4 acc[4];
#pragma unroll
                for (int i = 0; i < 4; ++i) { acc[i] = (f32x4){0.f, 0.f, 0.f, 0.f};
#pragma unroll
                    for (int ks = 0; ks < 4; ++ks) { const bf16x8 Cf = *(const LAS bf16x8*)(cb + img_off(16 * i + l15, 4 * ks + g)); acc[i] = MFMA16(Cf, Qf[ks], acc[i]); } }
#pragma unroll
                for (int i = 0; i < 4; ++i) acc[i] = acc[i] * wiT;
                { LAS unsigned char* img = lds + ((gq >> 1) ? L_V1 : L_V0);
#pragma unroll
                  for (int i = 0; i < 4; ++i) {
#pragma unroll
                    for (int ks = 0; ks < 4; ++ks) { const bf16x8 Vf = tr_frag2(img + 8192 * ks, xp[4 * (gq & 1) + i], xp[4 * (gq & 1) + i] + 4096u); acc[i] = MFMA16(Vf, Pf[ks], acc[i]); } } }
#pragma unroll
                for (int i = 0; i < 4; ++i) hsum[4 * gq + i] += acc[i] * inv;
                if (gq < 3) {
#pragma unroll
                    for (int i = 0; i < 2; ++i) { const int id = tid + NTHR * i; *(LAS v4u*)(lds + L_CB + ((gq + 1) & 1) * 16384 + img_off(id >> 4, id & 15)) = cr[i]; } }
              } }
        }
        { float ss = 0.f;
#pragma unroll
          for (int et = 0; et < 16; ++et) ss += (hsum[et][0] * hsum[et][0] + hsum[et][1] * hsum[et][1]) + (hsum[et][2] * hsum[et][2] + hsum[et][3] * hsum[et][3]);
          ss += __shfl_xor(ss, 16); ss += __shfl_xor(ss, 32);
          const float rstd = 1.0f / sqrtf(ss * (1.0f / VD) + EPS); const size_t row = row0 + 16 * wave + l15;
#pragma unroll
          for (int et = 0; et < 16; ++et) { const int col = h * VD + 16 * et + 4 * g;
              const v2u ow = *(const v2u*)(Z + row * ZW + ZO + col); const f32x4 gn = *(const f32x4*)(mnorm_g + col);
              const float v0 = hsum[et][0] * rstd * gn[0] * sigmoidf_(bf_lo(ow.x)), v1 = hsum[et][1] * rstd * gn[1] * sigmoidf_(bf_hi(ow.x));
              const float v2 = hsum[et][2] * rstd * gn[2] * sigmoidf_(bf_lo(ow.y)), v3 = hsum[et][3] * rstd * gn[3] * sigmoidf_(bf_hi(ow.y));
              v2u o; o.x = cvt_pk_bf16(v0, v1); o.y = cvt_pk_bf16(v2, v3); *(v2u*)(RO + row * DM + col) = o; } }
        __syncthreads();
    }
}

__device__ __forceinline__ void p9_phase(LAS unsigned char* lds, int wave, int lane, int G, const float* X1, const float* MOD, const float* norm_g, const bf16* SK, const float* router_b,
                                         unsigned* cnt, unsigned char* XG, int* RE, int* RR, float* RG) {
    LAS float* hrow = (LAS float*)(lds + wave * 8192); LAS float* part = (LAS float*)(lds + 65536);
    f32x4 vn[8];
    { const float* xr = X1 + (size_t)(blockIdx.x * 8 + wave) * DM;
#pragma unroll
      for (int j = 0; j < 8; ++j) vn[j] = *(const f32x4*)(xr + 4 * (lane + 64 * j)); }
    for (int it = blockIdx.x; it < NLAT / 8; it += G) {
        const int row = it * 8 + wave;
        const float* shift = MOD + (size_t)(row >> 11) * 12288 + 3 * 2048; const float* scale = shift + 2048;
        f32x4 v[8]; float ss = 0.f;
#pragma unroll
        for (int j = 0; j < 8; ++j) { v[j] = vn[j]; ss += (v[j][0] * v[j][0] + v[j][1] * v[j][1]) + (v[j][2] * v[j][2] + v[j][3] * v[j][3]); }
        const float rstd = 1.0f / sqrtf(wave_sum(ss) * (1.0f / DM) + EPS);
#pragma unroll
        for (int j = 0; j < 8; ++j) { const int col = 4 * (lane + 64 * j);
            const f32x4 g = *(const f32x4*)(norm_g + col), sc = *(const f32x4*)(scale + col), sh = *(const f32x4*)(shift + col);
            v[j] = (v[j] * rstd) * g * (sc + 1.0f) + sh; *(LAS f32x4*)(hrow + col) = v[j]; }
        if (it + G < NLAT / 8) { const float* xr = X1 + (size_t)((it + G) * 8 + wave) * DM;
#pragma unroll
            for (int j = 0; j < 8; ++j) vn[j] = *(const f32x4*)(xr + 4 * (lane + 64 * j)); }
        __syncthreads();
        skinny_mfma((const LAS float*)lds, SK + 2 * 65536, SK + 3 * 65536, part, wave, lane);
        __syncthreads();
        float val = router_b[lane & 31];
#pragma unroll
        for (int w = 0; w < 8; ++w) val += part[w * 256 + wave * 32 + (lane & 31)];
        float sv[4]; int si[4];
#pragma unroll
        for (int k = 0; k < 4; ++k) { float bv = val; int bi = lane & 31;
#pragma unroll
            for (int o = 16; o >= 1; o >>= 1) { const float ov = __shfl_xor(bv, o); const int oi = __shfl_xor(bi, o); const bool take = (ov > bv) || (ov == bv && oi < bi); bv = take ? ov : bv; bi = take ? oi : bi; }
            sv[k] = bv; si[k] = __builtin_amdgcn_readfirstlane(bi); if ((lane & 31) == bi) val = -3.0e38f; }
        const float e1 = __expf(sv[1] - sv[0]), e2 = __expf(sv[2] - sv[0]), e3 = __expf(sv[3] - sv[0]), inv = 1.0f / (1.0f + e1 + e2 + e3);
        const float gk[4] = {inv, e1 * inv, e2 * inv, e3 * inv};
        unsigned rank = 0;
        if (lane < 4) rank = __hip_atomic_fetch_add(cnt + (lane == 0 ? si[0] : lane == 1 ? si[1] : lane == 2 ? si[2] : si[3]), 1u, RLX_AGENT);
#pragma unroll
        for (int k = 0; k < 4; ++k) { const unsigned rk = (unsigned)__builtin_amdgcn_readlane((int)rank, k);
            unsigned char* dst = XG + ((size_t)si[k] * 8192 + rk) * DM;
#pragma unroll
            for (int j = 0; j < 8; ++j) *(unsigned*)(dst + 4 * (lane + 64 * j)) = pg8::pk4_fp8(v[j][0] * pg8::F8_SA, v[j][1] * pg8::F8_SA, v[j][2] * pg8::F8_SA, v[j][3] * pg8::F8_SA);
            if (lane == 0) { RE[row * 4 + k] = si[k]; RR[row * 4 + k] = (int)rk; RG[row * 4 + k] = gk[k]; } }
    }
}
__device__ __forceinline__ void moe_prefix(LAS int* pref, const unsigned* cnt, int tid) {
    if (tid == 0) { int s = 0; for (int e = 0; e < 32; ++e) { const unsigned ce = __hip_atomic_load(cnt + e, RLX_AGENT); pref[e] = s; pref[33 + e] = (int)ce; s += (int)((ce + 255u) >> 8); } pref[32] = s; }
    __syncthreads();
}
__device__ __forceinline__ void p12_phase(const LAS int* pref, int wave, int lane_, int G, const float* X1, const float* MOD, const bf16* Y2, const int* RE, const int* RR, const float* RG, const float* final_g, float* out) {
    const int gw = blockIdx.x * NWAVES + wave, NGW = G * NWAVES;
    int en[4], rn[4]; float gn[4];
    if (gw < NLAT) {
#pragma unroll
        for (int k = 0; k < 4; ++k) { en[k] = RE[gw * 4 + k]; rn[k] = RR[gw * 4 + k]; gn[k] = RG[gw * 4 + k]; } }
    for (int row = gw; row < NLAT; row += NGW) {
        int lane = lane_; asm volatile("" : "+v"(lane));
        const float* xr = X1 + (size_t)row * DM + 4 * lane; f32x4 xv[8]; v2u yv[4][8]; float gt[4];
#pragma unroll
        for (int k = 0; k < 4; ++k) { gt[k] = gn[k]; const bf16* src = Y2 + ((size_t)pref[en[k]] * 256 + rn[k]) * DM + 4 * lane;
#pragma unroll
            for (int j = 0; j < 8; ++j) yv[k][j] = __builtin_nontemporal_load((const v2u*)(src + 256 * j)); }
#pragma unroll
        for (int j = 0; j < 8; ++j) xv[j] = __builtin_nontemporal_load((const f32x4*)(xr + 256 * j));
        if (row + NGW < NLAT) { const int r2 = row + NGW;
#pragma unroll
            for (int k = 0; k < 4; ++k) { en[k] = RE[r2 * 4 + k]; rn[k] = RR[r2 * 4 + k]; gn[k] = RG[r2 * 4 + k]; } }
        const float* g5 = MOD + (size_t)(row >> 11) * 12288 + 5 * 2048; float ss = 0.f;
#pragma unroll
        for (int j = 0; j < 8; ++j) { f32x4 ys = {0.f, 0.f, 0.f, 0.f};
#pragma unroll
            for (int k = 0; k < 4; ++k) { const v2u y = yv[k][j]; ys[0] += gt[k] * bf_lo(y.x); ys[1] += gt[k] * bf_hi(y.x); ys[2] += gt[k] * bf_lo(y.y); ys[3] += gt[k] * bf_hi(y.y); }
            const int col = 4 * (lane + 64 * j); const f32x4 x2 = xv[j] + *(const f32x4*)(g5 + col) * ys; xv[j] = x2;
            ss += (x2[0] * x2[0] + x2[1] * x2[1]) + (x2[2] * x2[2] + x2[3] * x2[3]); }
        const float rstd = 1.0f / sqrtf(wave_sum(ss) * (1.0f / DM) + EPS);
#pragma unroll
        for (int j = 0; j < 8; ++j) { const int col = 4 * (lane + 64 * j); __builtin_nontemporal_store(xv[j] * rstd * *(const f32x4*)(final_g + col), (f32x4*)(out + (size_t)row * DM + col)); }
    }
}

#define XB_TMO      128
#define XB_XCNT(j)  (256  + 64 * (j))
#define XB_XSUB(j)  (1280 + 64 * (j))
#define XB_XGEN(j)  (2304 + 64 * (j))
#define XB_TOP      3328
#define XB_TOPGEN   3392
#define XCD_BAR_WORDS 3456
#define XB_SPIN_CAP (1u << 18)

__device__ __forceinline__ unsigned xb_ld(unsigned* p)              { return __hip_atomic_load(p, __ATOMIC_RELAXED, __HIP_MEMORY_SCOPE_AGENT); }
__device__ __forceinline__ unsigned xb_add(unsigned* p, unsigned v) { return __hip_atomic_fetch_add(p, v, __ATOMIC_RELAXED, __HIP_MEMORY_SCOPE_AGENT); }
__device__ __forceinline__ unsigned xb_xcc_id() { return (unsigned)__builtin_amdgcn_s_getreg((3 << 11) | 20) & 0xFu; }
#define XB_SPIN(cond, bar) do { unsigned _sp = 0; while (cond) { __builtin_amdgcn_s_sleep(1); \
    if ((++_sp & 255u) == 0u) { if (xb_ld(&(bar)[XB_TMO])) break; if (_sp > XB_SPIN_CAP) { atomicAdd(&(bar)[XB_TMO], 1u); break; } } } } while (0)

struct XcdBarrier {
    unsigned* bar; unsigned x;
    volatile LAS unsigned* st;
};

__device__ __forceinline__ XcdBarrier xcd_barrier_post(unsigned* bar, volatile LAS unsigned* st) {
    XcdBarrier b; b.bar = bar; b.x = xb_xcc_id(); b.st = st;
    if (threadIdx.x == 0) (void)xb_add(&bar[XB_XCNT(b.x)], 1u);
    return b;
}
__device__ __forceinline__ void xcd_barrier_complete(unsigned* bar, unsigned x, unsigned& nloc, unsigned& nx) {
    const unsigned G = gridDim.x * gridDim.y * gridDim.z;
    unsigned sum, cnt, mine, sp = 0u;
    for (;;) {
        sum = 0u; cnt = 0u; mine = 0u;
#pragma unroll
        for (unsigned j = 0; j < 16; ++j) { const unsigned c = xb_ld(&bar[XB_XCNT(j)]); sum += c; cnt += (c > 0u) ? 1u : 0u; mine = (j == x) ? c : mine; }
        if (sum == G) break;
        __builtin_amdgcn_s_sleep(1);
        if ((++sp & 255u) == 0u) { if (xb_ld(&bar[XB_TMO])) break; if (sp > XB_SPIN_CAP) { atomicAdd(&bar[XB_TMO], 1u); break; } }
    }
    nloc = mine > 0u ? mine : 1u; nx = cnt > 0u ? cnt : 1u;
}

__device__ __forceinline__ void xcd_barrier(const XcdBarrier& b) {
    asm volatile("s_waitcnt vmcnt(0)" ::: "memory");
    __syncthreads();
    if (threadIdx.x == 0) {
        unsigned* bar = b.bar;
        __builtin_amdgcn_s_waitcnt(0);
        unsigned nloc = b.st[0], nx = b.st[1];
        if (nloc == 0u) { xcd_barrier_complete(bar, b.x, nloc, nx); b.st[0] = nloc; b.st[1] = nx; }
        const unsigned old = xb_add(&bar[XB_XSUB(b.x)], 1u);
        const unsigned gen = old / nloc;
        if (old + 1u == (gen + 1u) * nloc) {
            __builtin_amdgcn_fence(__ATOMIC_RELEASE, "agent");
            asm volatile("s_waitcnt vmcnt(0)" ::: "memory");
            const unsigned og = xb_add(&bar[XB_TOP], 1u);
            const unsigned tg = og / nx;
            if (og + 1u == (tg + 1u) * nx) xb_add(&bar[XB_TOPGEN], 1u);
            else XB_SPIN(xb_ld(&bar[XB_TOPGEN]) == tg, bar);
            __builtin_amdgcn_fence(__ATOMIC_ACQUIRE, "agent");
            xb_add(&bar[XB_XGEN(b.x)], 1u);
            asm volatile("s_waitcnt vmcnt(0)" ::: "memory");
        } else {
            XB_SPIN(xb_ld(&bar[XB_XGEN(b.x)]) == gen, bar);
            __builtin_amdgcn_fence(__ATOMIC_ACQUIRE, "agent");
            asm volatile("s_waitcnt vmcnt(0)" ::: "memory");
        }
    }
    __syncthreads();
}

struct Args { const float* in[26]; float* out; unsigned char* ws; int ph_lo, ph_hi; };
__global__ void __launch_bounds__(NTHR, 2) mk_fwd(Args args) {
    extern __shared__ __attribute__((aligned(16))) unsigned char lds_raw[];
    LAS unsigned char* lds = (LAS unsigned char*)lds_raw;
    const int tid = threadIdx.x, lane = tid & 63, wave = __builtin_amdgcn_readfirstlane(tid >> 6), G = gridDim.x;
    unsigned char* ws = args.ws;
    gu32* ctl = (gu32*)(ws + WS_CTL);
    for (int u = tid; u < (LDS_BYTES - LDSCTL_OFF) / 4; u += NTHR) ((LAS unsigned*)(lds + LDSCTL_OFF))[u] = 0u;
    __syncthreads();
    volatile LAS unsigned* MISC = (volatile LAS unsigned*)(lds + MISC_OFF);
    XcdBarrier bar; bar.bar = (unsigned*)(ctl + CW_BAR); bar.x = 0; bar.st = nullptr;
    if (N_LAUNCHES == 1) bar = xcd_barrier_post((unsigned*)(ctl + CW_BAR), MISC + 8);
#define GRID_BAR() do { if (N_LAUNCHES == 1) xcd_barrier(bar); } while (0)
    const int lo = args.ph_lo, hi = args.ph_hi;
#ifdef ONLY_PHASE
#define IN(k) ((k) == ONLY_PHASE && lo <= (k) && (k) < hi)
#else
#define IN(k) (lo <= (k) && (k) < hi)
#endif
#define BOTH(k) (IN(k) && IN((k) + 1))
#ifndef REP_MASK
#define REP_MASK 0
#endif
#define NREP(k) ((((REP_MASK) >> (k)) & 1) ? 2 : 1)
#define INP(i) (args.in[i])
#define WSF(off) ((float*)(ws + (off)))
#define WSB(off) ((bf16*)(ws + (off)))
#define WSI(off) ((int*)(ws + (off)))
    unsigned* cnt = (unsigned*)(ctl + CW_CNT);
    LAS int* pref = (LAS int*)(lds + PREF_OFF);
    const int n_conv_p0 = I_WIN + 3 * I_P;
#define x_in INP(0)
#define cvec INP(1)
#define ctx INP(2)
#define c_ctx INP(3)
#define mod_w INP(4)
#define mod_b INP(5)
#define norm1_g INP(6)
#define norm2_g INP(7)
#define w_in INP(8)
#define gate_b INP(9)
#define conv_w INP(10)
#define conv_b INP(11)
#define mnorm_g INP(12)
#define sgu_norm_g INP(13)
#define sgu_w INP(14)
#define sgu_b INP(15)
#define proj_a INP(16)
#define proj_b INP(17)
#define w_out INP(18)
#define router_w INP(19)
#define router_b INP(20)
#define exp_w1 INP(21)
#define exp_b1 INP(22)
#define exp_w2 INP(23)
#define exp_b2 INP(24)
#define final_g INP(25)
#define MOD WSF(WS_MOD)
#define GATES WSF(WS_GATES)
#define BEND WSF(WS_SCAL)
#define GMAX (WSF(WS_SCAL) + 64 * 17)
#define MST (WSF(WS_SCAL) + 2 * 64 * 17)
#define RE WSI(WS_ROUTE)
#define RR (WSI(WS_ROUTE) + NLAT * 4)
#define RG (WSF(WS_ROUTE) + 2 * NLAT * 4)
#define WINT WSB(WS_WINT)
#define SKW WSB(WS_SK)
#define SCN WSF(WS_SCN)
#define PAT WSB(WS_PAT)
#define PBT WSB(WS_PBT)
#define WOT WSB(WS_WOT)
#define W1T WSB(WS_W1T)
#define W1T8 ((unsigned char*)(ws + WS_W1T))
#define HB8M ((unsigned char*)(ws + WS_HB8))
#define WG8M ((unsigned char*)(ws + WS_WG8))
#define W2T8 ((unsigned char*)(ws + WS_W2T))
#define XG8 ((unsigned char*)(ws + WS_XG))
#define ACT8 ((unsigned char*)(ws + WS_ACT))
#define W2T WSB(WS_W2T)
#define HB WSB(WS_HB)
#define Z WSB(WS_Z)
#define QC WSB(WS_QC)
#define KC WSB(WS_KC)
#define SVN WSB(WS_SVN)
#define DC WSB(WS_DC)
#define CS WSB(WS_CS)
#define RO WSB(WS_RO)
#define CM WSB(WS_CM)
#define YB WSF(WS_YB)
#define MRG WSB(WS_MRG)
#define X1 WSF(WS_X1)
#define ACT WSB(WS_ACT)
#define Y2 WSB(WS_Y2)
#define XG WSB(WS_XG)

    if (IN(0)) for (int rep_ = 0; rep_ < NREP(0); ++rep_) { p0_phase(lds, tid, G, cvec, c_ctx, mod_w, mod_b, MOD, w_in, proj_a, proj_b, w_out, exp_w1, exp_w2, router_w, WINT, PAT, PBT, WOT, W1T, W2T, SKW, n_conv_p0);
        cvt_run8(lds, tid, I_W1 + I_W2 + (int)blockIdx.x, G, I_W1 + I_W2 + I_GATE8, exp_w1, exp_w2, w_in, W1T8, W2T8, WG8M); if (BOTH(0) || rep_ + 1 < NREP(0)) GRID_BAR(); }
    if (IN(1)) for (int rep_ = 0; rep_ < NREP(1); ++rep_) { p1_phase(lds, tid, wave, lane, G, x_in, ctx, MOD, norm1_g, SKW, gate_b, HB, HB8M, GATES); if (BOTH(1) || rep_ + 1 < NREP(1)) GRID_BAR(); }
    if (IN(2)) for (int rep_ = 0; rep_ < NREP(2); ++rep_) {
        if ((int)blockIdx.x >= G - (G == 256 ? N_CONVERTERS : G))
            cvt_run8(lds, tid, (int)blockIdx.x - (G - (G == 256 ? N_CONVERTERS : G)), (G == 256 ? N_CONVERTERS : G), I_W1 + I_W2, exp_w1, exp_w2, w_in, W1T8, W2T8, WG8M);
        { pg8::Gemm g{(const bf16*)HB8M, (const bf16*)WG8M, NTOK, 12288, DM}; pg8::DynOrder S{(unsigned*)(ctl + CW_Q2), (LAS int*)(lds + PREF_OFF + 808), (int)(blockIdx.x & 7), 48, 8, 0}; pg8::EpiGate8 E{Z, ZW};
          pg8::gemm_phase8<pg8::EpiGate8, pg8::DynOrder, true, true>(lds, g, S, E); }
        { pg8::Gemm g{HB, WINT, NLAT, ZW, DM}; pg8::DynOrder S{(unsigned*)(ctl + CW_Q), (LAS int*)(lds + PREF_OFF + 800), (int)(blockIdx.x & 7), 8, 0, 24}; pg8::EpiBf16 E{Z, ZW, nullptr, ZW / 256};
          pg8::gemm_phase<pg8::EpiBf16, pg8::DynOrder, true, true>(lds, g, S, E); }
        if (BOTH(2) || rep_ + 1 < NREP(2)) GRID_BAR();
    }
    if (IN(3)) for (int rep_ = 0; rep_ < NREP(3); ++rep_) { p3_phase(wave, lane, G, Z, conv_w, conv_b, sgu_norm_g, QC, KC, SVN, GATES, SCN, BEND, GMAX); if (BOTH(3) || rep_ + 1 < NREP(3)) GRID_BAR(); }
    if (IN(4)) for (int rep_ = 0; rep_ < NREP(4); ++rep_) { p4_phase(lds, tid, wave, lane, G, Z, KC, SVN, SCN, sgu_w, sgu_b, DC, GMAX, CM); if (BOTH(4) || rep_ + 1 < NREP(4)) GRID_BAR(); }
    if (IN(5)) for (int rep_ = 0; rep_ < NREP(5); ++rep_) {
        { pg8::Gemm g{CM, PBT, NLAT, DM, DM}; pg8::StaticOrder S; S.init(NLAT, DM, G, (int)blockIdx.x); pg8::EpiF32 E{YB, DM};
          pg8::gemm_phase<pg8::EpiF32, pg8::StaticOrder, true, true>(lds, g, S, E); }
        p5_scan(tid, G, DC, BEND, GMAX, CS, MST);
        if (BOTH(5) || rep_ + 1 < NREP(5)) GRID_BAR();
    }
    if (IN(6)) for (int rep_ = 0; rep_ < NREP(6); ++rep_) { p6_phase(lds, tid, wave, lane, G, Z, QC, KC, SCN, CS, MST, mnorm_g, RO); if (BOTH(6) || rep_ + 1 < NREP(6)) GRID_BAR(); }
    if (IN(7)) for (int rep_ = 0; rep_ < NREP(7); ++rep_) {
        pg8::Gemm g{RO, PAT, NLAT, DM, DM}; pg8::StaticOrder S; S.init(NLAT, DM, G, (int)blockIdx.x); pg8::EpiMerge E{MRG, Z, ZW, ZGA, ZGB, YB};
        pg8::gemm_phase<pg8::EpiMerge, pg8::StaticOrder, true, true>(lds, g, S, E);
        if (BOTH(7) || rep_ + 1 < NREP(7)) GRID_BAR();
    }
    if (IN(8)) for (int rep_ = 0; rep_ < NREP(8); ++rep_) {
        pg8::Gemm g{MRG, WOT, NLAT, DM, DM}; pg8::StaticOrder S; S.init(NLAT, DM, G, (int)blockIdx.x); pg8::EpiX1 E{X1, x_in, MOD};
        pg8::gemm_phase<pg8::EpiX1, pg8::StaticOrder, true, true>(lds, g, S, E);
        if (BOTH(8) || rep_ + 1 < NREP(8)) GRID_BAR();
    }
    if (IN(9)) for (int rep_ = 0; rep_ < NREP(9); ++rep_) { p9_phase(lds, wave, lane, G, X1, MOD, norm2_g, SKW, router_b, cnt, XG8, RE, RR, RG); if (BOTH(9) || rep_ + 1 < NREP(9)) GRID_BAR(); }
    if (IN(10)) for (int rep_ = 0; rep_ < NREP(10); ++rep_) {
        moe_prefix(pref, cnt, tid);
        pg8::Gemm g{(const bf16*)XG8, (const bf16*)W1T8, 0, 0, DM}; pg8::MoeOrder S{pref, 16, G, (int)blockIdx.x, 1}; pg8::EpiSwiglu8 E{ACT8, exp_b1};
        pg8::gemm_phase8<pg8::EpiSwiglu8, pg8::MoeOrder, true, true, true>(lds, g, S, E);
        if (BOTH(10) || rep_ + 1 < NREP(10)) GRID_BAR();
    }
    if (IN(11)) for (int rep_ = 0; rep_ < NREP(11); ++rep_) {
        moe_prefix(pref, cnt, tid);
        pg8::Gemm g{(const bf16*)ACT8, (const bf16*)W2T8, 0, 0, DEXP}; pg8::MoeOrder S{pref, 8, G, (int)blockIdx.x, 0}; pg8::EpiY2f8 E{Y2, exp_b2};
        pg8::gemm_phase8<pg8::EpiY2f8, pg8::MoeOrder, true, true, true>(lds, g, S, E);
        if (BOTH(11) || rep_ + 1 < NREP(11)) GRID_BAR();
    }
    if (IN(12)) for (int rep_ = 0; rep_ < NREP(12); ++rep_) { moe_prefix(pref, cnt, tid); p12_phase(pref, wave, lane, G, X1, MOD, Y2, RE, RR, RG, final_g, args.out); if (rep_ + 1 < NREP(12)) GRID_BAR(); }
#undef IN
#undef BOTH
}

extern "C" void kernel_launch(void* const* d_in, const int* in_sizes, int n_in, void* d_out, int out_size, void* d_ws, size_t ws_size, hipStream_t stream) {
    static int grid = 0;
    if (grid == 0) {
        if (n_in != 26 || out_size != NLAT * DM || ws_size < WS_END) { fprintf(stderr, "kernel_launch: unexpected shapes (n_in %d, out %d, ws %zu)\n", n_in, out_size, ws_size); grid = -1; return; }
        int dev = 0, cus = 0;
        if (hipGetDevice(&dev) != hipSuccess || hipDeviceGetAttribute(&cus, hipDeviceAttributeMultiprocessorCount, dev) != hipSuccess) { grid = -1; return; }
        if (hipFuncSetAttribute((const void*)mk_fwd, hipFuncAttributeMaxDynamicSharedMemorySize, LDS_BYTES) != hipSuccess) { fprintf(stderr, "kernel_launch: hipFuncSetAttribute failed\n"); grid = -1; return; }
        int per_cu = 0;
        if (hipOccupancyMaxActiveBlocksPerMultiprocessor(&per_cu, (const void*)mk_fwd, NTHR, LDS_BYTES) != hipSuccess || per_cu < 1) fprintf(stderr, "kernel_launch: occupancy query reports %d\n", per_cu);
        (void)hipGetLastError();
        grid = cus;
    }
    if (grid < 0) return;
    if (hipMemsetAsync((char*)d_ws + WS_CTL, 0, CTL_ZERO_BYTES, stream) != hipSuccess) return;
    Args a{};
    for (int i = 0; i < 26; ++i) a.in[i] = (const float*)d_in[i];
    a.out = (float*)d_out; a.ws = (unsigned char*)d_ws;
    for (int li = 0; li < N_LAUNCHES; ++li) {
        a.ph_lo = (N_LAUNCHES == 1) ? 0 : li; a.ph_hi = (N_LAUNCHES == 1) ? N_PHASES : li + 1;
        hipLaunchKernelGGL(mk_fwd, dim3(grid), dim3(NTHR), LDS_BYTES, stream, a);
        const hipError_t le = hipPeekAtLastError();
        if (le != hipSuccess) { fprintf(stderr, "kernel_launch: launch %d failed: %s\n", li, hipGetErrorName(le)); break; }
    }
}
```

```cpp
#include <hip/hip_runtime.h>
#include <cstdio>
#include <cstdint>
#ifndef MK_N_LAUNCHES
#define MK_N_LAUNCHES 1
#endif
namespace pg8 {
#define PG8_LAS __attribute__((address_space(3)))
typedef unsigned short bf16_t;
typedef short bf16x8 __attribute__((ext_vector_type(8)));
typedef float f32x4 __attribute__((ext_vector_type(4)));
typedef unsigned u32x4 __attribute__((ext_vector_type(4)));
typedef int i32x4 __attribute__((ext_vector_type(4)));
typedef int i32x8 __attribute__((ext_vector_type(8)));
constexpr int BM = 256, BK = 64, HALF = 128, HTB = HALF * BK * 2  , STAGE_BYTES = 8 * HTB, NXCD = 8, WGM = 8;

__host__ __device__ __forceinline__ int lds_byte(int r, int c) { const int st = (r >> 4) * 2 + (c >> 5), rr = r & 15, cc = c & 31, ob = rr * 64 + cc * 2; return st * 1024 + (ob ^ (((ob >> 9) & 1) << 5)); }
__host__ __device__ __forceinline__ void stage_rc(int b, int& R, int& C) { const int st = b / 1024, sb = b % 1024, swz = sb ^ (((sb >> 9) & 1) << 5); R = (st >> 1) * 16 + swz / 64; C = (st & 1) * 32 + (swz % 64) / 2; }
__host__ __device__ __forceinline__ int perm32(int rho) { const int n = rho >> 4, i = rho & 15; return 8 * (i >> 2) + 4 * n + (i & 3); }

struct Unit { int pm, pn, po, hf; };
struct Gemm { const bf16_t* A; const bf16_t* Bt; int M, N, K; };

struct StaticOrder {
    int nM, nN, nwg, G, c;
    __host__ __device__ void init(int M, int N, int G_, int c_) { nM = M / BM; nN = N / BM; nwg = nM * nN; G = G_; c = c_; }
    __host__ __device__ bool next(int i, Unit& u) const {
        const long L = (long)i * G + c; if (L >= nwg) return false;
        int wgid = (int)L; { const int q = nwg / NXCD, r = nwg % NXCD, xcd = wgid % NXCD, off = wgid / NXCD; wgid = (xcd < r ? xcd * (q + 1) : r * (q + 1) + (xcd - r) * q) + off; }
        const int nig = WGM * nN, gid = wgid / nig, fm = gid * WGM, gsz = (nM - fm) < WGM ? (nM - fm) : WGM;
        u.pm = fm + ((wgid % nig) % gsz); u.pn = (wgid % nig) / gsz; u.po = u.pm; u.hf = 0; return true;
    }
    __device__ __forceinline__ void a_ready(const Unit&) const {}
    __device__ __forceinline__ void done(const Unit&) const {}
};
struct DynOrder {
    unsigned* q; PG8_LAS int* slot; int xcd, nN, ctx8, pn0;
    __device__ __forceinline__ bool next(int i, Unit& u) const {
        if (threadIdx.x == 0) { int id = -1;
            unsigned v = __hip_atomic_fetch_add(q + 64 * xcd, 1u, __ATOMIC_RELAXED, __HIP_MEMORY_SCOPE_AGENT);
            const unsigned per = (unsigned)(4 * nN + ctx8);
            if (v < per) id = xcd * (int)per + (int)v;
            else {
#pragma unroll 1
                for (int k = 1; k < 8 && id < 0; ++k) { const int x = (xcd + k) & 7;
                    if (__hip_atomic_load(q + 64 * x, __ATOMIC_RELAXED, __HIP_MEMORY_SCOPE_AGENT) < per) { v = __hip_atomic_fetch_add(q + 64 * x, 1u, __ATOMIC_RELAXED, __HIP_MEMORY_SCOPE_AGENT); if (v < per) id = x * (int)per + (int)v; } } }
            slot[i & 1] = id; asm volatile("s_waitcnt lgkmcnt(0)" ::: "memory"); }
        asm volatile("" ::: "memory"); __builtin_amdgcn_s_barrier(); asm volatile("" ::: "memory");
        const int id = slot[i & 1]; if (id < 0) return false;
        const int per = 4 * nN + ctx8, nl = 4 * nN, x = id / per, v = id - x * per;
        if (v < nl) { const int wgid = x * nl + v, nig = WGM * nN, gid = wgid / nig; u.pm = gid * WGM + ((wgid % nig) % WGM); u.pn = pn0 + (wgid % nig) / WGM; }
        else { const int j = x * 8 + (v - nl); u.pm = 32 + (j & 3); u.pn = j >> 2; }
        u.po = u.pm; u.hf = 0; return true;
    }
    __device__ __forceinline__ void a_ready(const Unit&) const {}
    __device__ __forceinline__ void done(const Unit&) const {}
};
struct MoeOrder {
    const PG8_LAS int* pref; int nN, G, c, a_sparse;
    __device__ __forceinline__ bool next(int i, Unit& u) const {
        const int L = i * G + c, total = pref[32]; if (L >= total * nN) return false;
        const int mt = L / nN, nt = L - mt * nN; int e = 0;
        for (int k = 1; k < 32; ++k) e += (pref[k] <= mt) ? 1 : 0;
        u.pm = a_sparse ? e * 32 + (mt - pref[e]) : mt; u.pn = e * nN + nt; u.po = mt; u.hf = (pref[33 + e] - 256 * (mt - pref[e]) <= 128) ? 1 : 0; return true;
    }
    __device__ __forceinline__ void a_ready(const Unit&) const {}
    __device__ __forceinline__ void done(const Unit&) const {}
};

struct MoeDyn {
    const PG8_LAS int* pref; int nN, a_sparse; unsigned* q; PG8_LAS int* slot; int xcd;
    __device__ __forceinline__ bool next(int i, Unit& u) const {
        const int total = pref[32], k = nN >> 3;
        if (threadIdx.x == 0) { int id = -1; const unsigned per = (unsigned)(total * k);
            unsigned v = __hip_atomic_fetch_add(q + 64 * xcd, 1u, __ATOMIC_RELAXED, __HIP_MEMORY_SCOPE_AGENT);
            if (v < per) id = (xcd << 16) | (int)v;
            else {
#pragma unroll 1
                for (int j = 1; j < 8 && id < 0; ++j) { const int x = (xcd + j) & 7;
                    if (__hip_atomic_load(q + 64 * x, __ATOMIC_RELAXED, __HIP_MEMORY_SCOPE_AGENT) < per) { v = __hip_atomic_fetch_add(q + 64 * x, 1u, __ATOMIC_RELAXED, __HIP_MEMORY_SCOPE_AGENT); if (v < per) id = (x << 16) | (int)v; } } }
            slot[i & 1] = id; asm volatile("s_waitcnt lgkmcnt(0)" ::: "memory"); }
        asm volatile("" ::: "memory"); __builtin_amdgcn_s_barrier(); asm volatile("" ::: "memory");
        const int id = slot[i & 1]; if (id < 0) return false;
        const int x = id >> 16, v = id & 0xffff, mt = v / k, nt = x + 8 * (v - mt * k); int e = 0;
        for (int j = 1; j < 32; ++j) e += (pref[j] <= mt) ? 1 : 0;
        u.pm = a_sparse ? e * 32 + (mt - pref[e]) : mt; u.pn = e * nN + nt; u.po = mt; u.hf = (pref[33 + e] - 256 * (mt - pref[e]) <= 128) ? 1 : 0; return true;
    }
    __device__ __forceinline__ void a_ready(const Unit&) const {}
    __device__ __forceinline__ void done(const Unit&) const {}
};

__device__ __forceinline__ unsigned cvt_pk_bf16(float lo, float hi) { unsigned r; asm volatile("v_cvt_pk_bf16_f32 %0, %1, %2" : "=v"(r) : "v"(lo), "v"(hi)); return r; }
__device__ __forceinline__ float bf_lo(unsigned w) { return __uint_as_float(w << 16); }
__device__ __forceinline__ float bf_hi(unsigned w) { return __uint_as_float(w & 0xffff0000u); }
__device__ __forceinline__ unsigned pk4_fp8(float a, float b, float c, float d) {
    a = fminf(fmaxf(a, -448.f), 448.f); b = fminf(fmaxf(b, -448.f), 448.f); c = fminf(fmaxf(c, -448.f), 448.f); d = fminf(fmaxf(d, -448.f), 448.f);
    int p = __builtin_amdgcn_cvt_pk_fp8_f32(a, b, 0, false); p = __builtin_amdgcn_cvt_pk_fp8_f32(c, d, p, true); return (unsigned)p; }
constexpr float F8_SA = 16.0f, F8_SW = 512.0f, F8_SC = 4.0f;
__device__ __forceinline__ float sigmoidf_(float x) { return __builtin_amdgcn_rcpf(1.0f + __expf(-x)); }

struct EpiBf16 {
    static constexpr bool PERM = true, AFTER_DRAIN = false;
    bf16_t* O; int ldc; const float* bias; int ncolt;
    __device__ __forceinline__ void operator()(const f32x4 (&acc)[2][2][4][2], const Unit& u, int wr, int wc, int fr, int fq) const {
        const int row0 = u.po * BM + wr * 64 + fr; const int colt = (u.pn % ncolt) * BM;
        const int col0 = colt + wc * 32 + 8 * fq, bcol0 = u.pn * BM + wc * 32 + 8 * fq;
        f32x4 bv[2][2];
#pragma unroll
        for (int bj = 0; bj < 2; ++bj)
#pragma unroll
            for (int n = 0; n < 2; ++n) bv[bj][n] = bias ? *(const f32x4*)(bias + bcol0 + bj * HALF + 4 * n) : (f32x4){0.f, 0.f, 0.f, 0.f};
#pragma unroll
        for (int ai = 0; ai < 2; ++ai)
#pragma unroll
            for (int m = 0; m < 4; ++m) { bf16_t* rowp = O + (size_t)(row0 + ai * HALF + m * 16) * ldc + col0;
#pragma unroll
                for (int bj = 0; bj < 2; ++bj) { const f32x4 v0 = acc[ai][bj][m][0] + bv[bj][0], v1 = acc[ai][bj][m][1] + bv[bj][1];
                    u32x4 w; w.x = cvt_pk_bf16(v0[0], v0[1]); w.y = cvt_pk_bf16(v0[2], v0[3]); w.z = cvt_pk_bf16(v1[0], v1[1]); w.w = cvt_pk_bf16(v1[2], v1[3]);
                    __builtin_nontemporal_store(w, (u32x4*)(rowp + bj * HALF)); } }
    }
};
struct EpiSwiglu8 {
    static constexpr bool PERM = true, AFTER_DRAIN = false;
    unsigned char* O; const float* b1;
    __device__ __forceinline__ void operator()(const f32x4 (&acc)[2][2][4][2], const Unit& u, int wr, int wc, int fr, int fq) const {
        const int e = u.pn >> 4, nt = u.pn & 15; const int row0 = u.po * BM + wr * 64 + fr, j0 = nt * 128 + wc * 32 + 8 * fq;
        const float* bg = b1 + (size_t)e * 4096 + j0; const float* bl = bg + 2048; constexpr float us = 1.0f / (F8_SA * F8_SW);
#pragma unroll
        for (int ai = 0; ai < 2; ++ai)
#pragma unroll
            for (int m = 0; m < 4; ++m) { const size_t row = (size_t)(row0 + ai * HALF + m * 16);
                asm volatile("" ::: "memory");
                unsigned w[2];
#pragma unroll
                for (int n = 0; n < 2; ++n) { const f32x4 gv = acc[ai][0][m][n] * us + *(const f32x4*)(bg + 4 * n), lv = acc[ai][1][m][n] * us + *(const f32x4*)(bl + 4 * n);
                    float o[4];
#pragma unroll
                    for (int i = 0; i < 4; ++i) { const float ga = fminf(gv[i], 7.0f), la = fminf(fmaxf(lv[i], -7.0f), 7.0f); o[i] = ga * sigmoidf_(1.702f * ga) * (la + 1.0f) * F8_SC; }
                    w[n] = pk4_fp8(o[0], o[1], o[2], o[3]); }
                typedef unsigned u32x2 __attribute__((ext_vector_type(2))); const u32x2 ww = {w[0], w[1]};
                *(u32x2*)(O + row * 2048 + j0) = ww; }
    }
};
struct EpiY2f8 {
    static constexpr bool PERM = true, AFTER_DRAIN = false;
    bf16_t* O; const float* bias;
    __device__ __forceinline__ void operator()(const f32x4 (&acc)[2][2][4][2], const Unit& u, int wr, int wc, int fr, int fq) const {
        const int row0 = u.po * BM + wr * 64 + fr; const int col0 = (u.pn & 7) * BM + wc * 32 + 8 * fq, bcol0 = u.pn * BM + wc * 32 + 8 * fq; constexpr float us = 1.0f / (F8_SC * F8_SW);
        f32x4 bv[2][2];
#pragma unroll
        for (int bj = 0; bj < 2; ++bj)
#pragma unroll
            for (int n = 0; n < 2; ++n) bv[bj][n] = *(const f32x4*)(bias + bcol0 + bj * HALF + 4 * n);
#pragma unroll
        for (int ai = 0; ai < 2; ++ai)
#pragma unroll
            for (int m = 0; m < 4; ++m) { bf16_t* rowp = O + (size_t)(row0 + ai * HALF + m * 16) * 2048 + col0;
#pragma unroll
                for (int bj = 0; bj < 2; ++bj) { const f32x4 v0 = acc[ai][bj][m][0] * us + bv[bj][0], v1 = acc[ai][bj][m][1] * us + bv[bj][1];
                    u32x4 w; w.x = cvt_pk_bf16(v0[0], v0[1]); w.y = cvt_pk_bf16(v0[2], v0[3]); w.z = cvt_pk_bf16(v1[0], v1[1]); w.w = cvt_pk_bf16(v1[2], v1[3]);
                    __builtin_nontemporal_store(w, (u32x4*)(rowp + bj * HALF)); } }
    }
};
struct EpiGate8 {
    static constexpr bool PERM = true, AFTER_DRAIN = false;
    bf16_t* O; int ldc;
    __device__ __forceinline__ void operator()(const f32x4 (&acc)[2][2][4][2], const Unit& u, int wr, int wc, int fr, int fq) const {
        const int row0 = u.po * BM + wr * 64 + fr, col0 = (u.pn < 24 ? u.pn : u.pn + 8) * BM + wc * 32 + 8 * fq; constexpr float us = 1.0f / (F8_SA * F8_SW);
#pragma unroll
        for (int ai = 0; ai < 2; ++ai)
#pragma unroll
            for (int m = 0; m < 4; ++m) { bf16_t* rowp = O + (size_t)(row0 + ai * HALF + m * 16) * ldc + col0;
#pragma unroll
                for (int bj = 0; bj < 2; ++bj) { const f32x4 v0 = acc[ai][bj][m][0] * us, v1 = acc[ai][bj][m][1] * us;
                    u32x4 w; w.x = cvt_pk_bf16(v0[0], v0[1]); w.y = cvt_pk_bf16(v0[2], v0[3]); w.z = cvt_pk_bf16(v1[0], v1[1]); w.w = cvt_pk_bf16(v1[2], v1[3]);
                    __builtin_nontemporal_store(w, (u32x4*)(rowp + bj * HALF)); } }
    }
};
struct EpiF32 {
    static constexpr bool PERM = false, AFTER_DRAIN = false;
    float* C; int ldc;
    __device__ __forceinline__ void operator()(const f32x4 (&acc)[2][2][4][2], const Unit& u, int wr, int wc, int fr, int fq) const {
        const int row0 = u.po * BM + wr * 64 + fr, col0 = u.pn * BM + wc * 32 + 4 * fq;
#pragma unroll
        for (int ai = 0; ai < 2; ++ai)
#pragma unroll
            for (int m = 0; m < 4; ++m) { float* rowp = C + (size_t)(row0 + ai * HALF + m * 16) * ldc + col0;
#pragma unroll
                for (int bj = 0; bj < 2; ++bj)
#pragma unroll
                    for (int n = 0; n < 2; ++n) *(f32x4*)(rowp + bj * HALF + n * 16) = acc[ai][bj][m][n]; }
    }
};
struct EpiMerge {
    static constexpr bool PERM = true, AFTER_DRAIN = false;
    bf16_t* O; const bf16_t* Z; int ldz, ga_off, gb_off; const float* YB;
    __device__ __forceinline__ void operator()(const f32x4 (&acc)[2][2][4][2], const Unit& u, int wr, int wc, int fr, int fq) const {
        const int row0 = u.po * BM + wr * 64 + fr, col0 = u.pn * BM + wc * 32 + 8 * fq;
#pragma unroll
        for (int ai = 0; ai < 2; ++ai)
#pragma unroll
            for (int m = 0; m < 4; ++m) { const size_t row = (size_t)(row0 + ai * HALF + m * 16);
#pragma unroll
                for (int bj = 0; bj < 2; ++bj) { const int col = col0 + bj * HALF;
                    const u32x4 ga = *(const u32x4*)(Z + row * ldz + ga_off + col), gb = *(const u32x4*)(Z + row * ldz + gb_off + col);
                    const f32x4 y0 = *(const f32x4*)(YB + row * 2048 + col), y1 = *(const f32x4*)(YB + row * 2048 + col + 4);
                    const f32x4 a0 = acc[ai][bj][m][0], a1 = acc[ai][bj][m][1];
                    float o[8];
                    o[0] = sigmoidf_(bf_lo(ga.x)) * a0[0] + sigmoidf_(bf_lo(gb.x)) * y0[0]; o[1] = sigmoidf_(bf_hi(ga.x)) * a0[1] + sigmoidf_(bf_hi(gb.x)) * y0[1];
                    o[2] = sigmoidf_(bf_lo(ga.y)) * a0[2] + sigmoidf_(bf_lo(gb.y)) * y0[2]; o[3] = sigmoidf_(bf_hi(ga.y)) * a0[3] + sigmoidf_(bf_hi(gb.y)) * y0[3];
                    o[4] = sigmoidf_(bf_lo(ga.z)) * a1[0] + sigmoidf_(bf_lo(gb.z)) * y1[0]; o[5] = sigmoidf_(bf_hi(ga.z)) * a1[1] + sigmoidf_(bf_hi(gb.z)) * y1[1];
                    o[6] = sigmoidf_(bf_lo(ga.w)) * a1[2] + sigmoidf_(bf_lo(gb.w)) * y1[2]; o[7] = sigmoidf_(bf_hi(ga.w)) * a1[3] + sigmoidf_(bf_hi(gb.w)) * y1[3];
                    u32x4 w; w.x = cvt_pk_bf16(o[0], o[1]); w.y = cvt_pk_bf16(o[2], o[3]); w.z = cvt_pk_bf16(o[4], o[5]); w.w = cvt_pk_bf16(o[6], o[7]);
                    *(u32x4*)(O + row * 2048 + col) = w; } }
    }
};
struct EpiX1 {
    static constexpr bool PERM = false, AFTER_DRAIN = false;
    float* X1; const float* X; const float* mod;
    __device__ __forceinline__ void operator()(const f32x4 (&acc)[2][2][4][2], const Unit& u, int wr, int wc, int fr, int fq) const {
        const int row0 = u.po * BM + wr * 64 + fr, col0 = u.pn * BM + wc * 32 + 4 * fq;
        const float* mg = mod + (size_t)((u.po * BM) >> 11) * 12288 + 2 * 2048;
#pragma unroll
        for (int bj = 0; bj < 2; ++bj)
#pragma unroll
            for (int n = 0; n < 2; ++n) { const int col = col0 + bj * HALF + n * 16; const f32x4 g = *(const f32x4*)(mg + col);
#pragma unroll
                for (int ai = 0; ai < 2; ++ai)
#pragma unroll
                    for (int m = 0; m < 4; ++m) { const size_t off = (size_t)(row0 + ai * HALF + m * 16) * 2048 + col;
                        *(f32x4*)(X1 + off) = *(const f32x4*)(X + off) + g * acc[ai][bj][m][n]; } }
    }
};
struct EpiSwiglu {
    static constexpr bool PERM = true, AFTER_DRAIN = false;
    bf16_t* O; const float* b1;
    __device__ __forceinline__ void operator()(const f32x4 (&acc)[2][2][4][2], const Unit& u, int wr, int wc, int fr, int fq) const {
        const int e = u.pn >> 4, nt = u.pn & 15; const int row0 = u.po * BM + wr * 64 + fr, j0 = nt * 128 + wc * 32 + 8 * fq;
        const float* bg = b1 + (size_t)e * 4096 + j0; const float* bl = bg + 2048;
#pragma unroll
        for (int ai = 0; ai < 2; ++ai)
#pragma unroll
            for (int m = 0; m < 4; ++m) { const size_t row = (size_t)(row0 + ai * HALF + m * 16);
                asm volatile("" ::: "memory");
#pragma unroll
                for (int n = 0; n < 2; ++n) { const f32x4 gv = acc[ai][0][m][n] + *(const f32x4*)(bg + 4 * n), lv = acc[ai][1][m][n] + *(const f32x4*)(bl + 4 * n);
                    float o[4];
#pragma unroll
                    for (int i = 0; i < 4; ++i) { const float ga = fminf(gv[i], 7.0f), la = fminf(fmaxf(lv[i], -7.0f), 7.0f); o[i] = ga * sigmoidf_(1.702f * ga) * (la + 1.0f); }
                    typedef unsigned u32x2 __attribute__((ext_vector_type(2))); u32x2 w; w.x = cvt_pk_bf16(o[0], o[1]); w.y = cvt_pk_bf16(o[2], o[3]);
                    *(u32x2*)(O + row * 2048 + j0 + 4 * n) = w; } }
    }
};

template <class Epi, class Sched, bool ALIGN_EPI = false, bool SP2 = false, bool HALFSKIP = false>
__device__ __forceinline__ void gemm_phase(PG8_LAS unsigned char* lds, const Gemm g, const Sched& S, const Epi& E) {
    const int tid = threadIdx.x, wid = __builtin_amdgcn_readfirstlane(tid >> 6), lane = tid & 63, wr = wid >> 2, wc = wid & 3, fr = lane & 15, fq = lane >> 4;
    const int K = g.K, nt = K / BK;
    unsigned voffA[2], voffB[2];
#pragma unroll
    for (int i = 0; i < 2; ++i) { int R, C; stage_rc(tid * 16 + i * 8192, R, C); const int Rb = Epi::PERM ? ((R & ~31) + perm32(R & 31)) : R;
        voffA[i] = (unsigned)(R * K + C) * 2u; voffB[i] = (unsigned)(Rb * K + C) * 2u; }
    const size_t kstep = (size_t)(BK * 2);
    const size_t hstep = (size_t)HALF * K * 2;
    const size_t tstep = 2 * hstep;
    const unsigned ldsw = (unsigned)wid * 1024u;
    const int aoff = lds_byte(wr * 64 + fr, fq * 8), boff = lds_byte(wc * 32 + fr, fq * 8);
#define PG8_SA(b, h) (((b) * 2 + (h)) * HTB)
#define PG8_SB(b, h) ((4 + (b) * 2 + (h)) * HTB)
#define PG8_STAGE(bufoff, gbase, voff) do { _Pragma("unroll") for (int _i = 0; _i < 2; ++_i) \
        __builtin_amdgcn_global_load_lds((const unsigned*)((const char*)(gbase) + (voff)[_i]), (PG8_LAS unsigned*)(lds + (bufoff) + ldsw + _i * 8192), 16, 0, 0); } while (0)
#define PG8_LDA(dst, b, h) do { _Pragma("unroll") for (int m = 0; m < 4; ++m) _Pragma("unroll") for (int k = 0; k < 2; ++k) dst[m][k] = *(const PG8_LAS bf16x8*)(lds + PG8_SA(b, h) + aoff + m * 2048 + k * 1024); } while (0)
#define PG8_LDB(dst, b, h) do { _Pragma("unroll") for (int n = 0; n < 2; ++n) _Pragma("unroll") for (int k = 0; k < 2; ++k) dst[n][k] = *(const PG8_LAS bf16x8*)(lds + PG8_SB(b, h) + boff + n * 2048 + k * 1024); } while (0)
#define PG8_MMA(ai, bj, At, Bt) do { __builtin_amdgcn_s_setprio(1); _Pragma("unroll") for (int m = 0; m < 4; ++m) _Pragma("unroll") for (int n = 0; n < 2; ++n) _Pragma("unroll") for (int k = 0; k < 2; ++k) \
        acc[ai][bj][m][n] = __builtin_amdgcn_mfma_f32_16x16x32_bf16(Bt[n][k], At[m][k], acc[ai][bj][m][n], 0, 0, 0); __builtin_amdgcn_s_setprio(0); } while (0)
#define PG8_WAIT_V(n) asm volatile("s_waitcnt vmcnt(" #n ")" ::: "memory")
#define PG8_WAIT_L(n) asm volatile("s_waitcnt lgkmcnt(" #n ")" ::: "memory")
#define PG8_BAR __builtin_amdgcn_s_barrier()
#define PG8_SCHED __builtin_amdgcn_sched_barrier(0)
    Unit cur, nxt; int ui = 0;
    if (!S.next(0, cur)) return;
    f32x4 acc[2][2][4][2];
#pragma unroll
    for (int a = 0; a < 2; ++a)
#pragma unroll
        for (int b = 0; b < 2; ++b)
#pragma unroll
            for (int m = 0; m < 4; ++m)
#pragma unroll
                for (int n = 0; n < 2; ++n) acc[a][b][m][n] = (f32x4){0.f, 0.f, 0.f, 0.f};
    bf16x8 At[4][2], B0[2][2], B1[2][2];
    const char* cA = (const char*)g.A + (size_t)cur.pm * tstep; const char* cB = (const char*)g.Bt + (size_t)cur.pn * tstep;
    S.a_ready(cur);
    if constexpr (SP2) {
        PG8_STAGE(PG8_SB(0, 0), cB, voffB); PG8_STAGE(PG8_SB(0, 1), cB + hstep, voffB); PG8_STAGE(PG8_SA(0, 0), cA, voffA); PG8_STAGE(PG8_SA(0, 1), cA + hstep, voffA);
        if (wr == 1) PG8_BAR;
        PG8_WAIT_V(2); PG8_BAR;
        PG8_STAGE(PG8_SB(1, 0), cB + kstep, voffB); PG8_STAGE(PG8_SA(1, 0), cA + kstep, voffA); PG8_STAGE(PG8_SB(1, 1), cB + hstep + kstep, voffB);
        PG8_WAIT_V(6); PG8_BAR;
    } else {
        PG8_STAGE(PG8_SB(0, 0), cB, voffB); PG8_STAGE(PG8_SA(0, 0), cA, voffA); PG8_STAGE(PG8_SB(0, 1), cB + hstep, voffB); PG8_STAGE(PG8_SA(0, 1), cA + hstep, voffA);
        if (wr == 1) PG8_BAR;
        PG8_WAIT_V(4); PG8_BAR;
        PG8_STAGE(PG8_SB(1, 0), cB + kstep, voffB); PG8_STAGE(PG8_SA(1, 0), cA + kstep, voffA); PG8_STAGE(PG8_SB(1, 1), cB + hstep + kstep, voffB);
        PG8_WAIT_V(6); PG8_BAR;
    }
    for (;;) {
        const bool has_next = S.next(ui + 1, nxt);
        const char* nA = has_next ? (const char*)g.A + (size_t)nxt.pm * tstep : cA; const char* nB = has_next ? (const char*)g.Bt + (size_t)nxt.pn * tstep : cB;
        for (int t = 0; t < nt; t += 2) {
            const bool last = (t == nt - 2);
            const char* a1 = cA + (size_t)(t + 1) * kstep;
            const char* a2 = last ? nA : cA + (size_t)(t + 2) * kstep; const char* b2 = last ? nB : cB + (size_t)(t + 2) * kstep;
            const char* a3 = a2 + kstep; const char* b3 = b2 + kstep;
            if (last && has_next) S.a_ready(nxt);
            if constexpr (SP2) {
            PG8_LDB(B0, 0, 0); PG8_LDB(B1, 0, 1); PG8_SCHED; PG8_LDA(At, 0, 0); PG8_STAGE(PG8_SA(1, 1), a1 + hstep, voffA);
            PG8_WAIT_V(8); PG8_WAIT_L(0); PG8_BAR; PG8_MMA(0, 0, At, B0); PG8_MMA(0, 1, At, B1); PG8_BAR; PG8_SCHED;
            PG8_LDA(At, 0, 1); PG8_STAGE(PG8_SB(0, 0), b2, voffB); PG8_STAGE(PG8_SB(0, 1), b2 + hstep, voffB); PG8_STAGE(PG8_SA(0, 0), a2, voffA);
            PG8_WAIT_V(8); PG8_WAIT_L(0); PG8_BAR; if (!(HALFSKIP && cur.hf)) { PG8_MMA(1, 0, At, B0); PG8_MMA(1, 1, At, B1); } PG8_BAR; PG8_SCHED;
            PG8_LDB(B0, 1, 0); PG8_LDB(B1, 1, 1); PG8_SCHED; PG8_LDA(At, 1, 0); PG8_STAGE(PG8_SA(0, 1), a2 + hstep, voffA);
            PG8_WAIT_V(8); PG8_WAIT_L(0); PG8_BAR; PG8_MMA(0, 0, At, B0); PG8_MMA(0, 1, At, B1); PG8_BAR; PG8_SCHED;
            PG8_LDA(At, 1, 1); PG8_STAGE(PG8_SB(1, 0), b3, voffB); PG8_STAGE(PG8_SB(1, 1), b3 + hstep, voffB); PG8_STAGE(PG8_SA(1, 0), a3, voffA);
            PG8_WAIT_V(8); PG8_WAIT_L(0); PG8_BAR; if (!(HALFSKIP && cur.hf)) { PG8_MMA(1, 0, At, B0); PG8_MMA(1, 1, At, B1); } PG8_BAR; PG8_SCHED;
            } else {
            PG8_LDB(B0, 0, 0); PG8_SCHED; PG8_LDA(At, 0, 0); PG8_STAGE(PG8_SA(1, 1), a1 + hstep, voffA);
            PG8_WAIT_L(8); PG8_BAR; PG8_WAIT_L(0); PG8_MMA(0, 0, At, B0); PG8_BAR; PG8_SCHED;
            PG8_LDB(B1, 0, 1); PG8_STAGE(PG8_SB(0, 0), b2, voffB);
            PG8_BAR; PG8_WAIT_L(0); PG8_MMA(0, 1, At, B1); PG8_BAR;
            PG8_LDA(At, 0, 1); PG8_STAGE(PG8_SA(0, 0), a2, voffA);
            PG8_BAR; PG8_WAIT_L(0); PG8_MMA(1, 0, At, B0); PG8_BAR; PG8_SCHED;
            PG8_STAGE(PG8_SB(0, 1), b2 + hstep, voffB);
            PG8_WAIT_V(6); PG8_BAR; PG8_MMA(1, 1, At, B1); PG8_BAR;
            PG8_LDB(B0, 1, 0); PG8_SCHED; PG8_LDA(At, 1, 0); PG8_STAGE(PG8_SA(0, 1), a2 + hstep, voffA);
            PG8_WAIT_L(8); PG8_BAR; PG8_WAIT_L(0); PG8_MMA(0, 0, At, B0); PG8_BAR; PG8_SCHED;
            PG8_LDB(B1, 1, 1); PG8_STAGE(PG8_SB(1, 0), b3, voffB);
            PG8_BAR; PG8_WAIT_L(0); PG8_MMA(0, 1, At, B1); PG8_BAR;
            PG8_LDA(At, 1, 1); PG8_STAGE(PG8_SA(1, 0), a3, voffA);
            PG8_BAR; PG8_WAIT_L(0); PG8_MMA(1, 0, At, B0); PG8_BAR; PG8_SCHED;
            PG8_STAGE(PG8_SB(1, 1), b3 + hstep, voffB);
            PG8_WAIT_V(6); PG8_BAR; PG8_MMA(1, 1, At, B1); PG8_BAR;
            }
        }
        if constexpr (ALIGN_EPI) { if (wr == 0) PG8_BAR; }
        if constexpr (!Epi::AFTER_DRAIN) { E(acc, cur, wr, wc, fr, fq); S.done(cur); }
        if (!has_next) break;
#pragma unroll
        for (int a = 0; a < 2; ++a)
#pragma unroll
            for (int b = 0; b < 2; ++b)
#pragma unroll
                for (int m = 0; m < 4; ++m)
#pragma unroll
                    for (int n = 0; n < 2; ++n) acc[a][b][m][n] = (f32x4){0.f, 0.f, 0.f, 0.f};
        cur = nxt; cA = nA; cB = nB; ++ui;
        if constexpr (ALIGN_EPI) { if (wr == 1) PG8_BAR; }
    }
    PG8_WAIT_V(0);
    if constexpr (!ALIGN_EPI) { if (wr == 0) PG8_BAR; }
    PG8_BAR;
    if constexpr (Epi::AFTER_DRAIN) { E.fused(acc, cur, wr, wc, fr, fq, lds, wid, lane); S.done(cur); }
#undef PG8_SA
#undef PG8_SB
#undef PG8_STAGE
#undef PG8_LDA
#undef PG8_LDB
#undef PG8_MMA
#undef PG8_WAIT_V
#undef PG8_WAIT_L
#undef PG8_BAR
#undef PG8_SCHED
}
template <class Epi, class Sched, bool ALIGN_EPI = false, bool SP2 = false, bool HALFSKIP = false>
__device__ __forceinline__ void gemm_phase8(PG8_LAS unsigned char* lds, const Gemm g, const Sched& S, const Epi& E) {
    const int tid = threadIdx.x, wid = __builtin_amdgcn_readfirstlane(tid >> 6), lane = tid & 63, wr = wid >> 2, wc = wid & 3, fr = lane & 15, fq = lane >> 4;
    const int K = g.K, nt = K / 128;
    unsigned voffA[2], voffB[2];
#pragma unroll
    for (int i = 0; i < 2; ++i) { int R, C; stage_rc(tid * 16 + i * 8192, R, C); const int Rb = Epi::PERM ? ((R & ~31) + perm32(R & 31)) : R;
        voffA[i] = (unsigned)(R * K + 2 * C); voffB[i] = (unsigned)(Rb * K + 2 * C); }
    const size_t kstep = (size_t)(BK * 2);
    const size_t hstep = (size_t)HALF * K;
    const size_t tstep = 2 * hstep;
    const unsigned ldsw = (unsigned)wid * 1024u;
    const int aoff = lds_byte(wr * 64 + fr, fq * 16), boff = lds_byte(wc * 32 + fr, fq * 16);
#define PG8_SA(b, h) (((b) * 2 + (h)) * HTB)
#define PG8_SB(b, h) ((4 + (b) * 2 + (h)) * HTB)
#define PG8_STAGE(bufoff, gbase, voff) do { _Pragma("unroll") for (int _i = 0; _i < 2; ++_i) \
        __builtin_amdgcn_global_load_lds((const unsigned*)((const char*)(gbase) + (voff)[_i]), (PG8_LAS unsigned*)(lds + (bufoff) + ldsw + _i * 8192), 16, 0, 0); } while (0)
#define PG8_LDA(dst, b, h) do { _Pragma("unroll") for (int m = 0; m < 4; ++m) { const i32x4 lo_ = *(const PG8_LAS i32x4*)(lds + PG8_SA(b, h) + aoff + m * 2048), hi_ = *(const PG8_LAS i32x4*)(lds + PG8_SA(b, h) + aoff + m * 2048 + 16); dst[m] = __builtin_shufflevector(lo_, hi_, 0, 1, 2, 3, 4, 5, 6, 7); } } while (0)
#define PG8_LDB(dst, b, h) do { _Pragma("unroll") for (int n = 0; n < 2; ++n) { const i32x4 lo_ = *(const PG8_LAS i32x4*)(lds + PG8_SB(b, h) + boff + n * 2048), hi_ = *(const PG8_LAS i32x4*)(lds + PG8_SB(b, h) + boff + n * 2048 + 16); dst[n] = __builtin_shufflevector(lo_, hi_, 0, 1, 2, 3, 4, 5, 6, 7); } } while (0)
#define PG8_MMA(ai, bj, At, Bt) do { __builtin_amdgcn_s_setprio(1); _Pragma("unroll") for (int m = 0; m < 4; ++m) _Pragma("unroll") for (int n = 0; n < 2; ++n) \
        asm volatile("v_mfma_scale_f32_16x16x128_f8f6f4 %0, %1, %2, %0, %3, %3 op_sel_hi:[0,0,0]" : "+v"(acc[ai][bj][m][n]) : "v"(Bt[n]), "v"(At[m]), "v"(sc127)); __builtin_amdgcn_s_setprio(0); } while (0)
#define PG8_WAIT_V(n) asm volatile("s_waitcnt vmcnt(" #n ")" ::: "memory")
#define PG8_WAIT_L(n) asm volatile("s_waitcnt lgkmcnt(" #n ")" ::: "memory")
#define PG8_BAR __builtin_amdgcn_s_barrier()
#define PG8_SCHED __builtin_amdgcn_sched_barrier(0)
    Unit cur, nxt; int ui = 0;
    if (!S.next(0, cur)) return;
    f32x4 acc[2][2][4][2];
#pragma unroll
    for (int a = 0; a < 2; ++a)
#pragma unroll
        for (int b = 0; b < 2; ++b)
#pragma unroll
            for (int m = 0; m < 4; ++m)
#pragma unroll
                for (int n = 0; n < 2; ++n) acc[a][b][m][n] = (f32x4){0.f, 0.f, 0.f, 0.f};
    i32x8 At[4], B0[2], B1[2]; const int sc127 = 127;
    const char* cA = (const char*)g.A + (size_t)cur.pm * tstep; const char* cB = (const char*)g.Bt + (size_t)cur.pn * tstep;
    S.a_ready(cur);
    if constexpr (SP2) {
        PG8_STAGE(PG8_SB(0, 0), cB, voffB); PG8_STAGE(PG8_SB(0, 1), cB + hstep, voffB); PG8_STAGE(PG8_SA(0, 0), cA, voffA); PG8_STAGE(PG8_SA(0, 1), cA + hstep, voffA);
        if (wr == 1) PG8_BAR;
        PG8_WAIT_V(2); PG8_BAR;
        PG8_STAGE(PG8_SB(1, 0), cB + kstep, voffB); PG8_STAGE(PG8_SA(1, 0), cA + kstep, voffA); PG8_STAGE(PG8_SB(1, 1), cB + hstep + kstep, voffB);
        PG8_WAIT_V(6); PG8_BAR;
    } else {
        PG8_STAGE(PG8_SB(0, 0), cB, voffB); PG8_STAGE(PG8_SA(0, 0), cA, voffA); PG8_STAGE(PG8_SB(0, 1), cB + hstep, voffB); PG8_STAGE(PG8_SA(0, 1), cA + hstep, voffA);
        if (wr == 1) PG8_BAR;
        PG8_WAIT_V(4); PG8_BAR;
        PG8_STAGE(PG8_SB(1, 0), cB + kstep, voffB); PG8_STAGE(PG8_SA(1, 0), cA + kstep, voffA); PG8_STAGE(PG8_SB(1, 1), cB + hstep + kstep, voffB);
        PG8_WAIT_V(6); PG8_BAR;
    }
    for (;;) {
        const bool has_next = S.next(ui + 1, nxt);
        const char* nA = has_next ? (const char*)g.A + (size_t)nxt.pm * tstep : cA; const char* nB = has_next ? (const char*)g.Bt + (size_t)nxt.pn * tstep : cB;
        for (int t = 0; t < nt; t += 2) {
            const bool last = (t == nt - 2);
            const char* a1 = cA + (size_t)(t + 1) * kstep;
            const char* a2 = last ? nA : cA + (size_t)(t + 2) * kstep; const char* b2 = last ? nB : cB + (size_t)(t + 2) * kstep;
            const char* a3 = a2 + kstep; const char* b3 = b2 + kstep;
            if (last && has_next) S.a_ready(nxt);
            if constexpr (SP2) {
            PG8_LDB(B0, 0, 0); PG8_LDB(B1, 0, 1); PG8_SCHED; PG8_LDA(At, 0, 0); PG8_STAGE(PG8_SA(1, 1), a1 + hstep, voffA);
            PG8_WAIT_V(8); PG8_WAIT_L(0); PG8_BAR; PG8_MMA(0, 0, At, B0); PG8_MMA(0, 1, At, B1); PG8_BAR; PG8_SCHED;
            if (!(HALFSKIP && cur.hf)) PG8_LDA(At, 0, 1); PG8_STAGE(PG8_SB(0, 0), b2, voffB); PG8_STAGE(PG8_SB(0, 1), b2 + hstep, voffB); PG8_STAGE(PG8_SA(0, 0), a2, voffA);
            PG8_WAIT_V(8); PG8_WAIT_L(0); PG8_BAR; if (!(HALFSKIP && cur.hf)) { PG8_MMA(1, 0, At, B0); PG8_MMA(1, 1, At, B1); } PG8_BAR; PG8_SCHED;
            PG8_LDB(B0, 1, 0); PG8_LDB(B1, 1, 1); PG8_SCHED; PG8_LDA(At, 1, 0); PG8_STAGE(PG8_SA(0, 1), a2 + hstep, voffA);
            PG8_WAIT_V(8); PG8_WAIT_L(0); PG8_BAR; PG8_MMA(0, 0, At, B0); PG8_MMA(0, 1, At, B1); PG8_BAR; PG8_SCHED;
            if (!(HALFSKIP && cur.hf)) PG8_LDA(At, 1, 1); PG8_STAGE(PG8_SB(1, 0), b3, voffB); PG8_STAGE(PG8_SB(1, 1), b3 + hstep, voffB); PG8_STAGE(PG8_SA(1, 0), a3, voffA);
            PG8_WAIT_V(8); PG8_WAIT_L(0); PG8_BAR; if (!(HALFSKIP && cur.hf)) { PG8_MMA(1, 0, At, B0); PG8_MMA(1, 1, At, B1); } PG8_BAR; PG8_SCHED;
            } else {
            PG8_LDB(B0, 0, 0); PG8_SCHED; PG8_LDA(At, 0, 0); PG8_STAGE(PG8_SA(1, 1), a1 + hstep, voffA);
            PG8_WAIT_L(8); PG8_BAR; PG8_WAIT_L(0); PG8_MMA(0, 0, At, B0); PG8_BAR; PG8_SCHED;
            PG8_LDB(B1, 0, 1); PG8_STAGE(PG8_SB(0, 0), b2, voffB);
            PG8_BAR; PG8_WAIT_L(0); PG8_MMA(0, 1, At, B1); PG8_BAR;
            PG8_LDA(At, 0, 1); PG8_STAGE(PG8_SA(0, 0), a2, voffA);
            PG8_BAR; PG8_WAIT_L(0); PG8_MMA(1, 0, At, B0); PG8_BAR; PG8_SCHED;
            PG8_STAGE(PG8_SB(0, 1), b2 + hstep, voffB);
            PG8_WAIT_V(6); PG8_BAR; PG8_MMA(1, 1, At, B1); PG8_BAR;
            PG8_LDB(B0, 1, 0); PG8_SCHED; PG8_LDA(At, 1, 0); PG8_STAGE(PG8_SA(0, 1), a2 + hstep, voffA);
            PG8_WAIT_L(8); PG8_BAR; PG8_WAIT_L(0); PG8_MMA(0, 0, At, B0); PG8_BAR; PG8_SCHED;
            PG8_LDB(B1, 1, 1); PG8_STAGE(PG8_SB(1, 0), b3, voffB);
            PG8_BAR; PG8_WAIT_L(0); PG8_MMA(0, 1, At, B1); PG8_BAR;
            PG8_LDA(At, 1, 1); PG8_STAGE(PG8_SA(1, 0), a3, voffA);
            PG8_BAR; PG8_WAIT_L(0); PG8_MMA(1, 0, At, B0); PG8_BAR; PG8_SCHED;
            PG8_STAGE(PG8_SB(1, 1), b3 + hstep, voffB);
            PG8_WAIT_V(6); PG8_BAR; PG8_MMA(1, 1, At, B1); PG8_BAR;
            }
        }
        if constexpr (ALIGN_EPI) { if (wr == 0) PG8_BAR; }
        if constexpr (!Epi::AFTER_DRAIN) { E(acc, cur, wr, wc, fr, fq); S.done(cur); }
        if (!has_next) break;
#pragma unroll
        for (int a = 0; a < 2; ++a)
#pragma unroll
            for (int b = 0; b < 2; ++b)
#pragma unroll
                for (int m = 0; m < 4; ++m)
#pragma unroll
                    for (int n = 0; n < 2; ++n) acc[a][b][m][n] = (f32x4){0.f, 0.f, 0.f, 0.f};
        cur = nxt; cA = nA; cB = nB; ++ui;
        if constexpr (ALIGN_EPI) { if (wr == 1) PG8_BAR; }
    }
    PG8_WAIT_V(0);
    if constexpr (!ALIGN_EPI) { if (wr == 0) PG8_BAR; }
    PG8_BAR;
    if constexpr (Epi::AFTER_DRAIN) { E.fused(acc, cur, wr, wc, fr, fq, lds, wid, lane); S.done(cur); }
#undef PG8_SA
#undef PG8_SB
#undef PG8_STAGE
#undef PG8_LDA
#undef PG8_LDB
#undef PG8_MMA
#undef PG8_WAIT_V
#undef PG8_WAIT_L
#undef PG8_BAR
#undef PG8_SCHED
}
}

constexpr int NWAVES = 8, NTHR = 512;
constexpr int N_LAUNCHES = MK_N_LAUNCHES;
constexpr int N_PHASES = 13;
constexpr int DM = 2048, NB = 4, TL = 2048, NLAT = NB * TL, TCX = 256, NCTX = NB * TCX, NTOK = NLAT + NCTX;
constexpr int NH = 8, QKD = 128, VD = 256, INC = 14368, ZW = 14336;
constexpr int ZQ = 0, ZK = 1024, ZV = 2048, ZO = 4096, ZU = 6144, ZS = 8192, ZGA = 10240, ZGB = 12288;
constexpr int NEXP = 32, DEXP = 2048, NCH = 18  , CROWS = 272  ;
constexpr float EPS = 1e-6f;

constexpr size_t MiB = 1u << 20;
constexpr size_t WS_CTL = 0, CTL_ZERO_BYTES = 1 * MiB;
constexpr size_t WS_MOD = 1 * MiB;
constexpr size_t WS_GATES = 2 * MiB;
constexpr size_t WS_SCAL = 4 * MiB;
constexpr size_t WS_ROUTE = 5 * MiB;
constexpr size_t WS_SCN = 2996 * MiB;
constexpr size_t WS_SK = 6 * MiB;
constexpr size_t WS_WINT = 8 * MiB;
constexpr size_t WS_PAT = 64 * MiB, WS_PBT = 72 * MiB, WS_WOT = 80 * MiB;
constexpr size_t WS_W1T = 88 * MiB;
constexpr size_t WS_W2T = 600 * MiB;
constexpr size_t WS_HB = 856 * MiB;
constexpr size_t WS_Z = 892 * MiB;
constexpr size_t WS_QC = 1144 * MiB, WS_KC = 1162 * MiB;
constexpr size_t WS_SVN = 1180 * MiB;
constexpr size_t WS_DC = 1212 * MiB;
constexpr size_t WS_CS = 1360 * MiB;
constexpr size_t WS_RO = 1428 * MiB;
constexpr size_t WS_CM = 1460 * MiB;
constexpr size_t WS_YB = 1492 * MiB;
constexpr size_t WS_MRG = 1556 * MiB;
constexpr size_t WS_X1 = 1588 * MiB;
constexpr size_t WS_ACT = 1652 * MiB;
constexpr size_t WS_Y2 = 1812 * MiB;
constexpr size_t WS_XG = 1972 * MiB;
constexpr size_t WS_HB8 = 2998 * MiB;
constexpr size_t WS_WG8 = 3016 * MiB;
constexpr size_t WS_END = 3040 * MiB;
static_assert(WS_DC + (size_t)64 * 17 * CROWS * 128 * 2 <= WS_CS && WS_CS + (size_t)64 * 16 * CROWS * 128 * 2 <= WS_RO && WS_Z + (size_t)NTOK * ZW * 2 <= WS_QC, "ws map");
constexpr int CW_Q3 = 3584, CW_Q4 = 8192;
constexpr int CW_Q2 = 3072;
constexpr int CW_Q = 2048;
constexpr int CW_CNT = 64;
constexpr int CW_BAR = 4096;
constexpr int RING_BYTES = 131072;
constexpr int LDS_BYTES = 147456;
constexpr int LDSCTL_OFF = LDS_BYTES - 2048, MISC_OFF = LDSCTL_OFF + 320, PREF_OFF = LDSCTL_OFF + 1024;

#define GAS __attribute__((address_space(1)))
#define LAS __attribute__((address_space(3)))
typedef unsigned short bf16;
typedef unsigned v4u __attribute__((ext_vector_type(4)));
typedef unsigned v2u __attribute__((ext_vector_type(2)));
typedef float f32x4 __attribute__((ext_vector_type(4)));
typedef short bf16x8 __attribute__((ext_vector_type(8)));
typedef short s16x4 __attribute__((ext_vector_type(4)));
typedef GAS unsigned gu32;
#define RLX_AGENT __ATOMIC_RELAXED, __HIP_MEMORY_SCOPE_AGENT
#define LDS_WAIT() asm volatile("s_waitcnt lgkmcnt(0)" ::: "memory")
#define VM_WAIT() asm volatile("s_waitcnt vmcnt(0)" ::: "memory")
using pg8::cvt_pk_bf16; using pg8::bf_lo; using pg8::bf_hi; using pg8::sigmoidf_;


__device__ __forceinline__ float wave_sum(float v) {
#pragma unroll
    for (int o = 1; o < 64; o <<= 1) v += __shfl_xor(v, o);
    return v;
}
__device__ __forceinline__ float siluf_(float x) { return x * __builtin_amdgcn_rcpf(1.0f + __expf(-x)); }
__device__ __forceinline__ float gelu_tanh(float x) { const float u = 0.7978845608028654f * (x + 0.044715f * x * x * x); return x * __builtin_amdgcn_rcpf(1.0f + __expf(-2.0f * u)); }
__device__ __forceinline__ float logsigf_(float f) { return fminf(f, 0.f) - log1pf(expf(-fabsf(f))); }
__device__ __forceinline__ unsigned img_off(unsigned row, unsigned ch) { return 256u * row + 16u * (ch ^ (((row & 3u) << 2) | ((row >> 2) & 3u))); }
__device__ __forceinline__ s16x4 tr_read(LAS unsigned char* p) { return __builtin_amdgcn_ds_read_tr16_b64_v4i16((LAS s16x4*)p); }
__device__ __forceinline__ bf16x8 tr_frag(LAS unsigned char* img, unsigned r0, unsigned r1, unsigned c, int lane) {
    const unsigned q = (lane & 15) >> 2, p = lane & 3;
    const s16x4 lo = tr_read(img + img_off(r0 + q, 2 * c + (p >> 1)) + 8 * (p & 1));
    const s16x4 hi = tr_read(img + img_off(r1 + q, 2 * c + (p >> 1)) + 8 * (p & 1));
    bf16x8 r; r[0] = lo[0]; r[1] = lo[1]; r[2] = lo[2]; r[3] = lo[3]; r[4] = hi[0]; r[5] = hi[1]; r[6] = hi[2]; r[7] = hi[3]; return r;
}
__device__ __forceinline__ bf16x8 tr_frag2(LAS unsigned char* base, unsigned x0, unsigned x1) {
    const s16x4 lo = tr_read(base + x0), hi = tr_read(base + x1);
    bf16x8 r; r[0] = lo[0]; r[1] = lo[1]; r[2] = lo[2]; r[3] = lo[3]; r[4] = hi[0]; r[5] = hi[1]; r[6] = hi[2]; r[7] = hi[3]; return r;
}
#define TR_NAT_OFFS(xn0, xn1, lane) unsigned xn0[8], xn1[8]; { const unsigned g_ = (lane) >> 4, q_ = ((lane) & 15) >> 2, p_ = (lane) & 3; \
    _Pragma("unroll") for (int c_ = 0; c_ < 8; ++c_) { xn0[c_] = 256u * (8 * g_ + q_) + 16u * ((2 * c_ + (p_ >> 1)) ^ ((q_ << 2) | ((2 * g_) & 3))) + 8u * (p_ & 1); \
                                                       xn1[c_] = 256u * (8 * g_ + 4 + q_) + 16u * ((2 * c_ + (p_ >> 1)) ^ ((q_ << 2) | ((2 * g_ + 1) & 3))) + 8u * (p_ & 1); } }
#define TR_PERM_OFFS(xp, lane) unsigned xp[8]; { const unsigned g_ = (lane) >> 4, q_ = ((lane) & 15) >> 2, p_ = (lane) & 3; \
    _Pragma("unroll") for (int c_ = 0; c_ < 8; ++c_) xp[c_] = 256u * (4 * g_ + q_) + 16u * ((2 * c_ + (p_ >> 1)) ^ ((q_ << 2) | g_)) + 8u * (p_ & 1); }
__device__ __forceinline__ void load_tile128(LAS unsigned char* img, const bf16* src, size_t ld, int tid) {
#pragma unroll
    for (int i = 0; i < 4; ++i) { const int id = tid + NTHR * i, row = id >> 4, ch = id & 15;
        const v4u v = *(const v4u*)(src + (size_t)row * ld + 8 * ch); *(LAS v4u*)(img + img_off(row, ch)) = v; }
}
__device__ __forceinline__ void load_tile128_scaled(LAS unsigned char* img, const bf16* src, size_t ld, const LAS float* w, int tid) {
#pragma unroll
    for (int i = 0; i < 4; ++i) { const int id = tid + NTHR * i, row = id >> 4, ch = id & 15; const float s = w[row];
        const v4u v = *(const v4u*)(src + (size_t)row * ld + 8 * ch); v4u o;
        o.x = cvt_pk_bf16(bf_lo(v.x) * s, bf_hi(v.x) * s); o.y = cvt_pk_bf16(bf_lo(v.y) * s, bf_hi(v.y) * s); o.z = cvt_pk_bf16(bf_lo(v.z) * s, bf_hi(v.z) * s); o.w = cvt_pk_bf16(bf_lo(v.w) * s, bf_hi(v.w) * s);
        *(LAS v4u*)(img + img_off(row, ch)) = o; }
}
__device__ __forceinline__ void gate_scan(const float* G, size_t row0, int col_i, int col_f, int dir, int lane, float* bc, float* gg, float* pmx, float& b_end, float& gmax) {
    const int j0 = dir ? 127 - 2 * lane : 2 * lane, j1 = dir ? 126 - 2 * lane : 2 * lane + 1;
    const float f0 = G[(row0 + j0) * 32 + col_f], f1 = G[(row0 + j1) * 32 + col_f], i0 = G[(row0 + j0) * 32 + col_i], i1 = G[(row0 + j1) * 32 + col_i];
    const float lf0 = logsigf_(f0), lf1 = logsigf_(f1), s = lf0 + lf1; float incl = s;
#pragma unroll
    for (int o = 1; o < 64; o <<= 1) { const float t = __shfl_up(incl, o); if (lane >= o) incl += t; }
    const float b0 = (incl - s) + lf0, b1 = incl, g0 = i0 - b0, g1 = i1 - b1;
    float mincl = fmaxf(g0, g1);
#pragma unroll
    for (int o = 1; o < 64; o <<= 1) { const float t = __shfl_up(mincl, o); if (lane >= o) mincl = fmaxf(mincl, t); }
    float mexcl = __shfl_up(mincl, 1); if (lane == 0) mexcl = -3.0e38f;
    bc[j0] = b0; bc[j1] = b1; gg[j0] = g0; gg[j1] = g1; pmx[j0] = fmaxf(mexcl, g0); pmx[j1] = mincl;
    b_end = __shfl(incl, 63); gmax = __shfl(mincl, 63);
}
#define MFMA16(a, b, c) __builtin_amdgcn_mfma_f32_16x16x32_bf16((a), (b), (c), 0, 0, 0)

struct CvtItem { const float* src; size_t ldw; bf16* dst; };
constexpr int N_CONVERTERS = 128;
constexpr int N_CONV_DEFER = 1440;
constexpr int I_GEMV = 192, I_WIN = 16 * 8, I_GATE8 = 16 * 48, I_P = 16 * 8, I_W1 = 32 * 16 * 16, I_W2 = 32 * 16 * 8, I_TOTAL = I_GEMV + I_WIN + 3 * I_P + I_W1 + I_W2;
__device__ __forceinline__ CvtItem cvt_decode(int r, int tid, const float* w_in, const float* proj_a, const float* proj_b, const float* w_out, const float* exp_w1, const float* exp_w2,
                                              bf16* WINT, bf16* PAT, bf16* PBT, bf16* WOT, bf16* W1T, bf16* W2T) {
    const int n4 = tid & 63, kg = tid >> 6; const float* W; size_t ldw, ca, cb, drow; int kt; bf16* WT;
    if (r < I_WIN) { kt = r / 8; const int nt = 24 + r % 8; W = w_in; ldw = INC; ca = (size_t)256 * nt + 32; cb = ca + 128; WT = WINT; drow = (size_t)256 * nt; }
    else if ((r -= I_WIN) < 3 * I_P) { const int m = r / I_P, q = r % I_P; kt = q / 8; const int nt = q % 8; W = m == 0 ? proj_a : (m == 1 ? proj_b : w_out); ldw = 2048; ca = (size_t)256 * nt; cb = ca + 128; WT = m == 0 ? PAT : (m == 1 ? PBT : WOT); drow = (size_t)256 * nt; }
    else if ((r -= 3 * I_P) < I_W1) { const int e = r / 256, q = r % 256; kt = q / 16; const int nt = q % 16; W = exp_w1 + (size_t)e * 2048 * 4096; ldw = 4096; ca = (size_t)128 * nt; cb = 2048 + ca; WT = W1T; drow = (size_t)e * 4096 + 256 * nt; }
    else { r -= I_W1; const int e = r / 128, q = r % 128; kt = q / 8; const int nt = q % 8; W = exp_w2 + (size_t)e * 2048 * 2048; ldw = 2048; ca = (size_t)256 * nt; cb = ca + 128; WT = W2T; drow = (size_t)e * 2048 + 256 * nt; }
    CvtItem it; it.ldw = ldw; it.src = W + (size_t)(128 * kt + 8 * kg) * ldw + (n4 < 32 ? ca + 4 * n4 : cb + 4 * (n4 - 32)); it.dst = WT + drow * 2048 + 128 * kt; return it;
}
__device__ __forceinline__ void cvt_run(LAS unsigned char* lds, int tid, int it, int stride, int end, const float* w_in, const float* proj_a, const float* proj_b, const float* w_out, const float* exp_w1, const float* exp_w2,
                                        bf16* WINT, bf16* PAT, bf16* PBT, bf16* WOT, bf16* W1T, bf16* W2T) {
    const int n4 = tid & 63, kg = tid >> 6;
    f32x4 v[16]; CvtItem cur;
    bool have = it < end;
    if (have) { cur = cvt_decode(it - I_GEMV, tid, w_in, proj_a, proj_b, w_out, exp_w1, exp_w2, WINT, PAT, PBT, WOT, W1T, W2T);
#pragma unroll
        for (int i = 0; i < 16; ++i) v[i] = __builtin_nontemporal_load((const f32x4*)(cur.src + (size_t)((i >> 3) * 64 + (i & 7)) * cur.ldw)); }
    while (have) {
#pragma unroll
        for (int hf = 0; hf < 2; ++hf)
#pragma unroll
            for (int j = 0; j < 4; ++j) { v4u o; o.x = cvt_pk_bf16(v[8 * hf + 0][j], v[8 * hf + 1][j]); o.y = cvt_pk_bf16(v[8 * hf + 2][j], v[8 * hf + 3][j]); o.z = cvt_pk_bf16(v[8 * hf + 4][j], v[8 * hf + 5][j]); o.w = cvt_pk_bf16(v[8 * hf + 6][j], v[8 * hf + 7][j]);
                *(LAS v4u*)(lds + img_off(4 * n4 + j, 8 * hf + kg)) = o; }
        __syncthreads();
        bf16* dst = cur.dst;
        it += stride; have = it < end;
        if (have) { cur = cvt_decode(it - I_GEMV, tid, w_in, proj_a, proj_b, w_out, exp_w1, exp_w2, WINT, PAT, PBT, WOT, W1T, W2T);
#pragma unroll
            for (int i = 0; i < 16; ++i) v[i] = __builtin_nontemporal_load((const f32x4*)(cur.src + (size_t)((i >> 3) * 64 + (i & 7)) * cur.ldw)); }
#pragma unroll
        for (int i = 0; i < 8; ++i) { const int id = tid + NTHR * i, row = id >> 4, ch = id & 15; const v4u o = *(const LAS v4u*)(lds + img_off(row, ch)); __builtin_nontemporal_store(o, (v4u*)(dst + (size_t)row * 2048 + 8 * ch)); }
        __syncthreads();
    }
}
__device__ __forceinline__ void cvt_run8(LAS unsigned char* lds, int tid, int r, int stride, int end, const float* exp_w1, const float* exp_w2, const float* w_in, unsigned char* W1T8, unsigned char* W2T8, unsigned char* WG8) {
    const int n4 = tid & 63, kg = tid >> 6;
    f32x4 v[16]; const float* src = nullptr; size_t ldw = 0; unsigned char* dst = nullptr;
#define CVT8_DECODE(R) do { int q_ = (R); const float* W_; size_t ca_, cb_, drow_; int kt_; unsigned char* WT_; \
        if (q_ < I_W1) { const int e = q_ / 256, qq = q_ % 256; kt_ = qq / 16; const int nt = qq % 16; W_ = exp_w1 + (size_t)e * 2048 * 4096; ldw = 4096; ca_ = (size_t)128 * nt; cb_ = 2048 + ca_; WT_ = W1T8; drow_ = (size_t)e * 4096 + 256 * nt; } \
        else if (q_ < I_W1 + I_W2) { q_ -= I_W1; const int e = q_ / 128, qq = q_ % 128; kt_ = qq / 8; const int nt = qq % 8; W_ = exp_w2 + (size_t)e * 2048 * 2048; ldw = 2048; ca_ = (size_t)256 * nt; cb_ = ca_ + 128; WT_ = W2T8; drow_ = (size_t)e * 2048 + 256 * nt; } \
        else { q_ -= I_W1 + I_W2; kt_ = q_ / 48; const int ft = q_ % 48, zt = ft < 24 ? ft : ft + 8; W_ = w_in; ldw = INC; ca_ = (size_t)256 * zt + (zt >= 16 ? 32 : 0); cb_ = ca_ + 128; WT_ = WG8; drow_ = (size_t)256 * ft; } \
        src = W_ + (size_t)(128 * kt_ + 8 * kg) * ldw + (n4 < 32 ? ca_ + 4 * n4 : cb_ + 4 * (n4 - 32)); dst = WT_ + drow_ * 2048 + 128 * kt_; \
        _Pragma("unroll") for (int i = 0; i < 16; ++i) v[i] = __builtin_nontemporal_load((const f32x4*)(src + (size_t)((i >> 3) * 64 + (i & 7)) * ldw)); } while (0)
    bool have = r < end;
    if (have) CVT8_DECODE(r);
    while (have) {
#pragma unroll
        for (int hf = 0; hf < 2; ++hf)
#pragma unroll
            for (int j = 0; j < 4; ++j) { const int row = 4 * n4 + j, p8 = 8 * hf + kg; v2u o;
                o.x = pg8::pk4_fp8(v[8 * hf + 0][j] * pg8::F8_SW, v[8 * hf + 1][j] * pg8::F8_SW, v[8 * hf + 2][j] * pg8::F8_SW, v[8 * hf + 3][j] * pg8::F8_SW);
                o.y = pg8::pk4_fp8(v[8 * hf + 4][j] * pg8::F8_SW, v[8 * hf + 5][j] * pg8::F8_SW, v[8 * hf + 6][j] * pg8::F8_SW, v[8 * hf + 7][j] * pg8::F8_SW);
                *(LAS v2u*)(lds + row * 128 + 16 * ((p8 >> 1) ^ ((row >> 2) & 7)) + 8 * (p8 & 1)) = o; }
        __syncthreads();
        unsigned char* d0 = dst;
        r += stride; have = r < end;
        if (have) CVT8_DECODE(r);
#pragma unroll
        for (int i = 0; i < 4; ++i) { const int id = tid + NTHR * i, row = id >> 3, ch = id & 7; const v4u o = *(const LAS v4u*)(lds + row * 128 + 16 * (ch ^ ((row >> 2) & 7)));
            __builtin_nontemporal_store(o, (v4u*)(d0 + (size_t)row * 2048 + 16 * ch)); }
        __syncthreads();
    }
#undef CVT8_DECODE
}
__device__ __forceinline__ void p0_phase(LAS unsigned char* lds, int tid, int G, const float* c, const float* c_ctx, const float* mod_w, const float* mod_b, float* MOD,
                                         const float* w_in, const float* proj_a, const float* proj_b, const float* w_out, const float* exp_w1, const float* exp_w2, const float* router_w,
                                         bf16* WINT, bf16* PAT, bf16* PBT, bf16* WOT, bf16* W1T, bf16* W2T, bf16* SK, int n_conv_p0) {
    LAS float* sc = (LAS float*)lds;
    LAS float* red = (LAS float*)(lds + 40960);
    int it = blockIdx.x;
    if (it < I_GEMV) {
        for (int i = tid; i < 5 * 2048; i += NTHR) { const float x = i < 4 * 2048 ? c[i] : c_ctx[i - 4 * 2048]; sc[i] = siluf_(x); }
        __syncthreads();
        for (; it < I_GEMV; it += G) {
            const int j0 = 64 * it, c4 = tid & 15, kg = tid >> 4;
            f32x4 a0 = {0.f, 0.f, 0.f, 0.f}, a1 = a0, a2 = a0, a3 = a0, a4 = a0;
            const float* wp = mod_w + (size_t)kg * 12288 + j0 + 4 * c4;
#pragma unroll 8
            for (int k = kg; k < 2048; k += 32) { const f32x4 w = *(const f32x4*)wp; wp += (size_t)32 * 12288;
                a0 += w * sc[k]; a1 += w * sc[2048 + k]; a2 += w * sc[4096 + k]; a3 += w * sc[6144 + k]; a4 += w * sc[8192 + k]; }
            *(LAS f32x4*)(red + (kg * 5 + 0) * 64 + 4 * c4) = a0; *(LAS f32x4*)(red + (kg * 5 + 1) * 64 + 4 * c4) = a1; *(LAS f32x4*)(red + (kg * 5 + 2) * 64 + 4 * c4) = a2;
            *(LAS f32x4*)(red + (kg * 5 + 3) * 64 + 4 * c4) = a3; *(LAS f32x4*)(red + (kg * 5 + 4) * 64 + 4 * c4) = a4;
            __syncthreads();
            if (tid < 320) { const int rr = tid >> 6, j = tid & 63; float s = 0.f;
#pragma unroll 8
                for (int g = 0; g < 32; ++g) s += red[(g * 5 + rr) * 64 + j];
                MOD[rr * 12288 + j0 + j] = s + mod_b[j0 + j]; }
            __syncthreads();
        }
    } else {
        for (int i = (it - I_GEMV) * NTHR + tid; i < 2 * 32 * 2048; i += (G - I_GEMV) * NTHR) { const int m = i >> 16, n = (i >> 11) & 31, k = i & 2047;
            const float w = m == 0 ? w_in[(size_t)k * INC + 4096 + n] : router_w[k * 32 + n];
            const unsigned hi = cvt_pk_bf16(w, 0.f) & 0xffffu; const unsigned lo = cvt_pk_bf16(w - __uint_as_float(hi << 16), 0.f) & 0xffffu;
            SK[(size_t)(2 * m) * 65536 + n * 2048 + k] = (bf16)hi; SK[(size_t)(2 * m + 1) * 65536 + n * 2048 + k] = (bf16)lo; }
    }
    cvt_run(lds, tid, it, G, I_GEMV + n_conv_p0, w_in, proj_a, proj_b, w_out, exp_w1, exp_w2, WINT, PAT, PBT, WOT, W1T, W2T);
}

__device__ __forceinline__ void skinny_mfma(const LAS float* hrow, const bf16* WT_hi, const bf16* WT_lo, LAS float* part, int wave, int lane) {
    const int g = lane >> 4, l15 = lane & 15;
    f32x4 acc0 = {0.f, 0.f, 0.f, 0.f}, acc1 = acc0;
#pragma unroll
    for (int ks = 0; ks < 8; ++ks) { const int kb = 256 * wave + 32 * ks + 8 * g;
        f32x4 a0 = {0.f, 0.f, 0.f, 0.f}, a1 = a0;
        if (l15 < 8) { a0 = *(const LAS f32x4*)(hrow + l15 * 2048 + kb); a1 = *(const LAS f32x4*)(hrow + l15 * 2048 + kb + 4); }
        v4u hi, lo;
        hi.x = cvt_pk_bf16(a0[0], a0[1]); hi.y = cvt_pk_bf16(a0[2], a0[3]); hi.z = cvt_pk_bf16(a1[0], a1[1]); hi.w = cvt_pk_bf16(a1[2], a1[3]);
        lo.x = cvt_pk_bf16(a0[0] - bf_lo(hi.x), a0[1] - bf_hi(hi.x)); lo.y = cvt_pk_bf16(a0[2] - bf_lo(hi.y), a0[3] - bf_hi(hi.y));
        lo.z = cvt_pk_bf16(a1[0] - bf_lo(hi.z), a1[1] - bf_hi(hi.z)); lo.w = cvt_pk_bf16(a1[2] - bf_lo(hi.w), a1[3] - bf_hi(hi.w));
        const bf16x8 Ah = __builtin_bit_cast(bf16x8, hi), Al = __builtin_bit_cast(bf16x8, lo);
        const bf16x8 b0h = *(const bf16x8*)(WT_hi + (size_t)l15 * 2048 + kb), b0l = *(const bf16x8*)(WT_lo + (size_t)l15 * 2048 + kb);
        const bf16x8 b1h = *(const bf16x8*)(WT_hi + (size_t)(16 + l15) * 2048 + kb), b1l = *(const bf16x8*)(WT_lo + (size_t)(16 + l15) * 2048 + kb);
        acc0 = MFMA16(Ah, b0h, acc0); acc0 = MFMA16(Ah, b0l, acc0); acc0 = MFMA16(Al, b0h, acc0);
        acc1 = MFMA16(Ah, b1h, acc1); acc1 = MFMA16(Ah, b1l, acc1); acc1 = MFMA16(Al, b1h, acc1); }
    if (g < 2) {
#pragma unroll
        for (int r = 0; r < 4; ++r) { part[wave * 256 + (4 * g + r) * 32 + l15] = acc0[r]; part[wave * 256 + (4 * g + r) * 32 + 16 + l15] = acc1[r]; } }
}

__device__ __forceinline__ void p1_phase(LAS unsigned char* lds, int tid, int wave, int lane, int G, const float* x, const float* ctx, const float* MOD, const float* norm_g,
                                         const bf16* SK, const float* gate_b, bf16* HB, unsigned char* HB8, float* GATES) {
    LAS float* hrow = (LAS float*)(lds + wave * 8192); LAS float* part = (LAS float*)(lds + 65536);
    f32x4 v[8];
    { const int row = blockIdx.x * 8 + wave; const float* xr = row < NLAT ? x + (size_t)row * DM : ctx + (size_t)(row - NLAT) * DM;
#pragma unroll
      for (int j = 0; j < 8; ++j) v[j] = *(const f32x4*)(xr + 4 * (lane + 64 * j)); }
    for (int it = blockIdx.x; it < NTOK / 8; it += G) {
        const int row = it * 8 + wave;
        const float* shift = MOD + (size_t)(row < NLAT ? (row >> 11) : 4) * 12288; const float* scale = shift + 2048;
        float ss = 0.f;
#pragma unroll
        for (int j = 0; j < 8; ++j) ss += (v[j][0] * v[j][0] + v[j][1] * v[j][1]) + (v[j][2] * v[j][2] + v[j][3] * v[j][3]);
        const float rstd = 1.0f / sqrtf(wave_sum(ss) * (1.0f / DM) + EPS);
#pragma unroll
        for (int j = 0; j < 8; ++j) { const int col = 4 * (lane + 64 * j);
            const f32x4 g = *(const f32x4*)(norm_g + col), sc = *(const f32x4*)(scale + col), sh = *(const f32x4*)(shift + col);
            const f32x4 h = (v[j] * rstd) * g * (sc + 1.0f) + sh;
            v2u o; o.x = cvt_pk_bf16(h[0], h[1]); o.y = cvt_pk_bf16(h[2], h[3]); *(v2u*)(HB + (size_t)row * DM + col) = o;
            *(unsigned*)(HB8 + (size_t)row * DM + col) = pg8::pk4_fp8(h[0] * pg8::F8_SA, h[1] * pg8::F8_SA, h[2] * pg8::F8_SA, h[3] * pg8::F8_SA);
            *(LAS f32x4*)(hrow + col) = h; }
        if (it + G < NTOK / 8) { const int rown = (it + G) * 8 + wave; const float* xr = rown < NLAT ? x + (size_t)rown * DM : ctx + (size_t)(rown - NLAT) * DM;
#pragma unroll
            for (int j = 0; j < 8; ++j) v[j] = *(const f32x4*)(xr + 4 * (lane + 64 * j)); }
        __syncthreads();
        skinny_mfma((const LAS float*)lds, SK, SK + 65536, part, wave, lane);
        __syncthreads();
        if (tid < 256) { float s = 0.f;
#pragma unroll
            for (int w = 0; w < 8; ++w) s += part[w * 256 + tid];
            GATES[(size_t)(it * 8) * 32 + tid] = s + gate_b[tid & 31]; }
    }
}

__device__ __forceinline__ void p3_phase(int wave, int lane, int G, const bf16* Z, const float* conv_w, const float* conv_b, const float* sgu_norm_g, bf16* QC, bf16* KC, bf16* SVN,
                                         const float* GATES, float* SCN, float* BEND, float* GMAX) {
    const int gw = blockIdx.x * NWAVES + wave, NGW = G * NWAVES;
    for (int task = gw; task < 64 * NCH; task += NGW) { const int bhd = task / NCH, bi = task - bhd * NCH, dir = bhd & 1, bh = bhd >> 1, b = bh >> 3, h = bh & 7;
        const size_t row0 = bi < 2 ? (size_t)NLAT + b * TCX + bi * 128 : (size_t)b * TL + (bi - 2) * 128;
        float* sp = SCN + (size_t)task * 384; float b_end, gmax;
        gate_scan(GATES, row0, (2 * dir) * 8 + h, (2 * dir + 1) * 8 + h, dir, lane, sp, sp + 128, sp + 256, b_end, gmax);
        const int c = dir == 0 ? bi : (bi < 2 ? 1 - bi : 19 - bi);
        if (lane == 0 && c < 17) { BEND[bhd * 17 + c] = b_end; GMAX[bhd * 17 + c] = gmax; } }
    for (int item = gw; item < NTOK; item += NGW) {
        const int rb = item >> 2, seg = item & 3, row0 = rb * 4, c0 = seg * 512 + lane * 8;
        const int t0 = row0 < NLAT ? (row0 & (TL - 1)) : ((row0 - NLAT) & (TCX - 1)), len = row0 < NLAT ? TL : TCX;
        v4u zr[8];
#pragma unroll
        for (int k = 0; k < 8; ++k) { const int tt = t0 + k - 2; zr[k] = (v4u){0u, 0u, 0u, 0u};
            if (tt >= 0 && tt < len) zr[k] = *(const v4u*)(Z + (size_t)(row0 + k - 2) * ZW + c0); }
        f32x4 w0[5], w1[5];
#pragma unroll
        for (int tau = 0; tau < 5; ++tau) { w0[tau] = *(const f32x4*)(conv_w + tau * 2048 + c0); w1[tau] = *(const f32x4*)(conv_w + tau * 2048 + c0 + 4); }
        const f32x4 b0 = *(const f32x4*)(conv_b + c0), b1 = *(const f32x4*)(conv_b + c0 + 4);
        const float qs = c0 < 1024 ? 0.08838834764831845f : 1.0f;
#pragma unroll
        for (int o = 0; o < 4; ++o) { float acc[8] = {b0[0], b0[1], b0[2], b0[3], b1[0], b1[1], b1[2], b1[3]};
#pragma unroll
            for (int tau = 0; tau < 5; ++tau) { const v4u z = zr[o + tau];
                acc[0] += w0[tau][0] * bf_lo(z.x); acc[1] += w0[tau][1] * bf_hi(z.x); acc[2] += w0[tau][2] * bf_lo(z.y); acc[3] += w0[tau][3] * bf_hi(z.y);
                acc[4] += w1[tau][0] * bf_lo(z.z); acc[5] += w1[tau][1] * bf_hi(z.z); acc[6] += w1[tau][2] * bf_lo(z.w); acc[7] += w1[tau][3] * bf_hi(z.w); }
#pragma unroll
            for (int i = 0; i < 8; ++i) acc[i] = siluf_(acc[i]) * qs;
            v4u ov; ov.x = cvt_pk_bf16(acc[0], acc[1]); ov.y = cvt_pk_bf16(acc[2], acc[3]); ov.z = cvt_pk_bf16(acc[4], acc[5]); ov.w = cvt_pk_bf16(acc[6], acc[7]);
            bf16* dst = c0 < 1024 ? QC + (size_t)(row0 + o) * 1024 + c0 : KC + (size_t)(row0 + o) * 1024 + (c0 - 1024);
            *(v4u*)dst = ov; }
    }
    for (int row = gw; row < NLAT; row += NGW) {
        float v[32]; float ss = 0.f;
#pragma unroll
        for (int j = 0; j < 4; ++j) { const v4u z = *(const v4u*)(Z + (size_t)row * ZW + ZS + 8 * lane + 512 * j);
            v[8 * j + 0] = gelu_tanh(bf_lo(z.x)); v[8 * j + 1] = gelu_tanh(bf_hi(z.x)); v[8 * j + 2] = gelu_tanh(bf_lo(z.y)); v[8 * j + 3] = gelu_tanh(bf_hi(z.y));
            v[8 * j + 4] = gelu_tanh(bf_lo(z.z)); v[8 * j + 5] = gelu_tanh(bf_hi(z.z)); v[8 * j + 6] = gelu_tanh(bf_lo(z.w)); v[8 * j + 7] = gelu_tanh(bf_hi(z.w)); }
#pragma unroll
        for (int i = 0; i < 32; ++i) ss += v[i] * v[i];
        const float rstd = 1.0f / sqrtf(wave_sum(ss) * (1.0f / DM) + EPS);
#pragma unroll
        for (int j = 0; j < 4; ++j) { const int col = 8 * lane + 512 * j; const f32x4 g0 = *(const f32x4*)(sgu_norm_g + col), g1 = *(const f32x4*)(sgu_norm_g + col + 4);
            v4u o; o.x = cvt_pk_bf16(v[8 * j] * rstd * g0[0], v[8 * j + 1] * rstd * g0[1]); o.y = cvt_pk_bf16(v[8 * j + 2] * rstd * g0[2], v[8 * j + 3] * rstd * g0[3]);
            o.z = cvt_pk_bf16(v[8 * j + 4] * rstd * g1[0], v[8 * j + 5] * rstd * g1[1]); o.w = cvt_pk_bf16(v[8 * j + 6] * rstd * g1[2], v[8 * j + 7] * rstd * g1[3]);
            *(v4u*)(SVN + (size_t)row * DM + col) = o; }
    }
}

constexpr int L_V0 = 0, L_V1 = 32768, L_K = 65536, L_SC = 98304, L_CB = 106496;
constexpr int N_M1 = 64 * 17, N_SGU = 512;
__device__ __forceinline__ void p4_phase(LAS unsigned char* lds, int tid_, int wave, int lane_, int G, const bf16* Z, const bf16* KC, const bf16* SVN, const float* SCN,
                                         const float* sgu_w, const float* sgu_b, bf16* DC, const float* GMAX, bf16* CM) {
    v4u pk[4], pv[8]; f32x4 pa[2];
#define P4_ISSUE(U) do { const int u_ = (U); int t_ = tid_; asm volatile("" : "+v"(t_)); \
        if (u_ < N_M1) { const int bhd_ = u_ / 17, c_ = u_ - bhd_ * 17, dir_ = bhd_ & 1, bh_ = bhd_ >> 1, b_ = bh_ >> 3, h_ = bh_ & 7; \
            const bool ic_ = c_ < 2; const int blk_ = dir_ == 0 ? (ic_ ? c_ : c_ - 2) : (ic_ ? 1 - c_ : 17 - c_); \
            const size_t r0_ = ic_ ? (size_t)NLAT + b_ * TCX + blk_ * 128 : (size_t)b_ * TL + blk_ * 128; \
            const float* sp_ = SCN + (size_t)(bhd_ * NCH + (ic_ ? blk_ : blk_ + 2)) * 384; \
            _Pragma("unroll") for (int i = 0; i < 4; ++i) { const int id = t_ + NTHR * i; pk[i] = *(const v4u*)(KC + (r0_ + (id >> 4)) * 1024 + h_ * QKD + 8 * (id & 15)); pa[0][i] = sp_[128 + (id >> 4)]; } \
            pa[1][0] = GMAX[bhd_ * 17 + c_]; \
            _Pragma("unroll") for (int i = 0; i < 8; ++i) { const int id = t_ + NTHR * (i & 3); pv[i] = *(const v4u*)(Z + (r0_ + (id >> 4)) * ZW + ZV + h_ * VD + 128 * (i >> 2) + 8 * (id & 15)); } \
        } else { const int u2_ = u_ - N_M1, b_ = u2_ >> 7, n_ = (u2_ >> 3) & 15, grp_ = u2_ & 7; const size_t r0_ = (size_t)b_ * TL + n_ * 128; \
            _Pragma("unroll") for (int i = 0; i < 8; ++i) { const int id = t_ + NTHR * (i & 3); pv[i] = *(const v4u*)(SVN + (r0_ + (id >> 4)) * DM + grp_ * 256 + 128 * (i >> 2) + 8 * (id & 15)); } \
            } } while (0)
    int u = blockIdx.x;
    if (u < N_M1 + N_SGU) P4_ISSUE(u);
    for (; u < N_M1 + N_SGU; u += G) {
        int tid = tid_; asm volatile("" : "+v"(tid)); const int lane = tid & 63; const unsigned g = lane >> 4, l15 = lane & 15;
        const bool m1 = u < N_M1;
        TR_NAT_OFFS(xn0, xn1, lane)
#pragma unroll
        for (int i = 0; i < 8; ++i) { const int id = tid + NTHR * (i & 3); *(LAS v4u*)(lds + ((i >> 2) ? L_V1 : L_V0) + img_off(id >> 4, id & 15)) = pv[i]; }
        bf16x8 Af[4]; v2u uw[16];
        if (m1) { const float gmax = pa[1][0];
#pragma unroll
            for (int i = 0; i < 4; ++i) { const int id = tid + NTHR * i, row = id >> 4, ch = id & 15; const float sw = __expf(pa[0][i] - gmax); const v4u v = pk[i]; v4u o;
                o.x = cvt_pk_bf16(bf_lo(v.x) * sw, bf_hi(v.x) * sw); o.y = cvt_pk_bf16(bf_lo(v.y) * sw, bf_hi(v.y) * sw); o.z = cvt_pk_bf16(bf_lo(v.z) * sw, bf_hi(v.z) * sw); o.w = cvt_pk_bf16(bf_lo(v.w) * sw, bf_hi(v.w) * sw);
                *(LAS v4u*)(lds + L_K + img_off(row, ch)) = o; }
        }
        __syncthreads();
        f32x4 af32[8];
        if (!m1) { const int u2 = u - N_M1, b = u2 >> 7, n = (u2 >> 3) & 15, grp = u2 & 7;
            const float* src = sgu_w + (size_t)grp * 16384 + (size_t)(16 * wave + l15) * 128 + 8 * g;
#pragma unroll
            for (int ks = 0; ks < 4; ++ks) { af32[2 * ks] = *(const f32x4*)(src + 32 * ks); af32[2 * ks + 1] = *(const f32x4*)(src + 32 * ks + 4); }
            const bf16* up = Z + ((size_t)b * TL + n * 128 + 16 * wave + l15) * ZW + ZU + grp * 256 + 4 * g;
#pragma unroll
            for (int et = 0; et < 16; ++et) uw[et] = *(const v2u*)(up + 16 * et); }
        if (u + G < N_M1 + N_SGU) P4_ISSUE(u + G);
        if (!m1) {
#pragma unroll
            for (int ks = 0; ks < 4; ++ks) { const f32x4 a = af32[2 * ks], b2 = af32[2 * ks + 1];
                const v4u p = {cvt_pk_bf16(a[0], a[1]), cvt_pk_bf16(a[2], a[3]), cvt_pk_bf16(b2[0], b2[1]), cvt_pk_bf16(b2[2], b2[3])}; Af[ks] = __builtin_bit_cast(bf16x8, p); } }
        if (m1) {
            const int bhd = u / 17, c = u - bhd * 17;
#pragma unroll
            for (int ks = 0; ks < 4; ++ks) Af[ks] = tr_frag(lds + L_K, 32 * ks + 8 * g, 32 * ks + 8 * g + 4, wave, lane);
            f32x4 acc[17];
#pragma unroll
            for (int et = 0; et < 17; ++et) acc[et] = (f32x4){0.f, 0.f, 0.f, 0.f};
#pragma unroll
            for (int et = 0; et < 16; ++et) { LAS unsigned char* img = lds + ((et >> 3) ? L_V1 : L_V0);
#pragma unroll
                for (int ks = 0; ks < 4; ++ks) { const bf16x8 Bf = tr_frag2(img + 8192 * ks, xn0[et & 7], xn1[et & 7]); acc[et] = MFMA16(Af[ks], Bf, acc[et]); } }
            { const short one = l15 == 0 ? (short)0x3F80 : (short)0; const bf16x8 Bo = {one, one, one, one, one, one, one, one};
#pragma unroll
                for (int ks = 0; ks < 4; ++ks) acc[16] = MFMA16(Af[ks], Bo, acc[16]); }
            bf16* dst = DC + ((size_t)bhd * 17 + c) * (CROWS * 128) + 16 * wave + 4 * g;
#pragma unroll
            for (int et = 0; et < 16; ++et) { v2u o; o.x = cvt_pk_bf16(acc[et][0], acc[et][1]); o.y = cvt_pk_bf16(acc[et][2], acc[et][3]); *(v2u*)(dst + (size_t)(16 * et + l15) * 128) = o; }
            if (l15 == 0) { v2u o; o.x = cvt_pk_bf16(acc[16][0], acc[16][1]); o.y = cvt_pk_bf16(acc[16][2], acc[16][3]); *(v2u*)(dst + (size_t)256 * 128) = o; }
        } else {
            const int u2 = u - N_M1, b = u2 >> 7, n = (u2 >> 3) & 15, grp = u2 & 7; const size_t row0 = (size_t)b * TL + n * 128;
            f32x4 acc[16];
#pragma unroll
            for (int et = 0; et < 16; ++et) { acc[et] = (f32x4){0.f, 0.f, 0.f, 0.f}; LAS unsigned char* img = lds + ((et >> 3) ? L_V1 : L_V0);
#pragma unroll
                for (int ks = 0; ks < 4; ++ks) { const bf16x8 Bf = tr_frag2(img + 8192 * ks, xn0[et & 7], xn1[et & 7]); acc[et] = MFMA16(Bf, Af[ks], acc[et]); } }
            { const int t = 16 * wave + l15; const float zb = sgu_b[grp * 128 + t]; const size_t row = row0 + t;
#pragma unroll
              for (int et = 0; et < 16; ++et) { const int col = grp * 256 + 16 * et + 4 * g; const v2u w2 = uw[et];
                  const float o0 = gelu_tanh(bf_lo(w2.x)) * (acc[et][0] + zb), o1 = gelu_tanh(bf_hi(w2.x)) * (acc[et][1] + zb), o2 = gelu_tanh(bf_lo(w2.y)) * (acc[et][2] + zb), o3 = gelu_tanh(bf_hi(w2.y)) * (acc[et][3] + zb);
                  v2u o; o.x = cvt_pk_bf16(o0, o1); o.y = cvt_pk_bf16(o2, o3); *(v2u*)(CM + row * DM + col) = o; } }
        }
        __syncthreads();
    }
#undef P4_ISSUE
}

__device__ __forceinline__ void p5_scan(int tid, int G, const bf16* DC, const float* BEND, const float* GMAX, bf16* CS, float* MST) {
    constexpr int QPB = 257 * 128 / 4;
    for (int idx = blockIdx.x * NTHR + tid; idx < 64 * QPB; idx += G * NTHR) {
        const int bhd = idx / QPB, q = idx - bhd * QPB;
        f32x4 C = {0.f, 0.f, 0.f, 0.f}; float m = 0.f;
#pragma unroll
        for (int c = 0; c < 17; ++c) {
            const float gm = GMAX[bhd * 17 + c], be = BEND[bhd * 17 + c], mx = fmaxf(m, gm), al = __expf(m - mx), bt = __expf(gm - mx);
            const v2u dw = *(const v2u*)(DC + ((size_t)bhd * 17 + c) * (CROWS * 128) + 4 * q); const f32x4 d = {bf_lo(dw.x), bf_hi(dw.x), bf_lo(dw.y), bf_hi(dw.y)};
            C = C * al + d * bt; m = be + mx;
            if (c >= 1) { v2u o; o.x = cvt_pk_bf16(C[0], C[1]); o.y = cvt_pk_bf16(C[2], C[3]);
                *(v2u*)(CS + ((size_t)bhd * 16 + (c - 1)) * (CROWS * 128) + 4 * q) = o; if (q == 0) MST[bhd * 18 + c + 1] = m; }
        }
    }
}

__device__ __forceinline__ void p6_phase(LAS unsigned char* lds, int tid, int wave, int lane_, int G, const bf16* Z, const bf16* QC, const bf16* KC, const float* SCN,
                                         const bf16* CS, const float* MST, const float* mnorm_g, bf16* RO) {
    for (int u = blockIdx.x; u < 512; u += G) {
        int lane = lane_; asm volatile("" : "+v"(lane)); const unsigned g = lane >> 4, l15 = lane & 15;
        const int bh = u >> 4, jb = u & 15, b = bh >> 3, h = bh & 7; const size_t row0 = (size_t)b * TL + jb * 128;
        load_tile128(lds + L_K, KC + row0 * 1024 + h * QKD, 1024, tid);
        load_tile128(lds + L_V0, Z + row0 * ZW + ZV + h * VD, ZW, tid);
        load_tile128(lds + L_V1, Z + row0 * ZW + ZV + h * VD + 128, ZW, tid);
        bf16x8 Qf[4];
#pragma unroll
        for (int ks = 0; ks < 4; ++ks) Qf[ks] = *(const bf16x8*)(QC + (row0 + 16 * wave + l15) * 1024 + h * QKD + 32 * ks + 8 * g);
        __syncthreads();
        f32x4 hsum[16];
#pragma unroll
        for (int et = 0; et < 16; ++et) hsum[et] = (f32x4){0.f, 0.f, 0.f, 0.f};
#pragma unroll 1
        for (int dir = 0; dir < 2; ++dir) {
            int lane = lane_; asm volatile("" : "+v"(lane));
            const unsigned g = lane >> 4, l15 = lane & 15;
            TR_PERM_OFFS(xp, lane)
            const int c = dir ? 17 - jb : 2 + jb; const bf16* cs = CS + ((size_t)(bh * 2 + dir) * 16 + (c - 2)) * (CROWS * 128);
            const float* sp = SCN + (size_t)((bh * 2 + dir) * NCH + 2 + jb) * 384; const float* gg = sp + 128; const float mc = MST[(bh * 2 + dir) * 18 + c];
            const int tS = 16 * wave + l15; const float MtS = fmaxf(mc, sp[256 + tS]);
            unsigned pw[16];
#pragma unroll
            for (int st = 0; st < 8; ++st) { f32x4 aS = {0.f, 0.f, 0.f, 0.f};
#pragma unroll
                for (int ks = 0; ks < 4; ++ks) { const bf16x8 Kf = *(const LAS bf16x8*)(lds + L_K + img_off(16 * st + l15, 4 * ks + g)); aS = MFMA16(Kf, Qf[ks], aS); }
                float pv[4]; const f32x4 gs = *(const f32x4*)(gg + 16 * st + 4 * g);
#pragma unroll
                for (int r = 0; r < 4; ++r) { const int s = 16 * st + 4 * g + r; const bool ok = dir ? (s >= tS) : (s <= tS); const float ev = __expf(fminf(gs[r] - MtS, 0.f)); pv[r] = ok ? aS[r] * ev : 0.f; }
                pw[2 * st] = cvt_pk_bf16(pv[0], pv[1]); pw[2 * st + 1] = cvt_pk_bf16(pv[2], pv[3]); asm volatile("" ::: "memory"); }
            bf16x8 Pf[4];
#pragma unroll
            for (int ks = 0; ks < 4; ++ks) { const v4u t4 = {pw[4 * ks], pw[4 * ks + 1], pw[4 * ks + 2], pw[4 * ks + 3]}; Pf[ks] = __builtin_bit_cast(bf16x8, t4); }
            const float wiT = __expf(mc - MtS), flT = __expf(-(sp[tS] + MtS));
            const short one = l15 == 0 ? (short)0x3F80 : (short)0; const bf16x8 Bo = {one, one, one, one, one, one, one, one};
            float inv;
            { f32x4 ad = {0.f, 0.f, 0.f, 0.f};
#pragma unroll
              for (int ks = 0; ks < 4; ++ks) { bf16x8 Cf = *(const bf16x8*)(cs + (size_t)256 * 128 + 32 * ks + 8 * g); if (l15 != 0) Cf = (bf16x8){0, 0, 0, 0, 0, 0, 0, 0}; ad = MFMA16(Cf, Qf[ks], ad); }
              ad[0] *= wiT;
#pragma unroll
              for (int ks = 0; ks < 4; ++ks) ad = MFMA16(Bo, Pf[ks], ad);
              const float den = __shfl(ad[0], lane & 15); inv = 1.0f / fmaxf(fabsf(den), flT); }
            { v4u cr[2];
#pragma unroll
              for (int i = 0; i < 2; ++i) { const int id = tid + NTHR * i; cr[i] = *(const v4u*)(cs + (size_t)(id >> 4) * 128 + 8 * (id & 15)); }
#pragma unroll
              for (int i = 0; i < 2; ++i) { const int id = tid + NTHR * i; *(LAS v4u*)(lds + L_CB + img_off(id >> 4, id & 15)) = cr[i]; }
#pragma unroll
              for (int gq = 0; gq < 4; ++gq) {
                LAS unsigned char* cb = lds + L_CB + (gq & 1) * 16384;
                __syncthreads();
                if (gq < 3) {
#pragma unroll
                    for (int i = 0; i < 2; ++i) { const int id = tid + NTHR * i; cr[i] = *(const v4u*)(cs + (size_t)(64 * (gq + 1) + (id >> 4)) * 128 + 8 * (id & 15)); } }
                f32x4 acc[4];
#pragma unroll
                for (int i = 0; i < 4; ++i) { acc[i] = (f32x4){0.f, 0.f, 0.f, 0.f};
#pragma unroll
                    for (int ks = 0; ks < 4; ++ks) { const bf16x8 Cf = *(const LAS bf16x8*)(cb + img_off(16 * i + l15, 4 * ks + g)); acc[i] = MFMA16(Cf, Qf[ks], acc[i]); } }
#pragma unroll
                for (int i = 0; i < 4; ++i) acc[i] = acc[i] * wiT;
                { LAS unsigned char* img = lds + ((gq >> 1) ? L_V1 : L_V0);
#pragma unroll
                  for (int i = 0; i < 4; ++i) {
#pragma unroll
                    for (int ks = 0; ks < 4; ++ks) { const bf16x8 Vf = tr_frag2(img + 8192 * ks, xp[4 * (gq & 1) + i], xp[4 * (gq & 1) + i] + 4096u); acc[i] = MFMA16(Vf, Pf[ks], acc[i]); } } }
#pragma unroll
                for (int i = 0; i < 4; ++i) hsum[4 * gq + i] += acc[i] * inv;
                if (gq < 3) {
#pragma unroll
                    for (int i = 0; i < 2; ++i) { const int id = tid + NTHR * i; *(LAS v4u*)(lds + L_CB + ((gq + 1) & 1) * 16384 + img_off(id >> 4, id & 15)) = cr[i]; } }
              } }
        }
        { float ss = 0.f;
#pragma unroll
          for (int et = 0; et < 16; ++et) ss += (hsum[et][0] * hsum[et][0] + hsum[et][1] * hsum[et][1]) + (hsum[et][2] * hsum[et][2] + hsum[et][3] * hsum[et][3]);
          ss += __shfl_xor(ss, 16); ss += __shfl_xor(ss, 32);
          const float rstd = 1.0f / sqrtf(ss * (1.0f / VD) + EPS); const size_t row = row0 + 16 * wave + l15;
#pragma unroll
          for (int et = 0; et < 16; ++et) { const int col = h * VD + 16 * et + 4 * g;
              const v2u ow = *(const v2u*)(Z + row * ZW + ZO + col); const f32x4 gn = *(const f32x4*)(mnorm_g + col);
              const float v0 = hsum[et][0] * rstd * gn[0] * sigmoidf_(bf_lo(ow.x)), v1 = hsum[et][1] * rstd * gn[1] * sigmoidf_(bf_hi(ow.x));
              const float v2 = hsum[et][2] * rstd * gn[2] * sigmoidf_(bf_lo(ow.y)), v3 = hsum[et][3] * rstd * gn[3] * sigmoidf_(bf_hi(ow.y));
              v2u o; o.x = cvt_pk_bf16(v0, v1); o.y = cvt_pk_bf16(v2, v3); *(v2u*)(RO + row * DM + col) = o; } }
        __syncthreads();
    }
}

__device__ __forceinline__ void p9_phase(LAS unsigned char* lds, int wave, int lane, int G, const float* X1, const float* MOD, const float* norm_g, const bf16* SK, const float* router_b,
                                         unsigned* cnt, unsigned char* XG, int* RE, int* RR, float* RG) {
    LAS float* hrow = (LAS float*)(lds + wave * 8192); LAS float* part = (LAS float*)(lds + 65536);
    f32x4 vn[8];
    { const float* xr = X1 + (size_t)(blockIdx.x * 8 + wave) * DM;
#pragma unroll
      for (int j = 0; j < 8; ++j) vn[j] = *(const f32x4*)(xr + 4 * (lane + 64 * j)); }
    for (int it = blockIdx.x; it < NLAT / 8; it += G) {
        const int row = it * 8 + wave;
        const float* shift = MOD + (size_t)(row >> 11) * 12288 + 3 * 2048; const float* scale = shift + 2048;
        f32x4 v[8]; float ss = 0.f;
#pragma unroll
        for (int j = 0; j < 8; ++j) { v[j] = vn[j]; ss += (v[j][0] * v[j][0] + v[j][1] * v[j][1]) + (v[j][2] * v[j][2] + v[j][3] * v[j][3]); }
        const float rstd = 1.0f / sqrtf(wave_sum(ss) * (1.0f / DM) + EPS);
#pragma unroll
        for (int j = 0; j < 8; ++j) { const int col = 4 * (lane + 64 * j);
            const f32x4 g = *(const f32x4*)(norm_g + col), sc = *(const f32x4*)(scale + col), sh = *(const f32x4*)(shift + col);
            v[j] = (v[j] * rstd) * g * (sc + 1.0f) + sh; *(LAS f32x4*)(hrow + col) = v[j]; }
        if (it + G < NLAT / 8) { const float* xr = X1 + (size_t)((it + G) * 8 + wave) * DM;
#pragma unroll
            for (int j = 0; j < 8; ++j) vn[j] = *(const f32x4*)(xr + 4 * (lane + 64 * j)); }
        __syncthreads();
        skinny_mfma((const LAS float*)lds, SK + 2 * 65536, SK + 3 * 65536, part, wave, lane);
        __syncthreads();
        float val = router_b[lane & 31];
#pragma unroll
        for (int w = 0; w < 8; ++w) val += part[w * 256 + wave * 32 + (lane & 31)];
        float sv[4]; int si[4];
#pragma unroll
        for (int k = 0; k < 4; ++k) { float bv = val; int bi = lane & 31;
#pragma unroll
            for (int o = 16; o >= 1; o >>= 1) { const float ov = __shfl_xor(bv, o); const int oi = __shfl_xor(bi, o); const bool take = (ov > bv) || (ov == bv && oi < bi); bv = take ? ov : bv; bi = take ? oi : bi; }
            sv[k] = bv; si[k] = __builtin_amdgcn_readfirstlane(bi); if ((lane & 31) == bi) val = -3.0e38f; }
        const float e1 = __expf(sv[1] - sv[0]), e2 = __expf(sv[2] - sv[0]), e3 = __expf(sv[3] - sv[0]), inv = 1.0f / (1.0f + e1 + e2 + e3);
        const float gk[4] = {inv, e1 * inv, e2 * inv, e3 * inv};
        unsigned rank = 0;
        if (lane < 4) rank = __hip_atomic_fetch_add(cnt + (lane == 0 ? si[0] : lane == 1 ? si[1] : lane == 2 ? si[2] : si[3]), 1u, RLX_AGENT);
#pragma unroll
        for (int k = 0; k < 4; ++k) { const unsigned rk = (unsigned)__builtin_amdgcn_readlane((int)rank, k);
            unsigned char* dst = XG + ((size_t)si[k] * 8192 + rk) * DM;
#pragma unroll
            for (int j = 0; j < 8; ++j) *(unsigned*)(dst + 4 * (lane + 64 * j)) = pg8::pk4_fp8(v[j][0] * pg8::F8_SA, v[j][1] * pg8::F8_SA, v[j][2] * pg8::F8_SA, v[j][3] * pg8::F8_SA);
            if (lane == 0) { RE[row * 4 + k] = si[k]; RR[row * 4 + k] = (int)rk; RG[row * 4 + k] = gk[k]; } }
    }
}
__device__ __forceinline__ void moe_prefix(LAS int* pref, const unsigned* cnt, int tid) {
    if (tid == 0) { int s = 0; for (int e = 0; e < 32; ++e) { const unsigned ce = __hip_atomic_load(cnt + e, RLX_AGENT); pref[e] = s; pref[33 + e] = (int)ce; s += (int)((ce + 255u) >> 8); } pref[32] = s; }
    __syncthreads();
}
__device__ __forceinline__ void p12_phase(const LAS int* pref, int wave, int lane_, int G, const float* X1, const float* MOD, const bf16* Y2, const int* RE, const int* RR, const float* RG, const float* final_g, float* out) {
    const int gw = blockIdx.x * NWAVES + wave, NGW = G * NWAVES;
    int en[4], rn[4]; float gn[4];
    if (gw < NLAT) {
#pragma unroll
        for (int k = 0; k < 4; ++k) { en[k] = RE[gw * 4 + k]; rn[k] = RR[gw * 4 + k]; gn[k] = RG[gw * 4 + k]; } }
    for (int row = gw; row < NLAT; row += NGW) {
        int lane = lane_; asm volatile("" : "+v"(lane));
        const float* xr = X1 + (size_t)row * DM + 4 * lane; f32x4 xv[8]; v2u yv[4][8]; float gt[4];
#pragma unroll
        for (int k = 0; k < 4; ++k) { gt[k] = gn[k]; const bf16* src = Y2 + ((size_t)pref[en[k]] * 256 + rn[k]) * DM + 4 * lane;
#pragma unroll
            for (int j = 0; j < 8; ++j) yv[k][j] = __builtin_nontemporal_load((const v2u*)(src + 256 * j)); }
#pragma unroll
        for (int j = 0; j < 8; ++j) xv[j] = __builtin_nontemporal_load((const f32x4*)(xr + 256 * j));
        if (row + NGW < NLAT) { const int r2 = row + NGW;
#pragma unroll
            for (int k = 0; k < 4; ++k) { en[k] = RE[r2 * 4 + k]; rn[k] = RR[r2 * 4 + k]; gn[k] = RG[r2 * 4 + k]; } }
        const float* g5 = MOD + (size_t)(row >> 11) * 12288 + 5 * 2048; float ss = 0.f;
#pragma unroll
        for (int j = 0; j < 8; ++j) { f32x4 ys = {0.f, 0.f, 0.f, 0.f};
#pragma unroll
            for (int k = 0; k < 4; ++k) { const v2u y = yv[k][j]; ys[0] += gt[k] * bf_lo(y.x); ys[1] += gt[k] * bf_hi(y.x); ys[2] += gt[k] * bf_lo(y.y); ys[3] += gt[k] * bf_hi(y.y); }
            const int col = 4 * (lane + 64 * j); const f32x4 x2 = xv[j] + *(const f32x4*)(g5 + col) * ys; xv[j] = x2;
            ss += (x2[0] * x2[0] + x2[1] * x2[1]) + (x2[2] * x2[2] + x2[3] * x2[3]); }
        const float rstd = 1.0f / sqrtf(wave_sum(ss) * (1.0f / DM) + EPS);
#pragma unroll
        for (int j = 0; j < 8; ++j) { const int col = 4 * (lane + 64 * j); __builtin_nontemporal_store(xv[j] * rstd * *(const f32x4*)(final_g + col), (f32x4*)(out + (size_t)row * DM + col)); }
    }
}

#define XB_TMO      128
#define XB_XCNT(j)  (256  + 64 * (j))
#define XB_XSUB(j)  (1280 + 64 * (j))
#define XB_XGEN(j)  (2304 + 64 * (j))
#define XB_TOP      3328
#define XB_TOPGEN   3392
#define XCD_BAR_WORDS 3456
#define XB_SPIN_CAP (1u << 18)

__device__ __forceinline__ unsigned xb_ld(unsigned* p)              { return __hip_atomic_load(p, __ATOMIC_RELAXED, __HIP_MEMORY_SCOPE_AGENT); }
__device__ __forceinline__ unsigned xb_add(unsigned* p, unsigned v) { return __hip_atomic_fetch_add(p, v, __ATOMIC_RELAXED, __HIP_MEMORY_SCOPE_AGENT); }
__device__ __forceinline__ unsigned xb_xcc_id() { return (unsigned)__builtin_amdgcn_s_getreg((3 << 11) | 20) & 0xFu; }
#define XB_SPIN(cond, bar) do { unsigned _sp = 0; while (cond) { __builtin_amdgcn_s_sleep(1); \
    if ((++_sp & 255u) == 0u) { if (xb_ld(&(bar)[XB_TMO])) break; if (_sp > XB_SPIN_CAP) { atomicAdd(&(bar)[XB_TMO], 1u); break; } } } } while (0)

struct XcdBarrier {
    unsigned* bar; unsigned x;
    volatile LAS unsigned* st;
};

__device__ __forceinline__ XcdBarrier xcd_barrier_post(unsigned* bar, volatile LAS unsigned* st) {
    XcdBarrier b; b.bar = bar; b.x = xb_xcc_id(); b.st = st;
    if (threadIdx.x == 0) (void)xb_add(&bar[XB_XCNT(b.x)], 1u);
    return b;
}
__device__ __forceinline__ void xcd_barrier_complete(unsigned* bar, unsigned x, unsigned& nloc, unsigned& nx) {
    const unsigned G = gridDim.x * gridDim.y * gridDim.z;
    unsigned sum, cnt, mine, sp = 0u;
    for (;;) {
        sum = 0u; cnt = 0u; mine = 0u;
#pragma unroll
        for (unsigned j = 0; j < 16; ++j) { const unsigned c = xb_ld(&bar[XB_XCNT(j)]); sum += c; cnt += (c > 0u) ? 1u : 0u; mine = (j == x) ? c : mine; }
        if (sum == G) break;
        __builtin_amdgcn_s_sleep(1);
        if ((++sp & 255u) == 0u) { if (xb_ld(&bar[XB_TMO])) break; if (sp > XB_SPIN_CAP) { atomicAdd(&bar[XB_TMO], 1u); break; } }
    }
    nloc = mine > 0u ? mine : 1u; nx = cnt > 0u ? cnt : 1u;
}

__device__ __forceinline__ void xcd_barrier(const XcdBarrier& b) {
    asm volatile("s_waitcnt vmcnt(0)" ::: "memory");
    __syncthreads();
    if (threadIdx.x == 0) {
        unsigned* bar = b.bar;
        __builtin_amdgcn_s_waitcnt(0);
        unsigned nloc = b.st[0], nx = b.st[1];
        if (nloc == 0u) { xcd_barrier_complete(bar, b.x, nloc, nx); b.st[0] = nloc; b.st[1] = nx; }
        const unsigned old = xb_add(&bar[XB_XSUB(b.x)], 1u);
        const unsigned gen = old / nloc;
        if (old + 1u == (gen + 1u) * nloc) {
            __builtin_amdgcn_fence(__ATOMIC_RELEASE, "agent");
            asm volatile("s_waitcnt vmcnt(0)" ::: "memory");
            const unsigned og = xb_add(&bar[XB_TOP], 1u);
            const unsigned tg = og / nx;
            if (og + 1u == (tg + 1u) * nx) xb_add(&bar[XB_TOPGEN], 1u);
            else XB_SPIN(xb_ld(&bar[XB_TOPGEN]) == tg, bar);
            __builtin_amdgcn_fence(__ATOMIC_ACQUIRE, "agent");
            xb_add(&bar[XB_XGEN(b.x)], 1u);
            asm volatile("s_waitcnt vmcnt(0)" ::: "memory");
        } else {
            XB_SPIN(xb_ld(&bar[XB_XGEN(b.x)]) == gen, bar);
            __builtin_amdgcn_fence(__ATOMIC_ACQUIRE, "agent");
            asm volatile("s_waitcnt vmcnt(0)" ::: "memory");
        }
    }
    __syncthreads();
}

struct Args { const float* in[26]; float* out; unsigned char* ws; int ph_lo, ph_hi; };
__global__ void __launch_bounds__(NTHR, 2) mk_fwd(Args args) {
    extern __shared__ __attribute__((aligned(16))) unsigned char lds_raw[];
    LAS unsigned char* lds = (LAS unsigned char*)lds_raw;
    const int tid = threadIdx.x, lane = tid & 63, wave = __builtin_amdgcn_readfirstlane(tid >> 6), G = gridDim.x;
    unsigned char* ws = args.ws;
    gu32* ctl = (gu32*)(ws + WS_CTL);
    for (int u = tid; u < (LDS_BYTES - LDSCTL_OFF) / 4; u += NTHR) ((LAS unsigned*)(lds + LDSCTL_OFF))[u] = 0u;
    __syncthreads();
    volatile LAS unsigned* MISC = (volatile LAS unsigned*)(lds + MISC_OFF);
    XcdBarrier bar; bar.bar = (unsigned*)(ctl + CW_BAR); bar.x = 0; bar.st = nullptr;
    if (N_LAUNCHES == 1) bar = xcd_barrier_post((unsigned*)(ctl + CW_BAR), MISC + 8);
#define GRID_BAR() do { if (N_LAUNCHES == 1) xcd_barrier(bar); } while (0)
    const int lo = args.ph_lo, hi = args.ph_hi;
#ifdef ONLY_PHASE
#define IN(k) ((k) == ONLY_PHASE && lo <= (k) && (k) < hi)
#else
#define IN(k) (lo <= (k) && (k) < hi)
#endif
#define BOTH(k) (IN(k) && IN((k) + 1))
#ifndef REP_MASK
#define REP_MASK 0
#endif
#define NREP(k) ((((REP_MASK) >> (k)) & 1) ? 2 : 1)
#define INP(i) (args.in[i])
#define WSF(off) ((float*)(ws + (off)))
#define WSB(off) ((bf16*)(ws + (off)))
#define WSI(off) ((int*)(ws + (off)))
    unsigned* cnt = (unsigned*)(ctl + CW_CNT);
    LAS int* pref = (LAS int*)(lds + PREF_OFF);
    const int n_conv_p0 = I_WIN + 3 * I_P;
#define x_in INP(0)
#define cvec INP(1)
#define ctx INP(2)
#define c_ctx INP(3)
#define mod_w INP(4)
#define mod_b INP(5)
#define norm1_g INP(6)
#define norm2_g INP(7)
#define w_in INP(8)
#define gate_b INP(9)
#define conv_w INP(10)
#define conv_b INP(11)
#define mnorm_g INP(12)
#define sgu_norm_g INP(13)
#define sgu_w INP(14)
#define sgu_b INP(15)
#define proj_a INP(16)
#define proj_b INP(17)
#define w_out INP(18)
#define router_w INP(19)
#define router_b INP(20)
#define exp_w1 INP(21)
#define exp_b1 INP(22)
#define exp_w2 INP(23)
#define exp_b2 INP(24)
#define final_g INP(25)
#define MOD WSF(WS_MOD)
#define GATES WSF(WS_GATES)
#define BEND WSF(WS_SCAL)
#define GMAX (WSF(WS_SCAL) + 64 * 17)
#define MST (WSF(WS_SCAL) + 2 * 64 * 17)
#define RE WSI(WS_ROUTE)
#define RR (WSI(WS_ROUTE) + NLAT * 4)
#define RG (WSF(WS_ROUTE) + 2 * NLAT * 4)
#define WINT WSB(WS_WINT)
#define SKW WSB(WS_SK)
#define SCN WSF(WS_SCN)
#define PAT WSB(WS_PAT)
#define PBT WSB(WS_PBT)
#define WOT WSB(WS_WOT)
#define W1T WSB(WS_W1T)
#define W1T8 ((unsigned char*)(ws + WS_W1T))
#define HB8M ((unsigned char*)(ws + WS_HB8))
#define WG8M ((unsigned char*)(ws + WS_WG8))
#define W2T8 ((unsigned char*)(ws + WS_W2T))
#define XG8 ((unsigned char*)(ws + WS_XG))
#define ACT8 ((unsigned char*)(ws + WS_ACT))
#define W2T WSB(WS_W2T)
#define HB WSB(WS_HB)
#define Z WSB(WS_Z)
#define QC WSB(WS_QC)
#define KC WSB(WS_KC)
#define SVN WSB(WS_SVN)
#define DC WSB(WS_DC)
#define CS WSB(WS_CS)
#define RO WSB(WS_RO)
#define CM WSB(WS_CM)
#define YB WSF(WS_YB)
#define MRG WSB(WS_MRG)
#define X1 WSF(WS_X1)
#define ACT WSB(WS_ACT)
#define Y2 WSB(WS_Y2)
#define XG WSB(WS_XG)

    if (IN(0)) for (int rep_ = 0; rep_ < NREP(0); ++rep_) { p0_phase(lds, tid, G, cvec, c_ctx, mod_w, mod_b, MOD, w_in, proj_a, proj_b, w_out, exp_w1, exp_w2, router_w, WINT, PAT, PBT, WOT, W1T, W2T, SKW, n_conv_p0);
        cvt_run8(lds, tid, I_W1 + I_W2 + (int)blockIdx.x, G, I_W1 + I_W2 + I_GATE8, exp_w1, exp_w2, w_in, W1T8, W2T8, WG8M); if (BOTH(0) || rep_ + 1 < NREP(0)) GRID_BAR(); }
    if (IN(1)) for (int rep_ = 0; rep_ < NREP(1); ++rep_) { p1_phase(lds, tid, wave, lane, G, x_in, ctx, MOD, norm1_g, SKW, gate_b, HB, HB8M, GATES); if (BOTH(1) || rep_ + 1 < NREP(1)) GRID_BAR(); }
    if (IN(2)) for (int rep_ = 0; rep_ < NREP(2); ++rep_) {
        if ((int)blockIdx.x >= G - (G == 256 ? N_CONVERTERS : G))
            cvt_run8(lds, tid, (int)blockIdx.x - (G - (G == 256 ? N_CONVERTERS : G)), (G == 256 ? N_CONVERTERS : G), I_W1 + I_W2, exp_w1, exp_w2, w_in, W1T8, W2T8, WG8M);
        { pg8::Gemm g{(const bf16*)HB8M, (const bf16*)WG8M, NTOK, 12288, DM}; pg8::DynOrder S{(unsigned*)(ctl + CW_Q2), (LAS int*)(lds + PREF_OFF + 808), (int)(blockIdx.x & 7), 48, 8, 0}; pg8::EpiGate8 E{Z, ZW};
          pg8::gemm_phase8<pg8::EpiGate8, pg8::DynOrder, true, true>(lds, g, S, E); }
        { pg8::Gemm g{HB, WINT, NLAT, ZW, DM}; pg8::DynOrder S{(unsigned*)(ctl + CW_Q), (LAS int*)(lds + PREF_OFF + 800), (int)(blockIdx.x & 7), 8, 0, 24}; pg8::EpiBf16 E{Z, ZW, nullptr, ZW / 256};
          pg8::gemm_phase<pg8::EpiBf16, pg8::DynOrder, true, true>(lds, g, S, E); }
        if (BOTH(2) || rep_ + 1 < NREP(2)) GRID_BAR();
    }
    if (IN(3)) for (int rep_ = 0; rep_ < NREP(3); ++rep_) { p3_phase(wave, lane, G, Z, conv_w, conv_b, sgu_norm_g, QC, KC, SVN, GATES, SCN, BEND, GMAX); if (BOTH(3) || rep_ + 1 < NREP(3)) GRID_BAR(); }
    if (IN(4)) for (int rep_ = 0; rep_ < NREP(4); ++rep_) { p4_phase(lds, tid, wave, lane, G, Z, KC, SVN, SCN, sgu_w, sgu_b, DC, GMAX, CM); if (BOTH(4) || rep_ + 1 < NREP(4)) GRID_BAR(); }
    if (IN(5)) for (int rep_ = 0; rep_ < NREP(5); ++rep_) {
        { pg8::Gemm g{CM, PBT, NLAT, DM, DM}; pg8::StaticOrder S; S.init(NLAT, DM, G, (int)blockIdx.x); pg8::EpiF32 E{YB, DM};
          pg8::gemm_phase<pg8::EpiF32, pg8::StaticOrder, true, true>(lds, g, S, E); }
        p5_scan(tid, G, DC, BEND, GMAX, CS, MST);
        if (BOTH(5) || rep_ + 1 < NREP(5)) GRID_BAR();
    }
    if (IN(6)) for (int rep_ = 0; rep_ < NREP(6); ++rep_) { p6_phase(lds, tid, wave, lane, G, Z, QC, KC, SCN, CS, MST, mnorm_g, RO); if (BOTH(6) || rep_ + 1 < NREP(6)) GRID_BAR(); }
    if (IN(7)) for (int rep_ = 0; rep_ < NREP(7); ++rep_) {
        pg8::Gemm g{RO, PAT, NLAT, DM, DM}; pg8::StaticOrder S; S.init(NLAT, DM, G, (int)blockIdx.x); pg8::EpiMerge E{MRG, Z, ZW, ZGA, ZGB, YB};
        pg8::gemm_phase<pg8::EpiMerge, pg8::StaticOrder, true, true>(lds, g, S, E);
        if (BOTH(7) || rep_ + 1 < NREP(7)) GRID_BAR();
    }
    if (IN(8)) for (int rep_ = 0; rep_ < NREP(8); ++rep_) {
        pg8::Gemm g{MRG, WOT, NLAT, DM, DM}; pg8::StaticOrder S; S.init(NLAT, DM, G, (int)blockIdx.x); pg8::EpiX1 E{X1, x_in, MOD};
        pg8::gemm_phase<pg8::EpiX1, pg8::StaticOrder, true, true>(lds, g, S, E);
        if (BOTH(8) || rep_ + 1 < NREP(8)) GRID_BAR();
    }
    if (IN(9)) for (int rep_ = 0; rep_ < NREP(9); ++rep_) { p9_phase(lds, wave, lane, G, X1, MOD, norm2_g, SKW, router_b, cnt, XG8, RE, RR, RG); if (BOTH(9) || rep_ + 1 < NREP(9)) GRID_BAR(); }
    if (IN(10)) for (int rep_ = 0; rep_ < NREP(10); ++rep_) {
        moe_prefix(pref, cnt, tid);
        pg8::Gemm g{(const bf16*)XG8, (const bf16*)W1T8, 0, 0, DM}; pg8::MoeDyn S{pref, 16, 1, (unsigned*)(ctl + CW_Q3), (LAS int*)(lds + PREF_OFF + 816), (int)(blockIdx.x & 7)}; pg8::EpiSwiglu8 E{ACT8, exp_b1};
        pg8::gemm_phase8<pg8::EpiSwiglu8, pg8::MoeDyn, true, true, true>(lds, g, S, E);
        if (BOTH(10) || rep_ + 1 < NREP(10)) GRID_BAR();
    }
    if (IN(11)) for (int rep_ = 0; rep_ < NREP(11); ++rep_) {
        moe_prefix(pref, cnt, tid);
        pg8::Gemm g{(const bf16*)ACT8, (const bf16*)W2T8, 0, 0, DEXP}; pg8::MoeDyn S{pref, 8, 0, (unsigned*)(ctl + CW_Q4), (LAS int*)(lds + PREF_OFF + 824), (int)(blockIdx.x & 7)}; pg8::EpiY2f8 E{Y2, exp_b2};
        pg8::gemm_phase8<pg8::EpiY2f8, pg8::MoeDyn, true, true, true>(lds, g, S, E);
        if (BOTH(11) || rep_ + 1 < NREP(11)) GRID_BAR();
    }
    if (IN(12)) for (int rep_ = 0; rep_ < NREP(12); ++rep_) { moe_prefix(pref, cnt, tid); p12_phase(pref, wave, lane, G, X1, MOD, Y2, RE, RR, RG, final_g, args.out); if (rep_ + 1 < NREP(12)) GRID_BAR(); }
#undef IN
#undef BOTH
}

extern "C" void kernel_launch(void* const* d_in, const int* in_sizes, int n_in, void* d_out, int out_size, void* d_ws, size_t ws_size, hipStream_t stream) {
    static int grid = 0;
    if (grid == 0) {
        if (n_in != 26 || out_size != NLAT * DM || ws_size < WS_END) { fprintf(stderr, "kernel_launch: unexpected shapes (n_in %d, out %d, ws %zu)\n", n_in, out_size, ws_size); grid = -1; return; }
        int dev = 0, cus = 0;
        if (hipGetDevice(&dev) != hipSuccess || hipDeviceGetAttribute(&cus, hipDeviceAttributeMultiprocessorCount, dev) != hipSuccess) { grid = -1; return; }
        if (hipFuncSetAttribute((const void*)mk_fwd, hipFuncAttributeMaxDynamicSharedMemorySize, LDS_BYTES) != hipSuccess) { fprintf(stderr, "kernel_launch: hipFuncSetAttribute failed\n"); grid = -1; return; }
        int per_cu = 0;
        if (hipOccupancyMaxActiveBlocksPerMultiprocessor(&per_cu, (const void*)mk_fwd, NTHR, LDS_BYTES) != hipSuccess || per_cu < 1) fprintf(stderr, "kernel_launch: occupancy query reports %d\n", per_cu);
        (void)hipGetLastError();
        grid = cus;
    }
    if (grid < 0) return;
    if (hipMemsetAsync((char*)d_ws + WS_CTL, 0, CTL_ZERO_BYTES, stream) != hipSuccess) return;
    Args a{};
    for (int i = 0; i < 26; ++i) a.in[i] = (const float*)d_in[i];
    a.out = (float*)d_out; a.ws = (unsigned char*)d_ws;
    for (int li = 0; li < N_LAUNCHES; ++li) {
        a.ph_lo = (N_LAUNCHES == 1) ? 0 : li; a.ph_hi = (N_LAUNCHES == 1) ? N_PHASES : li + 1;
        hipLaunchKernelGGL(mk_fwd, dim3(grid), dim3(NTHR), LDS_BYTES, stream, a);
        const hipError_t le = hipPeekAtLastError();
        if (le != hipSuccess) { fprintf(stderr, "kernel_launch: launch %d failed: %s\n", li, hipGetErrorName(le)); break; }
    }
}
```

```cpp
#include <hip/hip_runtime.h>
#include <cstdio>
#include <cstdint>
#ifndef MK_N_LAUNCHES
#define MK_N_LAUNCHES 1
#endif
namespace pg8 {
#define PG8_LAS __attribute__((address_space(3)))
typedef unsigned short bf16_t;
typedef short bf16x8 __attribute__((ext_vector_type(8)));
typedef float f32x4 __attribute__((ext_vector_type(4)));
typedef unsigned u32x4 __attribute__((ext_vector_type(4)));
typedef int i32x4 __attribute__((ext_vector_type(4)));
typedef int i32x8 __attribute__((ext_vector_type(8)));
constexpr int BM = 256, BK = 64, HALF = 128, HTB = HALF * BK * 2  , STAGE_BYTES = 8 * HTB, NXCD = 8, WGM = 8;

__host__ __device__ __forceinline__ int lds_byte(int r, int c) { const int st = (r >> 4) * 2 + (c >> 5), rr = r & 15, cc = c & 31, ob = rr * 64 + cc * 2; return st * 1024 + (ob ^ (((ob >> 9) & 1) << 5)); }
__host__ __device__ __forceinline__ void stage_rc(int b, int& R, int& C) { const int st = b / 1024, sb = b % 1024, swz = sb ^ (((sb >> 9) & 1) << 5); R = (st >> 1) * 16 + swz / 64; C = (st & 1) * 32 + (swz % 64) / 2; }
__host__ __device__ __forceinline__ int perm32(int rho) { const int n = rho >> 4, i = rho & 15; return 8 * (i >> 2) + 4 * n + (i & 3); }

struct Unit { int pm, pn, po, hf; };
struct Gemm { const bf16_t* A; const bf16_t* Bt; int M, N, K; };

struct StaticOrder {
    int nM, nN, nwg, G, c;
    __host__ __device__ void init(int M, int N, int G_, int c_) { nM = M / BM; nN = N / BM; nwg = nM * nN; G = G_; c = c_; }
    __host__ __device__ bool next(int i, Unit& u) const {
        const long L = (long)i * G + c; if (L >= nwg) return false;
        int wgid = (int)L; { const int q = nwg / NXCD, r = nwg % NXCD, xcd = wgid % NXCD, off = wgid / NXCD; wgid = (xcd < r ? xcd * (q + 1) : r * (q + 1) + (xcd - r) * q) + off; }
        const int nig = WGM * nN, gid = wgid / nig, fm = gid * WGM, gsz = (nM - fm) < WGM ? (nM - fm) : WGM;
        u.pm = fm + ((wgid % nig) % gsz); u.pn = (wgid % nig) / gsz; u.po = u.pm; u.hf = 0; return true;
    }
    __device__ __forceinline__ void a_ready(const Unit&) const {}
    __device__ __forceinline__ void done(const Unit&) const {}
};
struct DynOrder {
    unsigned* q; PG8_LAS int* slot; int xcd, nN, ctx8, pn0;
    __device__ __forceinline__ bool next(int i, Unit& u) const {
        if (threadIdx.x == 0) { int id = -1;
            unsigned v = __hip_atomic_fetch_add(q + 64 * xcd, 1u, __ATOMIC_RELAXED, __HIP_MEMORY_SCOPE_AGENT);
            const unsigned per = (unsigned)(4 * nN + ctx8);
            if (v < per) id = xcd * (int)per + (int)v;
            else {
#pragma unroll 1
                for (int k = 1; k < 8 && id < 0; ++k) { const int x = (xcd + k) & 7;
                    if (__hip_atomic_load(q + 64 * x, __ATOMIC_RELAXED, __HIP_MEMORY_SCOPE_AGENT) < per) { v = __hip_atomic_fetch_add(q + 64 * x, 1u, __ATOMIC_RELAXED, __HIP_MEMORY_SCOPE_AGENT); if (v < per) id = x * (int)per + (int)v; } } }
            slot[i & 1] = id; asm volatile("s_waitcnt lgkmcnt(0)" ::: "memory"); }
        asm volatile("" ::: "memory"); __builtin_amdgcn_s_barrier(); asm volatile("" ::: "memory");
        const int id = slot[i & 1]; if (id < 0) return false;
        const int per = 4 * nN + ctx8, nl = 4 * nN, x = id / per, v = id - x * per;
        if (v < nl) { const int wgid = x * nl + v, nig = WGM * nN, gid = wgid / nig; u.pm = gid * WGM + ((wgid % nig) % WGM); u.pn = pn0 + (wgid % nig) / WGM; }
        else { const int j = x * 8 + (v - nl); u.pm = 32 + (j & 3); u.pn = j >> 2; }
        u.po = u.pm; u.hf = 0; return true;
    }
    __device__ __forceinline__ void a_ready(const Unit&) const {}
    __device__ __forceinline__ void done(const Unit&) const {}
};
struct MoeOrder {
    const PG8_LAS int* pref; int nN, G, c, a_sparse;
    __device__ __forceinline__ bool next(int i, Unit& u) const {
        const int L = i * G + c, total = pref[32]; if (L >= total * nN) return false;
        const int mt = L / nN, nt = L - mt * nN; int e = 0;
        for (int k = 1; k < 32; ++k) e += (pref[k] <= mt) ? 1 : 0;
        u.pm = a_sparse ? e * 32 + (mt - pref[e]) : mt; u.pn = e * nN + nt; u.po = mt; u.hf = (pref[33 + e] - 256 * (mt - pref[e]) <= 128) ? 1 : 0; return true;
    }
    __device__ __forceinline__ void a_ready(const Unit&) const {}
    __device__ __forceinline__ void done(const Unit&) const {}
};

struct MoeDyn {
    const PG8_LAS int* pref; int nN, a_sparse; unsigned* q; PG8_LAS int* slot; int xcd;
    __device__ __forceinline__ bool next(int i, Unit& u) const {
        const int total = pref[32], k = nN >> 3;
        if (threadIdx.x == 0) { int id = -1; const unsigned per = (unsigned)(total * k);
            unsigned v = __hip_atomic_fetch_add(q + 64 * xcd, 1u, __ATOMIC_RELAXED, __HIP_MEMORY_SCOPE_AGENT);
            if (v < per) id = (xcd << 16) | (int)v;
            else {
#pragma unroll 1
                for (int j = 1; j < 8 && id < 0; ++j) { const int x = (xcd + j) & 7;
                    if (__hip_atomic_load(q + 64 * x, __ATOMIC_RELAXED, __HIP_MEMORY_SCOPE_AGENT) < per) { v = __hip_atomic_fetch_add(q + 64 * x, 1u, __ATOMIC_RELAXED, __HIP_MEMORY_SCOPE_AGENT); if (v < per) id = (x << 16) | (int)v; } } }
            slot[i & 1] = id; asm volatile("s_waitcnt lgkmcnt(0)" ::: "memory"); }
        asm volatile("" ::: "memory"); __builtin_amdgcn_s_barrier(); asm volatile("" ::: "memory");
        const int id = slot[i & 1]; if (id < 0) return false;
        const int x = id >> 16, v = id & 0xffff, mt = v / k, nt = x + 8 * (v - mt * k); int e = 0;
        for (int j = 1; j < 32; ++j) e += (pref[j] <= mt) ? 1 : 0;
        u.pm = a_sparse ? e * 32 + (mt - pref[e]) : mt; u.pn = e * nN + nt; u.po = mt; u.hf = (pref[33 + e] - 256 * (mt - pref[e]) <= 128) ? 1 : 0; return true;
    }
    __device__ __forceinline__ void a_ready(const Unit&) const {}
    __device__ __forceinline__ void done(const Unit&) const {}
};

__device__ __forceinline__ unsigned cvt_pk_bf16(float lo, float hi) { unsigned r; asm volatile("v_cvt_pk_bf16_f32 %0, %1, %2" : "=v"(r) : "v"(lo), "v"(hi)); return r; }
__device__ __forceinline__ float bf_lo(unsigned w) { return __uint_as_float(w << 16); }
__device__ __forceinline__ float bf_hi(unsigned w) { return __uint_as_float(w & 0xffff0000u); }
__device__ __forceinline__ unsigned pk4_fp8(float a, float b, float c, float d) {
    a = fminf(fmaxf(a, -448.f), 448.f); b = fminf(fmaxf(b, -448.f), 448.f); c = fminf(fmaxf(c, -448.f), 448.f); d = fminf(fmaxf(d, -448.f), 448.f);
    int p = __builtin_amdgcn_cvt_pk_fp8_f32(a, b, 0, false); p = __builtin_amdgcn_cvt_pk_fp8_f32(c, d, p, true); return (unsigned)p; }
constexpr float F8_SA = 16.0f, F8_SW = 512.0f, F8_SC = 4.0f;
__device__ __forceinline__ float sigmoidf_(float x) { return __builtin_amdgcn_rcpf(1.0f + __expf(-x)); }

struct EpiBf16 {
    static constexpr bool PERM = true, AFTER_DRAIN = false;
    bf16_t* O; int ldc; const float* bias; int ncolt;
    __device__ __forceinline__ void operator()(const f32x4 (&acc)[2][2][4][2], const Unit& u, int wr, int wc, int fr, int fq) const {
        const int row0 = u.po * BM + wr * 64 + fr; const int colt = (u.pn % ncolt) * BM;
        const int col0 = colt + wc * 32 + 8 * fq, bcol0 = u.pn * BM + wc * 32 + 8 * fq;
        f32x4 bv[2][2];
#pragma unroll
        for (int bj = 0; bj < 2; ++bj)
#pragma unroll
            for (int n = 0; n < 2; ++n) bv[bj][n] = bias ? *(const f32x4*)(bias + bcol0 + bj * HALF + 4 * n) : (f32x4){0.f, 0.f, 0.f, 0.f};
#pragma unroll
        for (int ai = 0; ai < 2; ++ai)
#pragma unroll
            for (int m = 0; m < 4; ++m) { bf16_t* rowp = O + (size_t)(row0 + ai * HALF + m * 16) * ldc + col0;
#pragma unroll
                for (int bj = 0; bj < 2; ++bj) { const f32x4 v0 = acc[ai][bj][m][0] + bv[bj][0], v1 = acc[ai][bj][m][1] + bv[bj][1];
                    u32x4 w; w.x = cvt_pk_bf16(v0[0], v0[1]); w.y = cvt_pk_bf16(v0[2], v0[3]); w.z = cvt_pk_bf16(v1[0], v1[1]); w.w = cvt_pk_bf16(v1[2], v1[3]);
                    __builtin_nontemporal_store(w, (u32x4*)(rowp + bj * HALF)); } }
    }
};
struct EpiSwiglu8 {
    static constexpr bool PERM = true, AFTER_DRAIN = false;
    unsigned char* O; const float* b1;
    __device__ __forceinline__ void operator()(const f32x4 (&acc)[2][2][4][2], const Unit& u, int wr, int wc, int fr, int fq) const {
        const int e = u.pn >> 4, nt = u.pn & 15; const int row0 = u.po * BM + wr * 64 + fr, j0 = nt * 128 + wc * 32 + 8 * fq;
        const float* bg = b1 + (size_t)e * 4096 + j0; const float* bl = bg + 2048; constexpr float us = 1.0f / (F8_SA * F8_SW);
#pragma unroll
        for (int ai = 0; ai < 2; ++ai)
#pragma unroll
            for (int m = 0; m < 4; ++m) { const size_t row = (size_t)(row0 + ai * HALF + m * 16);
                asm volatile("" ::: "memory");
                unsigned w[2];
#pragma unroll
                for (int n = 0; n < 2; ++n) { const f32x4 gv = acc[ai][0][m][n] * us + *(const f32x4*)(bg + 4 * n), lv = acc[ai][1][m][n] * us + *(const f32x4*)(bl + 4 * n);
                    float o[4];
#pragma unroll
                    for (int i = 0; i < 4; ++i) { const float ga = fminf(gv[i], 7.0f), la = fminf(fmaxf(lv[i], -7.0f), 7.0f); o[i] = ga * sigmoidf_(1.702f * ga) * (la + 1.0f) * F8_SC; }
                    w[n] = pk4_fp8(o[0], o[1], o[2], o[3]); }
                typedef unsigned u32x2 __attribute__((ext_vector_type(2))); const u32x2 ww = {w[0], w[1]};
                *(u32x2*)(O + row * 2048 + j0) = ww; }
    }
};
struct EpiY2f8 {
    static constexpr bool PERM = true, AFTER_DRAIN = false;
    bf16_t* O; const float* bias;
    __device__ __forceinline__ void operator()(const f32x4 (&acc)[2][2][4][2], const Unit& u, int wr, int wc, int fr, int fq) const {
        const int row0 = u.po * BM + wr * 64 + fr; const int col0 = (u.pn & 7) * BM + wc * 32 + 8 * fq, bcol0 = u.pn * BM + wc * 32 + 8 * fq; constexpr float us = 1.0f / (F8_SC * F8_SW);
        f32x4 bv[2][2];
#pragma unroll
        for (int bj = 0; bj < 2; ++bj)
#pragma unroll
            for (int n = 0; n < 2; ++n) bv[bj][n] = *(const f32x4*)(bias + bcol0 + bj * HALF + 4 * n);
#pragma unroll
        for (int ai = 0; ai < 2; ++ai)
#pragma unroll
            for (int m = 0; m < 4; ++m) { bf16_t* rowp = O + (size_t)(row0 + ai * HALF + m * 16) * 2048 + col0;
#pragma unroll
                for (int bj = 0; bj < 2; ++bj) { const f32x4 v0 = acc[ai][bj][m][0] * us + bv[bj][0], v1 = acc[ai][bj][m][1] * us + bv[bj][1];
                    u32x4 w; w.x = cvt_pk_bf16(v0[0], v0[1]); w.y = cvt_pk_bf16(v0[2], v0[3]); w.z = cvt_pk_bf16(v1[0], v1[1]); w.w = cvt_pk_bf16(v1[2], v1[3]);
                    __builtin_nontemporal_store(w, (u32x4*)(rowp + bj * HALF)); } }
    }
};
struct EpiGate8 {
    static constexpr bool PERM = true, AFTER_DRAIN = false;
    bf16_t* O; int ldc;
    __device__ __forceinline__ void operator()(const f32x4 (&acc)[2][2][4][2], const Unit& u, int wr, int wc, int fr, int fq) const {
        const int row0 = u.po * BM + wr * 64 + fr, col0 = (u.pn < 24 ? u.pn : u.pn + 8) * BM + wc * 32 + 8 * fq; constexpr float us = 1.0f / (F8_SA * F8_SW);
#pragma unroll
        for (int ai = 0; ai < 2; ++ai)
#pragma unroll
            for (int m = 0; m < 4; ++m) { bf16_t* rowp = O + (size_t)(row0 + ai * HALF + m * 16) * ldc + col0;
#pragma unroll
                for (int bj = 0; bj < 2; ++bj) { const f32x4 v0 = acc[ai][bj][m][0] * us, v1 = acc[ai][bj][m][1] * us;
                    u32x4 w; w.x = cvt_pk_bf16(v0[0], v0[1]); w.y = cvt_pk_bf16(v0[2], v0[3]); w.z = cvt_pk_bf16(v1[0], v1[1]); w.w = cvt_pk_bf16(v1[2], v1[3]);
                    __builtin_nontemporal_store(w, (u32x4*)(rowp + bj * HALF)); } }
    }
};
struct EpiF32 {
    static constexpr bool PERM = false, AFTER_DRAIN = false;
    float* C; int ldc;
    __device__ __forceinline__ void operator()(const f32x4 (&acc)[2][2][4][2], const Unit& u, int wr, int wc, int fr, int fq) const {
        const int row0 = u.po * BM + wr * 64 + fr, col0 = u.pn * BM + wc * 32 + 4 * fq;
#pragma unroll
        for (int ai = 0; ai < 2; ++ai)
#pragma unroll
            for (int m = 0; m < 4; ++m) { float* rowp = C + (size_t)(row0 + ai * HALF + m * 16) * ldc + col0;
#pragma unroll
                for (int bj = 0; bj < 2; ++bj)
#pragma unroll
                    for (int n = 0; n < 2; ++n) *(f32x4*)(rowp + bj * HALF + n * 16) = acc[ai][bj][m][n]; }
    }
};
struct EpiMerge {
    static constexpr bool PERM = true, AFTER_DRAIN = false;
    bf16_t* O; const bf16_t* Z; int ldz, ga_off, gb_off; const bf16_t* YB;
    __device__ __forceinline__ void operator()(const f32x4 (&acc)[2][2][4][2], const Unit& u, int wr, int wc, int fr, int fq) const {
        const int row0 = u.po * BM + wr * 64 + fr, col0 = u.pn * BM + wc * 32 + 8 * fq;
#pragma unroll
        for (int ai = 0; ai < 2; ++ai)
#pragma unroll
            for (int m = 0; m < 4; ++m) { const size_t row = (size_t)(row0 + ai * HALF + m * 16);
#pragma unroll
                for (int bj = 0; bj < 2; ++bj) { const int col = col0 + bj * HALF;
                    const u32x4 ga = *(const u32x4*)(Z + row * ldz + ga_off + col), gb = *(const u32x4*)(Z + row * ldz + gb_off + col);
                    const u32x4 yw = *(const u32x4*)(YB + row * 2048 + col); const f32x4 y0 = {bf_lo(yw.x), bf_hi(yw.x), bf_lo(yw.y), bf_hi(yw.y)}, y1 = {bf_lo(yw.z), bf_hi(yw.z), bf_lo(yw.w), bf_hi(yw.w)};
                    const f32x4 a0 = acc[ai][bj][m][0], a1 = acc[ai][bj][m][1];
                    float o[8];
                    o[0] = sigmoidf_(bf_lo(ga.x)) * a0[0] + sigmoidf_(bf_lo(gb.x)) * y0[0]; o[1] = sigmoidf_(bf_hi(ga.x)) * a0[1] + sigmoidf_(bf_hi(gb.x)) * y0[1];
                    o[2] = sigmoidf_(bf_lo(ga.y)) * a0[2] + sigmoidf_(bf_lo(gb.y)) * y0[2]; o[3] = sigmoidf_(bf_hi(ga.y)) * a0[3] + sigmoidf_(bf_hi(gb.y)) * y0[3];
                    o[4] = sigmoidf_(bf_lo(ga.z)) * a1[0] + sigmoidf_(bf_lo(gb.z)) * y1[0]; o[5] = sigmoidf_(bf_hi(ga.z)) * a1[1] + sigmoidf_(bf_hi(gb.z)) * y1[1];
                    o[6] = sigmoidf_(bf_lo(ga.w)) * a1[2] + sigmoidf_(bf_lo(gb.w)) * y1[2]; o[7] = sigmoidf_(bf_hi(ga.w)) * a1[3] + sigmoidf_(bf_hi(gb.w)) * y1[3];
                    u32x4 w; w.x = cvt_pk_bf16(o[0], o[1]); w.y = cvt_pk_bf16(o[2], o[3]); w.z = cvt_pk_bf16(o[4], o[5]); w.w = cvt_pk_bf16(o[6], o[7]);
                    *(u32x4*)(O + row * 2048 + col) = w; } }
    }
};
struct EpiX1 {
    static constexpr bool PERM = false, AFTER_DRAIN = false;
    float* X1; const float* X; const float* mod;
    __device__ __forceinline__ void operator()(const f32x4 (&acc)[2][2][4][2], const Unit& u, int wr, int wc, int fr, int fq) const {
        const int row0 = u.po * BM + wr * 64 + fr, col0 = u.pn * BM + wc * 32 + 4 * fq;
        const float* mg = mod + (size_t)((u.po * BM) >> 11) * 12288 + 2 * 2048;
#pragma unroll
        for (int bj = 0; bj < 2; ++bj)
#pragma unroll
            for (int n = 0; n < 2; ++n) { const int col = col0 + bj * HALF + n * 16; const f32x4 g = *(const f32x4*)(mg + col);
#pragma unroll
                for (int ai = 0; ai < 2; ++ai)
#pragma unroll
                    for (int m = 0; m < 4; ++m) { const size_t off = (size_t)(row0 + ai * HALF + m * 16) * 2048 + col;
                        *(f32x4*)(X1 + off) = *(const f32x4*)(X + off) + g * acc[ai][bj][m][n]; } }
    }
};
struct EpiSwiglu {
    static constexpr bool PERM = true, AFTER_DRAIN = false;
    bf16_t* O; const float* b1;
    __device__ __forceinline__ void operator()(const f32x4 (&acc)[2][2][4][2], const Unit& u, int wr, int wc, int fr, int fq) const {
        const int e = u.pn >> 4, nt = u.pn & 15; const int row0 = u.po * BM + wr * 64 + fr, j0 = nt * 128 + wc * 32 + 8 * fq;
        const float* bg = b1 + (size_t)e * 4096 + j0; const float* bl = bg + 2048;
#pragma unroll
        for (int ai = 0; ai < 2; ++ai)
#pragma unroll
            for (int m = 0; m < 4; ++m) { const size_t row = (size_t)(row0 + ai * HALF + m * 16);
                asm volatile("" ::: "memory");
#pragma unroll
                for (int n = 0; n < 2; ++n) { const f32x4 gv = acc[ai][0][m][n] + *(const f32x4*)(bg + 4 * n), lv = acc[ai][1][m][n] + *(const f32x4*)(bl + 4 * n);
                    float o[4];
#pragma unroll
                    for (int i = 0; i < 4; ++i) { const float ga = fminf(gv[i], 7.0f), la = fminf(fmaxf(lv[i], -7.0f), 7.0f); o[i] = ga * sigmoidf_(1.702f * ga) * (la + 1.0f); }
                    typedef unsigned u32x2 __attribute__((ext_vector_type(2))); u32x2 w; w.x = cvt_pk_bf16(o[0], o[1]); w.y = cvt_pk_bf16(o[2], o[3]);
                    *(u32x2*)(O + row * 2048 + j0 + 4 * n) = w; } }
    }
};

template <class Epi, class Sched, bool ALIGN_EPI = false, bool SP2 = false, bool HALFSKIP = false>
__device__ __forceinline__ void gemm_phase(PG8_LAS unsigned char* lds, const Gemm g, const Sched& S, const Epi& E) {
    const int tid = threadIdx.x, wid = __builtin_amdgcn_readfirstlane(tid >> 6), lane = tid & 63, wr = wid >> 2, wc = wid & 3, fr = lane & 15, fq = lane >> 4;
    const int K = g.K, nt = K / BK;
    unsigned voffA[2], voffB[2];
#pragma unroll
    for (int i = 0; i < 2; ++i) { int R, C; stage_rc(tid * 16 + i * 8192, R, C); const int Rb = Epi::PERM ? ((R & ~31) + perm32(R & 31)) : R;
        voffA[i] = (unsigned)(R * K + C) * 2u; voffB[i] = (unsigned)(Rb * K + C) * 2u; }
    const size_t kstep = (size_t)(BK * 2);
    const size_t hstep = (size_t)HALF * K * 2;
    const size_t tstep = 2 * hstep;
    const unsigned ldsw = (unsigned)wid * 1024u;
    const int aoff = lds_byte(wr * 64 + fr, fq * 8), boff = lds_byte(wc * 32 + fr, fq * 8);
#define PG8_SA(b, h) (((b) * 2 + (h)) * HTB)
#define PG8_SB(b, h) ((4 + (b) * 2 + (h)) * HTB)
#define PG8_STAGE(bufoff, gbase, voff) do { _Pragma("unroll") for (int _i = 0; _i < 2; ++_i) \
        __builtin_amdgcn_global_load_lds((const unsigned*)((const char*)(gbase) + (voff)[_i]), (PG8_LAS unsigned*)(lds + (bufoff) + ldsw + _i * 8192), 16, 0, 0); } while (0)
#define PG8_LDA(dst, b, h) do { _Pragma("unroll") for (int m = 0; m < 4; ++m) _Pragma("unroll") for (int k = 0; k < 2; ++k) dst[m][k] = *(const PG8_LAS bf16x8*)(lds + PG8_SA(b, h) + aoff + m * 2048 + k * 1024); } while (0)
#define PG8_LDB(dst, b, h) do { _Pragma("unroll") for (int n = 0; n < 2; ++n) _Pragma("unroll") for (int k = 0; k < 2; ++k) dst[n][k] = *(const PG8_LAS bf16x8*)(lds + PG8_SB(b, h) + boff + n * 2048 + k * 1024); } while (0)
#define PG8_MMA(ai, bj, At, Bt) do { __builtin_amdgcn_s_setprio(1); _Pragma("unroll") for (int m = 0; m < 4; ++m) _Pragma("unroll") for (int n = 0; n < 2; ++n) _Pragma("unroll") for (int k = 0; k < 2; ++k) \
        acc[ai][bj][m][n] = __builtin_amdgcn_mfma_f32_16x16x32_bf16(Bt[n][k], At[m][k], acc[ai][bj][m][n], 0, 0, 0); __builtin_amdgcn_s_setprio(0); } while (0)
#define PG8_WAIT_V(n) asm volatile("s_waitcnt vmcnt(" #n ")" ::: "memory")
#define PG8_WAIT_L(n) asm volatile("s_waitcnt lgkmcnt(" #n ")" ::: "memory")
#define PG8_BAR __builtin_amdgcn_s_barrier()
#define PG8_SCHED __builtin_amdgcn_sched_barrier(0)
    Unit cur, nxt; int ui = 0;
    if (!S.next(0, cur)) return;
    f32x4 acc[2][2][4][2];
#pragma unroll
    for (int a = 0; a < 2; ++a)
#pragma unroll
        for (int b = 0; b < 2; ++b)
#pragma unroll
            for (int m = 0; m < 4; ++m)
#pragma unroll
                for (int n = 0; n < 2; ++n) acc[a][b][m][n] = (f32x4){0.f, 0.f, 0.f, 0.f};
    bf16x8 At[4][2], B0[2][2], B1[2][2];
    const char* cA = (const char*)g.A + (size_t)cur.pm * tstep; const char* cB = (const char*)g.Bt + (size_t)cur.pn * tstep;
    S.a_ready(cur);
    if constexpr (SP2) {
        PG8_STAGE(PG8_SB(0, 0), cB, voffB); PG8_STAGE(PG8_SB(0, 1), cB + hstep, voffB); PG8_STAGE(PG8_SA(0, 0), cA, voffA); PG8_STAGE(PG8_SA(0, 1), cA + hstep, voffA);
        if (wr == 1) PG8_BAR;
        PG8_WAIT_V(2); PG8_BAR;
        PG8_STAGE(PG8_SB(1, 0), cB + kstep, voffB); PG8_STAGE(PG8_SA(1, 0), cA + kstep, voffA); PG8_STAGE(PG8_SB(1, 1), cB + hstep + kstep, voffB);
        PG8_WAIT_V(6); PG8_BAR;
    } else {
        PG8_STAGE(PG8_SB(0, 0), cB, voffB); PG8_STAGE(PG8_SA(0, 0), cA, voffA); PG8_STAGE(PG8_SB(0, 1), cB + hstep, voffB); PG8_STAGE(PG8_SA(0, 1), cA + hstep, voffA);
        if (wr == 1) PG8_BAR;
        PG8_WAIT_V(4); PG8_BAR;
        PG8_STAGE(PG8_SB(1, 0), cB + kstep, voffB); PG8_STAGE(PG8_SA(1, 0), cA + kstep, voffA); PG8_STAGE(PG8_SB(1, 1), cB + hstep + kstep, voffB);
        PG8_WAIT_V(6); PG8_BAR;
    }
    for (;;) {
        const bool has_next = S.next(ui + 1, nxt);
        const char* nA = has_next ? (const char*)g.A + (size_t)nxt.pm * tstep : cA; const char* nB = has_next ? (const char*)g.Bt + (size_t)nxt.pn * tstep : cB;
        for (int t = 0; t < nt; t += 2) {
            const bool last = (t == nt - 2);
            const char* a1 = cA + (size_t)(t + 1) * kstep;
            const char* a2 = last ? nA : cA + (size_t)(t + 2) * kstep; const char* b2 = last ? nB : cB + (size_t)(t + 2) * kstep;
            const char* a3 = a2 + kstep; const char* b3 = b2 + kstep;
            if (last && has_next) S.a_ready(nxt);
            if constexpr (SP2) {
            PG8_LDB(B0, 0, 0); PG8_LDB(B1, 0, 1); PG8_SCHED; PG8_LDA(At, 0, 0); PG8_STAGE(PG8_SA(1, 1), a1 + hstep, voffA);
            PG8_WAIT_V(8); PG8_WAIT_L(0); PG8_BAR; PG8_MMA(0, 0, At, B0); PG8_MMA(0, 1, At, B1); PG8_BAR; PG8_SCHED;
            PG8_LDA(At, 0, 1); PG8_STAGE(PG8_SB(0, 0), b2, voffB); PG8_STAGE(PG8_SB(0, 1), b2 + hstep, voffB); PG8_STAGE(PG8_SA(0, 0), a2, voffA);
            PG8_WAIT_V(8); PG8_WAIT_L(0); PG8_BAR; if (!(HALFSKIP && cur.hf)) { PG8_MMA(1, 0, At, B0); PG8_MMA(1, 1, At, B1); } PG8_BAR; PG8_SCHED;
            PG8_LDB(B0, 1, 0); PG8_LDB(B1, 1, 1); PG8_SCHED; PG8_LDA(At, 1, 0); PG8_STAGE(PG8_SA(0, 1), a2 + hstep, voffA);
            PG8_WAIT_V(8); PG8_WAIT_L(0); PG8_BAR; PG8_MMA(0, 0, At, B0); PG8_MMA(0, 1, At, B1); PG8_BAR; PG8_SCHED;
            PG8_LDA(At, 1, 1); PG8_STAGE(PG8_SB(1, 0), b3, voffB); PG8_STAGE(PG8_SB(1, 1), b3 + hstep, voffB); PG8_STAGE(PG8_SA(1, 0), a3, voffA);
            PG8_WAIT_V(8); PG8_WAIT_L(0); PG8_BAR; if (!(HALFSKIP && cur.hf)) { PG8_MMA(1, 0, At, B0); PG8_MMA(1, 1, At, B1); } PG8_BAR; PG8_SCHED;
            } else {
            PG8_LDB(B0, 0, 0); PG8_SCHED; PG8_LDA(At, 0, 0); PG8_STAGE(PG8_SA(1, 1), a1 + hstep, voffA);
            PG8_WAIT_L(8); PG8_BAR; PG8_WAIT_L(0); PG8_MMA(0, 0, At, B0); PG8_BAR; PG8_SCHED;
            PG8_LDB(B1, 0, 1); PG8_STAGE(PG8_SB(0, 0), b2, voffB);
            PG8_BAR; PG8_WAIT_L(0); PG8_MMA(0, 1, At, B1); PG8_BAR;
            PG8_LDA(At, 0, 1); PG8_STAGE(PG8_SA(0, 0), a2, voffA);
            PG8_BAR; PG8_WAIT_L(0); PG8_MMA(1, 0, At, B0); PG8_BAR; PG8_SCHED;
            PG8_STAGE(PG8_SB(0, 1), b2 + hstep, voffB);
            PG8_WAIT_V(6); PG8_BAR; PG8_MMA(1, 1, At, B1); PG8_BAR;
            PG8_LDB(B0, 1, 0); PG8_SCHED; PG8_LDA(At, 1, 0); PG8_STAGE(PG8_SA(0, 1), a2 + hstep, voffA);
            PG8_WAIT_L(8); PG8_BAR; PG8_WAIT_L(0); PG8_MMA(0, 0, At, B0); PG8_BAR; PG8_SCHED;
            PG8_LDB(B1, 1, 1); PG8_STAGE(PG8_SB(1, 0), b3, voffB);
            PG8_BAR; PG8_WAIT_L(0); PG8_MMA(0, 1, At, B1); PG8_BAR;
            PG8_LDA(At, 1, 1); PG8_STAGE(PG8_SA(1, 0), a3, voffA);
            PG8_BAR; PG8_WAIT_L(0); PG8_MMA(1, 0, At, B0); PG8_BAR; PG8_SCHED;
            PG8_STAGE(PG8_SB(1, 1), b3 + hstep, voffB);
            PG8_WAIT_V(6); PG8_BAR; PG8_MMA(1, 1, At, B1); PG8_BAR;
            }
        }
        if constexpr (ALIGN_EPI) { if (wr == 0) PG8_BAR; }
        if constexpr (!Epi::AFTER_DRAIN) { E(acc, cur, wr, wc, fr, fq); S.done(cur); }
        if (!has_next) break;
#pragma unroll
        for (int a = 0; a < 2; ++a)
#pragma unroll
            for (int b = 0; b < 2; ++b)
#pragma unroll
                for (int m = 0; m < 4; ++m)
#pragma unroll
                    for (int n = 0; n < 2; ++n) acc[a][b][m][n] = (f32x4){0.f, 0.f, 0.f, 0.f};
        cur = nxt; cA = nA; cB = nB; ++ui;
        if constexpr (ALIGN_EPI) { if (wr == 1) PG8_BAR; }
    }
    PG8_WAIT_V(0);
    if constexpr (!ALIGN_EPI) { if (wr == 0) PG8_BAR; }
    PG8_BAR;
    if constexpr (Epi::AFTER_DRAIN) { E.fused(acc, cur, wr, wc, fr, fq, lds, wid, lane); S.done(cur); }
#undef PG8_SA
#undef PG8_SB
#undef PG8_STAGE
#undef PG8_LDA
#undef PG8_LDB
#undef PG8_MMA
#undef PG8_WAIT_V
#undef PG8_WAIT_L
#undef PG8_BAR
#undef PG8_SCHED
}
template <class Epi, class Sched, bool ALIGN_EPI = false, bool SP2 = false, bool HALFSKIP = false>
__device__ __forceinline__ void gemm_phase8(PG8_LAS unsigned char* lds, const Gemm g, const Sched& S, const Epi& E) {
    const int tid = threadIdx.x, wid = __builtin_amdgcn_readfirstlane(tid >> 6), lane = tid & 63, wr = wid >> 2, wc = wid & 3, fr = lane & 15, fq = lane >> 4;
    const int K = g.K, nt = K / 128;
    unsigned voffA[2], voffB[2];
#pragma unroll
    for (int i = 0; i < 2; ++i) { int R, C; stage_rc(tid * 16 + i * 8192, R, C); const int Rb = Epi::PERM ? ((R & ~31) + perm32(R & 31)) : R;
        voffA[i] = (unsigned)(R * K + 2 * C); voffB[i] = (unsigned)(Rb * K + 2 * C); }
    const size_t kstep = (size_t)(BK * 2);
    const size_t hstep = (size_t)HALF * K;
    const size_t tstep = 2 * hstep;
    const unsigned ldsw = (unsigned)wid * 1024u;
    const int aoff = lds_byte(wr * 64 + fr, fq * 16), boff = lds_byte(wc * 32 + fr, fq * 16);
#define PG8_SA(b, h) (((b) * 2 + (h)) * HTB)
#define PG8_SB(b, h) ((4 + (b) * 2 + (h)) * HTB)
#define PG8_STAGE(bufoff, gbase, voff) do { _Pragma("unroll") for (int _i = 0; _i < 2; ++_i) \
        __builtin_amdgcn_global_load_lds((const unsigned*)((const char*)(gbase) + (voff)[_i]), (PG8_LAS unsigned*)(lds + (bufoff) + ldsw + _i * 8192), 16, 0, 0); } while (0)
#define PG8_LDA(dst, b, h) do { _Pragma("unroll") for (int m = 0; m < 4; ++m) { const i32x4 lo_ = *(const PG8_LAS i32x4*)(lds + PG8_SA(b, h) + aoff + m * 2048), hi_ = *(const PG8_LAS i32x4*)(lds + PG8_SA(b, h) + aoff + m * 2048 + 16); dst[m] = __builtin_shufflevector(lo_, hi_, 0, 1, 2, 3, 4, 5, 6, 7); } } while (0)
#define PG8_LDB(dst, b, h) do { _Pragma("unroll") for (int n = 0; n < 2; ++n) { const i32x4 lo_ = *(const PG8_LAS i32x4*)(lds + PG8_SB(b, h) + boff + n * 2048), hi_ = *(const PG8_LAS i32x4*)(lds + PG8_SB(b, h) + boff + n * 2048 + 16); dst[n] = __builtin_shufflevector(lo_, hi_, 0, 1, 2, 3, 4, 5, 6, 7); } } while (0)
#define PG8_MMA(ai, bj, At, Bt) do { __builtin_amdgcn_s_setprio(1); _Pragma("unroll") for (int m = 0; m < 4; ++m) _Pragma("unroll") for (int n = 0; n < 2; ++n) \
        asm volatile("v_mfma_scale_f32_16x16x128_f8f6f4 %0, %1, %2, %0, %3, %3 op_sel_hi:[0,0,0]" : "+v"(acc[ai][bj][m][n]) : "v"(Bt[n]), "v"(At[m]), "v"(sc127)); __builtin_amdgcn_s_setprio(0); } while (0)
#define PG8_WAIT_V(n) asm volatile("s_waitcnt vmcnt(" #n ")" ::: "memory")
#define PG8_WAIT_L(n) asm volatile("s_waitcnt lgkmcnt(" #n ")" ::: "memory")
#define PG8_BAR __builtin_amdgcn_s_barrier()
#define PG8_SCHED __builtin_amdgcn_sched_barrier(0)
    Unit cur, nxt; int ui = 0;
    if (!S.next(0, cur)) return;
    f32x4 acc[2][2][4][2];
#pragma unroll
    for (int a = 0; a < 2; ++a)
#pragma unroll
        for (int b = 0; b < 2; ++b)
#pragma unroll
            for (int m = 0; m < 4; ++m)
#pragma unroll
                for (int n = 0; n < 2; ++n) acc[a][b][m][n] = (f32x4){0.f, 0.f, 0.f, 0.f};
    i32x8 At[4], B0[2], B1[2]; const int sc127 = 127;
    const char* cA = (const char*)g.A + (size_t)cur.pm * tstep; const char* cB = (const char*)g.Bt + (size_t)cur.pn * tstep;
    S.a_ready(cur);
    if constexpr (SP2) {
        PG8_STAGE(PG8_SB(0, 0), cB, voffB); PG8_STAGE(PG8_SB(0, 1), cB + hstep, voffB); PG8_STAGE(PG8_SA(0, 0), cA, voffA); PG8_STAGE(PG8_SA(0, 1), cA + hstep, voffA);
        if (wr == 1) PG8_BAR;
        PG8_WAIT_V(2); PG8_BAR;
        PG8_STAGE(PG8_SB(1, 0), cB + kstep, voffB); PG8_STAGE(PG8_SA(1, 0), cA + kstep, voffA); PG8_STAGE(PG8_SB(1, 1), cB + hstep + kstep, voffB);
        PG8_WAIT_V(6); PG8_BAR;
    } else {
        PG8_STAGE(PG8_SB(0, 0), cB, voffB); PG8_STAGE(PG8_SA(0, 0), cA, voffA); PG8_STAGE(PG8_SB(0, 1), cB + hstep, voffB); PG8_STAGE(PG8_SA(0, 1), cA + hstep, voffA);
        if (wr == 1) PG8_BAR;
        PG8_WAIT_V(4); PG8_BAR;
        PG8_STAGE(PG8_SB(1, 0), cB + kstep, voffB); PG8_STAGE(PG8_SA(1, 0), cA + kstep, voffA); PG8_STAGE(PG8_SB(1, 1), cB + hstep + kstep, voffB);
        PG8_WAIT_V(6); PG8_BAR;
    }
    for (;;) {
        const bool has_next = S.next(ui + 1, nxt);
        const char* nA = has_next ? (const char*)g.A + (size_t)nxt.pm * tstep : cA; const char* nB = has_next ? (const char*)g.Bt + (size_t)nxt.pn * tstep : cB;
        for (int t = 0; t < nt; t += 2) {
            const bool last = (t == nt - 2);
            const char* a1 = cA + (size_t)(t + 1) * kstep;
            const char* a2 = last ? nA : cA + (size_t)(t + 2) * kstep; const char* b2 = last ? nB : cB + (size_t)(t + 2) * kstep;
            const char* a3 = a2 + kstep; const char* b3 = b2 + kstep;
            if (last && has_next) S.a_ready(nxt);
            if constexpr (SP2) {
            PG8_LDB(B0, 0, 0); PG8_LDB(B1, 0, 1); PG8_SCHED; PG8_LDA(At, 0, 0); PG8_STAGE(PG8_SA(1, 1), a1 + hstep, voffA);
            PG8_WAIT_V(8); PG8_WAIT_L(0); PG8_BAR; PG8_MMA(0, 0, At, B0); PG8_MMA(0, 1, At, B1); PG8_BAR; PG8_SCHED;
            if (!(HALFSKIP && cur.hf)) PG8_LDA(At, 0, 1); PG8_STAGE(PG8_SB(0, 0), b2, voffB); PG8_STAGE(PG8_SB(0, 1), b2 + hstep, voffB); PG8_STAGE(PG8_SA(0, 0), a2, voffA);
            PG8_WAIT_V(8); PG8_WAIT_L(0); PG8_BAR; if (!(HALFSKIP && cur.hf)) { PG8_MMA(1, 0, At, B0); PG8_MMA(1, 1, At, B1); } PG8_BAR; PG8_SCHED;
            PG8_LDB(B0, 1, 0); PG8_LDB(B1, 1, 1); PG8_SCHED; PG8_LDA(At, 1, 0); PG8_STAGE(PG8_SA(0, 1), a2 + hstep, voffA);
            PG8_WAIT_V(8); PG8_WAIT_L(0); PG8_BAR; PG8_MMA(0, 0, At, B0); PG8_MMA(0, 1, At, B1); PG8_BAR; PG8_SCHED;
            if (!(HALFSKIP && cur.hf)) PG8_LDA(At, 1, 1); PG8_STAGE(PG8_SB(1, 0), b3, voffB); PG8_STAGE(PG8_SB(1, 1), b3 + hstep, voffB); PG8_STAGE(PG8_SA(1, 0), a3, voffA);
            PG8_WAIT_V(8); PG8_WAIT_L(0); PG8_BAR; if (!(HALFSKIP && cur.hf)) { PG8_MMA(1, 0, At, B0); PG8_MMA(1, 1, At, B1); } PG8_BAR; PG8_SCHED;
            } else {
            PG8_LDB(B0, 0, 0); PG8_SCHED; PG8_LDA(At, 0, 0); PG8_STAGE(PG8_SA(1, 1), a1 + hstep, voffA);
            PG8_WAIT_L(8); PG8_BAR; PG8_WAIT_L(0); PG8_MMA(0, 0, At, B0); PG8_BAR; PG8_SCHED;
            PG8_LDB(B1, 0, 1); PG8_STAGE(PG8_SB(0, 0), b2, voffB);
            PG8_BAR; PG8_WAIT_L(0); PG8_MMA(0, 1, At, B1); PG8_BAR;
            PG8_LDA(At, 0, 1); PG8_STAGE(PG8_SA(0, 0), a2, voffA);
            PG8_BAR; PG8_WAIT_L(0); PG8_MMA(1, 0, At, B0); PG8_BAR; PG8_SCHED;
            PG8_STAGE(PG8_SB(0, 1), b2 + hstep, voffB);
            PG8_WAIT_V(6); PG8_BAR; PG8_MMA(1, 1, At, B1); PG8_BAR;
            PG8_LDB(B0, 1, 0); PG8_SCHED; PG8_LDA(At, 1, 0); PG8_STAGE(PG8_SA(0, 1), a2 + hstep, voffA);
            PG8_WAIT_L(8); PG8_BAR; PG8_WAIT_L(0); PG8_MMA(0, 0, At, B0); PG8_BAR; PG8_SCHED;
            PG8_LDB(B1, 1, 1); PG8_STAGE(PG8_SB(1, 0), b3, voffB);
            PG8_BAR; PG8_WAIT_L(0); PG8_MMA(0, 1, At, B1); PG8_BAR;
            PG8_LDA(At, 1, 1); PG8_STAGE(PG8_SA(1, 0), a3, voffA);
            PG8_BAR; PG8_WAIT_L(0); PG8_MMA(1, 0, At, B0); PG8_BAR; PG8_SCHED;
            PG8_STAGE(PG8_SB(1, 1), b3 + hstep, voffB);
            PG8_WAIT_V(6); PG8_BAR; PG8_MMA(1, 1, At, B1); PG8_BAR;
            }
        }
        if constexpr (ALIGN_EPI) { if (wr == 0) PG8_BAR; }
        if constexpr (!Epi::AFTER_DRAIN) { E(acc, cur, wr, wc, fr, fq); S.done(cur); }
        if (!has_next) break;
#pragma unroll
        for (int a = 0; a < 2; ++a)
#pragma unroll
            for (int b = 0; b < 2; ++b)
#pragma unroll
                for (int m = 0; m < 4; ++m)
#pragma unroll
                    for (int n = 0; n < 2; ++n) acc[a][b][m][n] = (f32x4){0.f, 0.f, 0.f, 0.f};
        cur = nxt; cA = nA; cB = nB; ++ui;
        if constexpr (ALIGN_EPI) { if (wr == 1) PG8_BAR; }
    }
    PG8_WAIT_V(0);
    if constexpr (!ALIGN_EPI) { if (wr == 0) PG8_BAR; }
    PG8_BAR;
    if constexpr (Epi::AFTER_DRAIN) { E.fused(acc, cur, wr, wc, fr, fq, lds, wid, lane); S.done(cur); }
#undef PG8_SA
#undef PG8_SB
#undef PG8_STAGE
#undef PG8_LDA
#undef PG8_LDB
#undef PG8_MMA
#undef PG8_WAIT_V
#undef PG8_WAIT_L
#undef PG8_BAR
#undef PG8_SCHED
}
}

constexpr int NWAVES = 8, NTHR = 512;
constexpr int N_LAUNCHES = MK_N_LAUNCHES;
constexpr int N_PHASES = 13;
constexpr int DM = 2048, NB = 4, TL = 2048, NLAT = NB * TL, TCX = 256, NCTX = NB * TCX, NTOK = NLAT + NCTX;
constexpr int NH = 8, QKD = 128, VD = 256, INC = 14368, ZW = 14336;
constexpr int ZQ = 0, ZK = 1024, ZV = 2048, ZO = 4096, ZU = 6144, ZS = 8192, ZGA = 10240, ZGB = 12288;
constexpr int NEXP = 32, DEXP = 2048, NCH = 18  , CROWS = 272  ;
constexpr float EPS = 1e-6f;

constexpr size_t MiB = 1u << 20;
constexpr size_t WS_CTL = 0, CTL_ZERO_BYTES = 1 * MiB;
constexpr size_t WS_MOD = 1 * MiB;
constexpr size_t WS_GATES = 2 * MiB;
constexpr size_t WS_SCAL = 4 * MiB;
constexpr size_t WS_ROUTE = 5 * MiB;
constexpr size_t WS_SCN = 2996 * MiB;
constexpr size_t WS_SK = 6 * MiB;
constexpr size_t WS_WINT = 8 * MiB;
constexpr size_t WS_PAT = 64 * MiB, WS_PBT = 72 * MiB, WS_WOT = 80 * MiB;
constexpr size_t WS_W1T = 88 * MiB;
constexpr size_t WS_W2T = 600 * MiB;
constexpr size_t WS_HB = 856 * MiB;
constexpr size_t WS_Z = 892 * MiB;
constexpr size_t WS_QC = 1144 * MiB, WS_KC = 1162 * MiB;
constexpr size_t WS_SVN = 1180 * MiB;
constexpr size_t WS_DC = 1212 * MiB;
constexpr size_t WS_CS = 1360 * MiB;
constexpr size_t WS_RO = 1428 * MiB;
constexpr size_t WS_CM = 1460 * MiB;
constexpr size_t WS_YB = 1492 * MiB;
constexpr size_t WS_MRG = 1556 * MiB;
constexpr size_t WS_X1 = 1588 * MiB;
constexpr size_t WS_ACT = 1652 * MiB;
constexpr size_t WS_Y2 = 1812 * MiB;
constexpr size_t WS_XG = 1972 * MiB;
constexpr size_t WS_HB8 = 2998 * MiB;
constexpr size_t WS_WG8 = 3016 * MiB;
constexpr size_t WS_END = 3040 * MiB;
static_assert(WS_DC + (size_t)64 * 17 * CROWS * 128 * 2 <= WS_CS && WS_CS + (size_t)64 * 16 * CROWS * 128 * 2 <= WS_RO && WS_Z + (size_t)NTOK * ZW * 2 <= WS_QC, "ws map");
constexpr int CW_Q3 = 3584, CW_Q4 = 8192;
constexpr int CW_Q2 = 3072;
constexpr int CW_Q = 2048;
constexpr int CW_CNT = 64;
constexpr int CW_BAR = 4096;
constexpr int RING_BYTES = 131072;
constexpr int LDS_BYTES = 147456;
constexpr int LDSCTL_OFF = LDS_BYTES - 2048, MISC_OFF = LDSCTL_OFF + 320, PREF_OFF = LDSCTL_OFF + 1024;

#define GAS __attribute__((address_space(1)))
#define LAS __attribute__((address_space(3)))
typedef unsigned short bf16;
typedef unsigned v4u __attribute__((ext_vector_type(4)));
typedef unsigned v2u __attribute__((ext_vector_type(2)));
typedef float f32x4 __attribute__((ext_vector_type(4)));
typedef short bf16x8 __attribute__((ext_vector_type(8)));
typedef short s16x4 __attribute__((ext_vector_type(4)));
typedef GAS unsigned gu32;
#define RLX_AGENT __ATOMIC_RELAXED, __HIP_MEMORY_SCOPE_AGENT
#define LDS_WAIT() asm volatile("s_waitcnt lgkmcnt(0)" ::: "memory")
#define VM_WAIT() asm volatile("s_waitcnt vmcnt(0)" ::: "memory")
using pg8::cvt_pk_bf16; using pg8::bf_lo; using pg8::bf_hi; using pg8::sigmoidf_;


__device__ __forceinline__ float wave_sum(float v) {
#pragma unroll
    for (int o = 1; o < 64; o <<= 1) v += __shfl_xor(v, o);
    return v;
}
__device__ __forceinline__ float siluf_(float x) { return x * __builtin_amdgcn_rcpf(1.0f + __expf(-x)); }
__device__ __forceinline__ float gelu_tanh(float x) { const float u = 0.7978845608028654f * (x + 0.044715f * x * x * x); return x * __builtin_amdgcn_rcpf(1.0f + __expf(-2.0f * u)); }
__device__ __forceinline__ float logsigf_(float f) { return fminf(f, 0.f) - log1pf(expf(-fabsf(f))); }
__device__ __forceinline__ unsigned img_off(unsigned row, unsigned ch) { return 256u * row + 16u * (ch ^ (((row & 3u) << 2) | ((row >> 2) & 3u))); }
__device__ __forceinline__ s16x4 tr_read(LAS unsigned char* p) { return __builtin_amdgcn_ds_read_tr16_b64_v4i16((LAS s16x4*)p); }
__device__ __forceinline__ bf16x8 tr_frag(LAS unsigned char* img, unsigned r0, unsigned r1, unsigned c, int lane) {
    const unsigned q = (lane & 15) >> 2, p = lane & 3;
    const s16x4 lo = tr_read(img + img_off(r0 + q, 2 * c + (p >> 1)) + 8 * (p & 1));
    const s16x4 hi = tr_read(img + img_off(r1 + q, 2 * c + (p >> 1)) + 8 * (p & 1));
    bf16x8 r; r[0] = lo[0]; r[1] = lo[1]; r[2] = lo[2]; r[3] = lo[3]; r[4] = hi[0]; r[5] = hi[1]; r[6] = hi[2]; r[7] = hi[3]; return r;
}
__device__ __forceinline__ bf16x8 tr_frag2(LAS unsigned char* base, unsigned x0, unsigned x1) {
    const s16x4 lo = tr_read(base + x0), hi = tr_read(base + x1);
    bf16x8 r; r[0] = lo[0]; r[1] = lo[1]; r[2] = lo[2]; r[3] = lo[3]; r[4] = hi[0]; r[5] = hi[1]; r[6] = hi[2]; r[7] = hi[3]; return r;
}
#define TR_NAT_OFFS(xn0, xn1, lane) unsigned xn0[8], xn1[8]; { const unsigned g_ = (lane) >> 4, q_ = ((lane) & 15) >> 2, p_ = (lane) & 3; \
    _Pragma("unroll") for (int c_ = 0; c_ < 8; ++c_) { xn0[c_] = 256u * (8 * g_ + q_) + 16u * ((2 * c_ + (p_ >> 1)) ^ ((q_ << 2) | ((2 * g_) & 3))) + 8u * (p_ & 1); \
                                                       xn1[c_] = 256u * (8 * g_ + 4 + q_) + 16u * ((2 * c_ + (p_ >> 1)) ^ ((q_ << 2) | ((2 * g_ + 1) & 3))) + 8u * (p_ & 1); } }
#define TR_PERM_OFFS(xp, lane) unsigned xp[8]; { const unsigned g_ = (lane) >> 4, q_ = ((lane) & 15) >> 2, p_ = (lane) & 3; \
    _Pragma("unroll") for (int c_ = 0; c_ < 8; ++c_) xp[c_] = 256u * (4 * g_ + q_) + 16u * ((2 * c_ + (p_ >> 1)) ^ ((q_ << 2) | g_)) + 8u * (p_ & 1); }
__device__ __forceinline__ void load_tile128(LAS unsigned char* img, const bf16* src, size_t ld, int tid) {
#pragma unroll
    for (int i = 0; i < 4; ++i) { const int id = tid + NTHR * i, row = id >> 4, ch = id & 15;
        const v4u v = *(const v4u*)(src + (size_t)row * ld + 8 * ch); *(LAS v4u*)(img + img_off(row, ch)) = v; }
}
__device__ __forceinline__ void load_tile128_scaled(LAS unsigned char* img, const bf16* src, size_t ld, const LAS float* w, int tid) {
#pragma unroll
    for (int i = 0; i < 4; ++i) { const int id = tid + NTHR * i, row = id >> 4, ch = id & 15; const float s = w[row];
        const v4u v = *(const v4u*)(src + (size_t)row * ld + 8 * ch); v4u o;
        o.x = cvt_pk_bf16(bf_lo(v.x) * s, bf_hi(v.x) * s); o.y = cvt_pk_bf16(bf_lo(v.y) * s, bf_hi(v.y) * s); o.z = cvt_pk_bf16(bf_lo(v.z) * s, bf_hi(v.z) * s); o.w = cvt_pk_bf16(bf_lo(v.w) * s, bf_hi(v.w) * s);
        *(LAS v4u*)(img + img_off(row, ch)) = o; }
}
__device__ __forceinline__ void gate_scan(const float* G, size_t row0, int col_i, int col_f, int dir, int lane, float* bc, float* gg, float* pmx, float& b_end, float& gmax) {
    const int j0 = dir ? 127 - 2 * lane : 2 * lane, j1 = dir ? 126 - 2 * lane : 2 * lane + 1;
    const float f0 = G[(row0 + j0) * 32 + col_f], f1 = G[(row0 + j1) * 32 + col_f], i0 = G[(row0 + j0) * 32 + col_i], i1 = G[(row0 + j1) * 32 + col_i];
    const float lf0 = logsigf_(f0), lf1 = logsigf_(f1), s = lf0 + lf1; float incl = s;
#pragma unroll
    for (int o = 1; o < 64; o <<= 1) { const float t = __shfl_up(incl, o); if (lane >= o) incl += t; }
    const float b0 = (incl - s) + lf0, b1 = incl, g0 = i0 - b0, g1 = i1 - b1;
    float mincl = fmaxf(g0, g1);
#pragma unroll
    for (int o = 1; o < 64; o <<= 1) { const float t = __shfl_up(mincl, o); if (lane >= o) mincl = fmaxf(mincl, t); }
    float mexcl = __shfl_up(mincl, 1); if (lane == 0) mexcl = -3.0e38f;
    bc[j0] = b0; bc[j1] = b1; gg[j0] = g0; gg[j1] = g1; pmx[j0] = fmaxf(mexcl, g0); pmx[j1] = mincl;
    b_end = __shfl(incl, 63); gmax = __shfl(mincl, 63);
}
#define MFMA16(a, b, c) __builtin_amdgcn_mfma_f32_16x16x32_bf16((a), (b), (c), 0, 0, 0)

struct CvtItem { const float* src; size_t ldw; bf16* dst; };
constexpr int N_CONVERTERS = 128;
constexpr int N_CONV_DEFER = 1440;
constexpr int I_GEMV = 192, I_WIN = 16 * 8, I_GATE8 = 16 * 48, I_P = 16 * 8, I_W1 = 32 * 16 * 16, I_W2 = 32 * 16 * 8, I_TOTAL = I_GEMV + I_WIN + 3 * I_P + I_W1 + I_W2;
__device__ __forceinline__ CvtItem cvt_decode(int r, int tid, const float* w_in, const float* proj_a, const float* proj_b, const float* w_out, const float* exp_w1, const float* exp_w2,
                                              bf16* WINT, bf16* PAT, bf16* PBT, bf16* WOT, bf16* W1T, bf16* W2T) {
    const int n4 = tid & 63, kg = tid >> 6; const float* W; size_t ldw, ca, cb, drow; int kt; bf16* WT;
    if (r < I_WIN) { kt = r / 8; const int nt = 24 + r % 8; W = w_in; ldw = INC; ca = (size_t)256 * nt + 32; cb = ca + 128; WT = WINT; drow = (size_t)256 * nt; }
    else if ((r -= I_WIN) < 3 * I_P) { const int m = r / I_P, q = r % I_P; kt = q / 8; const int nt = q % 8; W = m == 0 ? proj_a : (m == 1 ? proj_b : w_out); ldw = 2048; ca = (size_t)256 * nt; cb = ca + 128; WT = m == 0 ? PAT : (m == 1 ? PBT : WOT); drow = (size_t)256 * nt; }
    else if ((r -= 3 * I_P) < I_W1) { const int e = r / 256, q = r % 256; kt = q / 16; const int nt = q % 16; W = exp_w1 + (size_t)e * 2048 * 4096; ldw = 4096; ca = (size_t)128 * nt; cb = 2048 + ca; WT = W1T; drow = (size_t)e * 4096 + 256 * nt; }
    else { r -= I_W1; const int e = r / 128, q = r % 128; kt = q / 8; const int nt = q % 8; W = exp_w2 + (size_t)e * 2048 * 2048; ldw = 2048; ca = (size_t)256 * nt; cb = ca + 128; WT = W2T; drow = (size_t)e * 2048 + 256 * nt; }
    CvtItem it; it.ldw = ldw; it.src = W + (size_t)(128 * kt + 8 * kg) * ldw + (n4 < 32 ? ca + 4 * n4 : cb + 4 * (n4 - 32)); it.dst = WT + drow * 2048 + 128 * kt; return it;
}
__device__ __forceinline__ void cvt_run(LAS unsigned char* lds, int tid, int it, int stride, int end, const float* w_in, const float* proj_a, const float* proj_b, const float* w_out, const float* exp_w1, const float* exp_w2,
                                        bf16* WINT, bf16* PAT, bf16* PBT, bf16* WOT, bf16* W1T, bf16* W2T) {
    const int n4 = tid & 63, kg = tid >> 6;
    f32x4 v[16]; CvtItem cur;
    bool have = it < end;
    if (have) { cur = cvt_decode(it - I_GEMV, tid, w_in, proj_a, proj_b, w_out, exp_w1, exp_w2, WINT, PAT, PBT, WOT, W1T, W2T);
#pragma unroll
        for (int i = 0; i < 16; ++i) v[i] = __builtin_nontemporal_load((const f32x4*)(cur.src + (size_t)((i >> 3) * 64 + (i & 7)) * cur.ldw)); }
    while (have) {
#pragma unroll
        for (int hf = 0; hf < 2; ++hf)
#pragma unroll
            for (int j = 0; j < 4; ++j) { v4u o; o.x = cvt_pk_bf16(v[8 * hf + 0][j], v[8 * hf + 1][j]); o.y = cvt_pk_bf16(v[8 * hf + 2][j], v[8 * hf + 3][j]); o.z = cvt_pk_bf16(v[8 * hf + 4][j], v[8 * hf + 5][j]); o.w = cvt_pk_bf16(v[8 * hf + 6][j], v[8 * hf + 7][j]);
                *(LAS v4u*)(lds + img_off(4 * n4 + j, 8 * hf + kg)) = o; }
        __syncthreads();
        bf16* dst = cur.dst;
        it += stride; have = it < end;
        if (have) { cur = cvt_decode(it - I_GEMV, tid, w_in, proj_a, proj_b, w_out, exp_w1, exp_w2, WINT, PAT, PBT, WOT, W1T, W2T);
#pragma unroll
            for (int i = 0; i < 16; ++i) v[i] = __builtin_nontemporal_load((const f32x4*)(cur.src + (size_t)((i >> 3) * 64 + (i & 7)) * cur.ldw)); }
#pragma unroll
        for (int i = 0; i < 8; ++i) { const int id = tid + NTHR * i, row = id >> 4, ch = id & 15; const v4u o = *(const LAS v4u*)(lds + img_off(row, ch)); __builtin_nontemporal_store(o, (v4u*)(dst + (size_t)row * 2048 + 8 * ch)); }
        __syncthreads();
    }
}
__device__ __forceinline__ void cvt_run8(LAS unsigned char* lds, int tid, int r, int stride, int end, const float* exp_w1, const float* exp_w2, const float* w_in, unsigned char* W1T8, unsigned char* W2T8, unsigned char* WG8) {
    const int n4 = tid & 63, kg = tid >> 6;
    f32x4 v[16]; const float* src = nullptr; size_t ldw = 0; unsigned char* dst = nullptr;
#define CVT8_DECODE(R) do { int q_ = (R); const float* W_; size_t ca_, cb_, drow_; int kt_; unsigned char* WT_; \
        if (q_ < I_W1) { const int e = q_ / 256, qq = q_ % 256; kt_ = qq / 16; const int nt = qq % 16; W_ = exp_w1 + (size_t)e * 2048 * 4096; ldw = 4096; ca_ = (size_t)128 * nt; cb_ = 2048 + ca_; WT_ = W1T8; drow_ = (size_t)e * 4096 + 256 * nt; } \
        else if (q_ < I_W1 + I_W2) { q_ -= I_W1; const int e = q_ / 128, qq = q_ % 128; kt_ = qq / 8; const int nt = qq % 8; W_ = exp_w2 + (size_t)e * 2048 * 2048; ldw = 2048; ca_ = (size_t)256 * nt; cb_ = ca_ + 128; WT_ = W2T8; drow_ = (size_t)e * 2048 + 256 * nt; } \
        else { q_ -= I_W1 + I_W2; kt_ = q_ / 48; const int ft = q_ % 48, zt = ft < 24 ? ft : ft + 8; W_ = w_in; ldw = INC; ca_ = (size_t)256 * zt + (zt >= 16 ? 32 : 0); cb_ = ca_ + 128; WT_ = WG8; drow_ = (size_t)256 * ft; } \
        src = W_ + (size_t)(128 * kt_ + 8 * kg) * ldw + (n4 < 32 ? ca_ + 4 * n4 : cb_ + 4 * (n4 - 32)); dst = WT_ + drow_ * 2048 + 128 * kt_; \
        _Pragma("unroll") for (int i = 0; i < 16; ++i) v[i] = __builtin_nontemporal_load((const f32x4*)(src + (size_t)((i >> 3) * 64 + (i & 7)) * ldw)); } while (0)
    bool have = r < end;
    if (have) CVT8_DECODE(r);
    while (have) {
#pragma unroll
        for (int hf = 0; hf < 2; ++hf)
#pragma unroll
            for (int j = 0; j < 4; ++j) { const int row = 4 * n4 + j, p8 = 8 * hf + kg; v2u o;
                o.x = pg8::pk4_fp8(v[8 * hf + 0][j] * pg8::F8_SW, v[8 * hf + 1][j] * pg8::F8_SW, v[8 * hf + 2][j] * pg8::F8_SW, v[8 * hf + 3][j] * pg8::F8_SW);
                o.y = pg8::pk4_fp8(v[8 * hf + 4][j] * pg8::F8_SW, v[8 * hf + 5][j] * pg8::F8_SW, v[8 * hf + 6][j] * pg8::F8_SW, v[8 * hf + 7][j] * pg8::F8_SW);
                *(LAS v2u*)(lds + row * 128 + 16 * ((p8 >> 1) ^ ((row >> 2) & 7)) + 8 * (p8 & 1)) = o; }
        __syncthreads();
        unsigned char* d0 = dst;
        r += stride; have = r < end;
        if (have) CVT8_DECODE(r);
#pragma unroll
        for (int i = 0; i < 4; ++i) { const int id = tid + NTHR * i, row = id >> 3, ch = id & 7; const v4u o = *(const LAS v4u*)(lds + row * 128 + 16 * (ch ^ ((row >> 2) & 7)));
            __builtin_nontemporal_store(o, (v4u*)(d0 + (size_t)row * 2048 + 16 * ch)); }
        __syncthreads();
    }
#undef CVT8_DECODE
}
__device__ __forceinline__ void p0_phase(LAS unsigned char* lds, int tid, int G, const float* c, const float* c_ctx, const float* mod_w, const float* mod_b, float* MOD,
                                         const float* w_in, const float* proj_a, const float* proj_b, const float* w_out, const float* exp_w1, const float* exp_w2, const float* router_w,
                                         bf16* WINT, bf16* PAT, bf16* PBT, bf16* WOT, bf16* W1T, bf16* W2T, bf16* SK, int n_conv_p0) {
    LAS float* sc = (LAS float*)lds;
    LAS float* red = (LAS float*)(lds + 40960);
    int it = blockIdx.x;
    if (it < I_GEMV) {
        for (int i = tid; i < 5 * 2048; i += NTHR) { const float x = i < 4 * 2048 ? c[i] : c_ctx[i - 4 * 2048]; sc[i] = siluf_(x); }
        __syncthreads();
        for (; it < I_GEMV; it += G) {
            const int j0 = 64 * it, c4 = tid & 15, kg = tid >> 4;
            f32x4 a0 = {0.f, 0.f, 0.f, 0.f}, a1 = a0, a2 = a0, a3 = a0, a4 = a0;
            const float* wp = mod_w + (size_t)kg * 12288 + j0 + 4 * c4;
#pragma unroll 8
            for (int k = kg; k < 2048; k += 32) { const f32x4 w = *(const f32x4*)wp; wp += (size_t)32 * 12288;
                a0 += w * sc[k]; a1 += w * sc[2048 + k]; a2 += w * sc[4096 + k]; a3 += w * sc[6144 + k]; a4 += w * sc[8192 + k]; }
            *(LAS f32x4*)(red + (kg * 5 + 0) * 64 + 4 * c4) = a0; *(LAS f32x4*)(red + (kg * 5 + 1) * 64 + 4 * c4) = a1; *(LAS f32x4*)(red + (kg * 5 + 2) * 64 + 4 * c4) = a2;
            *(LAS f32x4*)(red + (kg * 5 + 3) * 64 + 4 * c4) = a3; *(LAS f32x4*)(red + (kg * 5 + 4) * 64 + 4 * c4) = a4;
            __syncthreads();
            if (tid < 320) { const int rr = tid >> 6, j = tid & 63; float s = 0.f;
#pragma unroll 8
                for (int g = 0; g < 32; ++g) s += red[(g * 5 + rr) * 64 + j];
                MOD[rr * 12288 + j0 + j] = s + mod_b[j0 + j]; }
            __syncthreads();
        }
    } else {
        for (int i = (it - I_GEMV) * NTHR + tid; i < 2 * 32 * 2048; i += (G - I_GEMV) * NTHR) { const int m = i >> 16, n = (i >> 11) & 31, k = i & 2047;
            const float w = m == 0 ? w_in[(size_t)k * INC + 4096 + n] : router_w[k * 32 + n];
            const unsigned hi = cvt_pk_bf16(w, 0.f) & 0xffffu; const unsigned lo = cvt_pk_bf16(w - __uint_as_float(hi << 16), 0.f) & 0xffffu;
            SK[(size_t)(2 * m) * 65536 + n * 2048 + k] = (bf16)hi; SK[(size_t)(2 * m + 1) * 65536 + n * 2048 + k] = (bf16)lo; }
    }
    cvt_run(lds, tid, it, G, I_GEMV + n_conv_p0, w_in, proj_a, proj_b, w_out, exp_w1, exp_w2, WINT, PAT, PBT, WOT, W1T, W2T);
}

__device__ __forceinline__ void skinny_mfma(const LAS float* hrow, const bf16* WT_hi, const bf16* WT_lo, LAS float* part, int wave, int lane) {
    const int g = lane >> 4, l15 = lane & 15;
    f32x4 acc0 = {0.f, 0.f, 0.f, 0.f}, acc1 = acc0;
#pragma unroll
    for (int ks = 0; ks < 8; ++ks) { const int kb = 256 * wave + 32 * ks + 8 * g;
        f32x4 a0 = {0.f, 0.f, 0.f, 0.f}, a1 = a0;
        if (l15 < 8) { a0 = *(const LAS f32x4*)(hrow + l15 * 2048 + kb); a1 = *(const LAS f32x4*)(hrow + l15 * 2048 + kb + 4); }
        v4u hi, lo;
        hi.x = cvt_pk_bf16(a0[0], a0[1]); hi.y = cvt_pk_bf16(a0[2], a0[3]); hi.z = cvt_pk_bf16(a1[0], a1[1]); hi.w = cvt_pk_bf16(a1[2], a1[3]);
        lo.x = cvt_pk_bf16(a0[0] - bf_lo(hi.x), a0[1] - bf_hi(hi.x)); lo.y = cvt_pk_bf16(a0[2] - bf_lo(hi.y), a0[3] - bf_hi(hi.y));
        lo.z = cvt_pk_bf16(a1[0] - bf_lo(hi.z), a1[1] - bf_hi(hi.z)); lo.w = cvt_pk_bf16(a1[2] - bf_lo(hi.w), a1[3] - bf_hi(hi.w));
        const bf16x8 Ah = __builtin_bit_cast(bf16x8, hi), Al = __builtin_bit_cast(bf16x8, lo);
        const bf16x8 b0h = *(const bf16x8*)(WT_hi + (size_t)l15 * 2048 + kb), b0l = *(const bf16x8*)(WT_lo + (size_t)l15 * 2048 + kb);
        const bf16x8 b1h = *(const bf16x8*)(WT_hi + (size_t)(16 + l15) * 2048 + kb), b1l = *(const bf16x8*)(WT_lo + (size_t)(16 + l15) * 2048 + kb);
        acc0 = MFMA16(Ah, b0h, acc0); acc0 = MFMA16(Ah, b0l, acc0); acc0 = MFMA16(Al, b0h, acc0);
        acc1 = MFMA16(Ah, b1h, acc1); acc1 = MFMA16(Ah, b1l, acc1); acc1 = MFMA16(Al, b1h, acc1); }
    if (g < 2) {
#pragma unroll
        for (int r = 0; r < 4; ++r) { part[wave * 256 + (4 * g + r) * 32 + l15] = acc0[r]; part[wave * 256 + (4 * g + r) * 32 + 16 + l15] = acc1[r]; } }
}

__device__ __forceinline__ void p1_phase(LAS unsigned char* lds, int tid, int wave, int lane, int G, const float* x, const float* ctx, const float* MOD, const float* norm_g,
                                         const bf16* SK, const float* gate_b, bf16* HB, unsigned char* HB8, float* GATES) {
    LAS float* hrow = (LAS float*)(lds + wave * 8192); LAS float* part = (LAS float*)(lds + 65536);
    f32x4 v[8];
    { const int row = blockIdx.x * 8 + wave; const float* xr = row < NLAT ? x + (size_t)row * DM : ctx + (size_t)(row - NLAT) * DM;
#pragma unroll
      for (int j = 0; j < 8; ++j) v[j] = *(const f32x4*)(xr + 4 * (lane + 64 * j)); }
    for (int it = blockIdx.x; it < NTOK / 8; it += G) {
        const int row = it * 8 + wave;
        const float* shift = MOD + (size_t)(row < NLAT ? (row >> 11) : 4) * 12288; const float* scale = shift + 2048;
        float ss = 0.f;
#pragma unroll
        for (int j = 0; j < 8; ++j) ss += (v[j][0] * v[j][0] + v[j][1] * v[j][1]) + (v[j][2] * v[j][2] + v[j][3] * v[j][3]);
        const float rstd = 1.0f / sqrtf(wave_sum(ss) * (1.0f / DM) + EPS);
#pragma unroll
        for (int j = 0; j < 8; ++j) { const int col = 4 * (lane + 64 * j);
            const f32x4 g = *(const f32x4*)(norm_g + col), sc = *(const f32x4*)(scale + col), sh = *(const f32x4*)(shift + col);
            const f32x4 h = (v[j] * rstd) * g * (sc + 1.0f) + sh;
            v2u o; o.x = cvt_pk_bf16(h[0], h[1]); o.y = cvt_pk_bf16(h[2], h[3]); *(v2u*)(HB + (size_t)row * DM + col) = o;
            *(unsigned*)(HB8 + (size_t)row * DM + col) = pg8::pk4_fp8(h[0] * pg8::F8_SA, h[1] * pg8::F8_SA, h[2] * pg8::F8_SA, h[3] * pg8::F8_SA);
            *(LAS f32x4*)(hrow + col) = h; }
        if (it + G < NTOK / 8) { const int rown = (it + G) * 8 + wave; const float* xr = rown < NLAT ? x + (size_t)rown * DM : ctx + (size_t)(rown - NLAT) * DM;
#pragma unroll
            for (int j = 0; j < 8; ++j) v[j] = *(const f32x4*)(xr + 4 * (lane + 64 * j)); }
        __syncthreads();
        skinny_mfma((const LAS float*)lds, SK, SK + 65536, part, wave, lane);
        __syncthreads();
        if (tid < 256) { float s = 0.f;
#pragma unroll
            for (int w = 0; w < 8; ++w) s += part[w * 256 + tid];
            GATES[(size_t)(it * 8) * 32 + tid] = s + gate_b[tid & 31]; }
    }
}

__device__ __forceinline__ void p3_phase(int wave, int lane, int G, const bf16* Z, const float* conv_w, const float* conv_b, const float* sgu_norm_g, bf16* QC, bf16* KC, bf16* SVN,
                                         const float* GATES, float* SCN, float* BEND, float* GMAX) {
    const int gw = blockIdx.x * NWAVES + wave, NGW = G * NWAVES;
    for (int task = gw; task < 64 * NCH; task += NGW) { const int bhd = task / NCH, bi = task - bhd * NCH, dir = bhd & 1, bh = bhd >> 1, b = bh >> 3, h = bh & 7;
        const size_t row0 = bi < 2 ? (size_t)NLAT + b * TCX + bi * 128 : (size_t)b * TL + (bi - 2) * 128;
        float* sp = SCN + (size_t)task * 384; float b_end, gmax;
        gate_scan(GATES, row0, (2 * dir) * 8 + h, (2 * dir + 1) * 8 + h, dir, lane, sp, sp + 128, sp + 256, b_end, gmax);
        const int c = dir == 0 ? bi : (bi < 2 ? 1 - bi : 19 - bi);
        if (lane == 0 && c < 17) { BEND[bhd * 17 + c] = b_end; GMAX[bhd * 17 + c] = gmax; } }
    for (int item = gw; item < NTOK; item += NGW) {
        const int rb = item >> 2, seg = item & 3, row0 = rb * 4, c0 = seg * 512 + lane * 8;
        const int t0 = row0 < NLAT ? (row0 & (TL - 1)) : ((row0 - NLAT) & (TCX - 1)), len = row0 < NLAT ? TL : TCX;
        v4u zr[8];
#pragma unroll
        for (int k = 0; k < 8; ++k) { const int tt = t0 + k - 2; zr[k] = (v4u){0u, 0u, 0u, 0u};
            if (tt >= 0 && tt < len) zr[k] = *(const v4u*)(Z + (size_t)(row0 + k - 2) * ZW + c0); }
        f32x4 w0[5], w1[5];
#pragma unroll
        for (int tau = 0; tau < 5; ++tau) { w0[tau] = *(const f32x4*)(conv_w + tau * 2048 + c0); w1[tau] = *(const f32x4*)(conv_w + tau * 2048 + c0 + 4); }
        const f32x4 b0 = *(const f32x4*)(conv_b + c0), b1 = *(const f32x4*)(conv_b + c0 + 4);
        const float qs = c0 < 1024 ? 0.08838834764831845f : 1.0f;
#pragma unroll
        for (int o = 0; o < 4; ++o) { float acc[8] = {b0[0], b0[1], b0[2], b0[3], b1[0], b1[1], b1[2], b1[3]};
#pragma unroll
            for (int tau = 0; tau < 5; ++tau) { const v4u z = zr[o + tau];
                acc[0] += w0[tau][0] * bf_lo(z.x); acc[1] += w0[tau][1] * bf_hi(z.x); acc[2] += w0[tau][2] * bf_lo(z.y); acc[3] += w0[tau][3] * bf_hi(z.y);
                acc[4] += w1[tau][0] * bf_lo(z.z); acc[5] += w1[tau][1] * bf_hi(z.z); acc[6] += w1[tau][2] * bf_lo(z.w); acc[7] += w1[tau][3] * bf_hi(z.w); }
#pragma unroll
            for (int i = 0; i < 8; ++i) acc[i] = siluf_(acc[i]) * qs;
            v4u ov; ov.x = cvt_pk_bf16(acc[0], acc[1]); ov.y = cvt_pk_bf16(acc[2], acc[3]); ov.z = cvt_pk_bf16(acc[4], acc[5]); ov.w = cvt_pk_bf16(acc[6], acc[7]);
            bf16* dst = c0 < 1024 ? QC + (size_t)(row0 + o) * 1024 + c0 : KC + (size_t)(row0 + o) * 1024 + (c0 - 1024);
            *(v4u*)dst = ov; }
    }
    for (int row = gw; row < NLAT; row += NGW) {
        float v[32]; float ss = 0.f;
#pragma unroll
        for (int j = 0; j < 4; ++j) { const v4u z = *(const v4u*)(Z + (size_t)row * ZW + ZS + 8 * lane + 512 * j);
            v[8 * j + 0] = gelu_tanh(bf_lo(z.x)); v[8 * j + 1] = gelu_tanh(bf_hi(z.x)); v[8 * j + 2] = gelu_tanh(bf_lo(z.y)); v[8 * j + 3] = gelu_tanh(bf_hi(z.y));
            v[8 * j + 4] = gelu_tanh(bf_lo(z.z)); v[8 * j + 5] = gelu_tanh(bf_hi(z.z)); v[8 * j + 6] = gelu_tanh(bf_lo(z.w)); v[8 * j + 7] = gelu_tanh(bf_hi(z.w)); }
#pragma unroll
        for (int i = 0; i < 32; ++i) ss += v[i] * v[i];
        const float rstd = 1.0f / sqrtf(wave_sum(ss) * (1.0f / DM) + EPS);
#pragma unroll
        for (int j = 0; j < 4; ++j) { const int col = 8 * lane + 512 * j; const f32x4 g0 = *(const f32x4*)(sgu_norm_g + col), g1 = *(const f32x4*)(sgu_norm_g + col + 4);
            v4u o; o.x = cvt_pk_bf16(v[8 * j] * rstd * g0[0], v[8 * j + 1] * rstd * g0[1]); o.y = cvt_pk_bf16(v[8 * j + 2] * rstd * g0[2], v[8 * j + 3] * rstd * g0[3]);
            o.z = cvt_pk_bf16(v[8 * j + 4] * rstd * g1[0], v[8 * j + 5] * rstd * g1[1]); o.w = cvt_pk_bf16(v[8 * j + 6] * rstd * g1[2], v[8 * j + 7] * rstd * g1[3]);
            *(v4u*)(SVN + (size_t)row * DM + col) = o; }
    }
}

constexpr int L_V0 = 0, L_V1 = 32768, L_K = 65536, L_SC = 98304, L_CB = 106496;
constexpr int N_M1 = 64 * 17, N_SGU = 512;
__device__ __forceinline__ void p4_phase(LAS unsigned char* lds, int tid_, int wave, int lane_, int G, const bf16* Z, const bf16* KC, const bf16* SVN, const float* SCN,
                                         const float* sgu_w, const float* sgu_b, bf16* DC, const float* GMAX, bf16* CM) {
    v4u pk[4], pv[8]; f32x4 pa[2];
#define P4_ISSUE(U) do { const int u_ = (U); int t_ = tid_; asm volatile("" : "+v"(t_)); \
        if (u_ < N_M1) { const int bhd_ = u_ / 17, c_ = u_ - bhd_ * 17, dir_ = bhd_ & 1, bh_ = bhd_ >> 1, b_ = bh_ >> 3, h_ = bh_ & 7; \
            const bool ic_ = c_ < 2; const int blk_ = dir_ == 0 ? (ic_ ? c_ : c_ - 2) : (ic_ ? 1 - c_ : 17 - c_); \
            const size_t r0_ = ic_ ? (size_t)NLAT + b_ * TCX + blk_ * 128 : (size_t)b_ * TL + blk_ * 128; \
            const float* sp_ = SCN + (size_t)(bhd_ * NCH + (ic_ ? blk_ : blk_ + 2)) * 384; \
            _Pragma("unroll") for (int i = 0; i < 4; ++i) { const int id = t_ + NTHR * i; pk[i] = *(const v4u*)(KC + (r0_ + (id >> 4)) * 1024 + h_ * QKD + 8 * (id & 15)); pa[0][i] = sp_[128 + (id >> 4)]; } \
            pa[1][0] = GMAX[bhd_ * 17 + c_]; \
            _Pragma("unroll") for (int i = 0; i < 8; ++i) { const int id = t_ + NTHR * (i & 3); pv[i] = *(const v4u*)(Z + (r0_ + (id >> 4)) * ZW + ZV + h_ * VD + 128 * (i >> 2) + 8 * (id & 15)); } \
        } else { const int u2_ = u_ - N_M1, b_ = u2_ >> 7, n_ = (u2_ >> 3) & 15, grp_ = u2_ & 7; const size_t r0_ = (size_t)b_ * TL + n_ * 128; \
            _Pragma("unroll") for (int i = 0; i < 8; ++i) { const int id = t_ + NTHR * (i & 3); pv[i] = *(const v4u*)(SVN + (r0_ + (id >> 4)) * DM + grp_ * 256 + 128 * (i >> 2) + 8 * (id & 15)); } \
            } } while (0)
    int u = blockIdx.x;
    if (u < N_M1 + N_SGU) P4_ISSUE(u);
    for (; u < N_M1 + N_SGU; u += G) {
        int tid = tid_; asm volatile("" : "+v"(tid)); const int lane = tid & 63; const unsigned g = lane >> 4, l15 = lane & 15;
        const bool m1 = u < N_M1;
        TR_NAT_OFFS(xn0, xn1, lane)
#pragma unroll
        for (int i = 0; i < 8; ++i) { const int id = tid + NTHR * (i & 3); *(LAS v4u*)(lds + ((i >> 2) ? L_V1 : L_V0) + img_off(id >> 4, id & 15)) = pv[i]; }
        bf16x8 Af[4]; v2u uw[16];
        if (m1) { const float gmax = pa[1][0];
#pragma unroll
            for (int i = 0; i < 4; ++i) { const int id = tid + NTHR * i, row = id >> 4, ch = id & 15; const float sw = __expf(pa[0][i] - gmax); const v4u v = pk[i]; v4u o;
                o.x = cvt_pk_bf16(bf_lo(v.x) * sw, bf_hi(v.x) * sw); o.y = cvt_pk_bf16(bf_lo(v.y) * sw, bf_hi(v.y) * sw); o.z = cvt_pk_bf16(bf_lo(v.z) * sw, bf_hi(v.z) * sw); o.w = cvt_pk_bf16(bf_lo(v.w) * sw, bf_hi(v.w) * sw);
                *(LAS v4u*)(lds + L_K + img_off(row, ch)) = o; }
        }
        __syncthreads();
        f32x4 af32[8];
        if (!m1) { const int u2 = u - N_M1, b = u2 >> 7, n = (u2 >> 3) & 15, grp = u2 & 7;
            const float* src = sgu_w + (size_t)grp * 16384 + (size_t)(16 * wave + l15) * 128 + 8 * g;
#pragma unroll
            for (int ks = 0; ks < 4; ++ks) { af32[2 * ks] = *(const f32x4*)(src + 32 * ks); af32[2 * ks + 1] = *(const f32x4*)(src + 32 * ks + 4); }
            const bf16* up = Z + ((size_t)b * TL + n * 128 + 16 * wave + l15) * ZW + ZU + grp * 256 + 4 * g;
#pragma unroll
            for (int et = 0; et < 16; ++et) uw[et] = *(const v2u*)(up + 16 * et); }
        if (u + G < N_M1 + N_SGU) P4_ISSUE(u + G);
        if (!m1) {
#pragma unroll
            for (int ks = 0; ks < 4; ++ks) { const f32x4 a = af32[2 * ks], b2 = af32[2 * ks + 1];
                const v4u p = {cvt_pk_bf16(a[0], a[1]), cvt_pk_bf16(a[2], a[3]), cvt_pk_bf16(b2[0], b2[1]), cvt_pk_bf16(b2[2], b2[3])}; Af[ks] = __builtin_bit_cast(bf16x8, p); } }
        if (m1) {
            const int bhd = u / 17, c = u - bhd * 17;
#pragma unroll
            for (int ks = 0; ks < 4; ++ks) Af[ks] = tr_frag(lds + L_K, 32 * ks + 8 * g, 32 * ks + 8 * g + 4, wave, lane);
            f32x4 acc[17];
#pragma unroll
            for (int et = 0; et < 17; ++et) acc[et] = (f32x4){0.f, 0.f, 0.f, 0.f};
#pragma unroll
            for (int et = 0; et < 16; ++et) { LAS unsigned char* img = lds + ((et >> 3) ? L_V1 : L_V0);
#pragma unroll
                for (int ks = 0; ks < 4; ++ks) { const bf16x8 Bf = tr_frag2(img + 8192 * ks, xn0[et & 7], xn1[et & 7]); acc[et] = MFMA16(Af[ks], Bf, acc[et]); } }
            { const short one = l15 == 0 ? (short)0x3F80 : (short)0; const bf16x8 Bo = {one, one, one, one, one, one, one, one};
#pragma unroll
                for (int ks = 0; ks < 4; ++ks) acc[16] = MFMA16(Af[ks], Bo, acc[16]); }
            bf16* dst = DC + ((size_t)bhd * 17 + c) * (CROWS * 128) + 16 * wave + 4 * g;
#pragma unroll
            for (int et = 0; et < 16; ++et) { v2u o; o.x = cvt_pk_bf16(acc[et][0], acc[et][1]); o.y = cvt_pk_bf16(acc[et][2], acc[et][3]); *(v2u*)(dst + (size_t)(16 * et + l15) * 128) = o; }
            if (l15 == 0) { v2u o; o.x = cvt_pk_bf16(acc[16][0], acc[16][1]); o.y = cvt_pk_bf16(acc[16][2], acc[16][3]); *(v2u*)(dst + (size_t)256 * 128) = o; }
        } else {
            const int u2 = u - N_M1, b = u2 >> 7, n = (u2 >> 3) & 15, grp = u2 & 7; const size_t row0 = (size_t)b * TL + n * 128;
            f32x4 acc[16];
#pragma unroll
            for (int et = 0; et < 16; ++et) { acc[et] = (f32x4){0.f, 0.f, 0.f, 0.f}; LAS unsigned char* img = lds + ((et >> 3) ? L_V1 : L_V0);
#pragma unroll
                for (int ks = 0; ks < 4; ++ks) { const bf16x8 Bf = tr_frag2(img + 8192 * ks, xn0[et & 7], xn1[et & 7]); acc[et] = MFMA16(Bf, Af[ks], acc[et]); } }
            { const int t = 16 * wave + l15; const float zb = sgu_b[grp * 128 + t]; const size_t row = row0 + t;
#pragma unroll
              for (int et = 0; et < 16; ++et) { const int col = grp * 256 + 16 * et + 4 * g; const v2u w2 = uw[et];
                  const float o0 = gelu_tanh(bf_lo(w2.x)) * (acc[et][0] + zb), o1 = gelu_tanh(bf_hi(w2.x)) * (acc[et][1] + zb), o2 = gelu_tanh(bf_lo(w2.y)) * (acc[et][2] + zb), o3 = gelu_tanh(bf_hi(w2.y)) * (acc[et][3] + zb);
                  v2u o; o.x = cvt_pk_bf16(o0, o1); o.y = cvt_pk_bf16(o2, o3); *(v2u*)(CM + row * DM + col) = o; } }
        }
        __syncthreads();
    }
#undef P4_ISSUE
}

__device__ __forceinline__ void p5_scan(int tid, int G, const bf16* DC, const float* BEND, const float* GMAX, bf16* CS, float* MST) {
    constexpr int QPB = 257 * 128 / 4;
    for (int idx = blockIdx.x * NTHR + tid; idx < 64 * QPB; idx += G * NTHR) {
        const int bhd = idx / QPB, q = idx - bhd * QPB;
        f32x4 C = {0.f, 0.f, 0.f, 0.f}; float m = 0.f;
#pragma unroll
        for (int c = 0; c < 17; ++c) {
            const float gm = GMAX[bhd * 17 + c], be = BEND[bhd * 17 + c], mx = fmaxf(m, gm), al = __expf(m - mx), bt = __expf(gm - mx);
            const v2u dw = *(const v2u*)(DC + ((size_t)bhd * 17 + c) * (CROWS * 128) + 4 * q); const f32x4 d = {bf_lo(dw.x), bf_hi(dw.x), bf_lo(dw.y), bf_hi(dw.y)};
            C = C * al + d * bt; m = be + mx;
            if (c >= 1) { v2u o; o.x = cvt_pk_bf16(C[0], C[1]); o.y = cvt_pk_bf16(C[2], C[3]);
                *(v2u*)(CS + ((size_t)bhd * 16 + (c - 1)) * (CROWS * 128) + 4 * q) = o; if (q == 0) MST[bhd * 18 + c + 1] = m; }
        }
    }
}

__device__ __forceinline__ void p6_phase(LAS unsigned char* lds, int tid, int wave, int lane_, int G, const bf16* Z, const bf16* QC, const bf16* KC, const float* SCN,
                                         const bf16* CS, const float* MST, const float* mnorm_g, bf16* RO) {
    for (int u = blockIdx.x; u < 512; u += G) {
        int lane = lane_; asm volatile("" : "+v"(lane)); const unsigned g = lane >> 4, l15 = lane & 15;
        const int bh = u >> 4, jb = u & 15, b = bh >> 3, h = bh & 7; const size_t row0 = (size_t)b * TL + jb * 128;
        load_tile128(lds + L_K, KC + row0 * 1024 + h * QKD, 1024, tid);
        load_tile128(lds + L_V0, Z + row0 * ZW + ZV + h * VD, ZW, tid);
        load_tile128(lds + L_V1, Z + row0 * ZW + ZV + h * VD + 128, ZW, tid);
        bf16x8 Qf[4];
#pragma unroll
        for (int ks = 0; ks < 4; ++ks) Qf[ks] = *(const bf16x8*)(QC + (row0 + 16 * wave + l15) * 1024 + h * QKD + 32 * ks + 8 * g);
        __syncthreads();
        f32x4 hsum[16];
#pragma unroll
        for (int et = 0; et < 16; ++et) hsum[et] = (f32x4){0.f, 0.f, 0.f, 0.f};
#pragma unroll 1
        for (int dir = 0; dir < 2; ++dir) {
            int lane = lane_; asm volatile("" : "+v"(lane));
            const unsigned g = lane >> 4, l15 = lane & 15;
            TR_PERM_OFFS(xp, lane)
            const int c = dir ? 17 - jb : 2 + jb; const bf16* cs = CS + ((size_t)(bh * 2 + dir) * 16 + (c - 2)) * (CROWS * 128);
            const float* sp = SCN + (size_t)((bh * 2 + dir) * NCH + 2 + jb) * 384; const float* gg = sp + 128; const float mc = MST[(bh * 2 + dir) * 18 + c];
            const int tS = 16 * wave + l15; const float MtS = fmaxf(mc, sp[256 + tS]);
            unsigned pw[16];
#pragma unroll
            for (int st = 0; st < 8; ++st) { f32x4 aS = {0.f, 0.f, 0.f, 0.f};
#pragma unroll
                for (int ks = 0; ks < 4; ++ks) { const bf16x8 Kf = *(const LAS bf16x8*)(lds + L_K + img_off(16 * st + l15, 4 * ks + g)); aS = MFMA16(Kf, Qf[ks], aS); }
                float pv[4]; const f32x4 gs = *(const f32x4*)(gg + 16 * st + 4 * g);
#pragma unroll
                for (int r = 0; r < 4; ++r) { const int s = 16 * st + 4 * g + r; const bool ok = dir ? (s >= tS) : (s <= tS); const float ev = __expf(fminf(gs[r] - MtS, 0.f)); pv[r] = ok ? aS[r] * ev : 0.f; }
                pw[2 * st] = cvt_pk_bf16(pv[0], pv[1]); pw[2 * st + 1] = cvt_pk_bf16(pv[2], pv[3]); asm volatile("" ::: "memory"); }
            bf16x8 Pf[4];
#pragma unroll
            for (int ks = 0; ks < 4; ++ks) { const v4u t4 = {pw[4 * ks], pw[4 * ks + 1], pw[4 * ks + 2], pw[4 * ks + 3]}; Pf[ks] = __builtin_bit_cast(bf16x8, t4); }
            const float wiT = __expf(mc - MtS), flT = __expf(-(sp[tS] + MtS));
            const short one = l15 == 0 ? (short)0x3F80 : (short)0; const bf16x8 Bo = {one, one, one, one, one, one, one, one};
            float inv;
            { f32x4 ad = {0.f, 0.f, 0.f, 0.f};
#pragma unroll
              for (int ks = 0; ks < 4; ++ks) { bf16x8 Cf = *(const bf16x8*)(cs + (size_t)256 * 128 + 32 * ks + 8 * g); if (l15 != 0) Cf = (bf16x8){0, 0, 0, 0, 0, 0, 0, 0}; ad = MFMA16(Cf, Qf[ks], ad); }
              ad[0] *= wiT;
#pragma unroll
              for (int ks = 0; ks < 4; ++ks) ad = MFMA16(Bo, Pf[ks], ad);
              const float den = __shfl(ad[0], lane & 15); inv = 1.0f / fmaxf(fabsf(den), flT); }
            { v4u cr[2];
#pragma unroll
              for (int i = 0; i < 2; ++i) { const int id = tid + NTHR * i; cr[i] = *(const v4u*)(cs + (size_t)(id >> 4) * 128 + 8 * (id & 15)); }
#pragma unroll
              for (int i = 0; i < 2; ++i) { const int id = tid + NTHR * i; *(LAS v4u*)(lds + L_CB + img_off(id >> 4, id & 15)) = cr[i]; }
#pragma unroll
              for (int gq = 0; gq < 4; ++gq) {
                LAS unsigned char* cb = lds + L_CB + (gq & 1) * 16384;
                __syncthreads();
                if (gq < 3) {
#pragma unroll
                    for (int i = 0; i < 2; ++i) { const int id = tid + NTHR * i; cr[i] = *(const v4u*)(cs + (size_t)(64 * (gq + 1) + (id >> 4)) * 128 + 8 * (id & 15)); } }
                f32x4 acc[4];
#pragma unroll
                for (int i = 0; i < 4; ++i) { acc[i] = (f32x4){0.f, 0.f, 0.f, 0.f};
#pragma unroll
                    for (int ks = 0; ks < 4; ++ks) { const bf16x8 Cf = *(const LAS bf16x8*)(cb + img_off(16 * i + l15, 4 * ks + g)); acc[i] = MFMA16(Cf, Qf[ks], acc[i]); } }
#pragma unroll
                for (int i = 0; i < 4; ++i) acc[i] = acc[i] * wiT;
                { LAS unsigned char* img = lds + ((gq >> 1) ? L_V1 : L_V0);
#pragma unroll
                  for (int i = 0; i < 4; ++i) {
#pragma unroll
                    for (int ks = 0; ks < 4; ++ks) { const bf16x8 Vf = tr_frag2(img + 8192 * ks, xp[4 * (gq & 1) + i], xp[4 * (gq & 1) + i] + 4096u); acc[i] = MFMA16(Vf, Pf[ks], acc[i]); } } }
#pragma unroll
                for (int i = 0; i < 4; ++i) hsum[4 * gq + i] += acc[i] * inv;
                if (gq < 3) {
#pragma unroll
                    for (int i = 0; i < 2; ++i) { const int id = tid + NTHR * i; *(LAS v4u*)(lds + L_CB + ((gq + 1) & 1) * 16384 + img_off(id >> 4, id & 15)) = cr[i]; } }
              } }
        }
        { float ss = 0.f;
#pragma unroll
          for (int et = 0; et < 16; ++et) ss += (hsum[et][0] * hsum[et][0] + hsum[et][1] * hsum[et][1]) + (hsum[et][2] * hsum[et][2] + hsum[et][3] * hsum[et][3]);
          ss += __shfl_xor(ss, 16); ss += __shfl_xor(ss, 32);
          const float rstd = 1.0f / sqrtf(ss * (1.0f / VD) + EPS); const size_t row = row0 + 16 * wave + l15;
#pragma unroll
          for (int et = 0; et < 16; ++et) { const int col = h * VD + 16 * et + 4 * g;
              const v2u ow = *(const v2u*)(Z + row * ZW + ZO + col); const f32x4 gn = *(const f32x4*)(mnorm_g + col);
              const float v0 = hsum[et][0] * rstd * gn[0] * sigmoidf_(bf_lo(ow.x)), v1 = hsum[et][1] * rstd * gn[1] * sigmoidf_(bf_hi(ow.x));
              const float v2 = hsum[et][2] * rstd * gn[2] * sigmoidf_(bf_lo(ow.y)), v3 = hsum[et][3] * rstd * gn[3] * sigmoidf_(bf_hi(ow.y));
              v2u o; o.x = cvt_pk_bf16(v0, v1); o.y = cvt_pk_bf16(v2, v3); *(v2u*)(RO + row * DM + col) = o; } }
        __syncthreads();
    }
}

__device__ __forceinline__ void p9_phase(LAS unsigned char* lds, int wave, int lane, int G, const float* X1, const float* MOD, const float* norm_g, const bf16* SK, const float* router_b,
                                         unsigned* cnt, unsigned char* XG, int* RE, int* RR, float* RG) {
    LAS float* hrow = (LAS float*)(lds + wave * 8192); LAS float* part = (LAS float*)(lds + 65536);
    f32x4 vn[8];
    { const float* xr = X1 + (size_t)(blockIdx.x * 8 + wave) * DM;
#pragma unroll
      for (int j = 0; j < 8; ++j) vn[j] = *(const f32x4*)(xr + 4 * (lane + 64 * j)); }
    for (int it = blockIdx.x; it < NLAT / 8; it += G) {
        const int row = it * 8 + wave;
        const float* shift = MOD + (size_t)(row >> 11) * 12288 + 3 * 2048; const float* scale = shift + 2048;
        f32x4 v[8]; float ss = 0.f;
#pragma unroll
        for (int j = 0; j < 8; ++j) { v[j] = vn[j]; ss += (v[j][0] * v[j][0] + v[j][1] * v[j][1]) + (v[j][2] * v[j][2] + v[j][3] * v[j][3]); }
        const float rstd = 1.0f / sqrtf(wave_sum(ss) * (1.0f / DM) + EPS);
#pragma unroll
        for (int j = 0; j < 8; ++j) { const int col = 4 * (lane + 64 * j);
            const f32x4 g = *(const f32x4*)(norm_g + col), sc = *(const f32x4*)(scale + col), sh = *(const f32x4*)(shift + col);
            v[j] = (v[j] * rstd) * g * (sc + 1.0f) + sh; *(LAS f32x4*)(hrow + col) = v[j]; }
        if (it + G < NLAT / 8) { const float* xr = X1 + (size_t)((it + G) * 8 + wave) * DM;
#pragma unroll
            for (int j = 0; j < 8; ++j) vn[j] = *(const f32x4*)(xr + 4 * (lane + 64 * j)); }
        __syncthreads();
        skinny_mfma((const LAS float*)lds, SK + 2 * 65536, SK + 3 * 65536, part, wave, lane);
        __syncthreads();
        float val = router_b[lane & 31];
#pragma unroll
        for (int w = 0; w < 8; ++w) val += part[w * 256 + wave * 32 + (lane & 31)];
        float sv[4]; int si[4];
#pragma unroll
        for (int k = 0; k < 4; ++k) { float bv = val; int bi = lane & 31;
#pragma unroll
            for (int o = 16; o >= 1; o >>= 1) { const float ov = __shfl_xor(bv, o); const int oi = __shfl_xor(bi, o); const bool take = (ov > bv) || (ov == bv && oi < bi); bv = take ? ov : bv; bi = take ? oi : bi; }
            sv[k] = bv; si[k] = __builtin_amdgcn_readfirstlane(bi); if ((lane & 31) == bi) val = -3.0e38f; }
        const float e1 = __expf(sv[1] - sv[0]), e2 = __expf(sv[2] - sv[0]), e3 = __expf(sv[3] - sv[0]), inv = 1.0f / (1.0f + e1 + e2 + e3);
        const float gk[4] = {inv, e1 * inv, e2 * inv, e3 * inv};
        unsigned rank = 0;
        if (lane < 4) rank = __hip_atomic_fetch_add(cnt + (lane == 0 ? si[0] : lane == 1 ? si[1] : lane == 2 ? si[2] : si[3]), 1u, RLX_AGENT);
#pragma unroll
        for (int k = 0; k < 4; ++k) { const unsigned rk = (unsigned)__builtin_amdgcn_readlane((int)rank, k);
            unsigned char* dst = XG + ((size_t)si[k] * 8192 + rk) * DM;
#pragma unroll
            for (int j = 0; j < 8; ++j) *(unsigned*)(dst + 4 * (lane + 64 * j)) = pg8::pk4_fp8(v[j][0] * pg8::F8_SA, v[j][1] * pg8::F8_SA, v[j][2] * pg8::F8_SA, v[j][3] * pg8::F8_SA);
            if (lane == 0) { RE[row * 4 + k] = si[k]; RR[row * 4 + k] = (int)rk; RG[row * 4 + k] = gk[k]; } }
    }
}
__device__ __forceinline__ void moe_prefix(LAS int* pref, const unsigned* cnt, int tid) {
    if (tid == 0) { int s = 0; for (int e = 0; e < 32; ++e) { const unsigned ce = __hip_atomic_load(cnt + e, RLX_AGENT); pref[e] = s; pref[33 + e] = (int)ce; s += (int)((ce + 255u) >> 8); } pref[32] = s; }
    __syncthreads();
}
__device__ __forceinline__ void p12_phase(const LAS int* pref, int wave, int lane_, int G, const float* X1, const float* MOD, const bf16* Y2, const int* RE, const int* RR, const float* RG, const float* final_g, float* out) {
    const int gw = blockIdx.x * NWAVES + wave, NGW = G * NWAVES;
    int en[4], rn[4]; float gn[4];
    if (gw < NLAT) {
#pragma unroll
        for (int k = 0; k < 4; ++k) { en[k] = RE[gw * 4 + k]; rn[k] = RR[gw * 4 + k]; gn[k] = RG[gw * 4 + k]; } }
    for (int row = gw; row < NLAT; row += NGW) {
        int lane = lane_; asm volatile("" : "+v"(lane));
        const float* xr = X1 + (size_t)row * DM + 4 * lane; f32x4 xv[8]; v2u yv[4][8]; float gt[4];
#pragma unroll
        for (int k = 0; k < 4; ++k) { gt[k] = gn[k]; const bf16* src = Y2 + ((size_t)pref[en[k]] * 256 + rn[k]) * DM + 4 * lane;
#pragma unroll
            for (int j = 0; j < 8; ++j) yv[k][j] = __builtin_nontemporal_load((const v2u*)(src + 256 * j)); }
#pragma unroll
        for (int j = 0; j < 8; ++j) xv[j] = __builtin_nontemporal_load((const f32x4*)(xr + 256 * j));
        if (row + NGW < NLAT) { const int r2 = row + NGW;
#pragma unroll
            for (int k = 0; k < 4; ++k) { en[k] = RE[r2 * 4 + k]; rn[k] = RR[r2 * 4 + k]; gn[k] = RG[r2 * 4 + k]; } }
        const float* g5 = MOD + (size_t)(row >> 11) * 12288 + 5 * 2048; float ss = 0.f;
#pragma unroll
        for (int j = 0; j < 8; ++j) { f32x4 ys = {0.f, 0.f, 0.f, 0.f};
#pragma unroll
            for (int k = 0; k < 4; ++k) { const v2u y = yv[k][j]; ys[0] += gt[k] * bf_lo(y.x); ys[1] += gt[k] * bf_hi(y.x); ys[2] += gt[k] * bf_lo(y.y); ys[3] += gt[k] * bf_hi(y.y); }
            const int col = 4 * (lane + 64 * j); const f32x4 x2 = xv[j] + *(const f32x4*)(g5 + col) * ys; xv[j] = x2;
            ss += (x2[0] * x2[0] + x2[1] * x2[1]) + (x2[2] * x2[2] + x2[3] * x2[3]); }
        const float rstd = 1.0f / sqrtf(wave_sum(ss) * (1.0f / DM) + EPS);
#pragma unroll
        for (int j = 0; j < 8; ++j) { const int col = 4 * (lane + 64 * j); __builtin_nontemporal_store(xv[j] * rstd * *(const f32x4*)(final_g + col), (f32x4*)(out + (size_t)row * DM + col)); }
    }
}

#define XB_TMO      128
#define XB_XCNT(j)  (256  + 64 * (j))
#define XB_XSUB(j)  (1280 + 64 * (j))
#define XB_XGEN(j)  (2304 + 64 * (j))
#define XB_TOP      3328
#define XB_TOPGEN   3392
#define XCD_BAR_WORDS 3456
#define XB_SPIN_CAP (1u << 18)

__device__ __forceinline__ unsigned xb_ld(unsigned* p)              { return __hip_atomic_load(p, __ATOMIC_RELAXED, __HIP_MEMORY_SCOPE_AGENT); }
__device__ __forceinline__ unsigned xb_add(unsigned* p, unsigned v) { return __hip_atomic_fetch_add(p, v, __ATOMIC_RELAXED, __HIP_MEMORY_SCOPE_AGENT); }
__device__ __forceinline__ unsigned xb_xcc_id() { return (unsigned)__builtin_amdgcn_s_getreg((3 << 11) | 20) & 0xFu; }
#define XB_SPIN(cond, bar) do { unsigned _sp = 0; while (cond) { __builtin_amdgcn_s_sleep(1); \
    if ((++_sp & 255u) == 0u) { if (xb_ld(&(bar)[XB_TMO])) break; if (_sp > XB_SPIN_CAP) { atomicAdd(&(bar)[XB_TMO], 1u); break; } } } } while (0)

struct XcdBarrier {
    unsigned* bar; unsigned x;
    volatile LAS unsigned* st;
};

__device__ __forceinline__ XcdBarrier xcd_barrier_post(unsigned* bar, volatile LAS unsigned* st) {
    XcdBarrier b; b.bar = bar; b.x = xb_xcc_id(); b.st = st;
    if (threadIdx.x == 0) (void)xb_add(&bar[XB_XCNT(b.x)], 1u);
    return b;
}
__device__ __forceinline__ void xcd_barrier_complete(unsigned* bar, unsigned x, unsigned& nloc, unsigned& nx) {
    const unsigned G = gridDim.x * gridDim.y * gridDim.z;
    unsigned sum, cnt, mine, sp = 0u;
    for (;;) {
        sum = 0u; cnt = 0u; mine = 0u;
#pragma unroll
        for (unsigned j = 0; j < 16; ++j) { const unsigned c = xb_ld(&bar[XB_XCNT(j)]); sum += c; cnt += (c > 0u) ? 1u : 0u; mine = (j == x) ? c : mine; }
        if (sum == G) break;
        __builtin_amdgcn_s_sleep(1);
        if ((++sp & 255u) == 0u) { if (xb_ld(&bar[XB_TMO])) break; if (sp > XB_SPIN_CAP) { atomicAdd(&bar[XB_TMO], 1u); break; } }
    }
    nloc = mine > 0u ? mine : 1u; nx = cnt > 0u ? cnt : 1u;
}

__device__ __forceinline__ void xcd_barrier(const XcdBarrier& b) {
    asm volatile("s_waitcnt vmcnt(0)" ::: "memory");
    __syncthreads();
    if (threadIdx.x == 0) {
        unsigned* bar = b.bar;
        __builtin_amdgcn_s_waitcnt(0);
        unsigned nloc = b.st[0], nx = b.st[1];
        if (nloc == 0u) { xcd_barrier_complete(bar, b.x, nloc, nx); b.st[0] = nloc; b.st[1] = nx; }
        const unsigned old = xb_add(&bar[XB_XSUB(b.x)], 1u);
        const unsigned gen = old / nloc;
        if (old + 1u == (gen + 1u) * nloc) {
            __builtin_amdgcn_fence(__ATOMIC_RELEASE, "agent");
            asm volatile("s_waitcnt vmcnt(0)" ::: "memory");
            const unsigned og = xb_add(&bar[XB_TOP], 1u);
            const unsigned tg = og / nx;
            if (og + 1u == (tg + 1u) * nx) xb_add(&bar[XB_TOPGEN], 1u);
            else XB_SPIN(xb_ld(&bar[XB_TOPGEN]) == tg, bar);
            __builtin_amdgcn_fence(__ATOMIC_ACQUIRE, "agent");
            xb_add(&bar[XB_XGEN(b.x)], 1u);
            asm volatile("s_waitcnt vmcnt(0)" ::: "memory");
        } else {
            XB_SPIN(xb_ld(&bar[XB_XGEN(b.x)]) == gen, bar);
            __builtin_amdgcn_fence(__ATOMIC_ACQUIRE, "agent");
            asm volatile("s_waitcnt vmcnt(0)" ::: "memory");
        }
    }
    __syncthreads();
}

struct Args { const float* in[26]; float* out; unsigned char* ws; int ph_lo, ph_hi; };
__global__ void __launch_bounds__(NTHR, 2) mk_fwd(Args args) {
    extern __shared__ __attribute__((aligned(16))) unsigned char lds_raw[];
    LAS unsigned char* lds = (LAS unsigned char*)lds_raw;
    const int tid = threadIdx.x, lane = tid & 63, wave = __builtin_amdgcn_readfirstlane(tid >> 6), G = gridDim.x;
    unsigned char* ws = args.ws;
    gu32* ctl = (gu32*)(ws + WS_CTL);
    for (int u = tid; u < (LDS_BYTES - LDSCTL_OFF) / 4; u += NTHR) ((LAS unsigned*)(lds + LDSCTL_OFF))[u] = 0u;
    __syncthreads();
    volatile LAS unsigned* MISC = (volatile LAS unsigned*)(lds + MISC_OFF);
    XcdBarrier bar; bar.bar = (unsigned*)(ctl + CW_BAR); bar.x = 0; bar.st = nullptr;
    if (N_LAUNCHES == 1) bar = xcd_barrier_post((unsigned*)(ctl + CW_BAR), MISC + 8);
#define GRID_BAR() do { if (N_LAUNCHES == 1) xcd_barrier(bar); } while (0)
    const int lo = args.ph_lo, hi = args.ph_hi;
#ifdef ONLY_PHASE
#define IN(k) ((k) == ONLY_PHASE && lo <= (k) && (k) < hi)
#else
#define IN(k) (lo <= (k) && (k) < hi)
#endif
#define BOTH(k) (IN(k) && IN((k) + 1))
#ifndef REP_MASK
#define REP_MASK 0
#endif
#define NREP(k) ((((REP_MASK) >> (k)) & 1) ? 2 : 1)
#define INP(i) (args.in[i])
#define WSF(off) ((float*)(ws + (off)))
#define WSB(off) ((bf16*)(ws + (off)))
#define WSI(off) ((int*)(ws + (off)))
    unsigned* cnt = (unsigned*)(ctl + CW_CNT);
    LAS int* pref = (LAS int*)(lds + PREF_OFF);
    const int n_conv_p0 = I_WIN + 3 * I_P;
#define x_in INP(0)
#define cvec INP(1)
#define ctx INP(2)
#define c_ctx INP(3)
#define mod_w INP(4)
#define mod_b INP(5)
#define norm1_g INP(6)
#define norm2_g INP(7)
#define w_in INP(8)
#define gate_b INP(9)
#define conv_w INP(10)
#define conv_b INP(11)
#define mnorm_g INP(12)
#define sgu_norm_g INP(13)
#define sgu_w INP(14)
#define sgu_b INP(15)
#define proj_a INP(16)
#define proj_b INP(17)
#define w_out INP(18)
#define router_w INP(19)
#define router_b INP(20)
#define exp_w1 INP(21)
#define exp_b1 INP(22)
#define exp_w2 INP(23)
#define exp_b2 INP(24)
#define final_g INP(25)
#define MOD WSF(WS_MOD)
#define GATES WSF(WS_GATES)
#define BEND WSF(WS_SCAL)
#define GMAX (WSF(WS_SCAL) + 64 * 17)
#define MST (WSF(WS_SCAL) + 2 * 64 * 17)
#define RE WSI(WS_ROUTE)
#define RR (WSI(WS_ROUTE) + NLAT * 4)
#define RG (WSF(WS_ROUTE) + 2 * NLAT * 4)
#define WINT WSB(WS_WINT)
#define SKW WSB(WS_SK)
#define SCN WSF(WS_SCN)
#define PAT WSB(WS_PAT)
#define PBT WSB(WS_PBT)
#define WOT WSB(WS_WOT)
#define W1T WSB(WS_W1T)
#define W1T8 ((unsigned char*)(ws + WS_W1T))
#define HB8M ((unsigned char*)(ws + WS_HB8))
#define WG8M ((unsigned char*)(ws + WS_WG8))
#define W2T8 ((unsigned char*)(ws + WS_W2T))
#define XG8 ((unsigned char*)(ws + WS_XG))
#define ACT8 ((unsigned char*)(ws + WS_ACT))
#define W2T WSB(WS_W2T)
#define HB WSB(WS_HB)
#define Z WSB(WS_Z)
#define QC WSB(WS_QC)
#define KC WSB(WS_KC)
#define SVN WSB(WS_SVN)
#define DC WSB(WS_DC)
#define CS WSB(WS_CS)
#define RO WSB(WS_RO)
#define CM WSB(WS_CM)
#define YB WSB(WS_YB)
#define MRG WSB(WS_MRG)
#define X1 WSF(WS_X1)
#define ACT WSB(WS_ACT)
#define Y2 WSB(WS_Y2)
#define XG WSB(WS_XG)

    if (IN(0)) for (int rep_ = 0; rep_ < NREP(0); ++rep_) { p0_phase(lds, tid, G, cvec, c_ctx, mod_w, mod_b, MOD, w_in, proj_a, proj_b, w_out, exp_w1, exp_w2, router_w, WINT, PAT, PBT, WOT, W1T, W2T, SKW, n_conv_p0);
        cvt_run8(lds, tid, I_W1 + I_W2 + (int)blockIdx.x, G, I_W1 + I_W2 + I_GATE8, exp_w1, exp_w2, w_in, W1T8, W2T8, WG8M); if (BOTH(0) || rep_ + 1 < NREP(0)) GRID_BAR(); }
    if (IN(1)) for (int rep_ = 0; rep_ < NREP(1); ++rep_) { p1_phase(lds, tid, wave, lane, G, x_in, ctx, MOD, norm1_g, SKW, gate_b, HB, HB8M, GATES); if (BOTH(1) || rep_ + 1 < NREP(1)) GRID_BAR(); }
    if (IN(2)) for (int rep_ = 0; rep_ < NREP(2); ++rep_) {
        if ((int)blockIdx.x >= G - (G == 256 ? N_CONVERTERS : G))
            cvt_run8(lds, tid, (int)blockIdx.x - (G - (G == 256 ? N_CONVERTERS : G)), (G == 256 ? N_CONVERTERS : G), I_W1 + I_W2, exp_w1, exp_w2, w_in, W1T8, W2T8, WG8M);
        { pg8::Gemm g{(const bf16*)HB8M, (const bf16*)WG8M, NTOK, 12288, DM}; pg8::DynOrder S{(unsigned*)(ctl + CW_Q2), (LAS int*)(lds + PREF_OFF + 808), (int)(blockIdx.x & 7), 48, 8, 0}; pg8::EpiGate8 E{Z, ZW};
          pg8::gemm_phase8<pg8::EpiGate8, pg8::DynOrder, true, true>(lds, g, S, E); }
        { pg8::Gemm g{HB, WINT, NLAT, ZW, DM}; pg8::DynOrder S{(unsigned*)(ctl + CW_Q), (LAS int*)(lds + PREF_OFF + 800), (int)(blockIdx.x & 7), 8, 0, 24}; pg8::EpiBf16 E{Z, ZW, nullptr, ZW / 256};
          pg8::gemm_phase<pg8::EpiBf16, pg8::DynOrder, true, true>(lds, g, S, E); }
        if (BOTH(2) || rep_ + 1 < NREP(2)) GRID_BAR();
    }
    if (IN(3)) for (int rep_ = 0; rep_ < NREP(3); ++rep_) { p3_phase(wave, lane, G, Z, conv_w, conv_b, sgu_norm_g, QC, KC, SVN, GATES, SCN, BEND, GMAX); if (BOTH(3) || rep_ + 1 < NREP(3)) GRID_BAR(); }
    if (IN(4)) for (int rep_ = 0; rep_ < NREP(4); ++rep_) { p4_phase(lds, tid, wave, lane, G, Z, KC, SVN, SCN, sgu_w, sgu_b, DC, GMAX, CM); if (BOTH(4) || rep_ + 1 < NREP(4)) GRID_BAR(); }
    if (IN(5)) for (int rep_ = 0; rep_ < NREP(5); ++rep_) {
        { pg8::Gemm g{CM, PBT, NLAT, DM, DM}; pg8::StaticOrder S; S.init(NLAT, DM, G, (int)blockIdx.x); pg8::EpiBf16 E{YB, DM, nullptr, DM / 256};
          pg8::gemm_phase<pg8::EpiBf16, pg8::StaticOrder, true, true>(lds, g, S, E); }
        p5_scan(tid, G, DC, BEND, GMAX, CS, MST);
        if (BOTH(5) || rep_ + 1 < NREP(5)) GRID_BAR();
    }
    if (IN(6)) for (int rep_ = 0; rep_ < NREP(6); ++rep_) { p6_phase(lds, tid, wave, lane, G, Z, QC, KC, SCN, CS, MST, mnorm_g, RO); if (BOTH(6) || rep_ + 1 < NREP(6)) GRID_BAR(); }
    if (IN(7)) for (int rep_ = 0; rep_ < NREP(7); ++rep_) {
        pg8::Gemm g{RO, PAT, NLAT, DM, DM}; pg8::StaticOrder S; S.init(NLAT, DM, G, (int)blockIdx.x); pg8::EpiMerge E{MRG, Z, ZW, ZGA, ZGB, YB};
        pg8::gemm_phase<pg8::EpiMerge, pg8::StaticOrder, true, true>(lds, g, S, E);
        if (BOTH(7) || rep_ + 1 < NREP(7)) GRID_BAR();
    }
    if (IN(8)) for (int rep_ = 0; rep_ < NREP(8); ++rep_) {
        pg8::Gemm g{MRG, WOT, NLAT, DM, DM}; pg8::StaticOrder S; S.init(NLAT, DM, G, (int)blockIdx.x); pg8::EpiX1 E{X1, x_in, MOD};
        pg8::gemm_phase<pg8::EpiX1, pg8::StaticOrder, true, true>(lds, g, S, E);
        if (BOTH(8) || rep_ + 1 < NREP(8)) GRID_BAR();
    }
    if (IN(9)) for (int rep_ = 0; rep_ < NREP(9); ++rep_) { p9_phase(lds, wave, lane, G, X1, MOD, norm2_g, SKW, router_b, cnt, XG8, RE, RR, RG); if (BOTH(9) || rep_ + 1 < NREP(9)) GRID_BAR(); }
    if (IN(10)) for (int rep_ = 0; rep_ < NREP(10); ++rep_) {
        moe_prefix(pref, cnt, tid);
        pg8::Gemm g{(const bf16*)XG8, (const bf16*)W1T8, 0, 0, DM}; pg8::MoeDyn S{pref, 16, 1, (unsigned*)(ctl + CW_Q3), (LAS int*)(lds + PREF_OFF + 816), (int)(blockIdx.x & 7)}; pg8::EpiSwiglu8 E{ACT8, exp_b1};
        pg8::gemm_phase8<pg8::EpiSwiglu8, pg8::MoeDyn, true, true, true>(lds, g, S, E);
        if (BOTH(10) || rep_ + 1 < NREP(10)) GRID_BAR();
    }
    if (IN(11)) for (int rep_ = 0; rep_ < NREP(11); ++rep_) {
        moe_prefix(pref, cnt, tid);
        pg8::Gemm g{(const bf16*)ACT8, (const bf16*)W2T8, 0, 0, DEXP}; pg8::MoeDyn S{pref, 8, 0, (unsigned*)(ctl + CW_Q4), (LAS int*)(lds + PREF_OFF + 824), (int)(blockIdx.x & 7)}; pg8::EpiY2f8 E{Y2, exp_b2};
        pg8::gemm_phase8<pg8::EpiY2f8, pg8::MoeDyn, true, true, true>(lds, g, S, E);
        if (BOTH(11) || rep_ + 1 < NREP(11)) GRID_BAR();
    }
    if (IN(12)) for (int rep_ = 0; rep_ < NREP(12); ++rep_) { moe_prefix(pref, cnt, tid); p12_phase(pref, wave, lane, G, X1, MOD, Y2, RE, RR, RG, final_g, args.out); if (rep_ + 1 < NREP(12)) GRID_BAR(); }
#undef IN
#undef BOTH
}

extern "C" void kernel_launch(void* const* d_in, const int* in_sizes, int n_in, void* d_out, int out_size, void* d_ws, size_t ws_size, hipStream_t stream) {
    static int grid = 0;
    if (grid == 0) {
        if (n_in != 26 || out_size != NLAT * DM || ws_size < WS_END) { fprintf(stderr, "kernel_launch: unexpected shapes (n_in %d, out %d, ws %zu)\n", n_in, out_size, ws_size); grid = -1; return; }
        int dev = 0, cus = 0;
        if (hipGetDevice(&dev) != hipSuccess || hipDeviceGetAttribute(&cus, hipDeviceAttributeMultiprocessorCount, dev) != hipSuccess) { grid = -1; return; }
        if (hipFuncSetAttribute((const void*)mk_fwd, hipFuncAttributeMaxDynamicSharedMemorySize, LDS_BYTES) != hipSuccess) { fprintf(stderr, "kernel_launch: hipFuncSetAttribute failed\n"); grid = -1; return; }
        int per_cu = 0;
        if (hipOccupancyMaxActiveBlocksPerMultiprocessor(&per_cu, (const void*)mk_fwd, NTHR, LDS_BYTES) != hipSuccess || per_cu < 1) fprintf(stderr, "kernel_launch: occupancy query reports %d\n", per_cu);
        (void)hipGetLastError();
        grid = cus;
    }
    if (grid < 0) return;
    if (hipMemsetAsync((char*)d_ws + WS_CTL, 0, CTL_ZERO_BYTES, stream) != hipSuccess) return;
    Args a{};
    for (int i = 0; i < 26; ++i) a.in[i] = (const float*)d_in[i];
    a.out = (float*)d_out; a.ws = (unsigned char*)d_ws;
    for (int li = 0; li < N_LAUNCHES; ++li) {
        a.ph_lo = (N_LAUNCHES == 1) ? 0 : li; a.ph_hi = (N_LAUNCHES == 1) ? N_PHASES : li + 1;
        hipLaunchKernelGGL(mk_fwd, dim3(grid), dim3(NTHR), LDS_BYTES, stream, a);
        const hipError_t le = hipPeekAtLastError();
        if (le != hipSuccess) { fprintf(stderr, "kernel_launch: launch %d failed: %s\n", li, hipGetErrorName(le)); break; }
    }
}
```

```cpp
#include <hip/hip_runtime.h>
#include <cstdio>
#include <cstdint>
#ifndef MK_N_LAUNCHES
#define MK_N_LAUNCHES 1
#endif
namespace pg8 {
#define PG8_LAS __attribute__((address_space(3)))
typedef unsigned short bf16_t;
typedef short bf16x8 __attribute__((ext_vector_type(8)));
typedef float f32x4 __attribute__((ext_vector_type(4)));
typedef unsigned u32x4 __attribute__((ext_vector_type(4)));
typedef int i32x4 __attribute__((ext_vector_type(4)));
typedef int i32x8 __attribute__((ext_vector_type(8)));
constexpr int BM = 256, BK = 64, HALF = 128, HTB = HALF * BK * 2  , STAGE_BYTES = 8 * HTB, NXCD = 8, WGM = 8;

__host__ __device__ __forceinline__ int lds_byte(int r, int c) { const int st = (r >> 4) * 2 + (c >> 5), rr = r & 15, cc = c & 31, ob = rr * 64 + cc * 2; return st * 1024 + (ob ^ (((ob >> 9) & 1) << 5)); }
__host__ __device__ __forceinline__ void stage_rc(int b, int& R, int& C) { const int st = b / 1024, sb = b % 1024, swz = sb ^ (((sb >> 9) & 1) << 5); R = (st >> 1) * 16 + swz / 64; C = (st & 1) * 32 + (swz % 64) / 2; }
__host__ __device__ __forceinline__ int perm32(int rho) { const int n = rho >> 4, i = rho & 15; return 8 * (i >> 2) + 4 * n + (i & 3); }

struct Unit { int pm, pn, po, hf; };
struct Gemm { const bf16_t* A; const bf16_t* Bt; int M, N, K; };

struct StaticOrder {
    int nM, nN, nwg, G, c;
    __host__ __device__ void init(int M, int N, int G_, int c_) { nM = M / BM; nN = N / BM; nwg = nM * nN; G = G_; c = c_; }
    __host__ __device__ bool next(int i, Unit& u) const {
        const long L = (long)i * G + c; if (L >= nwg) return false;
        int wgid = (int)L; { const int q = nwg / NXCD, r = nwg % NXCD, xcd = wgid % NXCD, off = wgid / NXCD; wgid = (xcd < r ? xcd * (q + 1) : r * (q + 1) + (xcd - r) * q) + off; }
        const int nig = WGM * nN, gid = wgid / nig, fm = gid * WGM, gsz = (nM - fm) < WGM ? (nM - fm) : WGM;
        u.pm = fm + ((wgid % nig) % gsz); u.pn = (wgid % nig) / gsz; u.po = u.pm; u.hf = 0; return true;
    }
    __device__ __forceinline__ void a_ready(const Unit&) const {}
    __device__ __forceinline__ void done(const Unit&) const {}
};
struct DynOrder {
    unsigned* q; PG8_LAS int* slot; int xcd, nN, ctx8, pn0;
    __device__ __forceinline__ bool next(int i, Unit& u) const {
        if (threadIdx.x == 0) { int id = -1;
            unsigned v = __hip_atomic_fetch_add(q + 64 * xcd, 1u, __ATOMIC_RELAXED, __HIP_MEMORY_SCOPE_AGENT);
            const unsigned per = (unsigned)(4 * nN + ctx8);
            if (v < per) id = xcd * (int)per + (int)v;
            else {
#pragma unroll 1
                for (int k = 1; k < 8 && id < 0; ++k) { const int x = (xcd + k) & 7;
                    if (__hip_atomic_load(q + 64 * x, __ATOMIC_RELAXED, __HIP_MEMORY_SCOPE_AGENT) < per) { v = __hip_atomic_fetch_add(q + 64 * x, 1u, __ATOMIC_RELAXED, __HIP_MEMORY_SCOPE_AGENT); if (v < per) id = x * (int)per + (int)v; } } }
            slot[i & 1] = id; asm volatile("s_waitcnt lgkmcnt(0)" ::: "memory"); }
        asm volatile("" ::: "memory"); __builtin_amdgcn_s_barrier(); asm volatile("" ::: "memory");
        const int id = slot[i & 1]; if (id < 0) return false;
        const int per = 4 * nN + ctx8, nl = 4 * nN, x = id / per, v = id - x * per;
        if (v < nl) { const int wgid = x * nl + v, nig = WGM * nN, gid = wgid / nig; u.pm = gid * WGM + ((wgid % nig) % WGM); u.pn = pn0 + (wgid % nig) / WGM; }
        else { const int j = x * 8 + (v - nl); u.pm = 32 + (j & 3); u.pn = j >> 2; }
        u.po = u.pm; u.hf = 0; return true;
    }
    __device__ __forceinline__ void a_ready(const Unit&) const {}
    __device__ __forceinline__ void done(const Unit&) const {}
};
struct MoeOrder {
    const PG8_LAS int* pref; int nN, G, c, a_sparse;
    __device__ __forceinline__ bool next(int i, Unit& u) const {
        const int L = i * G + c, total = pref[32]; if (L >= total * nN) return false;
        const int mt = L / nN, nt = L - mt * nN; int e = 0;
        for (int k = 1; k < 32; ++k) e += (pref[k] <= mt) ? 1 : 0;
        u.pm = a_sparse ? e * 32 + (mt - pref[e]) : mt; u.pn = e * nN + nt; u.po = mt; u.hf = (pref[33 + e] - 256 * (mt - pref[e]) <= 128) ? 1 : 0; return true;
    }
    __device__ __forceinline__ void a_ready(const Unit&) const {}
    __device__ __forceinline__ void done(const Unit&) const {}
};

struct MoeDyn {
    const PG8_LAS int* pref; int nN, a_sparse; unsigned* q; PG8_LAS int* slot; int xcd;
    __device__ __forceinline__ bool next(int i, Unit& u) const {
        const int total = pref[32], k = nN >> 3;
        if (threadIdx.x == 0) { int id = -1; const unsigned per = (unsigned)(total * k);
            unsigned v = __hip_atomic_fetch_add(q + 64 * xcd, 1u, __ATOMIC_RELAXED, __HIP_MEMORY_SCOPE_AGENT);
            if (v < per) id = (xcd << 16) | (int)v;
            else {
#pragma unroll 1
                for (int j = 1; j < 8 && id < 0; ++j) { const int x = (xcd + j) & 7;
                    if (__hip_atomic_load(q + 64 * x, __ATOMIC_RELAXED, __HIP_MEMORY_SCOPE_AGENT) < per) { v = __hip_atomic_fetch_add(q + 64 * x, 1u, __ATOMIC_RELAXED, __HIP_MEMORY_SCOPE_AGENT); if (v < per) id = (x << 16) | (int)v; } } }
            slot[i & 1] = id; asm volatile("s_waitcnt lgkmcnt(0)" ::: "memory"); }
        asm volatile("" ::: "memory"); __builtin_amdgcn_s_barrier(); asm volatile("" ::: "memory");
        const int id = slot[i & 1]; if (id < 0) return false;
        const int x = id >> 16, v = id & 0xffff, mt = v / k, nt = x + 8 * (v - mt * k); int e = 0;
        for (int j = 1; j < 32; ++j) e += (pref[j] <= mt) ? 1 : 0;
        u.pm = a_sparse ? e * 32 + (mt - pref[e]) : mt; u.pn = e * nN + nt; u.po = mt; u.hf = (pref[33 + e] - 256 * (mt - pref[e]) <= 128) ? 1 : 0; return true;
    }
    __device__ __forceinline__ void a_ready(const Unit&) const {}
    __device__ __forceinline__ void done(const Unit&) const {}
};

__device__ __forceinline__ unsigned cvt_pk_bf16(float lo, float hi) { unsigned r; asm volatile("v_cvt_pk_bf16_f32 %0, %1, %2" : "=v"(r) : "v"(lo), "v"(hi)); return r; }
__device__ __forceinline__ float bf_lo(unsigned w) { return __uint_as_float(w << 16); }
__device__ __forceinline__ float bf_hi(unsigned w) { return __uint_as_float(w & 0xffff0000u); }
__device__ __forceinline__ unsigned pk4_fp8(float a, float b, float c, float d) {
    a = fminf(fmaxf(a, -448.f), 448.f); b = fminf(fmaxf(b, -448.f), 448.f); c = fminf(fmaxf(c, -448.f), 448.f); d = fminf(fmaxf(d, -448.f), 448.f);
    int p = __builtin_amdgcn_cvt_pk_fp8_f32(a, b, 0, false); p = __builtin_amdgcn_cvt_pk_fp8_f32(c, d, p, true); return (unsigned)p; }
constexpr float F8_SA = 16.0f, F8_SW = 512.0f, F8_SC = 4.0f;
__device__ __forceinline__ float sigmoidf_(float x) { return __builtin_amdgcn_rcpf(1.0f + __expf(-x)); }

struct EpiBf16 {
    static constexpr bool PERM = true, AFTER_DRAIN = false;
    bf16_t* O; int ldc; const float* bias; int ncolt;
    __device__ __forceinline__ void operator()(const f32x4 (&acc)[2][2][4][2], const Unit& u, int wr, int wc, int fr, int fq) const {
        const int row0 = u.po * BM + wr * 64 + fr; const int colt = (u.pn % ncolt) * BM;
        const int col0 = colt + wc * 32 + 8 * fq, bcol0 = u.pn * BM + wc * 32 + 8 * fq;
        f32x4 bv[2][2];
#pragma unroll
        for (int bj = 0; bj < 2; ++bj)
#pragma unroll
            for (int n = 0; n < 2; ++n) bv[bj][n] = bias ? *(const f32x4*)(bias + bcol0 + bj * HALF + 4 * n) : (f32x4){0.f, 0.f, 0.f, 0.f};
#pragma unroll
        for (int ai = 0; ai < 2; ++ai)
#pragma unroll
            for (int m = 0; m < 4; ++m) { bf16_t* rowp = O + (size_t)(row0 + ai * HALF + m * 16) * ldc + col0;
#pragma unroll
                for (int bj = 0; bj < 2; ++bj) { const f32x4 v0 = acc[ai][bj][m][0] + bv[bj][0], v1 = acc[ai][bj][m][1] + bv[bj][1];
                    u32x4 w; w.x = cvt_pk_bf16(v0[0], v0[1]); w.y = cvt_pk_bf16(v0[2], v0[3]); w.z = cvt_pk_bf16(v1[0], v1[1]); w.w = cvt_pk_bf16(v1[2], v1[3]);
                    __builtin_nontemporal_store(w, (u32x4*)(rowp + bj * HALF)); } }
    }
};
struct EpiSwiglu8 {
    static constexpr bool PERM = true, AFTER_DRAIN = false;
    unsigned char* O; const float* b1;
    __device__ __forceinline__ void operator()(const f32x4 (&acc)[2][2][4][2], const Unit& u, int wr, int wc, int fr, int fq) const {
        const int e = u.pn >> 4, nt = u.pn & 15; const int row0 = u.po * BM + wr * 64 + fr, j0 = nt * 128 + wc * 32 + 8 * fq;
        const float* bg = b1 + (size_t)e * 4096 + j0; const float* bl = bg + 2048; constexpr float us = 1.0f / (F8_SA * F8_SW);
#pragma unroll
        for (int ai = 0; ai < 2; ++ai)
#pragma unroll
            for (int m = 0; m < 4; ++m) { const size_t row = (size_t)(row0 + ai * HALF + m * 16);
                asm volatile("" ::: "memory");
                unsigned w[2];
#pragma unroll
                for (int n = 0; n < 2; ++n) { const f32x4 gv = acc[ai][0][m][n] * us + *(const f32x4*)(bg + 4 * n), lv = acc[ai][1][m][n] * us + *(const f32x4*)(bl + 4 * n);
                    float o[4];
#pragma unroll
                    for (int i = 0; i < 4; ++i) { const float ga = fminf(gv[i], 7.0f), la = fminf(fmaxf(lv[i], -7.0f), 7.0f); o[i] = ga * sigmoidf_(1.702f * ga) * (la + 1.0f) * F8_SC; }
                    w[n] = pk4_fp8(o[0], o[1], o[2], o[3]); }
                typedef unsigned u32x2 __attribute__((ext_vector_type(2))); const u32x2 ww = {w[0], w[1]};
                *(u32x2*)(O + row * 2048 + j0) = ww; }
    }
};
struct EpiY2f8 {
    static constexpr bool PERM = true, AFTER_DRAIN = false;
    bf16_t* O; const float* bias;
    __device__ __forceinline__ void operator()(const f32x4 (&acc)[2][2][4][2], const Unit& u, int wr, int wc, int fr, int fq) const {
        const int row0 = u.po * BM + wr * 64 + fr; const int col0 = (u.pn & 7) * BM + wc * 32 + 8 * fq, bcol0 = u.pn * BM + wc * 32 + 8 * fq; constexpr float us = 1.0f / (F8_SC * F8_SW);
        f32x4 bv[2][2];
#pragma unroll
        for (int bj = 0; bj < 2; ++bj)
#pragma unroll
            for (int n = 0; n < 2; ++n) bv[bj][n] = *(const f32x4*)(bias + bcol0 + bj * HALF + 4 * n);
#pragma unroll
        for (int ai = 0; ai < 2; ++ai)
#pragma unroll
            for (int m = 0; m < 4; ++m) { bf16_t* rowp = O + (size_t)(row0 + ai * HALF + m * 16) * 2048 + col0;
#pragma unroll
                for (int bj = 0; bj < 2; ++bj) { const f32x4 v0 = acc[ai][bj][m][0] * us + bv[bj][0], v1 = acc[ai][bj][m][1] * us + bv[bj][1];
                    u32x4 w; w.x = cvt_pk_bf16(v0[0], v0[1]); w.y = cvt_pk_bf16(v0[2], v0[3]); w.z = cvt_pk_bf16(v1[0], v1[1]); w.w = cvt_pk_bf16(v1[2], v1[3]);
                    __builtin_nontemporal_store(w, (u32x4*)(rowp + bj * HALF)); } }
    }
};
struct EpiGate8 {
    static constexpr bool PERM = true, AFTER_DRAIN = false;
    bf16_t* O; int ldc;
    __device__ __forceinline__ void operator()(const f32x4 (&acc)[2][2][4][2], const Unit& u, int wr, int wc, int fr, int fq) const {
        const int row0 = u.po * BM + wr * 64 + fr, col0 = (u.pn < 24 ? u.pn : u.pn + 8) * BM + wc * 32 + 8 * fq; constexpr float us = 1.0f / (F8_SA * F8_SW);
#pragma unroll
        for (int ai = 0; ai < 2; ++ai)
#pragma unroll
            for (int m = 0; m < 4; ++m) { bf16_t* rowp = O + (size_t)(row0 + ai * HALF + m * 16) * ldc + col0;
#pragma unroll
                for (int bj = 0; bj < 2; ++bj) { const f32x4 v0 = acc[ai][bj][m][0] * us, v1 = acc[ai][bj][m][1] * us;
                    u32x4 w; w.x = cvt_pk_bf16(v0[0], v0[1]); w.y = cvt_pk_bf16(v0[2], v0[3]); w.z = cvt_pk_bf16(v1[0], v1[1]); w.w = cvt_pk_bf16(v1[2], v1[3]);
                    __builtin_nontemporal_store(w, (u32x4*)(rowp + bj * HALF)); } }
    }
};
struct EpiF32 {
    static constexpr bool PERM = false, AFTER_DRAIN = false;
    float* C; int ldc;
    __device__ __forceinline__ void operator()(const f32x4 (&acc)[2][2][4][2], const Unit& u, int wr, int wc, int fr, int fq) const {
        const int row0 = u.po * BM + wr * 64 + fr, col0 = u.pn * BM + wc * 32 + 4 * fq;
#pragma unroll
        for (int ai = 0; ai < 2; ++ai)
#pragma unroll
            for (int m = 0; m < 4; ++m) { float* rowp = C + (size_t)(row0 + ai * HALF + m * 16) * ldc + col0;
#pragma unroll
                for (int bj = 0; bj < 2; ++bj)
#pragma unroll
                    for (int n = 0; n < 2; ++n) *(f32x4*)(rowp + bj * HALF + n * 16) = acc[ai][bj][m][n]; }
    }
};
struct EpiMerge {
    static constexpr bool PERM = true, AFTER_DRAIN = false;
    bf16_t* O; const bf16_t* Z; int ldz, ga_off, gb_off; const bf16_t* YB;
    __device__ __forceinline__ void operator()(const f32x4 (&acc)[2][2][4][2], const Unit& u, int wr, int wc, int fr, int fq) const {
        const int row0 = u.po * BM + wr * 64 + fr, col0 = u.pn * BM + wc * 32 + 8 * fq;
#pragma unroll
        for (int ai = 0; ai < 2; ++ai)
#pragma unroll
            for (int m = 0; m < 4; ++m) { const size_t row = (size_t)(row0 + ai * HALF + m * 16);
#pragma unroll
                for (int bj = 0; bj < 2; ++bj) { const int col = col0 + bj * HALF;
                    const u32x4 ga = *(const u32x4*)(Z + row * ldz + ga_off + col), gb = *(const u32x4*)(Z + row * ldz + gb_off + col);
                    const u32x4 yw = *(const u32x4*)(YB + row * 2048 + col); const f32x4 y0 = {bf_lo(yw.x), bf_hi(yw.x), bf_lo(yw.y), bf_hi(yw.y)}, y1 = {bf_lo(yw.z), bf_hi(yw.z), bf_lo(yw.w), bf_hi(yw.w)};
                    const f32x4 a0 = acc[ai][bj][m][0], a1 = acc[ai][bj][m][1];
                    float o[8];
                    o[0] = sigmoidf_(bf_lo(ga.x)) * a0[0] + sigmoidf_(bf_lo(gb.x)) * y0[0]; o[1] = sigmoidf_(bf_hi(ga.x)) * a0[1] + sigmoidf_(bf_hi(gb.x)) * y0[1];
                    o[2] = sigmoidf_(bf_lo(ga.y)) * a0[2] + sigmoidf_(bf_lo(gb.y)) * y0[2]; o[3] = sigmoidf_(bf_hi(ga.y)) * a0[3] + sigmoidf_(bf_hi(gb.y)) * y0[3];
                    o[4] = sigmoidf_(bf_lo(ga.z)) * a1[0] + sigmoidf_(bf_lo(gb.z)) * y1[0]; o[5] = sigmoidf_(bf_hi(ga.z)) * a1[1] + sigmoidf_(bf_hi(gb.z)) * y1[1];
                    o[6] = sigmoidf_(bf_lo(ga.w)) * a1[2] + sigmoidf_(bf_lo(gb.w)) * y1[2]; o[7] = sigmoidf_(bf_hi(ga.w)) * a1[3] + sigmoidf_(bf_hi(gb.w)) * y1[3];
                    u32x4 w; w.x = cvt_pk_bf16(o[0], o[1]); w.y = cvt_pk_bf16(o[2], o[3]); w.z = cvt_pk_bf16(o[4], o[5]); w.w = cvt_pk_bf16(o[6], o[7]);
                    *(u32x4*)(O + row * 2048 + col) = w; } }
    }
};
struct EpiX1 {
    static constexpr bool PERM = false, AFTER_DRAIN = false;
    float* X1; const float* X; const float* mod;
    __device__ __forceinline__ void operator()(const f32x4 (&acc)[2][2][4][2], const Unit& u, int wr, int wc, int fr, int fq) const {
        const int row0 = u.po * BM + wr * 64 + fr, col0 = u.pn * BM + wc * 32 + 4 * fq;
        const float* mg = mod + (size_t)((u.po * BM) >> 11) * 12288 + 2 * 2048;
#pragma unroll
        for (int bj = 0; bj < 2; ++bj)
#pragma unroll
            for (int n = 0; n < 2; ++n) { const int col = col0 + bj * HALF + n * 16; const f32x4 g = *(const f32x4*)(mg + col);
#pragma unroll
                for (int ai = 0; ai < 2; ++ai)
#pragma unroll
                    for (int m = 0; m < 4; ++m) { const size_t off = (size_t)(row0 + ai * HALF + m * 16) * 2048 + col;
                        *(f32x4*)(X1 + off) = *(const f32x4*)(X + off) + g * acc[ai][bj][m][n]; } }
    }
};
struct EpiSwiglu {
    static constexpr bool PERM = true, AFTER_DRAIN = false;
    bf16_t* O; const float* b1;
    __device__ __forceinline__ void operator()(const f32x4 (&acc)[2][2][4][2], const Unit& u, int wr, int wc, int fr, int fq) const {
        const int e = u.pn >> 4, nt = u.pn & 15; const int row0 = u.po * BM + wr * 64 + fr, j0 = nt * 128 + wc * 32 + 8 * fq;
        const float* bg = b1 + (size_t)e * 4096 + j0; const float* bl = bg + 2048;
#pragma unroll
        for (int ai = 0; ai < 2; ++ai)
#pragma unroll
            for (int m = 0; m < 4; ++m) { const size_t row = (size_t)(row0 + ai * HALF + m * 16);
                asm volatile("" ::: "memory");
#pragma unroll
                for (int n = 0; n < 2; ++n) { const f32x4 gv = acc[ai][0][m][n] + *(const f32x4*)(bg + 4 * n), lv = acc[ai][1][m][n] + *(const f32x4*)(bl + 4 * n);
                    float o[4];
#pragma unroll
                    for (int i = 0; i < 4; ++i) { const float ga = fminf(gv[i], 7.0f), la = fminf(fmaxf(lv[i], -7.0f), 7.0f); o[i] = ga * sigmoidf_(1.702f * ga) * (la + 1.0f); }
                    typedef unsigned u32x2 __attribute__((ext_vector_type(2))); u32x2 w; w.x = cvt_pk_bf16(o[0], o[1]); w.y = cvt_pk_bf16(o[2], o[3]);
                    *(u32x2*)(O + row * 2048 + j0 + 4 * n) = w; } }
    }
};

template <class Epi, class Sched, bool ALIGN_EPI = false, bool SP2 = false, bool HALFSKIP = false>
__device__ __forceinline__ void gemm_phase(PG8_LAS unsigned char* lds, const Gemm g, const Sched& S, const Epi& E) {
    const int tid = threadIdx.x, wid = __builtin_amdgcn_readfirstlane(tid >> 6), lane = tid & 63, wr = wid >> 2, wc = wid & 3, fr = lane & 15, fq = lane >> 4;
    const int K = g.K, nt = K / BK;
    unsigned voffA[2], voffB[2];
#pragma unroll
    for (int i = 0; i < 2; ++i) { int R, C; stage_rc(tid * 16 + i * 8192, R, C); const int Rb = Epi::PERM ? ((R & ~31) + perm32(R & 31)) : R;
        voffA[i] = (unsigned)(R * K + C) * 2u; voffB[i] = (unsigned)(Rb * K + C) * 2u; }
    const size_t kstep = (size_t)(BK * 2);
    const size_t hstep = (size_t)HALF * K * 2;
    const size_t tstep = 2 * hstep;
    const unsigned ldsw = (unsigned)wid * 1024u;
    const int aoff = lds_byte(wr * 64 + fr, fq * 8), boff = lds_byte(wc * 32 + fr, fq * 8);
#define PG8_SA(b, h) (((b) * 2 + (h)) * HTB)
#define PG8_SB(b, h) ((4 + (b) * 2 + (h)) * HTB)
#define PG8_STAGE(bufoff, gbase, voff) do { _Pragma("unroll") for (int _i = 0; _i < 2; ++_i) \
        __builtin_amdgcn_global_load_lds((const unsigned*)((const char*)(gbase) + (voff)[_i]), (PG8_LAS unsigned*)(lds + (bufoff) + ldsw + _i * 8192), 16, 0, 0); } while (0)
#define PG8_LDA(dst, b, h) do { _Pragma("unroll") for (int m = 0; m < 4; ++m) _Pragma("unroll") for (int k = 0; k < 2; ++k) dst[m][k] = *(const PG8_LAS bf16x8*)(lds + PG8_SA(b, h) + aoff + m * 2048 + k * 1024); } while (0)
#define PG8_LDB(dst, b, h) do { _Pragma("unroll") for (int n = 0; n < 2; ++n) _Pragma("unroll") for (int k = 0; k < 2; ++k) dst[n][k] = *(const PG8_LAS bf16x8*)(lds + PG8_SB(b, h) + boff + n * 2048 + k * 1024); } while (0)
#define PG8_MMA(ai, bj, At, Bt) do { __builtin_amdgcn_s_setprio(1); _Pragma("unroll") for (int m = 0; m < 4; ++m) _Pragma("unroll") for (int n = 0; n < 2; ++n) _Pragma("unroll") for (int k = 0; k < 2; ++k) \
        acc[ai][bj][m][n] = __builtin_amdgcn_mfma_f32_16x16x32_bf16(Bt[n][k], At[m][k], acc[ai][bj][m][n], 0, 0, 0); __builtin_amdgcn_s_setprio(0); } while (0)
#define PG8_WAIT_V(n) asm volatile("s_waitcnt vmcnt(" #n ")" ::: "memory")
#define PG8_WAIT_L(n) asm volatile("s_waitcnt lgkmcnt(" #n ")" ::: "memory")
#define PG8_BAR __builtin_amdgcn_s_barrier()
#define PG8_SCHED __builtin_amdgcn_sched_barrier(0)
    Unit cur, nxt; int ui = 0;
    if (!S.next(0, cur)) return;
    f32x4 acc[2][2][4][2];
#pragma unroll
    for (int a = 0; a < 2; ++a)
#pragma unroll
        for (int b = 0; b < 2; ++b)
#pragma unroll
            for (int m = 0; m < 4; ++m)
#pragma unroll
                for (int n = 0; n < 2; ++n) acc[a][b][m][n] = (f32x4){0.f, 0.f, 0.f, 0.f};
    bf16x8 At[4][2], B0[2][2], B1[2][2];
    const char* cA = (const char*)g.A + (size_t)cur.pm * tstep; const char* cB = (const char*)g.Bt + (size_t)cur.pn * tstep;
    S.a_ready(cur);
    if constexpr (SP2) {
        PG8_STAGE(PG8_SB(0, 0), cB, voffB); PG8_STAGE(PG8_SB(0, 1), cB + hstep, voffB); PG8_STAGE(PG8_SA(0, 0), cA, voffA); PG8_STAGE(PG8_SA(0, 1), cA + hstep, voffA);
        if (wr == 1) PG8_BAR;
        PG8_WAIT_V(2); PG8_BAR;
        PG8_STAGE(PG8_SB(1, 0), cB + kstep, voffB); PG8_STAGE(PG8_SA(1, 0), cA + kstep, voffA); PG8_STAGE(PG8_SB(1, 1), cB + hstep + kstep, voffB);
        PG8_WAIT_V(6); PG8_BAR;
    } else {
        PG8_STAGE(PG8_SB(0, 0), cB, voffB); PG8_STAGE(PG8_SA(0, 0), cA, voffA); PG8_STAGE(PG8_SB(0, 1), cB + hstep, voffB); PG8_STAGE(PG8_SA(0, 1), cA + hstep, voffA);
        if (wr == 1) PG8_BAR;
        PG8_WAIT_V(4); PG8_BAR;
        PG8_STAGE(PG8_SB(1, 0), cB + kstep, voffB); PG8_STAGE(PG8_SA(1, 0), cA + kstep, voffA); PG8_STAGE(PG8_SB(1, 1), cB + hstep + kstep, voffB);
        PG8_WAIT_V(6); PG8_BAR;
    }
    for (;;) {
        const bool has_next = S.next(ui + 1, nxt);
        const char* nA = has_next ? (const char*)g.A + (size_t)nxt.pm * tstep : cA; const char* nB = has_next ? (const char*)g.Bt + (size_t)nxt.pn * tstep : cB;
        for (int t = 0; t < nt; t += 2) {
            const bool last = (t == nt - 2);
            const char* a1 = cA + (size_t)(t + 1) * kstep;
            const char* a2 = last ? nA : cA + (size_t)(t + 2) * kstep; const char* b2 = last ? nB : cB + (size_t)(t + 2) * kstep;
            const char* a3 = a2 + kstep; const char* b3 = b2 + kstep;
            if (last && has_next) S.a_ready(nxt);
            if constexpr (SP2) {
            PG8_LDB(B0, 0, 0); PG8_LDB(B1, 0, 1); PG8_SCHED; PG8_LDA(At, 0, 0); PG8_STAGE(PG8_SA(1, 1), a1 + hstep, voffA);
            PG8_WAIT_V(8); PG8_WAIT_L(0); PG8_BAR; PG8_MMA(0, 0, At, B0); PG8_MMA(0, 1, At, B1); PG8_BAR; PG8_SCHED;
            PG8_LDA(At, 0, 1); PG8_STAGE(PG8_SB(0, 0), b2, voffB); PG8_STAGE(PG8_SB(0, 1), b2 + hstep, voffB); PG8_STAGE(PG8_SA(0, 0), a2, voffA);
            PG8_WAIT_V(8); PG8_WAIT_L(0); PG8_BAR; if (!(HALFSKIP && cur.hf)) { PG8_MMA(1, 0, At, B0); PG8_MMA(1, 1, At, B1); } PG8_BAR; PG8_SCHED;
            PG8_LDB(B0, 1, 0); PG8_LDB(B1, 1, 1); PG8_SCHED; PG8_LDA(At, 1, 0); PG8_STAGE(PG8_SA(0, 1), a2 + hstep, voffA);
            PG8_WAIT_V(8); PG8_WAIT_L(0); PG8_BAR; PG8_MMA(0, 0, At, B0); PG8_MMA(0, 1, At, B1); PG8_BAR; PG8_SCHED;
            PG8_LDA(At, 1, 1); PG8_STAGE(PG8_SB(1, 0), b3, voffB); PG8_STAGE(PG8_SB(1, 1), b3 + hstep, voffB); PG8_STAGE(PG8_SA(1, 0), a3, voffA);
            PG8_WAIT_V(8); PG8_WAIT_L(0); PG8_BAR; if (!(HALFSKIP && cur.hf)) { PG8_MMA(1, 0, At, B0); PG8_MMA(1, 1, At, B1); } PG8_BAR; PG8_SCHED;
            } else {
            PG8_LDB(B0, 0, 0); PG8_SCHED; PG8_LDA(At, 0, 0); PG8_STAGE(PG8_SA(1, 1), a1 + hstep, voffA);
            PG8_WAIT_L(8); PG8_BAR; PG8_WAIT_L(0); PG8_MMA(0, 0, At, B0); PG8_BAR; PG8_SCHED;
            PG8_LDB(B1, 0, 1); PG8_STAGE(PG8_SB(0, 0), b2, voffB);
            PG8_BAR; PG8_WAIT_L(0); PG8_MMA(0, 1, At, B1); PG8_BAR;
            PG8_LDA(At, 0, 1); PG8_STAGE(PG8_SA(0, 0), a2, voffA);
            PG8_BAR; PG8_WAIT_L(0); PG8_MMA(1, 0, At, B0); PG8_BAR; PG8_SCHED;
            PG8_STAGE(PG8_SB(0, 1), b2 + hstep, voffB);
            PG8_WAIT_V(6); PG8_BAR; PG8_MMA(1, 1, At, B1); PG8_BAR;
            PG8_LDB(B0, 1, 0); PG8_SCHED; PG8_LDA(At, 1, 0); PG8_STAGE(PG8_SA(0, 1), a2 + hstep, voffA);
            PG8_WAIT_L(8); PG8_BAR; PG8_WAIT_L(0); PG8_MMA(0, 0, At, B0); PG8_BAR; PG8_SCHED;
            PG8_LDB(B1, 1, 1); PG8_STAGE(PG8_SB(1, 0), b3, voffB);
            PG8_BAR; PG8_WAIT_L(0); PG8_MMA(0, 1, At, B1); PG8_BAR;
            PG8_LDA(At, 1, 1); PG8_STAGE(PG8_SA(1, 0), a3, voffA);
            PG8_BAR; PG8_WAIT_L(0); PG8_MMA(1, 0, At, B0); PG8_BAR; PG8_SCHED;
            PG8_STAGE(PG8_SB(1, 1), b3 + hstep, voffB);
            PG8_WAIT_V(6); PG8_BAR; PG8_MMA(1, 1, At, B1); PG8_BAR;
            }
        }
        if constexpr (ALIGN_EPI) { if (wr == 0) PG8_BAR; }
        if constexpr (!Epi::AFTER_DRAIN) { E(acc, cur, wr, wc, fr, fq); S.done(cur); }
        if (!has_next) break;
#pragma unroll
        for (int a = 0; a < 2; ++a)
#pragma unroll
            for (int b = 0; b < 2; ++b)
#pragma unroll
                for (int m = 0; m < 4; ++m)
#pragma unroll
                    for (int n = 0; n < 2; ++n) acc[a][b][m][n] = (f32x4){0.f, 0.f, 0.f, 0.f};
        cur = nxt; cA = nA; cB = nB; ++ui;
        if constexpr (ALIGN_EPI) { if (wr == 1) PG8_BAR; }
    }
    PG8_WAIT_V(0);
    if constexpr (!ALIGN_EPI) { if (wr == 0) PG8_BAR; }
    PG8_BAR;
    if constexpr (Epi::AFTER_DRAIN) { E.fused(acc, cur, wr, wc, fr, fq, lds, wid, lane); S.done(cur); }
#undef PG8_SA
#undef PG8_SB
#undef PG8_STAGE
#undef PG8_LDA
#undef PG8_LDB
#undef PG8_MMA
#undef PG8_WAIT_V
#undef PG8_WAIT_L
#undef PG8_BAR
#undef PG8_SCHED
}
template <class Epi, class Sched, bool ALIGN_EPI = false, bool SP2 = false, bool HALFSKIP = false>
__device__ __forceinline__ void gemm_phase8(PG8_LAS unsigned char* lds, const Gemm g, const Sched& S, const Epi& E) {
    const int tid = threadIdx.x, wid = __builtin_amdgcn_readfirstlane(tid >> 6), lane = tid & 63, wr = wid >> 2, wc = wid & 3, fr = lane & 15, fq = lane >> 4;
    const int K = g.K, nt = K / 128;
    unsigned voffA[2], voffB[2];
#pragma unroll
    for (int i = 0; i < 2; ++i) { int R, C; stage_rc(tid * 16 + i * 8192, R, C); const int Rb = Epi::PERM ? ((R & ~31) + perm32(R & 31)) : R;
        voffA[i] = (unsigned)(R * K + 2 * C); voffB[i] = (unsigned)(Rb * K + 2 * C); }
    const size_t kstep = (size_t)(BK * 2);
    const size_t hstep = (size_t)HALF * K;
    const size_t tstep = 2 * hstep;
    const unsigned ldsw = (unsigned)wid * 1024u;
    const int aoff = lds_byte(wr * 64 + fr, fq * 16), boff = lds_byte(wc * 32 + fr, fq * 16);
#define PG8_SA(b, h) (((b) * 2 + (h)) * HTB)
#define PG8_SB(b, h) ((4 + (b) * 2 + (h)) * HTB)
#define PG8_STAGE(bufoff, gbase, voff) do { _Pragma("unroll") for (int _i = 0; _i < 2; ++_i) \
        __builtin_amdgcn_global_load_lds((const unsigned*)((const char*)(gbase) + (voff)[_i]), (PG8_LAS unsigned*)(lds + (bufoff) + ldsw + _i * 8192), 16, 0, 0); } while (0)
#define PG8_LDA(dst, b, h) do { _Pragma("unroll") for (int m = 0; m < 4; ++m) { const i32x4 lo_ = *(const PG8_LAS i32x4*)(lds + PG8_SA(b, h) + aoff + m * 2048), hi_ = *(const PG8_LAS i32x4*)(lds + PG8_SA(b, h) + aoff + m * 2048 + 16); dst[m] = __builtin_shufflevector(lo_, hi_, 0, 1, 2, 3, 4, 5, 6, 7); } } while (0)
#define PG8_LDB(dst, b, h) do { _Pragma("unroll") for (int n = 0; n < 2; ++n) { const i32x4 lo_ = *(const PG8_LAS i32x4*)(lds + PG8_SB(b, h) + boff + n * 2048), hi_ = *(const PG8_LAS i32x4*)(lds + PG8_SB(b, h) + boff + n * 2048 + 16); dst[n] = __builtin_shufflevector(lo_, hi_, 0, 1, 2, 3, 4, 5, 6, 7); } } while (0)
#define PG8_MMA(ai, bj, At, Bt) do { __builtin_amdgcn_s_setprio(1); _Pragma("unroll") for (int m = 0; m < 4; ++m) _Pragma("unroll") for (int n = 0; n < 2; ++n) \
        asm volatile("v_mfma_scale_f32_16x16x128_f8f6f4 %0, %1, %2, %0, %3, %3 op_sel_hi:[0,0,0]" : "+v"(acc[ai][bj][m][n]) : "v"(Bt[n]), "v"(At[m]), "v"(sc127)); __builtin_amdgcn_s_setprio(0); } while (0)
#define PG8_WAIT_V(n) asm volatile("s_waitcnt vmcnt(" #n ")" ::: "memory")
#define PG8_WAIT_L(n) asm volatile("s_waitcnt lgkmcnt(" #n ")" ::: "memory")
#define PG8_BAR __builtin_amdgcn_s_barrier()
#define PG8_SCHED __builtin_amdgcn_sched_barrier(0)
    Unit cur, nxt; int ui = 0;
    if (!S.next(0, cur)) return;
    f32x4 acc[2][2][4][2];
#pragma unroll
    for (int a = 0; a < 2; ++a)
#pragma unroll
        for (int b = 0; b < 2; ++b)
#pragma unroll
            for (int m = 0; m < 4; ++m)
#pragma unroll
                for (int n = 0; n < 2; ++n) acc[a][b][m][n] = (f32x4){0.f, 0.f, 0.f, 0.f};
    i32x8 At[4], B0[2], B1[2]; const int sc127 = 127;
    const char* cA = (const char*)g.A + (size_t)cur.pm * tstep; const char* cB = (const char*)g.Bt + (size_t)cur.pn * tstep;
    S.a_ready(cur);
    if constexpr (SP2) {
        PG8_STAGE(PG8_SB(0, 0), cB, voffB); PG8_STAGE(PG8_SB(0, 1), cB + hstep, voffB); PG8_STAGE(PG8_SA(0, 0), cA, voffA); PG8_STAGE(PG8_SA(0, 1), cA + hstep, voffA);
        if (wr == 1) PG8_BAR;
        PG8_WAIT_V(2); PG8_BAR;
        PG8_STAGE(PG8_SB(1, 0), cB + kstep, voffB); PG8_STAGE(PG8_SA(1, 0), cA + kstep, voffA); PG8_STAGE(PG8_SB(1, 1), cB + hstep + kstep, voffB);
        PG8_WAIT_V(6); PG8_BAR;
    } else {
        PG8_STAGE(PG8_SB(0, 0), cB, voffB); PG8_STAGE(PG8_SA(0, 0), cA, voffA); PG8_STAGE(PG8_SB(0, 1), cB + hstep, voffB); PG8_STAGE(PG8_SA(0, 1), cA + hstep, voffA);
        if (wr == 1) PG8_BAR;
        PG8_WAIT_V(4); PG8_BAR;
        PG8_STAGE(PG8_SB(1, 0), cB + kstep, voffB); PG8_STAGE(PG8_SA(1, 0), cA + kstep, voffA); PG8_STAGE(PG8_SB(1, 1), cB + hstep + kstep, voffB);
        PG8_WAIT_V(6); PG8_BAR;
    }
    for (;;) {
        const bool has_next = S.next(ui + 1, nxt);
        const char* nA = has_next ? (const char*)g.A + (size_t)nxt.pm * tstep : cA; const char* nB = has_next ? (const char*)g.Bt + (size_t)nxt.pn * tstep : cB;
        for (int t = 0; t < nt; t += 2) {
            const bool last = (t == nt - 2);
            const char* a1 = cA + (size_t)(t + 1) * kstep;
            const char* a2 = last ? nA : cA + (size_t)(t + 2) * kstep; const char* b2 = last ? nB : cB + (size_t)(t + 2) * kstep;
            const char* a3 = a2 + kstep; const char* b3 = b2 + kstep;
            if (last && has_next) S.a_ready(nxt);
            if constexpr (SP2) {
            PG8_LDB(B0, 0, 0); PG8_LDB(B1, 0, 1); PG8_SCHED; PG8_LDA(At, 0, 0); PG8_STAGE(PG8_SA(1, 1), a1 + hstep, voffA);
            PG8_WAIT_V(8); PG8_WAIT_L(0); PG8_BAR; PG8_MMA(0, 0, At, B0); PG8_MMA(0, 1, At, B1); PG8_BAR; PG8_SCHED;
            if (!(HALFSKIP && cur.hf)) PG8_LDA(At, 0, 1); PG8_STAGE(PG8_SB(0, 0), b2, voffB); PG8_STAGE(PG8_SB(0, 1), b2 + hstep, voffB); PG8_STAGE(PG8_SA(0, 0), a2, voffA);
            PG8_WAIT_V(8); PG8_WAIT_L(0); PG8_BAR; if (!(HALFSKIP && cur.hf)) { PG8_MMA(1, 0, At, B0); PG8_MMA(1, 1, At, B1); } PG8_BAR; PG8_SCHED;
            PG8_LDB(B0, 1, 0); PG8_LDB(B1, 1, 1); PG8_SCHED; PG8_LDA(At, 1, 0); PG8_STAGE(PG8_SA(0, 1), a2 + hstep, voffA);
            PG8_WAIT_V(8); PG8_WAIT_L(0); PG8_BAR; PG8_MMA(0, 0, At, B0); PG8_MMA(0, 1, At, B1); PG8_BAR; PG8_SCHED;
            if (!(HALFSKIP && cur.hf)) PG8_LDA(At, 1, 1); PG8_STAGE(PG8_SB(1, 0), b3, voffB); PG8_STAGE(PG8_SB(1, 1), b3 + hstep, voffB); PG8_STAGE(PG8_SA(1, 0), a3, voffA);
            PG8_WAIT_V(8); PG8_WAIT_L(0); PG8_BAR; if (!(HALFSKIP && cur.hf)) { PG8_MMA(1, 0, At, B0); PG8_MMA(1, 1, At, B1); } PG8_BAR; PG8_SCHED;
            } else {
            PG8_LDB(B0, 0, 0); PG8_SCHED; PG8_LDA(At, 0, 0); PG8_STAGE(PG8_SA(1, 1), a1 + hstep, voffA);
            PG8_WAIT_L(8); PG8_BAR; PG8_WAIT_L(0); PG8_MMA(0, 0, At, B0); PG8_BAR; PG8_SCHED;
            PG8_LDB(B1, 0, 1); PG8_STAGE(PG8_SB(0, 0), b2, voffB);
            PG8_BAR; PG8_WAIT_L(0); PG8_MMA(0, 1, At, B1); PG8_BAR;
            PG8_LDA(At, 0, 1); PG8_STAGE(PG8_SA(0, 0), a2, voffA);
            PG8_BAR; PG8_WAIT_L(0); PG8_MMA(1, 0, At, B0); PG8_BAR; PG8_SCHED;
            PG8_STAGE(PG8_SB(0, 1), b2 + hstep, voffB);
            PG8_WAIT_V(6); PG8_BAR; PG8_MMA(1, 1, At, B1); PG8_BAR;
            PG8_LDB(B0, 1, 0); PG8_SCHED; PG8_LDA(At, 1, 0); PG8_STAGE(PG8_SA(0, 1), a2 + hstep, voffA);
            PG8_WAIT_L(8); PG8_BAR; PG8_WAIT_L(0); PG8_MMA(0, 0, At, B0); PG8_BAR; PG8_SCHED;
            PG8_LDB(B1, 1, 1); PG8_STAGE(PG8_SB(1, 0), b3, voffB);
            PG8_BAR; PG8_WAIT_L(0); PG8_MMA(0, 1, At, B1); PG8_BAR;
            PG8_LDA(At, 1, 1); PG8_STAGE(PG8_SA(1, 0), a3, voffA);
            PG8_BAR; PG8_WAIT_L(0); PG8_MMA(1, 0, At, B0); PG8_BAR; PG8_SCHED;
            PG8_STAGE(PG8_SB(1, 1), b3 + hstep, voffB);
            PG8_WAIT_V(6); PG8_BAR; PG8_MMA(1, 1, At, B1); PG8_BAR;
            }
        }
        if constexpr (ALIGN_EPI) { if (wr == 0) PG8_BAR; }
        if constexpr (!Epi::AFTER_DRAIN) { E(acc, cur, wr, wc, fr, fq); S.done(cur); }
        if (!has_next) break;
#pragma unroll
        for (int a = 0; a < 2; ++a)
#pragma unroll
            for (int b = 0; b < 2; ++b)
#pragma unroll
                for (int m = 0; m < 4; ++m)
#pragma unroll
                    for (int n = 0; n < 2; ++n) acc[a][b][m][n] = (f32x4){0.f, 0.f, 0.f, 0.f};
        cur = nxt; cA = nA; cB = nB; ++ui;
        if constexpr (ALIGN_EPI) { if (wr == 1) PG8_BAR; }
    }
    PG8_WAIT_V(0);
    if constexpr (!ALIGN_EPI) { if (wr == 0) PG8_BAR; }
    PG8_BAR;
    if constexpr (Epi::AFTER_DRAIN) { E.fused(acc, cur, wr, wc, fr, fq, lds, wid, lane); S.done(cur); }
#undef PG8_SA
#undef PG8_SB
#undef PG8_STAGE
#undef PG8_LDA
#undef PG8_LDB
#undef PG8_MMA
#undef PG8_WAIT_V
#undef PG8_WAIT_L
#undef PG8_BAR
#undef PG8_SCHED
}
}

constexpr int NWAVES = 8, NTHR = 512;
constexpr int N_LAUNCHES = MK_N_LAUNCHES;
constexpr int N_PHASES = 13;
constexpr int DM = 2048, NB = 4, TL = 2048, NLAT = NB * TL, TCX = 256, NCTX = NB * TCX, NTOK = NLAT + NCTX;
constexpr int NH = 8, QKD = 128, VD = 256, INC = 14368, ZW = 14336;
constexpr int ZQ = 0, ZK = 1024, ZV = 2048, ZO = 4096, ZU = 6144, ZS = 8192, ZGA = 10240, ZGB = 12288;
constexpr int NEXP = 32, DEXP = 2048, NCH = 18  , CROWS = 272  ;
constexpr float EPS = 1e-6f;

constexpr size_t MiB = 1u << 20;
constexpr size_t WS_CTL = 0, CTL_ZERO_BYTES = 1 * MiB;
constexpr size_t WS_MOD = 1 * MiB;
constexpr size_t WS_GATES = 2 * MiB;
constexpr size_t WS_SCAL = 4 * MiB;
constexpr size_t WS_ROUTE = 5 * MiB;
constexpr size_t WS_SCN = 2996 * MiB;
constexpr size_t WS_SK = 6 * MiB;
constexpr size_t WS_WINT = 8 * MiB;
constexpr size_t WS_PAT = 64 * MiB, WS_PBT = 72 * MiB, WS_WOT = 80 * MiB;
constexpr size_t WS_W1T = 88 * MiB;
constexpr size_t WS_W2T = 600 * MiB;
constexpr size_t WS_HB = 856 * MiB;
constexpr size_t WS_Z = 892 * MiB;
constexpr size_t WS_QC = 1144 * MiB, WS_KC = 1162 * MiB;
constexpr size_t WS_SVN = 1180 * MiB;
constexpr size_t WS_DC = 1212 * MiB;
constexpr size_t WS_CS = 1360 * MiB;
constexpr size_t WS_RO = 1428 * MiB;
constexpr size_t WS_CM = 1460 * MiB;
constexpr size_t WS_YB = 1492 * MiB;
constexpr size_t WS_MRG = 1556 * MiB;
constexpr size_t WS_X1 = 1588 * MiB;
constexpr size_t WS_ACT = 1652 * MiB;
constexpr size_t WS_Y2 = 1812 * MiB;
constexpr size_t WS_XG = 1972 * MiB;
constexpr size_t WS_HB8 = 2998 * MiB;
constexpr size_t WS_WG8 = 3016 * MiB;
constexpr size_t WS_END = 3040 * MiB;
static_assert(WS_DC + (size_t)64 * 17 * CROWS * 128 * 2 <= WS_CS && WS_CS + (size_t)64 * 16 * CROWS * 128 * 2 <= WS_RO && WS_Z + (size_t)NTOK * ZW * 2 <= WS_QC, "ws map");
constexpr int CW_Q3 = 3584, CW_Q4 = 8192;
constexpr int CW_Q2 = 3072;
constexpr int CW_Q = 2048;
constexpr int CW_CNT = 64;
constexpr int CW_BAR = 4096;
constexpr int RING_BYTES = 131072;
constexpr int LDS_BYTES = 147456;
constexpr int LDSCTL_OFF = LDS_BYTES - 2048, MISC_OFF = LDSCTL_OFF + 320, PREF_OFF = LDSCTL_OFF + 1024;

#define GAS __attribute__((address_space(1)))
#define LAS __attribute__((address_space(3)))
typedef unsigned short bf16;
typedef unsigned v4u __attribute__((ext_vector_type(4)));
typedef unsigned v2u __attribute__((ext_vector_type(2)));
typedef float f32x4 __attribute__((ext_vector_type(4)));
typedef short bf16x8 __attribute__((ext_vector_type(8)));
typedef short s16x4 __attribute__((ext_vector_type(4)));
typedef GAS unsigned gu32;
#define RLX_AGENT __ATOMIC_RELAXED, __HIP_MEMORY_SCOPE_AGENT
#define LDS_WAIT() asm volatile("s_waitcnt lgkmcnt(0)" ::: "memory")
#define VM_WAIT() asm volatile("s_waitcnt vmcnt(0)" ::: "memory")
using pg8::cvt_pk_bf16; using pg8::bf_lo; using pg8::bf_hi; using pg8::sigmoidf_;


__device__ __forceinline__ float wave_sum(float v) {
#pragma unroll
    for (int o = 1; o < 64; o <<= 1) v += __shfl_xor(v, o);
    return v;
}
__device__ __forceinline__ float siluf_(float x) { return x * __builtin_amdgcn_rcpf(1.0f + __expf(-x)); }
__device__ __forceinline__ float gelu_tanh(float x) { const float u = 0.7978845608028654f * (x + 0.044715f * x * x * x); return x * __builtin_amdgcn_rcpf(1.0f + __expf(-2.0f * u)); }
__device__ __forceinline__ float logsigf_(float f) { return fminf(f, 0.f) - log1pf(expf(-fabsf(f))); }
__device__ __forceinline__ unsigned img_off(unsigned row, unsigned ch) { return 256u * row + 16u * (ch ^ (((row & 3u) << 2) | ((row >> 2) & 3u))); }
__device__ __forceinline__ s16x4 tr_read(LAS unsigned char* p) { return __builtin_amdgcn_ds_read_tr16_b64_v4i16((LAS s16x4*)p); }
__device__ __forceinline__ bf16x8 tr_frag(LAS unsigned char* img, unsigned r0, unsigned r1, unsigned c, int lane) {
    const unsigned q = (lane & 15) >> 2, p = lane & 3;
    const s16x4 lo = tr_read(img + img_off(r0 + q, 2 * c + (p >> 1)) + 8 * (p & 1));
    const s16x4 hi = tr_read(img + img_off(r1 + q, 2 * c + (p >> 1)) + 8 * (p & 1));
    bf16x8 r; r[0] = lo[0]; r[1] = lo[1]; r[2] = lo[2]; r[3] = lo[3]; r[4] = hi[0]; r[5] = hi[1]; r[6] = hi[2]; r[7] = hi[3]; return r;
}
__device__ __forceinline__ bf16x8 tr_frag2(LAS unsigned char* base, unsigned x0, unsigned x1) {
    const s16x4 lo = tr_read(base + x0), hi = tr_read(base + x1);
    bf16x8 r; r[0] = lo[0]; r[1] = lo[1]; r[2] = lo[2]; r[3] = lo[3]; r[4] = hi[0]; r[5] = hi[1]; r[6] = hi[2]; r[7] = hi[3]; return r;
}
#define TR_NAT_OFFS(xn0, xn1, lane) unsigned xn0[8], xn1[8]; { const unsigned g_ = (lane) >> 4, q_ = ((lane) & 15) >> 2, p_ = (lane) & 3; \
    _Pragma("unroll") for (int c_ = 0; c_ < 8; ++c_) { xn0[c_] = 256u * (8 * g_ + q_) + 16u * ((2 * c_ + (p_ >> 1)) ^ ((q_ << 2) | ((2 * g_) & 3))) + 8u * (p_ & 1); \
                                                       xn1[c_] = 256u * (8 * g_ + 4 + q_) + 16u * ((2 * c_ + (p_ >> 1)) ^ ((q_ << 2) | ((2 * g_ + 1) & 3))) + 8u * (p_ & 1); } }
#define TR_PERM_OFFS(xp, lane) unsigned xp[8]; { const unsigned g_ = (lane) >> 4, q_ = ((lane) & 15) >> 2, p_ = (lane) & 3; \
    _Pragma("unroll") for (int c_ = 0; c_ < 8; ++c_) xp[c_] = 256u * (4 * g_ + q_) + 16u * ((2 * c_ + (p_ >> 1)) ^ ((q_ << 2) | g_)) + 8u * (p_ & 1); }
__device__ __forceinline__ void load_tile128(LAS unsigned char* img, const bf16* src, size_t ld, int tid) {
#pragma unroll
    for (int i = 0; i < 4; ++i) { const int id = tid + NTHR * i, row = id >> 4, ch = id & 15;
        const v4u v = *(const v4u*)(src + (size_t)row * ld + 8 * ch); *(LAS v4u*)(img + img_off(row, ch)) = v; }
}
__device__ __forceinline__ void load_tile128_scaled(LAS unsigned char* img, const bf16* src, size_t ld, const LAS float* w, int tid) {
#pragma unroll
    for (int i = 0; i < 4; ++i) { const int id = tid + NTHR * i, row = id >> 4, ch = id & 15; const float s = w[row];
        const v4u v = *(const v4u*)(src + (size_t)row * ld + 8 * ch); v4u o;
        o.x = cvt_pk_bf16(bf_lo(v.x) * s, bf_hi(v.x) * s); o.y = cvt_pk_bf16(bf_lo(v.y) * s, bf_hi(v.y) * s); o.z = cvt_pk_bf16(bf_lo(v.z) * s, bf_hi(v.z) * s); o.w = cvt_pk_bf16(bf_lo(v.w) * s, bf_hi(v.w) * s);
        *(LAS v4u*)(img + img_off(row, ch)) = o; }
}
__device__ __forceinline__ void gate_scan(const float* G, size_t row0, int col_i, int col_f, int dir, int lane, float* bc, float* gg, float* pmx, float& b_end, float& gmax) {
    const int j0 = dir ? 127 - 2 * lane : 2 * lane, j1 = dir ? 126 - 2 * lane : 2 * lane + 1;
    const float f0 = G[(row0 + j0) * 32 + col_f], f1 = G[(row0 + j1) * 32 + col_f], i0 = G[(row0 + j0) * 32 + col_i], i1 = G[(row0 + j1) * 32 + col_i];
    const float lf0 = logsigf_(f0), lf1 = logsigf_(f1), s = lf0 + lf1; float incl = s;
#pragma unroll
    for (int o = 1; o < 64; o <<= 1) { const float t = __shfl_up(incl, o); if (lane >= o) incl += t; }
    const float b0 = (incl - s) + lf0, b1 = incl, g0 = i0 - b0, g1 = i1 - b1;
    float mincl = fmaxf(g0, g1);
#pragma unroll
    for (int o = 1; o < 64; o <<= 1) { const float t = __shfl_up(mincl, o); if (lane >= o) mincl = fmaxf(mincl, t); }
    float mexcl = __shfl_up(mincl, 1); if (lane == 0) mexcl = -3.0e38f;
    bc[j0] = b0; bc[j1] = b1; gg[j0] = g0; gg[j1] = g1; pmx[j0] = fmaxf(mexcl, g0); pmx[j1] = mincl;
    b_end = __shfl(incl, 63); gmax = __shfl(mincl, 63);
}
#define MFMA16(a, b, c) __builtin_amdgcn_mfma_f32_16x16x32_bf16((a), (b), (c), 0, 0, 0)

struct CvtItem { const float* src; size_t ldw; bf16* dst; };
constexpr int N_CONVERTERS = 128;
constexpr int N_CONV_DEFER = 1440;
constexpr int I_GEMV = 192, I_WIN = 16 * 8, I_GATE8 = 16 * 48, I_P = 16 * 8, I_W1 = 32 * 16 * 16, I_W2 = 32 * 16 * 8, I_TOTAL = I_GEMV + I_WIN + 3 * I_P + I_W1 + I_W2;
__device__ __forceinline__ CvtItem cvt_decode(int r, int tid, const float* w_in, const float* proj_a, const float* proj_b, const float* w_out, const float* exp_w1, const float* exp_w2,
                                              bf16* WINT, bf16* PAT, bf16* PBT, bf16* WOT, bf16* W1T, bf16* W2T) {
    const int n4 = tid & 63, kg = tid >> 6; const float* W; size_t ldw, ca, cb, drow; int kt; bf16* WT;
    if (r < I_WIN) { kt = r / 8; const int nt = 24 + r % 8; W = w_in; ldw = INC; ca = (size_t)256 * nt + 32; cb = ca + 128; WT = WINT; drow = (size_t)256 * nt; }
    else if ((r -= I_WIN) < 3 * I_P) { const int m = r / I_P, q = r % I_P; kt = q / 8; const int nt = q % 8; W = m == 0 ? proj_a : (m == 1 ? proj_b : w_out); ldw = 2048; ca = (size_t)256 * nt; cb = ca + 128; WT = m == 0 ? PAT : (m == 1 ? PBT : WOT); drow = (size_t)256 * nt; }
    else if ((r -= 3 * I_P) < I_W1) { const int e = r / 256, q = r % 256; kt = q / 16; const int nt = q % 16; W = exp_w1 + (size_t)e * 2048 * 4096; ldw = 4096; ca = (size_t)128 * nt; cb = 2048 + ca; WT = W1T; drow = (size_t)e * 4096 + 256 * nt; }
    else { r -= I_W1; const int e = r / 128, q = r % 128; kt = q / 8; const int nt = q % 8; W = exp_w2 + (size_t)e * 2048 * 2048; ldw = 2048; ca = (size_t)256 * nt; cb = ca + 128; WT = W2T; drow = (size_t)e * 2048 + 256 * nt; }
    CvtItem it; it.ldw = ldw; it.src = W + (size_t)(128 * kt + 8 * kg) * ldw + (n4 < 32 ? ca + 4 * n4 : cb + 4 * (n4 - 32)); it.dst = WT + drow * 2048 + 128 * kt; return it;
}
__device__ __forceinline__ void cvt_run(LAS unsigned char* lds, int tid, int it, int stride, int end, const float* w_in, const float* proj_a, const float* proj_b, const float* w_out, const float* exp_w1, const float* exp_w2,
                                        bf16* WINT, bf16* PAT, bf16* PBT, bf16* WOT, bf16* W1T, bf16* W2T) {
    const int n4 = tid & 63, kg = tid >> 6;
    f32x4 v[16]; CvtItem cur;
    bool have = it < end;
    if (have) { cur = cvt_decode(it - I_GEMV, tid, w_in, proj_a, proj_b, w_out, exp_w1, exp_w2, WINT, PAT, PBT, WOT, W1T, W2T);
#pragma unroll
        for (int i = 0; i < 16; ++i) v[i] = __builtin_nontemporal_load((const f32x4*)(cur.src + (size_t)((i >> 3) * 64 + (i & 7)) * cur.ldw)); }
    while (have) {
#pragma unroll
        for (int hf = 0; hf < 2; ++hf)
#pragma unroll
            for (int j = 0; j < 4; ++j) { v4u o; o.x = cvt_pk_bf16(v[8 * hf + 0][j], v[8 * hf + 1][j]); o.y = cvt_pk_bf16(v[8 * hf + 2][j], v[8 * hf + 3][j]); o.z = cvt_pk_bf16(v[8 * hf + 4][j], v[8 * hf + 5][j]); o.w = cvt_pk_bf16(v[8 * hf + 6][j], v[8 * hf + 7][j]);
                *(LAS v4u*)(lds + img_off(4 * n4 + j, 8 * hf + kg)) = o; }
        __syncthreads();
        bf16* dst = cur.dst;
        it += stride; have = it < end;
        if (have) { cur = cvt_decode(it - I_GEMV, tid, w_in, proj_a, proj_b, w_out, exp_w1, exp_w2, WINT, PAT, PBT, WOT, W1T, W2T);
#pragma unroll
            for (int i = 0; i < 16; ++i) v[i] = __builtin_nontemporal_load((const f32x4*)(cur.src + (size_t)((i >> 3) * 64 + (i & 7)) * cur.ldw)); }
#pragma unroll
        for (int i = 0; i < 8; ++i) { const int id = tid + NTHR * i, row = id >> 4, ch = id & 15; const v4u o = *(const LAS v4u*)(lds + img_off(row, ch)); __builtin_nontemporal_store(o, (v4u*)(dst + (size_t)row * 2048 + 8 * ch)); }
        __syncthreads();
    }
}
__device__ __forceinline__ void cvt_run8(LAS unsigned char* lds, int tid, int r, int stride, int end, const float* exp_w1, const float* exp_w2, const float* w_in, unsigned char* W1T8, unsigned char* W2T8, unsigned char* WG8) {
    const int n4 = tid & 63, kg = tid >> 6;
    f32x4 v[16]; const float* src = nullptr; size_t ldw = 0; unsigned char* dst = nullptr;
#define CVT8_DECODE(R) do { int q_ = (R); const float* W_; size_t ca_, cb_, drow_; int kt_; unsigned char* WT_; \
        if (q_ < I_W1) { const int e = q_ / 256, qq = q_ % 256; kt_ = qq / 16; const int nt = qq % 16; W_ = exp_w1 + (size_t)e * 2048 * 4096; ldw = 4096; ca_ = (size_t)128 * nt; cb_ = 2048 + ca_; WT_ = W1T8; drow_ = (size_t)e * 4096 + 256 * nt; } \
        else if (q_ < I_W1 + I_W2) { q_ -= I_W1; const int e = q_ / 128, qq = q_ % 128; kt_ = qq / 8; const int nt = qq % 8; W_ = exp_w2 + (size_t)e * 2048 * 2048; ldw = 2048; ca_ = (size_t)256 * nt; cb_ = ca_ + 128; WT_ = W2T8; drow_ = (size_t)e * 2048 + 256 * nt; } \
        else { q_ -= I_W1 + I_W2; kt_ = q_ / 48; const int ft = q_ % 48, zt = ft < 24 ? ft : ft + 8; W_ = w_in; ldw = INC; ca_ = (size_t)256 * zt + (zt >= 16 ? 32 : 0); cb_ = ca_ + 128; WT_ = WG8; drow_ = (size_t)256 * ft; } \
        src = W_ + (size_t)(128 * kt_ + 8 * kg) * ldw + (n4 < 32 ? ca_ + 4 * n4 : cb_ + 4 * (n4 - 32)); dst = WT_ + drow_ * 2048 + 128 * kt_; \
        _Pragma("unroll") for (int i = 0; i < 16; ++i) v[i] = __builtin_nontemporal_load((const f32x4*)(src + (size_t)((i >> 3) * 64 + (i & 7)) * ldw)); } while (0)
    bool have = r < end;
    if (have) CVT8_DECODE(r);
    while (have) {
#pragma unroll
        for (int hf = 0; hf < 2; ++hf)
#pragma unroll
            for (int j = 0; j < 4; ++j) { const int row = 4 * n4 + j, p8 = 8 * hf + kg; v2u o;
                o.x = pg8::pk4_fp8(v[8 * hf + 0][j] * pg8::F8_SW, v[8 * hf + 1][j] * pg8::F8_SW, v[8 * hf + 2][j] * pg8::F8_SW, v[8 * hf + 3][j] * pg8::F8_SW);
                o.y = pg8::pk4_fp8(v[8 * hf + 4][j] * pg8::F8_SW, v[8 * hf + 5][j] * pg8::F8_SW, v[8 * hf + 6][j] * pg8::F8_SW, v[8 * hf + 7][j] * pg8::F8_SW);
                *(LAS v2u*)(lds + row * 128 + 16 * ((p8 >> 1) ^ ((row >> 2) & 7)) + 8 * (p8 & 1)) = o; }
        __syncthreads();
        unsigned char* d0 = dst;
        r += stride; have = r < end;
        if (have) CVT8_DECODE(r);
#pragma unroll
        for (int i = 0; i < 4; ++i) { const int id = tid + NTHR * i, row = id >> 3, ch = id & 7; const v4u o = *(const LAS v4u*)(lds + row * 128 + 16 * (ch ^ ((row >> 2) & 7)));
            __builtin_nontemporal_store(o, (v4u*)(d0 + (size_t)row * 2048 + 16 * ch)); }
        __syncthreads();
    }
#undef CVT8_DECODE
}
__device__ __forceinline__ void p0_phase(LAS unsigned char* lds, int tid, int G, const float* c, const float* c_ctx, const float* mod_w, const float* mod_b, float* MOD,
                                         const float* w_in, const float* proj_a, const float* proj_b, const float* w_out, const float* exp_w1, const float* exp_w2, const float* router_w,
                                         bf16* WINT, bf16* PAT, bf16* PBT, bf16* WOT, bf16* W1T, bf16* W2T, bf16* SK, int n_conv_p0) {
    LAS float* sc = (LAS float*)lds;
    LAS float* red = (LAS float*)(lds + 40960);
    int it = blockIdx.x;
    if (it < I_GEMV) {
        for (int i = tid; i < 5 * 2048; i += NTHR) { const float x = i < 4 * 2048 ? c[i] : c_ctx[i - 4 * 2048]; sc[i] = siluf_(x); }
        __syncthreads();
        for (; it < I_GEMV; it += G) {
            const int j0 = 64 * it, c4 = tid & 15, kg = tid >> 4;
            f32x4 a0 = {0.f, 0.f, 0.f, 0.f}, a1 = a0, a2 = a0, a3 = a0, a4 = a0;
            const float* wp = mod_w + (size_t)kg * 12288 + j0 + 4 * c4;
#pragma unroll 8
            for (int k = kg; k < 2048; k += 32) { const f32x4 w = *(const f32x4*)wp; wp += (size_t)32 * 12288;
                a0 += w * sc[k]; a1 += w * sc[2048 + k]; a2 += w * sc[4096 + k]; a3 += w * sc[6144 + k]; a4 += w * sc[8192 + k]; }
            *(LAS f32x4*)(red + (kg * 5 + 0) * 64 + 4 * c4) = a0; *(LAS f32x4*)(red + (kg * 5 + 1) * 64 + 4 * c4) = a1; *(LAS f32x4*)(red + (kg * 5 + 2) * 64 + 4 * c4) = a2;
            *(LAS f32x4*)(red + (kg * 5 + 3) * 64 + 4 * c4) = a3; *(LAS f32x4*)(red + (kg * 5 + 4) * 64 + 4 * c4) = a4;
            __syncthreads();
            if (tid < 320) { const int rr = tid >> 6, j = tid & 63; float s = 0.f;
#pragma unroll 8
                for (int g = 0; g < 32; ++g) s += red[(g * 5 + rr) * 64 + j];
                MOD[rr * 12288 + j0 + j] = s + mod_b[j0 + j]; }
            __syncthreads();
        }
    } else {
        for (int i = (it - I_GEMV) * NTHR + tid; i < 2 * 32 * 2048; i += (G - I_GEMV) * NTHR) { const int m = i >> 16, n = (i >> 11) & 31, k = i & 2047;
            const float w = m == 0 ? w_in[(size_t)k * INC + 4096 + n] : router_w[k * 32 + n];
            const unsigned hi = cvt_pk_bf16(w, 0.f) & 0xffffu; const unsigned lo = cvt_pk_bf16(w - __uint_as_float(hi << 16), 0.f) & 0xffffu;
            SK[(size_t)(2 * m) * 65536 + n * 2048 + k] = (bf16)hi; SK[(size_t)(2 * m + 1) * 65536 + n * 2048 + k] = (bf16)lo; }
    }
    cvt_run(lds, tid, it, G, I_GEMV + n_conv_p0, w_in, proj_a, proj_b, w_out, exp_w1, exp_w2, WINT, PAT, PBT, WOT, W1T, W2T);
}

__device__ __forceinline__ void skinny_mfma(const LAS float* hrow, const bf16* WT_hi, const bf16* WT_lo, LAS float* part, int wave, int lane) {
    const int g = lane >> 4, l15 = lane & 15;
    f32x4 acc0 = {0.f, 0.f, 0.f, 0.f}, acc1 = acc0;
#pragma unroll
    for (int ks = 0; ks < 8; ++ks) { const int kb = 256 * wave + 32 * ks + 8 * g;
        f32x4 a0 = {0.f, 0.f, 0.f, 0.f}, a1 = a0;
        if (l15 < 8) { a0 = *(const LAS f32x4*)(hrow + l15 * 2048 + kb); a1 = *(const LAS f32x4*)(hrow + l15 * 2048 + kb + 4); }
        v4u hi, lo;
        hi.x = cvt_pk_bf16(a0[0], a0[1]); hi.y = cvt_pk_bf16(a0[2], a0[3]); hi.z = cvt_pk_bf16(a1[0], a1[1]); hi.w = cvt_pk_bf16(a1[2], a1[3]);
        lo.x = cvt_pk_bf16(a0[0] - bf_lo(hi.x), a0[1] - bf_hi(hi.x)); lo.y = cvt_pk_bf16(a0[2] - bf_lo(hi.y), a0[3] - bf_hi(hi.y));
        lo.z = cvt_pk_bf16(a1[0] - bf_lo(hi.z), a1[1] - bf_hi(hi.z)); lo.w = cvt_pk_bf16(a1[2] - bf_lo(hi.w), a1[3] - bf_hi(hi.w));
        const bf16x8 Ah = __builtin_bit_cast(bf16x8, hi), Al = __builtin_bit_cast(bf16x8, lo);
        const bf16x8 b0h = *(const bf16x8*)(WT_hi + (size_t)l15 * 2048 + kb), b0l = *(const bf16x8*)(WT_lo + (size_t)l15 * 2048 + kb);
        const bf16x8 b1h = *(const bf16x8*)(WT_hi + (size_t)(16 + l15) * 2048 + kb), b1l = *(const bf16x8*)(WT_lo + (size_t)(16 + l15) * 2048 + kb);
        acc0 = MFMA16(Ah, b0h, acc0); acc0 = MFMA16(Ah, b0l, acc0); acc0 = MFMA16(Al, b0h, acc0);
        acc1 = MFMA16(Ah, b1h, acc1); acc1 = MFMA16(Ah, b1l, acc1); acc1 = MFMA16(Al, b1h, acc1); }
    if (g < 2) {
#pragma unroll
        for (int r = 0; r < 4; ++r) { part[wave * 256 + (4 * g + r) * 32 + l15] = acc0[r]; part[wave * 256 + (4 * g + r) * 32 + 16 + l15] = acc1[r]; } }
}

template <bool LOREG>
__device__ __forceinline__ void skinny_mfma_r(const LAS float* hrow, const bf16x8 (&Bh)[8][2], const bf16x8 (&Bl)[8][2], const bf16* WT_lo, LAS float* part, int wave, int lane) {
    const int g = lane >> 4, l15 = lane & 15;
    f32x4 acc0 = {0.f, 0.f, 0.f, 0.f}, acc1 = acc0;
#pragma unroll
    for (int ks = 0; ks < 8; ++ks) { const int kb = 256 * wave + 32 * ks + 8 * g;
        f32x4 a0 = {0.f, 0.f, 0.f, 0.f}, a1 = a0;
        if (l15 < 8) { a0 = *(const LAS f32x4*)(hrow + l15 * 2048 + kb); a1 = *(const LAS f32x4*)(hrow + l15 * 2048 + kb + 4); }
        v4u hi, lo;
        hi.x = cvt_pk_bf16(a0[0], a0[1]); hi.y = cvt_pk_bf16(a0[2], a0[3]); hi.z = cvt_pk_bf16(a1[0], a1[1]); hi.w = cvt_pk_bf16(a1[2], a1[3]);
        lo.x = cvt_pk_bf16(a0[0] - bf_lo(hi.x), a0[1] - bf_hi(hi.x)); lo.y = cvt_pk_bf16(a0[2] - bf_lo(hi.y), a0[3] - bf_hi(hi.y));
        lo.z = cvt_pk_bf16(a1[0] - bf_lo(hi.z), a1[1] - bf_hi(hi.z)); lo.w = cvt_pk_bf16(a1[2] - bf_lo(hi.w), a1[3] - bf_hi(hi.w));
        const bf16x8 Ah = __builtin_bit_cast(bf16x8, hi), Al = __builtin_bit_cast(bf16x8, lo);
        bf16x8 b0l, b1l;
        if constexpr (LOREG) { b0l = Bl[ks][0]; b1l = Bl[ks][1]; }
        else { b0l = *(const bf16x8*)(WT_lo + (size_t)l15 * 2048 + kb); b1l = *(const bf16x8*)(WT_lo + (size_t)(16 + l15) * 2048 + kb); }
        acc0 = MFMA16(Ah, Bh[ks][0], acc0); acc0 = MFMA16(Ah, b0l, acc0); acc0 = MFMA16(Al, Bh[ks][0], acc0);
        acc1 = MFMA16(Ah, Bh[ks][1], acc1); acc1 = MFMA16(Ah, b1l, acc1); acc1 = MFMA16(Al, Bh[ks][1], acc1); }
    if (g < 2) {
#pragma unroll
        for (int r = 0; r < 4; ++r) { part[wave * 256 + (4 * g + r) * 32 + l15] = acc0[r]; part[wave * 256 + (4 * g + r) * 32 + 16 + l15] = acc1[r]; } }
}
#define SK_LOAD(B, BASE) do { _Pragma("unroll") for (int ks_ = 0; ks_ < 8; ++ks_) _Pragma("unroll") for (int n_ = 0; n_ < 2; ++n_) \
        B[ks_][n_] = *(const bf16x8*)((BASE) + (size_t)(16 * n_ + (lane & 15)) * 2048 + 256 * wave + 32 * ks_ + 8 * (lane >> 4)); } while (0)

__device__ __forceinline__ void p1_phase(LAS unsigned char* lds, int tid, int wave, int lane, int G, const float* x, const float* ctx, const float* MOD, const float* norm_g,
                                         const bf16* SK, const float* gate_b, bf16* HB, unsigned char* HB8, float* GATES) {
    LAS float* hrow = (LAS float*)(lds + wave * 8192); LAS float* part = (LAS float*)(lds + 65536);
    bf16x8 Bh[8][2], Bl[8][2]; SK_LOAD(Bh, SK); SK_LOAD(Bl, SK + 65536);
    f32x4 v[8];
    { const int row = blockIdx.x * 8 + wave; const float* xr = row < NLAT ? x + (size_t)row * DM : ctx + (size_t)(row - NLAT) * DM;
#pragma unroll
      for (int j = 0; j < 8; ++j) v[j] = *(const f32x4*)(xr + 4 * (lane + 64 * j)); }
    for (int it = blockIdx.x; it < NTOK / 8; it += G) {
        const int row = it * 8 + wave;
        const float* shift = MOD + (size_t)(row < NLAT ? (row >> 11) : 4) * 12288; const float* scale = shift + 2048;
        float ss = 0.f;
#pragma unroll
        for (int j = 0; j < 8; ++j) ss += (v[j][0] * v[j][0] + v[j][1] * v[j][1]) + (v[j][2] * v[j][2] + v[j][3] * v[j][3]);
        const float rstd = 1.0f / sqrtf(wave_sum(ss) * (1.0f / DM) + EPS);
#pragma unroll
        for (int j = 0; j < 8; ++j) { const int col = 4 * (lane + 64 * j);
            const f32x4 g = *(const f32x4*)(norm_g + col), sc = *(const f32x4*)(scale + col), sh = *(const f32x4*)(shift + col);
            const f32x4 h = (v[j] * rstd) * g * (sc + 1.0f) + sh;
            v2u o; o.x = cvt_pk_bf16(h[0], h[1]); o.y = cvt_pk_bf16(h[2], h[3]); *(v2u*)(HB + (size_t)row * DM + col) = o;
            *(unsigned*)(HB8 + (size_t)row * DM + col) = pg8::pk4_fp8(h[0] * pg8::F8_SA, h[1] * pg8::F8_SA, h[2] * pg8::F8_SA, h[3] * pg8::F8_SA);
            *(LAS f32x4*)(hrow + col) = h; }
        if (it + G < NTOK / 8) { const int rown = (it + G) * 8 + wave; const float* xr = rown < NLAT ? x + (size_t)rown * DM : ctx + (size_t)(rown - NLAT) * DM;
#pragma unroll
            for (int j = 0; j < 8; ++j) v[j] = *(const f32x4*)(xr + 4 * (lane + 64 * j)); }
        __syncthreads();
        skinny_mfma_r<true>((const LAS float*)lds, Bh, Bl, nullptr, part, wave, lane);
        __syncthreads();
        if (tid < 256) { float s = 0.f;
#pragma unroll
            for (int w = 0; w < 8; ++w) s += part[w * 256 + tid];
            GATES[(size_t)(it * 8) * 32 + tid] = s + gate_b[tid & 31]; }
    }
}

__device__ __forceinline__ void p3_phase(int wave, int lane, int G, const bf16* Z, const float* conv_w, const float* conv_b, const float* sgu_norm_g, bf16* QC, bf16* KC, bf16* SVN,
                                         const float* GATES, float* SCN, float* BEND, float* GMAX) {
    const int gw = blockIdx.x * NWAVES + wave, NGW = G * NWAVES;
    for (int task = gw; task < 64 * NCH; task += NGW) { const int bhd = task / NCH, bi = task - bhd * NCH, dir = bhd & 1, bh = bhd >> 1, b = bh >> 3, h = bh & 7;
        const size_t row0 = bi < 2 ? (size_t)NLAT + b * TCX + bi * 128 : (size_t)b * TL + (bi - 2) * 128;
        float* sp = SCN + (size_t)task * 384; float b_end, gmax;
        gate_scan(GATES, row0, (2 * dir) * 8 + h, (2 * dir + 1) * 8 + h, dir, lane, sp, sp + 128, sp + 256, b_end, gmax);
        const int c = dir == 0 ? bi : (bi < 2 ? 1 - bi : 19 - bi);
        if (lane == 0 && c < 17) { BEND[bhd * 17 + c] = b_end; GMAX[bhd * 17 + c] = gmax; } }
    for (int item = gw; item < NTOK; item += NGW) {
        const int rb = item >> 2, seg = item & 3, row0 = rb * 4, c0 = seg * 512 + lane * 8;
        const int t0 = row0 < NLAT ? (row0 & (TL - 1)) : ((row0 - NLAT) & (TCX - 1)), len = row0 < NLAT ? TL : TCX;
        v4u zr[8];
#pragma unroll
        for (int k = 0; k < 8; ++k) { const int tt = t0 + k - 2; zr[k] = (v4u){0u, 0u, 0u, 0u};
            if (tt >= 0 && tt < len) zr[k] = *(const v4u*)(Z + (size_t)(row0 + k - 2) * ZW + c0); }
        f32x4 w0[5], w1[5];
#pragma unroll
        for (int tau = 0; tau < 5; ++tau) { w0[tau] = *(const f32x4*)(conv_w + tau * 2048 + c0); w1[tau] = *(const f32x4*)(conv_w + tau * 2048 + c0 + 4); }
        const f32x4 b0 = *(const f32x4*)(conv_b + c0), b1 = *(const f32x4*)(conv_b + c0 + 4);
        const float qs = c0 < 1024 ? 0.08838834764831845f : 1.0f;
#pragma unroll
        for (int o = 0; o < 4; ++o) { float acc[8] = {b0[0], b0[1], b0[2], b0[3], b1[0], b1[1], b1[2], b1[3]};
#pragma unroll
            for (int tau = 0; tau < 5; ++tau) { const v4u z = zr[o + tau];
                acc[0] += w0[tau][0] * bf_lo(z.x); acc[1] += w0[tau][1] * bf_hi(z.x); acc[2] += w0[tau][2] * bf_lo(z.y); acc[3] += w0[tau][3] * bf_hi(z.y);
                acc[4] += w1[tau][0] * bf_lo(z.z); acc[5] += w1[tau][1] * bf_hi(z.z); acc[6] += w1[tau][2] * bf_lo(z.w); acc[7] += w1[tau][3] * bf_hi(z.w); }
#pragma unroll
            for (int i = 0; i < 8; ++i) acc[i] = siluf_(acc[i]) * qs;
            v4u ov; ov.x = cvt_pk_bf16(acc[0], acc[1]); ov.y = cvt_pk_bf16(acc[2], acc[3]); ov.z = cvt_pk_bf16(acc[4], acc[5]); ov.w = cvt_pk_bf16(acc[6], acc[7]);
            bf16* dst = c0 < 1024 ? QC + (size_t)(row0 + o) * 1024 + c0 : KC + (size_t)(row0 + o) * 1024 + (c0 - 1024);
            *(v4u*)dst = ov; }
    }
    for (int row = gw; row < NLAT; row += NGW) {
        float v[32]; float ss = 0.f;
#pragma unroll
        for (int j = 0; j < 4; ++j) { const v4u z = *(const v4u*)(Z + (size_t)row * ZW + ZS + 8 * lane + 512 * j);
            v[8 * j + 0] = gelu_tanh(bf_lo(z.x)); v[8 * j + 1] = gelu_tanh(bf_hi(z.x)); v[8 * j + 2] = gelu_tanh(bf_lo(z.y)); v[8 * j + 3] = gelu_tanh(bf_hi(z.y));
            v[8 * j + 4] = gelu_tanh(bf_lo(z.z)); v[8 * j + 5] = gelu_tanh(bf_hi(z.z)); v[8 * j + 6] = gelu_tanh(bf_lo(z.w)); v[8 * j + 7] = gelu_tanh(bf_hi(z.w)); }
#pragma unroll
        for (int i = 0; i < 32; ++i) ss += v[i] * v[i];
        const float rstd = 1.0f / sqrtf(wave_sum(ss) * (1.0f / DM) + EPS);
#pragma unroll
        for (int j = 0; j < 4; ++j) { const int col = 8 * lane + 512 * j; const f32x4 g0 = *(const f32x4*)(sgu_norm_g + col), g1 = *(const f32x4*)(sgu_norm_g + col + 4);
            v4u o; o.x = cvt_pk_bf16(v[8 * j] * rstd * g0[0], v[8 * j + 1] * rstd * g0[1]); o.y = cvt_pk_bf16(v[8 * j + 2] * rstd * g0[2], v[8 * j + 3] * rstd * g0[3]);
            o.z = cvt_pk_bf16(v[8 * j + 4] * rstd * g1[0], v[8 * j + 5] * rstd * g1[1]); o.w = cvt_pk_bf16(v[8 * j + 6] * rstd * g1[2], v[8 * j + 7] * rstd * g1[3]);
            *(v4u*)(SVN + (size_t)row * DM + col) = o; }
    }
}

constexpr int L_V0 = 0, L_V1 = 32768, L_K = 65536, L_SC = 98304, L_CB = 106496;
constexpr int N_M1 = 64 * 17, N_SGU = 512;
__device__ __forceinline__ void p4_phase(LAS unsigned char* lds, int tid_, int wave, int lane_, int G, const bf16* Z, const bf16* KC, const bf16* SVN, const float* SCN,
                                         const float* sgu_w, const float* sgu_b, bf16* DC, const float* GMAX, bf16* CM) {
    v4u pk[4], pv[8]; f32x4 pa[2];
#define P4_ISSUE(U) do { const int u_ = (U); int t_ = tid_; asm volatile("" : "+v"(t_)); \
        if (u_ < N_M1) { const int bhd_ = u_ / 17, c_ = u_ - bhd_ * 17, dir_ = bhd_ & 1, bh_ = bhd_ >> 1, b_ = bh_ >> 3, h_ = bh_ & 7; \
            const bool ic_ = c_ < 2; const int blk_ = dir_ == 0 ? (ic_ ? c_ : c_ - 2) : (ic_ ? 1 - c_ : 17 - c_); \
            const size_t r0_ = ic_ ? (size_t)NLAT + b_ * TCX + blk_ * 128 : (size_t)b_ * TL + blk_ * 128; \
            const float* sp_ = SCN + (size_t)(bhd_ * NCH + (ic_ ? blk_ : blk_ + 2)) * 384; \
            _Pragma("unroll") for (int i = 0; i < 4; ++i) { const int id = t_ + NTHR * i; pk[i] = *(const v4u*)(KC + (r0_ + (id >> 4)) * 1024 + h_ * QKD + 8 * (id & 15)); pa[0][i] = sp_[128 + (id >> 4)]; } \
            pa[1][0] = GMAX[bhd_ * 17 + c_]; \
            _Pragma("unroll") for (int i = 0; i < 8; ++i) { const int id = t_ + NTHR * (i & 3); pv[i] = *(const v4u*)(Z + (r0_ + (id >> 4)) * ZW + ZV + h_ * VD + 128 * (i >> 2) + 8 * (id & 15)); } \
        } else { const int u2_ = u_ - N_M1, b_ = u2_ >> 7, n_ = (u2_ >> 3) & 15, grp_ = u2_ & 7; const size_t r0_ = (size_t)b_ * TL + n_ * 128; \
            _Pragma("unroll") for (int i = 0; i < 8; ++i) { const int id = t_ + NTHR * (i & 3); pv[i] = *(const v4u*)(SVN + (r0_ + (id >> 4)) * DM + grp_ * 256 + 128 * (i >> 2) + 8 * (id & 15)); } \
            } } while (0)
    int u = blockIdx.x;
    if (u < N_M1 + N_SGU) P4_ISSUE(u);
    for (; u < N_M1 + N_SGU; u += G) {
        int tid = tid_; asm volatile("" : "+v"(tid)); const int lane = tid & 63; const unsigned g = lane >> 4, l15 = lane & 15;
        const bool m1 = u < N_M1;
        TR_NAT_OFFS(xn0, xn1, lane)
#pragma unroll
        for (int i = 0; i < 8; ++i) { const int id = tid + NTHR * (i & 3); *(LAS v4u*)(lds + ((i >> 2) ? L_V1 : L_V0) + img_off(id >> 4, id & 15)) = pv[i]; }
        bf16x8 Af[4]; v2u uw[16];
        if (m1) { const float gmax = pa[1][0];
#pragma unroll
            for (int i = 0; i < 4; ++i) { const int id = tid + NTHR * i, row = id >> 4, ch = id & 15; const float sw = __expf(pa[0][i] - gmax); const v4u v = pk[i]; v4u o;
                o.x = cvt_pk_bf16(bf_lo(v.x) * sw, bf_hi(v.x) * sw); o.y = cvt_pk_bf16(bf_lo(v.y) * sw, bf_hi(v.y) * sw); o.z = cvt_pk_bf16(bf_lo(v.z) * sw, bf_hi(v.z) * sw); o.w = cvt_pk_bf16(bf_lo(v.w) * sw, bf_hi(v.w) * sw);
                *(LAS v4u*)(lds + L_K + img_off(row, ch)) = o; }
        }
        __syncthreads();
        f32x4 af32[8];
        if (!m1) { const int u2 = u - N_M1, b = u2 >> 7, n = (u2 >> 3) & 15, grp = u2 & 7;
            const float* src = sgu_w + (size_t)grp * 16384 + (size_t)(16 * wave + l15) * 128 + 8 * g;
#pragma unroll
            for (int ks = 0; ks < 4; ++ks) { af32[2 * ks] = *(const f32x4*)(src + 32 * ks); af32[2 * ks + 1] = *(const f32x4*)(src + 32 * ks + 4); }
            const bf16* up = Z + ((size_t)b * TL + n * 128 + 16 * wave + l15) * ZW + ZU + grp * 256 + 4 * g;
#pragma unroll
            for (int et = 0; et < 16; ++et) uw[et] = *(const v2u*)(up + 16 * et); }
        if (u + G < N_M1 + N_SGU) P4_ISSUE(u + G);
        if (!m1) {
#pragma unroll
            for (int ks = 0; ks < 4; ++ks) { const f32x4 a = af32[2 * ks], b2 = af32[2 * ks + 1];
                const v4u p = {cvt_pk_bf16(a[0], a[1]), cvt_pk_bf16(a[2], a[3]), cvt_pk_bf16(b2[0], b2[1]), cvt_pk_bf16(b2[2], b2[3])}; Af[ks] = __builtin_bit_cast(bf16x8, p); } }
        if (m1) {
            const int bhd = u / 17, c = u - bhd * 17;
#pragma unroll
            for (int ks = 0; ks < 4; ++ks) Af[ks] = tr_frag(lds + L_K, 32 * ks + 8 * g, 32 * ks + 8 * g + 4, wave, lane);
            f32x4 acc[17];
#pragma unroll
            for (int et = 0; et < 17; ++et) acc[et] = (f32x4){0.f, 0.f, 0.f, 0.f};
#pragma unroll
            for (int et = 0; et < 16; ++et) { LAS unsigned char* img = lds + ((et >> 3) ? L_V1 : L_V0);
#pragma unroll
                for (int ks = 0; ks < 4; ++ks) { const bf16x8 Bf = tr_frag2(img + 8192 * ks, xn0[et & 7], xn1[et & 7]); acc[et] = MFMA16(Af[ks], Bf, acc[et]); } }
            { const short one = l15 == 0 ? (short)0x3F80 : (short)0; const bf16x8 Bo = {one, one, one, one, one, one, one, one};
#pragma unroll
                for (int ks = 0; ks < 4; ++ks) acc[16] = MFMA16(Af[ks], Bo, acc[16]); }
            bf16* dst = DC + ((size_t)bhd * 17 + c) * (CROWS * 128) + 16 * wave + 4 * g;
#pragma unroll
            for (int et = 0; et < 16; ++et) { v2u o; o.x = cvt_pk_bf16(acc[et][0], acc[et][1]); o.y = cvt_pk_bf16(acc[et][2], acc[et][3]); *(v2u*)(dst + (size_t)(16 * et + l15) * 128) = o; }
            if (l15 == 0) { v2u o; o.x = cvt_pk_bf16(acc[16][0], acc[16][1]); o.y = cvt_pk_bf16(acc[16][2], acc[16][3]); *(v2u*)(dst + (size_t)256 * 128) = o; }
        } else {
            const int u2 = u - N_M1, b = u2 >> 7, n = (u2 >> 3) & 15, grp = u2 & 7; const size_t row0 = (size_t)b * TL + n * 128;
            f32x4 acc[16];
#pragma unroll
            for (int et = 0; et < 16; ++et) { acc[et] = (f32x4){0.f, 0.f, 0.f, 0.f}; LAS unsigned char* img = lds + ((et >> 3) ? L_V1 : L_V0);
#pragma unroll
                for (int ks = 0; ks < 4; ++ks) { const bf16x8 Bf = tr_frag2(img + 8192 * ks, xn0[et & 7], xn1[et & 7]); acc[et] = MFMA16(Bf, Af[ks], acc[et]); } }
            { const int t = 16 * wave + l15; const float zb = sgu_b[grp * 128 + t]; const size_t row = row0 + t;
#pragma unroll
              for (int et = 0; et < 16; ++et) { const int col = grp * 256 + 16 * et + 4 * g; const v2u w2 = uw[et];
                  const float o0 = gelu_tanh(bf_lo(w2.x)) * (acc[et][0] + zb), o1 = gelu_tanh(bf_hi(w2.x)) * (acc[et][1] + zb), o2 = gelu_tanh(bf_lo(w2.y)) * (acc[et][2] + zb), o3 = gelu_tanh(bf_hi(w2.y)) * (acc[et][3] + zb);
                  v2u o; o.x = cvt_pk_bf16(o0, o1); o.y = cvt_pk_bf16(o2, o3); *(v2u*)(CM + row * DM + col) = o; } }
        }
        __syncthreads();
    }
#undef P4_ISSUE
}

__device__ __forceinline__ void p5_scan(int tid, int G, const bf16* DC, const float* BEND, const float* GMAX, bf16* CS, float* MST) {
    constexpr int QPB = 257 * 128 / 4;
    for (int idx = blockIdx.x * NTHR + tid; idx < 64 * QPB; idx += G * NTHR) {
        const int bhd = idx / QPB, q = idx - bhd * QPB;
        f32x4 C = {0.f, 0.f, 0.f, 0.f}; float m = 0.f;
#pragma unroll
        for (int c = 0; c < 17; ++c) {
            const float gm = GMAX[bhd * 17 + c], be = BEND[bhd * 17 + c], mx = fmaxf(m, gm), al = __expf(m - mx), bt = __expf(gm - mx);
            const v2u dw = *(const v2u*)(DC + ((size_t)bhd * 17 + c) * (CROWS * 128) + 4 * q); const f32x4 d = {bf_lo(dw.x), bf_hi(dw.x), bf_lo(dw.y), bf_hi(dw.y)};
            C = C * al + d * bt; m = be + mx;
            if (c >= 1) { v2u o; o.x = cvt_pk_bf16(C[0], C[1]); o.y = cvt_pk_bf16(C[2], C[3]);
                *(v2u*)(CS + ((size_t)bhd * 16 + (c - 1)) * (CROWS * 128) + 4 * q) = o; if (q == 0) MST[bhd * 18 + c + 1] = m; }
        }
    }
}

__device__ __forceinline__ void p6_phase(LAS unsigned char* lds, int tid, int wave, int lane_, int G, const bf16* Z, const bf16* QC, const bf16* KC, const float* SCN,
                                         const bf16* CS, const float* MST, const float* mnorm_g, bf16* RO) {
    for (int u = blockIdx.x; u < 512; u += G) {
        int lane = lane_; asm volatile("" : "+v"(lane)); const unsigned g = lane >> 4, l15 = lane & 15;
        const int bh = u >> 4, jb = u & 15, b = bh >> 3, h = bh & 7; const size_t row0 = (size_t)b * TL + jb * 128;
        load_tile128(lds + L_K, KC + row0 * 1024 + h * QKD, 1024, tid);
        load_tile128(lds + L_V0, Z + row0 * ZW + ZV + h * VD, ZW, tid);
        load_tile128(lds + L_V1, Z + row0 * ZW + ZV + h * VD + 128, ZW, tid);
        bf16x8 Qf[4];
#pragma unroll
        for (int ks = 0; ks < 4; ++ks) Qf[ks] = *(const bf16x8*)(QC + (row0 + 16 * wave + l15) * 1024 + h * QKD + 32 * ks + 8 * g);
        __syncthreads();
        f32x4 hsum[16];
#pragma unroll
        for (int et = 0; et < 16; ++et) hsum[et] = (f32x4){0.f, 0.f, 0.f, 0.f};
#pragma unroll 1
        for (int dir = 0; dir < 2; ++dir) {
            int lane = lane_; asm volatile("" : "+v"(lane));
            const unsigned g = lane >> 4, l15 = lane & 15;
            TR_PERM_OFFS(xp, lane)
            const int c = dir ? 17 - jb : 2 + jb; const bf16* cs = CS + ((size_t)(bh * 2 + dir) * 16 + (c - 2)) * (CROWS * 128);
            const float* sp = SCN + (size_t)((bh * 2 + dir) * NCH + 2 + jb) * 384; const float* gg = sp + 128; const float mc = MST[(bh * 2 + dir) * 18 + c];
            const int tS = 16 * wave + l15; const float MtS = fmaxf(mc, sp[256 + tS]);
            unsigned pw[16];
#pragma unroll
            for (int st = 0; st < 8; ++st) { f32x4 aS = {0.f, 0.f, 0.f, 0.f};
#pragma unroll
                for (int ks = 0; ks < 4; ++ks) { const bf16x8 Kf = *(const LAS bf16x8*)(lds + L_K + img_off(16 * st + l15, 4 * ks + g)); aS = MFMA16(Kf, Qf[ks], aS); }
                float pv[4]; const f32x4 gs = *(const f32x4*)(gg + 16 * st + 4 * g);
#pragma unroll
                for (int r = 0; r < 4; ++r) { const int s = 16 * st + 4 * g + r; const bool ok = dir ? (s >= tS) : (s <= tS); const float ev = __expf(fminf(gs[r] - MtS, 0.f)); pv[r] = ok ? aS[r] * ev : 0.f; }
                pw[2 * st] = cvt_pk_bf16(pv[0], pv[1]); pw[2 * st + 1] = cvt_pk_bf16(pv[2], pv[3]); asm volatile("" ::: "memory"); }
            bf16x8 Pf[4];
#pragma unroll
            for (int ks = 0; ks < 4; ++ks) { const v4u t4 = {pw[4 * ks], pw[4 * ks + 1], pw[4 * ks + 2], pw[4 * ks + 3]}; Pf[ks] = __builtin_bit_cast(bf16x8, t4); }
            const float wiT = __expf(mc - MtS), flT = __expf(-(sp[tS] + MtS));
            const short one = l15 == 0 ? (short)0x3F80 : (short)0; const bf16x8 Bo = {one, one, one, one, one, one, one, one};
            float inv;
            { f32x4 ad = {0.f, 0.f, 0.f, 0.f};
#pragma unroll
              for (int ks = 0; ks < 4; ++ks) { bf16x8 Cf = *(const bf16x8*)(cs + (size_t)256 * 128 + 32 * ks + 8 * g); if (l15 != 0) Cf = (bf16x8){0, 0, 0, 0, 0, 0, 0, 0}; ad = MFMA16(Cf, Qf[ks], ad); }
              ad[0] *= wiT;
#pragma unroll
              for (int ks = 0; ks < 4; ++ks) ad = MFMA16(Bo, Pf[ks], ad);
              const float den = __shfl(ad[0], lane & 15); inv = 1.0f / fmaxf(fabsf(den), flT); }
            { v4u cr[2];
#pragma unroll
              for (int i = 0; i < 2; ++i) { const int id = tid + NTHR * i; cr[i] = *(const v4u*)(cs + (size_t)(id >> 4) * 128 + 8 * (id & 15)); }
#pragma unroll
              for (int i = 0; i < 2; ++i) { const int id = tid + NTHR * i; *(LAS v4u*)(lds + L_CB + img_off(id >> 4, id & 15)) = cr[i]; }
#pragma unroll
              for (int gq = 0; gq < 4; ++gq) {
                LAS unsigned char* cb = lds + L_CB + (gq & 1) * 16384;
                __syncthreads();
                if (gq < 3) {
#pragma unroll
                    for (int i = 0; i < 2; ++i) { const int id = tid + NTHR * i; cr[i] = *(const v4u*)(cs + (size_t)(64 * (gq + 1) + (id >> 4)) * 128 + 8 * (id & 15)); } }
                f32x4 acc[4];
#pragma unroll
                for (int i = 0; i < 4; ++i) { acc[i] = (f32x4){0.f, 0.f, 0.f, 0.f};
#pragma unroll
                    for (int ks = 0; ks < 4; ++ks) { const bf16x8 Cf = *(const LAS bf16x8*)(cb + img_off(16 * i + l15, 4 * ks + g)); acc[i] = MFMA16(Cf, Qf[ks], acc[i]); } }
#pragma unroll
                for (int i = 0; i < 4; ++i) acc[i] = acc[i] * wiT;
                { LAS unsigned char* img = lds + ((gq >> 1) ? L_V1 : L_V0);
#pragma unroll
                  for (int i = 0; i < 4; ++i) {
#pragma unroll
                    for (int ks = 0; ks < 4; ++ks) { const bf16x8 Vf = tr_frag2(img + 8192 * ks, xp[4 * (gq & 1) + i], xp[4 * (gq & 1) + i] + 4096u); acc[i] = MFMA16(Vf, Pf[ks], acc[i]); } } }
#pragma unroll
                for (int i = 0; i < 4; ++i) hsum[4 * gq + i] += acc[i] * inv;
                if (gq < 3) {
#pragma unroll
                    for (int i = 0; i < 2; ++i) { const int id = tid + NTHR * i; *(LAS v4u*)(lds + L_CB + ((gq + 1) & 1) * 16384 + img_off(id >> 4, id & 15)) = cr[i]; } }
              } }
        }
        { float ss = 0.f;
#pragma unroll
          for (int et = 0; et < 16; ++et) ss += (hsum[et][0] * hsum[et][0] + hsum[et][1] * hsum[et][1]) + (hsum[et][2] * hsum[et][2] + hsum[et][3] * hsum[et][3]);
          ss += __shfl_xor(ss, 16); ss += __shfl_xor(ss, 32);
          const float rstd = 1.0f / sqrtf(ss * (1.0f / VD) + EPS); const size_t row = row0 + 16 * wave + l15;
#pragma unroll
          for (int et = 0; et < 16; ++et) { const int col = h * VD + 16 * et + 4 * g;
              const v2u ow = *(const v2u*)(Z + row * ZW + ZO + col); const f32x4 gn = *(const f32x4*)(mnorm_g + col);
              const float v0 = hsum[et][0] * rstd * gn[0] * sigmoidf_(bf_lo(ow.x)), v1 = hsum[et][1] * rstd * gn[1] * sigmoidf_(bf_hi(ow.x));
              const float v2 = hsum[et][2] * rstd * gn[2] * sigmoidf_(bf_lo(ow.y)), v3 = hsum[et][3] * rstd * gn[3] * sigmoidf_(bf_hi(ow.y));
              v2u o; o.x = cvt_pk_bf16(v0, v1); o.y = cvt_pk_bf16(v2, v3); *(v2u*)(RO + row * DM + col) = o; } }
        __syncthreads();
    }
}

__device__ __forceinline__ void p9_phase(LAS unsigned char* lds, int wave, int lane, int G, const float* X1, const float* MOD, const float* norm_g, const bf16* SK, const float* router_b,
                                         unsigned* cnt, unsigned char* XG, int* RE, int* RR, float* RG) {
    LAS float* hrow = (LAS float*)(lds + wave * 8192); LAS float* part = (LAS float*)(lds + 65536);
    bf16x8 Bh[8][2]; SK_LOAD(Bh, SK + 2 * 65536);
    f32x4 vn[8];
    { const float* xr = X1 + (size_t)(blockIdx.x * 8 + wave) * DM;
#pragma unroll
      for (int j = 0; j < 8; ++j) vn[j] = *(const f32x4*)(xr + 4 * (lane + 64 * j)); }
    for (int it = blockIdx.x; it < NLAT / 8; it += G) {
        const int row = it * 8 + wave;
        const float* shift = MOD + (size_t)(row >> 11) * 12288 + 3 * 2048; const float* scale = shift + 2048;
        f32x4 v[8]; float ss = 0.f;
#pragma unroll
        for (int j = 0; j < 8; ++j) { v[j] = vn[j]; ss += (v[j][0] * v[j][0] + v[j][1] * v[j][1]) + (v[j][2] * v[j][2] + v[j][3] * v[j][3]); }
        const float rstd = 1.0f / sqrtf(wave_sum(ss) * (1.0f / DM) + EPS);
#pragma unroll
        for (int j = 0; j < 8; ++j) { const int col = 4 * (lane + 64 * j);
            const f32x4 g = *(const f32x4*)(norm_g + col), sc = *(const f32x4*)(scale + col), sh = *(const f32x4*)(shift + col);
            v[j] = (v[j] * rstd) * g * (sc + 1.0f) + sh; *(LAS f32x4*)(hrow + col) = v[j]; }
        if (it + G < NLAT / 8) { const float* xr = X1 + (size_t)((it + G) * 8 + wave) * DM;
#pragma unroll
            for (int j = 0; j < 8; ++j) vn[j] = *(const f32x4*)(xr + 4 * (lane + 64 * j)); }
        __syncthreads();
        skinny_mfma_r<false>((const LAS float*)lds, Bh, Bh, SK + 3 * 65536, part, wave, lane);
        __syncthreads();
        float val = router_b[lane & 31];
#pragma unroll
        for (int w = 0; w < 8; ++w) val += part[w * 256 + wave * 32 + (lane & 31)];
        float sv[4]; int si[4];
#pragma unroll
        for (int k = 0; k < 4; ++k) { float bv = val; int bi = lane & 31;
#pragma unroll
            for (int o = 16; o >= 1; o >>= 1) { const float ov = __shfl_xor(bv, o); const int oi = __shfl_xor(bi, o); const bool take = (ov > bv) || (ov == bv && oi < bi); bv = take ? ov : bv; bi = take ? oi : bi; }
            sv[k] = bv; si[k] = __builtin_amdgcn_readfirstlane(bi); if ((lane & 31) == bi) val = -3.0e38f; }
        const float e1 = __expf(sv[1] - sv[0]), e2 = __expf(sv[2] - sv[0]), e3 = __expf(sv[3] - sv[0]), inv = 1.0f / (1.0f + e1 + e2 + e3);
        const float gk[4] = {inv, e1 * inv, e2 * inv, e3 * inv};
        unsigned rank = 0;
        if (lane < 4) rank = __hip_atomic_fetch_add(cnt + (lane == 0 ? si[0] : lane == 1 ? si[1] : lane == 2 ? si[2] : si[3]), 1u, RLX_AGENT);
#pragma unroll
        for (int k = 0; k < 4; ++k) { const unsigned rk = (unsigned)__builtin_amdgcn_readlane((int)rank, k);
            unsigned char* dst = XG + ((size_t)si[k] * 8192 + rk) * DM;
#pragma unroll
            for (int j = 0; j < 8; ++j) *(unsigned*)(dst + 4 * (lane + 64 * j)) = pg8::pk4_fp8(v[j][0] * pg8::F8_SA, v[j][1] * pg8::F8_SA, v[j][2] * pg8::F8_SA, v[j][3] * pg8::F8_SA);
            if (lane == 0) { RE[row * 4 + k] = si[k]; RR[row * 4 + k] = (int)rk; RG[row * 4 + k] = gk[k]; } }
    }
}
__device__ __forceinline__ void moe_prefix(LAS int* pref, const unsigned* cnt, int tid) {
    if (tid == 0) { int s = 0; for (int e = 0; e < 32; ++e) { const unsigned ce = __hip_atomic_load(cnt + e, RLX_AGENT); pref[e] = s; pref[33 + e] = (int)ce; s += (int)((ce + 255u) >> 8); } pref[32] = s; }
    __syncthreads();
}
__device__ __forceinline__ void p12_phase(const LAS int* pref, int wave, int lane_, int G, const float* X1, const float* MOD, const bf16* Y2, const int* RE, const int* RR, const float* RG, const float* final_g, float* out) {
    const int gw = blockIdx.x * NWAVES + wave, NGW = G * NWAVES;
    int en[4], rn[4]; float gn[4];
    if (gw < NLAT) {
#pragma unroll
        for (int k = 0; k < 4; ++k) { en[k] = RE[gw * 4 + k]; rn[k] = RR[gw * 4 + k]; gn[k] = RG[gw * 4 + k]; } }
    for (int row = gw; row < NLAT; row += NGW) {
        int lane = lane_; asm volatile("" : "+v"(lane));
        const float* xr = X1 + (size_t)row * DM + 4 * lane; f32x4 xv[8]; v2u yv[4][8]; float gt[4];
#pragma unroll
        for (int k = 0; k < 4; ++k) { gt[k] = gn[k]; const bf16* src = Y2 + ((size_t)pref[en[k]] * 256 + rn[k]) * DM + 4 * lane;
#pragma unroll
            for (int j = 0; j < 8; ++j) yv[k][j] = __builtin_nontemporal_load((const v2u*)(src + 256 * j)); }
#pragma unroll
        for (int j = 0; j < 8; ++j) xv[j] = __builtin_nontemporal_load((const f32x4*)(xr + 256 * j));
        if (row + NGW < NLAT) { const int r2 = row + NGW;
#pragma unroll
            for (int k = 0; k < 4; ++k) { en[k] = RE[r2 * 4 + k]; rn[k] = RR[r2 * 4 + k]; gn[k] = RG[r2 * 4 + k]; } }
        const float* g5 = MOD + (size_t)(row >> 11) * 12288 + 5 * 2048; float ss = 0.f;
#pragma unroll
        for (int j = 0; j < 8; ++j) { f32x4 ys = {0.f, 0.f, 0.f, 0.f};
#pragma unroll
            for (int k = 0; k < 4; ++k) { const v2u y = yv[k][j]; ys[0] += gt[k] * bf_lo(y.x); ys[1] += gt[k] * bf_hi(y.x); ys[2] += gt[k] * bf_lo(y.y); ys[3] += gt[k] * bf_hi(y.y); }
            const int col = 4 * (lane + 64 * j); const f32x4 x2 = xv[j] + *(const f32x4*)(g5 + col) * ys; xv[j] = x2;
            ss += (x2[0] * x2[0] + x2[1] * x2[1]) + (x2[2] * x2[2] + x2[3] * x2[3]); }
        const float rstd = 1.0f / sqrtf(wave_sum(ss) * (1.0f / DM) + EPS);
#pragma unroll
        for (int j = 0; j < 8; ++j) { const int col = 4 * (lane + 64 * j); __builtin_nontemporal_store(xv[j] * rstd * *(const f32x4*)(final_g + col), (f32x4*)(out + (size_t)row * DM + col)); }
    }
}

#define XB_TMO      128
#define XB_XCNT(j)  (256  + 64 * (j))
#define XB_XSUB(j)  (1280 + 64 * (j))
#define XB_XGEN(j)  (2304 + 64 * (j))
#define XB_TOP      3328
#define XB_TOPGEN   3392
#define XCD_BAR_WORDS 3456
#define XB_SPIN_CAP (1u << 18)

__device__ __forceinline__ unsigned xb_ld(unsigned* p)              { return __hip_atomic_load(p, __ATOMIC_RELAXED, __HIP_MEMORY_SCOPE_AGENT); }
__device__ __forceinline__ unsigned xb_add(unsigned* p, unsigned v) { return __hip_atomic_fetch_add(p, v, __ATOMIC_RELAXED, __HIP_MEMORY_SCOPE_AGENT); }
__device__ __forceinline__ unsigned xb_xcc_id() { return (unsigned)__builtin_amdgcn_s_getreg((3 << 11) | 20) & 0xFu; }
#define XB_SPIN(cond, bar) do { unsigned _sp = 0; while (cond) { __builtin_amdgcn_s_sleep(1); \
    if ((++_sp & 255u) == 0u) { if (xb_ld(&(bar)[XB_TMO])) break; if (_sp > XB_SPIN_CAP) { atomicAdd(&(bar)[XB_TMO], 1u); break; } } } } while (0)

struct XcdBarrier {
    unsigned* bar; unsigned x;
    volatile LAS unsigned* st;
};

__device__ __forceinline__ XcdBarrier xcd_barrier_post(unsigned* bar, volatile LAS unsigned* st) {
    XcdBarrier b; b.bar = bar; b.x = xb_xcc_id(); b.st = st;
    if (threadIdx.x == 0) (void)xb_add(&bar[XB_XCNT(b.x)], 1u);
    return b;
}
__device__ __forceinline__ void xcd_barrier_complete(unsigned* bar, unsigned x, unsigned& nloc, unsigned& nx) {
    const unsigned G = gridDim.x * gridDim.y * gridDim.z;
    unsigned sum, cnt, mine, sp = 0u;
    for (;;) {
        sum = 0u; cnt = 0u; mine = 0u;
#pragma unroll
        for (unsigned j = 0; j < 16; ++j) { const unsigned c = xb_ld(&bar[XB_XCNT(j)]); sum += c; cnt += (c > 0u) ? 1u : 0u; mine = (j == x) ? c : mine; }
        if (sum == G) break;
        __builtin_amdgcn_s_sleep(1);
        if ((++sp & 255u) == 0u) { if (xb_ld(&bar[XB_TMO])) break; if (sp > XB_SPIN_CAP) { atomicAdd(&bar[XB_TMO], 1u); break; } }
    }
    nloc = mine > 0u ? mine : 1u; nx = cnt > 0u ? cnt : 1u;
}

__device__ __forceinline__ void xcd_barrier(const XcdBarrier& b) {
    asm volatile("s_waitcnt vmcnt(0)" ::: "memory");
    __syncthreads();
    if (threadIdx.x == 0) {
        unsigned* bar = b.bar;
        __builtin_amdgcn_s_waitcnt(0);
        unsigned nloc = b.st[0], nx = b.st[1];
        if (nloc == 0u) { xcd_barrier_complete(bar, b.x, nloc, nx); b.st[0] = nloc; b.st[1] = nx; }
        const unsigned old = xb_add(&bar[XB_XSUB(b.x)], 1u);
        const unsigned gen = old / nloc;
        if (old + 1u == (gen + 1u) * nloc) {
            __builtin_amdgcn_fence(__ATOMIC_RELEASE, "agent");
            asm volatile("s_waitcnt vmcnt(0)" ::: "memory");
            const unsigned og = xb_add(&bar[XB_TOP], 1u);
            const unsigned tg = og / nx;
            if (og + 1u == (tg + 1u) * nx) xb_add(&bar[XB_TOPGEN], 1u);
            else XB_SPIN(xb_ld(&bar[XB_TOPGEN]) == tg, bar);
            __builtin_amdgcn_fence(__ATOMIC_ACQUIRE, "agent");
            xb_add(&bar[XB_XGEN(b.x)], 1u);
            asm volatile("s_waitcnt vmcnt(0)" ::: "memory");
        } else {
            XB_SPIN(xb_ld(&bar[XB_XGEN(b.x)]) == gen, bar);
            __builtin_amdgcn_fence(__ATOMIC_ACQUIRE, "agent");
            asm volatile("s_waitcnt vmcnt(0)" ::: "memory");
        }
    }
    __syncthreads();
}

struct Args { const float* in[26]; float* out; unsigned char* ws; int ph_lo, ph_hi; };
__global__ void __launch_bounds__(NTHR, 2) mk_fwd(Args args) {
    extern __shared__ __attribute__((aligned(16))) unsigned char lds_raw[];
    LAS unsigned char* lds = (LAS unsigned char*)lds_raw;
    const int tid = threadIdx.x, lane = tid & 63, wave = __builtin_amdgcn_readfirstlane(tid >> 6), G = gridDim.x;
    unsigned char* ws = args.ws;
    gu32* ctl = (gu32*)(ws + WS_CTL);
    for (int u = tid; u < (LDS_BYTES - LDSCTL_OFF) / 4; u += NTHR) ((LAS unsigned*)(lds + LDSCTL_OFF))[u] = 0u;
    __syncthreads();
    volatile LAS unsigned* MISC = (volatile LAS unsigned*)(lds + MISC_OFF);
    XcdBarrier bar; bar.bar = (unsigned*)(ctl + CW_BAR); bar.x = 0; bar.st = nullptr;
    if (N_LAUNCHES == 1) bar = xcd_barrier_post((unsigned*)(ctl + CW_BAR), MISC + 8);
#define GRID_BAR() do { if (N_LAUNCHES == 1) xcd_barrier(bar); } while (0)
    const int lo = args.ph_lo, hi = args.ph_hi;
#ifdef ONLY_PHASE
#define IN(k) ((k) == ONLY_PHASE && lo <= (k) && (k) < hi)
#else
#define IN(k) (lo <= (k) && (k) < hi)
#endif
#define BOTH(k) (IN(k) && IN((k) + 1))
#ifndef REP_MASK
#define REP_MASK 0
#endif
#define NREP(k) ((((REP_MASK) >> (k)) & 1) ? 2 : 1)
#define INP(i) (args.in[i])
#define WSF(off) ((float*)(ws + (off)))
#define WSB(off) ((bf16*)(ws + (off)))
#define WSI(off) ((int*)(ws + (off)))
    unsigned* cnt = (unsigned*)(ctl + CW_CNT);
    LAS int* pref = (LAS int*)(lds + PREF_OFF);
    const int n_conv_p0 = I_WIN + 3 * I_P;
#define x_in INP(0)
#define cvec INP(1)
#define ctx INP(2)
#define c_ctx INP(3)
#define mod_w INP(4)
#define mod_b INP(5)
#define norm1_g INP(6)
#define norm2_g INP(7)
#define w_in INP(8)
#define gate_b INP(9)
#define conv_w INP(10)
#define conv_b INP(11)
#define mnorm_g INP(12)
#define sgu_norm_g INP(13)
#define sgu_w INP(14)
#define sgu_b INP(15)
#define proj_a INP(16)
#define proj_b INP(17)
#define w_out INP(18)
#define router_w INP(19)
#define router_b INP(20)
#define exp_w1 INP(21)
#define exp_b1 INP(22)
#define exp_w2 INP(23)
#define exp_b2 INP(24)
#define final_g INP(25)
#define MOD WSF(WS_MOD)
#define GATES WSF(WS_GATES)
#define BEND WSF(WS_SCAL)
#define GMAX (WSF(WS_SCAL) + 64 * 17)
#define MST (WSF(WS_SCAL) + 2 * 64 * 17)
#define RE WSI(WS_ROUTE)
#define RR (WSI(WS_ROUTE) + NLAT * 4)
#define RG (WSF(WS_ROUTE) + 2 * NLAT * 4)
#define WINT WSB(WS_WINT)
#define SKW WSB(WS_SK)
#define SCN WSF(WS_SCN)
#define PAT WSB(WS_PAT)
#define PBT WSB(WS_PBT)
#define WOT WSB(WS_WOT)
#define W1T WSB(WS_W1T)
#define W1T8 ((unsigned char*)(ws + WS_W1T))
#define HB8M ((unsigned char*)(ws + WS_HB8))
#define WG8M ((unsigned char*)(ws + WS_WG8))
#define W2T8 ((unsigned char*)(ws + WS_W2T))
#define XG8 ((unsigned char*)(ws + WS_XG))
#define ACT8 ((unsigned char*)(ws + WS_ACT))
#define W2T WSB(WS_W2T)
#define HB WSB(WS_HB)
#define Z WSB(WS_Z)
#define QC WSB(WS_QC)
#define KC WSB(WS_KC)
#define SVN WSB(WS_SVN)
#define DC WSB(WS_DC)
#define CS WSB(WS_CS)
#define RO WSB(WS_RO)
#define CM WSB(WS_CM)
#define YB WSB(WS_YB)
#define MRG WSB(WS_MRG)
#define X1 WSF(WS_X1)
#define ACT WSB(WS_ACT)
#define Y2 WSB(WS_Y2)
#define XG WSB(WS_XG)

    if (IN(0)) for (int rep_ = 0; rep_ < NREP(0); ++rep_) { p0_phase(lds, tid, G, cvec, c_ctx, mod_w, mod_b, MOD, w_in, proj_a, proj_b, w_out, exp_w1, exp_w2, router_w, WINT, PAT, PBT, WOT, W1T, W2T, SKW, n_conv_p0);
        cvt_run8(lds, tid, I_W1 + I_W2 + (int)blockIdx.x, G, I_W1 + I_W2 + I_GATE8, exp_w1, exp_w2, w_in, W1T8, W2T8, WG8M); if (BOTH(0) || rep_ + 1 < NREP(0)) GRID_BAR(); }
    if (IN(1)) for (int rep_ = 0; rep_ < NREP(1); ++rep_) { p1_phase(lds, tid, wave, lane, G, x_in, ctx, MOD, norm1_g, SKW, gate_b, HB, HB8M, GATES); if (BOTH(1) || rep_ + 1 < NREP(1)) GRID_BAR(); }
    if (IN(2)) for (int rep_ = 0; rep_ < NREP(2); ++rep_) {
        if ((int)blockIdx.x >= G - (G == 256 ? N_CONVERTERS : G))
            cvt_run8(lds, tid, (int)blockIdx.x - (G - (G == 256 ? N_CONVERTERS : G)), (G == 256 ? N_CONVERTERS : G), I_W1 + I_W2, exp_w1, exp_w2, w_in, W1T8, W2T8, WG8M);
        { pg8::Gemm g{(const bf16*)HB8M, (const bf16*)WG8M, NTOK, 12288, DM}; pg8::DynOrder S{(unsigned*)(ctl + CW_Q2), (LAS int*)(lds + PREF_OFF + 808), (int)(blockIdx.x & 7), 48, 8, 0}; pg8::EpiGate8 E{Z, ZW};
          pg8::gemm_phase8<pg8::EpiGate8, pg8::DynOrder, true, true>(lds, g, S, E); }
        { pg8::Gemm g{HB, WINT, NLAT, ZW, DM}; pg8::DynOrder S{(unsigned*)(ctl + CW_Q), (LAS int*)(lds + PREF_OFF + 800), (int)(blockIdx.x & 7), 8, 0, 24}; pg8::EpiBf16 E{Z, ZW, nullptr, ZW / 256};
          pg8::gemm_phase<pg8::EpiBf16, pg8::DynOrder, true, true>(lds, g, S, E); }
        if (BOTH(2) || rep_ + 1 < NREP(2)) GRID_BAR();
    }
    if (IN(3)) for (int rep_ = 0; rep_ < NREP(3); ++rep_) { p3_phase(wave, lane, G, Z, conv_w, conv_b, sgu_norm_g, QC, KC, SVN, GATES, SCN, BEND, GMAX); if (BOTH(3) || rep_ + 1 < NREP(3)) GRID_BAR(); }
    if (IN(4)) for (int rep_ = 0; rep_ < NREP(4); ++rep_) { p4_phase(lds, tid, wave, lane, G, Z, KC, SVN, SCN, sgu_w, sgu_b, DC, GMAX, CM); if (BOTH(4) || rep_ + 1 < NREP(4)) GRID_BAR(); }
    if (IN(5)) for (int rep_ = 0; rep_ < NREP(5); ++rep_) {
        { pg8::Gemm g{CM, PBT, NLAT, DM, DM}; pg8::StaticOrder S; S.init(NLAT, DM, G, (int)blockIdx.x); pg8::EpiBf16 E{YB, DM, nullptr, DM / 256};
          pg8::gemm_phase<pg8::EpiBf16, pg8::StaticOrder, true, true>(lds, g, S, E); }
        p5_scan(tid, G, DC, BEND, GMAX, CS, MST);
        if (BOTH(5) || rep_ + 1 < NREP(5)) GRID_BAR();
    }
    if (IN(6)) for (int rep_ = 0; rep_ < NREP(6); ++rep_) { p6_phase(lds, tid, wave, lane, G, Z, QC, KC, SCN, CS, MST, mnorm_g, RO); if (BOTH(6) || rep_ + 1 < NREP(6)) GRID_BAR(); }
    if (IN(7)) for (int rep_ = 0; rep_ < NREP(7); ++rep_) {
        pg8::Gemm g{RO, PAT, NLAT, DM, DM}; pg8::StaticOrder S; S.init(NLAT, DM, G, (int)blockIdx.x); pg8::EpiMerge E{MRG, Z, ZW, ZGA, ZGB, YB};
        pg8::gemm_phase<pg8::EpiMerge, pg8::StaticOrder, true, true>(lds, g, S, E);
        if (BOTH(7) || rep_ + 1 < NREP(7)) GRID_BAR();
    }
    if (IN(8)) for (int rep_ = 0; rep_ < NREP(8); ++rep_) {
        pg8::Gemm g{MRG, WOT, NLAT, DM, DM}; pg8::StaticOrder S; S.init(NLAT, DM, G, (int)blockIdx.x); pg8::EpiX1 E{X1, x_in, MOD};
        pg8::gemm_phase<pg8::EpiX1, pg8::StaticOrder, true, true>(lds, g, S, E);
        if (BOTH(8) || rep_ + 1 < NREP(8)) GRID_BAR();
    }
    if (IN(9)) for (int rep_ = 0; rep_ < NREP(9); ++rep_) { p9_phase(lds, wave, lane, G, X1, MOD, norm2_g, SKW, router_b, cnt, XG8, RE, RR, RG); if (BOTH(9) || rep_ + 1 < NREP(9)) GRID_BAR(); }
    if (IN(10)) for (int rep_ = 0; rep_ < NREP(10); ++rep_) {
        moe_prefix(pref, cnt, tid);
        pg8::Gemm g{(const bf16*)XG8, (const bf16*)W1T8, 0, 0, DM}; pg8::MoeDyn S{pref, 16, 1, (unsigned*)(ctl + CW_Q3), (LAS int*)(lds + PREF_OFF + 816), (int)(blockIdx.x & 7)}; pg8::EpiSwiglu8 E{ACT8, exp_b1};
        pg8::gemm_phase8<pg8::EpiSwiglu8, pg8::MoeDyn, true, true, true>(lds, g, S, E);
        if (BOTH(10) || rep_ + 1 < NREP(10)) GRID_BAR();
    }
    if (IN(11)) for (int rep_ = 0; rep_ < NREP(11); ++rep_) {
        moe_prefix(pref, cnt, tid);
        pg8::Gemm g{(const bf16*)ACT8, (const bf16*)W2T8, 0, 0, DEXP}; pg8::MoeDyn S{pref, 8, 0, (unsigned*)(ctl + CW_Q4), (LAS int*)(lds + PREF_OFF + 824), (int)(blockIdx.x & 7)}; pg8::EpiY2f8 E{Y2, exp_b2};
        pg8::gemm_phase8<pg8::EpiY2f8, pg8::MoeDyn, true, true, true>(lds, g, S, E);
        if (BOTH(11) || rep_ + 1 < NREP(11)) GRID_BAR();
    }
    if (IN(12)) for (int rep_ = 0; rep_ < NREP(12); ++rep_) { moe_prefix(pref, cnt, tid); p12_phase(pref, wave, lane, G, X1, MOD, Y2, RE, RR, RG, final_g, args.out); if (rep_ + 1 < NREP(12)) GRID_BAR(); }
#undef IN
#undef BOTH
}

extern "C" void kernel_launch(void* const* d_in, const int* in_sizes, int n_in, void* d_out, int out_size, void* d_ws, size_t ws_size, hipStream_t stream) {
    static int grid = 0;
    if (grid == 0) {
        if (n_in != 26 || out_size != NLAT * DM || ws_size < WS_END) { fprintf(stderr, "kernel_launch: unexpected shapes (n_in %d, out %d, ws %zu)\n", n_in, out_size, ws_size); grid = -1; return; }
        int dev = 0, cus = 0;
        if (hipGetDevice(&dev) != hipSuccess || hipDeviceGetAttribute(&cus, hipDeviceAttributeMultiprocessorCount, dev) != hipSuccess) { grid = -1; return; }
        if (hipFuncSetAttribute((const void*)mk_fwd, hipFuncAttributeMaxDynamicSharedMemorySize, LDS_BYTES) != hipSuccess) { fprintf(stderr, "kernel_launch: hipFuncSetAttribute failed\n"); grid = -1; return; }
        int per_cu = 0;
        if (hipOccupancyMaxActiveBlocksPerMultiprocessor(&per_cu, (const void*)mk_fwd, NTHR, LDS_BYTES) != hipSuccess || per_cu < 1) fprintf(stderr, "kernel_launch: occupancy query reports %d\n", per_cu);
        (void)hipGetLastError();
        grid = cus;
    }
    if (grid < 0) return;
    if (hipMemsetAsync((char*)d_ws + WS_CTL, 0, CTL_ZERO_BYTES, stream) != hipSuccess) return;
    Args a{};
    for (int i = 0; i < 26; ++i) a.in[i] = (const float*)d_in[i];
    a.out = (float*)d_out; a.ws = (unsigned char*)d_ws;
    for (int li = 0; li < N_LAUNCHES; ++li) {
        a.ph_lo = (N_LAUNCHES == 1) ? 0 : li; a.ph_hi = (N_LAUNCHES == 1) ? N_PHASES : li + 1;
        hipLaunchKernelGGL(mk_fwd, dim3(grid), dim3(NTHR), LDS_BYTES, stream, a);
        const hipError_t le = hipPeekAtLastError();
        if (le != hipSuccess) { fprintf(stderr, "kernel_launch: launch %d failed: %s\n", li, hipGetErrorName(le)); break; }
    }
}
```

```cpp
#include <hip/hip_runtime.h>
#include <cstdio>
#include <cstdint>
#ifndef MK_N_LAUNCHES
#define MK_N_LAUNCHES 1
#endif
namespace pg8 {
#define PG8_LAS __attribute__((address_space(3)))
typedef unsigned short bf16_t;
typedef short bf16x8 __attribute__((ext_vector_type(8)));
typedef float f32x4 __attribute__((ext_vector_type(4)));
typedef unsigned u32x4 __attribute__((ext_vector_type(4)));
typedef int i32x4 __attribute__((ext_vector_type(4)));
typedef int i32x8 __attribute__((ext_vector_type(8)));
constexpr int BM = 256, BK = 64, HALF = 128, HTB = HALF * BK * 2  , STAGE_BYTES = 8 * HTB, NXCD = 8, WGM = 8;

__host__ __device__ __forceinline__ int lds_byte(int r, int c) { const int st = (r >> 4) * 2 + (c >> 5), rr = r & 15, cc = c & 31, ob = rr * 64 + cc * 2; return st * 1024 + (ob ^ (((ob >> 9) & 1) << 5)); }
__host__ __device__ __forceinline__ void stage_rc(int b, int& R, int& C) { const int st = b / 1024, sb = b % 1024, swz = sb ^ (((sb >> 9) & 1) << 5); R = (st >> 1) * 16 + swz / 64; C = (st & 1) * 32 + (swz % 64) / 2; }
__host__ __device__ __forceinline__ int perm32(int rho) { const int n = rho >> 4, i = rho & 15; return 8 * (i >> 2) + 4 * n + (i & 3); }

struct Unit { int pm, pn, po, hf; };
struct Gemm { const bf16_t* A; const bf16_t* Bt; int M, N, K; };

struct StaticOrder {
    int nM, nN, nwg, G, c;
    __host__ __device__ void init(int M, int N, int G_, int c_) { nM = M / BM; nN = N / BM; nwg = nM * nN; G = G_; c = c_; }
    __host__ __device__ bool next(int i, Unit& u) const {
        const long L = (long)i * G + c; if (L >= nwg) return false;
        int wgid = (int)L; { const int q = nwg / NXCD, r = nwg % NXCD, xcd = wgid % NXCD, off = wgid / NXCD; wgid = (xcd < r ? xcd * (q + 1) : r * (q + 1) + (xcd - r) * q) + off; }
        const int nig = WGM * nN, gid = wgid / nig, fm = gid * WGM, gsz = (nM - fm) < WGM ? (nM - fm) : WGM;
        u.pm = fm + ((wgid % nig) % gsz); u.pn = (wgid % nig) / gsz; u.po = u.pm; u.hf = 0; return true;
    }
    __device__ __forceinline__ void a_ready(const Unit&) const {}
    __device__ __forceinline__ void done(const Unit&) const {}
};
struct DynOrder {
    unsigned* q; PG8_LAS int* slot; int xcd, nN, ctx8, pn0;
    __device__ __forceinline__ bool next(int i, Unit& u) const {
        if (threadIdx.x == 0) { int id = -1;
            unsigned v = __hip_atomic_fetch_add(q + 64 * xcd, 1u, __ATOMIC_RELAXED, __HIP_MEMORY_SCOPE_AGENT);
            const unsigned per = (unsigned)(4 * nN + ctx8);
            if (v < per) id = xcd * (int)per + (int)v;
            else {
#pragma unroll 1
                for (int k = 1; k < 8 && id < 0; ++k) { const int x = (xcd + k) & 7;
                    if (__hip_atomic_load(q + 64 * x, __ATOMIC_RELAXED, __HIP_MEMORY_SCOPE_AGENT) < per) { v = __hip_atomic_fetch_add(q + 64 * x, 1u, __ATOMIC_RELAXED, __HIP_MEMORY_SCOPE_AGENT); if (v < per) id = x * (int)per + (int)v; } } }
            slot[i & 1] = id; asm volatile("s_waitcnt lgkmcnt(0)" ::: "memory"); }
        asm volatile("" ::: "memory"); __builtin_amdgcn_s_barrier(); asm volatile("" ::: "memory");
        const int id = slot[i & 1]; if (id < 0) return false;
        const int per = 4 * nN + ctx8, nl = 4 * nN, x = id / per, v = id - x * per;
        if (v < nl) { const int wgid = x * nl + v, nig = WGM * nN, gid = wgid / nig; u.pm = gid * WGM + ((wgid % nig) % WGM); u.pn = pn0 + (wgid % nig) / WGM; }
        else { const int j = x * 8 + (v - nl); u.pm = 32 + (j & 3); u.pn = j >> 2; }
        u.po = u.pm; u.hf = 0; return true;
    }
    __device__ __forceinline__ void a_ready(const Unit&) const {}
    __device__ __forceinline__ void done(const Unit&) const {}
};
struct MoeOrder {
    const PG8_LAS int* pref; int nN, G, c, a_sparse;
    __device__ __forceinline__ bool next(int i, Unit& u) const {
        const int L = i * G + c, total = pref[32]; if (L >= total * nN) return false;
        const int mt = L / nN, nt = L - mt * nN; int e = 0;
        for (int k = 1; k < 32; ++k) e += (pref[k] <= mt) ? 1 : 0;
        u.pm = a_sparse ? e * 32 + (mt - pref[e]) : mt; u.pn = e * nN + nt; u.po = mt; u.hf = (pref[33 + e] - 256 * (mt - pref[e]) <= 128) ? 1 : 0; return true;
    }
    __device__ __forceinline__ void a_ready(const Unit&) const {}
    __device__ __forceinline__ void done(const Unit&) const {}
};

struct MoeDyn {
    const PG8_LAS int* pref; int nN, a_sparse; unsigned* q; PG8_LAS int* slot; int xcd;
    __device__ __forceinline__ bool next(int i, Unit& u) const {
        const int total = pref[32], k = nN >> 3;
        if (threadIdx.x == 0) { int id = -1; const unsigned per = (unsigned)(total * k);
            unsigned v = __hip_atomic_fetch_add(q + 64 * xcd, 1u, __ATOMIC_RELAXED, __HIP_MEMORY_SCOPE_AGENT);
            if (v < per) id = (xcd << 16) | (int)v;
            else {
#pragma unroll 1
                for (int j = 1; j < 8 && id < 0; ++j) { const int x = (xcd + j) & 7;
                    if (__hip_atomic_load(q + 64 * x, __ATOMIC_RELAXED, __HIP_MEMORY_SCOPE_AGENT) < per) { v = __hip_atomic_fetch_add(q + 64 * x, 1u, __ATOMIC_RELAXED, __HIP_MEMORY_SCOPE_AGENT); if (v < per) id = (x << 16) | (int)v; } } }
            slot[i & 1] = id; asm volatile("s_waitcnt lgkmcnt(0)" ::: "memory"); }
        asm volatile("" ::: "memory"); __builtin_amdgcn_s_barrier(); asm volatile("" ::: "memory");
        const int id = slot[i & 1]; if (id < 0) return false;
        const int x = id >> 16, v = id & 0xffff, mt = v / k, nt = x + 8 * (v - mt * k); int e = 0;
        for (int j = 1; j < 32; ++j) e += (pref[j] <= mt) ? 1 : 0;
        u.pm = a_sparse ? e * 32 + (mt - pref[e]) : mt; u.pn = e * nN + nt; u.po = mt; u.hf = (pref[33 + e] - 256 * (mt - pref[e]) <= 128) ? 1 : 0; return true;
    }
    __device__ __forceinline__ void a_ready(const Unit&) const {}
    __device__ __forceinline__ void done(const Unit&) const {}
};

__device__ __forceinline__ unsigned cvt_pk_bf16(float lo, float hi) { unsigned r; asm volatile("v_cvt_pk_bf16_f32 %0, %1, %2" : "=v"(r) : "v"(lo), "v"(hi)); return r; }
__device__ __forceinline__ float bf_lo(unsigned w) { return __uint_as_float(w << 16); }
__device__ __forceinline__ float bf_hi(unsigned w) { return __uint_as_float(w & 0xffff0000u); }
__device__ __forceinline__ unsigned pk4_fp8(float a, float b, float c, float d) {
    a = fminf(fmaxf(a, -448.f), 448.f); b = fminf(fmaxf(b, -448.f), 448.f); c = fminf(fmaxf(c, -448.f), 448.f); d = fminf(fmaxf(d, -448.f), 448.f);
    int p = __builtin_amdgcn_cvt_pk_fp8_f32(a, b, 0, false); p = __builtin_amdgcn_cvt_pk_fp8_f32(c, d, p, true); return (unsigned)p; }
constexpr float F8_SA = 16.0f, F8_SW = 512.0f, F8_SC = 4.0f;
__device__ __forceinline__ float sigmoidf_(float x) { return __builtin_amdgcn_rcpf(1.0f + __expf(-x)); }

struct EpiBf16 {
    static constexpr bool PERM = true, AFTER_DRAIN = false;
    bf16_t* O; int ldc; const float* bias; int ncolt;
    __device__ __forceinline__ void operator()(const f32x4 (&acc)[2][2][4][2], const Unit& u, int wr, int wc, int fr, int fq) const {
        const int row0 = u.po * BM + wr * 64 + fr; const int colt = (u.pn % ncolt) * BM;
        const int col0 = colt + wc * 32 + 8 * fq, bcol0 = u.pn * BM + wc * 32 + 8 * fq;
        f32x4 bv[2][2];
#pragma unroll
        for (int bj = 0; bj < 2; ++bj)
#pragma unroll
            for (int n = 0; n < 2; ++n) bv[bj][n] = bias ? *(const f32x4*)(bias + bcol0 + bj * HALF + 4 * n) : (f32x4){0.f, 0.f, 0.f, 0.f};
#pragma unroll
        for (int ai = 0; ai < 2; ++ai)
#pragma unroll
            for (int m = 0; m < 4; ++m) { bf16_t* rowp = O + (size_t)(row0 + ai * HALF + m * 16) * ldc + col0;
#pragma unroll
                for (int bj = 0; bj < 2; ++bj) { const f32x4 v0 = acc[ai][bj][m][0] + bv[bj][0], v1 = acc[ai][bj][m][1] + bv[bj][1];
                    u32x4 w; w.x = cvt_pk_bf16(v0[0], v0[1]); w.y = cvt_pk_bf16(v0[2], v0[3]); w.z = cvt_pk_bf16(v1[0], v1[1]); w.w = cvt_pk_bf16(v1[2], v1[3]);
                    __builtin_nontemporal_store(w, (u32x4*)(rowp + bj * HALF)); } }
    }
};
struct EpiSwiglu8 {
    static constexpr bool PERM = true, AFTER_DRAIN = false;
    unsigned char* O; const float* b1;
    __device__ __forceinline__ void operator()(const f32x4 (&acc)[2][2][4][2], const Unit& u, int wr, int wc, int fr, int fq) const {
        const int e = u.pn >> 4, nt = u.pn & 15; const int row0 = u.po * BM + wr * 64 + fr, j0 = nt * 128 + wc * 32 + 8 * fq;
        const float* bg = b1 + (size_t)e * 4096 + j0; const float* bl = bg + 2048; constexpr float us = 1.0f / (F8_SA * F8_SW);
#pragma unroll
        for (int ai = 0; ai < 2; ++ai)
#pragma unroll
            for (int m = 0; m < 4; ++m) { const size_t row = (size_t)(row0 + ai * HALF + m * 16);
                asm volatile("" ::: "memory");
                unsigned w[2];
#pragma unroll
                for (int n = 0; n < 2; ++n) { const f32x4 gv = acc[ai][0][m][n] * us + *(const f32x4*)(bg + 4 * n), lv = acc[ai][1][m][n] * us + *(const f32x4*)(bl + 4 * n);
                    float o[4];
#pragma unroll
                    for (int i = 0; i < 4; ++i) { const float ga = fminf(gv[i], 7.0f), la = fminf(fmaxf(lv[i], -7.0f), 7.0f); o[i] = ga * sigmoidf_(1.702f * ga) * (la + 1.0f) * F8_SC; }
                    w[n] = pk4_fp8(o[0], o[1], o[2], o[3]); }
                typedef unsigned u32x2 __attribute__((ext_vector_type(2))); const u32x2 ww = {w[0], w[1]};
                *(u32x2*)(O + row * 2048 + j0) = ww; }
    }
};
struct EpiY2f8 {
    static constexpr bool PERM = true, AFTER_DRAIN = false;
    bf16_t* O; const float* bias;
    __device__ __forceinline__ void operator()(const f32x4 (&acc)[2][2][4][2], const Unit& u, int wr, int wc, int fr, int fq) const {
        const int row0 = u.po * BM + wr * 64 + fr; const int col0 = (u.pn & 7) * BM + wc * 32 + 8 * fq, bcol0 = u.pn * BM + wc * 32 + 8 * fq; constexpr float us = 1.0f / (F8_SC * F8_SW);
        f32x4 bv[2][2];
#pragma unroll
        for (int bj = 0; bj < 2; ++bj)
#pragma unroll
            for (int n = 0; n < 2; ++n) bv[bj][n] = *(const f32x4*)(bias + bcol0 + bj * HALF + 4 * n);
#pragma unroll
        for (int ai = 0; ai < 2; ++ai)
#pragma unroll
            for (int m = 0; m < 4; ++m) { bf16_t* rowp = O + (size_t)(row0 + ai * HALF + m * 16) * 2048 + col0;
#pragma unroll
                for (int bj = 0; bj < 2; ++bj) { const f32x4 v0 = acc[ai][bj][m][0] * us + bv[bj][0], v1 = acc[ai][bj][m][1] * us + bv[bj][1];
                    u32x4 w; w.x = cvt_pk_bf16(v0[0], v0[1]); w.y = cvt_pk_bf16(v0[2], v0[3]); w.z = cvt_pk_bf16(v1[0], v1[1]); w.w = cvt_pk_bf16(v1[2], v1[3]);
                    __builtin_nontemporal_store(w, (u32x4*)(rowp + bj * HALF)); } }
    }
};
struct EpiGate8 {
    static constexpr bool PERM = true, AFTER_DRAIN = false;
    bf16_t* O; int ldc;
    __device__ __forceinline__ void operator()(const f32x4 (&acc)[2][2][4][2], const Unit& u, int wr, int wc, int fr, int fq) const {
        const int row0 = u.po * BM + wr * 64 + fr, col0 = (u.pn < 24 ? u.pn : u.pn + 8) * BM + wc * 32 + 8 * fq; constexpr float us = 1.0f / (F8_SA * F8_SW);
#pragma unroll
        for (int ai = 0; ai < 2; ++ai)
#pragma unroll
            for (int m = 0; m < 4; ++m) { bf16_t* rowp = O + (size_t)(row0 + ai * HALF + m * 16) * ldc + col0;
#pragma unroll
                for (int bj = 0; bj < 2; ++bj) { const f32x4 v0 = acc[ai][bj][m][0] * us, v1 = acc[ai][bj][m][1] * us;
                    u32x4 w; w.x = cvt_pk_bf16(v0[0], v0[1]); w.y = cvt_pk_bf16(v0[2], v0[3]); w.z = cvt_pk_bf16(v1[0], v1[1]); w.w = cvt_pk_bf16(v1[2], v1[3]);
                    __builtin_nontemporal_store(w, (u32x4*)(rowp + bj * HALF)); } }
    }
};
struct EpiF32 {
    static constexpr bool PERM = false, AFTER_DRAIN = false;
    float* C; int ldc;
    __device__ __forceinline__ void operator()(const f32x4 (&acc)[2][2][4][2], const Unit& u, int wr, int wc, int fr, int fq) const {
        const int row0 = u.po * BM + wr * 64 + fr, col0 = u.pn * BM + wc * 32 + 4 * fq;
#pragma unroll
        for (int ai = 0; ai < 2; ++ai)
#pragma unroll
            for (int m = 0; m < 4; ++m) { float* rowp = C + (size_t)(row0 + ai * HALF + m * 16) * ldc + col0;
#pragma unroll
                for (int bj = 0; bj < 2; ++bj)
#pragma unroll
                    for (int n = 0; n < 2; ++n) *(f32x4*)(rowp + bj * HALF + n * 16) = acc[ai][bj][m][n]; }
    }
};
struct EpiMerge {
    static constexpr bool PERM = true, AFTER_DRAIN = false;
    bf16_t* O; const bf16_t* Z; int ldz, ga_off, gb_off; const bf16_t* YB;
    __device__ __forceinline__ void operator()(const f32x4 (&acc)[2][2][4][2], const Unit& u, int wr, int wc, int fr, int fq) const {
        const int row0 = u.po * BM + wr * 64 + fr, col0 = u.pn * BM + wc * 32 + 8 * fq;
#pragma unroll
        for (int ai = 0; ai < 2; ++ai)
#pragma unroll
            for (int m = 0; m < 4; ++m) { const size_t row = (size_t)(row0 + ai * HALF + m * 16);
#pragma unroll
                for (int bj = 0; bj < 2; ++bj) { const int col = col0 + bj * HALF;
                    const u32x4 ga = *(const u32x4*)(Z + row * ldz + ga_off + col), gb = *(const u32x4*)(Z + row * ldz + gb_off + col);
                    const u32x4 yw = *(const u32x4*)(YB + row * 2048 + col); const f32x4 y0 = {bf_lo(yw.x), bf_hi(yw.x), bf_lo(yw.y), bf_hi(yw.y)}, y1 = {bf_lo(yw.z), bf_hi(yw.z), bf_lo(yw.w), bf_hi(yw.w)};
                    const f32x4 a0 = acc[ai][bj][m][0], a1 = acc[ai][bj][m][1];
                    float o[8];
                    o[0] = sigmoidf_(bf_lo(ga.x)) * a0[0] + sigmoidf_(bf_lo(gb.x)) * y0[0]; o[1] = sigmoidf_(bf_hi(ga.x)) * a0[1] + sigmoidf_(bf_hi(gb.x)) * y0[1];
                    o[2] = sigmoidf_(bf_lo(ga.y)) * a0[2] + sigmoidf_(bf_lo(gb.y)) * y0[2]; o[3] = sigmoidf_(bf_hi(ga.y)) * a0[3] + sigmoidf_(bf_hi(gb.y)) * y0[3];
                    o[4] = sigmoidf_(bf_lo(ga.z)) * a1[0] + sigmoidf_(bf_lo(gb.z)) * y1[0]; o[5] = sigmoidf_(bf_hi(ga.z)) * a1[1] + sigmoidf_(bf_hi(gb.z)) * y1[1];
                    o[6] = sigmoidf_(bf_lo(ga.w)) * a1[2] + sigmoidf_(bf_lo(gb.w)) * y1[2]; o[7] = sigmoidf_(bf_hi(ga.w)) * a1[3] + sigmoidf_(bf_hi(gb.w)) * y1[3];
                    u32x4 w; w.x = cvt_pk_bf16(o[0], o[1]); w.y = cvt_pk_bf16(o[2], o[3]); w.z = cvt_pk_bf16(o[4], o[5]); w.w = cvt_pk_bf16(o[6], o[7]);
                    *(u32x4*)(O + row * 2048 + col) = w; } }
    }
};
struct EpiX1 {
    static constexpr bool PERM = false, AFTER_DRAIN = false;
    float* X1; const float* X; const float* mod;
    __device__ __forceinline__ void operator()(const f32x4 (&acc)[2][2][4][2], const Unit& u, int wr, int wc, int fr, int fq) const {
        const int row0 = u.po * BM + wr * 64 + fr, col0 = u.pn * BM + wc * 32 + 4 * fq;
        const float* mg = mod + (size_t)((u.po * BM) >> 11) * 12288 + 2 * 2048;
#pragma unroll
        for (int bj = 0; bj < 2; ++bj)
#pragma unroll
            for (int n = 0; n < 2; ++n) { const int col = col0 + bj * HALF + n * 16; const f32x4 g = *(const f32x4*)(mg + col);
#pragma unroll
                for (int ai = 0; ai < 2; ++ai)
#pragma unroll
                    for (int m = 0; m < 4; ++m) { const size_t off = (size_t)(row0 + ai * HALF + m * 16) * 2048 + col;
                        *(f32x4*)(X1 + off) = *(const f32x4*)(X + off) + g * acc[ai][bj][m][n]; } }
    }
};
struct EpiSwiglu {
    static constexpr bool PERM = true, AFTER_DRAIN = false;
    bf16_t* O; const float* b1;
    __device__ __forceinline__ void operator()(const f32x4 (&acc)[2][2][4][2], const Unit& u, int wr, int wc, int fr, int fq) const {
        const int e = u.pn >> 4, nt = u.pn & 15; const int row0 = u.po * BM + wr * 64 + fr, j0 = nt * 128 + wc * 32 + 8 * fq;
        const float* bg = b1 + (size_t)e * 4096 + j0; const float* bl = bg + 2048;
#pragma unroll
        for (int ai = 0; ai < 2; ++ai)
#pragma unroll
            for (int m = 0; m < 4; ++m) { const size_t row = (size_t)(row0 + ai * HALF + m * 16);
                asm volatile("" ::: "memory");
#pragma unroll
                for (int n = 0; n < 2; ++n) { const f32x4 gv = acc[ai][0][m][n] + *(const f32x4*)(bg + 4 * n), lv = acc[ai][1][m][n] + *(const f32x4*)(bl + 4 * n);
                    float o[4];
#pragma unroll
                    for (int i = 0; i < 4; ++i) { const float ga = fminf(gv[i], 7.0f), la = fminf(fmaxf(lv[i], -7.0f), 7.0f); o[i] = ga * sigmoidf_(1.702f * ga) * (la + 1.0f); }
                    typedef unsigned u32x2 __attribute__((ext_vector_type(2))); u32x2 w; w.x = cvt_pk_bf16(o[0], o[1]); w.y = cvt_pk_bf16(o[2], o[3]);
                    *(u32x2*)(O + row * 2048 + j0 + 4 * n) = w; } }
    }
};

template <class Epi, class Sched, bool ALIGN_EPI = false, bool SP2 = false, bool HALFSKIP = false>
__device__ __forceinline__ void gemm_phase(PG8_LAS unsigned char* lds, const Gemm g, const Sched& S, const Epi& E) {
    const int tid = threadIdx.x, wid = __builtin_amdgcn_readfirstlane(tid >> 6), lane = tid & 63, wr = wid >> 2, wc = wid & 3, fr = lane & 15, fq = lane >> 4;
    const int K = g.K, nt = K / BK;
    unsigned voffA[2], voffB[2];
#pragma unroll
    for (int i = 0; i < 2; ++i) { int R, C; stage_rc(tid * 16 + i * 8192, R, C); const int Rb = Epi::PERM ? ((R & ~31) + perm32(R & 31)) : R;
        voffA[i] = (unsigned)(R * K + C) * 2u; voffB[i] = (unsigned)(Rb * K + C) * 2u; }
    const size_t kstep = (size_t)(BK * 2);
    const size_t hstep = (size_t)HALF * K * 2;
    const size_t tstep = 2 * hstep;
    const unsigned ldsw = (unsigned)wid * 1024u;
    const int aoff = lds_byte(wr * 64 + fr, fq * 8), boff = lds_byte(wc * 32 + fr, fq * 8);
#define PG8_SA(b, h) (((b) * 2 + (h)) * HTB)
#define PG8_SB(b, h) ((4 + (b) * 2 + (h)) * HTB)
#define PG8_STAGE(bufoff, gbase, voff) do { _Pragma("unroll") for (int _i = 0; _i < 2; ++_i) \
        __builtin_amdgcn_global_load_lds((const unsigned*)((const char*)(gbase) + (voff)[_i]), (PG8_LAS unsigned*)(lds + (bufoff) + ldsw + _i * 8192), 16, 0, 0); } while (0)
#define PG8_LDA(dst, b, h) do { _Pragma("unroll") for (int m = 0; m < 4; ++m) _Pragma("unroll") for (int k = 0; k < 2; ++k) dst[m][k] = *(const PG8_LAS bf16x8*)(lds + PG8_SA(b, h) + aoff + m * 2048 + k * 1024); } while (0)
#define PG8_LDB(dst, b, h) do { _Pragma("unroll") for (int n = 0; n < 2; ++n) _Pragma("unroll") for (int k = 0; k < 2; ++k) dst[n][k] = *(const PG8_LAS bf16x8*)(lds + PG8_SB(b, h) + boff + n * 2048 + k * 1024); } while (0)
#define PG8_MMA(ai, bj, At, Bt) do { __builtin_amdgcn_s_setprio(1); _Pragma("unroll") for (int m = 0; m < 4; ++m) _Pragma("unroll") for (int n = 0; n < 2; ++n) _Pragma("unroll") for (int k = 0; k < 2; ++k) \
        acc[ai][bj][m][n] = __builtin_amdgcn_mfma_f32_16x16x32_bf16(Bt[n][k], At[m][k], acc[ai][bj][m][n], 0, 0, 0); __builtin_amdgcn_s_setprio(0); } while (0)
#define PG8_WAIT_V(n) asm volatile("s_waitcnt vmcnt(" #n ")" ::: "memory")
#define PG8_WAIT_L(n) asm volatile("s_waitcnt lgkmcnt(" #n ")" ::: "memory")
#define PG8_BAR __builtin_amdgcn_s_barrier()
#define PG8_SCHED __builtin_amdgcn_sched_barrier(0)
    Unit cur, nxt; int ui = 0;
    if (!S.next(0, cur)) return;
    f32x4 acc[2][2][4][2];
#pragma unroll
    for (int a = 0; a < 2; ++a)
#pragma unroll
        for (int b = 0; b < 2; ++b)
#pragma unroll
            for (int m = 0; m < 4; ++m)
#pragma unroll
                for (int n = 0; n < 2; ++n) acc[a][b][m][n] = (f32x4){0.f, 0.f, 0.f, 0.f};
    bf16x8 At[4][2], B0[2][2], B1[2][2];
    const char* cA = (const char*)g.A + (size_t)cur.pm * tstep; const char* cB = (const char*)g.Bt + (size_t)cur.pn * tstep;
    S.a_ready(cur);
    if constexpr (SP2) {
        PG8_STAGE(PG8_SB(0, 0), cB, voffB); PG8_STAGE(PG8_SB(0, 1), cB + hstep, voffB); PG8_STAGE(PG8_SA(0, 0), cA, voffA); PG8_STAGE(PG8_SA(0, 1), cA + hstep, voffA);
        if (wr == 1) PG8_BAR;
        PG8_WAIT_V(2); PG8_BAR;
        PG8_STAGE(PG8_SB(1, 0), cB + kstep, voffB); PG8_STAGE(PG8_SA(1, 0), cA + kstep, voffA); PG8_STAGE(PG8_SB(1, 1), cB + hstep + kstep, voffB);
        PG8_WAIT_V(6); PG8_BAR;
    } else {
        PG8_STAGE(PG8_SB(0, 0), cB, voffB); PG8_STAGE(PG8_SA(0, 0), cA, voffA); PG8_STAGE(PG8_SB(0, 1), cB + hstep, voffB); PG8_STAGE(PG8_SA(0, 1), cA + hstep, voffA);
        if (wr == 1) PG8_BAR;
        PG8_WAIT_V(4); PG8_BAR;
        PG8_STAGE(PG8_SB(1, 0), cB + kstep, voffB); PG8_STAGE(PG8_SA(1, 0), cA + kstep, voffA); PG8_STAGE(PG8_SB(1, 1), cB + hstep + kstep, voffB);
        PG8_WAIT_V(6); PG8_BAR;
    }
    for (;;) {
        const bool has_next = S.next(ui + 1, nxt);
        const char* nA = has_next ? (const char*)g.A + (size_t)nxt.pm * tstep : cA; const char* nB = has_next ? (const char*)g.Bt + (size_t)nxt.pn * tstep : cB;
        for (int t = 0; t < nt; t += 2) {
            const bool last = (t == nt - 2);
            const char* a1 = cA + (size_t)(t + 1) * kstep;
            const char* a2 = last ? nA : cA + (size_t)(t + 2) * kstep; const char* b2 = last ? nB : cB + (size_t)(t + 2) * kstep;
            const char* a3 = a2 + kstep; const char* b3 = b2 + kstep;
            if (last && has_next) S.a_ready(nxt);
            if constexpr (SP2) {
            PG8_LDB(B0, 0, 0); PG8_LDB(B1, 0, 1); PG8_SCHED; PG8_LDA(At, 0, 0); PG8_STAGE(PG8_SA(1, 1), a1 + hstep, voffA);
            PG8_WAIT_V(8); PG8_WAIT_L(0); PG8_BAR; PG8_MMA(0, 0, At, B0); PG8_MMA(0, 1, At, B1); PG8_BAR; PG8_SCHED;
            PG8_LDA(At, 0, 1); PG8_STAGE(PG8_SB(0, 0), b2, voffB); PG8_STAGE(PG8_SB(0, 1), b2 + hstep, voffB); PG8_STAGE(PG8_SA(0, 0), a2, voffA);
            PG8_WAIT_V(8); PG8_WAIT_L(0); PG8_BAR; if (!(HALFSKIP && cur.hf)) { PG8_MMA(1, 0, At, B0); PG8_MMA(1, 1, At, B1); } PG8_BAR; PG8_SCHED;
            PG8_LDB(B0, 1, 0); PG8_LDB(B1, 1, 1); PG8_SCHED; PG8_LDA(At, 1, 0); PG8_STAGE(PG8_SA(0, 1), a2 + hstep, voffA);
            PG8_WAIT_V(8); PG8_WAIT_L(0); PG8_BAR; PG8_MMA(0, 0, At, B0); PG8_MMA(0, 1, At, B1); PG8_BAR; PG8_SCHED;
            PG8_LDA(At, 1, 1); PG8_STAGE(PG8_SB(1, 0), b3, voffB); PG8_STAGE(PG8_SB(1, 1), b3 + hstep, voffB); PG8_STAGE(PG8_SA(1, 0), a3, voffA);
            PG8_WAIT_V(8); PG8_WAIT_L(0); PG8_BAR; if (!(HALFSKIP && cur.hf)) { PG8_MMA(1, 0, At, B0); PG8_MMA(1, 1, At, B1); } PG8_BAR; PG8_SCHED;
            } else {
            PG8_LDB(B0, 0, 0); PG8_SCHED; PG8_LDA(At, 0, 0); PG8_STAGE(PG8_SA(1, 1), a1 + hstep, voffA);
            PG8_WAIT_L(8); PG8_BAR; PG8_WAIT_L(0); PG8_MMA(0, 0, At, B0); PG8_BAR; PG8_SCHED;
            PG8_LDB(B1, 0, 1); PG8_STAGE(PG8_SB(0, 0), b2, voffB);
            PG8_BAR; PG8_WAIT_L(0); PG8_MMA(0, 1, At, B1); PG8_BAR;
            PG8_LDA(At, 0, 1); PG8_STAGE(PG8_SA(0, 0), a2, voffA);
            PG8_BAR; PG8_WAIT_L(0); PG8_MMA(1, 0, At, B0); PG8_BAR; PG8_SCHED;
            PG8_STAGE(PG8_SB(0, 1), b2 + hstep, voffB);
            PG8_WAIT_V(6); PG8_BAR; PG8_MMA(1, 1, At, B1); PG8_BAR;
            PG8_LDB(B0, 1, 0); PG8_SCHED; PG8_LDA(At, 1, 0); PG8_STAGE(PG8_SA(0, 1), a2 + hstep, voffA);
            PG8_WAIT_L(8); PG8_BAR; PG8_WAIT_L(0); PG8_MMA(0, 0, At, B0); PG8_BAR; PG8_SCHED;
            PG8_LDB(B1, 1, 1); PG8_STAGE(PG8_SB(1, 0), b3, voffB);
            PG8_BAR; PG8_WAIT_L(0); PG8_MMA(0, 1, At, B1); PG8_BAR;
            PG8_LDA(At, 1, 1); PG8_STAGE(PG8_SA(1, 0), a3, voffA);
            PG8_BAR; PG8_WAIT_L(0); PG8_MMA(1, 0, At, B0); PG8_BAR; PG8_SCHED;
            PG8_STAGE(PG8_SB(1, 1), b3 + hstep, voffB);
            PG8_WAIT_V(6); PG8_BAR; PG8_MMA(1, 1, At, B1); PG8_BAR;
            }
        }
        if constexpr (ALIGN_EPI) { if (wr == 0) PG8_BAR; }
        if constexpr (!Epi::AFTER_DRAIN) { E(acc, cur, wr, wc, fr, fq); S.done(cur); }
        if (!has_next) break;
#pragma unroll
        for (int a = 0; a < 2; ++a)
#pragma unroll
            for (int b = 0; b < 2; ++b)
#pragma unroll
                for (int m = 0; m < 4; ++m)
#pragma unroll
                    for (int n = 0; n < 2; ++n) acc[a][b][m][n] = (f32x4){0.f, 0.f, 0.f, 0.f};
        cur = nxt; cA = nA; cB = nB; ++ui;
        if constexpr (ALIGN_EPI) { if (wr == 1) PG8_BAR; }
    }
    PG8_WAIT_V(0);
    if constexpr (!ALIGN_EPI) { if (wr == 0) PG8_BAR; }
    PG8_BAR;
    if constexpr (Epi::AFTER_DRAIN) { E.fused(acc, cur, wr, wc, fr, fq, lds, wid, lane); S.done(cur); }
#undef PG8_SA
#undef PG8_SB
#undef PG8_STAGE
#undef PG8_LDA
#undef PG8_LDB
#undef PG8_MMA
#undef PG8_WAIT_V
#undef PG8_WAIT_L
#undef PG8_BAR
#undef PG8_SCHED
}
template <class Epi, class Sched, bool ALIGN_EPI = false, bool SP2 = false, bool HALFSKIP = false>
__device__ __forceinline__ void gemm_phase8(PG8_LAS unsigned char* lds, const Gemm g, const Sched& S, const Epi& E) {
    const int tid = threadIdx.x, wid = __builtin_amdgcn_readfirstlane(tid >> 6), lane = tid & 63, wr = wid >> 2, wc = wid & 3, fr = lane & 15, fq = lane >> 4;
    const int K = g.K, nt = K / 128;
    unsigned voffA[2], voffB[2];
#pragma unroll
    for (int i = 0; i < 2; ++i) { int R, C; stage_rc(tid * 16 + i * 8192, R, C); const int Rb = Epi::PERM ? ((R & ~31) + perm32(R & 31)) : R;
        voffA[i] = (unsigned)(R * K + 2 * C); voffB[i] = (unsigned)(Rb * K + 2 * C); }
    const size_t kstep = (size_t)(BK * 2);
    const size_t hstep = (size_t)HALF * K;
    const size_t tstep = 2 * hstep;
    const unsigned ldsw = (unsigned)wid * 1024u;
    const int aoff = lds_byte(wr * 64 + fr, fq * 16), boff = lds_byte(wc * 32 + fr, fq * 16);
#define PG8_SA(b, h) (((b) * 2 + (h)) * HTB)
#define PG8_SB(b, h) ((4 + (b) * 2 + (h)) * HTB)
#define PG8_STAGE(bufoff, gbase, voff) do { _Pragma("unroll") for (int _i = 0; _i < 2; ++_i) \
        __builtin_amdgcn_global_load_lds((const unsigned*)((const char*)(gbase) + (voff)[_i]), (PG8_LAS unsigned*)(lds + (bufoff) + ldsw + _i * 8192), 16, 0, 0); } while (0)
#define PG8_LDA(dst, b, h) do { _Pragma("unroll") for (int m = 0; m < 4; ++m) { const i32x4 lo_ = *(const PG8_LAS i32x4*)(lds + PG8_SA(b, h) + aoff + m * 2048), hi_ = *(const PG8_LAS i32x4*)(lds + PG8_SA(b, h) + aoff + m * 2048 + 16); dst[m] = __builtin_shufflevector(lo_, hi_, 0, 1, 2, 3, 4, 5, 6, 7); } } while (0)
#define PG8_LDB(dst, b, h) do { _Pragma("unroll") for (int n = 0; n < 2; ++n) { const i32x4 lo_ = *(const PG8_LAS i32x4*)(lds + PG8_SB(b, h) + boff + n * 2048), hi_ = *(const PG8_LAS i32x4*)(lds + PG8_SB(b, h) + boff + n * 2048 + 16); dst[n] = __builtin_shufflevector(lo_, hi_, 0, 1, 2, 3, 4, 5, 6, 7); } } while (0)
#define PG8_MMA(ai, bj, At, Bt) do { __builtin_amdgcn_s_setprio(1); _Pragma("unroll") for (int m = 0; m < 4; ++m) _Pragma("unroll") for (int n = 0; n < 2; ++n) \
        asm volatile("v_mfma_scale_f32_16x16x128_f8f6f4 %0, %1, %2, %0, %3, %3 op_sel_hi:[0,0,0]" : "+v"(acc[ai][bj][m][n]) : "v"(Bt[n]), "v"(At[m]), "v"(sc127)); __builtin_amdgcn_s_setprio(0); } while (0)
#define PG8_WAIT_V(n) asm volatile("s_waitcnt vmcnt(" #n ")" ::: "memory")
#define PG8_WAIT_L(n) asm volatile("s_waitcnt lgkmcnt(" #n ")" ::: "memory")
#define PG8_BAR __builtin_amdgcn_s_barrier()
#define PG8_SCHED __builtin_amdgcn_sched_barrier(0)
    Unit cur, nxt; int ui = 0;
    if (!S.next(0, cur)) return;
    f32x4 acc[2][2][4][2];
#pragma unroll
    for (int a = 0; a < 2; ++a)
#pragma unroll
        for (int b = 0; b < 2; ++b)
#pragma unroll
            for (int m = 0; m < 4; ++m)
#pragma unroll
                for (int n = 0; n < 2; ++n) acc[a][b][m][n] = (f32x4){0.f, 0.f, 0.f, 0.f};
    i32x8 At[4], B0[2], B1[2]; const int sc127 = 127;
    const char* cA = (const char*)g.A + (size_t)cur.pm * tstep; const char* cB = (const char*)g.Bt + (size_t)cur.pn * tstep;
    S.a_ready(cur);
    if constexpr (SP2) {
        PG8_STAGE(PG8_SB(0, 0), cB, voffB); PG8_STAGE(PG8_SB(0, 1), cB + hstep, voffB); PG8_STAGE(PG8_SA(0, 0), cA, voffA); PG8_STAGE(PG8_SA(0, 1), cA + hstep, voffA);
        if (wr == 1) PG8_BAR;
        PG8_WAIT_V(2); PG8_BAR;
        PG8_STAGE(PG8_SB(1, 0), cB + kstep, voffB); PG8_STAGE(PG8_SA(1, 0), cA + kstep, voffA); PG8_STAGE(PG8_SB(1, 1), cB + hstep + kstep, voffB);
        PG8_WAIT_V(6); PG8_BAR;
    } else {
        PG8_STAGE(PG8_SB(0, 0), cB, voffB); PG8_STAGE(PG8_SA(0, 0), cA, voffA); PG8_STAGE(PG8_SB(0, 1), cB + hstep, voffB); PG8_STAGE(PG8_SA(0, 1), cA + hstep, voffA);
        if (wr == 1) PG8_BAR;
        PG8_WAIT_V(4); PG8_BAR;
        PG8_STAGE(PG8_SB(1, 0), cB + kstep, voffB); PG8_STAGE(PG8_SA(1, 0), cA + kstep, voffA); PG8_STAGE(PG8_SB(1, 1), cB + hstep + kstep, voffB);
        PG8_WAIT_V(6); PG8_BAR;
    }
    for (;;) {
        const bool has_next = S.next(ui + 1, nxt);
        const char* nA = has_next ? (const char*)g.A + (size_t)nxt.pm * tstep : cA; const char* nB = has_next ? (const char*)g.Bt + (size_t)nxt.pn * tstep : cB;
        for (int t = 0; t < nt; t += 2) {
            const bool last = (t == nt - 2);
            const char* a1 = cA + (size_t)(t + 1) * kstep;
            const char* a2 = last ? nA : cA + (size_t)(t + 2) * kstep; const char* b2 = last ? nB : cB + (size_t)(t + 2) * kstep;
            const char* a3 = a2 + kstep; const char* b3 = b2 + kstep;
            if (last && has_next) S.a_ready(nxt);
            if constexpr (SP2) {
            PG8_LDB(B0, 0, 0); PG8_LDB(B1, 0, 1); PG8_SCHED; PG8_LDA(At, 0, 0); PG8_STAGE(PG8_SA(1, 1), a1 + hstep, voffA);
            PG8_WAIT_V(8); PG8_WAIT_L(0); PG8_BAR; PG8_MMA(0, 0, At, B0); PG8_MMA(0, 1, At, B1); PG8_BAR; PG8_SCHED;
            if (!(HALFSKIP && cur.hf)) PG8_LDA(At, 0, 1); PG8_STAGE(PG8_SB(0, 0), b2, voffB); PG8_STAGE(PG8_SB(0, 1), b2 + hstep, voffB); PG8_STAGE(PG8_SA(0, 0), a2, voffA);
            PG8_WAIT_V(8); PG8_WAIT_L(0); PG8_BAR; if (!(HALFSKIP && cur.hf)) { PG8_MMA(1, 0, At, B0); PG8_MMA(1, 1, At, B1); } PG8_BAR; PG8_SCHED;
            PG8_LDB(B0, 1, 0); PG8_LDB(B1, 1, 1); PG8_SCHED; PG8_LDA(At, 1, 0); PG8_STAGE(PG8_SA(0, 1), a2 + hstep, voffA);
            PG8_WAIT_V(8); PG8_WAIT_L(0); PG8_BAR; PG8_MMA(0, 0, At, B0); PG8_MMA(0, 1, At, B1); PG8_BAR; PG8_SCHED;
            if (!(HALFSKIP && cur.hf)) PG8_LDA(At, 1, 1); PG8_STAGE(PG8_SB(1, 0), b3, voffB); PG8_STAGE(PG8_SB(1, 1), b3 + hstep, voffB); PG8_STAGE(PG8_SA(1, 0), a3, voffA);
            PG8_WAIT_V(8); PG8_WAIT_L(0); PG8_BAR; if (!(HALFSKIP && cur.hf)) { PG8_MMA(1, 0, At, B0); PG8_MMA(1, 1, At, B1); } PG8_BAR; PG8_SCHED;
            } else {
            PG8_LDB(B0, 0, 0); PG8_SCHED; PG8_LDA(At, 0, 0); PG8_STAGE(PG8_SA(1, 1), a1 + hstep, voffA);
            PG8_WAIT_L(8); PG8_BAR; PG8_WAIT_L(0); PG8_MMA(0, 0, At, B0); PG8_BAR; PG8_SCHED;
            PG8_LDB(B1, 0, 1); PG8_STAGE(PG8_SB(0, 0), b2, voffB);
            PG8_BAR; PG8_WAIT_L(0); PG8_MMA(0, 1, At, B1); PG8_BAR;
            PG8_LDA(At, 0, 1); PG8_STAGE(PG8_SA(0, 0), a2, voffA);
            PG8_BAR; PG8_WAIT_L(0); PG8_MMA(1, 0, At, B0); PG8_BAR; PG8_SCHED;
            PG8_STAGE(PG8_SB(0, 1), b2 + hstep, voffB);
            PG8_WAIT_V(6); PG8_BAR; PG8_MMA(1, 1, At, B1); PG8_BAR;
            PG8_LDB(B0, 1, 0); PG8_SCHED; PG8_LDA(At, 1, 0); PG8_STAGE(PG8_SA(0, 1), a2 + hstep, voffA);
            PG8_WAIT_L(8); PG8_BAR; PG8_WAIT_L(0); PG8_MMA(0, 0, At, B0); PG8_BAR; PG8_SCHED;
            PG8_LDB(B1, 1, 1); PG8_STAGE(PG8_SB(1, 0), b3, voffB);
            PG8_BAR; PG8_WAIT_L(0); PG8_MMA(0, 1, At, B1); PG8_BAR;
            PG8_LDA(At, 1, 1); PG8_STAGE(PG8_SA(1, 0), a3, voffA);
            PG8_BAR; PG8_WAIT_L(0); PG8_MMA(1, 0, At, B0); PG8_BAR; PG8_SCHED;
            PG8_STAGE(PG8_SB(1, 1), b3 + hstep, voffB);
            PG8_WAIT_V(6); PG8_BAR; PG8_MMA(1, 1, At, B1); PG8_BAR;
            }
        }
        if constexpr (ALIGN_EPI) { if (wr == 0) PG8_BAR; }
        if constexpr (!Epi::AFTER_DRAIN) { E(acc, cur, wr, wc, fr, fq); S.done(cur); }
        if (!has_next) break;
#pragma unroll
        for (int a = 0; a < 2; ++a)
#pragma unroll
            for (int b = 0; b < 2; ++b)
#pragma unroll
                for (int m = 0; m < 4; ++m)
#pragma unroll
                    for (int n = 0; n < 2; ++n) acc[a][b][m][n] = (f32x4){0.f, 0.f, 0.f, 0.f};
        cur = nxt; cA = nA; cB = nB; ++ui;
        if constexpr (ALIGN_EPI) { if (wr == 1) PG8_BAR; }
    }
    PG8_WAIT_V(0);
    if constexpr (!ALIGN_EPI) { if (wr == 0) PG8_BAR; }
    PG8_BAR;
    if constexpr (Epi::AFTER_DRAIN) { E.fused(acc, cur, wr, wc, fr, fq, lds, wid, lane); S.done(cur); }
#undef PG8_SA
#undef PG8_SB
#undef PG8_STAGE
#undef PG8_LDA
#undef PG8_LDB
#undef PG8_MMA
#undef PG8_WAIT_V
#undef PG8_WAIT_L
#undef PG8_BAR
#undef PG8_SCHED
}
}

constexpr int NWAVES = 8, NTHR = 512;
constexpr int N_LAUNCHES = MK_N_LAUNCHES;
constexpr int N_PHASES = 13;
constexpr int DM = 2048, NB = 4, TL = 2048, NLAT = NB * TL, TCX = 256, NCTX = NB * TCX, NTOK = NLAT + NCTX;
constexpr int NH = 8, QKD = 128, VD = 256, INC = 14368, ZW = 14336;
constexpr int ZQ = 0, ZK = 1024, ZV = 2048, ZO = 4096, ZU = 6144, ZS = 8192, ZGA = 10240, ZGB = 12288;
constexpr int NEXP = 32, DEXP = 2048, NCH = 18  , CROWS = 272  ;
constexpr float EPS = 1e-6f;

constexpr size_t MiB = 1u << 20;
constexpr size_t WS_CTL = 0, CTL_ZERO_BYTES = 1 * MiB;
constexpr size_t WS_MOD = 1 * MiB;
constexpr size_t WS_GATES = 2 * MiB;
constexpr size_t WS_SCAL = 4 * MiB;
constexpr size_t WS_ROUTE = 5 * MiB;
constexpr size_t WS_SCN = 2996 * MiB;
constexpr size_t WS_SK = 6 * MiB;
constexpr size_t WS_WINT = 8 * MiB;
constexpr size_t WS_PAT = 64 * MiB, WS_PBT = 72 * MiB, WS_WOT = 80 * MiB;
constexpr size_t WS_W1T = 88 * MiB;
constexpr size_t WS_W2T = 600 * MiB;
constexpr size_t WS_HB = 856 * MiB;
constexpr size_t WS_Z = 892 * MiB;
constexpr size_t WS_QC = 1144 * MiB, WS_KC = 1162 * MiB;
constexpr size_t WS_SVN = 1180 * MiB;
constexpr size_t WS_DC = 1212 * MiB;
constexpr size_t WS_CS = 1360 * MiB;
constexpr size_t WS_RO = 1428 * MiB;
constexpr size_t WS_CM = 1460 * MiB;
constexpr size_t WS_YB = 1492 * MiB;
constexpr size_t WS_MRG = 1556 * MiB;
constexpr size_t WS_X1 = 1588 * MiB;
constexpr size_t WS_ACT = 1652 * MiB;
constexpr size_t WS_Y2 = 1812 * MiB;
constexpr size_t WS_XG = 1972 * MiB;
constexpr size_t WS_HB8 = 2998 * MiB;
constexpr size_t WS_WG8 = 3016 * MiB;
constexpr size_t WS_END = 3040 * MiB;
static_assert(WS_DC + (size_t)64 * 17 * CROWS * 128 * 2 <= WS_CS && WS_CS + (size_t)64 * 16 * CROWS * 128 * 2 <= WS_RO && WS_Z + (size_t)NTOK * ZW * 2 <= WS_QC, "ws map");
constexpr int CW_Q3 = 3584, CW_Q4 = 8192;
constexpr int CW_Q2 = 3072;
constexpr int CW_Q = 2048;
constexpr int CW_CNT = 64;
constexpr int CW_BAR = 4096;
constexpr int RING_BYTES = 131072;
constexpr int LDS_BYTES = 147456;
constexpr int LDSCTL_OFF = LDS_BYTES - 2048, MISC_OFF = LDSCTL_OFF + 320, PREF_OFF = LDSCTL_OFF + 1024;

#define GAS __attribute__((address_space(1)))
#define LAS __attribute__((address_space(3)))
typedef unsigned short bf16;
typedef unsigned v4u __attribute__((ext_vector_type(4)));
typedef unsigned v2u __attribute__((ext_vector_type(2)));
typedef float f32x4 __attribute__((ext_vector_type(4)));
typedef short bf16x8 __attribute__((ext_vector_type(8)));
typedef short s16x4 __attribute__((ext_vector_type(4)));
typedef GAS unsigned gu32;
#define RLX_AGENT __ATOMIC_RELAXED, __HIP_MEMORY_SCOPE_AGENT
#define LDS_WAIT() asm volatile("s_waitcnt lgkmcnt(0)" ::: "memory")
#define VM_WAIT() asm volatile("s_waitcnt vmcnt(0)" ::: "memory")
using pg8::cvt_pk_bf16; using pg8::bf_lo; using pg8::bf_hi; using pg8::sigmoidf_;


__device__ __forceinline__ float wave_sum(float v) {
#pragma unroll
    for (int o = 1; o < 64; o <<= 1) v += __shfl_xor(v, o);
    return v;
}
__device__ __forceinline__ float siluf_(float x) { return x * __builtin_amdgcn_rcpf(1.0f + __expf(-x)); }
__device__ __forceinline__ float gelu_tanh(float x) { const float u = 0.7978845608028654f * (x + 0.044715f * x * x * x); return x * __builtin_amdgcn_rcpf(1.0f + __expf(-2.0f * u)); }
__device__ __forceinline__ float logsigf_(float f) { return fminf(f, 0.f) - log1pf(expf(-fabsf(f))); }
__device__ __forceinline__ unsigned img_off(unsigned row, unsigned ch) { return 256u * row + 16u * (ch ^ (((row & 3u) << 2) | ((row >> 2) & 3u))); }
__device__ __forceinline__ s16x4 tr_read(LAS unsigned char* p) { return __builtin_amdgcn_ds_read_tr16_b64_v4i16((LAS s16x4*)p); }
__device__ __forceinline__ bf16x8 tr_frag(LAS unsigned char* img, unsigned r0, unsigned r1, unsigned c, int lane) {
    const unsigned q = (lane & 15) >> 2, p = lane & 3;
    const s16x4 lo = tr_read(img + img_off(r0 + q, 2 * c + (p >> 1)) + 8 * (p & 1));
    const s16x4 hi = tr_read(img + img_off(r1 + q, 2 * c + (p >> 1)) + 8 * (p & 1));
    bf16x8 r; r[0] = lo[0]; r[1] = lo[1]; r[2] = lo[2]; r[3] = lo[3]; r[4] = hi[0]; r[5] = hi[1]; r[6] = hi[2]; r[7] = hi[3]; return r;
}
__device__ __forceinline__ bf16x8 tr_frag2(LAS unsigned char* base, unsigned x0, unsigned x1) {
    const s16x4 lo = tr_read(base + x0), hi = tr_read(base + x1);
    bf16x8 r; r[0] = lo[0]; r[1] = lo[1]; r[2] = lo[2]; r[3] = lo[3]; r[4] = hi[0]; r[5] = hi[1]; r[6] = hi[2]; r[7] = hi[3]; return r;
}
#define TR_NAT_OFFS(xn0, xn1, lane) unsigned xn0[8], xn1[8]; { const unsigned g_ = (lane) >> 4, q_ = ((lane) & 15) >> 2, p_ = (lane) & 3; \
    _Pragma("unroll") for (int c_ = 0; c_ < 8; ++c_) { xn0[c_] = 256u * (8 * g_ + q_) + 16u * ((2 * c_ + (p_ >> 1)) ^ ((q_ << 2) | ((2 * g_) & 3))) + 8u * (p_ & 1); \
                                                       xn1[c_] = 256u * (8 * g_ + 4 + q_) + 16u * ((2 * c_ + (p_ >> 1)) ^ ((q_ << 2) | ((2 * g_ + 1) & 3))) + 8u * (p_ & 1); } }
#define TR_PERM_OFFS(xp, lane) unsigned xp[8]; { const unsigned g_ = (lane) >> 4, q_ = ((lane) & 15) >> 2, p_ = (lane) & 3; \
    _Pragma("unroll") for (int c_ = 0; c_ < 8; ++c_) xp[c_] = 256u * (4 * g_ + q_) + 16u * ((2 * c_ + (p_ >> 1)) ^ ((q_ << 2) | g_)) + 8u * (p_ & 1); }
__device__ __forceinline__ void load_tile128(LAS unsigned char* img, const bf16* src, size_t ld, int tid) {
#pragma unroll
    for (int i = 0; i < 4; ++i) { const int id = tid + NTHR * i, row = id >> 4, ch = id & 15;
        const v4u v = *(const v4u*)(src + (size_t)row * ld + 8 * ch); *(LAS v4u*)(img + img_off(row, ch)) = v; }
}
__device__ __forceinline__ void load_tile128_scaled(LAS unsigned char* img, const bf16* src, size_t ld, const LAS float* w, int tid) {
#pragma unroll
    for (int i = 0; i < 4; ++i) { const int id = tid + NTHR * i, row = id >> 4, ch = id & 15; const float s = w[row];
        const v4u v = *(const v4u*)(src + (size_t)row * ld + 8 * ch); v4u o;
        o.x = cvt_pk_bf16(bf_lo(v.x) * s, bf_hi(v.x) * s); o.y = cvt_pk_bf16(bf_lo(v.y) * s, bf_hi(v.y) * s); o.z = cvt_pk_bf16(bf_lo(v.z) * s, bf_hi(v.z) * s); o.w = cvt_pk_bf16(bf_lo(v.w) * s, bf_hi(v.w) * s);
        *(LAS v4u*)(img + img_off(row, ch)) = o; }
}
__device__ __forceinline__ void gate_scan(const float* G, size_t row0, int col_i, int col_f, int dir, int lane, float* bc, float* gg, float* pmx, float& b_end, float& gmax) {
    const int j0 = dir ? 127 - 2 * lane : 2 * lane, j1 = dir ? 126 - 2 * lane : 2 * lane + 1;
    const float f0 = G[(row0 + j0) * 32 + col_f], f1 = G[(row0 + j1) * 32 + col_f], i0 = G[(row0 + j0) * 32 + col_i], i1 = G[(row0 + j1) * 32 + col_i];
    const float lf0 = logsigf_(f0), lf1 = logsigf_(f1), s = lf0 + lf1; float incl = s;
#pragma unroll
    for (int o = 1; o < 64; o <<= 1) { const float t = __shfl_up(incl, o); if (lane >= o) incl += t; }
    const float b0 = (incl - s) + lf0, b1 = incl, g0 = i0 - b0, g1 = i1 - b1;
    float mincl = fmaxf(g0, g1);
#pragma unroll
    for (int o = 1; o < 64; o <<= 1) { const float t = __shfl_up(mincl, o); if (lane >= o) mincl = fmaxf(mincl, t); }
    float mexcl = __shfl_up(mincl, 1); if (lane == 0) mexcl = -3.0e38f;
    bc[j0] = b0; bc[j1] = b1; gg[j0] = g0; gg[j1] = g1; pmx[j0] = fmaxf(mexcl, g0); pmx[j1] = mincl;
    b_end = __shfl(incl, 63); gmax = __shfl(mincl, 63);
}
#define MFMA16(a, b, c) __builtin_amdgcn_mfma_f32_16x16x32_bf16((a), (b), (c), 0, 0, 0)

struct CvtItem { const float* src; size_t ldw; bf16* dst; };
constexpr int N_CONVERTERS = 128;
constexpr int N_CONV_DEFER = 1440;
constexpr int I_GEMV = 192, I_WIN = 16 * 8, I_GATE8 = 16 * 48, I_P = 16 * 8, I_W1 = 32 * 16 * 16, I_W2 = 32 * 16 * 8, I_TOTAL = I_GEMV + I_WIN + 3 * I_P + I_W1 + I_W2;
__device__ __forceinline__ CvtItem cvt_decode(int r, int tid, const float* w_in, const float* proj_a, const float* proj_b, const float* w_out, const float* exp_w1, const float* exp_w2,
                                              bf16* WINT, bf16* PAT, bf16* PBT, bf16* WOT, bf16* W1T, bf16* W2T) {
    const int n4 = tid & 63, kg = tid >> 6; const float* W; size_t ldw, ca, cb, drow; int kt; bf16* WT;
    if (r < I_WIN) { kt = r / 8; const int nt = 24 + r % 8; W = w_in; ldw = INC; ca = (size_t)256 * nt + 32; cb = ca + 128; WT = WINT; drow = (size_t)256 * nt; }
    else if ((r -= I_WIN) < 3 * I_P) { const int m = r / I_P, q = r % I_P; kt = q / 8; const int nt = q % 8; W = m == 0 ? proj_a : (m == 1 ? proj_b : w_out); ldw = 2048; ca = (size_t)256 * nt; cb = ca + 128; WT = m == 0 ? PAT : (m == 1 ? PBT : WOT); drow = (size_t)256 * nt; }
    else if ((r -= 3 * I_P) < I_W1) { const int e = r / 256, q = r % 256; kt = q / 16; const int nt = q % 16; W = exp_w1 + (size_t)e * 2048 * 4096; ldw = 4096; ca = (size_t)128 * nt; cb = 2048 + ca; WT = W1T; drow = (size_t)e * 4096 + 256 * nt; }
    else { r -= I_W1; const int e = r / 128, q = r % 128; kt = q / 8; const int nt = q % 8; W = exp_w2 + (size_t)e * 2048 * 2048; ldw = 2048; ca = (size_t)256 * nt; cb = ca + 128; WT = W2T; drow = (size_t)e * 2048 + 256 * nt; }
    CvtItem it; it.ldw = ldw; it.src = W + (size_t)(128 * kt + 8 * kg) * ldw + (n4 < 32 ? ca + 4 * n4 : cb + 4 * (n4 - 32)); it.dst = WT + drow * 2048 + 128 * kt; return it;
}
__device__ __forceinline__ void cvt_run(LAS unsigned char* lds, int tid, int it, int stride, int end, const float* w_in, const float* proj_a, const float* proj_b, const float* w_out, const float* exp_w1, const float* exp_w2,
                                        bf16* WINT, bf16* PAT, bf16* PBT, bf16* WOT, bf16* W1T, bf16* W2T) {
    const int n4 = tid & 63, kg = tid >> 6;
    f32x4 v[16]; CvtItem cur;
    bool have = it < end;
    if (have) { cur = cvt_decode(it - I_GEMV, tid, w_in, proj_a, proj_b, w_out, exp_w1, exp_w2, WINT, PAT, PBT, WOT, W1T, W2T);
#pragma unroll
        for (int i = 0; i < 16; ++i) v[i] = __builtin_nontemporal_load((const f32x4*)(cur.src + (size_t)((i >> 3) * 64 + (i & 7)) * cur.ldw)); }
    while (have) {
#pragma unroll
        for (int hf = 0; hf < 2; ++hf)
#pragma unroll
            for (int j = 0; j < 4; ++j) { v4u o; o.x = cvt_pk_bf16(v[8 * hf + 0][j], v[8 * hf + 1][j]); o.y = cvt_pk_bf16(v[8 * hf + 2][j], v[8 * hf + 3][j]); o.z = cvt_pk_bf16(v[8 * hf + 4][j], v[8 * hf + 5][j]); o.w = cvt_pk_bf16(v[8 * hf + 6][j], v[8 * hf + 7][j]);
                *(LAS v4u*)(lds + img_off(4 * n4 + j, 8 * hf + kg)) = o; }
        __syncthreads();
        bf16* dst = cur.dst;
        it += stride; have = it < end;
        if (have) { cur = cvt_decode(it - I_GEMV, tid, w_in, proj_a, proj_b, w_out, exp_w1, exp_w2, WINT, PAT, PBT, WOT, W1T, W2T);
#pragma unroll
            for (int i = 0; i < 16; ++i) v[i] = __builtin_nontemporal_load((const f32x4*)(cur.src + (size_t)((i >> 3) * 64 + (i & 7)) * cur.ldw)); }
#pragma unroll
        for (int i = 0; i < 8; ++i) { const int id = tid + NTHR * i, row = id >> 4, ch = id & 15; const v4u o = *(const LAS v4u*)(lds + img_off(row, ch)); __builtin_nontemporal_store(o, (v4u*)(dst + (size_t)row * 2048 + 8 * ch)); }
        __syncthreads();
    }
}
__device__ __forceinline__ void cvt_run8(LAS unsigned char* lds, int tid, int r, int stride, int end, const float* exp_w1, const float* exp_w2, const float* w_in, unsigned char* W1T8, unsigned char* W2T8, unsigned char* WG8) {
    const int n4 = tid & 63, kg = tid >> 6;
    f32x4 v[16]; const float* src = nullptr; size_t ldw = 0; unsigned char* dst = nullptr;
#define CVT8_DECODE(R) do { int q_ = (R); const float* W_; size_t ca_, cb_, drow_; int kt_; unsigned char* WT_; \
        if (q_ < I_W1) { const int e = q_ / 256, qq = q_ % 256; kt_ = qq / 16; const int nt = qq % 16; W_ = exp_w1 + (size_t)e * 2048 * 4096; ldw = 4096; ca_ = (size_t)128 * nt; cb_ = 2048 + ca_; WT_ = W1T8; drow_ = (size_t)e * 4096 + 256 * nt; } \
        else if (q_ < I_W1 + I_W2) { q_ -= I_W1; const int e = q_ / 128, qq = q_ % 128; kt_ = qq / 8; const int nt = qq % 8; W_ = exp_w2 + (size_t)e * 2048 * 2048; ldw = 2048; ca_ = (size_t)256 * nt; cb_ = ca_ + 128; WT_ = W2T8; drow_ = (size_t)e * 2048 + 256 * nt; } \
        else { q_ -= I_W1 + I_W2; kt_ = q_ / 48; const int ft = q_ % 48, zt = ft < 24 ? ft : ft + 8; W_ = w_in; ldw = INC; ca_ = (size_t)256 * zt + (zt >= 16 ? 32 : 0); cb_ = ca_ + 128; WT_ = WG8; drow_ = (size_t)256 * ft; } \
        src = W_ + (size_t)(128 * kt_ + 8 * kg) * ldw + (n4 < 32 ? ca_ + 4 * n4 : cb_ + 4 * (n4 - 32)); dst = WT_ + drow_ * 2048 + 128 * kt_; \
        _Pragma("unroll") for (int i = 0; i < 16; ++i) v[i] = __builtin_nontemporal_load((const f32x4*)(src + (size_t)((i >> 3) * 64 + (i & 7)) * ldw)); } while (0)
    bool have = r < end;
    if (have) CVT8_DECODE(r);
    while (have) {
#pragma unroll
        for (int hf = 0; hf < 2; ++hf)
#pragma unroll
            for (int j = 0; j < 4; ++j) { const int row = 4 * n4 + j, p8 = 8 * hf + kg; v2u o;
                o.x = pg8::pk4_fp8(v[8 * hf + 0][j] * pg8::F8_SW, v[8 * hf + 1][j] * pg8::F8_SW, v[8 * hf + 2][j] * pg8::F8_SW, v[8 * hf + 3][j] * pg8::F8_SW);
                o.y = pg8::pk4_fp8(v[8 * hf + 4][j] * pg8::F8_SW, v[8 * hf + 5][j] * pg8::F8_SW, v[8 * hf + 6][j] * pg8::F8_SW, v[8 * hf + 7][j] * pg8::F8_SW);
                *(LAS v2u*)(lds + row * 128 + 16 * ((p8 >> 1) ^ ((row >> 2) & 7)) + 8 * (p8 & 1)) = o; }
        __syncthreads();
        unsigned char* d0 = dst;
        r += stride; have = r < end;
        if (have) CVT8_DECODE(r);
#pragma unroll
        for (int i = 0; i < 4; ++i) { const int id = tid + NTHR * i, row = id >> 3, ch = id & 7; const v4u o = *(const LAS v4u*)(lds + row * 128 + 16 * (ch ^ ((row >> 2) & 7)));
            __builtin_nontemporal_store(o, (v4u*)(d0 + (size_t)row * 2048 + 16 * ch)); }
        __syncthreads();
    }
#undef CVT8_DECODE
}
__device__ __forceinline__ void p0_phase(LAS unsigned char* lds, int tid, int G, const float* c, const float* c_ctx, const float* mod_w, const float* mod_b, float* MOD,
                                         const float* w_in, const float* proj_a, const float* proj_b, const float* w_out, const float* exp_w1, const float* exp_w2, const float* router_w,
                                         bf16* WINT, bf16* PAT, bf16* PBT, bf16* WOT, bf16* W1T, bf16* W2T, bf16* SK, int n_conv_p0) {
    LAS float* sc = (LAS float*)lds;
    LAS float* red = (LAS float*)(lds + 40960);
    int it = blockIdx.x;
    if (it < I_GEMV) {
        for (int i = tid; i < 5 * 2048; i += NTHR) { const float x = i < 4 * 2048 ? c[i] : c_ctx[i - 4 * 2048]; sc[i] = siluf_(x); }
        __syncthreads();
        for (; it < I_GEMV; it += G) {
            const int j0 = 64 * it, c4 = tid & 15, kg = tid >> 4;
            f32x4 a0 = {0.f, 0.f, 0.f, 0.f}, a1 = a0, a2 = a0, a3 = a0, a4 = a0;
            const float* wp = mod_w + (size_t)kg * 12288 + j0 + 4 * c4;
#pragma unroll 8
            for (int k = kg; k < 2048; k += 32) { const f32x4 w = *(const f32x4*)wp; wp += (size_t)32 * 12288;
                a0 += w * sc[k]; a1 += w * sc[2048 + k]; a2 += w * sc[4096 + k]; a3 += w * sc[6144 + k]; a4 += w * sc[8192 + k]; }
            *(LAS f32x4*)(red + (kg * 5 + 0) * 64 + 4 * c4) = a0; *(LAS f32x4*)(red + (kg * 5 + 1) * 64 + 4 * c4) = a1; *(LAS f32x4*)(red + (kg * 5 + 2) * 64 + 4 * c4) = a2;
            *(LAS f32x4*)(red + (kg * 5 + 3) * 64 + 4 * c4) = a3; *(LAS f32x4*)(red + (kg * 5 + 4) * 64 + 4 * c4) = a4;
            __syncthreads();
            if (tid < 320) { const int rr = tid >> 6, j = tid & 63; float s = 0.f;
#pragma unroll 8
                for (int g = 0; g < 32; ++g) s += red[(g * 5 + rr) * 64 + j];
                MOD[rr * 12288 + j0 + j] = s + mod_b[j0 + j]; }
            __syncthreads();
        }
    } else {
        for (int i = (it - I_GEMV) * NTHR + tid; i < 2 * 32 * 2048; i += (G - I_GEMV) * NTHR) { const int m = i >> 16, n = (i >> 11) & 31, k = i & 2047;
            const float w = m == 0 ? w_in[(size_t)k * INC + 4096 + n] : router_w[k * 32 + n];
            const unsigned hi = cvt_pk_bf16(w, 0.f) & 0xffffu; const unsigned lo = cvt_pk_bf16(w - __uint_as_float(hi << 16), 0.f) & 0xffffu;
            SK[(size_t)(2 * m) * 65536 + n * 2048 + k] = (bf16)hi; SK[(size_t)(2 * m + 1) * 65536 + n * 2048 + k] = (bf16)lo; }
    }
    cvt_run(lds, tid, it, G, I_GEMV + n_conv_p0, w_in, proj_a, proj_b, w_out, exp_w1, exp_w2, WINT, PAT, PBT, WOT, W1T, W2T);
}

__device__ __forceinline__ void skinny_mfma(const LAS float* hrow, const bf16* WT_hi, const bf16* WT_lo, LAS float* part, int wave, int lane) {
    const int g = lane >> 4, l15 = lane & 15;
    f32x4 acc0 = {0.f, 0.f, 0.f, 0.f}, acc1 = acc0;
#pragma unroll
    for (int ks = 0; ks < 8; ++ks) { const int kb = 256 * wave + 32 * ks + 8 * g;
        f32x4 a0 = {0.f, 0.f, 0.f, 0.f}, a1 = a0;
        if (l15 < 8) { a0 = *(const LAS f32x4*)(hrow + l15 * 2048 + kb); a1 = *(const LAS f32x4*)(hrow + l15 * 2048 + kb + 4); }
        v4u hi, lo;
        hi.x = cvt_pk_bf16(a0[0], a0[1]); hi.y = cvt_pk_bf16(a0[2], a0[3]); hi.z = cvt_pk_bf16(a1[0], a1[1]); hi.w = cvt_pk_bf16(a1[2], a1[3]);
        lo.x = cvt_pk_bf16(a0[0] - bf_lo(hi.x), a0[1] - bf_hi(hi.x)); lo.y = cvt_pk_bf16(a0[2] - bf_lo(hi.y), a0[3] - bf_hi(hi.y));
        lo.z = cvt_pk_bf16(a1[0] - bf_lo(hi.z), a1[1] - bf_hi(hi.z)); lo.w = cvt_pk_bf16(a1[2] - bf_lo(hi.w), a1[3] - bf_hi(hi.w));
        const bf16x8 Ah = __builtin_bit_cast(bf16x8, hi), Al = __builtin_bit_cast(bf16x8, lo);
        const bf16x8 b0h = *(const bf16x8*)(WT_hi + (size_t)l15 * 2048 + kb), b0l = *(const bf16x8*)(WT_lo + (size_t)l15 * 2048 + kb);
        const bf16x8 b1h = *(const bf16x8*)(WT_hi + (size_t)(16 + l15) * 2048 + kb), b1l = *(const bf16x8*)(WT_lo + (size_t)(16 + l15) * 2048 + kb);
        acc0 = MFMA16(Ah, b0h, acc0); acc0 = MFMA16(Ah, b0l, acc0); acc0 = MFMA16(Al, b0h, acc0);
        acc1 = MFMA16(Ah, b1h, acc1); acc1 = MFMA16(Ah, b1l, acc1); acc1 = MFMA16(Al, b1h, acc1); }
    if (g < 2) {
#pragma unroll
        for (int r = 0; r < 4; ++r) { part[wave * 256 + (4 * g + r) * 32 + l15] = acc0[r]; part[wave * 256 + (4 * g + r) * 32 + 16 + l15] = acc1[r]; } }
}

template <bool LOREG>
__device__ __forceinline__ void skinny_mfma_r(const LAS float* hrow, const bf16x8 (&Bh)[8][2], const bf16x8 (&Bl)[8][2], const bf16* WT_lo, LAS float* part, int wave, int lane) {
    const int g = lane >> 4, l15 = lane & 15;
    f32x4 acc0 = {0.f, 0.f, 0.f, 0.f}, acc1 = acc0;
#pragma unroll
    for (int ks = 0; ks < 8; ++ks) { const int kb = 256 * wave + 32 * ks + 8 * g;
        f32x4 a0 = {0.f, 0.f, 0.f, 0.f}, a1 = a0;
        if (l15 < 8) { a0 = *(const LAS f32x4*)(hrow + l15 * 2048 + kb); a1 = *(const LAS f32x4*)(hrow + l15 * 2048 + kb + 4); }
        v4u hi, lo;
        hi.x = cvt_pk_bf16(a0[0], a0[1]); hi.y = cvt_pk_bf16(a0[2], a0[3]); hi.z = cvt_pk_bf16(a1[0], a1[1]); hi.w = cvt_pk_bf16(a1[2], a1[3]);
        lo.x = cvt_pk_bf16(a0[0] - bf_lo(hi.x), a0[1] - bf_hi(hi.x)); lo.y = cvt_pk_bf16(a0[2] - bf_lo(hi.y), a0[3] - bf_hi(hi.y));
        lo.z = cvt_pk_bf16(a1[0] - bf_lo(hi.z), a1[1] - bf_hi(hi.z)); lo.w = cvt_pk_bf16(a1[2] - bf_lo(hi.w), a1[3] - bf_hi(hi.w));
        const bf16x8 Ah = __builtin_bit_cast(bf16x8, hi), Al = __builtin_bit_cast(bf16x8, lo);
        bf16x8 b0l, b1l;
        if constexpr (LOREG) { b0l = Bl[ks][0]; b1l = Bl[ks][1]; }
        else { b0l = *(const bf16x8*)(WT_lo + (size_t)l15 * 2048 + kb); b1l = *(const bf16x8*)(WT_lo + (size_t)(16 + l15) * 2048 + kb); }
        acc0 = MFMA16(Ah, Bh[ks][0], acc0); acc0 = MFMA16(Ah, b0l, acc0); acc0 = MFMA16(Al, Bh[ks][0], acc0);
        acc1 = MFMA16(Ah, Bh[ks][1], acc1); acc1 = MFMA16(Ah, b1l, acc1); acc1 = MFMA16(Al, Bh[ks][1], acc1); }
    if (g < 2) {
#pragma unroll
        for (int r = 0; r < 4; ++r) { part[wave * 256 + (4 * g + r) * 32 + l15] = acc0[r]; part[wave * 256 + (4 * g + r) * 32 + 16 + l15] = acc1[r]; } }
}
#define SK_LOAD(B, BASE) do { _Pragma("unroll") for (int ks_ = 0; ks_ < 8; ++ks_) _Pragma("unroll") for (int n_ = 0; n_ < 2; ++n_) \
        B[ks_][n_] = *(const bf16x8*)((BASE) + (size_t)(16 * n_ + (lane & 15)) * 2048 + 256 * wave + 32 * ks_ + 8 * (lane >> 4)); } while (0)

__device__ __forceinline__ void p1_phase(LAS unsigned char* lds, int tid, int wave, int lane, int G, const float* x, const float* ctx, const float* MOD, const float* norm_g,
                                         const bf16* SK, const float* gate_b, bf16* HB, unsigned char* HB8, float* GATES) {
    LAS float* hrow = (LAS float*)(lds + wave * 8192); LAS float* part = (LAS float*)(lds + 65536);
    bf16x8 Bh[8][2], Bl[8][2]; SK_LOAD(Bh, SK); SK_LOAD(Bl, SK + 65536);
    f32x4 v[8];
    { const int row = blockIdx.x * 8 + wave; const float* xr = row < NLAT ? x + (size_t)row * DM : ctx + (size_t)(row - NLAT) * DM;
#pragma unroll
      for (int j = 0; j < 8; ++j) v[j] = *(const f32x4*)(xr + 4 * (lane + 64 * j)); }
    for (int it = blockIdx.x; it < NTOK / 8; it += G) {
        const int row = it * 8 + wave;
        const float* shift = MOD + (size_t)(row < NLAT ? (row >> 11) : 4) * 12288; const float* scale = shift + 2048;
        float ss = 0.f;
#pragma unroll
        for (int j = 0; j < 8; ++j) ss += (v[j][0] * v[j][0] + v[j][1] * v[j][1]) + (v[j][2] * v[j][2] + v[j][3] * v[j][3]);
        const float rstd = 1.0f / sqrtf(wave_sum(ss) * (1.0f / DM) + EPS);
#pragma unroll
        for (int j = 0; j < 8; ++j) { const int col = 4 * (lane + 64 * j);
            const f32x4 g = *(const f32x4*)(norm_g + col), sc = *(const f32x4*)(scale + col), sh = *(const f32x4*)(shift + col);
            const f32x4 h = (v[j] * rstd) * g * (sc + 1.0f) + sh;
            v2u o; o.x = cvt_pk_bf16(h[0], h[1]); o.y = cvt_pk_bf16(h[2], h[3]); *(v2u*)(HB + (size_t)row * DM + col) = o;
            *(unsigned*)(HB8 + (size_t)row * DM + col) = pg8::pk4_fp8(h[0] * pg8::F8_SA, h[1] * pg8::F8_SA, h[2] * pg8::F8_SA, h[3] * pg8::F8_SA);
            *(LAS f32x4*)(hrow + col) = h; }
        if (it + G < NTOK / 8) { const int rown = (it + G) * 8 + wave; const float* xr = rown < NLAT ? x + (size_t)rown * DM : ctx + (size_t)(rown - NLAT) * DM;
#pragma unroll
            for (int j = 0; j < 8; ++j) v[j] = *(const f32x4*)(xr + 4 * (lane + 64 * j)); }
        __syncthreads();
        skinny_mfma_r<true>((const LAS float*)lds, Bh, Bl, nullptr, part, wave, lane);
        __syncthreads();
        if (tid < 256) { float s = 0.f;
#pragma unroll
            for (int w = 0; w < 8; ++w) s += part[w * 256 + tid];
            GATES[(size_t)(it * 8) * 32 + tid] = s + gate_b[tid & 31]; }
    }
}

__device__ __forceinline__ void p3_phase(int wave, int lane, int G, const bf16* Z, const float* conv_w, const float* conv_b, const float* sgu_norm_g, bf16* QC, bf16* KC, bf16* SVN,
                                         const float* GATES, float* SCN, float* BEND, float* GMAX) {
    const int gw = blockIdx.x * NWAVES + wave, NGW = G * NWAVES;
    for (int task = gw; task < 64 * NCH; task += NGW) { const int bhd = task / NCH, bi = task - bhd * NCH, dir = bhd & 1, bh = bhd >> 1, b = bh >> 3, h = bh & 7;
        const size_t row0 = bi < 2 ? (size_t)NLAT + b * TCX + bi * 128 : (size_t)b * TL + (bi - 2) * 128;
        float* sp = SCN + (size_t)task * 384; float b_end, gmax;
        gate_scan(GATES, row0, (2 * dir) * 8 + h, (2 * dir + 1) * 8 + h, dir, lane, sp, sp + 128, sp + 256, b_end, gmax);
        const int c = dir == 0 ? bi : (bi < 2 ? 1 - bi : 19 - bi);
        if (lane == 0 && c < 17) { BEND[bhd * 17 + c] = b_end; GMAX[bhd * 17 + c] = gmax; } }
    for (int item = gw; item < NTOK; item += NGW) {
        const int rb = item >> 2, seg = item & 3, row0 = rb * 4, c0 = seg * 512 + lane * 8;
        const int t0 = row0 < NLAT ? (row0 & (TL - 1)) : ((row0 - NLAT) & (TCX - 1)), len = row0 < NLAT ? TL : TCX;
        v4u zr[8];
#pragma unroll
        for (int k = 0; k < 8; ++k) { const int tt = t0 + k - 2; zr[k] = (v4u){0u, 0u, 0u, 0u};
            if (tt >= 0 && tt < len) zr[k] = *(const v4u*)(Z + (size_t)(row0 + k - 2) * ZW + c0); }
        f32x4 w0[5], w1[5];
#pragma unroll
        for (int tau = 0; tau < 5; ++tau) { w0[tau] = *(const f32x4*)(conv_w + tau * 2048 + c0); w1[tau] = *(const f32x4*)(conv_w + tau * 2048 + c0 + 4); }
        const f32x4 b0 = *(const f32x4*)(conv_b + c0), b1 = *(const f32x4*)(conv_b + c0 + 4);
        const float qs = c0 < 1024 ? 0.08838834764831845f : 1.0f;
#pragma unroll
        for (int o = 0; o < 4; ++o) { float acc[8] = {b0[0], b0[1], b0[2], b0[3], b1[0], b1[1], b1[2], b1[3]};
#pragma unroll
            for (int tau = 0; tau < 5; ++tau) { const v4u z = zr[o + tau];
                acc[0] += w0[tau][0] * bf_lo(z.x); acc[1] += w0[tau][1] * bf_hi(z.x); acc[2] += w0[tau][2] * bf_lo(z.y); acc[3] += w0[tau][3] * bf_hi(z.y);
                acc[4] += w1[tau][0] * bf_lo(z.z); acc[5] += w1[tau][1] * bf_hi(z.z); acc[6] += w1[tau][2] * bf_lo(z.w); acc[7] += w1[tau][3] * bf_hi(z.w); }
#pragma unroll
            for (int i = 0; i < 8; ++i) acc[i] = siluf_(acc[i]) * qs;
            v4u ov; ov.x = cvt_pk_bf16(acc[0], acc[1]); ov.y = cvt_pk_bf16(acc[2], acc[3]); ov.z = cvt_pk_bf16(acc[4], acc[5]); ov.w = cvt_pk_bf16(acc[6], acc[7]);
            bf16* dst = c0 < 1024 ? QC + (size_t)(row0 + o) * 1024 + c0 : KC + (size_t)(row0 + o) * 1024 + (c0 - 1024);
            *(v4u*)dst = ov; }
    }
    for (int row = gw; row < NLAT; row += NGW) {
        float v[32]; float ss = 0.f;
#pragma unroll
        for (int j = 0; j < 4; ++j) { const v4u z = *(const v4u*)(Z + (size_t)row * ZW + ZS + 8 * lane + 512 * j);
            v[8 * j + 0] = gelu_tanh(bf_lo(z.x)); v[8 * j + 1] = gelu_tanh(bf_hi(z.x)); v[8 * j + 2] = gelu_tanh(bf_lo(z.y)); v[8 * j + 3] = gelu_tanh(bf_hi(z.y));
            v[8 * j + 4] = gelu_tanh(bf_lo(z.z)); v[8 * j + 5] = gelu_tanh(bf_hi(z.z)); v[8 * j + 6] = gelu_tanh(bf_lo(z.w)); v[8 * j + 7] = gelu_tanh(bf_hi(z.w)); }
#pragma unroll
        for (int i = 0; i < 32; ++i) ss += v[i] * v[i];
        const float rstd = 1.0f / sqrtf(wave_sum(ss) * (1.0f / DM) + EPS);
#pragma unroll
        for (int j = 0; j < 4; ++j) { const int col = 8 * lane + 512 * j; const f32x4 g0 = *(const f32x4*)(sgu_norm_g + col), g1 = *(const f32x4*)(sgu_norm_g + col + 4);
            v4u o; o.x = cvt_pk_bf16(v[8 * j] * rstd * g0[0], v[8 * j + 1] * rstd * g0[1]); o.y = cvt_pk_bf16(v[8 * j + 2] * rstd * g0[2], v[8 * j + 3] * rstd * g0[3]);
            o.z = cvt_pk_bf16(v[8 * j + 4] * rstd * g1[0], v[8 * j + 5] * rstd * g1[1]); o.w = cvt_pk_bf16(v[8 * j + 6] * rstd * g1[2], v[8 * j + 7] * rstd * g1[3]);
            *(v4u*)(SVN + (size_t)row * DM + col) = o; }
    }
}

constexpr int L_V0 = 0, L_V1 = 32768, L_K = 65536, L_SC = 98304, L_CB = 106496;
constexpr int N_M1 = 64 * 17, N_SGU = 512;
__device__ __forceinline__ void p4_phase(LAS unsigned char* lds, int tid_, int wave, int lane_, int G, const bf16* Z, const bf16* KC, const bf16* SVN, const float* SCN,
                                         const float* sgu_w, const float* sgu_b, bf16* DC, const float* GMAX, bf16* CM, int ufirst, int ustep) {
    v4u pk[4], pv[8]; f32x4 pa[2];
#define P4_ISSUE(U) do { const int u_ = (U); int t_ = tid_; asm volatile("" : "+v"(t_)); \
        if (u_ < N_M1) { const int bhd_ = u_ / 17, c_ = u_ - bhd_ * 17, dir_ = bhd_ & 1, bh_ = bhd_ >> 1, b_ = bh_ >> 3, h_ = bh_ & 7; \
            const bool ic_ = c_ < 2; const int blk_ = dir_ == 0 ? (ic_ ? c_ : c_ - 2) : (ic_ ? 1 - c_ : 17 - c_); \
            const size_t r0_ = ic_ ? (size_t)NLAT + b_ * TCX + blk_ * 128 : (size_t)b_ * TL + blk_ * 128; \
            const float* sp_ = SCN + (size_t)(bhd_ * NCH + (ic_ ? blk_ : blk_ + 2)) * 384; \
            _Pragma("unroll") for (int i = 0; i < 4; ++i) { const int id = t_ + NTHR * i; pk[i] = *(const v4u*)(KC + (r0_ + (id >> 4)) * 1024 + h_ * QKD + 8 * (id & 15)); pa[0][i] = sp_[128 + (id >> 4)]; } \
            pa[1][0] = GMAX[bhd_ * 17 + c_]; \
            _Pragma("unroll") for (int i = 0; i < 8; ++i) { const int id = t_ + NTHR * (i & 3); pv[i] = *(const v4u*)(Z + (r0_ + (id >> 4)) * ZW + ZV + h_ * VD + 128 * (i >> 2) + 8 * (id & 15)); } \
        } else { const int u2_ = u_ - N_M1, b_ = u2_ >> 7, n_ = (u2_ >> 3) & 15, grp_ = u2_ & 7; const size_t r0_ = (size_t)b_ * TL + n_ * 128; \
            _Pragma("unroll") for (int i = 0; i < 8; ++i) { const int id = t_ + NTHR * (i & 3); pv[i] = *(const v4u*)(SVN + (r0_ + (id >> 4)) * DM + grp_ * 256 + 128 * (i >> 2) + 8 * (id & 15)); } \
            } } while (0)
    int u = ufirst;
    if (u < N_M1 + N_SGU) P4_ISSUE(u);
    for (; u < N_M1 + N_SGU; u += ustep) {
        int tid = tid_; asm volatile("" : "+v"(tid)); const int lane = tid & 63; const unsigned g = lane >> 4, l15 = lane & 15;
        const bool m1 = u < N_M1;
        TR_NAT_OFFS(xn0, xn1, lane)
#pragma unroll
        for (int i = 0; i < 8; ++i) { const int id = tid + NTHR * (i & 3); *(LAS v4u*)(lds + ((i >> 2) ? L_V1 : L_V0) + img_off(id >> 4, id & 15)) = pv[i]; }
        bf16x8 Af[4]; v2u uw[16];
        if (m1) { const float gmax = pa[1][0];
#pragma unroll
            for (int i = 0; i < 4; ++i) { const int id = tid + NTHR * i, row = id >> 4, ch = id & 15; const float sw = __expf(pa[0][i] - gmax); const v4u v = pk[i]; v4u o;
                o.x = cvt_pk_bf16(bf_lo(v.x) * sw, bf_hi(v.x) * sw); o.y = cvt_pk_bf16(bf_lo(v.y) * sw, bf_hi(v.y) * sw); o.z = cvt_pk_bf16(bf_lo(v.z) * sw, bf_hi(v.z) * sw); o.w = cvt_pk_bf16(bf_lo(v.w) * sw, bf_hi(v.w) * sw);
                *(LAS v4u*)(lds + L_K + img_off(row, ch)) = o; }
        }
        __syncthreads();
        f32x4 af32[8];
        if (!m1) { const int u2 = u - N_M1, b = u2 >> 7, n = (u2 >> 3) & 15, grp = u2 & 7;
            const float* src = sgu_w + (size_t)grp * 16384 + (size_t)(16 * wave + l15) * 128 + 8 * g;
#pragma unroll
            for (int ks = 0; ks < 4; ++ks) { af32[2 * ks] = *(const f32x4*)(src + 32 * ks); af32[2 * ks + 1] = *(const f32x4*)(src + 32 * ks + 4); }
            const bf16* up = Z + ((size_t)b * TL + n * 128 + 16 * wave + l15) * ZW + ZU + grp * 256 + 4 * g;
#pragma unroll
            for (int et = 0; et < 16; ++et) uw[et] = *(const v2u*)(up + 16 * et); }
        if (u + ustep < N_M1 + N_SGU) P4_ISSUE(u + ustep);
        if (!m1) {
#pragma unroll
            for (int ks = 0; ks < 4; ++ks) { const f32x4 a = af32[2 * ks], b2 = af32[2 * ks + 1];
                const v4u p = {cvt_pk_bf16(a[0], a[1]), cvt_pk_bf16(a[2], a[3]), cvt_pk_bf16(b2[0], b2[1]), cvt_pk_bf16(b2[2], b2[3])}; Af[ks] = __builtin_bit_cast(bf16x8, p); } }
        if (m1) {
            const int bhd = u / 17, c = u - bhd * 17;
#pragma unroll
            for (int ks = 0; ks < 4; ++ks) Af[ks] = tr_frag(lds + L_K, 32 * ks + 8 * g, 32 * ks + 8 * g + 4, wave, lane);
            f32x4 acc[17];
#pragma unroll
            for (int et = 0; et < 17; ++et) acc[et] = (f32x4){0.f, 0.f, 0.f, 0.f};
#pragma unroll
            for (int et = 0; et < 16; ++et) { LAS unsigned char* img = lds + ((et >> 3) ? L_V1 : L_V0);
#pragma unroll
                for (int ks = 0; ks < 4; ++ks) { const bf16x8 Bf = tr_frag2(img + 8192 * ks, xn0[et & 7], xn1[et & 7]); acc[et] = MFMA16(Af[ks], Bf, acc[et]); } }
            { const short one = l15 == 0 ? (short)0x3F80 : (short)0; const bf16x8 Bo = {one, one, one, one, one, one, one, one};
#pragma unroll
                for (int ks = 0; ks < 4; ++ks) acc[16] = MFMA16(Af[ks], Bo, acc[16]); }
            bf16* dst = DC + ((size_t)bhd * 17 + c) * (CROWS * 128) + 16 * wave + 4 * g;
#pragma unroll
            for (int et = 0; et < 16; ++et) { v2u o; o.x = cvt_pk_bf16(acc[et][0], acc[et][1]); o.y = cvt_pk_bf16(acc[et][2], acc[et][3]); *(v2u*)(dst + (size_t)(16 * et + l15) * 128) = o; }
            if (l15 == 0) { v2u o; o.x = cvt_pk_bf16(acc[16][0], acc[16][1]); o.y = cvt_pk_bf16(acc[16][2], acc[16][3]); *(v2u*)(dst + (size_t)256 * 128) = o; }
        } else {
            const int u2 = u - N_M1, b = u2 >> 7, n = (u2 >> 3) & 15, grp = u2 & 7; const size_t row0 = (size_t)b * TL + n * 128;
            f32x4 acc[16];
#pragma unroll
            for (int et = 0; et < 16; ++et) { acc[et] = (f32x4){0.f, 0.f, 0.f, 0.f}; LAS unsigned char* img = lds + ((et >> 3) ? L_V1 : L_V0);
#pragma unroll
                for (int ks = 0; ks < 4; ++ks) { const bf16x8 Bf = tr_frag2(img + 8192 * ks, xn0[et & 7], xn1[et & 7]); acc[et] = MFMA16(Bf, Af[ks], acc[et]); } }
            { const int t = 16 * wave + l15; const float zb = sgu_b[grp * 128 + t]; const size_t row = row0 + t;
#pragma unroll
              for (int et = 0; et < 16; ++et) { const int col = grp * 256 + 16 * et + 4 * g; const v2u w2 = uw[et];
                  const float o0 = gelu_tanh(bf_lo(w2.x)) * (acc[et][0] + zb), o1 = gelu_tanh(bf_hi(w2.x)) * (acc[et][1] + zb), o2 = gelu_tanh(bf_lo(w2.y)) * (acc[et][2] + zb), o3 = gelu_tanh(bf_hi(w2.y)) * (acc[et][3] + zb);
                  v2u o; o.x = cvt_pk_bf16(o0, o1); o.y = cvt_pk_bf16(o2, o3); *(v2u*)(CM + row * DM + col) = o; } }
        }
        __syncthreads();
    }
#undef P4_ISSUE
}

__device__ __forceinline__ void p4_chain(LAS unsigned char* lds, int tid_, int wave, const bf16* Z, const bf16* KC, const float* SCN, const float* BEND, const float* GMAX, bf16* CS, float* MST) {
    const int bhd = blockIdx.x >> 1, eh = blockIdx.x & 1, dir = bhd & 1, bh = bhd >> 1, b = bh >> 3, h = bh & 7;
    v4u pk[4], pv[4]; f32x4 pg;
#define CH_ISSUE(C_) do { const int c_ = (C_); int t_ = tid_; asm volatile("" : "+v"(t_)); const bool ic_ = c_ < 2; const int blk_ = dir == 0 ? (ic_ ? c_ : c_ - 2) : (ic_ ? 1 - c_ : 17 - c_); \
        const size_t r0_ = ic_ ? (size_t)NLAT + b * TCX + blk_ * 128 : (size_t)b * TL + blk_ * 128; const float* sp_ = SCN + (size_t)(bhd * NCH + (ic_ ? blk_ : blk_ + 2)) * 384; \
        _Pragma("unroll") for (int i = 0; i < 4; ++i) { const int id = t_ + NTHR * i; pk[i] = *(const v4u*)(KC + (r0_ + (id >> 4)) * 1024 + h * QKD + 8 * (id & 15)); pg[i] = sp_[128 + (id >> 4)]; \
            pv[i] = *(const v4u*)(Z + (r0_ + (id >> 4)) * ZW + ZV + h * VD + 128 * eh + 8 * (id & 15)); } } while (0)
    f32x4 C[9];
#pragma unroll
    for (int et = 0; et < 9; ++et) C[et] = (f32x4){0.f, 0.f, 0.f, 0.f};
    float m = 0.f;
    CH_ISSUE(0);
#pragma unroll 1
    for (int c = 0; c < 17; ++c) {
        int tid = tid_; asm volatile("" : "+v"(tid)); const int lane = tid & 63; const unsigned g = lane >> 4, l15 = lane & 15;
        TR_NAT_OFFS(xn0, xn1, lane)
        const float gm = GMAX[bhd * 17 + c], be = BEND[bhd * 17 + c], mx = fmaxf(m, gm), al = __expf(m - mx);
#pragma unroll
        for (int i = 0; i < 4; ++i) { const int id = tid + NTHR * i, row = id >> 4, ch = id & 15; *(LAS v4u*)(lds + L_V0 + img_off(row, ch)) = pv[i];
            const float sw = __expf(pg[i] - mx); const v4u v = pk[i]; v4u o;
            o.x = cvt_pk_bf16(bf_lo(v.x) * sw, bf_hi(v.x) * sw); o.y = cvt_pk_bf16(bf_lo(v.y) * sw, bf_hi(v.y) * sw); o.z = cvt_pk_bf16(bf_lo(v.z) * sw, bf_hi(v.z) * sw); o.w = cvt_pk_bf16(bf_lo(v.w) * sw, bf_hi(v.w) * sw);
            *(LAS v4u*)(lds + L_K + img_off(row, ch)) = o; }
        __syncthreads();
        if (c + 1 < 17) CH_ISSUE(c + 1);
#pragma unroll
        for (int et = 0; et < 9; ++et) C[et] = C[et] * al;
        bf16x8 Af[4];
#pragma unroll
        for (int ks = 0; ks < 4; ++ks) Af[ks] = tr_frag(lds + L_K, 32 * ks + 8 * g, 32 * ks + 8 * g + 4, wave, lane);
#pragma unroll
        for (int et = 0; et < 8; ++et)
#pragma unroll
            for (int ks = 0; ks < 4; ++ks) { const bf16x8 Bf = tr_frag2(lds + L_V0 + 8192 * ks, xn0[et], xn1[et]); C[et] = MFMA16(Af[ks], Bf, C[et]); }
        if (eh == 0) { const short one = l15 == 0 ? (short)0x3F80 : (short)0; const bf16x8 Bo = {one, one, one, one, one, one, one, one};
#pragma unroll
            for (int ks = 0; ks < 4; ++ks) C[8] = MFMA16(Af[ks], Bo, C[8]); }
        m = be + mx;
        if (c >= 1) { bf16* dst = CS + ((size_t)bhd * 16 + (c - 1)) * (CROWS * 128) + 16 * wave + 4 * g;
#pragma unroll
            for (int et = 0; et < 8; ++et) { v2u o; o.x = cvt_pk_bf16(C[et][0], C[et][1]); o.y = cvt_pk_bf16(C[et][2], C[et][3]); *(v2u*)(dst + (size_t)(128 * eh + 16 * et + l15) * 128) = o; }
            if (eh == 0 && l15 == 0) { v2u o; o.x = cvt_pk_bf16(C[8][0], C[8][1]); o.y = cvt_pk_bf16(C[8][2], C[8][3]); *(v2u*)(dst + (size_t)256 * 128) = o; }
            if (eh == 0 && tid == 0) MST[bhd * 18 + c + 1] = m; }
        __syncthreads();
    }
#undef CH_ISSUE
}

__device__ __forceinline__ void p5_scan(int tid, int G, const bf16* DC, const float* BEND, const float* GMAX, bf16* CS, float* MST) {
    constexpr int QPB = 257 * 128 / 4;
    for (int idx = blockIdx.x * NTHR + tid; idx < 64 * QPB; idx += G * NTHR) {
        const int bhd = idx / QPB, q = idx - bhd * QPB;
        f32x4 C = {0.f, 0.f, 0.f, 0.f}; float m = 0.f;
#pragma unroll
        for (int c = 0; c < 17; ++c) {
            const float gm = GMAX[bhd * 17 + c], be = BEND[bhd * 17 + c], mx = fmaxf(m, gm), al = __expf(m - mx), bt = __expf(gm - mx);
            const v2u dw = *(const v2u*)(DC + ((size_t)bhd * 17 + c) * (CROWS * 128) + 4 * q); const f32x4 d = {bf_lo(dw.x), bf_hi(dw.x), bf_lo(dw.y), bf_hi(dw.y)};
            C = C * al + d * bt; m = be + mx;
            if (c >= 1) { v2u o; o.x = cvt_pk_bf16(C[0], C[1]); o.y = cvt_pk_bf16(C[2], C[3]);
                *(v2u*)(CS + ((size_t)bhd * 16 + (c - 1)) * (CROWS * 128) + 4 * q) = o; if (q == 0) MST[bhd * 18 + c + 1] = m; }
        }
    }
}

__device__ __forceinline__ void p6_phase(LAS unsigned char* lds, int tid, int wave, int lane_, int G, const bf16* Z, const bf16* QC, const bf16* KC, const float* SCN,
                                         const bf16* CS, const float* MST, const float* mnorm_g, bf16* RO) {
    for (int u = blockIdx.x; u < 512; u += G) {
        int lane = lane_; asm volatile("" : "+v"(lane)); const unsigned g = lane >> 4, l15 = lane & 15;
        const int bh = u >> 4, jb = u & 15, b = bh >> 3, h = bh & 7; const size_t row0 = (size_t)b * TL + jb * 128;
        load_tile128(lds + L_K, KC + row0 * 1024 + h * QKD, 1024, tid);
        load_tile128(lds + L_V0, Z + row0 * ZW + ZV + h * VD, ZW, tid);
        load_tile128(lds + L_V1, Z + row0 * ZW + ZV + h * VD + 128, ZW, tid);
        bf16x8 Qf[4];
#pragma unroll
        for (int ks = 0; ks < 4; ++ks) Qf[ks] = *(const bf16x8*)(QC + (row0 + 16 * wave + l15) * 1024 + h * QKD + 32 * ks + 8 * g);
        __syncthreads();
        f32x4 hsum[16];
#pragma unroll
        for (int et = 0; et < 16; ++et) hsum[et] = (f32x4){0.f, 0.f, 0.f, 0.f};
#pragma unroll 1
        for (int dir = 0; dir < 2; ++dir) {
            int lane = lane_; asm volatile("" : "+v"(lane));
            const unsigned g = lane >> 4, l15 = lane & 15;
            TR_PERM_OFFS(xp, lane)
            const int c = dir ? 17 - jb : 2 + jb; const bf16* cs = CS + ((size_t)(bh * 2 + dir) * 16 + (c - 2)) * (CROWS * 128);
            const float* sp = SCN + (size_t)((bh * 2 + dir) * NCH + 2 + jb) * 384; const float* gg = sp + 128; const float mc = MST[(bh * 2 + dir) * 18 + c];
            const int tS = 16 * wave + l15; const float MtS = fmaxf(mc, sp[256 + tS]);
            unsigned pw[16];
#pragma unroll
            for (int st = 0; st < 8; ++st) { f32x4 aS = {0.f, 0.f, 0.f, 0.f};
#pragma unroll
                for (int ks = 0; ks < 4; ++ks) { const bf16x8 Kf = *(const LAS bf16x8*)(lds + L_K + img_off(16 * st + l15, 4 * ks + g)); aS = MFMA16(Kf, Qf[ks], aS); }
                float pv[4]; const f32x4 gs = *(const f32x4*)(gg + 16 * st + 4 * g);
#pragma unroll
                for (int r = 0; r < 4; ++r) { const int s = 16 * st + 4 * g + r; const bool ok = dir ? (s >= tS) : (s <= tS); const float ev = __expf(fminf(gs[r] - MtS, 0.f)); pv[r] = ok ? aS[r] * ev : 0.f; }
                pw[2 * st] = cvt_pk_bf16(pv[0], pv[1]); pw[2 * st + 1] = cvt_pk_bf16(pv[2], pv[3]); asm volatile("" ::: "memory"); }
            bf16x8 Pf[4];
#pragma unroll
            for (int ks = 0; ks < 4; ++ks) { const v4u t4 = {pw[4 * ks], pw[4 * ks + 1], pw[4 * ks + 2], pw[4 * ks + 3]}; Pf[ks] = __builtin_bit_cast(bf16x8, t4); }
            const float wiT = __expf(mc - MtS), flT = __expf(-(sp[tS] + MtS));
            const short one = l15 == 0 ? (short)0x3F80 : (short)0; const bf16x8 Bo = {one, one, one, one, one, one, one, one};
            float inv;
            { f32x4 ad = {0.f, 0.f, 0.f, 0.f};
#pragma unroll
              for (int ks = 0; ks < 4; ++ks) { bf16x8 Cf = *(const bf16x8*)(cs + (size_t)256 * 128 + 32 * ks + 8 * g); if (l15 != 0) Cf = (bf16x8){0, 0, 0, 0, 0, 0, 0, 0}; ad = MFMA16(Cf, Qf[ks], ad); }
              ad[0] *= wiT;
#pragma unroll
              for (int ks = 0; ks < 4; ++ks) ad = MFMA16(Bo, Pf[ks], ad);
              const float den = __shfl(ad[0], lane & 15); inv = 1.0f / fmaxf(fabsf(den), flT); }
            { v4u cr[2];
#pragma unroll
              for (int i = 0; i < 2; ++i) { const int id = tid + NTHR * i; cr[i] = *(const v4u*)(cs + (size_t)(id >> 4) * 128 + 8 * (id & 15)); }
#pragma unroll
              for (int i = 0; i < 2; ++i) { const int id = tid + NTHR * i; *(LAS v4u*)(lds + L_CB + img_off(id >> 4, id & 15)) = cr[i]; }
#pragma unroll
              for (int gq = 0; gq < 4; ++gq) {
                LAS unsigned char* cb = lds + L_CB + (gq & 1) * 16384;
                __syncthreads();
                if (gq < 3) {
#pragma unroll
                    for (int i = 0; i < 2; ++i) { const int id = tid + NTHR * i; cr[i] = *(const v4u*)(cs + (size_t)(64 * (gq + 1) + (id >> 4)) * 128 + 8 * (id & 15)); } }
                f32x4 acc[4];
#pragma unroll
                for (int i = 0; i < 4; ++i) { acc[i] = (f32x4){0.f, 0.f, 0.f, 0.f};
#pragma unroll
                    for (int ks = 0; ks < 4; ++ks) { const bf16x8 Cf = *(const LAS bf16x8*)(cb + img_off(16 * i + l15, 4 * ks + g)); acc[i] = MFMA16(Cf, Qf[ks], acc[i]); } }
#pragma unroll
                for (int i = 0; i < 4; ++i) acc[i] = acc[i] * wiT;
                { LAS unsigned char* img = lds + ((gq >> 1) ? L_V1 : L_V0);
#pragma unroll
                  for (int i = 0; i < 4; ++i) {
#pragma unroll
                    for (int ks = 0; ks < 4; ++ks) { const bf16x8 Vf = tr_frag2(img + 8192 * ks, xp[4 * (gq & 1) + i], xp[4 * (gq & 1) + i] + 4096u); acc[i] = MFMA16(Vf, Pf[ks], acc[i]); } } }
#pragma unroll
                for (int i = 0; i < 4; ++i) hsum[4 * gq + i] += acc[i] * inv;
                if (gq < 3) {
#pragma unroll
                    for (int i = 0; i < 2; ++i) { const int id = tid + NTHR * i; *(LAS v4u*)(lds + L_CB + ((gq + 1) & 1) * 16384 + img_off(id >> 4, id & 15)) = cr[i]; } }
              } }
        }
        { float ss = 0.f;
#pragma unroll
          for (int et = 0; et < 16; ++et) ss += (hsum[et][0] * hsum[et][0] + hsum[et][1] * hsum[et][1]) + (hsum[et][2] * hsum[et][2] + hsum[et][3] * hsum[et][3]);
          ss += __shfl_xor(ss, 16); ss += __shfl_xor(ss, 32);
          const float rstd = 1.0f / sqrtf(ss * (1.0f / VD) + EPS); const size_t row = row0 + 16 * wave + l15;
#pragma unroll
          for (int et = 0; et < 16; ++et) { const int col = h * VD + 16 * et + 4 * g;
              const v2u ow = *(const v2u*)(Z + row * ZW + ZO + col); const f32x4 gn = *(const f32x4*)(mnorm_g + col);
              const float v0 = hsum[et][0] * rstd * gn[0] * sigmoidf_(bf_lo(ow.x)), v1 = hsum[et][1] * rstd * gn[1] * sigmoidf_(bf_hi(ow.x));
              const float v2 = hsum[et][2] * rstd * gn[2] * sigmoidf_(bf_lo(ow.y)), v3 = hsum[et][3] * rstd * gn[3] * sigmoidf_(bf_hi(ow.y));
              v2u o; o.x = cvt_pk_bf16(v0, v1); o.y = cvt_pk_bf16(v2, v3); *(v2u*)(RO + row * DM + col) = o; } }
        __syncthreads();
    }
}

__device__ __forceinline__ void p9_phase(LAS unsigned char* lds, int wave, int lane, int G, const float* X1, const float* MOD, const float* norm_g, const bf16* SK, const float* router_b,
                                         unsigned* cnt, unsigned char* XG, int* RE, int* RR, float* RG) {
    LAS float* hrow = (LAS float*)(lds + wave * 8192); LAS float* part = (LAS float*)(lds + 65536);
    bf16x8 Bh[8][2]; SK_LOAD(Bh, SK + 2 * 65536);
    f32x4 vn[8];
    { const float* xr = X1 + (size_t)(blockIdx.x * 8 + wave) * DM;
#pragma unroll
      for (int j = 0; j < 8; ++j) vn[j] = *(const f32x4*)(xr + 4 * (lane + 64 * j)); }
    for (int it = blockIdx.x; it < NLAT / 8; it += G) {
        const int row = it * 8 + wave;
        const float* shift = MOD + (size_t)(row >> 11) * 12288 + 3 * 2048; const float* scale = shift + 2048;
        f32x4 v[8]; float ss = 0.f;
#pragma unroll
        for (int j = 0; j < 8; ++j) { v[j] = vn[j]; ss += (v[j][0] * v[j][0] + v[j][1] * v[j][1]) + (v[j][2] * v[j][2] + v[j][3] * v[j][3]); }
        const float rstd = 1.0f / sqrtf(wave_sum(ss) * (1.0f / DM) + EPS);
#pragma unroll
        for (int j = 0; j < 8; ++j) { const int col = 4 * (lane + 64 * j);
            const f32x4 g = *(const f32x4*)(norm_g + col), sc = *(const f32x4*)(scale + col), sh = *(const f32x4*)(shift + col);
            v[j] = (v[j] * rstd) * g * (sc + 1.0f) + sh; *(LAS f32x4*)(hrow + col) = v[j]; }
        if (it + G < NLAT / 8) { const float* xr = X1 + (size_t)((it + G) * 8 + wave) * DM;
#pragma unroll
            for (int j = 0; j < 8; ++j) vn[j] = *(const f32x4*)(xr + 4 * (lane + 64 * j)); }
        __syncthreads();
        skinny_mfma_r<false>((const LAS float*)lds, Bh, Bh, SK + 3 * 65536, part, wave, lane);
        __syncthreads();
        float val = router_b[lane & 31];
#pragma unroll
        for (int w = 0; w < 8; ++w) val += part[w * 256 + wave * 32 + (lane & 31)];
        float sv[4]; int si[4];
#pragma unroll
        for (int k = 0; k < 4; ++k) { float bv = val; int bi = lane & 31;
#pragma unroll
            for (int o = 16; o >= 1; o >>= 1) { const float ov = __shfl_xor(bv, o); const int oi = __shfl_xor(bi, o); const bool take = (ov > bv) || (ov == bv && oi < bi); bv = take ? ov : bv; bi = take ? oi : bi; }
            sv[k] = bv; si[k] = __builtin_amdgcn_readfirstlane(bi); if ((lane & 31) == bi) val = -3.0e38f; }
        const float e1 = __expf(sv[1] - sv[0]), e2 = __expf(sv[2] - sv[0]), e3 = __expf(sv[3] - sv[0]), inv = 1.0f / (1.0f + e1 + e2 + e3);
        const float gk[4] = {inv, e1 * inv, e2 * inv, e3 * inv};
        unsigned rank = 0;
        if (lane < 4) rank = __hip_atomic_fetch_add(cnt + (lane == 0 ? si[0] : lane == 1 ? si[1] : lane == 2 ? si[2] : si[3]), 1u, RLX_AGENT);
#pragma unroll
        for (int k = 0; k < 4; ++k) { const unsigned rk = (unsigned)__builtin_amdgcn_readlane((int)rank, k);
            unsigned char* dst = XG + ((size_t)si[k] * 8192 + rk) * DM;
#pragma unroll
            for (int j = 0; j < 8; ++j) *(unsigned*)(dst + 4 * (lane + 64 * j)) = pg8::pk4_fp8(v[j][0] * pg8::F8_SA, v[j][1] * pg8::F8_SA, v[j][2] * pg8::F8_SA, v[j][3] * pg8::F8_SA);
            if (lane == 0) { RE[row * 4 + k] = si[k]; RR[row * 4 + k] = (int)rk; RG[row * 4 + k] = gk[k]; } }
    }
}
__device__ __forceinline__ void moe_prefix(LAS int* pref, const unsigned* cnt, int tid) {
    if (tid == 0) { int s = 0; for (int e = 0; e < 32; ++e) { const unsigned ce = __hip_atomic_load(cnt + e, RLX_AGENT); pref[e] = s; pref[33 + e] = (int)ce; s += (int)((ce + 255u) >> 8); } pref[32] = s; }
    __syncthreads();
}
__device__ __forceinline__ void p12_phase(const LAS int* pref, int wave, int lane_, int G, const float* X1, const float* MOD, const bf16* Y2, const int* RE, const int* RR, const float* RG, const float* final_g, float* out) {
    const int gw = blockIdx.x * NWAVES + wave, NGW = G * NWAVES;
    int en[4], rn[4]; float gn[4];
    if (gw < NLAT) {
#pragma unroll
        for (int k = 0; k < 4; ++k) { en[k] = RE[gw * 4 + k]; rn[k] = RR[gw * 4 + k]; gn[k] = RG[gw * 4 + k]; } }
    for (int row = gw; row < NLAT; row += NGW) {
        int lane = lane_; asm volatile("" : "+v"(lane));
        const float* xr = X1 + (size_t)row * DM + 4 * lane; f32x4 xv[8]; v2u yv[4][8]; float gt[4];
#pragma unroll
        for (int k = 0; k < 4; ++k) { gt[k] = gn[k]; const bf16* src = Y2 + ((size_t)pref[en[k]] * 256 + rn[k]) * DM + 4 * lane;
#pragma unroll
            for (int j = 0; j < 8; ++j) yv[k][j] = __builtin_nontemporal_load((const v2u*)(src + 256 * j)); }
#pragma unroll
        for (int j = 0; j < 8; ++j) xv[j] = __builtin_nontemporal_load((const f32x4*)(xr + 256 * j));
        if (row + NGW < NLAT) { const int r2 = row + NGW;
#pragma unroll
            for (int k = 0; k < 4; ++k) { en[k] = RE[r2 * 4 + k]; rn[k] = RR[r2 * 4 + k]; gn[k] = RG[r2 * 4 + k]; } }
        const float* g5 = MOD + (size_t)(row >> 11) * 12288 + 5 * 2048; float ss = 0.f;
#pragma unroll
        for (int j = 0; j < 8; ++j) { f32x4 ys = {0.f, 0.f, 0.f, 0.f};
#pragma unroll
            for (int k = 0; k < 4; ++k) { const v2u y = yv[k][j]; ys[0] += gt[k] * bf_lo(y.x); ys[1] += gt[k] * bf_hi(y.x); ys[2] += gt[k] * bf_lo(y.y); ys[3] += gt[k] * bf_hi(y.y); }
            const int col = 4 * (lane + 64 * j); const f32x4 x2 = xv[j] + *(const f32x4*)(g5 + col) * ys; xv[j] = x2;
            ss += (x2[0] * x2[0] + x2[1] * x2[1]) + (x2[2] * x2[2] + x2[3] * x2[3]); }
        const float rstd = 1.0f / sqrtf(wave_sum(ss) * (1.0f / DM) + EPS);
#pragma unroll
        for (int j = 0; j < 8; ++j) { const int col = 4 * (lane + 64 * j); __builtin_nontemporal_store(xv[j] * rstd * *(const f32x4*)(final_g + col), (f32x4*)(out + (size_t)row * DM + col)); }
    }
}

#define XB_TMO      128
#define XB_XCNT(j)  (256  + 64 * (j))
#define XB_XSUB(j)  (1280 + 64 * (j))
#define XB_XGEN(j)  (2304 + 64 * (j))
#define XB_TOP      3328
#define XB_TOPGEN   3392
#define XCD_BAR_WORDS 3456
#define XB_SPIN_CAP (1u << 18)

__device__ __forceinline__ unsigned xb_ld(unsigned* p)              { return __hip_atomic_load(p, __ATOMIC_RELAXED, __HIP_MEMORY_SCOPE_AGENT); }
__device__ __forceinline__ unsigned xb_add(unsigned* p, unsigned v) { return __hip_atomic_fetch_add(p, v, __ATOMIC_RELAXED, __HIP_MEMORY_SCOPE_AGENT); }
__device__ __forceinline__ unsigned xb_xcc_id() { return (unsigned)__builtin_amdgcn_s_getreg((3 << 11) | 20) & 0xFu; }
#define XB_SPIN(cond, bar) do { unsigned _sp = 0; while (cond) { __builtin_amdgcn_s_sleep(1); \
    if ((++_sp & 255u) == 0u) { if (xb_ld(&(bar)[XB_TMO])) break; if (_sp > XB_SPIN_CAP) { atomicAdd(&(bar)[XB_TMO], 1u); break; } } } } while (0)

struct XcdBarrier {
    unsigned* bar; unsigned x;
    volatile LAS unsigned* st;
};

__device__ __forceinline__ XcdBarrier xcd_barrier_post(unsigned* bar, volatile LAS unsigned* st) {
    XcdBarrier b; b.bar = bar; b.x = xb_xcc_id(); b.st = st;
    if (threadIdx.x == 0) (void)xb_add(&bar[XB_XCNT(b.x)], 1u);
    return b;
}
__device__ __forceinline__ void xcd_barrier_complete(unsigned* bar, unsigned x, unsigned& nloc, unsigned& nx) {
    const unsigned G = gridDim.x * gridDim.y * gridDim.z;
    unsigned sum, cnt, mine, sp = 0u;
    for (;;) {
        sum = 0u; cnt = 0u; mine = 0u;
#pragma unroll
        for (unsigned j = 0; j < 16; ++j) { const unsigned c = xb_ld(&bar[XB_XCNT(j)]); sum += c; cnt += (c > 0u) ? 1u : 0u; mine = (j == x) ? c : mine; }
        if (sum == G) break;
        __builtin_amdgcn_s_sleep(1);
        if ((++sp & 255u) == 0u) { if (xb_ld(&bar[XB_TMO])) break; if (sp > XB_SPIN_CAP) { atomicAdd(&bar[XB_TMO], 1u); break; } }
    }
    nloc = mine > 0u ? mine : 1u; nx = cnt > 0u ? cnt : 1u;
}

__device__ __forceinline__ void xcd_barrier(const XcdBarrier& b) {
    asm volatile("s_waitcnt vmcnt(0)" ::: "memory");
    __syncthreads();
    if (threadIdx.x == 0) {
        unsigned* bar = b.bar;
        __builtin_amdgcn_s_waitcnt(0);
        unsigned nloc = b.st[0], nx = b.st[1];
        if (nloc == 0u) { xcd_barrier_complete(bar, b.x, nloc, nx); b.st[0] = nloc; b.st[1] = nx; }
        const unsigned old = xb_add(&bar[XB_XSUB(b.x)], 1u);
        const unsigned gen = old / nloc;
        if (old + 1u == (gen + 1u) * nloc) {
            __builtin_amdgcn_fence(__ATOMIC_RELEASE, "agent");
            asm volatile("s_waitcnt vmcnt(0)" ::: "memory");
            const unsigned og = xb_add(&bar[XB_TOP], 1u);
            const unsigned tg = og / nx;
            if (og + 1u == (tg + 1u) * nx) xb_add(&bar[XB_TOPGEN], 1u);
            else XB_SPIN(xb_ld(&bar[XB_TOPGEN]) == tg, bar);
            __builtin_amdgcn_fence(__ATOMIC_ACQUIRE, "agent");
            xb_add(&bar[XB_XGEN(b.x)], 1u);
            asm volatile("s_waitcnt vmcnt(0)" ::: "memory");
        } else {
            XB_SPIN(xb_ld(&bar[XB_XGEN(b.x)]) == gen, bar);
            __builtin_amdgcn_fence(__ATOMIC_ACQUIRE, "agent");
            asm volatile("s_waitcnt vmcnt(0)" ::: "memory");
        }
    }
    __syncthreads();
}

struct Args { const float* in[26]; float* out; unsigned char* ws; int ph_lo, ph_hi; };
__global__ void __launch_bounds__(NTHR, 2) mk_fwd(Args args) {
    extern __shared__ __attribute__((aligned(16))) unsigned char lds_raw[];
    LAS unsigned char* lds = (LAS unsigned char*)lds_raw;
    const int tid = threadIdx.x, lane = tid & 63, wave = __builtin_amdgcn_readfirstlane(tid >> 6), G = gridDim.x;
    unsigned char* ws = args.ws;
    gu32* ctl = (gu32*)(ws + WS_CTL);
    for (int u = tid; u < (LDS_BYTES - LDSCTL_OFF) / 4; u += NTHR) ((LAS unsigned*)(lds + LDSCTL_OFF))[u] = 0u;
    __syncthreads();
    volatile LAS unsigned* MISC = (volatile LAS unsigned*)(lds + MISC_OFF);
    XcdBarrier bar; bar.bar = (unsigned*)(ctl + CW_BAR); bar.x = 0; bar.st = nullptr;
    if (N_LAUNCHES == 1) bar = xcd_barrier_post((unsigned*)(ctl + CW_BAR), MISC + 8);
#define GRID_BAR() do { if (N_LAUNCHES == 1) xcd_barrier(bar); } while (0)
    const int lo = args.ph_lo, hi = args.ph_hi;
#ifdef ONLY_PHASE
#define IN(k) ((k) == ONLY_PHASE && lo <= (k) && (k) < hi)
#else
#define IN(k) (lo <= (k) && (k) < hi)
#endif
#define BOTH(k) (IN(k) && IN((k) + 1))
#ifndef REP_MASK
#define REP_MASK 0
#endif
#define NREP(k) ((((REP_MASK) >> (k)) & 1) ? 2 : 1)
#define INP(i) (args.in[i])
#define WSF(off) ((float*)(ws + (off)))
#define WSB(off) ((bf16*)(ws + (off)))
#define WSI(off) ((int*)(ws + (off)))
    unsigned* cnt = (unsigned*)(ctl + CW_CNT);
    LAS int* pref = (LAS int*)(lds + PREF_OFF);
    const int n_conv_p0 = I_WIN + 3 * I_P;
#define x_in INP(0)
#define cvec INP(1)
#define ctx INP(2)
#define c_ctx INP(3)
#define mod_w INP(4)
#define mod_b INP(5)
#define norm1_g INP(6)
#define norm2_g INP(7)
#define w_in INP(8)
#define gate_b INP(9)
#define conv_w INP(10)
#define conv_b INP(11)
#define mnorm_g INP(12)
#define sgu_norm_g INP(13)
#define sgu_w INP(14)
#define sgu_b INP(15)
#define proj_a INP(16)
#define proj_b INP(17)
#define w_out INP(18)
#define router_w INP(19)
#define router_b INP(20)
#define exp_w1 INP(21)
#define exp_b1 INP(22)
#define exp_w2 INP(23)
#define exp_b2 INP(24)
#define final_g INP(25)
#define MOD WSF(WS_MOD)
#define GATES WSF(WS_GATES)
#define BEND WSF(WS_SCAL)
#define GMAX (WSF(WS_SCAL) + 64 * 17)
#define MST (WSF(WS_SCAL) + 2 * 64 * 17)
#define RE WSI(WS_ROUTE)
#define RR (WSI(WS_ROUTE) + NLAT * 4)
#define RG (WSF(WS_ROUTE) + 2 * NLAT * 4)
#define WINT WSB(WS_WINT)
#define SKW WSB(WS_SK)
#define SCN WSF(WS_SCN)
#define PAT WSB(WS_PAT)
#define PBT WSB(WS_PBT)
#define WOT WSB(WS_WOT)
#define W1T WSB(WS_W1T)
#define W1T8 ((unsigned char*)(ws + WS_W1T))
#define HB8M ((unsigned char*)(ws + WS_HB8))
#define WG8M ((unsigned char*)(ws + WS_WG8))
#define W2T8 ((unsigned char*)(ws + WS_W2T))
#define XG8 ((unsigned char*)(ws + WS_XG))
#define ACT8 ((unsigned char*)(ws + WS_ACT))
#define W2T WSB(WS_W2T)
#define HB WSB(WS_HB)
#define Z WSB(WS_Z)
#define QC WSB(WS_QC)
#define KC WSB(WS_KC)
#define SVN WSB(WS_SVN)
#define DC WSB(WS_DC)
#define CS WSB(WS_CS)
#define RO WSB(WS_RO)
#define CM WSB(WS_CM)
#define YB WSB(WS_YB)
#define MRG WSB(WS_MRG)
#define X1 WSF(WS_X1)
#define ACT WSB(WS_ACT)
#define Y2 WSB(WS_Y2)
#define XG WSB(WS_XG)

    if (IN(0)) for (int rep_ = 0; rep_ < NREP(0); ++rep_) { p0_phase(lds, tid, G, cvec, c_ctx, mod_w, mod_b, MOD, w_in, proj_a, proj_b, w_out, exp_w1, exp_w2, router_w, WINT, PAT, PBT, WOT, W1T, W2T, SKW, n_conv_p0);
        cvt_run8(lds, tid, I_W1 + I_W2 + (int)blockIdx.x, G, I_W1 + I_W2 + I_GATE8, exp_w1, exp_w2, w_in, W1T8, W2T8, WG8M); if (BOTH(0) || rep_ + 1 < NREP(0)) GRID_BAR(); }
    if (IN(1)) for (int rep_ = 0; rep_ < NREP(1); ++rep_) { p1_phase(lds, tid, wave, lane, G, x_in, ctx, MOD, norm1_g, SKW, gate_b, HB, HB8M, GATES); if (BOTH(1) || rep_ + 1 < NREP(1)) GRID_BAR(); }
    if (IN(2)) for (int rep_ = 0; rep_ < NREP(2); ++rep_) {
        if ((int)blockIdx.x >= G - (G == 256 ? N_CONVERTERS : G))
            cvt_run8(lds, tid, (int)blockIdx.x - (G - (G == 256 ? N_CONVERTERS : G)), (G == 256 ? N_CONVERTERS : G), I_W1 + I_W2, exp_w1, exp_w2, w_in, W1T8, W2T8, WG8M);
        { pg8::Gemm g{(const bf16*)HB8M, (const bf16*)WG8M, NTOK, 12288, DM}; pg8::DynOrder S{(unsigned*)(ctl + CW_Q2), (LAS int*)(lds + PREF_OFF + 808), (int)(blockIdx.x & 7), 48, 8, 0}; pg8::EpiGate8 E{Z, ZW};
          pg8::gemm_phase8<pg8::EpiGate8, pg8::DynOrder, true, true>(lds, g, S, E); }
        { pg8::Gemm g{HB, WINT, NLAT, ZW, DM}; pg8::DynOrder S{(unsigned*)(ctl + CW_Q), (LAS int*)(lds + PREF_OFF + 800), (int)(blockIdx.x & 7), 8, 0, 24}; pg8::EpiBf16 E{Z, ZW, nullptr, ZW / 256};
          pg8::gemm_phase<pg8::EpiBf16, pg8::DynOrder, true, true>(lds, g, S, E); }
        if (BOTH(2) || rep_ + 1 < NREP(2)) GRID_BAR();
    }
    if (IN(3)) for (int rep_ = 0; rep_ < NREP(3); ++rep_) { p3_phase(wave, lane, G, Z, conv_w, conv_b, sgu_norm_g, QC, KC, SVN, GATES, SCN, BEND, GMAX); if (BOTH(3) || rep_ + 1 < NREP(3)) GRID_BAR(); }
    if (IN(4)) for (int rep_ = 0; rep_ < NREP(4); ++rep_) { if (G == 256) { if ((int)blockIdx.x < 128) p4_chain(lds, tid, wave, Z, KC, SCN, BEND, GMAX, CS, MST); else p4_phase(lds, tid, wave, lane, G, Z, KC, SVN, SCN, sgu_w, sgu_b, DC, GMAX, CM, N_M1 + (int)blockIdx.x - 128, 128); }
        else p4_phase(lds, tid, wave, lane, G, Z, KC, SVN, SCN, sgu_w, sgu_b, DC, GMAX, CM, (int)blockIdx.x, G);
        if (BOTH(4) || rep_ + 1 < NREP(4)) GRID_BAR(); }
    if (IN(5)) for (int rep_ = 0; rep_ < NREP(5); ++rep_) {
        { pg8::Gemm g{CM, PBT, NLAT, DM, DM}; pg8::StaticOrder S; S.init(NLAT, DM, G, (int)blockIdx.x); pg8::EpiBf16 E{YB, DM, nullptr, DM / 256};
          pg8::gemm_phase<pg8::EpiBf16, pg8::StaticOrder, true, true>(lds, g, S, E); }
        if (G != 256) p5_scan(tid, G, DC, BEND, GMAX, CS, MST);
        if (BOTH(5) || rep_ + 1 < NREP(5)) GRID_BAR();
    }
    if (IN(6)) for (int rep_ = 0; rep_ < NREP(6); ++rep_) { p6_phase(lds, tid, wave, lane, G, Z, QC, KC, SCN, CS, MST, mnorm_g, RO); if (BOTH(6) || rep_ + 1 < NREP(6)) GRID_BAR(); }
    if (IN(7)) for (int rep_ = 0; rep_ < NREP(7); ++rep_) {
        pg8::Gemm g{RO, PAT, NLAT, DM, DM}; pg8::StaticOrder S; S.init(NLAT, DM, G, (int)blockIdx.x); pg8::EpiMerge E{MRG, Z, ZW, ZGA, ZGB, YB};
        pg8::gemm_phase<pg8::EpiMerge, pg8::StaticOrder, true, true>(lds, g, S, E);
        if (BOTH(7) || rep_ + 1 < NREP(7)) GRID_BAR();
    }
    if (IN(8)) for (int rep_ = 0; rep_ < NREP(8); ++rep_) {
        pg8::Gemm g{MRG, WOT, NLAT, DM, DM}; pg8::StaticOrder S; S.init(NLAT, DM, G, (int)blockIdx.x); pg8::EpiX1 E{X1, x_in, MOD};
        pg8::gemm_phase<pg8::EpiX1, pg8::StaticOrder, true, true>(lds, g, S, E);
        if (BOTH(8) || rep_ + 1 < NREP(8)) GRID_BAR();
    }
    if (IN(9)) for (int rep_ = 0; rep_ < NREP(9); ++rep_) { p9_phase(lds, wave, lane, G, X1, MOD, norm2_g, SKW, router_b, cnt, XG8, RE, RR, RG); if (BOTH(9) || rep_ + 1 < NREP(9)) GRID_BAR(); }
    if (IN(10)) for (int rep_ = 0; rep_ < NREP(10); ++rep_) {
        moe_prefix(pref, cnt, tid);
        pg8::Gemm g{(const bf16*)XG8, (const bf16*)W1T8, 0, 0, DM}; pg8::MoeDyn S{pref, 16, 1, (unsigned*)(ctl + CW_Q3), (LAS int*)(lds + PREF_OFF + 816), (int)(blockIdx.x & 7)}; pg8::EpiSwiglu8 E{ACT8, exp_b1};
        pg8::gemm_phase8<pg8::EpiSwiglu8, pg8::MoeDyn, true, true, true>(lds, g, S, E);
        if (BOTH(10) || rep_ + 1 < NREP(10)) GRID_BAR();
    }
    if (IN(11)) for (int rep_ = 0; rep_ < NREP(11); ++rep_) {
        moe_prefix(pref, cnt, tid);
        pg8::Gemm g{(const bf16*)ACT8, (const bf16*)W2T8, 0, 0, DEXP}; pg8::MoeDyn S{pref, 8, 0, (unsigned*)(ctl + CW_Q4), (LAS int*)(lds + PREF_OFF + 824), (int)(blockIdx.x & 7)}; pg8::EpiY2f8 E{Y2, exp_b2};
        pg8::gemm_phase8<pg8::EpiY2f8, pg8::MoeDyn, true, true, true>(lds, g, S, E);
        if (BOTH(11) || rep_ + 1 < NREP(11)) GRID_BAR();
    }
    if (IN(12)) for (int rep_ = 0; rep_ < NREP(12); ++rep_) { moe_prefix(pref, cnt, tid); p12_phase(pref, wave, lane, G, X1, MOD, Y2, RE, RR, RG, final_g, args.out); if (rep_ + 1 < NREP(12)) GRID_BAR(); }
#undef IN
#undef BOTH
}

extern "C" void kernel_launch(void* const* d_in, const int* in_sizes, int n_in, void* d_out, int out_size, void* d_ws, size_t ws_size, hipStream_t stream) {
    static int grid = 0;
    if (grid == 0) {
        if (n_in != 26 || out_size != NLAT * DM || ws_size < WS_END) { fprintf(stderr, "kernel_launch: unexpected shapes (n_in %d, out %d, ws %zu)\n", n_in, out_size, ws_size); grid = -1; return; }
        int dev = 0, cus = 0;
        if (hipGetDevice(&dev) != hipSuccess || hipDeviceGetAttribute(&cus, hipDeviceAttributeMultiprocessorCount, dev) != hipSuccess) { grid = -1; return; }
        if (hipFuncSetAttribute((const void*)mk_fwd, hipFuncAttributeMaxDynamicSharedMemorySize, LDS_BYTES) != hipSuccess) { fprintf(stderr, "kernel_launch: hipFuncSetAttribute failed\n"); grid = -1; return; }
        int per_cu = 0;
        if (hipOccupancyMaxActiveBlocksPerMultiprocessor(&per_cu, (const void*)mk_fwd, NTHR, LDS_BYTES) != hipSuccess || per_cu < 1) fprintf(stderr, "kernel_launch: occupancy query reports %d\n", per_cu);
        (void)hipGetLastError();
        grid = cus;
    }
    if (grid < 0) return;
    if (hipMemsetAsync((char*)d_ws + WS_CTL, 0, CTL_ZERO_BYTES, stream) != hipSuccess) return;
    Args a{};
    for (int i = 0; i < 26; ++i) a.in[i] = (const float*)d_in[i];
    a.out = (float*)d_out; a.ws = (unsigned char*)d_ws;
    for (int li = 0; li < N_LAUNCHES; ++li) {
        a.ph_lo = (N_LAUNCHES == 1) ? 0 : li; a.ph_hi = (N_LAUNCHES == 1) ? N_PHASES : li + 1;
        hipLaunchKernelGGL(mk_fwd, dim3(grid), dim3(NTHR), LDS_BYTES, stream, a);
        const hipError_t le = hipPeekAtLastError();
        if (le != hipSuccess) { fprintf(stderr, "kernel_launch: launch %d failed: %s\n", li, hipGetErrorName(le)); break; }
    }
}
```

```cpp
#include <hip/hip_runtime.h>
#include <cstdio>
#include <cstdint>
#ifndef MK_N_LAUNCHES
#define MK_N_LAUNCHES 1
#endif
namespace pg8 {
#define PG8_LAS __attribute__((address_space(3)))
typedef unsigned short bf16_t;
typedef short bf16x8 __attribute__((ext_vector_type(8)));
typedef float f32x4 __attribute__((ext_vector_type(4)));
typedef unsigned u32x4 __attribute__((ext_vector_type(4)));
typedef int i32x4 __attribute__((ext_vector_type(4)));
typedef int i32x8 __attribute__((ext_vector_type(8)));
constexpr int BM = 256, BK = 64, HALF = 128, HTB = HALF * BK * 2  , STAGE_BYTES = 8 * HTB, NXCD = 8, WGM = 8;

__host__ __device__ __forceinline__ int lds_byte(int r, int c) { const int st = (r >> 4) * 2 + (c >> 5), rr = r & 15, cc = c & 31, ob = rr * 64 + cc * 2; return st * 1024 + (ob ^ (((ob >> 9) & 1) << 5)); }
__host__ __device__ __forceinline__ void stage_rc(int b, int& R, int& C) { const int st = b / 1024, sb = b % 1024, swz = sb ^ (((sb >> 9) & 1) << 5); R = (st >> 1) * 16 + swz / 64; C = (st & 1) * 32 + (swz % 64) / 2; }
__host__ __device__ __forceinline__ int perm32(int rho) { const int n = rho >> 4, i = rho & 15; return 8 * (i >> 2) + 4 * n + (i & 3); }

struct Unit { int pm, pn, po, hf; };
struct Gemm { const bf16_t* A; const bf16_t* Bt; int M, N, K; };

struct StaticOrder {
    int nM, nN, nwg, G, c;
    __host__ __device__ void init(int M, int N, int G_, int c_) { nM = M / BM; nN = N / BM; nwg = nM * nN; G = G_; c = c_; }
    __host__ __device__ bool next(int i, Unit& u) const {
        const long L = (long)i * G + c; if (L >= nwg) return false;
        int wgid = (int)L; { const int q = nwg / NXCD, r = nwg % NXCD, xcd = wgid % NXCD, off = wgid / NXCD; wgid = (xcd < r ? xcd * (q + 1) : r * (q + 1) + (xcd - r) * q) + off; }
        const int nig = WGM * nN, gid = wgid / nig, fm = gid * WGM, gsz = (nM - fm) < WGM ? (nM - fm) : WGM;
        u.pm = fm + ((wgid % nig) % gsz); u.pn = (wgid % nig) / gsz; u.po = u.pm; u.hf = 0; return true;
    }
    __device__ __forceinline__ void a_ready(const Unit&) const {}
    __device__ __forceinline__ void done(const Unit&) const {}
};
struct DynOrder {
    unsigned* q; PG8_LAS int* slot; int xcd, nN, ctx8, pn0;
    __device__ __forceinline__ bool next(int i, Unit& u) const {
        if (threadIdx.x == 0) { int id = -1;
            unsigned v = __hip_atomic_fetch_add(q + 64 * xcd, 1u, __ATOMIC_RELAXED, __HIP_MEMORY_SCOPE_AGENT);
            const unsigned per = (unsigned)(4 * nN + ctx8);
            if (v < per) id = xcd * (int)per + (int)v;
            else {
#pragma unroll 1
                for (int k = 1; k < 8 && id < 0; ++k) { const int x = (xcd + k) & 7;
                    if (__hip_atomic_load(q + 64 * x, __ATOMIC_RELAXED, __HIP_MEMORY_SCOPE_AGENT) < per) { v = __hip_atomic_fetch_add(q + 64 * x, 1u, __ATOMIC_RELAXED, __HIP_MEMORY_SCOPE_AGENT); if (v < per) id = x * (int)per + (int)v; } } }
            slot[i & 1] = id; asm volatile("s_waitcnt lgkmcnt(0)" ::: "memory"); }
        asm volatile("" ::: "memory"); __builtin_amdgcn_s_barrier(); asm volatile("" ::: "memory");
        const int id = slot[i & 1]; if (id < 0) return false;
        const int per = 4 * nN + ctx8, nl = 4 * nN, x = id / per, v = id - x * per;
        if (v < nl) { const int wgid = x * nl + v, nig = WGM * nN, gid = wgid / nig; u.pm = gid * WGM + ((wgid % nig) % WGM); u.pn = pn0 + (wgid % nig) / WGM; }
        else { const int j = x * 8 + (v - nl); u.pm = 32 + (j & 3); u.pn = j >> 2; }
        u.po = u.pm; u.hf = 0; return true;
    }
    __device__ __forceinline__ void a_ready(const Unit&) const {}
    __device__ __forceinline__ void done(const Unit&) const {}
};
struct MoeOrder {
    const PG8_LAS int* pref; int nN, G, c, a_sparse;
    __device__ __forceinline__ bool next(int i, Unit& u) const {
        const int L = i * G + c, total = pref[32]; if (L >= total * nN) return false;
        const int mt = L / nN, nt = L - mt * nN; int e = 0;
        for (int k = 1; k < 32; ++k) e += (pref[k] <= mt) ? 1 : 0;
        u.pm = a_sparse ? e * 32 + (mt - pref[e]) : mt; u.pn = e * nN + nt; u.po = mt; u.hf = (pref[33 + e] - 256 * (mt - pref[e]) <= 128) ? 1 : 0; return true;
    }
    __device__ __forceinline__ void a_ready(const Unit&) const {}
    __device__ __forceinline__ void done(const Unit&) const {}
};

struct MoeDyn {
    const PG8_LAS int* pref; int nN, a_sparse; unsigned* q; PG8_LAS int* slot; int xcd;
    __device__ __forceinline__ bool next(int i, Unit& u) const {
        if (threadIdx.x == 0) { int id = -1; const unsigned per = (unsigned)((pref[4 * xcd + 4] - pref[4 * xcd]) * nN);
            unsigned v = __hip_atomic_fetch_add(q + 64 * xcd, 1u, __ATOMIC_RELAXED, __HIP_MEMORY_SCOPE_AGENT);
            if (v < per) id = (xcd << 16) | (int)v;
            else {
#pragma unroll 1
                for (int j = 1; j < 8 && id < 0; ++j) { const int x = (xcd + j) & 7; const unsigned perx = (unsigned)((pref[4 * x + 4] - pref[4 * x]) * nN);
                    if (__hip_atomic_load(q + 64 * x, __ATOMIC_RELAXED, __HIP_MEMORY_SCOPE_AGENT) < perx) { v = __hip_atomic_fetch_add(q + 64 * x, 1u, __ATOMIC_RELAXED, __HIP_MEMORY_SCOPE_AGENT); if (v < perx) id = (x << 16) | (int)v; } } }
            slot[i & 1] = id; asm volatile("s_waitcnt lgkmcnt(0)" ::: "memory"); }
        asm volatile("" ::: "memory"); __builtin_amdgcn_s_barrier(); asm volatile("" ::: "memory");
        const int id = slot[i & 1]; if (id < 0) return false;
        int v = id & 0xffff, e = 4 * (id >> 16);
#pragma unroll
        for (int j = 0; j < 3; ++j) { const int ue = (pref[e + 1] - pref[e]) * nN; if (v >= ue) { v -= ue; ++e; } }
        const int T = pref[e + 1] - pref[e], blk = 8 * T, nb = v / blk, r2 = v - nb * blk, mtl = r2 >> 3, nt = nb * 8 + (r2 & 7), mt = pref[e] + mtl;
        u.pm = a_sparse ? e * 32 + mtl : mt; u.pn = e * nN + nt; u.po = mt; u.hf = (pref[33 + e] - 256 * mtl <= 128) ? 1 : 0; return true;
    }
    __device__ __forceinline__ void a_ready(const Unit&) const {}
    __device__ __forceinline__ void done(const Unit&) const {}
};

__device__ __forceinline__ unsigned cvt_pk_bf16(float lo, float hi) { unsigned r; asm volatile("v_cvt_pk_bf16_f32 %0, %1, %2" : "=v"(r) : "v"(lo), "v"(hi)); return r; }
__device__ __forceinline__ float bf_lo(unsigned w) { return __uint_as_float(w << 16); }
__device__ __forceinline__ float bf_hi(unsigned w) { return __uint_as_float(w & 0xffff0000u); }
__device__ __forceinline__ unsigned pk4_fp8(float a, float b, float c, float d) {
    a = fminf(fmaxf(a, -448.f), 448.f); b = fminf(fmaxf(b, -448.f), 448.f); c = fminf(fmaxf(c, -448.f), 448.f); d = fminf(fmaxf(d, -448.f), 448.f);
    int p = __builtin_amdgcn_cvt_pk_fp8_f32(a, b, 0, false); p = __builtin_amdgcn_cvt_pk_fp8_f32(c, d, p, true); return (unsigned)p; }
constexpr float F8_SA = 16.0f, F8_SW = 512.0f, F8_SC = 4.0f;
__device__ __forceinline__ float sigmoidf_(float x) { return __builtin_amdgcn_rcpf(1.0f + __expf(-x)); }

struct EpiBf16 {
    static constexpr bool PERM = true, AFTER_DRAIN = false;
    bf16_t* O; int ldc; const float* bias; int ncolt;
    __device__ __forceinline__ void operator()(const f32x4 (&acc)[2][2][4][2], const Unit& u, int wr, int wc, int fr, int fq) const {
        const int row0 = u.po * BM + wr * 64 + fr; const int colt = (u.pn % ncolt) * BM;
        const int col0 = colt + wc * 32 + 8 * fq, bcol0 = u.pn * BM + wc * 32 + 8 * fq;
        f32x4 bv[2][2];
#pragma unroll
        for (int bj = 0; bj < 2; ++bj)
#pragma unroll
            for (int n = 0; n < 2; ++n) bv[bj][n] = bias ? *(const f32x4*)(bias + bcol0 + bj * HALF + 4 * n) : (f32x4){0.f, 0.f, 0.f, 0.f};
#pragma unroll
        for (int ai = 0; ai < 2; ++ai)
#pragma unroll
            for (int m = 0; m < 4; ++m) { bf16_t* rowp = O + (size_t)(row0 + ai * HALF + m * 16) * ldc + col0;
#pragma unroll
                for (int bj = 0; bj < 2; ++bj) { const f32x4 v0 = acc[ai][bj][m][0] + bv[bj][0], v1 = acc[ai][bj][m][1] + bv[bj][1];
                    u32x4 w; w.x = cvt_pk_bf16(v0[0], v0[1]); w.y = cvt_pk_bf16(v0[2], v0[3]); w.z = cvt_pk_bf16(v1[0], v1[1]); w.w = cvt_pk_bf16(v1[2], v1[3]);
                    __builtin_nontemporal_store(w, (u32x4*)(rowp + bj * HALF)); } }
    }
};
struct EpiSwiglu8 {
    static constexpr bool PERM = true, AFTER_DRAIN = false, LDS_BIAS = true;
    unsigned char* O; const float* b1;
    __device__ __forceinline__ void stage_bias(const Unit& u, PG8_LAS unsigned char* dst, int lane) const {
        const int e = u.pn >> 4, nt = u.pn & 15; const float* src = b1 + (size_t)e * 4096 + nt * 128 + (lane < 32 ? 4 * lane : 2048 + 4 * (lane - 32));
        __builtin_amdgcn_global_load_lds((const unsigned*)src, (PG8_LAS unsigned*)dst, 16, 0, 0); }
    __device__ __forceinline__ void operator()(const f32x4 (&acc)[2][2][4][2], const Unit& u, int wr, int wc, int fr, int fq, const PG8_LAS unsigned char* bias) const {
        const int nt = u.pn & 15; const int row0 = u.po * BM + wr * 64 + fr; constexpr float us = 1.0f / (F8_SA * F8_SW);
        const PG8_LAS float* bg = (const PG8_LAS float*)bias + wc * 32 + 8 * fq; const PG8_LAS float* bl = bg + 128;
        unsigned char* obase = O + (size_t)(row0 + (fq & 1) * 16) * 2048 + nt * 128 + wc * 32 + 16 * (fq >> 1);
#pragma unroll
        for (int ai = 0; ai < 2; ++ai)
#pragma unroll
            for (int mp = 0; mp < 2; ++mp) { unsigned w[2][2];
#pragma unroll
                for (int mm = 0; mm < 2; ++mm)
#pragma unroll
                    for (int n = 0; n < 2; ++n) { const int m = 2 * mp + mm; const f32x4 gv = acc[ai][0][m][n] * us + *(const PG8_LAS f32x4*)(bg + 4 * n), lv = acc[ai][1][m][n] * us + *(const PG8_LAS f32x4*)(bl + 4 * n);
                        float o[4];
#pragma unroll
                        for (int i = 0; i < 4; ++i) { const float ga = fminf(gv[i], 7.0f), la = fminf(fmaxf(lv[i], -7.0f), 7.0f); o[i] = ga * sigmoidf_(1.702f * ga) * (la + 1.0f) * F8_SC; }
                        w[mm][n] = pk4_fp8(o[0], o[1], o[2], o[3]); }
                const auto r0 = __builtin_amdgcn_permlane16_swap(w[0][0], w[1][0], false, false), r1 = __builtin_amdgcn_permlane16_swap(w[0][1], w[1][1], false, false);
                const u32x4 ww = {r0[0], r1[0], r0[1], r1[1]};
                *(u32x4*)(obase + (size_t)(ai * HALF + mp * 32) * 2048) = ww; }
    }
};
struct EpiY2f8 {
    static constexpr bool PERM = true, AFTER_DRAIN = false, LDS_BIAS = true;
    bf16_t* O; const float* bias;
    __device__ __forceinline__ void stage_bias(const Unit& u, PG8_LAS unsigned char* dst, int lane) const {
        __builtin_amdgcn_global_load_lds((const unsigned*)(bias + (size_t)u.pn * BM + 4 * lane), (PG8_LAS unsigned*)dst, 16, 0, 0); }
    __device__ __forceinline__ void operator()(const f32x4 (&acc)[2][2][4][2], const Unit& u, int wr, int wc, int fr, int fq, const PG8_LAS unsigned char* lb) const {
        const int row0 = u.po * BM + wr * 64 + fr; const int col0 = (u.pn & 7) * BM + wc * 32 + 8 * fq; constexpr float us = 1.0f / (F8_SC * F8_SW);
        f32x4 bv[2][2];
#pragma unroll
        for (int bj = 0; bj < 2; ++bj)
#pragma unroll
            for (int n = 0; n < 2; ++n) bv[bj][n] = *(const PG8_LAS f32x4*)((const PG8_LAS float*)lb + wc * 32 + 8 * fq + bj * HALF + 4 * n);
#pragma unroll
        for (int ai = 0; ai < 2; ++ai)
#pragma unroll
            for (int m = 0; m < 4; ++m) { bf16_t* rowp = O + (size_t)(row0 + ai * HALF + m * 16) * 2048 + col0;
#pragma unroll
                for (int bj = 0; bj < 2; ++bj) { const f32x4 v0 = acc[ai][bj][m][0] * us + bv[bj][0], v1 = acc[ai][bj][m][1] * us + bv[bj][1];
                    u32x4 w; w.x = cvt_pk_bf16(v0[0], v0[1]); w.y = cvt_pk_bf16(v0[2], v0[3]); w.z = cvt_pk_bf16(v1[0], v1[1]); w.w = cvt_pk_bf16(v1[2], v1[3]);
                    __builtin_nontemporal_store(w, (u32x4*)(rowp + bj * HALF)); } }
    }
};
struct EpiGate8 {
    static constexpr bool PERM = true, AFTER_DRAIN = false, LDS_BIAS = false;
    bf16_t* O; int ldc;
    __device__ __forceinline__ void operator()(const f32x4 (&acc)[2][2][4][2], const Unit& u, int wr, int wc, int fr, int fq) const {
        const int row0 = u.po * BM + wr * 64 + fr, col0 = (u.pn < 24 ? u.pn : u.pn + 8) * BM + wc * 32 + 8 * fq; constexpr float us = 1.0f / (F8_SA * F8_SW);
#pragma unroll
        for (int ai = 0; ai < 2; ++ai)
#pragma unroll
            for (int m = 0; m < 4; ++m) { bf16_t* rowp = O + (size_t)(row0 + ai * HALF + m * 16) * ldc + col0;
#pragma unroll
                for (int bj = 0; bj < 2; ++bj) { const f32x4 v0 = acc[ai][bj][m][0] * us, v1 = acc[ai][bj][m][1] * us;
                    u32x4 w; w.x = cvt_pk_bf16(v0[0], v0[1]); w.y = cvt_pk_bf16(v0[2], v0[3]); w.z = cvt_pk_bf16(v1[0], v1[1]); w.w = cvt_pk_bf16(v1[2], v1[3]);
                    __builtin_nontemporal_store(w, (u32x4*)(rowp + bj * HALF)); } }
    }
};
struct EpiF32 {
    static constexpr bool PERM = false, AFTER_DRAIN = false;
    float* C; int ldc;
    __device__ __forceinline__ void operator()(const f32x4 (&acc)[2][2][4][2], const Unit& u, int wr, int wc, int fr, int fq) const {
        const int row0 = u.po * BM + wr * 64 + fr, col0 = u.pn * BM + wc * 32 + 4 * fq;
#pragma unroll
        for (int ai = 0; ai < 2; ++ai)
#pragma unroll
            for (int m = 0; m < 4; ++m) { float* rowp = C + (size_t)(row0 + ai * HALF + m * 16) * ldc + col0;
#pragma unroll
                for (int bj = 0; bj < 2; ++bj)
#pragma unroll
                    for (int n = 0; n < 2; ++n) *(f32x4*)(rowp + bj * HALF + n * 16) = acc[ai][bj][m][n]; }
    }
};
struct EpiMerge {
    static constexpr bool PERM = true, AFTER_DRAIN = false;
    bf16_t* O; const bf16_t* Z; int ldz, ga_off, gb_off; const bf16_t* YB;
    __device__ __forceinline__ void operator()(const f32x4 (&acc)[2][2][4][2], const Unit& u, int wr, int wc, int fr, int fq) const {
        const int row0 = u.po * BM + wr * 64 + fr, col0 = u.pn * BM + wc * 32 + 8 * fq;
#pragma unroll
        for (int ai = 0; ai < 2; ++ai)
#pragma unroll
            for (int m = 0; m < 4; ++m) { const size_t row = (size_t)(row0 + ai * HALF + m * 16);
#pragma unroll
                for (int bj = 0; bj < 2; ++bj) { const int col = col0 + bj * HALF;
                    const u32x4 ga = *(const u32x4*)(Z + row * ldz + ga_off + col), gb = *(const u32x4*)(Z + row * ldz + gb_off + col);
                    const u32x4 yw = *(const u32x4*)(YB + row * 2048 + col); const f32x4 y0 = {bf_lo(yw.x), bf_hi(yw.x), bf_lo(yw.y), bf_hi(yw.y)}, y1 = {bf_lo(yw.z), bf_hi(yw.z), bf_lo(yw.w), bf_hi(yw.w)};
                    const f32x4 a0 = acc[ai][bj][m][0], a1 = acc[ai][bj][m][1];
                    float o[8];
                    o[0] = sigmoidf_(bf_lo(ga.x)) * a0[0] + sigmoidf_(bf_lo(gb.x)) * y0[0]; o[1] = sigmoidf_(bf_hi(ga.x)) * a0[1] + sigmoidf_(bf_hi(gb.x)) * y0[1];
                    o[2] = sigmoidf_(bf_lo(ga.y)) * a0[2] + sigmoidf_(bf_lo(gb.y)) * y0[2]; o[3] = sigmoidf_(bf_hi(ga.y)) * a0[3] + sigmoidf_(bf_hi(gb.y)) * y0[3];
                    o[4] = sigmoidf_(bf_lo(ga.z)) * a1[0] + sigmoidf_(bf_lo(gb.z)) * y1[0]; o[5] = sigmoidf_(bf_hi(ga.z)) * a1[1] + sigmoidf_(bf_hi(gb.z)) * y1[1];
                    o[6] = sigmoidf_(bf_lo(ga.w)) * a1[2] + sigmoidf_(bf_lo(gb.w)) * y1[2]; o[7] = sigmoidf_(bf_hi(ga.w)) * a1[3] + sigmoidf_(bf_hi(gb.w)) * y1[3];
                    u32x4 w; w.x = cvt_pk_bf16(o[0], o[1]); w.y = cvt_pk_bf16(o[2], o[3]); w.z = cvt_pk_bf16(o[4], o[5]); w.w = cvt_pk_bf16(o[6], o[7]);
                    *(u32x4*)(O + row * 2048 + col) = w; } }
    }
};
struct EpiX1 {
    static constexpr bool PERM = false, AFTER_DRAIN = false;
    float* X1; const float* X; const float* mod;
    __device__ __forceinline__ void operator()(const f32x4 (&acc)[2][2][4][2], const Unit& u, int wr, int wc, int fr, int fq) const {
        const int row0 = u.po * BM + wr * 64 + fr, col0 = u.pn * BM + wc * 32 + 4 * fq;
        const float* mg = mod + (size_t)((u.po * BM) >> 11) * 12288 + 2 * 2048;
#pragma unroll
        for (int bj = 0; bj < 2; ++bj)
#pragma unroll
            for (int n = 0; n < 2; ++n) { const int col = col0 + bj * HALF + n * 16; const f32x4 g = *(const f32x4*)(mg + col);
#pragma unroll
                for (int ai = 0; ai < 2; ++ai)
#pragma unroll
                    for (int m = 0; m < 4; ++m) { const size_t off = (size_t)(row0 + ai * HALF + m * 16) * 2048 + col;
                        *(f32x4*)(X1 + off) = *(const f32x4*)(X + off) + g * acc[ai][bj][m][n]; } }
    }
};
struct EpiSwiglu {
    static constexpr bool PERM = true, AFTER_DRAIN = false;
    bf16_t* O; const float* b1;
    __device__ __forceinline__ void operator()(const f32x4 (&acc)[2][2][4][2], const Unit& u, int wr, int wc, int fr, int fq) const {
        const int e = u.pn >> 4, nt = u.pn & 15; const int row0 = u.po * BM + wr * 64 + fr, j0 = nt * 128 + wc * 32 + 8 * fq;
        const float* bg = b1 + (size_t)e * 4096 + j0; const float* bl = bg + 2048;
#pragma unroll
        for (int ai = 0; ai < 2; ++ai)
#pragma unroll
            for (int m = 0; m < 4; ++m) { const size_t row = (size_t)(row0 + ai * HALF + m * 16);
                asm volatile("" ::: "memory");
#pragma unroll
                for (int n = 0; n < 2; ++n) { const f32x4 gv = acc[ai][0][m][n] + *(const f32x4*)(bg + 4 * n), lv = acc[ai][1][m][n] + *(const f32x4*)(bl + 4 * n);
                    float o[4];
#pragma unroll
                    for (int i = 0; i < 4; ++i) { const float ga = fminf(gv[i], 7.0f), la = fminf(fmaxf(lv[i], -7.0f), 7.0f); o[i] = ga * sigmoidf_(1.702f * ga) * (la + 1.0f); }
                    typedef unsigned u32x2 __attribute__((ext_vector_type(2))); u32x2 w; w.x = cvt_pk_bf16(o[0], o[1]); w.y = cvt_pk_bf16(o[2], o[3]);
                    *(u32x2*)(O + row * 2048 + j0 + 4 * n) = w; } }
    }
};

template <class Epi, class Sched, bool ALIGN_EPI = false, bool SP2 = false, bool HALFSKIP = false>
__device__ __forceinline__ void gemm_phase(PG8_LAS unsigned char* lds, const Gemm g, const Sched& S, const Epi& E) {
    const int tid = threadIdx.x, wid = __builtin_amdgcn_readfirstlane(tid >> 6), lane = tid & 63, wr = wid >> 2, wc = wid & 3, fr = lane & 15, fq = lane >> 4;
    const int K = g.K, nt = K / BK;
    unsigned voffA[2], voffB[2];
#pragma unroll
    for (int i = 0; i < 2; ++i) { int R, C; stage_rc(tid * 16 + i * 8192, R, C); const int Rb = Epi::PERM ? ((R & ~31) + perm32(R & 31)) : R;
        voffA[i] = (unsigned)(R * K + C) * 2u; voffB[i] = (unsigned)(Rb * K + C) * 2u; }
    const size_t kstep = (size_t)(BK * 2);
    const size_t hstep = (size_t)HALF * K * 2;
    const size_t tstep = 2 * hstep;
    const unsigned ldsw = (unsigned)wid * 1024u;
    const int aoff = lds_byte(wr * 64 + fr, fq * 8), boff = lds_byte(wc * 32 + fr, fq * 8);
#define PG8_SA(b, h) (((b) * 2 + (h)) * HTB)
#define PG8_SB(b, h) ((4 + (b) * 2 + (h)) * HTB)
#define PG8_STAGE(bufoff, gbase, voff) do { _Pragma("unroll") for (int _i = 0; _i < 2; ++_i) \
        __builtin_amdgcn_global_load_lds((const unsigned*)((const char*)(gbase) + (voff)[_i]), (PG8_LAS unsigned*)(lds + (bufoff) + ldsw + _i * 8192), 16, 0, 0); } while (0)
#define PG8_LDA(dst, b, h) do { _Pragma("unroll") for (int m = 0; m < 4; ++m) _Pragma("unroll") for (int k = 0; k < 2; ++k) dst[m][k] = *(const PG8_LAS bf16x8*)(lds + PG8_SA(b, h) + aoff + m * 2048 + k * 1024); } while (0)
#define PG8_LDB(dst, b, h) do { _Pragma("unroll") for (int n = 0; n < 2; ++n) _Pragma("unroll") for (int k = 0; k < 2; ++k) dst[n][k] = *(const PG8_LAS bf16x8*)(lds + PG8_SB(b, h) + boff + n * 2048 + k * 1024); } while (0)
#define PG8_MMA(ai, bj, At, Bt) do { __builtin_amdgcn_s_setprio(1); _Pragma("unroll") for (int m = 0; m < 4; ++m) _Pragma("unroll") for (int n = 0; n < 2; ++n) _Pragma("unroll") for (int k = 0; k < 2; ++k) \
        acc[ai][bj][m][n] = __builtin_amdgcn_mfma_f32_16x16x32_bf16(Bt[n][k], At[m][k], acc[ai][bj][m][n], 0, 0, 0); __builtin_amdgcn_s_setprio(0); } while (0)
#define PG8_WAIT_V(n) asm volatile("s_waitcnt vmcnt(" #n ")" ::: "memory")
#define PG8_WAIT_L(n) asm volatile("s_waitcnt lgkmcnt(" #n ")" ::: "memory")
#define PG8_BAR __builtin_amdgcn_s_barrier()
#define PG8_SCHED __builtin_amdgcn_sched_barrier(0)
    Unit cur, nxt; int ui = 0;
    if (!S.next(0, cur)) return;
    f32x4 acc[2][2][4][2];
#pragma unroll
    for (int a = 0; a < 2; ++a)
#pragma unroll
        for (int b = 0; b < 2; ++b)
#pragma unroll
            for (int m = 0; m < 4; ++m)
#pragma unroll
                for (int n = 0; n < 2; ++n) acc[a][b][m][n] = (f32x4){0.f, 0.f, 0.f, 0.f};
    bf16x8 At[4][2], B0[2][2], B1[2][2];
    const char* cA = (const char*)g.A + (size_t)cur.pm * tstep; const char* cB = (const char*)g.Bt + (size_t)cur.pn * tstep;
    S.a_ready(cur);
    if constexpr (SP2) {
        PG8_STAGE(PG8_SB(0, 0), cB, voffB); PG8_STAGE(PG8_SB(0, 1), cB + hstep, voffB); PG8_STAGE(PG8_SA(0, 0), cA, voffA); PG8_STAGE(PG8_SA(0, 1), cA + hstep, voffA);
        if (wr == 1) PG8_BAR;
        PG8_WAIT_V(2); PG8_BAR;
        PG8_STAGE(PG8_SB(1, 0), cB + kstep, voffB); PG8_STAGE(PG8_SA(1, 0), cA + kstep, voffA); PG8_STAGE(PG8_SB(1, 1), cB + hstep + kstep, voffB);
        PG8_WAIT_V(6); PG8_BAR;
    } else {
        PG8_STAGE(PG8_SB(0, 0), cB, voffB); PG8_STAGE(PG8_SA(0, 0), cA, voffA); PG8_STAGE(PG8_SB(0, 1), cB + hstep, voffB); PG8_STAGE(PG8_SA(0, 1), cA + hstep, voffA);
        if (wr == 1) PG8_BAR;
        PG8_WAIT_V(4); PG8_BAR;
        PG8_STAGE(PG8_SB(1, 0), cB + kstep, voffB); PG8_STAGE(PG8_SA(1, 0), cA + kstep, voffA); PG8_STAGE(PG8_SB(1, 1), cB + hstep + kstep, voffB);
        PG8_WAIT_V(6); PG8_BAR;
    }
    for (;;) {
        const bool has_next = S.next(ui + 1, nxt);
        const char* nA = has_next ? (const char*)g.A + (size_t)nxt.pm * tstep : cA; const char* nB = has_next ? (const char*)g.Bt + (size_t)nxt.pn * tstep : cB;
        for (int t = 0; t < nt; t += 2) {
            const bool last = (t == nt - 2);
            const char* a1 = cA + (size_t)(t + 1) * kstep;
            const char* a2 = last ? nA : cA + (size_t)(t + 2) * kstep; const char* b2 = last ? nB : cB + (size_t)(t + 2) * kstep;
            const char* a3 = a2 + kstep; const char* b3 = b2 + kstep;
            if (last && has_next) S.a_ready(nxt);
            if constexpr (SP2) {
            PG8_LDB(B0, 0, 0); PG8_LDB(B1, 0, 1); PG8_SCHED; PG8_LDA(At, 0, 0); PG8_STAGE(PG8_SA(1, 1), a1 + hstep, voffA);
            PG8_WAIT_V(8); PG8_WAIT_L(0); PG8_BAR; PG8_MMA(0, 0, At, B0); PG8_MMA(0, 1, At, B1); PG8_BAR; PG8_SCHED;
            PG8_LDA(At, 0, 1); PG8_STAGE(PG8_SB(0, 0), b2, voffB); PG8_STAGE(PG8_SB(0, 1), b2 + hstep, voffB); PG8_STAGE(PG8_SA(0, 0), a2, voffA);
            PG8_WAIT_V(8); PG8_WAIT_L(0); PG8_BAR; if (!(HALFSKIP && cur.hf)) { PG8_MMA(1, 0, At, B0); PG8_MMA(1, 1, At, B1); } PG8_BAR; PG8_SCHED;
            PG8_LDB(B0, 1, 0); PG8_LDB(B1, 1, 1); PG8_SCHED; PG8_LDA(At, 1, 0); PG8_STAGE(PG8_SA(0, 1), a2 + hstep, voffA);
            PG8_WAIT_V(8); PG8_WAIT_L(0); PG8_BAR; PG8_MMA(0, 0, At, B0); PG8_MMA(0, 1, At, B1); PG8_BAR; PG8_SCHED;
            PG8_LDA(At, 1, 1); PG8_STAGE(PG8_SB(1, 0), b3, voffB); PG8_STAGE(PG8_SB(1, 1), b3 + hstep, voffB); PG8_STAGE(PG8_SA(1, 0), a3, voffA);
            PG8_WAIT_V(8); PG8_WAIT_L(0); PG8_BAR; if (!(HALFSKIP && cur.hf)) { PG8_MMA(1, 0, At, B0); PG8_MMA(1, 1, At, B1); } PG8_BAR; PG8_SCHED;
            } else {
            PG8_LDB(B0, 0, 0); PG8_SCHED; PG8_LDA(At, 0, 0); PG8_STAGE(PG8_SA(1, 1), a1 + hstep, voffA);
            PG8_WAIT_L(8); PG8_BAR; PG8_WAIT_L(0); PG8_MMA(0, 0, At, B0); PG8_BAR; PG8_SCHED;
            PG8_LDB(B1, 0, 1); PG8_STAGE(PG8_SB(0, 0), b2, voffB);
            PG8_BAR; PG8_WAIT_L(0); PG8_MMA(0, 1, At, B1); PG8_BAR;
            PG8_LDA(At, 0, 1); PG8_STAGE(PG8_SA(0, 0), a2, voffA);
            PG8_BAR; PG8_WAIT_L(0); PG8_MMA(1, 0, At, B0); PG8_BAR; PG8_SCHED;
            PG8_STAGE(PG8_SB(0, 1), b2 + hstep, voffB);
            PG8_WAIT_V(6); PG8_BAR; PG8_MMA(1, 1, At, B1); PG8_BAR;
            PG8_LDB(B0, 1, 0); PG8_SCHED; PG8_LDA(At, 1, 0); PG8_STAGE(PG8_SA(0, 1), a2 + hstep, voffA);
            PG8_WAIT_L(8); PG8_BAR; PG8_WAIT_L(0); PG8_MMA(0, 0, At, B0); PG8_BAR; PG8_SCHED;
            PG8_LDB(B1, 1, 1); PG8_STAGE(PG8_SB(1, 0), b3, voffB);
            PG8_BAR; PG8_WAIT_L(0); PG8_MMA(0, 1, At, B1); PG8_BAR;
            PG8_LDA(At, 1, 1); PG8_STAGE(PG8_SA(1, 0), a3, voffA);
            PG8_BAR; PG8_WAIT_L(0); PG8_MMA(1, 0, At, B0); PG8_BAR; PG8_SCHED;
            PG8_STAGE(PG8_SB(1, 1), b3 + hstep, voffB);
            PG8_WAIT_V(6); PG8_BAR; PG8_MMA(1, 1, At, B1); PG8_BAR;
            }
        }
        if constexpr (ALIGN_EPI) { if (wr == 0) PG8_BAR; }
        if constexpr (!Epi::AFTER_DRAIN) { E(acc, cur, wr, wc, fr, fq); S.done(cur); }
        if (!has_next) break;
#pragma unroll
        for (int a = 0; a < 2; ++a)
#pragma unroll
            for (int b = 0; b < 2; ++b)
#pragma unroll
                for (int m = 0; m < 4; ++m)
#pragma unroll
                    for (int n = 0; n < 2; ++n) acc[a][b][m][n] = (f32x4){0.f, 0.f, 0.f, 0.f};
        cur = nxt; cA = nA; cB = nB; ++ui;
        if constexpr (ALIGN_EPI) { if (wr == 1) PG8_BAR; }
    }
    PG8_WAIT_V(0);
    if constexpr (!ALIGN_EPI) { if (wr == 0) PG8_BAR; }
    PG8_BAR;
    if constexpr (Epi::AFTER_DRAIN) { E.fused(acc, cur, wr, wc, fr, fq, lds, wid, lane); S.done(cur); }
#undef PG8_SA
#undef PG8_SB
#undef PG8_STAGE
#undef PG8_LDA
#undef PG8_LDB
#undef PG8_MMA
#undef PG8_WAIT_V
#undef PG8_WAIT_L
#undef PG8_BAR
#undef PG8_SCHED
}
template <class Epi, class Sched, bool ALIGN_EPI = false, bool SP2 = false, bool HALFSKIP = false>
__device__ __forceinline__ void gemm_phase8(PG8_LAS unsigned char* lds, const Gemm g, const Sched& S, const Epi& E) {
    const int tid = threadIdx.x, wid = __builtin_amdgcn_readfirstlane(tid >> 6), lane = tid & 63, wr = wid >> 2, wc = wid & 3, fr = lane & 15, fq = lane >> 4;
    const int K = g.K, nt = K / 128;
    unsigned voffA[2], voffB[2];
#pragma unroll
    for (int i = 0; i < 2; ++i) { int R, C; stage_rc(tid * 16 + i * 8192, R, C); const int Rb = Epi::PERM ? ((R & ~31) + perm32(R & 31)) : R;
        voffA[i] = (unsigned)(R * K + 2 * C); voffB[i] = (unsigned)(Rb * K + 2 * C); }
    const size_t kstep = (size_t)(BK * 2);
    const size_t hstep = (size_t)HALF * K;
    const size_t tstep = 2 * hstep;
    const unsigned ldsw = (unsigned)wid * 1024u;
    const int aoff = lds_byte(wr * 64 + fr, fq * 8), boff = lds_byte(wc * 32 + fr, fq * 8);
#define PG8_SA(b, h) (((b) * 2 + (h)) * HTB)
#define PG8_SB(b, h) ((4 + (b) * 2 + (h)) * HTB)
#define PG8_STAGE(bufoff, gbase, voff) do { _Pragma("unroll") for (int _i = 0; _i < 2; ++_i) \
        __builtin_amdgcn_global_load_lds((const unsigned*)((const char*)(gbase) + (voff)[_i]), (PG8_LAS unsigned*)(lds + (bufoff) + ldsw + _i * 8192), 16, 0, 0); } while (0)
#define PG8_LDA(dst, b, h) do { _Pragma("unroll") for (int m = 0; m < 4; ++m) { const i32x4 lo_ = *(const PG8_LAS i32x4*)(lds + PG8_SA(b, h) + aoff + m * 2048), hi_ = *(const PG8_LAS i32x4*)(lds + PG8_SA(b, h) + aoff + m * 2048 + 1024); dst[m] = __builtin_shufflevector(lo_, hi_, 0, 1, 2, 3, 4, 5, 6, 7); } } while (0)
#define PG8_LDB(dst, b, h) do { _Pragma("unroll") for (int n = 0; n < 2; ++n) { const i32x4 lo_ = *(const PG8_LAS i32x4*)(lds + PG8_SB(b, h) + boff + n * 2048), hi_ = *(const PG8_LAS i32x4*)(lds + PG8_SB(b, h) + boff + n * 2048 + 1024); dst[n] = __builtin_shufflevector(lo_, hi_, 0, 1, 2, 3, 4, 5, 6, 7); } } while (0)
#define PG8_MMA(ai, bj, At, Bt) do { __builtin_amdgcn_s_setprio(1); _Pragma("unroll") for (int m = 0; m < 4; ++m) _Pragma("unroll") for (int n = 0; n < 2; ++n) \
        asm volatile("v_mfma_scale_f32_16x16x128_f8f6f4 %0, %1, %2, %0, %3, %3 op_sel_hi:[0,0,0]" : "+v"(acc[ai][bj][m][n]) : "v"(Bt[n]), "v"(At[m]), "v"(sc127)); __builtin_amdgcn_s_setprio(0); } while (0)
#define PG8_WAIT_V(n) asm volatile("s_waitcnt vmcnt(" #n ")" ::: "memory")
#define PG8_WAIT_L(n) asm volatile("s_waitcnt lgkmcnt(" #n ")" ::: "memory")
#define PG8_BAR __builtin_amdgcn_s_barrier()
#define PG8_SCHED __builtin_amdgcn_sched_barrier(0)
    Unit cur, nxt; int ui = 0;
    if (!S.next(0, cur)) return;
    f32x4 acc[2][2][4][2];
#pragma unroll
    for (int a = 0; a < 2; ++a)
#pragma unroll
        for (int b = 0; b < 2; ++b)
#pragma unroll
            for (int m = 0; m < 4; ++m)
#pragma unroll
                for (int n = 0; n < 2; ++n) acc[a][b][m][n] = (f32x4){0.f, 0.f, 0.f, 0.f};
    i32x8 At[4], B0[2], B1[2]; const int sc127 = 127;
    const char* cA = (const char*)g.A + (size_t)cur.pm * tstep; const char* cB = (const char*)g.Bt + (size_t)cur.pn * tstep;
    S.a_ready(cur);
    constexpr int BIAS_OFF = 8 * HTB;
    if constexpr (Epi::LDS_BIAS) { if (wid == 0) E.stage_bias(cur, lds + BIAS_OFF, lane); }
    if constexpr (SP2) {
        PG8_STAGE(PG8_SB(0, 0), cB, voffB); PG8_STAGE(PG8_SB(0, 1), cB + hstep, voffB); PG8_STAGE(PG8_SA(0, 0), cA, voffA); PG8_STAGE(PG8_SA(0, 1), cA + hstep, voffA);
        if (wr == 1) PG8_BAR;
        PG8_WAIT_V(2); PG8_BAR;
        PG8_STAGE(PG8_SB(1, 0), cB + kstep, voffB); PG8_STAGE(PG8_SA(1, 0), cA + kstep, voffA); PG8_STAGE(PG8_SB(1, 1), cB + hstep + kstep, voffB);
        PG8_WAIT_V(6); PG8_BAR;
    } else {
        PG8_STAGE(PG8_SB(0, 0), cB, voffB); PG8_STAGE(PG8_SA(0, 0), cA, voffA); PG8_STAGE(PG8_SB(0, 1), cB + hstep, voffB); PG8_STAGE(PG8_SA(0, 1), cA + hstep, voffA);
        if (wr == 1) PG8_BAR;
        PG8_WAIT_V(4); PG8_BAR;
        PG8_STAGE(PG8_SB(1, 0), cB + kstep, voffB); PG8_STAGE(PG8_SA(1, 0), cA + kstep, voffA); PG8_STAGE(PG8_SB(1, 1), cB + hstep + kstep, voffB);
        PG8_WAIT_V(6); PG8_BAR;
    }
    for (;;) {
        const bool has_next = S.next(ui + 1, nxt);
        const char* nA = has_next ? (const char*)g.A + (size_t)nxt.pm * tstep : cA; const char* nB = has_next ? (const char*)g.Bt + (size_t)nxt.pn * tstep : cB;
        for (int t = 0; t < nt; t += 2) {
            const bool last = (t == nt - 2);
            const char* a1 = cA + (size_t)(t + 1) * kstep;
            const char* a2 = last ? nA : cA + (size_t)(t + 2) * kstep; const char* b2 = last ? nB : cB + (size_t)(t + 2) * kstep;
            const char* a3 = a2 + kstep; const char* b3 = b2 + kstep;
            if (last && has_next) S.a_ready(nxt);
            if constexpr (SP2) {
            PG8_LDB(B0, 0, 0); PG8_LDB(B1, 0, 1); PG8_SCHED; PG8_LDA(At, 0, 0); PG8_STAGE(PG8_SA(1, 1), a1 + hstep, voffA);
            PG8_WAIT_V(8); PG8_WAIT_L(0); PG8_BAR; PG8_MMA(0, 0, At, B0); PG8_MMA(0, 1, At, B1); PG8_BAR; PG8_SCHED;
            if (!(HALFSKIP && cur.hf)) PG8_LDA(At, 0, 1); PG8_STAGE(PG8_SB(0, 0), b2, voffB); PG8_STAGE(PG8_SB(0, 1), b2 + hstep, voffB); PG8_STAGE(PG8_SA(0, 0), a2, voffA);
            PG8_WAIT_V(8); PG8_WAIT_L(0); PG8_BAR; if (!(HALFSKIP && cur.hf)) { PG8_MMA(1, 0, At, B0); PG8_MMA(1, 1, At, B1); } PG8_BAR; PG8_SCHED;
            PG8_LDB(B0, 1, 0); PG8_LDB(B1, 1, 1); PG8_SCHED; PG8_LDA(At, 1, 0); PG8_STAGE(PG8_SA(0, 1), a2 + hstep, voffA);
            PG8_WAIT_V(8); PG8_WAIT_L(0); PG8_BAR; PG8_MMA(0, 0, At, B0); PG8_MMA(0, 1, At, B1); PG8_BAR; PG8_SCHED;
            if (!(HALFSKIP && cur.hf)) PG8_LDA(At, 1, 1); PG8_STAGE(PG8_SB(1, 0), b3, voffB); PG8_STAGE(PG8_SB(1, 1), b3 + hstep, voffB); PG8_STAGE(PG8_SA(1, 0), a3, voffA);
            PG8_WAIT_V(8); PG8_WAIT_L(0); PG8_BAR; if (!(HALFSKIP && cur.hf)) { PG8_MMA(1, 0, At, B0); PG8_MMA(1, 1, At, B1); } PG8_BAR; PG8_SCHED;
            } else {
            PG8_LDB(B0, 0, 0); PG8_SCHED; PG8_LDA(At, 0, 0); PG8_STAGE(PG8_SA(1, 1), a1 + hstep, voffA);
            PG8_WAIT_L(8); PG8_BAR; PG8_WAIT_L(0); PG8_MMA(0, 0, At, B0); PG8_BAR; PG8_SCHED;
            PG8_LDB(B1, 0, 1); PG8_STAGE(PG8_SB(0, 0), b2, voffB);
            PG8_BAR; PG8_WAIT_L(0); PG8_MMA(0, 1, At, B1); PG8_BAR;
            PG8_LDA(At, 0, 1); PG8_STAGE(PG8_SA(0, 0), a2, voffA);
            PG8_BAR; PG8_WAIT_L(0); PG8_MMA(1, 0, At, B0); PG8_BAR; PG8_SCHED;
            PG8_STAGE(PG8_SB(0, 1), b2 + hstep, voffB);
            PG8_WAIT_V(6); PG8_BAR; PG8_MMA(1, 1, At, B1); PG8_BAR;
            PG8_LDB(B0, 1, 0); PG8_SCHED; PG8_LDA(At, 1, 0); PG8_STAGE(PG8_SA(0, 1), a2 + hstep, voffA);
            PG8_WAIT_L(8); PG8_BAR; PG8_WAIT_L(0); PG8_MMA(0, 0, At, B0); PG8_BAR; PG8_SCHED;
            PG8_LDB(B1, 1, 1); PG8_STAGE(PG8_SB(1, 0), b3, voffB);
            PG8_BAR; PG8_WAIT_L(0); PG8_MMA(0, 1, At, B1); PG8_BAR;
            PG8_LDA(At, 1, 1); PG8_STAGE(PG8_SA(1, 0), a3, voffA);
            PG8_BAR; PG8_WAIT_L(0); PG8_MMA(1, 0, At, B0); PG8_BAR; PG8_SCHED;
            PG8_STAGE(PG8_SB(1, 1), b3 + hstep, voffB);
            PG8_WAIT_V(6); PG8_BAR; PG8_MMA(1, 1, At, B1); PG8_BAR;
            }
        }
        if constexpr (ALIGN_EPI) { if (wr == 0) PG8_BAR; }
        if constexpr (!Epi::AFTER_DRAIN) { if constexpr (Epi::LDS_BIAS) E(acc, cur, wr, wc, fr, fq, lds + BIAS_OFF + (ui & 1) * 1024); else E(acc, cur, wr, wc, fr, fq); S.done(cur); }
        if (!has_next) break;
#pragma unroll
        for (int a = 0; a < 2; ++a)
#pragma unroll
            for (int b = 0; b < 2; ++b)
#pragma unroll
                for (int m = 0; m < 4; ++m)
#pragma unroll
                    for (int n = 0; n < 2; ++n) acc[a][b][m][n] = (f32x4){0.f, 0.f, 0.f, 0.f};
        cur = nxt; cA = nA; cB = nB; ++ui;
        if constexpr (Epi::LDS_BIAS) { if (wid == 0) E.stage_bias(cur, lds + BIAS_OFF + (ui & 1) * 1024, lane); }
        if constexpr (ALIGN_EPI) { if (wr == 1) PG8_BAR; }
    }
    PG8_WAIT_V(0);
    if constexpr (!ALIGN_EPI) { if (wr == 0) PG8_BAR; }
    PG8_BAR;
    if constexpr (Epi::AFTER_DRAIN) { E.fused(acc, cur, wr, wc, fr, fq, lds, wid, lane); S.done(cur); }
#undef PG8_SA
#undef PG8_SB
#undef PG8_STAGE
#undef PG8_LDA
#undef PG8_LDB
#undef PG8_MMA
#undef PG8_WAIT_V
#undef PG8_WAIT_L
#undef PG8_BAR
#undef PG8_SCHED
}
}

constexpr int NWAVES = 8, NTHR = 512;
constexpr int N_LAUNCHES = MK_N_LAUNCHES;
constexpr int N_PHASES = 13;
constexpr int DM = 2048, NB = 4, TL = 2048, NLAT = NB * TL, TCX = 256, NCTX = NB * TCX, NTOK = NLAT + NCTX;
constexpr int NH = 8, QKD = 128, VD = 256, INC = 14368, ZW = 14336;
constexpr int ZQ = 0, ZK = 1024, ZV = 2048, ZO = 4096, ZU = 6144, ZS = 8192, ZGA = 10240, ZGB = 12288;
constexpr int NEXP = 32, DEXP = 2048, NCH = 18  , CROWS = 272  ;
constexpr float EPS = 1e-6f;

constexpr size_t MiB = 1u << 20;
constexpr size_t WS_CTL = 0, CTL_ZERO_BYTES = 1 * MiB;
constexpr size_t WS_MOD = 1 * MiB;
constexpr size_t WS_GATES = 2 * MiB;
constexpr size_t WS_SCAL = 4 * MiB;
constexpr size_t WS_ROUTE = 5 * MiB;
constexpr size_t WS_SCN = 2996 * MiB;
constexpr size_t WS_SK = 6 * MiB;
constexpr size_t WS_WINT = 8 * MiB;
constexpr size_t WS_PAT = 64 * MiB, WS_PBT = 72 * MiB, WS_WOT = 80 * MiB;
constexpr size_t WS_W1T = 88 * MiB;
constexpr size_t WS_W2T = 600 * MiB;
constexpr size_t WS_HB = 856 * MiB;
constexpr size_t WS_Z = 892 * MiB;
constexpr size_t WS_QC = 1144 * MiB, WS_KC = 1162 * MiB;
constexpr size_t WS_SVN = 1180 * MiB;
constexpr size_t WS_DC = 1212 * MiB;
constexpr size_t WS_CS = 1360 * MiB;
constexpr size_t WS_RO = 1428 * MiB;
constexpr size_t WS_CM = 1460 * MiB;
constexpr size_t WS_YB = 1492 * MiB;
constexpr size_t WS_MRG = 1556 * MiB;
constexpr size_t WS_X1 = 1588 * MiB;
constexpr size_t WS_ACT = 1652 * MiB;
constexpr size_t WS_Y2 = 1812 * MiB;
constexpr size_t WS_XG = 1972 * MiB;
constexpr size_t WS_HB8 = 2998 * MiB;
constexpr size_t WS_WG8 = 3016 * MiB;
constexpr size_t WS_END = 3040 * MiB;
static_assert(WS_DC + (size_t)64 * 17 * CROWS * 128 * 2 <= WS_CS && WS_CS + (size_t)64 * 16 * CROWS * 128 * 2 <= WS_RO && WS_Z + (size_t)NTOK * ZW * 2 <= WS_QC, "ws map");
constexpr int CW_Q3 = 3584, CW_Q4 = 8192;
constexpr int CW_Q2 = 3072;
constexpr int CW_Q = 2048;
constexpr int CW_CNT = 64;
constexpr int CW_BAR = 4096;
constexpr int RING_BYTES = 131072;
constexpr int LDS_BYTES = 147456;
constexpr int LDSCTL_OFF = LDS_BYTES - 2048, MISC_OFF = LDSCTL_OFF + 320, PREF_OFF = LDSCTL_OFF + 1024;

#define GAS __attribute__((address_space(1)))
#define LAS __attribute__((address_space(3)))
typedef unsigned short bf16;
typedef unsigned v4u __attribute__((ext_vector_type(4)));
typedef unsigned v2u __attribute__((ext_vector_type(2)));
typedef float f32x4 __attribute__((ext_vector_type(4)));
typedef short bf16x8 __attribute__((ext_vector_type(8)));
typedef short s16x4 __attribute__((ext_vector_type(4)));
typedef GAS unsigned gu32;
#define RLX_AGENT __ATOMIC_RELAXED, __HIP_MEMORY_SCOPE_AGENT
#define LDS_WAIT() asm volatile("s_waitcnt lgkmcnt(0)" ::: "memory")
#define VM_WAIT() asm volatile("s_waitcnt vmcnt(0)" ::: "memory")
using pg8::cvt_pk_bf16; using pg8::bf_lo; using pg8::bf_hi; using pg8::sigmoidf_;


__device__ __forceinline__ float wave_sum(float v) {
#pragma unroll
    for (int o = 1; o < 64; o <<= 1) v += __shfl_xor(v, o);
    return v;
}
__device__ __forceinline__ float siluf_(float x) { return x * __builtin_amdgcn_rcpf(1.0f + __expf(-x)); }
__device__ __forceinline__ float gelu_tanh(float x) { const float u = 0.7978845608028654f * (x + 0.044715f * x * x * x); return x * __builtin_amdgcn_rcpf(1.0f + __expf(-2.0f * u)); }
__device__ __forceinline__ float logsigf_(float f) { return fminf(f, 0.f) - log1pf(expf(-fabsf(f))); }
__device__ __forceinline__ unsigned img_off(unsigned row, unsigned ch) { return 256u * row + 16u * (ch ^ (((row & 3u) << 2) | ((row >> 2) & 3u))); }
__device__ __forceinline__ s16x4 tr_read(LAS unsigned char* p) { return __builtin_amdgcn_ds_read_tr16_b64_v4i16((LAS s16x4*)p); }
__device__ __forceinline__ bf16x8 tr_frag(LAS unsigned char* img, unsigned r0, unsigned r1, unsigned c, int lane) {
    const unsigned q = (lane & 15) >> 2, p = lane & 3;
    const s16x4 lo = tr_read(img + img_off(r0 + q, 2 * c + (p >> 1)) + 8 * (p & 1));
    const s16x4 hi = tr_read(img + img_off(r1 + q, 2 * c + (p >> 1)) + 8 * (p & 1));
    bf16x8 r; r[0] = lo[0]; r[1] = lo[1]; r[2] = lo[2]; r[3] = lo[3]; r[4] = hi[0]; r[5] = hi[1]; r[6] = hi[2]; r[7] = hi[3]; return r;
}
__device__ __forceinline__ bf16x8 tr_frag2(LAS unsigned char* base, unsigned x0, unsigned x1) {
    const s16x4 lo = tr_read(base + x0), hi = tr_read(base + x1);
    bf16x8 r; r[0] = lo[0]; r[1] = lo[1]; r[2] = lo[2]; r[3] = lo[3]; r[4] = hi[0]; r[5] = hi[1]; r[6] = hi[2]; r[7] = hi[3]; return r;
}
#define TR_NAT_OFFS(xn0, xn1, lane) unsigned xn0[8], xn1[8]; { const unsigned g_ = (lane) >> 4, q_ = ((lane) & 15) >> 2, p_ = (lane) & 3; \
    _Pragma("unroll") for (int c_ = 0; c_ < 8; ++c_) { xn0[c_] = 256u * (8 * g_ + q_) + 16u * ((2 * c_ + (p_ >> 1)) ^ ((q_ << 2) | ((2 * g_) & 3))) + 8u * (p_ & 1); \
                                                       xn1[c_] = 256u * (8 * g_ + 4 + q_) + 16u * ((2 * c_ + (p_ >> 1)) ^ ((q_ << 2) | ((2 * g_ + 1) & 3))) + 8u * (p_ & 1); } }
#define TR_PERM_OFFS(xp, lane) unsigned xp[8]; { const unsigned g_ = (lane) >> 4, q_ = ((lane) & 15) >> 2, p_ = (lane) & 3; \
    _Pragma("unroll") for (int c_ = 0; c_ < 8; ++c_) xp[c_] = 256u * (4 * g_ + q_) + 16u * ((2 * c_ + (p_ >> 1)) ^ ((q_ << 2) | g_)) + 8u * (p_ & 1); }
__device__ __forceinline__ void load_tile128(LAS unsigned char* img, const bf16* src, size_t ld, int tid) {
#pragma unroll
    for (int i = 0; i < 4; ++i) { const int id = tid + NTHR * i, row = id >> 4, ch = id & 15;
        const v4u v = *(const v4u*)(src + (size_t)row * ld + 8 * ch); *(LAS v4u*)(img + img_off(row, ch)) = v; }
}
__device__ __forceinline__ void load_tile128_scaled(LAS unsigned char* img, const bf16* src, size_t ld, const LAS float* w, int tid) {
#pragma unroll
    for (int i = 0; i < 4; ++i) { const int id = tid + NTHR * i, row = id >> 4, ch = id & 15; const float s = w[row];
        const v4u v = *(const v4u*)(src + (size_t)row * ld + 8 * ch); v4u o;
        o.x = cvt_pk_bf16(bf_lo(v.x) * s, bf_hi(v.x) * s); o.y = cvt_pk_bf16(bf_lo(v.y) * s, bf_hi(v.y) * s); o.z = cvt_pk_bf16(bf_lo(v.z) * s, bf_hi(v.z) * s); o.w = cvt_pk_bf16(bf_lo(v.w) * s, bf_hi(v.w) * s);
        *(LAS v4u*)(img + img_off(row, ch)) = o; }
}
__device__ __forceinline__ void gate_scan(const float* G, size_t row0, int col_i, int col_f, int dir, int lane, float* bc, float* gg, float* pmx, float& b_end, float& gmax) {
    const int j0 = dir ? 127 - 2 * lane : 2 * lane, j1 = dir ? 126 - 2 * lane : 2 * lane + 1;
    const float f0 = G[(row0 + j0) * 32 + col_f], f1 = G[(row0 + j1) * 32 + col_f], i0 = G[(row0 + j0) * 32 + col_i], i1 = G[(row0 + j1) * 32 + col_i];
    const float lf0 = logsigf_(f0), lf1 = logsigf_(f1), s = lf0 + lf1; float incl = s;
#pragma unroll
    for (int o = 1; o < 64; o <<= 1) { const float t = __shfl_up(incl, o); if (lane >= o) incl += t; }
    const float b0 = (incl - s) + lf0, b1 = incl, g0 = i0 - b0, g1 = i1 - b1;
    float mincl = fmaxf(g0, g1);
#pragma unroll
    for (int o = 1; o < 64; o <<= 1) { const float t = __shfl_up(mincl, o); if (lane >= o) mincl = fmaxf(mincl, t); }
    float mexcl = __shfl_up(mincl, 1); if (lane == 0) mexcl = -3.0e38f;
    bc[j0] = b0; bc[j1] = b1; gg[j0] = g0; gg[j1] = g1; pmx[j0] = fmaxf(mexcl, g0); pmx[j1] = mincl;
    b_end = __shfl(incl, 63); gmax = __shfl(mincl, 63);
}
#define MFMA16(a, b, c) __builtin_amdgcn_mfma_f32_16x16x32_bf16((a), (b), (c), 0, 0, 0)

struct CvtItem { const float* src; size_t ldw; bf16* dst; };
constexpr int N_CONVERTERS = 128;
constexpr int N_CONV_DEFER = 1440;
constexpr int I_GEMV = 192, I_WIN = 16 * 8, I_GATE8 = 16 * 48, I_P = 16 * 8, I_W1 = 32 * 16 * 16, I_W2 = 32 * 16 * 8, I_TOTAL = I_GEMV + I_WIN + 3 * I_P + I_W1 + I_W2;
__device__ __forceinline__ CvtItem cvt_decode(int r, int tid, const float* w_in, const float* proj_a, const float* proj_b, const float* w_out, const float* exp_w1, const float* exp_w2,
                                              bf16* WINT, bf16* PAT, bf16* PBT, bf16* WOT, bf16* W1T, bf16* W2T) {
    const int n4 = tid & 63, kg = tid >> 6; const float* W; size_t ldw, ca, cb, drow; int kt; bf16* WT;
    if (r < I_WIN) { kt = r / 8; const int nt = 24 + r % 8; W = w_in; ldw = INC; ca = (size_t)256 * nt + 32; cb = ca + 128; WT = WINT; drow = (size_t)256 * nt; }
    else if ((r -= I_WIN) < 3 * I_P) { const int m = r / I_P, q = r % I_P; kt = q / 8; const int nt = q % 8; W = m == 0 ? proj_a : (m == 1 ? proj_b : w_out); ldw = 2048; ca = (size_t)256 * nt; cb = ca + 128; WT = m == 0 ? PAT : (m == 1 ? PBT : WOT); drow = (size_t)256 * nt; }
    else if ((r -= 3 * I_P) < I_W1) { const int e = r / 256, q = r % 256; kt = q / 16; const int nt = q % 16; W = exp_w1 + (size_t)e * 2048 * 4096; ldw = 4096; ca = (size_t)128 * nt; cb = 2048 + ca; WT = W1T; drow = (size_t)e * 4096 + 256 * nt; }
    else { r -= I_W1; const int e = r / 128, q = r % 128; kt = q / 8; const int nt = q % 8; W = exp_w2 + (size_t)e * 2048 * 2048; ldw = 2048; ca = (size_t)256 * nt; cb = ca + 128; WT = W2T; drow = (size_t)e * 2048 + 256 * nt; }
    CvtItem it; it.ldw = ldw; it.src = W + (size_t)(128 * kt + 8 * kg) * ldw + (n4 < 32 ? ca + 4 * n4 : cb + 4 * (n4 - 32)); it.dst = WT + drow * 2048 + 128 * kt; return it;
}
__device__ __forceinline__ void cvt_run(LAS unsigned char* lds, int tid, int it, int stride, int end, const float* w_in, const float* proj_a, const float* proj_b, const float* w_out, const float* exp_w1, const float* exp_w2,
                                        bf16* WINT, bf16* PAT, bf16* PBT, bf16* WOT, bf16* W1T, bf16* W2T) {
    const int n4 = tid & 63, kg = tid >> 6;
    f32x4 v[16]; CvtItem cur;
    bool have = it < end;
    if (have) { cur = cvt_decode(it - I_GEMV, tid, w_in, proj_a, proj_b, w_out, exp_w1, exp_w2, WINT, PAT, PBT, WOT, W1T, W2T);
#pragma unroll
        for (int i = 0; i < 16; ++i) v[i] = __builtin_nontemporal_load((const f32x4*)(cur.src + (size_t)((i >> 3) * 64 + (i & 7)) * cur.ldw)); }
    while (have) {
#pragma unroll
        for (int hf = 0; hf < 2; ++hf)
#pragma unroll
            for (int j = 0; j < 4; ++j) { v4u o; o.x = cvt_pk_bf16(v[8 * hf + 0][j], v[8 * hf + 1][j]); o.y = cvt_pk_bf16(v[8 * hf + 2][j], v[8 * hf + 3][j]); o.z = cvt_pk_bf16(v[8 * hf + 4][j], v[8 * hf + 5][j]); o.w = cvt_pk_bf16(v[8 * hf + 6][j], v[8 * hf + 7][j]);
                *(LAS v4u*)(lds + img_off(4 * n4 + j, 8 * hf + kg)) = o; }
        __syncthreads();
        bf16* dst = cur.dst;
        it += stride; have = it < end;
        if (have) { cur = cvt_decode(it - I_GEMV, tid, w_in, proj_a, proj_b, w_out, exp_w1, exp_w2, WINT, PAT, PBT, WOT, W1T, W2T);
#pragma unroll
            for (int i = 0; i < 16; ++i) v[i] = __builtin_nontemporal_load((const f32x4*)(cur.src + (size_t)((i >> 3) * 64 + (i & 7)) * cur.ldw)); }
#pragma unroll
        for (int i = 0; i < 8; ++i) { const int id = tid + NTHR * i, row = id >> 4, ch = id & 15; const v4u o = *(const LAS v4u*)(lds + img_off(row, ch)); __builtin_nontemporal_store(o, (v4u*)(dst + (size_t)row * 2048 + 8 * ch)); }
        __syncthreads();
    }
}
__device__ __forceinline__ void cvt_run8(LAS unsigned char* lds, int tid, int r, int stride, int end, const float* exp_w1, const float* exp_w2, const float* w_in, unsigned char* W1T8, unsigned char* W2T8, unsigned char* WG8) {
    const int n4 = tid & 63, kg = tid >> 6;
    f32x4 v[16]; const float* src = nullptr; size_t ldw = 0; unsigned char* dst = nullptr;
#define CVT8_DECODE(R) do { int q_ = (R); const float* W_; size_t ca_, cb_, drow_; int kt_; unsigned char* WT_; \
        if (q_ < I_W1) { const int e = q_ / 256, qq = q_ % 256; kt_ = qq / 16; const int nt = qq % 16; W_ = exp_w1 + (size_t)e * 2048 * 4096; ldw = 4096; ca_ = (size_t)128 * nt; cb_ = 2048 + ca_; WT_ = W1T8; drow_ = (size_t)e * 4096 + 256 * nt; } \
        else if (q_ < I_W1 + I_W2) { q_ -= I_W1; const int e = q_ / 128, qq = q_ % 128; kt_ = qq / 8; const int nt = qq % 8; W_ = exp_w2 + (size_t)e * 2048 * 2048; ldw = 2048; ca_ = (size_t)256 * nt; cb_ = ca_ + 128; WT_ = W2T8; drow_ = (size_t)e * 2048 + 256 * nt; } \
        else { q_ -= I_W1 + I_W2; kt_ = q_ / 48; const int ft = q_ % 48, zt = ft < 24 ? ft : ft + 8; W_ = w_in; ldw = INC; ca_ = (size_t)256 * zt + (zt >= 16 ? 32 : 0); cb_ = ca_ + 128; WT_ = WG8; drow_ = (size_t)256 * ft; } \
        src = W_ + (size_t)(128 * kt_ + 8 * kg) * ldw + (n4 < 32 ? ca_ + 4 * n4 : cb_ + 4 * (n4 - 32)); dst = WT_ + drow_ * 2048 + 128 * kt_; \
        _Pragma("unroll") for (int i = 0; i < 16; ++i) v[i] = __builtin_nontemporal_load((const f32x4*)(src + (size_t)((i >> 3) * 64 + (i & 7)) * ldw)); } while (0)
    bool have = r < end;
    if (have) CVT8_DECODE(r);
    while (have) {
#pragma unroll
        for (int hf = 0; hf < 2; ++hf)
#pragma unroll
            for (int j = 0; j < 4; ++j) { const int row = 4 * n4 + j, p8 = 8 * hf + kg; v2u o;
                o.x = pg8::pk4_fp8(v[8 * hf + 0][j] * pg8::F8_SW, v[8 * hf + 1][j] * pg8::F8_SW, v[8 * hf + 2][j] * pg8::F8_SW, v[8 * hf + 3][j] * pg8::F8_SW);
                o.y = pg8::pk4_fp8(v[8 * hf + 4][j] * pg8::F8_SW, v[8 * hf + 5][j] * pg8::F8_SW, v[8 * hf + 6][j] * pg8::F8_SW, v[8 * hf + 7][j] * pg8::F8_SW);
                *(LAS v2u*)(lds + row * 128 + 16 * ((p8 >> 1) ^ ((row >> 2) & 7)) + 8 * (p8 & 1)) = o; }
        __syncthreads();
        unsigned char* d0 = dst;
        r += stride; have = r < end;
        if (have) CVT8_DECODE(r);
#pragma unroll
        for (int i = 0; i < 4; ++i) { const int id = tid + NTHR * i, row = id >> 3, ch = id & 7; const v4u o = *(const LAS v4u*)(lds + row * 128 + 16 * (ch ^ ((row >> 2) & 7)));
            __builtin_nontemporal_store(o, (v4u*)(d0 + (size_t)row * 2048 + 16 * ch)); }
        __syncthreads();
    }
#undef CVT8_DECODE
}
__device__ __forceinline__ void p0_phase(LAS unsigned char* lds, int tid, int G, const float* c, const float* c_ctx, const float* mod_w, const float* mod_b, float* MOD,
                                         const float* w_in, const float* proj_a, const float* proj_b, const float* w_out, const float* exp_w1, const float* exp_w2, const float* router_w,
                                         bf16* WINT, bf16* PAT, bf16* PBT, bf16* WOT, bf16* W1T, bf16* W2T, bf16* SK, int n_conv_p0) {
    LAS float* sc = (LAS float*)lds;
    LAS float* red = (LAS float*)(lds + 40960);
    int it = blockIdx.x;
    if (it < I_GEMV) {
        for (int i = tid; i < 5 * 2048; i += NTHR) { const float x = i < 4 * 2048 ? c[i] : c_ctx[i - 4 * 2048]; sc[i] = siluf_(x); }
        __syncthreads();
        for (; it < I_GEMV; it += G) {
            const int j0 = 64 * it, c4 = tid & 15, kg = tid >> 4;
            f32x4 a0 = {0.f, 0.f, 0.f, 0.f}, a1 = a0, a2 = a0, a3 = a0, a4 = a0;
            const float* wp = mod_w + (size_t)kg * 12288 + j0 + 4 * c4;
#pragma unroll 8
            for (int k = kg; k < 2048; k += 32) { const f32x4 w = *(const f32x4*)wp; wp += (size_t)32 * 12288;
                a0 += w * sc[k]; a1 += w * sc[2048 + k]; a2 += w * sc[4096 + k]; a3 += w * sc[6144 + k]; a4 += w * sc[8192 + k]; }
            *(LAS f32x4*)(red + (kg * 5 + 0) * 64 + 4 * c4) = a0; *(LAS f32x4*)(red + (kg * 5 + 1) * 64 + 4 * c4) = a1; *(LAS f32x4*)(red + (kg * 5 + 2) * 64 + 4 * c4) = a2;
            *(LAS f32x4*)(red + (kg * 5 + 3) * 64 + 4 * c4) = a3; *(LAS f32x4*)(red + (kg * 5 + 4) * 64 + 4 * c4) = a4;
            __syncthreads();
            if (tid < 320) { const int rr = tid >> 6, j = tid & 63; float s = 0.f;
#pragma unroll 8
                for (int g = 0; g < 32; ++g) s += red[(g * 5 + rr) * 64 + j];
                MOD[rr * 12288 + j0 + j] = s + mod_b[j0 + j]; }
            __syncthreads();
        }
    } else {
        for (int i = (it - I_GEMV) * NTHR + tid; i < 2 * 32 * 2048; i += (G - I_GEMV) * NTHR) { const int m = i >> 16, n = (i >> 11) & 31, k = i & 2047;
            const float w = m == 0 ? w_in[(size_t)k * INC + 4096 + n] : router_w[k * 32 + n];
            const unsigned hi = cvt_pk_bf16(w, 0.f) & 0xffffu; const unsigned lo = cvt_pk_bf16(w - __uint_as_float(hi << 16), 0.f) & 0xffffu;
            SK[(size_t)(2 * m) * 65536 + n * 2048 + k] = (bf16)hi; SK[(size_t)(2 * m + 1) * 65536 + n * 2048 + k] = (bf16)lo; }
    }
    cvt_run(lds, tid, it, G, I_GEMV + n_conv_p0, w_in, proj_a, proj_b, w_out, exp_w1, exp_w2, WINT, PAT, PBT, WOT, W1T, W2T);
}

__device__ __forceinline__ void skinny_mfma(const LAS float* hrow, const bf16* WT_hi, const bf16* WT_lo, LAS float* part, int wave, int lane) {
    const int g = lane >> 4, l15 = lane & 15;
    f32x4 acc0 = {0.f, 0.f, 0.f, 0.f}, acc1 = acc0;
#pragma unroll
    for (int ks = 0; ks < 8; ++ks) { const int kb = 256 * wave + 32 * ks + 8 * g;
        f32x4 a0 = {0.f, 0.f, 0.f, 0.f}, a1 = a0;
        if (l15 < 8) { a0 = *(const LAS f32x4*)(hrow + l15 * 2048 + kb); a1 = *(const LAS f32x4*)(hrow + l15 * 2048 + kb + 4); }
        v4u hi, lo;
        hi.x = cvt_pk_bf16(a0[0], a0[1]); hi.y = cvt_pk_bf16(a0[2], a0[3]); hi.z = cvt_pk_bf16(a1[0], a1[1]); hi.w = cvt_pk_bf16(a1[2], a1[3]);
        lo.x = cvt_pk_bf16(a0[0] - bf_lo(hi.x), a0[1] - bf_hi(hi.x)); lo.y = cvt_pk_bf16(a0[2] - bf_lo(hi.y), a0[3] - bf_hi(hi.y));
        lo.z = cvt_pk_bf16(a1[0] - bf_lo(hi.z), a1[1] - bf_hi(hi.z)); lo.w = cvt_pk_bf16(a1[2] - bf_lo(hi.w), a1[3] - bf_hi(hi.w));
        const bf16x8 Ah = __builtin_bit_cast(bf16x8, hi), Al = __builtin_bit_cast(bf16x8, lo);
        const bf16x8 b0h = *(const bf16x8*)(WT_hi + (size_t)l15 * 2048 + kb), b0l = *(const bf16x8*)(WT_lo + (size_t)l15 * 2048 + kb);
        const bf16x8 b1h = *(const bf16x8*)(WT_hi + (size_t)(16 + l15) * 2048 + kb), b1l = *(const bf16x8*)(WT_lo + (size_t)(16 + l15) * 2048 + kb);
        acc0 = MFMA16(Ah, b0h, acc0); acc0 = MFMA16(Ah, b0l, acc0); acc0 = MFMA16(Al, b0h, acc0);
        acc1 = MFMA16(Ah, b1h, acc1); acc1 = MFMA16(Ah, b1l, acc1); acc1 = MFMA16(Al, b1h, acc1); }
    if (g < 2) {
#pragma unroll
        for (int r = 0; r < 4; ++r) { part[wave * 256 + (4 * g + r) * 32 + l15] = acc0[r]; part[wave * 256 + (4 * g + r) * 32 + 16 + l15] = acc1[r]; } }
}

template <bool LOREG>
__device__ __forceinline__ void skinny_mfma_r(const LAS float* hrow, const bf16x8 (&Bh)[8][2], const bf16x8 (&Bl)[8][2], const bf16* WT_lo, LAS float* part, int wave, int lane) {
    const int g = lane >> 4, l15 = lane & 15;
    f32x4 acc0 = {0.f, 0.f, 0.f, 0.f}, acc1 = acc0;
#pragma unroll
    for (int ks = 0; ks < 8; ++ks) { const int kb = 256 * wave + 32 * ks + 8 * g;
        f32x4 a0 = {0.f, 0.f, 0.f, 0.f}, a1 = a0;
        if (l15 < 8) { a0 = *(const LAS f32x4*)(hrow + l15 * 2048 + kb); a1 = *(const LAS f32x4*)(hrow + l15 * 2048 + kb + 4); }
        v4u hi, lo;
        hi.x = cvt_pk_bf16(a0[0], a0[1]); hi.y = cvt_pk_bf16(a0[2], a0[3]); hi.z = cvt_pk_bf16(a1[0], a1[1]); hi.w = cvt_pk_bf16(a1[2], a1[3]);
        lo.x = cvt_pk_bf16(a0[0] - bf_lo(hi.x), a0[1] - bf_hi(hi.x)); lo.y = cvt_pk_bf16(a0[2] - bf_lo(hi.y), a0[3] - bf_hi(hi.y));
        lo.z = cvt_pk_bf16(a1[0] - bf_lo(hi.z), a1[1] - bf_hi(hi.z)); lo.w = cvt_pk_bf16(a1[2] - bf_lo(hi.w), a1[3] - bf_hi(hi.w));
        const bf16x8 Ah = __builtin_bit_cast(bf16x8, hi), Al = __builtin_bit_cast(bf16x8, lo);
        bf16x8 b0l, b1l;
        if constexpr (LOREG) { b0l = Bl[ks][0]; b1l = Bl[ks][1]; }
        else { b0l = *(const bf16x8*)(WT_lo + (size_t)l15 * 2048 + kb); b1l = *(const bf16x8*)(WT_lo + (size_t)(16 + l15) * 2048 + kb); }
        acc0 = MFMA16(Ah, Bh[ks][0], acc0); acc0 = MFMA16(Ah, b0l, acc0); acc0 = MFMA16(Al, Bh[ks][0], acc0);
        acc1 = MFMA16(Ah, Bh[ks][1], acc1); acc1 = MFMA16(Ah, b1l, acc1); acc1 = MFMA16(Al, Bh[ks][1], acc1); }
    if (g < 2) {
#pragma unroll
        for (int r = 0; r < 4; ++r) { part[wave * 256 + (4 * g + r) * 32 + l15] = acc0[r]; part[wave * 256 + (4 * g + r) * 32 + 16 + l15] = acc1[r]; } }
}
#define SK_LOAD(B, BASE) do { _Pragma("unroll") for (int ks_ = 0; ks_ < 8; ++ks_) _Pragma("unroll") for (int n_ = 0; n_ < 2; ++n_) \
        B[ks_][n_] = *(const bf16x8*)((BASE) + (size_t)(16 * n_ + (lane & 15)) * 2048 + 256 * wave + 32 * ks_ + 8 * (lane >> 4)); } while (0)

__device__ __forceinline__ void p1_phase(LAS unsigned char* lds, int tid, int wave, int lane, int G, const float* x, const float* ctx, const float* MOD, const float* norm_g,
                                         const bf16* SK, const float* gate_b, bf16* HB, unsigned char* HB8, float* GATES) {
    LAS float* hrow = (LAS float*)(lds + wave * 8192); LAS float* part = (LAS float*)(lds + 65536);
    bf16x8 Bh[8][2], Bl[8][2]; SK_LOAD(Bh, SK); SK_LOAD(Bl, SK + 65536);
    f32x4 v[8];
    { const int row = blockIdx.x * 8 + wave; const float* xr = row < NLAT ? x + (size_t)row * DM : ctx + (size_t)(row - NLAT) * DM;
#pragma unroll
      for (int j = 0; j < 8; ++j) v[j] = *(const f32x4*)(xr + 4 * (lane + 64 * j)); }
    for (int it = blockIdx.x; it < NTOK / 8; it += G) {
        const int row = it * 8 + wave;
        const float* shift = MOD + (size_t)(row < NLAT ? (row >> 11) : 4) * 12288; const float* scale = shift + 2048;
        float ss = 0.f;
#pragma unroll
        for (int j = 0; j < 8; ++j) ss += (v[j][0] * v[j][0] + v[j][1] * v[j][1]) + (v[j][2] * v[j][2] + v[j][3] * v[j][3]);
        const float rstd = 1.0f / sqrtf(wave_sum(ss) * (1.0f / DM) + EPS);
#pragma unroll
        for (int j = 0; j < 8; ++j) { const int col = 4 * (lane + 64 * j);
            const f32x4 g = *(const f32x4*)(norm_g + col), sc = *(const f32x4*)(scale + col), sh = *(const f32x4*)(shift + col);
            const f32x4 h = (v[j] * rstd) * g * (sc + 1.0f) + sh;
            v2u o; o.x = cvt_pk_bf16(h[0], h[1]); o.y = cvt_pk_bf16(h[2], h[3]); *(v2u*)(HB + (size_t)row * DM + col) = o;
            *(unsigned*)(HB8 + (size_t)row * DM + col) = pg8::pk4_fp8(h[0] * pg8::F8_SA, h[1] * pg8::F8_SA, h[2] * pg8::F8_SA, h[3] * pg8::F8_SA);
            *(LAS f32x4*)(hrow + col) = h; }
        if (it + G < NTOK / 8) { const int rown = (it + G) * 8 + wave; const float* xr = rown < NLAT ? x + (size_t)rown * DM : ctx + (size_t)(rown - NLAT) * DM;
#pragma unroll
            for (int j = 0; j < 8; ++j) v[j] = *(const f32x4*)(xr + 4 * (lane + 64 * j)); }
        __syncthreads();
        skinny_mfma_r<true>((const LAS float*)lds, Bh, Bl, nullptr, part, wave, lane);
        __syncthreads();
        if (tid < 256) { float s = 0.f;
#pragma unroll
            for (int w = 0; w < 8; ++w) s += part[w * 256 + tid];
            GATES[(size_t)(it * 8) * 32 + tid] = s + gate_b[tid & 31]; }
    }
}

__device__ __forceinline__ void p3_phase(int wave, int lane, int G, const bf16* Z, const float* conv_w, const float* conv_b, const float* sgu_norm_g, bf16* QC, bf16* KC, bf16* SVN,
                                         const float* GATES, float* SCN, float* BEND, float* GMAX) {
    const int gw = blockIdx.x * NWAVES + wave, NGW = G * NWAVES;
    for (int task = gw; task < 64 * NCH; task += NGW) { const int bhd = task / NCH, bi = task - bhd * NCH, dir = bhd & 1, bh = bhd >> 1, b = bh >> 3, h = bh & 7;
        const size_t row0 = bi < 2 ? (size_t)NLAT + b * TCX + bi * 128 : (size_t)b * TL + (bi - 2) * 128;
        float* sp = SCN + (size_t)task * 384; float b_end, gmax;
        gate_scan(GATES, row0, (2 * dir) * 8 + h, (2 * dir + 1) * 8 + h, dir, lane, sp, sp + 128, sp + 256, b_end, gmax);
        const int c = dir == 0 ? bi : (bi < 2 ? 1 - bi : 19 - bi);
        if (lane == 0 && c < 17) { BEND[bhd * 17 + c] = b_end; GMAX[bhd * 17 + c] = gmax; } }
    for (int item = gw; item < NTOK; item += NGW) {
        const int rb = item >> 2, seg = item & 3, row0 = rb * 4, c0 = seg * 512 + lane * 8;
        const int t0 = row0 < NLAT ? (row0 & (TL - 1)) : ((row0 - NLAT) & (TCX - 1)), len = row0 < NLAT ? TL : TCX;
        v4u zr[8];
#pragma unroll
        for (int k = 0; k < 8; ++k) { const int tt = t0 + k - 2; zr[k] = (v4u){0u, 0u, 0u, 0u};
            if (tt >= 0 && tt < len) zr[k] = *(const v4u*)(Z + (size_t)(row0 + k - 2) * ZW + c0); }
        f32x4 w0[5], w1[5];
#pragma unroll
        for (int tau = 0; tau < 5; ++tau) { w0[tau] = *(const f32x4*)(conv_w + tau * 2048 + c0); w1[tau] = *(const f32x4*)(conv_w + tau * 2048 + c0 + 4); }
        const f32x4 b0 = *(const f32x4*)(conv_b + c0), b1 = *(const f32x4*)(conv_b + c0 + 4);
        const float qs = c0 < 1024 ? 0.08838834764831845f : 1.0f;
#pragma unroll
        for (int o = 0; o < 4; ++o) { float acc[8] = {b0[0], b0[1], b0[2], b0[3], b1[0], b1[1], b1[2], b1[3]};
#pragma unroll
            for (int tau = 0; tau < 5; ++tau) { const v4u z = zr[o + tau];
                acc[0] += w0[tau][0] * bf_lo(z.x); acc[1] += w0[tau][1] * bf_hi(z.x); acc[2] += w0[tau][2] * bf_lo(z.y); acc[3] += w0[tau][3] * bf_hi(z.y);
                acc[4] += w1[tau][0] * bf_lo(z.z); acc[5] += w1[tau][1] * bf_hi(z.z); acc[6] += w1[tau][2] * bf_lo(z.w); acc[7] += w1[tau][3] * bf_hi(z.w); }
#pragma unroll
            for (int i = 0; i < 8; ++i) acc[i] = siluf_(acc[i]) * qs;
            v4u ov; ov.x = cvt_pk_bf16(acc[0], acc[1]); ov.y = cvt_pk_bf16(acc[2], acc[3]); ov.z = cvt_pk_bf16(acc[4], acc[5]); ov.w = cvt_pk_bf16(acc[6], acc[7]);
            bf16* dst = c0 < 1024 ? QC + (size_t)(row0 + o) * 1024 + c0 : KC + (size_t)(row0 + o) * 1024 + (c0 - 1024);
            *(v4u*)dst = ov; }
    }
    for (int row = gw; row < NLAT; row += NGW) {
        float v[32]; float ss = 0.f;
#pragma unroll
        for (int j = 0; j < 4; ++j) { const v4u z = *(const v4u*)(Z + (size_t)row * ZW + ZS + 8 * lane + 512 * j);
            v[8 * j + 0] = gelu_tanh(bf_lo(z.x)); v[8 * j + 1] = gelu_tanh(bf_hi(z.x)); v[8 * j + 2] = gelu_tanh(bf_lo(z.y)); v[8 * j + 3] = gelu_tanh(bf_hi(z.y));
            v[8 * j + 4] = gelu_tanh(bf_lo(z.z)); v[8 * j + 5] = gelu_tanh(bf_hi(z.z)); v[8 * j + 6] = gelu_tanh(bf_lo(z.w)); v[8 * j + 7] = gelu_tanh(bf_hi(z.w)); }
#pragma unroll
        for (int i = 0; i < 32; ++i) ss += v[i] * v[i];
        const float rstd = 1.0f / sqrtf(wave_sum(ss) * (1.0f / DM) + EPS);
#pragma unroll
        for (int j = 0; j < 4; ++j) { const int col = 8 * lane + 512 * j; const f32x4 g0 = *(const f32x4*)(sgu_norm_g + col), g1 = *(const f32x4*)(sgu_norm_g + col + 4);
            v4u o; o.x = cvt_pk_bf16(v[8 * j] * rstd * g0[0], v[8 * j + 1] * rstd * g0[1]); o.y = cvt_pk_bf16(v[8 * j + 2] * rstd * g0[2], v[8 * j + 3] * rstd * g0[3]);
            o.z = cvt_pk_bf16(v[8 * j + 4] * rstd * g1[0], v[8 * j + 5] * rstd * g1[1]); o.w = cvt_pk_bf16(v[8 * j + 6] * rstd * g1[2], v[8 * j + 7] * rstd * g1[3]);
            *(v4u*)(SVN + (size_t)row * DM + col) = o; }
    }
}

constexpr int L_V0 = 0, L_V1 = 32768, L_K = 65536, L_SC = 98304, L_CB = 106496;
constexpr int N_M1 = 64 * 17, N_SGU = 512;
__device__ __forceinline__ void p4_phase(LAS unsigned char* lds, int tid_, int wave, int lane_, int G, const bf16* Z, const bf16* KC, const bf16* SVN, const float* SCN,
                                         const float* sgu_w, const float* sgu_b, bf16* DC, const float* GMAX, bf16* CM, int ufirst, int ustep) {
    v4u pk[4], pv[8]; f32x4 pa[2];
#define P4_ISSUE(U) do { const int u_ = (U); int t_ = tid_; asm volatile("" : "+v"(t_)); \
        if (u_ < N_M1) { const int bhd_ = u_ / 17, c_ = u_ - bhd_ * 17, dir_ = bhd_ & 1, bh_ = bhd_ >> 1, b_ = bh_ >> 3, h_ = bh_ & 7; \
            const bool ic_ = c_ < 2; const int blk_ = dir_ == 0 ? (ic_ ? c_ : c_ - 2) : (ic_ ? 1 - c_ : 17 - c_); \
            const size_t r0_ = ic_ ? (size_t)NLAT + b_ * TCX + blk_ * 128 : (size_t)b_ * TL + blk_ * 128; \
            const float* sp_ = SCN + (size_t)(bhd_ * NCH + (ic_ ? blk_ : blk_ + 2)) * 384; \
            _Pragma("unroll") for (int i = 0; i < 4; ++i) { const int id = t_ + NTHR * i; pk[i] = *(const v4u*)(KC + (r0_ + (id >> 4)) * 1024 + h_ * QKD + 8 * (id & 15)); pa[0][i] = sp_[128 + (id >> 4)]; } \
            pa[1][0] = GMAX[bhd_ * 17 + c_]; \
            _Pragma("unroll") for (int i = 0; i < 8; ++i) { const int id = t_ + NTHR * (i & 3); pv[i] = *(const v4u*)(Z + (r0_ + (id >> 4)) * ZW + ZV + h_ * VD + 128 * (i >> 2) + 8 * (id & 15)); } \
        } else { const int u2_ = u_ - N_M1, b_ = u2_ >> 7, n_ = (u2_ >> 3) & 15, grp_ = u2_ & 7; const size_t r0_ = (size_t)b_ * TL + n_ * 128; \
            _Pragma("unroll") for (int i = 0; i < 8; ++i) { const int id = t_ + NTHR * (i & 3); pv[i] = *(const v4u*)(SVN + (r0_ + (id >> 4)) * DM + grp_ * 256 + 128 * (i >> 2) + 8 * (id & 15)); } \
            } } while (0)
    int u = ufirst;
    if (u < N_M1 + N_SGU) P4_ISSUE(u);
    for (; u < N_M1 + N_SGU; u += ustep) {
        int tid = tid_; asm volatile("" : "+v"(tid)); const int lane = tid & 63; const unsigned g = lane >> 4, l15 = lane & 15;
        const bool m1 = u < N_M1;
        TR_NAT_OFFS(xn0, xn1, lane)
#pragma unroll
        for (int i = 0; i < 8; ++i) { const int id = tid + NTHR * (i & 3); *(LAS v4u*)(lds + ((i >> 2) ? L_V1 : L_V0) + img_off(id >> 4, id & 15)) = pv[i]; }
        bf16x8 Af[4]; v2u uw[16];
        if (m1) { const float gmax = pa[1][0];
#pragma unroll
            for (int i = 0; i < 4; ++i) { const int id = tid + NTHR * i, row = id >> 4, ch = id & 15; const float sw = __expf(pa[0][i] - gmax); const v4u v = pk[i]; v4u o;
                o.x = cvt_pk_bf16(bf_lo(v.x) * sw, bf_hi(v.x) * sw); o.y = cvt_pk_bf16(bf_lo(v.y) * sw, bf_hi(v.y) * sw); o.z = cvt_pk_bf16(bf_lo(v.z) * sw, bf_hi(v.z) * sw); o.w = cvt_pk_bf16(bf_lo(v.w) * sw, bf_hi(v.w) * sw);
                *(LAS v4u*)(lds + L_K + img_off(row, ch)) = o; }
        }
        __syncthreads();
        f32x4 af32[8];
        if (!m1) { const int u2 = u - N_M1, b = u2 >> 7, n = (u2 >> 3) & 15, grp = u2 & 7;
            const float* src = sgu_w + (size_t)grp * 16384 + (size_t)(16 * wave + l15) * 128 + 8 * g;
#pragma unroll
            for (int ks = 0; ks < 4; ++ks) { af32[2 * ks] = *(const f32x4*)(src + 32 * ks); af32[2 * ks + 1] = *(const f32x4*)(src + 32 * ks + 4); }
            const bf16* up = Z + ((size_t)b * TL + n * 128 + 16 * wave + l15) * ZW + ZU + grp * 256 + 4 * g;
#pragma unroll
            for (int et = 0; et < 16; ++et) uw[et] = *(const v2u*)(up + 16 * et); }
        if (u + ustep < N_M1 + N_SGU) P4_ISSUE(u + ustep);
        if (!m1) {
#pragma unroll
            for (int ks = 0; ks < 4; ++ks) { const f32x4 a = af32[2 * ks], b2 = af32[2 * ks + 1];
                const v4u p = {cvt_pk_bf16(a[0], a[1]), cvt_pk_bf16(a[2], a[3]), cvt_pk_bf16(b2[0], b2[1]), cvt_pk_bf16(b2[2], b2[3])}; Af[ks] = __builtin_bit_cast(bf16x8, p); } }
        if (m1) {
            const int bhd = u / 17, c = u - bhd * 17;
#pragma unroll
            for (int ks = 0; ks < 4; ++ks) Af[ks] = tr_frag(lds + L_K, 32 * ks + 8 * g, 32 * ks + 8 * g + 4, wave, lane);
            f32x4 acc[17];
#pragma unroll
            for (int et = 0; et < 17; ++et) acc[et] = (f32x4){0.f, 0.f, 0.f, 0.f};
#pragma unroll
            for (int et = 0; et < 16; ++et) { LAS unsigned char* img = lds + ((et >> 3) ? L_V1 : L_V0);
#pragma unroll
                for (int ks = 0; ks < 4; ++ks) { const bf16x8 Bf = tr_frag2(img + 8192 * ks, xn0[et & 7], xn1[et & 7]); acc[et] = MFMA16(Af[ks], Bf, acc[et]); } }
            { const short one = l15 == 0 ? (short)0x3F80 : (short)0; const bf16x8 Bo = {one, one, one, one, one, one, one, one};
#pragma unroll
                for (int ks = 0; ks < 4; ++ks) acc[16] = MFMA16(Af[ks], Bo, acc[16]); }
            bf16* dst = DC + ((size_t)bhd * 17 + c) * (CROWS * 128) + 16 * wave + 4 * g;
#pragma unroll
            for (int et = 0; et < 16; ++et) { v2u o; o.x = cvt_pk_bf16(acc[et][0], acc[et][1]); o.y = cvt_pk_bf16(acc[et][2], acc[et][3]); *(v2u*)(dst + (size_t)(16 * et + l15) * 128) = o; }
            if (l15 == 0) { v2u o; o.x = cvt_pk_bf16(acc[16][0], acc[16][1]); o.y = cvt_pk_bf16(acc[16][2], acc[16][3]); *(v2u*)(dst + (size_t)256 * 128) = o; }
        } else {
            const int u2 = u - N_M1, b = u2 >> 7, n = (u2 >> 3) & 15, grp = u2 & 7; const size_t row0 = (size_t)b * TL + n * 128;
            f32x4 acc[16];
#pragma unroll
            for (int et = 0; et < 16; ++et) { acc[et] = (f32x4){0.f, 0.f, 0.f, 0.f}; LAS unsigned char* img = lds + ((et >> 3) ? L_V1 : L_V0);
#pragma unroll
                for (int ks = 0; ks < 4; ++ks) { const bf16x8 Bf = tr_frag2(img + 8192 * ks, xn0[et & 7], xn1[et & 7]); acc[et] = MFMA16(Bf, Af[ks], acc[et]); } }
            { const int t = 16 * wave + l15; const float zb = sgu_b[grp * 128 + t]; const size_t row = row0 + t;
#pragma unroll
              for (int et = 0; et < 16; ++et) { const int col = grp * 256 + 16 * et + 4 * g; const v2u w2 = uw[et];
                  const float o0 = gelu_tanh(bf_lo(w2.x)) * (acc[et][0] + zb), o1 = gelu_tanh(bf_hi(w2.x)) * (acc[et][1] + zb), o2 = gelu_tanh(bf_lo(w2.y)) * (acc[et][2] + zb), o3 = gelu_tanh(bf_hi(w2.y)) * (acc[et][3] + zb);
                  v2u o; o.x = cvt_pk_bf16(o0, o1); o.y = cvt_pk_bf16(o2, o3); *(v2u*)(CM + row * DM + col) = o; } }
        }
        __syncthreads();
    }
#undef P4_ISSUE
}

__device__ __forceinline__ void p4_chain(LAS unsigned char* lds, int tid_, int wave, const bf16* Z, const bf16* KC, const float* SCN, const float* BEND, const float* GMAX, bf16* CS, float* MST) {
    const int bhd = blockIdx.x >> 1, eh = blockIdx.x & 1, dir = bhd & 1, bh = bhd >> 1, b = bh >> 3, h = bh & 7;
    v4u pk[4], pv[4]; f32x4 pg;
#define CH_ISSUE(C_) do { const int c_ = (C_); int t_ = tid_; asm volatile("" : "+v"(t_)); const bool ic_ = c_ < 2; const int blk_ = dir == 0 ? (ic_ ? c_ : c_ - 2) : (ic_ ? 1 - c_ : 17 - c_); \
        const size_t r0_ = ic_ ? (size_t)NLAT + b * TCX + blk_ * 128 : (size_t)b * TL + blk_ * 128; const float* sp_ = SCN + (size_t)(bhd * NCH + (ic_ ? blk_ : blk_ + 2)) * 384; \
        _Pragma("unroll") for (int i = 0; i < 4; ++i) { const int id = t_ + NTHR * i; pk[i] = *(const v4u*)(KC + (r0_ + (id >> 4)) * 1024 + h * QKD + 8 * (id & 15)); pg[i] = sp_[128 + (id >> 4)]; \
            pv[i] = *(const v4u*)(Z + (r0_ + (id >> 4)) * ZW + ZV + h * VD + 128 * eh + 8 * (id & 15)); } } while (0)
    f32x4 C[9];
#pragma unroll
    for (int et = 0; et < 9; ++et) C[et] = (f32x4){0.f, 0.f, 0.f, 0.f};
    float m = 0.f;
    CH_ISSUE(0);
#pragma unroll 1
    for (int c = 0; c < 17; ++c) {
        int tid = tid_; asm volatile("" : "+v"(tid)); const int lane = tid & 63; const unsigned g = lane >> 4, l15 = lane & 15;
        TR_NAT_OFFS(xn0, xn1, lane)
        const float gm = GMAX[bhd * 17 + c], be = BEND[bhd * 17 + c], mx = fmaxf(m, gm), al = __expf(m - mx);
#pragma unroll
        for (int i = 0; i < 4; ++i) { const int id = tid + NTHR * i, row = id >> 4, ch = id & 15; *(LAS v4u*)(lds + L_V0 + img_off(row, ch)) = pv[i];
            const float sw = __expf(pg[i] - mx); const v4u v = pk[i]; v4u o;
            o.x = cvt_pk_bf16(bf_lo(v.x) * sw, bf_hi(v.x) * sw); o.y = cvt_pk_bf16(bf_lo(v.y) * sw, bf_hi(v.y) * sw); o.z = cvt_pk_bf16(bf_lo(v.z) * sw, bf_hi(v.z) * sw); o.w = cvt_pk_bf16(bf_lo(v.w) * sw, bf_hi(v.w) * sw);
            *(LAS v4u*)(lds + L_K + img_off(row, ch)) = o; }
        __syncthreads();
        if (c + 1 < 17) CH_ISSUE(c + 1);
#pragma unroll
        for (int et = 0; et < 9; ++et) C[et] = C[et] * al;
        bf16x8 Af[4];
#pragma unroll
        for (int ks = 0; ks < 4; ++ks) Af[ks] = tr_frag(lds + L_K, 32 * ks + 8 * g, 32 * ks + 8 * g + 4, wave, lane);
#pragma unroll
        for (int et = 0; et < 8; ++et)
#pragma unroll
            for (int ks = 0; ks < 4; ++ks) { const bf16x8 Bf = tr_frag2(lds + L_V0 + 8192 * ks, xn0[et], xn1[et]); C[et] = MFMA16(Af[ks], Bf, C[et]); }
        if (eh == 0) { const short one = l15 == 0 ? (short)0x3F80 : (short)0; const bf16x8 Bo = {one, one, one, one, one, one, one, one};
#pragma unroll
            for (int ks = 0; ks < 4; ++ks) C[8] = MFMA16(Af[ks], Bo, C[8]); }
        m = be + mx;
        if (c >= 1) { bf16* dst = CS + ((size_t)bhd * 16 + (c - 1)) * (CROWS * 128) + 16 * wave + 4 * g;
#pragma unroll
            for (int et = 0; et < 8; ++et) { v2u o; o.x = cvt_pk_bf16(C[et][0], C[et][1]); o.y = cvt_pk_bf16(C[et][2], C[et][3]); *(v2u*)(dst + (size_t)(128 * eh + 16 * et + l15) * 128) = o; }
            if (eh == 0 && l15 == 0) { v2u o; o.x = cvt_pk_bf16(C[8][0], C[8][1]); o.y = cvt_pk_bf16(C[8][2], C[8][3]); *(v2u*)(dst + (size_t)256 * 128) = o; }
            if (eh == 0 && tid == 0) MST[bhd * 18 + c + 1] = m; }
        __syncthreads();
    }
#undef CH_ISSUE
}

__device__ __forceinline__ void p5_scan(int tid, int G, const bf16* DC, const float* BEND, const float* GMAX, bf16* CS, float* MST) {
    constexpr int QPB = 257 * 128 / 4;
    for (int idx = blockIdx.x * NTHR + tid; idx < 64 * QPB; idx += G * NTHR) {
        const int bhd = idx / QPB, q = idx - bhd * QPB;
        f32x4 C = {0.f, 0.f, 0.f, 0.f}; float m = 0.f;
#pragma unroll
        for (int c = 0; c < 17; ++c) {
            const float gm = GMAX[bhd * 17 + c], be = BEND[bhd * 17 + c], mx = fmaxf(m, gm), al = __expf(m - mx), bt = __expf(gm - mx);
            const v2u dw = *(const v2u*)(DC + ((size_t)bhd * 17 + c) * (CROWS * 128) + 4 * q); const f32x4 d = {bf_lo(dw.x), bf_hi(dw.x), bf_lo(dw.y), bf_hi(dw.y)};
            C = C * al + d * bt; m = be + mx;
            if (c >= 1) { v2u o; o.x = cvt_pk_bf16(C[0], C[1]); o.y = cvt_pk_bf16(C[2], C[3]);
                *(v2u*)(CS + ((size_t)bhd * 16 + (c - 1)) * (CROWS * 128) + 4 * q) = o; if (q == 0) MST[bhd * 18 + c + 1] = m; }
        }
    }
}

__device__ __forceinline__ void p6_phase(LAS unsigned char* lds, int tid, int wave, int lane_, int G, const bf16* Z, const bf16* QC, const bf16* KC, const float* SCN,
                                         const bf16* CS, const float* MST, const float* mnorm_g, bf16* RO) {
    for (int u = blockIdx.x; u < 512; u += G) {
        int lane = lane_; asm volatile("" : "+v"(lane)); const unsigned g = lane >> 4, l15 = lane & 15;
        const int bh = u >> 4, jb = u & 15, b = bh >> 3, h = bh & 7; const size_t row0 = (size_t)b * TL + jb * 128;
        load_tile128(lds + L_K, KC + row0 * 1024 + h * QKD, 1024, tid);
        load_tile128(lds + L_V0, Z + row0 * ZW + ZV + h * VD, ZW, tid);
        load_tile128(lds + L_V1, Z + row0 * ZW + ZV + h * VD + 128, ZW, tid);
        bf16x8 Qf[4];
#pragma unroll
        for (int ks = 0; ks < 4; ++ks) Qf[ks] = *(const bf16x8*)(QC + (row0 + 16 * wave + l15) * 1024 + h * QKD + 32 * ks + 8 * g);
        __syncthreads();
        f32x4 hsum[16];
#pragma unroll
        for (int et = 0; et < 16; ++et) hsum[et] = (f32x4){0.f, 0.f, 0.f, 0.f};
#pragma unroll 1
        for (int dir = 0; dir < 2; ++dir) {
            int lane = lane_; asm volatile("" : "+v"(lane));
            const unsigned g = lane >> 4, l15 = lane & 15;
            TR_PERM_OFFS(xp, lane)
            const int c = dir ? 17 - jb : 2 + jb; const bf16* cs = CS + ((size_t)(bh * 2 + dir) * 16 + (c - 2)) * (CROWS * 128);
            const float* sp = SCN + (size_t)((bh * 2 + dir) * NCH + 2 + jb) * 384; const float* gg = sp + 128; const float mc = MST[(bh * 2 + dir) * 18 + c];
            const int tS = 16 * wave + l15; const float MtS = fmaxf(mc, sp[256 + tS]);
            unsigned pw[16];
#pragma unroll
            for (int st = 0; st < 8; ++st) { f32x4 aS = {0.f, 0.f, 0.f, 0.f};
#pragma unroll
                for (int ks = 0; ks < 4; ++ks) { const bf16x8 Kf = *(const LAS bf16x8*)(lds + L_K + img_off(16 * st + l15, 4 * ks + g)); aS = MFMA16(Kf, Qf[ks], aS); }
                float pv[4]; const f32x4 gs = *(const f32x4*)(gg + 16 * st + 4 * g);
#pragma unroll
                for (int r = 0; r < 4; ++r) { const int s = 16 * st + 4 * g + r; const bool ok = dir ? (s >= tS) : (s <= tS); const float ev = __expf(fminf(gs[r] - MtS, 0.f)); pv[r] = ok ? aS[r] * ev : 0.f; }
                pw[2 * st] = cvt_pk_bf16(pv[0], pv[1]); pw[2 * st + 1] = cvt_pk_bf16(pv[2], pv[3]); asm volatile("" ::: "memory"); }
            bf16x8 Pf[4];
#pragma unroll
            for (int ks = 0; ks < 4; ++ks) { const v4u t4 = {pw[4 * ks], pw[4 * ks + 1], pw[4 * ks + 2], pw[4 * ks + 3]}; Pf[ks] = __builtin_bit_cast(bf16x8, t4); }
            const float wiT = __expf(mc - MtS), flT = __expf(-(sp[tS] + MtS));
            const short one = l15 == 0 ? (short)0x3F80 : (short)0; const bf16x8 Bo = {one, one, one, one, one, one, one, one};
            float inv;
            { f32x4 ad = {0.f, 0.f, 0.f, 0.f};
#pragma unroll
              for (int ks = 0; ks < 4; ++ks) { bf16x8 Cf = *(const bf16x8*)(cs + (size_t)256 * 128 + 32 * ks + 8 * g); if (l15 != 0) Cf = (bf16x8){0, 0, 0, 0, 0, 0, 0, 0}; ad = MFMA16(Cf, Qf[ks], ad); }
              ad[0] *= wiT;
#pragma unroll
              for (int ks = 0; ks < 4; ++ks) ad = MFMA16(Bo, Pf[ks], ad);
              const float den = __shfl(ad[0], lane & 15); inv = 1.0f / fmaxf(fabsf(den), flT); }
            { v4u cr[2];
#pragma unroll
              for (int i = 0; i < 2; ++i) { const int id = tid + NTHR * i; cr[i] = *(const v4u*)(cs + (size_t)(id >> 4) * 128 + 8 * (id & 15)); }
#pragma unroll
              for (int i = 0; i < 2; ++i) { const int id = tid + NTHR * i; *(LAS v4u*)(lds + L_CB + img_off(id >> 4, id & 15)) = cr[i]; }
#pragma unroll
              for (int gq = 0; gq < 4; ++gq) {
                LAS unsigned char* cb = lds + L_CB + (gq & 1) * 16384;
                __syncthreads();
                if (gq < 3) {
#pragma unroll
                    for (int i = 0; i < 2; ++i) { const int id = tid + NTHR * i; cr[i] = *(const v4u*)(cs + (size_t)(64 * (gq + 1) + (id >> 4)) * 128 + 8 * (id & 15)); } }
                f32x4 acc[4];
#pragma unroll
                for (int i = 0; i < 4; ++i) { acc[i] = (f32x4){0.f, 0.f, 0.f, 0.f};
#pragma unroll
                    for (int ks = 0; ks < 4; ++ks) { const bf16x8 Cf = *(const LAS bf16x8*)(cb + img_off(16 * i + l15, 4 * ks + g)); acc[i] = MFMA16(Cf, Qf[ks], acc[i]); } }
#pragma unroll
                for (int i = 0; i < 4; ++i) acc[i] = acc[i] * wiT;
                { LAS unsigned char* img = lds + ((gq >> 1) ? L_V1 : L_V0);
#pragma unroll
                  for (int i = 0; i < 4; ++i) {
#pragma unroll
                    for (int ks = 0; ks < 4; ++ks) { const bf16x8 Vf = tr_frag2(img + 8192 * ks, xp[4 * (gq & 1) + i], xp[4 * (gq & 1) + i] + 4096u); acc[i] = MFMA16(Vf, Pf[ks], acc[i]); } } }
#pragma unroll
                for (int i = 0; i < 4; ++i) hsum[4 * gq + i] += acc[i] * inv;
                if (gq < 3) {
#pragma unroll
                    for (int i = 0; i < 2; ++i) { const int id = tid + NTHR * i; *(LAS v4u*)(lds + L_CB + ((gq + 1) & 1) * 16384 + img_off(id >> 4, id & 15)) = cr[i]; } }
              } }
        }
        { float ss = 0.f;
#pragma unroll
          for (int et = 0; et < 16; ++et) ss += (hsum[et][0] * hsum[et][0] + hsum[et][1] * hsum[et][1]) + (hsum[et][2] * hsum[et][2] + hsum[et][3] * hsum[et][3]);
          ss += __shfl_xor(ss, 16); ss += __shfl_xor(ss, 32);
          const float rstd = 1.0f / sqrtf(ss * (1.0f / VD) + EPS); const size_t row = row0 + 16 * wave + l15;
#pragma unroll
          for (int et = 0; et < 16; ++et) { const int col = h * VD + 16 * et + 4 * g;
              const v2u ow = *(const v2u*)(Z + row * ZW + ZO + col); const f32x4 gn = *(const f32x4*)(mnorm_g + col);
              const float v0 = hsum[et][0] * rstd * gn[0] * sigmoidf_(bf_lo(ow.x)), v1 = hsum[et][1] * rstd * gn[1] * sigmoidf_(bf_hi(ow.x));
              const float v2 = hsum[et][2] * rstd * gn[2] * sigmoidf_(bf_lo(ow.y)), v3 = hsum[et][3] * rstd * gn[3] * sigmoidf_(bf_hi(ow.y));
              v2u o; o.x = cvt_pk_bf16(v0, v1); o.y = cvt_pk_bf16(v2, v3); *(v2u*)(RO + row * DM + col) = o; } }
        __syncthreads();
    }
}

__device__ __forceinline__ void p9_phase(LAS unsigned char* lds, int wave, int lane, int G, const float* X1, const float* MOD, const float* norm_g, const bf16* SK, const float* router_b,
                                         unsigned* cnt, unsigned char* XG, int* RE, int* RR, float* RG) {
    LAS float* hrow = (LAS float*)(lds + wave * 8192); LAS float* part = (LAS float*)(lds + 65536);
    bf16x8 Bh[8][2]; SK_LOAD(Bh, SK + 2 * 65536);
    f32x4 vn[8];
    { const float* xr = X1 + (size_t)(blockIdx.x * 8 + wave) * DM;
#pragma unroll
      for (int j = 0; j < 8; ++j) vn[j] = *(const f32x4*)(xr + 4 * (lane + 64 * j)); }
    for (int it = blockIdx.x; it < NLAT / 8; it += G) {
        const int row = it * 8 + wave;
        const float* shift = MOD + (size_t)(row >> 11) * 12288 + 3 * 2048; const float* scale = shift + 2048;
        f32x4 v[8]; float ss = 0.f;
#pragma unroll
        for (int j = 0; j < 8; ++j) { v[j] = vn[j]; ss += (v[j][0] * v[j][0] + v[j][1] * v[j][1]) + (v[j][2] * v[j][2] + v[j][3] * v[j][3]); }
        const float rstd = 1.0f / sqrtf(wave_sum(ss) * (1.0f / DM) + EPS);
#pragma unroll
        for (int j = 0; j < 8; ++j) { const int col = 4 * (lane + 64 * j);
            const f32x4 g = *(const f32x4*)(norm_g + col), sc = *(const f32x4*)(scale + col), sh = *(const f32x4*)(shift + col);
            v[j] = (v[j] * rstd) * g * (sc + 1.0f) + sh; *(LAS f32x4*)(hrow + col) = v[j]; }
        if (it + G < NLAT / 8) { const float* xr = X1 + (size_t)((it + G) * 8 + wave) * DM;
#pragma unroll
            for (int j = 0; j < 8; ++j) vn[j] = *(const f32x4*)(xr + 4 * (lane + 64 * j)); }
        __syncthreads();
        skinny_mfma_r<false>((const LAS float*)lds, Bh, Bh, SK + 3 * 65536, part, wave, lane);
        __syncthreads();
        float val = router_b[lane & 31];
#pragma unroll
        for (int w = 0; w < 8; ++w) val += part[w * 256 + wave * 32 + (lane & 31)];
        float sv[4]; int si[4];
#pragma unroll
        for (int k = 0; k < 4; ++k) { float bv = val; int bi = lane & 31;
#pragma unroll
            for (int o = 16; o >= 1; o >>= 1) { const float ov = __shfl_xor(bv, o); const int oi = __shfl_xor(bi, o); const bool take = (ov > bv) || (ov == bv && oi < bi); bv = take ? ov : bv; bi = take ? oi : bi; }
            sv[k] = bv; si[k] = __builtin_amdgcn_readfirstlane(bi); if ((lane & 31) == bi) val = -3.0e38f; }
        const float e1 = __expf(sv[1] - sv[0]), e2 = __expf(sv[2] - sv[0]), e3 = __expf(sv[3] - sv[0]), inv = 1.0f / (1.0f + e1 + e2 + e3);
        const float gk[4] = {inv, e1 * inv, e2 * inv, e3 * inv};
        unsigned rank = 0;
        if (lane < 4) rank = __hip_atomic_fetch_add(cnt + (lane == 0 ? si[0] : lane == 1 ? si[1] : lane == 2 ? si[2] : si[3]), 1u, RLX_AGENT);
#pragma unroll
        for (int k = 0; k < 4; ++k) { const unsigned rk = (unsigned)__builtin_amdgcn_readlane((int)rank, k);
            unsigned char* dst = XG + ((size_t)si[k] * 8192 + rk) * DM;
#pragma unroll
            for (int j = 0; j < 8; ++j) *(unsigned*)(dst + 4 * (lane + 64 * j)) = pg8::pk4_fp8(v[j][0] * pg8::F8_SA, v[j][1] * pg8::F8_SA, v[j][2] * pg8::F8_SA, v[j][3] * pg8::F8_SA);
            if (lane == 0) { RE[row * 4 + k] = si[k]; RR[row * 4 + k] = (int)rk; RG[row * 4 + k] = gk[k]; } }
    }
}
__device__ __forceinline__ void moe_prefix(LAS int* pref, const unsigned* cnt, int tid) {
    if (tid == 0) { int s = 0; for (int e = 0; e < 32; ++e) { const unsigned ce = __hip_atomic_load(cnt + e, RLX_AGENT); pref[e] = s; pref[33 + e] = (int)ce; s += (int)((ce + 255u) >> 8); } pref[32] = s; }
    __syncthreads();
}
__device__ __forceinline__ void p12_phase(const LAS int* pref, int wave, int lane_, int G, const float* X1, const float* MOD, const bf16* Y2, const int* RE, const int* RR, const float* RG, const float* final_g, float* out) {
    const int gw = blockIdx.x * NWAVES + wave, NGW = G * NWAVES;
    int en[4], rn[4]; float gn[4];
    if (gw < NLAT) {
#pragma unroll
        for (int k = 0; k < 4; ++k) { en[k] = RE[gw * 4 + k]; rn[k] = RR[gw * 4 + k]; gn[k] = RG[gw * 4 + k]; } }
    for (int row = gw; row < NLAT; row += NGW) {
        int lane = lane_; asm volatile("" : "+v"(lane));
        const float* xr = X1 + (size_t)row * DM + 4 * lane; f32x4 xv[8]; v2u yv[4][8]; float gt[4];
#pragma unroll
        for (int k = 0; k < 4; ++k) { gt[k] = gn[k]; const bf16* src = Y2 + ((size_t)pref[en[k]] * 256 + rn[k]) * DM + 4 * lane;
#pragma unroll
            for (int j = 0; j < 8; ++j) yv[k][j] = __builtin_nontemporal_load((const v2u*)(src + 256 * j)); }
#pragma unroll
        for (int j = 0; j < 8; ++j) xv[j] = __builtin_nontemporal_load((const f32x4*)(xr + 256 * j));
        if (row + NGW < NLAT) { const int r2 = row + NGW;
#pragma unroll
            for (int k = 0; k < 4; ++k) { en[k] = RE[r2 * 4 + k]; rn[k] = RR[r2 * 4 + k]; gn[k] = RG[r2 * 4 + k]; } }
        const float* g5 = MOD + (size_t)(row >> 11) * 12288 + 5 * 2048; float ss = 0.f;
#pragma unroll
        for (int j = 0; j < 8; ++j) { f32x4 ys = {0.f, 0.f, 0.f, 0.f};
#pragma unroll
            for (int k = 0; k < 4; ++k) { const v2u y = yv[k][j]; ys[0] += gt[k] * bf_lo(y.x); ys[1] += gt[k] * bf_hi(y.x); ys[2] += gt[k] * bf_lo(y.y); ys[3] += gt[k] * bf_hi(y.y); }
            const int col = 4 * (lane + 64 * j); const f32x4 x2 = xv[j] + *(const f32x4*)(g5 + col) * ys; xv[j] = x2;
            ss += (x2[0] * x2[0] + x2[1] * x2[1]) + (x2[2] * x2[2] + x2[3] * x2[3]); }
        const float rstd = 1.0f / sqrtf(wave_sum(ss) * (1.0f / DM) + EPS);
#pragma unroll
        for (int j = 0; j < 8; ++j) { const int col = 4 * (lane + 64 * j); __builtin_nontemporal_store(xv[j] * rstd * *(const f32x4*)(final_g + col), (f32x4*)(out + (size_t)row * DM + col)); }
    }
}

#define XB_TMO      128
#define XB_XCNT(j)  (256  + 64 * (j))
#define XB_XSUB(j)  (1280 + 64 * (j))
#define XB_XGEN(j)  (2304 + 64 * (j))
#define XB_TOP      3328
#define XB_TOPGEN   3392
#define XCD_BAR_WORDS 3456
#define XB_SPIN_CAP (1u << 18)

__device__ __forceinline__ unsigned xb_ld(unsigned* p)              { return __hip_atomic_load(p, __ATOMIC_RELAXED, __HIP_MEMORY_SCOPE_AGENT); }
__device__ __forceinline__ unsigned xb_add(unsigned* p, unsigned v) { return __hip_atomic_fetch_add(p, v, __ATOMIC_RELAXED, __HIP_MEMORY_SCOPE_AGENT); }
__device__ __forceinline__ unsigned xb_xcc_id() { return (unsigned)__builtin_amdgcn_s_getreg((3 << 11) | 20) & 0xFu; }
#define XB_SPIN(cond, bar) do { unsigned _sp = 0; while (cond) { __builtin_amdgcn_s_sleep(1); \
    if ((++_sp & 255u) == 0u) { if (xb_ld(&(bar)[XB_TMO])) break; if (_sp > XB_SPIN_CAP) { atomicAdd(&(bar)[XB_TMO], 1u); break; } } } } while (0)

struct XcdBarrier {
    unsigned* bar; unsigned x;
    volatile LAS unsigned* st;
};

__device__ __forceinline__ XcdBarrier xcd_barrier_post(unsigned* bar, volatile LAS unsigned* st) {
    XcdBarrier b; b.bar = bar; b.x = xb_xcc_id(); b.st = st;
    if (threadIdx.x == 0) (void)xb_add(&bar[XB_XCNT(b.x)], 1u);
    return b;
}
__device__ __forceinline__ void xcd_barrier_complete(unsigned* bar, unsigned x, unsigned& nloc, unsigned& nx) {
    const unsigned G = gridDim.x * gridDim.y * gridDim.z;
    unsigned sum, cnt, mine, sp = 0u;
    for (;;) {
        sum = 0u; cnt = 0u; mine = 0u;
#pragma unroll
        for (unsigned j = 0; j < 16; ++j) { const unsigned c = xb_ld(&bar[XB_XCNT(j)]); sum += c; cnt += (c > 0u) ? 1u : 0u; mine = (j == x) ? c : mine; }
        if (sum == G) break;
        __builtin_amdgcn_s_sleep(1);
        if ((++sp & 255u) == 0u) { if (xb_ld(&bar[XB_TMO])) break; if (sp > XB_SPIN_CAP) { atomicAdd(&bar[XB_TMO], 1u); break; } }
    }
    nloc = mine > 0u ? mine : 1u; nx = cnt > 0u ? cnt : 1u;
}

__device__ __forceinline__ void xcd_barrier(const XcdBarrier& b) {
    asm volatile("s_waitcnt vmcnt(0)" ::: "memory");
    __syncthreads();
    if (threadIdx.x == 0) {
        unsigned* bar = b.bar;
        __builtin_amdgcn_s_waitcnt(0);
        unsigned nloc = b.st[0], nx = b.st[1];
        if (nloc == 0u) { xcd_barrier_complete(bar, b.x, nloc, nx); b.st[0] = nloc; b.st[1] = nx; }
        const unsigned old = xb_add(&bar[XB_XSUB(b.x)], 1u);
        const unsigned gen = old / nloc;
        if (old + 1u == (gen + 1u) * nloc) {
            __builtin_amdgcn_fence(__ATOMIC_RELEASE, "agent");
            asm volatile("s_waitcnt vmcnt(0)" ::: "memory");
            const unsigned og = xb_add(&bar[XB_TOP], 1u);
            const unsigned tg = og / nx;
            if (og + 1u == (tg + 1u) * nx) xb_add(&bar[XB_TOPGEN], 1u);
            else XB_SPIN(xb_ld(&bar[XB_TOPGEN]) == tg, bar);
            __builtin_amdgcn_fence(__ATOMIC_ACQUIRE, "agent");
            xb_add(&bar[XB_XGEN(b.x)], 1u);
            asm volatile("s_waitcnt vmcnt(0)" ::: "memory");
        } else {
            XB_SPIN(xb_ld(&bar[XB_XGEN(b.x)]) == gen, bar);
            __builtin_amdgcn_fence(__ATOMIC_ACQUIRE, "agent");
            asm volatile("s_waitcnt vmcnt(0)" ::: "memory");
        }
    }
    __syncthreads();
}

struct Args { const float* in[26]; float* out; unsigned char* ws; int ph_lo, ph_hi; };
__global__ void __launch_bounds__(NTHR, 2) mk_fwd(Args args) {
    extern __shared__ __attribute__((aligned(16))) unsigned char lds_raw[];
    LAS unsigned char* lds = (LAS unsigned char*)lds_raw;
    const int tid = threadIdx.x, lane = tid & 63, wave = __builtin_amdgcn_readfirstlane(tid >> 6), G = gridDim.x;
    unsigned char* ws = args.ws;
    gu32* ctl = (gu32*)(ws + WS_CTL);
    for (int u = tid; u < (LDS_BYTES - LDSCTL_OFF) / 4; u += NTHR) ((LAS unsigned*)(lds + LDSCTL_OFF))[u] = 0u;
    __syncthreads();
    volatile LAS unsigned* MISC = (volatile LAS unsigned*)(lds + MISC_OFF);
    XcdBarrier bar; bar.bar = (unsigned*)(ctl + CW_BAR); bar.x = 0; bar.st = nullptr;
    if (N_LAUNCHES == 1) bar = xcd_barrier_post((unsigned*)(ctl + CW_BAR), MISC + 8);
#define GRID_BAR() do { if (N_LAUNCHES == 1) xcd_barrier(bar); } while (0)
    const int lo = args.ph_lo, hi = args.ph_hi;
#ifdef ONLY_PHASE
#define IN(k) ((k) == ONLY_PHASE && lo <= (k) && (k) < hi)
#else
#define IN(k) (lo <= (k) && (k) < hi)
#endif
#define BOTH(k) (IN(k) && IN((k) + 1))
#ifndef REP_MASK
#define REP_MASK 0
#endif
#define NREP(k) ((((REP_MASK) >> (k)) & 1) ? 2 : 1)
#define INP(i) (args.in[i])
#define WSF(off) ((float*)(ws + (off)))
#define WSB(off) ((bf16*)(ws + (off)))
#define WSI(off) ((int*)(ws + (off)))
    unsigned* cnt = (unsigned*)(ctl + CW_CNT);
    LAS int* pref = (LAS int*)(lds + PREF_OFF);
    const int n_conv_p0 = I_WIN + 3 * I_P;
#define x_in INP(0)
#define cvec INP(1)
#define ctx INP(2)
#define c_ctx INP(3)
#define mod_w INP(4)
#define mod_b INP(5)
#define norm1_g INP(6)
#define norm2_g INP(7)
#define w_in INP(8)
#define gate_b INP(9)
#define conv_w INP(10)
#define conv_b INP(11)
#define mnorm_g INP(12)
#define sgu_norm_g INP(13)
#define sgu_w INP(14)
#define sgu_b INP(15)
#define proj_a INP(16)
#define proj_b INP(17)
#define w_out INP(18)
#define router_w INP(19)
#define router_b INP(20)
#define exp_w1 INP(21)
#define exp_b1 INP(22)
#define exp_w2 INP(23)
#define exp_b2 INP(24)
#define final_g INP(25)
#define MOD WSF(WS_MOD)
#define GATES WSF(WS_GATES)
#define BEND WSF(WS_SCAL)
#define GMAX (WSF(WS_SCAL) + 64 * 17)
#define MST (WSF(WS_SCAL) + 2 * 64 * 17)
#define RE WSI(WS_ROUTE)
#define RR (WSI(WS_ROUTE) + NLAT * 4)
#define RG (WSF(WS_ROUTE) + 2 * NLAT * 4)
#define WINT WSB(WS_WINT)
#define SKW WSB(WS_SK)
#define SCN WSF(WS_SCN)
#define PAT WSB(WS_PAT)
#define PBT WSB(WS_PBT)
#define WOT WSB(WS_WOT)
#define W1T WSB(WS_W1T)
#define W1T8 ((unsigned char*)(ws + WS_W1T))
#define HB8M ((unsigned char*)(ws + WS_HB8))
#define WG8M ((unsigned char*)(ws + WS_WG8))
#define W2T8 ((unsigned char*)(ws + WS_W2T))
#define XG8 ((unsigned char*)(ws + WS_XG))
#define ACT8 ((unsigned char*)(ws + WS_ACT))
#define W2T WSB(WS_W2T)
#define HB WSB(WS_HB)
#define Z WSB(WS_Z)
#define QC WSB(WS_QC)
#define KC WSB(WS_KC)
#define SVN WSB(WS_SVN)
#define DC WSB(WS_DC)
#define CS WSB(WS_CS)
#define RO WSB(WS_RO)
#define CM WSB(WS_CM)
#define YB WSB(WS_YB)
#define MRG WSB(WS_MRG)
#define X1 WSF(WS_X1)
#define ACT WSB(WS_ACT)
#define Y2 WSB(WS_Y2)
#define XG WSB(WS_XG)

    if (IN(0)) for (int rep_ = 0; rep_ < NREP(0); ++rep_) { p0_phase(lds, tid, G, cvec, c_ctx, mod_w, mod_b, MOD, w_in, proj_a, proj_b, w_out, exp_w1, exp_w2, router_w, WINT, PAT, PBT, WOT, W1T, W2T, SKW, n_conv_p0);
        cvt_run8(lds, tid, I_W1 + I_W2 + (int)blockIdx.x, G, I_W1 + I_W2 + I_GATE8, exp_w1, exp_w2, w_in, W1T8, W2T8, WG8M); if (BOTH(0) || rep_ + 1 < NREP(0)) GRID_BAR(); }
    if (IN(1)) for (int rep_ = 0; rep_ < NREP(1); ++rep_) { p1_phase(lds, tid, wave, lane, G, x_in, ctx, MOD, norm1_g, SKW, gate_b, HB, HB8M, GATES); if (BOTH(1) || rep_ + 1 < NREP(1)) GRID_BAR(); }
    if (IN(2)) for (int rep_ = 0; rep_ < NREP(2); ++rep_) {
        if ((int)blockIdx.x >= G - (G == 256 ? N_CONVERTERS : G))
            cvt_run8(lds, tid, (int)blockIdx.x - (G - (G == 256 ? N_CONVERTERS : G)), (G == 256 ? N_CONVERTERS : G), I_W1 + I_W2, exp_w1, exp_w2, w_in, W1T8, W2T8, WG8M);
        { pg8::Gemm g{(const bf16*)HB8M, (const bf16*)WG8M, NTOK, 12288, DM}; pg8::DynOrder S{(unsigned*)(ctl + CW_Q2), (LAS int*)(lds + PREF_OFF + 808), (int)(blockIdx.x & 7), 48, 8, 0}; pg8::EpiGate8 E{Z, ZW};
          pg8::gemm_phase8<pg8::EpiGate8, pg8::DynOrder, true, true>(lds, g, S, E); }
        { pg8::Gemm g{HB, WINT, NLAT, ZW, DM}; pg8::DynOrder S{(unsigned*)(ctl + CW_Q), (LAS int*)(lds + PREF_OFF + 800), (int)(blockIdx.x & 7), 8, 0, 24}; pg8::EpiBf16 E{Z, ZW, nullptr, ZW / 256};
          pg8::gemm_phase<pg8::EpiBf16, pg8::DynOrder, true, true>(lds, g, S, E); }
        if (BOTH(2) || rep_ + 1 < NREP(2)) GRID_BAR();
    }
    if (IN(3)) for (int rep_ = 0; rep_ < NREP(3); ++rep_) { p3_phase(wave, lane, G, Z, conv_w, conv_b, sgu_norm_g, QC, KC, SVN, GATES, SCN, BEND, GMAX); if (BOTH(3) || rep_ + 1 < NREP(3)) GRID_BAR(); }
    if (IN(4)) for (int rep_ = 0; rep_ < NREP(4); ++rep_) { if (G == 256) { if ((int)blockIdx.x < 128) p4_chain(lds, tid, wave, Z, KC, SCN, BEND, GMAX, CS, MST); else p4_phase(lds, tid, wave, lane, G, Z, KC, SVN, SCN, sgu_w, sgu_b, DC, GMAX, CM, N_M1 + (int)blockIdx.x - 128, 128); }
        else p4_phase(lds, tid, wave, lane, G, Z, KC, SVN, SCN, sgu_w, sgu_b, DC, GMAX, CM, (int)blockIdx.x, G);
        if (BOTH(4) || rep_ + 1 < NREP(4)) GRID_BAR(); }
    if (IN(5)) for (int rep_ = 0; rep_ < NREP(5); ++rep_) {
        { pg8::Gemm g{CM, PBT, NLAT, DM, DM}; pg8::StaticOrder S; S.init(NLAT, DM, G, (int)blockIdx.x); pg8::EpiBf16 E{YB, DM, nullptr, DM / 256};
          pg8::gemm_phase<pg8::EpiBf16, pg8::StaticOrder, true, true>(lds, g, S, E); }
        if (G != 256) p5_scan(tid, G, DC, BEND, GMAX, CS, MST);
        if (BOTH(5) || rep_ + 1 < NREP(5)) GRID_BAR();
    }
    if (IN(6)) for (int rep_ = 0; rep_ < NREP(6); ++rep_) { p6_phase(lds, tid, wave, lane, G, Z, QC, KC, SCN, CS, MST, mnorm_g, RO); if (BOTH(6) || rep_ + 1 < NREP(6)) GRID_BAR(); }
    if (IN(7)) for (int rep_ = 0; rep_ < NREP(7); ++rep_) {
        pg8::Gemm g{RO, PAT, NLAT, DM, DM}; pg8::StaticOrder S; S.init(NLAT, DM, G, (int)blockIdx.x); pg8::EpiMerge E{MRG, Z, ZW, ZGA, ZGB, YB};
        pg8::gemm_phase<pg8::EpiMerge, pg8::StaticOrder, true, true>(lds, g, S, E);
        if (BOTH(7) || rep_ + 1 < NREP(7)) GRID_BAR();
    }
    if (IN(8)) for (int rep_ = 0; rep_ < NREP(8); ++rep_) {
        pg8::Gemm g{MRG, WOT, NLAT, DM, DM}; pg8::StaticOrder S; S.init(NLAT, DM, G, (int)blockIdx.x); pg8::EpiX1 E{X1, x_in, MOD};
        pg8::gemm_phase<pg8::EpiX1, pg8::StaticOrder, true, true>(lds, g, S, E);
        if (BOTH(8) || rep_ + 1 < NREP(8)) GRID_BAR();
    }
    if (IN(9)) for (int rep_ = 0; rep_ < NREP(9); ++rep_) { p9_phase(lds, wave, lane, G, X1, MOD, norm2_g, SKW, router_b, cnt, XG8, RE, RR, RG); if (BOTH(9) || rep_ + 1 < NREP(9)) GRID_BAR(); }
    if (IN(10)) for (int rep_ = 0; rep_ < NREP(10); ++rep_) {
        moe_prefix(pref, cnt, tid);
        pg8::Gemm g{(const bf16*)XG8, (const bf16*)W1T8, 0, 0, DM}; pg8::MoeDyn S{pref, 16, 1, (unsigned*)(ctl + CW_Q3), (LAS int*)(lds + PREF_OFF + 816), (int)(blockIdx.x & 7)}; pg8::EpiSwiglu8 E{ACT8, exp_b1};
        pg8::gemm_phase8<pg8::EpiSwiglu8, pg8::MoeDyn, true, true, true>(lds, g, S, E);
        if (BOTH(10) || rep_ + 1 < NREP(10)) GRID_BAR();
    }
    if (IN(11)) for (int rep_ = 0; rep_ < NREP(11); ++rep_) {
        moe_prefix(pref, cnt, tid);
        pg8::Gemm g{(const bf16*)ACT8, (const bf16*)W2T8, 0, 0, DEXP}; pg8::MoeDyn S{pref, 8, 0, (unsigned*)(ctl + CW_Q4), (LAS int*)(lds + PREF_OFF + 824), (int)(blockIdx.x & 7)}; pg8::EpiY2f8 E{Y2, exp_b2};
        pg8::gemm_phase8<pg8::EpiY2f8, pg8::MoeDyn, true, true, true>(lds, g, S, E);
        if (BOTH(11) || rep_ + 1 < NREP(11)) GRID_BAR();
    }
    if (IN(12)) for (int rep_ = 0; rep_ < NREP(12); ++rep_) { moe_prefix(pref, cnt, tid); p12_phase(pref, wave, lane, G, X1, MOD, Y2, RE, RR, RG, final_g, args.out); if (rep_ + 1 < NREP(12)) GRID_BAR(); }
#undef IN
#undef BOTH
}

extern "C" void kernel_launch(void* const* d_in, const int* in_sizes, int n_in, void* d_out, int out_size, void* d_ws, size_t ws_size, hipStream_t stream) {
    static int grid = 0;
    if (grid == 0) {
        if (n_in != 26 || out_size != NLAT * DM || ws_size < WS_END) { fprintf(stderr, "kernel_launch: unexpected shapes (n_in %d, out %d, ws %zu)\n", n_in, out_size, ws_size); grid = -1; return; }
        int dev = 0, cus = 0;
        if (hipGetDevice(&dev) != hipSuccess || hipDeviceGetAttribute(&cus, hipDeviceAttributeMultiprocessorCount, dev) != hipSuccess) { grid = -1; return; }
        if (hipFuncSetAttribute((const void*)mk_fwd, hipFuncAttributeMaxDynamicSharedMemorySize, LDS_BYTES) != hipSuccess) { fprintf(stderr, "kernel_launch: hipFuncSetAttribute failed\n"); grid = -1; return; }
        int per_cu = 0;
        if (hipOccupancyMaxActiveBlocksPerMultiprocessor(&per_cu, (const void*)mk_fwd, NTHR, LDS_BYTES) != hipSuccess || per_cu < 1) fprintf(stderr, "kernel_launch: occupancy query reports %d\n", per_cu);
        (void)hipGetLastError();
        grid = cus;
    }
    if (grid < 0) return;
    if (hipMemsetAsync((char*)d_ws + WS_CTL, 0, CTL_ZERO_BYTES, stream) != hipSuccess) return;
    Args a{};
    for (int i = 0; i < 26; ++i) a.in[i] = (const float*)d_in[i];
    a.out = (float*)d_out; a.ws = (unsigned char*)d_ws;
    for (int li = 0; li < N_LAUNCHES; ++li) {
        a.ph_lo = (N_LAUNCHES == 1) ? 0 : li; a.ph_hi = (N_LAUNCHES == 1) ? N_PHASES : li + 1;
        hipLaunchKernelGGL(mk_fwd, dim3(grid), dim3(NTHR), LDS_BYTES, stream, a);
        const hipError_t le = hipPeekAtLastError();
        if (le != hipSuccess) { fprintf(stderr, "kernel_launch: launch %d failed: %s\n", li, hipGetErrorName(le)); break; }
    }
}
```

```cpp
#include <hip/hip_runtime.h>
#include <cstdio>
#include <cstdint>
#ifndef MK_N_LAUNCHES
#define MK_N_LAUNCHES 1
#endif
namespace pg8 {
#define PG8_LAS __attribute__((address_space(3)))
typedef unsigned short bf16_t;
typedef short bf16x8 __attribute__((ext_vector_type(8)));
typedef float f32x4 __attribute__((ext_vector_type(4)));
typedef unsigned u32x4 __attribute__((ext_vector_type(4)));
typedef int i32x4 __attribute__((ext_vector_type(4)));
typedef int i32x8 __attribute__((ext_vector_type(8)));
constexpr int BM = 256, BK = 64, HALF = 128, HTB = HALF * BK * 2  , STAGE_BYTES = 8 * HTB, NXCD = 8, WGM = 8;

__host__ __device__ __forceinline__ int lds_byte(int r, int c) { const int st = (r >> 4) * 2 + (c >> 5), rr = r & 15, cc = c & 31, ob = rr * 64 + cc * 2; return st * 1024 + (ob ^ (((ob >> 9) & 1) << 5)); }
__host__ __device__ __forceinline__ void stage_rc(int b, int& R, int& C) { const int st = b / 1024, sb = b % 1024, swz = sb ^ (((sb >> 9) & 1) << 5); R = (st >> 1) * 16 + swz / 64; C = (st & 1) * 32 + (swz % 64) / 2; }
__host__ __device__ __forceinline__ int perm32(int rho) { const int n = rho >> 4, i = rho & 15; return 8 * (i >> 2) + 4 * n + (i & 3); }

struct Unit { int pm, pn, po, hf; };
struct Gemm { const bf16_t* A; const bf16_t* Bt; int M, N, K; };

struct StaticOrder {
    int nM, nN, nwg, G, c;
    __host__ __device__ void init(int M, int N, int G_, int c_) { nM = M / BM; nN = N / BM; nwg = nM * nN; G = G_; c = c_; }
    __host__ __device__ bool next(int i, Unit& u) const {
        const long L = (long)i * G + c; if (L >= nwg) return false;
        int wgid = (int)L; { const int q = nwg / NXCD, r = nwg % NXCD, xcd = wgid % NXCD, off = wgid / NXCD; wgid = (xcd < r ? xcd * (q + 1) : r * (q + 1) + (xcd - r) * q) + off; }
        const int nig = WGM * nN, gid = wgid / nig, fm = gid * WGM, gsz = (nM - fm) < WGM ? (nM - fm) : WGM;
        u.pm = fm + ((wgid % nig) % gsz); u.pn = (wgid % nig) / gsz; u.po = u.pm; u.hf = 0; return true;
    }
    __device__ __forceinline__ void a_ready(const Unit&) const {}
    __device__ __forceinline__ void done(const Unit&) const {}
};
struct PairOrder {
    StaticOrder S; int dM, dN;
    __device__ __forceinline__ bool next(int i, Unit& u) const { Unit b; if (!S.next(i >> 1, b)) return false; const int k = i & 1; u.pm = b.pm + dM * k; u.pn = b.pn + dN * k; u.po = b.po; u.hf = k; return true; }
    __device__ __forceinline__ void a_ready(const Unit&) const {}
    __device__ __forceinline__ void done(const Unit&) const {}
};
struct DynOrder {
    unsigned* q; PG8_LAS int* slot; int xcd, nN, ctx8, pn0;
    __device__ __forceinline__ bool next(int i, Unit& u) const {
        if (threadIdx.x == 0) { int id = -1;
            unsigned v = __hip_atomic_fetch_add(q + 64 * xcd, 1u, __ATOMIC_RELAXED, __HIP_MEMORY_SCOPE_AGENT);
            const unsigned per = (unsigned)(4 * nN + ctx8);
            if (v < per) id = xcd * (int)per + (int)v;
            else {
#pragma unroll 1
                for (int k = 1; k < 8 && id < 0; ++k) { const int x = (xcd + k) & 7;
                    if (__hip_atomic_load(q + 64 * x, __ATOMIC_RELAXED, __HIP_MEMORY_SCOPE_AGENT) < per) { v = __hip_atomic_fetch_add(q + 64 * x, 1u, __ATOMIC_RELAXED, __HIP_MEMORY_SCOPE_AGENT); if (v < per) id = x * (int)per + (int)v; } } }
            slot[i & 1] = id; asm volatile("s_waitcnt lgkmcnt(0)" ::: "memory"); }
        asm volatile("" ::: "memory"); __builtin_amdgcn_s_barrier(); asm volatile("" ::: "memory");
        const int id = slot[i & 1]; if (id < 0) return false;
        const int per = 4 * nN + ctx8, nl = 4 * nN, x = id / per, v = id - x * per;
        if (v < nl) { const int wgid = x * nl + v, nig = WGM * nN, gid = wgid / nig; u.pm = gid * WGM + ((wgid % nig) % WGM); u.pn = pn0 + (wgid % nig) / WGM; }
        else { const int j = x * 8 + (v - nl); u.pm = 32 + (j & 3); u.pn = j >> 2; }
        u.po = u.pm; u.hf = 0; return true;
    }
    __device__ __forceinline__ void a_ready(const Unit&) const {}
    __device__ __forceinline__ void done(const Unit&) const {}
};
struct MoeOrder {
    const PG8_LAS int* pref; int nN, G, c, a_sparse;
    __device__ __forceinline__ bool next(int i, Unit& u) const {
        const int L = i * G + c, total = pref[32]; if (L >= total * nN) return false;
        const int mt = L / nN, nt = L - mt * nN; int e = 0;
        for (int k = 1; k < 32; ++k) e += (pref[k] <= mt) ? 1 : 0;
        u.pm = a_sparse ? e * 32 + (mt - pref[e]) : mt; u.pn = e * nN + nt; u.po = mt; u.hf = (pref[33 + e] - 256 * (mt - pref[e]) <= 128) ? 1 : 0; return true;
    }
    __device__ __forceinline__ void a_ready(const Unit&) const {}
    __device__ __forceinline__ void done(const Unit&) const {}
};

struct MoeDyn {
    const PG8_LAS int* pref; int nN, a_sparse; unsigned* q; PG8_LAS int* slot; int xcd;
    __device__ __forceinline__ bool next(int i, Unit& u) const {
        if (threadIdx.x == 0) { int id = -1; const unsigned per = (unsigned)((pref[4 * xcd + 4] - pref[4 * xcd]) * nN);
            unsigned v = __hip_atomic_fetch_add(q + 64 * xcd, 1u, __ATOMIC_RELAXED, __HIP_MEMORY_SCOPE_AGENT);
            if (v < per) id = (xcd << 16) | (int)v;
            else {
#pragma unroll 1
                for (int j = 1; j < 8 && id < 0; ++j) { const int x = (xcd + j) & 7; const unsigned perx = (unsigned)((pref[4 * x + 4] - pref[4 * x]) * nN);
                    if (__hip_atomic_load(q + 64 * x, __ATOMIC_RELAXED, __HIP_MEMORY_SCOPE_AGENT) < perx) { v = __hip_atomic_fetch_add(q + 64 * x, 1u, __ATOMIC_RELAXED, __HIP_MEMORY_SCOPE_AGENT); if (v < perx) id = (x << 16) | (int)v; } } }
            slot[i & 1] = id; asm volatile("s_waitcnt lgkmcnt(0)" ::: "memory"); }
        asm volatile("" ::: "memory"); __builtin_amdgcn_s_barrier(); asm volatile("" ::: "memory");
        const int id = slot[i & 1]; if (id < 0) return false;
        int v = id & 0xffff, e = 4 * (id >> 16);
#pragma unroll
        for (int j = 0; j < 3; ++j) { const int ue = (pref[e + 1] - pref[e]) * nN; if (v >= ue) { v -= ue; ++e; } }
        const int T = pref[e + 1] - pref[e], blk = 8 * T, nb = v / blk, r2 = v - nb * blk, mtl = r2 >> 3, nt = nb * 8 + (r2 & 7), mt = pref[e] + mtl;
        u.pm = a_sparse ? e * 32 + mtl : mt; u.pn = e * nN + nt; u.po = mt; u.hf = (pref[33 + e] - 256 * mtl <= 128) ? 1 : 0; return true;
    }
    __device__ __forceinline__ void a_ready(const Unit&) const {}
    __device__ __forceinline__ void done(const Unit&) const {}
};

__device__ __forceinline__ unsigned cvt_pk_bf16(float lo, float hi) { unsigned r; asm volatile("v_cvt_pk_bf16_f32 %0, %1, %2" : "=v"(r) : "v"(lo), "v"(hi)); return r; }
__device__ __forceinline__ float bf_lo(unsigned w) { return __uint_as_float(w << 16); }
__device__ __forceinline__ float bf_hi(unsigned w) { return __uint_as_float(w & 0xffff0000u); }
__device__ __forceinline__ unsigned pk4_fp8(float a, float b, float c, float d) {
    a = fminf(fmaxf(a, -448.f), 448.f); b = fminf(fmaxf(b, -448.f), 448.f); c = fminf(fmaxf(c, -448.f), 448.f); d = fminf(fmaxf(d, -448.f), 448.f);
    int p = __builtin_amdgcn_cvt_pk_fp8_f32(a, b, 0, false); p = __builtin_amdgcn_cvt_pk_fp8_f32(c, d, p, true); return (unsigned)p; }
constexpr float F8_SA = 16.0f, F8_SW = 512.0f, F8_SC = 4.0f;
__device__ __forceinline__ float sigmoidf_(float x) { return __builtin_amdgcn_rcpf(1.0f + __expf(-x)); }

struct EpiBf16 {
    static constexpr bool PERM = true, AFTER_DRAIN = false, CHAIN = false;
    bf16_t* O; int ldc; const float* bias; int ncolt;
    __device__ __forceinline__ void operator()(const f32x4 (&acc)[2][2][4][2], const Unit& u, int wr, int wc, int fr, int fq) const {
        const int row0 = u.po * BM + wr * 64 + fr; const int colt = (u.pn % ncolt) * BM;
        const int col0 = colt + wc * 32 + 8 * fq, bcol0 = u.pn * BM + wc * 32 + 8 * fq;
        f32x4 bv[2][2];
#pragma unroll
        for (int bj = 0; bj < 2; ++bj)
#pragma unroll
            for (int n = 0; n < 2; ++n) bv[bj][n] = bias ? *(const f32x4*)(bias + bcol0 + bj * HALF + 4 * n) : (f32x4){0.f, 0.f, 0.f, 0.f};
#pragma unroll
        for (int ai = 0; ai < 2; ++ai)
#pragma unroll
            for (int m = 0; m < 4; ++m) { bf16_t* rowp = O + (size_t)(row0 + ai * HALF + m * 16) * ldc + col0;
#pragma unroll
                for (int bj = 0; bj < 2; ++bj) { const f32x4 v0 = acc[ai][bj][m][0] + bv[bj][0], v1 = acc[ai][bj][m][1] + bv[bj][1];
                    u32x4 w; w.x = cvt_pk_bf16(v0[0], v0[1]); w.y = cvt_pk_bf16(v0[2], v0[3]); w.z = cvt_pk_bf16(v1[0], v1[1]); w.w = cvt_pk_bf16(v1[2], v1[3]);
                    __builtin_nontemporal_store(w, (u32x4*)(rowp + bj * HALF)); } }
    }
};
struct EpiSwiglu8 {
    static constexpr bool PERM = true, AFTER_DRAIN = false, LDS_BIAS = true;
    unsigned char* O; const float* b1;
    __device__ __forceinline__ void stage_bias(const Unit& u, PG8_LAS unsigned char* dst, int lane) const {
        const int e = u.pn >> 4, nt = u.pn & 15; const float* src = b1 + (size_t)e * 4096 + nt * 128 + (lane < 32 ? 4 * lane : 2048 + 4 * (lane - 32));
        __builtin_amdgcn_global_load_lds((const unsigned*)src, (PG8_LAS unsigned*)dst, 16, 0, 0); }
    __device__ __forceinline__ void operator()(const f32x4 (&acc)[2][2][4][2], const Unit& u, int wr, int wc, int fr, int fq, const PG8_LAS unsigned char* bias) const {
        const int nt = u.pn & 15; const int row0 = u.po * BM + wr * 64 + fr; constexpr float us = 1.0f / (F8_SA * F8_SW);
        const PG8_LAS float* bg = (const PG8_LAS float*)bias + wc * 32 + 8 * fq; const PG8_LAS float* bl = bg + 128;
        unsigned char* obase = O + (size_t)(row0 + (fq & 1) * 16) * 2048 + nt * 128 + wc * 32 + 16 * (fq >> 1);
#pragma unroll
        for (int ai = 0; ai < 2; ++ai)
#pragma unroll
            for (int mp = 0; mp < 2; ++mp) { unsigned w[2][2];
#pragma unroll
                for (int mm = 0; mm < 2; ++mm)
#pragma unroll
                    for (int n = 0; n < 2; ++n) { const int m = 2 * mp + mm; const f32x4 gv = acc[ai][0][m][n] * us + *(const PG8_LAS f32x4*)(bg + 4 * n), lv = acc[ai][1][m][n] * us + *(const PG8_LAS f32x4*)(bl + 4 * n);
                        float o[4];
#pragma unroll
                        for (int i = 0; i < 4; ++i) { const float ga = fminf(gv[i], 7.0f), la = fminf(fmaxf(lv[i], -7.0f), 7.0f); o[i] = ga * sigmoidf_(1.702f * ga) * (la + 1.0f) * F8_SC; }
                        w[mm][n] = pk4_fp8(o[0], o[1], o[2], o[3]); }
                const auto r0 = __builtin_amdgcn_permlane16_swap(w[0][0], w[1][0], false, false), r1 = __builtin_amdgcn_permlane16_swap(w[0][1], w[1][1], false, false);
                const u32x4 ww = {r0[0], r1[0], r0[1], r1[1]};
                *(u32x4*)(obase + (size_t)(ai * HALF + mp * 32) * 2048) = ww; }
    }
};
struct EpiY2f8 {
    static constexpr bool PERM = true, AFTER_DRAIN = false, LDS_BIAS = true;
    bf16_t* O; const float* bias;
    __device__ __forceinline__ void stage_bias(const Unit& u, PG8_LAS unsigned char* dst, int lane) const {
        __builtin_amdgcn_global_load_lds((const unsigned*)(bias + (size_t)u.pn * BM + 4 * lane), (PG8_LAS unsigned*)dst, 16, 0, 0); }
    __device__ __forceinline__ void operator()(const f32x4 (&acc)[2][2][4][2], const Unit& u, int wr, int wc, int fr, int fq, const PG8_LAS unsigned char* lb) const {
        const int row0 = u.po * BM + wr * 64 + fr; const int col0 = (u.pn & 7) * BM + wc * 32 + 8 * fq; constexpr float us = 1.0f / (F8_SC * F8_SW);
        f32x4 bv[2][2];
#pragma unroll
        for (int bj = 0; bj < 2; ++bj)
#pragma unroll
            for (int n = 0; n < 2; ++n) bv[bj][n] = *(const PG8_LAS f32x4*)((const PG8_LAS float*)lb + wc * 32 + 8 * fq + bj * HALF + 4 * n);
#pragma unroll
        for (int ai = 0; ai < 2; ++ai)
#pragma unroll
            for (int m = 0; m < 4; ++m) { bf16_t* rowp = O + (size_t)(row0 + ai * HALF + m * 16) * 2048 + col0;
#pragma unroll
                for (int bj = 0; bj < 2; ++bj) { const f32x4 v0 = acc[ai][bj][m][0] * us + bv[bj][0], v1 = acc[ai][bj][m][1] * us + bv[bj][1];
                    u32x4 w; w.x = cvt_pk_bf16(v0[0], v0[1]); w.y = cvt_pk_bf16(v0[2], v0[3]); w.z = cvt_pk_bf16(v1[0], v1[1]); w.w = cvt_pk_bf16(v1[2], v1[3]);
                    __builtin_nontemporal_store(w, (u32x4*)(rowp + bj * HALF)); } }
    }
};
struct EpiGate8 {
    static constexpr bool PERM = true, AFTER_DRAIN = false, LDS_BIAS = false;
    bf16_t* O; int ldc;
    __device__ __forceinline__ void operator()(const f32x4 (&acc)[2][2][4][2], const Unit& u, int wr, int wc, int fr, int fq) const {
        const int row0 = u.po * BM + wr * 64 + fr, col0 = (u.pn < 24 ? u.pn : u.pn + 8) * BM + wc * 32 + 8 * fq; constexpr float us = 1.0f / (F8_SA * F8_SW);
#pragma unroll
        for (int ai = 0; ai < 2; ++ai)
#pragma unroll
            for (int m = 0; m < 4; ++m) { bf16_t* rowp = O + (size_t)(row0 + ai * HALF + m * 16) * ldc + col0;
#pragma unroll
                for (int bj = 0; bj < 2; ++bj) { const f32x4 v0 = acc[ai][bj][m][0] * us, v1 = acc[ai][bj][m][1] * us;
                    u32x4 w; w.x = cvt_pk_bf16(v0[0], v0[1]); w.y = cvt_pk_bf16(v0[2], v0[3]); w.z = cvt_pk_bf16(v1[0], v1[1]); w.w = cvt_pk_bf16(v1[2], v1[3]);
                    __builtin_nontemporal_store(w, (u32x4*)(rowp + bj * HALF)); } }
    }
};
struct EpiF32 {
    static constexpr bool PERM = false, AFTER_DRAIN = false;
    float* C; int ldc;
    __device__ __forceinline__ void operator()(const f32x4 (&acc)[2][2][4][2], const Unit& u, int wr, int wc, int fr, int fq) const {
        const int row0 = u.po * BM + wr * 64 + fr, col0 = u.pn * BM + wc * 32 + 4 * fq;
#pragma unroll
        for (int ai = 0; ai < 2; ++ai)
#pragma unroll
            for (int m = 0; m < 4; ++m) { float* rowp = C + (size_t)(row0 + ai * HALF + m * 16) * ldc + col0;
#pragma unroll
                for (int bj = 0; bj < 2; ++bj)
#pragma unroll
                    for (int n = 0; n < 2; ++n) *(f32x4*)(rowp + bj * HALF + n * 16) = acc[ai][bj][m][n]; }
    }
};
struct EpiMerge {
    static constexpr bool PERM = true, AFTER_DRAIN = false;
    bf16_t* O; const bf16_t* Z; int ldz, ga_off, gb_off; const bf16_t* YB;
    __device__ __forceinline__ void operator()(const f32x4 (&acc)[2][2][4][2], const Unit& u, int wr, int wc, int fr, int fq) const {
        const int row0 = u.po * BM + wr * 64 + fr, col0 = u.pn * BM + wc * 32 + 8 * fq;
#pragma unroll
        for (int ai = 0; ai < 2; ++ai)
#pragma unroll
            for (int m = 0; m < 4; ++m) { const size_t row = (size_t)(row0 + ai * HALF + m * 16);
#pragma unroll
                for (int bj = 0; bj < 2; ++bj) { const int col = col0 + bj * HALF;
                    const u32x4 ga = *(const u32x4*)(Z + row * ldz + ga_off + col), gb = *(const u32x4*)(Z + row * ldz + gb_off + col);
                    const u32x4 yw = *(const u32x4*)(YB + row * 2048 + col); const f32x4 y0 = {bf_lo(yw.x), bf_hi(yw.x), bf_lo(yw.y), bf_hi(yw.y)}, y1 = {bf_lo(yw.z), bf_hi(yw.z), bf_lo(yw.w), bf_hi(yw.w)};
                    const f32x4 a0 = acc[ai][bj][m][0], a1 = acc[ai][bj][m][1];
                    float o[8];
                    o[0] = sigmoidf_(bf_lo(ga.x)) * a0[0] + sigmoidf_(bf_lo(gb.x)) * y0[0]; o[1] = sigmoidf_(bf_hi(ga.x)) * a0[1] + sigmoidf_(bf_hi(gb.x)) * y0[1];
                    o[2] = sigmoidf_(bf_lo(ga.y)) * a0[2] + sigmoidf_(bf_lo(gb.y)) * y0[2]; o[3] = sigmoidf_(bf_hi(ga.y)) * a0[3] + sigmoidf_(bf_hi(gb.y)) * y0[3];
                    o[4] = sigmoidf_(bf_lo(ga.z)) * a1[0] + sigmoidf_(bf_lo(gb.z)) * y1[0]; o[5] = sigmoidf_(bf_hi(ga.z)) * a1[1] + sigmoidf_(bf_hi(gb.z)) * y1[1];
                    o[6] = sigmoidf_(bf_lo(ga.w)) * a1[2] + sigmoidf_(bf_lo(gb.w)) * y1[2]; o[7] = sigmoidf_(bf_hi(ga.w)) * a1[3] + sigmoidf_(bf_hi(gb.w)) * y1[3];
                    u32x4 w; w.x = cvt_pk_bf16(o[0], o[1]); w.y = cvt_pk_bf16(o[2], o[3]); w.z = cvt_pk_bf16(o[4], o[5]); w.w = cvt_pk_bf16(o[6], o[7]);
                    *(u32x4*)(O + row * 2048 + col) = w; } }
    }
};
struct EpiMerge2 {
    static constexpr bool PERM = true, AFTER_DRAIN = false, CHAIN = true;
    bf16_t* O; const bf16_t* Z; int ldz, ga_off, gb_off;
    __device__ __forceinline__ void mid(f32x4 (&acc)[2][2][4][2], const Unit& u, int wr, int wc, int fr, int fq) const {
        const int row0 = u.po * BM + wr * 64 + fr, col0 = (u.pn & 7) * BM + wc * 32 + 8 * fq;
#pragma unroll
        for (int ai = 0; ai < 2; ++ai)
#pragma unroll
            for (int m = 0; m < 4; ++m) { const size_t row = (size_t)(row0 + ai * HALF + m * 16);
#pragma unroll
                for (int bj = 0; bj < 2; ++bj) { const int col = col0 + bj * HALF;
                    const u32x4 ga = *(const u32x4*)(Z + row * ldz + ga_off + col), gb = *(const u32x4*)(Z + row * ldz + gb_off + col);
                    float r[8];
                    r[0] = (1.0f + __expf(-bf_lo(gb.x))) * __builtin_amdgcn_rcpf(1.0f + __expf(-bf_lo(ga.x))); r[1] = (1.0f + __expf(-bf_hi(gb.x))) * __builtin_amdgcn_rcpf(1.0f + __expf(-bf_hi(ga.x)));
                    r[2] = (1.0f + __expf(-bf_lo(gb.y))) * __builtin_amdgcn_rcpf(1.0f + __expf(-bf_lo(ga.y))); r[3] = (1.0f + __expf(-bf_hi(gb.y))) * __builtin_amdgcn_rcpf(1.0f + __expf(-bf_hi(ga.y)));
                    r[4] = (1.0f + __expf(-bf_lo(gb.z))) * __builtin_amdgcn_rcpf(1.0f + __expf(-bf_lo(ga.z))); r[5] = (1.0f + __expf(-bf_hi(gb.z))) * __builtin_amdgcn_rcpf(1.0f + __expf(-bf_hi(ga.z)));
                    r[6] = (1.0f + __expf(-bf_lo(gb.w))) * __builtin_amdgcn_rcpf(1.0f + __expf(-bf_lo(ga.w))); r[7] = (1.0f + __expf(-bf_hi(gb.w))) * __builtin_amdgcn_rcpf(1.0f + __expf(-bf_hi(ga.w)));
                    acc[ai][bj][m][0] = acc[ai][bj][m][0] * (f32x4){r[0], r[1], r[2], r[3]}; acc[ai][bj][m][1] = acc[ai][bj][m][1] * (f32x4){r[4], r[5], r[6], r[7]}; } }
    }
    __device__ __forceinline__ void operator()(const f32x4 (&acc)[2][2][4][2], const Unit& u, int wr, int wc, int fr, int fq) const {
        const int row0 = u.po * BM + wr * 64 + fr, col0 = (u.pn & 7) * BM + wc * 32 + 8 * fq;
#pragma unroll
        for (int ai = 0; ai < 2; ++ai)
#pragma unroll
            for (int m = 0; m < 4; ++m) { const size_t row = (size_t)(row0 + ai * HALF + m * 16);
#pragma unroll
                for (int bj = 0; bj < 2; ++bj) { const int col = col0 + bj * HALF;
                    const u32x4 gb = *(const u32x4*)(Z + row * ldz + gb_off + col);
                    const f32x4 a0 = acc[ai][bj][m][0], a1 = acc[ai][bj][m][1];
                    float o[8];
                    o[0] = sigmoidf_(bf_lo(gb.x)) * a0[0]; o[1] = sigmoidf_(bf_hi(gb.x)) * a0[1]; o[2] = sigmoidf_(bf_lo(gb.y)) * a0[2]; o[3] = sigmoidf_(bf_hi(gb.y)) * a0[3];
                    o[4] = sigmoidf_(bf_lo(gb.z)) * a1[0]; o[5] = sigmoidf_(bf_hi(gb.z)) * a1[1]; o[6] = sigmoidf_(bf_lo(gb.w)) * a1[2]; o[7] = sigmoidf_(bf_hi(gb.w)) * a1[3];
                    u32x4 w; w.x = cvt_pk_bf16(o[0], o[1]); w.y = cvt_pk_bf16(o[2], o[3]); w.z = cvt_pk_bf16(o[4], o[5]); w.w = cvt_pk_bf16(o[6], o[7]);
                    *(u32x4*)(O + row * 2048 + col) = w; } }
    }
};
struct EpiX1 {
    static constexpr bool PERM = false, AFTER_DRAIN = false, CHAIN = false;
    float* X1; const float* X; const float* mod;
    __device__ __forceinline__ void operator()(const f32x4 (&acc)[2][2][4][2], const Unit& u, int wr, int wc, int fr, int fq) const {
        const int row0 = u.po * BM + wr * 64 + fr, col0 = u.pn * BM + wc * 32 + 4 * fq;
        const float* mg = mod + (size_t)((u.po * BM) >> 11) * 12288 + 2 * 2048;
#pragma unroll
        for (int bj = 0; bj < 2; ++bj)
#pragma unroll
            for (int n = 0; n < 2; ++n) { const int col = col0 + bj * HALF + n * 16; const f32x4 g = *(const f32x4*)(mg + col);
#pragma unroll
                for (int ai = 0; ai < 2; ++ai)
#pragma unroll
                    for (int m = 0; m < 4; ++m) { const size_t off = (size_t)(row0 + ai * HALF + m * 16) * 2048 + col;
                        *(f32x4*)(X1 + off) = *(const f32x4*)(X + off) + g * acc[ai][bj][m][n]; } }
    }
};
struct EpiSwiglu {
    static constexpr bool PERM = true, AFTER_DRAIN = false;
    bf16_t* O; const float* b1;
    __device__ __forceinline__ void operator()(const f32x4 (&acc)[2][2][4][2], const Unit& u, int wr, int wc, int fr, int fq) const {
        const int e = u.pn >> 4, nt = u.pn & 15; const int row0 = u.po * BM + wr * 64 + fr, j0 = nt * 128 + wc * 32 + 8 * fq;
        const float* bg = b1 + (size_t)e * 4096 + j0; const float* bl = bg + 2048;
#pragma unroll
        for (int ai = 0; ai < 2; ++ai)
#pragma unroll
            for (int m = 0; m < 4; ++m) { const size_t row = (size_t)(row0 + ai * HALF + m * 16);
                asm volatile("" ::: "memory");
#pragma unroll
                for (int n = 0; n < 2; ++n) { const f32x4 gv = acc[ai][0][m][n] + *(const f32x4*)(bg + 4 * n), lv = acc[ai][1][m][n] + *(const f32x4*)(bl + 4 * n);
                    float o[4];
#pragma unroll
                    for (int i = 0; i < 4; ++i) { const float ga = fminf(gv[i], 7.0f), la = fminf(fmaxf(lv[i], -7.0f), 7.0f); o[i] = ga * sigmoidf_(1.702f * ga) * (la + 1.0f); }
                    typedef unsigned u32x2 __attribute__((ext_vector_type(2))); u32x2 w; w.x = cvt_pk_bf16(o[0], o[1]); w.y = cvt_pk_bf16(o[2], o[3]);
                    *(u32x2*)(O + row * 2048 + j0 + 4 * n) = w; } }
    }
};

template <class Epi, class Sched, bool ALIGN_EPI = false, bool SP2 = false, bool HALFSKIP = false>
__device__ __forceinline__ void gemm_phase(PG8_LAS unsigned char* lds, const Gemm g, const Sched& S, const Epi& E) {
    const int tid = threadIdx.x, wid = __builtin_amdgcn_readfirstlane(tid >> 6), lane = tid & 63, wr = wid >> 2, wc = wid & 3, fr = lane & 15, fq = lane >> 4;
    const int K = g.K, nt = K / BK;
    unsigned voffA[2], voffB[2];
#pragma unroll
    for (int i = 0; i < 2; ++i) { int R, C; stage_rc(tid * 16 + i * 8192, R, C); const int Rb = Epi::PERM ? ((R & ~31) + perm32(R & 31)) : R;
        voffA[i] = (unsigned)(R * K + C) * 2u; voffB[i] = (unsigned)(Rb * K + C) * 2u; }
    const size_t kstep = (size_t)(BK * 2);
    const size_t hstep = (size_t)HALF * K * 2;
    const size_t tstep = 2 * hstep;
    const unsigned ldsw = (unsigned)wid * 1024u;
    const int aoff = lds_byte(wr * 64 + fr, fq * 8), boff = lds_byte(wc * 32 + fr, fq * 8);
#define PG8_SA(b, h) (((b) * 2 + (h)) * HTB)
#define PG8_SB(b, h) ((4 + (b) * 2 + (h)) * HTB)
#define PG8_STAGE(bufoff, gbase, voff) do { _Pragma("unroll") for (int _i = 0; _i < 2; ++_i) \
        __builtin_amdgcn_global_load_lds((const unsigned*)((const char*)(gbase) + (voff)[_i]), (PG8_LAS unsigned*)(lds + (bufoff) + ldsw + _i * 8192), 16, 0, 0); } while (0)
#define PG8_LDA(dst, b, h) do { _Pragma("unroll") for (int m = 0; m < 4; ++m) _Pragma("unroll") for (int k = 0; k < 2; ++k) dst[m][k] = *(const PG8_LAS bf16x8*)(lds + PG8_SA(b, h) + aoff + m * 2048 + k * 1024); } while (0)
#define PG8_LDB(dst, b, h) do { _Pragma("unroll") for (int n = 0; n < 2; ++n) _Pragma("unroll") for (int k = 0; k < 2; ++k) dst[n][k] = *(const PG8_LAS bf16x8*)(lds + PG8_SB(b, h) + boff + n * 2048 + k * 1024); } while (0)
#define PG8_MMA(ai, bj, At, Bt) do { __builtin_amdgcn_s_setprio(1); _Pragma("unroll") for (int m = 0; m < 4; ++m) _Pragma("unroll") for (int n = 0; n < 2; ++n) _Pragma("unroll") for (int k = 0; k < 2; ++k) \
        acc[ai][bj][m][n] = __builtin_amdgcn_mfma_f32_16x16x32_bf16(Bt[n][k], At[m][k], acc[ai][bj][m][n], 0, 0, 0); __builtin_amdgcn_s_setprio(0); } while (0)
#define PG8_WAIT_V(n) asm volatile("s_waitcnt vmcnt(" #n ")" ::: "memory")
#define PG8_WAIT_L(n) asm volatile("s_waitcnt lgkmcnt(" #n ")" ::: "memory")
#define PG8_BAR __builtin_amdgcn_s_barrier()
#define PG8_SCHED __builtin_amdgcn_sched_barrier(0)
    Unit cur, nxt; int ui = 0;
    if (!S.next(0, cur)) return;
    f32x4 acc[2][2][4][2];
#pragma unroll
    for (int a = 0; a < 2; ++a)
#pragma unroll
        for (int b = 0; b < 2; ++b)
#pragma unroll
            for (int m = 0; m < 4; ++m)
#pragma unroll
                for (int n = 0; n < 2; ++n) acc[a][b][m][n] = (f32x4){0.f, 0.f, 0.f, 0.f};
    bf16x8 At[4][2], B0[2][2], B1[2][2];
    const char* cA = (const char*)g.A + (size_t)cur.pm * tstep; const char* cB = (const char*)g.Bt + (size_t)cur.pn * tstep;
    S.a_ready(cur);
    if constexpr (SP2) {
        PG8_STAGE(PG8_SB(0, 0), cB, voffB); PG8_STAGE(PG8_SB(0, 1), cB + hstep, voffB); PG8_STAGE(PG8_SA(0, 0), cA, voffA); PG8_STAGE(PG8_SA(0, 1), cA + hstep, voffA);
        if (wr == 1) PG8_BAR;
        PG8_WAIT_V(2); PG8_BAR;
        PG8_STAGE(PG8_SB(1, 0), cB + kstep, voffB); PG8_STAGE(PG8_SA(1, 0), cA + kstep, voffA); PG8_STAGE(PG8_SB(1, 1), cB + hstep + kstep, voffB);
        PG8_WAIT_V(6); PG8_BAR;
    } else {
        PG8_STAGE(PG8_SB(0, 0), cB, voffB); PG8_STAGE(PG8_SA(0, 0), cA, voffA); PG8_STAGE(PG8_SB(0, 1), cB + hstep, voffB); PG8_STAGE(PG8_SA(0, 1), cA + hstep, voffA);
        if (wr == 1) PG8_BAR;
        PG8_WAIT_V(4); PG8_BAR;
        PG8_STAGE(PG8_SB(1, 0), cB + kstep, voffB); PG8_STAGE(PG8_SA(1, 0), cA + kstep, voffA); PG8_STAGE(PG8_SB(1, 1), cB + hstep + kstep, voffB);
        PG8_WAIT_V(6); PG8_BAR;
    }
    for (;;) {
        const bool has_next = S.next(ui + 1, nxt);
        const char* nA = has_next ? (const char*)g.A + (size_t)nxt.pm * tstep : cA; const char* nB = has_next ? (const char*)g.Bt + (size_t)nxt.pn * tstep : cB;
        for (int t = 0; t < nt; t += 2) {
            const bool last = (t == nt - 2);
            const char* a1 = cA + (size_t)(t + 1) * kstep;
            const char* a2 = last ? nA : cA + (size_t)(t + 2) * kstep; const char* b2 = last ? nB : cB + (size_t)(t + 2) * kstep;
            const char* a3 = a2 + kstep; const char* b3 = b2 + kstep;
            if (last && has_next) S.a_ready(nxt);
            if constexpr (SP2) {
            PG8_LDB(B0, 0, 0); PG8_LDB(B1, 0, 1); PG8_SCHED; PG8_LDA(At, 0, 0); PG8_STAGE(PG8_SA(1, 1), a1 + hstep, voffA);
            PG8_WAIT_V(8); PG8_WAIT_L(0); PG8_BAR; PG8_MMA(0, 0, At, B0); PG8_MMA(0, 1, At, B1); PG8_BAR; PG8_SCHED;
            PG8_LDA(At, 0, 1); PG8_STAGE(PG8_SB(0, 0), b2, voffB); PG8_STAGE(PG8_SB(0, 1), b2 + hstep, voffB); PG8_STAGE(PG8_SA(0, 0), a2, voffA);
            PG8_WAIT_V(8); PG8_WAIT_L(0); PG8_BAR; if (!(HALFSKIP && cur.hf)) { PG8_MMA(1, 0, At, B0); PG8_MMA(1, 1, At, B1); } PG8_BAR; PG8_SCHED;
            PG8_LDB(B0, 1, 0); PG8_LDB(B1, 1, 1); PG8_SCHED; PG8_LDA(At, 1, 0); PG8_STAGE(PG8_SA(0, 1), a2 + hstep, voffA);
            PG8_WAIT_V(8); PG8_WAIT_L(0); PG8_BAR; PG8_MMA(0, 0, At, B0); PG8_MMA(0, 1, At, B1); PG8_BAR; PG8_SCHED;
            PG8_LDA(At, 1, 1); PG8_STAGE(PG8_SB(1, 0), b3, voffB); PG8_STAGE(PG8_SB(1, 1), b3 + hstep, voffB); PG8_STAGE(PG8_SA(1, 0), a3, voffA);
            PG8_WAIT_V(8); PG8_WAIT_L(0); PG8_BAR; if (!(HALFSKIP && cur.hf)) { PG8_MMA(1, 0, At, B0); PG8_MMA(1, 1, At, B1); } PG8_BAR; PG8_SCHED;
            } else {
            PG8_LDB(B0, 0, 0); PG8_SCHED; PG8_LDA(At, 0, 0); PG8_STAGE(PG8_SA(1, 1), a1 + hstep, voffA);
            PG8_WAIT_L(8); PG8_BAR; PG8_WAIT_L(0); PG8_MMA(0, 0, At, B0); PG8_BAR; PG8_SCHED;
            PG8_LDB(B1, 0, 1); PG8_STAGE(PG8_SB(0, 0), b2, voffB);
            PG8_BAR; PG8_WAIT_L(0); PG8_MMA(0, 1, At, B1); PG8_BAR;
            PG8_LDA(At, 0, 1); PG8_STAGE(PG8_SA(0, 0), a2, voffA);
            PG8_BAR; PG8_WAIT_L(0); PG8_MMA(1, 0, At, B0); PG8_BAR; PG8_SCHED;
            PG8_STAGE(PG8_SB(0, 1), b2 + hstep, voffB);
            PG8_WAIT_V(6); PG8_BAR; PG8_MMA(1, 1, At, B1); PG8_BAR;
            PG8_LDB(B0, 1, 0); PG8_SCHED; PG8_LDA(At, 1, 0); PG8_STAGE(PG8_SA(0, 1), a2 + hstep, voffA);
            PG8_WAIT_L(8); PG8_BAR; PG8_WAIT_L(0); PG8_MMA(0, 0, At, B0); PG8_BAR; PG8_SCHED;
            PG8_LDB(B1, 1, 1); PG8_STAGE(PG8_SB(1, 0), b3, voffB);
            PG8_BAR; PG8_WAIT_L(0); PG8_MMA(0, 1, At, B1); PG8_BAR;
            PG8_LDA(At, 1, 1); PG8_STAGE(PG8_SA(1, 0), a3, voffA);
            PG8_BAR; PG8_WAIT_L(0); PG8_MMA(1, 0, At, B0); PG8_BAR; PG8_SCHED;
            PG8_STAGE(PG8_SB(1, 1), b3 + hstep, voffB);
            PG8_WAIT_V(6); PG8_BAR; PG8_MMA(1, 1, At, B1); PG8_BAR;
            }
        }
        if constexpr (ALIGN_EPI) { if (wr == 0) PG8_BAR; }
        if constexpr (Epi::CHAIN) { if (cur.hf == 0) E.mid(acc, cur, wr, wc, fr, fq); else E(acc, cur, wr, wc, fr, fq); }
        else if constexpr (!Epi::AFTER_DRAIN) { E(acc, cur, wr, wc, fr, fq); S.done(cur); }
        if (!has_next) break;
        bool keep = false; if constexpr (Epi::CHAIN) keep = cur.hf == 0;
        if (!keep) {
#pragma unroll
        for (int a = 0; a < 2; ++a)
#pragma unroll
            for (int b = 0; b < 2; ++b)
#pragma unroll
                for (int m = 0; m < 4; ++m)
#pragma unroll
                    for (int n = 0; n < 2; ++n) acc[a][b][m][n] = (f32x4){0.f, 0.f, 0.f, 0.f};
        }
        cur = nxt; cA = nA; cB = nB; ++ui;
        if constexpr (ALIGN_EPI) { if (wr == 1) PG8_BAR; }
    }
    PG8_WAIT_V(0);
    if constexpr (!ALIGN_EPI) { if (wr == 0) PG8_BAR; }
    PG8_BAR;
    if constexpr (Epi::AFTER_DRAIN) { E.fused(acc, cur, wr, wc, fr, fq, lds, wid, lane); S.done(cur); }
#undef PG8_SA
#undef PG8_SB
#undef PG8_STAGE
#undef PG8_LDA
#undef PG8_LDB
#undef PG8_MMA
#undef PG8_WAIT_V
#undef PG8_WAIT_L
#undef PG8_BAR
#undef PG8_SCHED
}
template <class Epi, class Sched, bool ALIGN_EPI = false, bool SP2 = false, bool HALFSKIP = false>
__device__ __forceinline__ void gemm_phase8(PG8_LAS unsigned char* lds, const Gemm g, const Sched& S, const Epi& E) {
    const int tid = threadIdx.x, wid = __builtin_amdgcn_readfirstlane(tid >> 6), lane = tid & 63, wr = wid >> 2, wc = wid & 3, fr = lane & 15, fq = lane >> 4;
    const int K = g.K, nt = K / 128;
    unsigned voffA[2], voffB[2];
#pragma unroll
    for (int i = 0; i < 2; ++i) { int R, C; stage_rc(tid * 16 + i * 8192, R, C); const int Rb = Epi::PERM ? ((R & ~31) + perm32(R & 31)) : R;
        voffA[i] = (unsigned)(R * K + 2 * C); voffB[i] = (unsigned)(Rb * K + 2 * C); }
    const size_t kstep = (size_t)(BK * 2);
    const size_t hstep = (size_t)HALF * K;
    const size_t tstep = 2 * hstep;
    const unsigned ldsw = (unsigned)wid * 1024u;
    const int aoff = lds_byte(wr * 64 + fr, fq * 8), boff = lds_byte(wc * 32 + fr, fq * 8);
#define PG8_SA(b, h) (((b) * 2 + (h)) * HTB)
#define PG8_SB(b, h) ((4 + (b) * 2 + (h)) * HTB)
#define PG8_STAGE(bufoff, gbase, voff) do { _Pragma("unroll") for (int _i = 0; _i < 2; ++_i) \
        __builtin_amdgcn_global_load_lds((const unsigned*)((const char*)(gbase) + (voff)[_i]), (PG8_LAS unsigned*)(lds + (bufoff) + ldsw + _i * 8192), 16, 0, 0); } while (0)
#define PG8_LDA(dst, b, h) do { _Pragma("unroll") for (int m = 0; m < 4; ++m) { const i32x4 lo_ = *(const PG8_LAS i32x4*)(lds + PG8_SA(b, h) + aoff + m * 2048), hi_ = *(const PG8_LAS i32x4*)(lds + PG8_SA(b, h) + aoff + m * 2048 + 1024); dst[m] = __builtin_shufflevector(lo_, hi_, 0, 1, 2, 3, 4, 5, 6, 7); } } while (0)
#define PG8_LDB(dst, b, h) do { _Pragma("unroll") for (int n = 0; n < 2; ++n) { const i32x4 lo_ = *(const PG8_LAS i32x4*)(lds + PG8_SB(b, h) + boff + n * 2048), hi_ = *(const PG8_LAS i32x4*)(lds + PG8_SB(b, h) + boff + n * 2048 + 1024); dst[n] = __builtin_shufflevector(lo_, hi_, 0, 1, 2, 3, 4, 5, 6, 7); } } while (0)
#define PG8_MMA(ai, bj, At, Bt) do { __builtin_amdgcn_s_setprio(1); _Pragma("unroll") for (int m = 0; m < 4; ++m) _Pragma("unroll") for (int n = 0; n < 2; ++n) \
        asm volatile("v_mfma_scale_f32_16x16x128_f8f6f4 %0, %1, %2, %0, %3, %3 op_sel_hi:[0,0,0]" : "+v"(acc[ai][bj][m][n]) : "v"(Bt[n]), "v"(At[m]), "v"(sc127)); __builtin_amdgcn_s_setprio(0); } while (0)
#define PG8_WAIT_V(n) asm volatile("s_waitcnt vmcnt(" #n ")" ::: "memory")
#define PG8_WAIT_L(n) asm volatile("s_waitcnt lgkmcnt(" #n ")" ::: "memory")
#define PG8_BAR __builtin_amdgcn_s_barrier()
#define PG8_SCHED __builtin_amdgcn_sched_barrier(0)
    Unit cur, nxt; int ui = 0;
    if (!S.next(0, cur)) return;
    f32x4 acc[2][2][4][2];
#pragma unroll
    for (int a = 0; a < 2; ++a)
#pragma unroll
        for (int b = 0; b < 2; ++b)
#pragma unroll
            for (int m = 0; m < 4; ++m)
#pragma unroll
                for (int n = 0; n < 2; ++n) acc[a][b][m][n] = (f32x4){0.f, 0.f, 0.f, 0.f};
    i32x8 At[4], B0[2], B1[2]; const int sc127 = 127;
    const char* cA = (const char*)g.A + (size_t)cur.pm * tstep; const char* cB = (const char*)g.Bt + (size_t)cur.pn * tstep;
    S.a_ready(cur);
    constexpr int BIAS_OFF = 8 * HTB;
    if constexpr (Epi::LDS_BIAS) { if (wid == 0) E.stage_bias(cur, lds + BIAS_OFF, lane); }
    if constexpr (SP2) {
        PG8_STAGE(PG8_SB(0, 0), cB, voffB); PG8_STAGE(PG8_SB(0, 1), cB + hstep, voffB); PG8_STAGE(PG8_SA(0, 0), cA, voffA); PG8_STAGE(PG8_SA(0, 1), cA + hstep, voffA);
        if (wr == 1) PG8_BAR;
        PG8_WAIT_V(2); PG8_BAR;
        PG8_STAGE(PG8_SB(1, 0), cB + kstep, voffB); PG8_STAGE(PG8_SA(1, 0), cA + kstep, voffA); PG8_STAGE(PG8_SB(1, 1), cB + hstep + kstep, voffB);
        PG8_WAIT_V(6); PG8_BAR;
    } else {
        PG8_STAGE(PG8_SB(0, 0), cB, voffB); PG8_STAGE(PG8_SA(0, 0), cA, voffA); PG8_STAGE(PG8_SB(0, 1), cB + hstep, voffB); PG8_STAGE(PG8_SA(0, 1), cA + hstep, voffA);
        if (wr == 1) PG8_BAR;
        PG8_WAIT_V(4); PG8_BAR;
        PG8_STAGE(PG8_SB(1, 0), cB + kstep, voffB); PG8_STAGE(PG8_SA(1, 0), cA + kstep, voffA); PG8_STAGE(PG8_SB(1, 1), cB + hstep + kstep, voffB);
        PG8_WAIT_V(6); PG8_BAR;
    }
    for (;;) {
        const bool has_next = S.next(ui + 1, nxt);
        const char* nA = has_next ? (const char*)g.A + (size_t)nxt.pm * tstep : cA; const char* nB = has_next ? (const char*)g.Bt + (size_t)nxt.pn * tstep : cB;
        for (int t = 0; t < nt; t += 2) {
            const bool last = (t == nt - 2);
            const char* a1 = cA + (size_t)(t + 1) * kstep;
            const char* a2 = last ? nA : cA + (size_t)(t + 2) * kstep; const char* b2 = last ? nB : cB + (size_t)(t + 2) * kstep;
            const char* a3 = a2 + kstep; const char* b3 = b2 + kstep;
            if (last && has_next) S.a_ready(nxt);
            if constexpr (SP2) {
            PG8_LDB(B0, 0, 0); PG8_LDB(B1, 0, 1); PG8_SCHED; PG8_LDA(At, 0, 0); PG8_STAGE(PG8_SA(1, 1), a1 + hstep, voffA);
            PG8_WAIT_V(8); PG8_WAIT_L(0); PG8_BAR; PG8_MMA(0, 0, At, B0); PG8_MMA(0, 1, At, B1); PG8_BAR; PG8_SCHED;
            if (!(HALFSKIP && cur.hf)) PG8_LDA(At, 0, 1); PG8_STAGE(PG8_SB(0, 0), b2, voffB); PG8_STAGE(PG8_SB(0, 1), b2 + hstep, voffB); PG8_STAGE(PG8_SA(0, 0), a2, voffA);
            PG8_WAIT_V(8); PG8_WAIT_L(0); PG8_BAR; if (!(HALFSKIP && cur.hf)) { PG8_MMA(1, 0, At, B0); PG8_MMA(1, 1, At, B1); } PG8_BAR; PG8_SCHED;
            PG8_LDB(B0, 1, 0); PG8_LDB(B1, 1, 1); PG8_SCHED; PG8_LDA(At, 1, 0); PG8_STAGE(PG8_SA(0, 1), a2 + hstep, voffA);
            PG8_WAIT_V(8); PG8_WAIT_L(0); PG8_BAR; PG8_MMA(0, 0, At, B0); PG8_MMA(0, 1, At, B1); PG8_BAR; PG8_SCHED;
            if (!(HALFSKIP && cur.hf)) PG8_LDA(At, 1, 1); PG8_STAGE(PG8_SB(1, 0), b3, voffB); PG8_STAGE(PG8_SB(1, 1), b3 + hstep, voffB); PG8_STAGE(PG8_SA(1, 0), a3, voffA);
            PG8_WAIT_V(8); PG8_WAIT_L(0); PG8_BAR; if (!(HALFSKIP && cur.hf)) { PG8_MMA(1, 0, At, B0); PG8_MMA(1, 1, At, B1); } PG8_BAR; PG8_SCHED;
            } else {
            PG8_LDB(B0, 0, 0); PG8_SCHED; PG8_LDA(At, 0, 0); PG8_STAGE(PG8_SA(1, 1), a1 + hstep, voffA);
            PG8_WAIT_L(8); PG8_BAR; PG8_WAIT_L(0); PG8_MMA(0, 0, At, B0); PG8_BAR; PG8_SCHED;
            PG8_LDB(B1, 0, 1); PG8_STAGE(PG8_SB(0, 0), b2, voffB);
            PG8_BAR; PG8_WAIT_L(0); PG8_MMA(0, 1, At, B1); PG8_BAR;
            PG8_LDA(At, 0, 1); PG8_STAGE(PG8_SA(0, 0), a2, voffA);
            PG8_BAR; PG8_WAIT_L(0); PG8_MMA(1, 0, At, B0); PG8_BAR; PG8_SCHED;
            PG8_STAGE(PG8_SB(0, 1), b2 + hstep, voffB);
            PG8_WAIT_V(6); PG8_BAR; PG8_MMA(1, 1, At, B1); PG8_BAR;
            PG8_LDB(B0, 1, 0); PG8_SCHED; PG8_LDA(At, 1, 0); PG8_STAGE(PG8_SA(0, 1), a2 + hstep, voffA);
            PG8_WAIT_L(8); PG8_BAR; PG8_WAIT_L(0); PG8_MMA(0, 0, At, B0); PG8_BAR; PG8_SCHED;
            PG8_LDB(B1, 1, 1); PG8_STAGE(PG8_SB(1, 0), b3, voffB);
            PG8_BAR; PG8_WAIT_L(0); PG8_MMA(0, 1, At, B1); PG8_BAR;
            PG8_LDA(At, 1, 1); PG8_STAGE(PG8_SA(1, 0), a3, voffA);
            PG8_BAR; PG8_WAIT_L(0); PG8_MMA(1, 0, At, B0); PG8_BAR; PG8_SCHED;
            PG8_STAGE(PG8_SB(1, 1), b3 + hstep, voffB);
            PG8_WAIT_V(6); PG8_BAR; PG8_MMA(1, 1, At, B1); PG8_BAR;
            }
        }
        if constexpr (ALIGN_EPI) { if (wr == 0) PG8_BAR; }
        if constexpr (!Epi::AFTER_DRAIN) { if constexpr (Epi::LDS_BIAS) E(acc, cur, wr, wc, fr, fq, lds + BIAS_OFF + (ui & 1) * 1024); else E(acc, cur, wr, wc, fr, fq); S.done(cur); }
        if (!has_next) break;
#pragma unroll
        for (int a = 0; a < 2; ++a)
#pragma unroll
            for (int b = 0; b < 2; ++b)
#pragma unroll
                for (int m = 0; m < 4; ++m)
#pragma unroll
                    for (int n = 0; n < 2; ++n) acc[a][b][m][n] = (f32x4){0.f, 0.f, 0.f, 0.f};
        cur = nxt; cA = nA; cB = nB; ++ui;
        if constexpr (Epi::LDS_BIAS) { if (wid == 0) E.stage_bias(cur, lds + BIAS_OFF + (ui & 1) * 1024, lane); }
        if constexpr (ALIGN_EPI) { if (wr == 1) PG8_BAR; }
    }
    PG8_WAIT_V(0);
    if constexpr (!ALIGN_EPI) { if (wr == 0) PG8_BAR; }
    PG8_BAR;
    if constexpr (Epi::AFTER_DRAIN) { E.fused(acc, cur, wr, wc, fr, fq, lds, wid, lane); S.done(cur); }
#undef PG8_SA
#undef PG8_SB
#undef PG8_STAGE
#undef PG8_LDA
#undef PG8_LDB
#undef PG8_MMA
#undef PG8_WAIT_V
#undef PG8_WAIT_L
#undef PG8_BAR
#undef PG8_SCHED
}
}

constexpr int NWAVES = 8, NTHR = 512;
constexpr int N_LAUNCHES = MK_N_LAUNCHES;
constexpr int N_PHASES = 13;
constexpr int DM = 2048, NB = 4, TL = 2048, NLAT = NB * TL, TCX = 256, NCTX = NB * TCX, NTOK = NLAT + NCTX;
constexpr int NH = 8, QKD = 128, VD = 256, INC = 14368, ZW = 14336;
constexpr int ZQ = 0, ZK = 1024, ZV = 2048, ZO = 4096, ZU = 6144, ZS = 8192, ZGA = 10240, ZGB = 12288;
constexpr int NEXP = 32, DEXP = 2048, NCH = 18  , CROWS = 272  ;
constexpr float EPS = 1e-6f;

constexpr size_t MiB = 1u << 20;
constexpr size_t WS_CTL = 0, CTL_ZERO_BYTES = 1 * MiB;
constexpr size_t WS_MOD = 1 * MiB;
constexpr size_t WS_GATES = 2 * MiB;
constexpr size_t WS_SCAL = 4 * MiB;
constexpr size_t WS_ROUTE = 5 * MiB;
constexpr size_t WS_SCN = 2996 * MiB;
constexpr size_t WS_SK = 6 * MiB;
constexpr size_t WS_WINT = 8 * MiB;
constexpr size_t WS_PAT = 64 * MiB, WS_PBT = 72 * MiB, WS_WOT = 80 * MiB;
constexpr size_t WS_W1T = 88 * MiB;
constexpr size_t WS_W2T = 600 * MiB;
constexpr size_t WS_HB = 856 * MiB;
constexpr size_t WS_Z = 892 * MiB;
constexpr size_t WS_QC = 1144 * MiB, WS_KC = 1162 * MiB;
constexpr size_t WS_SVN = 1180 * MiB;
constexpr size_t WS_DC = 1212 * MiB;
constexpr size_t WS_CS = 1360 * MiB;
constexpr size_t WS_RO = 1428 * MiB;
constexpr size_t WS_CM = 1460 * MiB;
constexpr size_t WS_YB = 1492 * MiB;
constexpr size_t WS_MRG = 1556 * MiB;
constexpr size_t WS_X1 = 1588 * MiB;
constexpr size_t WS_ACT = 1652 * MiB;
constexpr size_t WS_Y2 = 1812 * MiB;
constexpr size_t WS_XG = 1972 * MiB;
constexpr size_t WS_HB8 = 2998 * MiB;
constexpr size_t WS_WG8 = 3016 * MiB;
constexpr size_t WS_END = 3040 * MiB;
static_assert(WS_CM == WS_RO + (size_t)NLAT * DM * 2 && WS_PBT == WS_PAT + (size_t)DM * DM * 2, "P7's chained units address [RO ; CM] and [proj_a^T ; proj_b^T] as one matrix each");
static_assert(WS_DC + (size_t)64 * 17 * CROWS * 128 * 2 <= WS_CS && WS_CS + (size_t)64 * 16 * CROWS * 128 * 2 <= WS_RO && WS_Z + (size_t)NTOK * ZW * 2 <= WS_QC, "ws map");
constexpr int CW_Q3 = 3584, CW_Q4 = 8192;
constexpr int CW_Q2 = 3072;
constexpr int CW_Q = 2048;
constexpr int CW_CNT = 64;
constexpr int CW_BAR = 4096;
constexpr int RING_BYTES = 131072;
constexpr int LDS_BYTES = 147456;
constexpr int LDSCTL_OFF = LDS_BYTES - 2048, MISC_OFF = LDSCTL_OFF + 320, PREF_OFF = LDSCTL_OFF + 1024;

#define GAS __attribute__((address_space(1)))
#define LAS __attribute__((address_space(3)))
typedef unsigned short bf16;
typedef unsigned v4u __attribute__((ext_vector_type(4)));
typedef unsigned v2u __attribute__((ext_vector_type(2)));
typedef float f32x4 __attribute__((ext_vector_type(4)));
typedef short bf16x8 __attribute__((ext_vector_type(8)));
typedef short s16x4 __attribute__((ext_vector_type(4)));
typedef GAS unsigned gu32;
#define RLX_AGENT __ATOMIC_RELAXED, __HIP_MEMORY_SCOPE_AGENT
#define LDS_WAIT() asm volatile("s_waitcnt lgkmcnt(0)" ::: "memory")
#define VM_WAIT() asm volatile("s_waitcnt vmcnt(0)" ::: "memory")
using pg8::cvt_pk_bf16; using pg8::bf_lo; using pg8::bf_hi; using pg8::sigmoidf_;


__device__ __forceinline__ float wave_sum(float v) {
#pragma unroll
    for (int o = 1; o < 64; o <<= 1) v += __shfl_xor(v, o);
    return v;
}
__device__ __forceinline__ float siluf_(float x) { return x * __builtin_amdgcn_rcpf(1.0f + __expf(-x)); }
__device__ __forceinline__ float gelu_tanh(float x) { const float u = 0.7978845608028654f * (x + 0.044715f * x * x * x); return x * __builtin_amdgcn_rcpf(1.0f + __expf(-2.0f * u)); }
__device__ __forceinline__ float logsigf_(float f) { return fminf(f, 0.f) - log1pf(expf(-fabsf(f))); }
__device__ __forceinline__ unsigned img_off(unsigned row, unsigned ch) { return 256u * row + 16u * (ch ^ (((row & 3u) << 2) | ((row >> 2) & 3u))); }
__device__ __forceinline__ s16x4 tr_read(LAS unsigned char* p) { return __builtin_amdgcn_ds_read_tr16_b64_v4i16((LAS s16x4*)p); }
__device__ __forceinline__ bf16x8 tr_frag(LAS unsigned char* img, unsigned r0, unsigned r1, unsigned c, int lane) {
    const unsigned q = (lane & 15) >> 2, p = lane & 3;
    const s16x4 lo = tr_read(img + img_off(r0 + q, 2 * c + (p >> 1)) + 8 * (p & 1));
    const s16x4 hi = tr_read(img + img_off(r1 + q, 2 * c + (p >> 1)) + 8 * (p & 1));
    bf16x8 r; r[0] = lo[0]; r[1] = lo[1]; r[2] = lo[2]; r[3] = lo[3]; r[4] = hi[0]; r[5] = hi[1]; r[6] = hi[2]; r[7] = hi[3]; return r;
}
__device__ __forceinline__ bf16x8 tr_frag2(LAS unsigned char* base, unsigned x0, unsigned x1) {
    const s16x4 lo = tr_read(base + x0), hi = tr_read(base + x1);
    bf16x8 r; r[0] = lo[0]; r[1] = lo[1]; r[2] = lo[2]; r[3] = lo[3]; r[4] = hi[0]; r[5] = hi[1]; r[6] = hi[2]; r[7] = hi[3]; return r;
}
#define TR_NAT_OFFS(xn0, xn1, lane) unsigned xn0[8], xn1[8]; { const unsigned g_ = (lane) >> 4, q_ = ((lane) & 15) >> 2, p_ = (lane) & 3; \
    _Pragma("unroll") for (int c_ = 0; c_ < 8; ++c_) { xn0[c_] = 256u * (8 * g_ + q_) + 16u * ((2 * c_ + (p_ >> 1)) ^ ((q_ << 2) | ((2 * g_) & 3))) + 8u * (p_ & 1); \
                                                       xn1[c_] = 256u * (8 * g_ + 4 + q_) + 16u * ((2 * c_ + (p_ >> 1)) ^ ((q_ << 2) | ((2 * g_ + 1) & 3))) + 8u * (p_ & 1); } }
#define TR_PERM_OFFS(xp, lane) unsigned xp[8]; { const unsigned g_ = (lane) >> 4, q_ = ((lane) & 15) >> 2, p_ = (lane) & 3; \
    _Pragma("unroll") for (int c_ = 0; c_ < 8; ++c_) xp[c_] = 256u * (4 * g_ + q_) + 16u * ((2 * c_ + (p_ >> 1)) ^ ((q_ << 2) | g_)) + 8u * (p_ & 1); }
__device__ __forceinline__ void load_tile128(LAS unsigned char* img, const bf16* src, size_t ld, int tid) {
#pragma unroll
    for (int i = 0; i < 4; ++i) { const int id = tid + NTHR * i, row = id >> 4, ch = id & 15;
        const v4u v = *(const v4u*)(src + (size_t)row * ld + 8 * ch); *(LAS v4u*)(img + img_off(row, ch)) = v; }
}
__device__ __forceinline__ void load_tile128_scaled(LAS unsigned char* img, const bf16* src, size_t ld, const LAS float* w, int tid) {
#pragma unroll
    for (int i = 0; i < 4; ++i) { const int id = tid + NTHR * i, row = id >> 4, ch = id & 15; const float s = w[row];
        const v4u v = *(const v4u*)(src + (size_t)row * ld + 8 * ch); v4u o;
        o.x = cvt_pk_bf16(bf_lo(v.x) * s, bf_hi(v.x) * s); o.y = cvt_pk_bf16(bf_lo(v.y) * s, bf_hi(v.y) * s); o.z = cvt_pk_bf16(bf_lo(v.z) * s, bf_hi(v.z) * s); o.w = cvt_pk_bf16(bf_lo(v.w) * s, bf_hi(v.w) * s);
        *(LAS v4u*)(img + img_off(row, ch)) = o; }
}
__device__ __forceinline__ void gate_scan(const float* G, size_t row0, int col_i, int col_f, int dir, int lane, float* bc, float* gg, float* pmx, float& b_end, float& gmax) {
    const int j0 = dir ? 127 - 2 * lane : 2 * lane, j1 = dir ? 126 - 2 * lane : 2 * lane + 1;
    const float f0 = G[(row0 + j0) * 32 + col_f], f1 = G[(row0 + j1) * 32 + col_f], i0 = G[(row0 + j0) * 32 + col_i], i1 = G[(row0 + j1) * 32 + col_i];
    const float lf0 = logsigf_(f0), lf1 = logsigf_(f1), s = lf0 + lf1; float incl = s;
#pragma unroll
    for (int o = 1; o < 64; o <<= 1) { const float t = __shfl_up(incl, o); if (lane >= o) incl += t; }
    const float b0 = (incl - s) + lf0, b1 = incl, g0 = i0 - b0, g1 = i1 - b1;
    float mincl = fmaxf(g0, g1);
#pragma unroll
    for (int o = 1; o < 64; o <<= 1) { const float t = __shfl_up(mincl, o); if (lane >= o) mincl = fmaxf(mincl, t); }
    float mexcl = __shfl_up(mincl, 1); if (lane == 0) mexcl = -3.0e38f;
    bc[j0] = b0; bc[j1] = b1; gg[j0] = g0; gg[j1] = g1; pmx[j0] = fmaxf(mexcl, g0); pmx[j1] = mincl;
    b_end = __shfl(incl, 63); gmax = __shfl(mincl, 63);
}
#define MFMA16(a, b, c) __builtin_amdgcn_mfma_f32_16x16x32_bf16((a), (b), (c), 0, 0, 0)

__device__ __forceinline__ v4u pair16(v2u X, v2u Y) {
    const auto r0 = __builtin_amdgcn_permlane16_swap(X.x, Y.x, false, false), r1 = __builtin_amdgcn_permlane16_swap(X.y, Y.y, false, false);
    v4u o; o.x = r0[0]; o.y = r1[0]; o.z = r0[1]; o.w = r1[1]; return o; }

struct CvtItem { const float* src; size_t ldw; bf16* dst; };
constexpr int N_CONVERTERS = 128;
constexpr int N_CONV_DEFER = 1440;
constexpr int I_GEMV = 192, I_WIN = 16 * 8, I_GATE8 = 16 * 48, I_P = 16 * 8, I_W1 = 32 * 16 * 16, I_W2 = 32 * 16 * 8, I_TOTAL = I_GEMV + I_WIN + 3 * I_P + I_W1 + I_W2;
__device__ __forceinline__ CvtItem cvt_decode(int r, int tid, const float* w_in, const float* proj_a, const float* proj_b, const float* w_out, const float* exp_w1, const float* exp_w2,
                                              bf16* WINT, bf16* PAT, bf16* PBT, bf16* WOT, bf16* W1T, bf16* W2T) {
    const int n4 = tid & 63, kg = tid >> 6; const float* W; size_t ldw, ca, cb, drow; int kt; bf16* WT;
    if (r < I_WIN) { kt = r / 8; const int nt = 24 + r % 8; W = w_in; ldw = INC; ca = (size_t)256 * nt + 32; cb = ca + 128; WT = WINT; drow = (size_t)256 * nt; }
    else if ((r -= I_WIN) < 3 * I_P) { const int m = r / I_P, q = r % I_P; kt = q / 8; const int nt = q % 8; W = m == 0 ? proj_a : (m == 1 ? proj_b : w_out); ldw = 2048; ca = (size_t)256 * nt; cb = ca + 128; WT = m == 0 ? PAT : (m == 1 ? PBT : WOT); drow = (size_t)256 * nt; }
    else if ((r -= 3 * I_P) < I_W1) { const int e = r / 256, q = r % 256; kt = q / 16; const int nt = q % 16; W = exp_w1 + (size_t)e * 2048 * 4096; ldw = 4096; ca = (size_t)128 * nt; cb = 2048 + ca; WT = W1T; drow = (size_t)e * 4096 + 256 * nt; }
    else { r -= I_W1; const int e = r / 128, q = r % 128; kt = q / 8; const int nt = q % 8; W = exp_w2 + (size_t)e * 2048 * 2048; ldw = 2048; ca = (size_t)256 * nt; cb = ca + 128; WT = W2T; drow = (size_t)e * 2048 + 256 * nt; }
    CvtItem it; it.ldw = ldw; it.src = W + (size_t)(128 * kt + 8 * kg) * ldw + (n4 < 32 ? ca + 4 * n4 : cb + 4 * (n4 - 32)); it.dst = WT + drow * 2048 + 128 * kt; return it;
}
__device__ __forceinline__ void cvt_run(LAS unsigned char* lds, int tid, int it, int stride, int end, const float* w_in, const float* proj_a, const float* proj_b, const float* w_out, const float* exp_w1, const float* exp_w2,
                                        bf16* WINT, bf16* PAT, bf16* PBT, bf16* WOT, bf16* W1T, bf16* W2T) {
    const int n4 = tid & 63, kg = tid >> 6;
    f32x4 v[16]; CvtItem cur;
    bool have = it < end;
    if (have) { cur = cvt_decode(it - I_GEMV, tid, w_in, proj_a, proj_b, w_out, exp_w1, exp_w2, WINT, PAT, PBT, WOT, W1T, W2T);
#pragma unroll
        for (int i = 0; i < 16; ++i) v[i] = __builtin_nontemporal_load((const f32x4*)(cur.src + (size_t)((i >> 3) * 64 + (i & 7)) * cur.ldw)); }
    while (have) {
#pragma unroll
        for (int hf = 0; hf < 2; ++hf)
#pragma unroll
            for (int j = 0; j < 4; ++j) { v4u o; o.x = cvt_pk_bf16(v[8 * hf + 0][j], v[8 * hf + 1][j]); o.y = cvt_pk_bf16(v[8 * hf + 2][j], v[8 * hf + 3][j]); o.z = cvt_pk_bf16(v[8 * hf + 4][j], v[8 * hf + 5][j]); o.w = cvt_pk_bf16(v[8 * hf + 6][j], v[8 * hf + 7][j]);
                *(LAS v4u*)(lds + img_off(4 * n4 + j, 8 * hf + kg)) = o; }
        __syncthreads();
        bf16* dst = cur.dst;
        it += stride; have = it < end;
        if (have) { cur = cvt_decode(it - I_GEMV, tid, w_in, proj_a, proj_b, w_out, exp_w1, exp_w2, WINT, PAT, PBT, WOT, W1T, W2T);
#pragma unroll
            for (int i = 0; i < 16; ++i) v[i] = __builtin_nontemporal_load((const f32x4*)(cur.src + (size_t)((i >> 3) * 64 + (i & 7)) * cur.ldw)); }
#pragma unroll
        for (int i = 0; i < 8; ++i) { const int id = tid + NTHR * i, row = id >> 4, ch = id & 15; const v4u o = *(const LAS v4u*)(lds + img_off(row, ch)); __builtin_nontemporal_store(o, (v4u*)(dst + (size_t)row * 2048 + 8 * ch)); }
        __syncthreads();
    }
}
__device__ __forceinline__ void cvt_run8(LAS unsigned char* lds, int tid, int r, int stride, int end, const float* exp_w1, const float* exp_w2, const float* w_in, unsigned char* W1T8, unsigned char* W2T8, unsigned char* WG8) {
    const int n4 = tid & 63, kg = tid >> 6;
    f32x4 v[16]; const float* src = nullptr; size_t ldw = 0; unsigned char* dst = nullptr;
#define CVT8_DECODE(R) do { int q_ = (R); const float* W_; size_t ca_, cb_, drow_; int kt_; unsigned char* WT_; \
        if (q_ < I_W1) { const int e = q_ / 256, qq = q_ % 256; kt_ = qq / 16; const int nt = qq % 16; W_ = exp_w1 + (size_t)e * 2048 * 4096; ldw = 4096; ca_ = (size_t)128 * nt; cb_ = 2048 + ca_; WT_ = W1T8; drow_ = (size_t)e * 4096 + 256 * nt; } \
        else if (q_ < I_W1 + I_W2) { q_ -= I_W1; const int e = q_ / 128, qq = q_ % 128; kt_ = qq / 8; const int nt = qq % 8; W_ = exp_w2 + (size_t)e * 2048 * 2048; ldw = 2048; ca_ = (size_t)256 * nt; cb_ = ca_ + 128; WT_ = W2T8; drow_ = (size_t)e * 2048 + 256 * nt; } \
        else { q_ -= I_W1 + I_W2; kt_ = q_ / 48; const int ft = q_ % 48, zt = ft < 24 ? ft : ft + 8; W_ = w_in; ldw = INC; ca_ = (size_t)256 * zt + (zt >= 16 ? 32 : 0); cb_ = ca_ + 128; WT_ = WG8; drow_ = (size_t)256 * ft; } \
        src = W_ + (size_t)(128 * kt_ + 8 * kg) * ldw + (n4 < 32 ? ca_ + 4 * n4 : cb_ + 4 * (n4 - 32)); dst = WT_ + drow_ * 2048 + 128 * kt_; \
        _Pragma("unroll") for (int i = 0; i < 16; ++i) v[i] = __builtin_nontemporal_load((const f32x4*)(src + (size_t)((i >> 3) * 64 + (i & 7)) * ldw)); } while (0)
    bool have = r < end;
    if (have) CVT8_DECODE(r);
    while (have) {
#pragma unroll
        for (int hf = 0; hf < 2; ++hf)
#pragma unroll
            for (int j = 0; j < 4; ++j) { const int row = 4 * n4 + j, p8 = 8 * hf + kg; v2u o;
                o.x = pg8::pk4_fp8(v[8 * hf + 0][j] * pg8::F8_SW, v[8 * hf + 1][j] * pg8::F8_SW, v[8 * hf + 2][j] * pg8::F8_SW, v[8 * hf + 3][j] * pg8::F8_SW);
                o.y = pg8::pk4_fp8(v[8 * hf + 4][j] * pg8::F8_SW, v[8 * hf + 5][j] * pg8::F8_SW, v[8 * hf + 6][j] * pg8::F8_SW, v[8 * hf + 7][j] * pg8::F8_SW);
                *(LAS v2u*)(lds + row * 128 + 16 * ((p8 >> 1) ^ ((row >> 2) & 7)) + 8 * (p8 & 1)) = o; }
        __syncthreads();
        unsigned char* d0 = dst;
        r += stride; have = r < end;
        if (have) CVT8_DECODE(r);
#pragma unroll
        for (int i = 0; i < 4; ++i) { const int id = tid + NTHR * i, row = id >> 3, ch = id & 7; const v4u o = *(const LAS v4u*)(lds + row * 128 + 16 * (ch ^ ((row >> 2) & 7)));
            __builtin_nontemporal_store(o, (v4u*)(d0 + (size_t)row * 2048 + 16 * ch)); }
        __syncthreads();
    }
#undef CVT8_DECODE
}
__device__ __forceinline__ void p0_phase(LAS unsigned char* lds, int tid, int G, const float* c, const float* c_ctx, const float* mod_w, const float* mod_b, float* MOD,
                                         const float* w_in, const float* proj_a, const float* proj_b, const float* w_out, const float* exp_w1, const float* exp_w2, const float* router_w,
                                         bf16* WINT, bf16* PAT, bf16* PBT, bf16* WOT, bf16* W1T, bf16* W2T, bf16* SK, int n_conv_p0) {
    LAS float* sc = (LAS float*)lds;
    LAS float* red = (LAS float*)(lds + 40960);
    int it = blockIdx.x;
    if (it < I_GEMV) {
        for (int i = tid; i < 5 * 2048; i += NTHR) { const float x = i < 4 * 2048 ? c[i] : c_ctx[i - 4 * 2048]; sc[i] = siluf_(x); }
        __syncthreads();
        for (; it < I_GEMV; it += G) {
            const int j0 = 64 * it, c4 = tid & 15, kg = tid >> 4;
            f32x4 a0 = {0.f, 0.f, 0.f, 0.f}, a1 = a0, a2 = a0, a3 = a0, a4 = a0;
            const float* wp = mod_w + (size_t)kg * 12288 + j0 + 4 * c4;
#pragma unroll 8
            for (int k = kg; k < 2048; k += 32) { const f32x4 w = *(const f32x4*)wp; wp += (size_t)32 * 12288;
                a0 += w * sc[k]; a1 += w * sc[2048 + k]; a2 += w * sc[4096 + k]; a3 += w * sc[6144 + k]; a4 += w * sc[8192 + k]; }
            *(LAS f32x4*)(red + (kg * 5 + 0) * 64 + 4 * c4) = a0; *(LAS f32x4*)(red + (kg * 5 + 1) * 64 + 4 * c4) = a1; *(LAS f32x4*)(red + (kg * 5 + 2) * 64 + 4 * c4) = a2;
            *(LAS f32x4*)(red + (kg * 5 + 3) * 64 + 4 * c4) = a3; *(LAS f32x4*)(red + (kg * 5 + 4) * 64 + 4 * c4) = a4;
            __syncthreads();
            if (tid < 320) { const int rr = tid >> 6, j = tid & 63; float s = 0.f;
#pragma unroll 8
                for (int g = 0; g < 32; ++g) s += red[(g * 5 + rr) * 64 + j];
                MOD[rr * 12288 + j0 + j] = s + mod_b[j0 + j]; }
            __syncthreads();
        }
    } else {
        for (int i = (it - I_GEMV) * NTHR + tid; i < 2 * 32 * 2048; i += (G - I_GEMV) * NTHR) { const int m = i >> 16, n = (i >> 11) & 31, k = i & 2047;
            const float w = m == 0 ? w_in[(size_t)k * INC + 4096 + n] : router_w[k * 32 + n];
            const unsigned hi = cvt_pk_bf16(w, 0.f) & 0xffffu; const unsigned lo = cvt_pk_bf16(w - __uint_as_float(hi << 16), 0.f) & 0xffffu;
            SK[(size_t)(2 * m) * 65536 + n * 2048 + k] = (bf16)hi; SK[(size_t)(2 * m + 1) * 65536 + n * 2048 + k] = (bf16)lo; }
    }
    cvt_run(lds, tid, it, G, I_GEMV + n_conv_p0, w_in, proj_a, proj_b, w_out, exp_w1, exp_w2, WINT, PAT, PBT, WOT, W1T, W2T);
}

__device__ __forceinline__ void skinny_mfma(const LAS float* hrow, const bf16* WT_hi, const bf16* WT_lo, LAS float* part, int wave, int lane) {
    const int g = lane >> 4, l15 = lane & 15;
    f32x4 acc0 = {0.f, 0.f, 0.f, 0.f}, acc1 = acc0;
#pragma unroll
    for (int ks = 0; ks < 8; ++ks) { const int kb = 256 * wave + 32 * ks + 8 * g;
        f32x4 a0 = {0.f, 0.f, 0.f, 0.f}, a1 = a0;
        if (l15 < 8) { a0 = *(const LAS f32x4*)(hrow + l15 * 2048 + kb); a1 = *(const LAS f32x4*)(hrow + l15 * 2048 + kb + 4); }
        v4u hi, lo;
        hi.x = cvt_pk_bf16(a0[0], a0[1]); hi.y = cvt_pk_bf16(a0[2], a0[3]); hi.z = cvt_pk_bf16(a1[0], a1[1]); hi.w = cvt_pk_bf16(a1[2], a1[3]);
        lo.x = cvt_pk_bf16(a0[0] - bf_lo(hi.x), a0[1] - bf_hi(hi.x)); lo.y = cvt_pk_bf16(a0[2] - bf_lo(hi.y), a0[3] - bf_hi(hi.y));
        lo.z = cvt_pk_bf16(a1[0] - bf_lo(hi.z), a1[1] - bf_hi(hi.z)); lo.w = cvt_pk_bf16(a1[2] - bf_lo(hi.w), a1[3] - bf_hi(hi.w));
        const bf16x8 Ah = __builtin_bit_cast(bf16x8, hi), Al = __builtin_bit_cast(bf16x8, lo);
        const bf16x8 b0h = *(const bf16x8*)(WT_hi + (size_t)l15 * 2048 + kb), b0l = *(const bf16x8*)(WT_lo + (size_t)l15 * 2048 + kb);
        const bf16x8 b1h = *(const bf16x8*)(WT_hi + (size_t)(16 + l15) * 2048 + kb), b1l = *(const bf16x8*)(WT_lo + (size_t)(16 + l15) * 2048 + kb);
        acc0 = MFMA16(Ah, b0h, acc0); acc0 = MFMA16(Ah, b0l, acc0); acc0 = MFMA16(Al, b0h, acc0);
        acc1 = MFMA16(Ah, b1h, acc1); acc1 = MFMA16(Ah, b1l, acc1); acc1 = MFMA16(Al, b1h, acc1); }
    if (g < 2) {
#pragma unroll
        for (int r = 0; r < 4; ++r) { part[wave * 256 + (4 * g + r) * 32 + l15] = acc0[r]; part[wave * 256 + (4 * g + r) * 32 + 16 + l15] = acc1[r]; } }
}

template <bool LOREG>
__device__ __forceinline__ void skinny_mfma_r(const LAS float* hrow, const bf16x8 (&Bh)[8][2], const bf16x8 (&Bl)[8][2], const bf16* WT_lo, LAS float* part, int wave, int lane) {
    const int g = lane >> 4, l15 = lane & 15;
    f32x4 acc0 = {0.f, 0.f, 0.f, 0.f}, acc1 = acc0;
#pragma unroll
    for (int ks = 0; ks < 8; ++ks) { const int kb = 256 * wave + 32 * ks + 8 * g;
        f32x4 a0 = {0.f, 0.f, 0.f, 0.f}, a1 = a0;
        if (l15 < 8) { a0 = *(const LAS f32x4*)(hrow + l15 * 2048 + kb); a1 = *(const LAS f32x4*)(hrow + l15 * 2048 + kb + 4); }
        v4u hi, lo;
        hi.x = cvt_pk_bf16(a0[0], a0[1]); hi.y = cvt_pk_bf16(a0[2], a0[3]); hi.z = cvt_pk_bf16(a1[0], a1[1]); hi.w = cvt_pk_bf16(a1[2], a1[3]);
        lo.x = cvt_pk_bf16(a0[0] - bf_lo(hi.x), a0[1] - bf_hi(hi.x)); lo.y = cvt_pk_bf16(a0[2] - bf_lo(hi.y), a0[3] - bf_hi(hi.y));
        lo.z = cvt_pk_bf16(a1[0] - bf_lo(hi.z), a1[1] - bf_hi(hi.z)); lo.w = cvt_pk_bf16(a1[2] - bf_lo(hi.w), a1[3] - bf_hi(hi.w));
        const bf16x8 Ah = __builtin_bit_cast(bf16x8, hi), Al = __builtin_bit_cast(bf16x8, lo);
        bf16x8 b0l, b1l;
        if constexpr (LOREG) { b0l = Bl[ks][0]; b1l = Bl[ks][1]; }
        else { b0l = *(const bf16x8*)(WT_lo + (size_t)l15 * 2048 + kb); b1l = *(const bf16x8*)(WT_lo + (size_t)(16 + l15) * 2048 + kb); }
        acc0 = MFMA16(Ah, Bh[ks][0], acc0); acc0 = MFMA16(Ah, b0l, acc0); acc0 = MFMA16(Al, Bh[ks][0], acc0);
        acc1 = MFMA16(Ah, Bh[ks][1], acc1); acc1 = MFMA16(Ah, b1l, acc1); acc1 = MFMA16(Al, Bh[ks][1], acc1); }
    if (g < 2) {
#pragma unroll
        for (int r = 0; r < 4; ++r) { part[wave * 256 + (4 * g + r) * 32 + l15] = acc0[r]; part[wave * 256 + (4 * g + r) * 32 + 16 + l15] = acc1[r]; } }
}
#define SK_LOAD(B, BASE) do { _Pragma("unroll") for (int ks_ = 0; ks_ < 8; ++ks_) _Pragma("unroll") for (int n_ = 0; n_ < 2; ++n_) \
        B[ks_][n_] = *(const bf16x8*)((BASE) + (size_t)(16 * n_ + (lane & 15)) * 2048 + 256 * wave + 32 * ks_ + 8 * (lane >> 4)); } while (0)

__device__ __forceinline__ void p1_phase(LAS unsigned char* lds, int tid, int wave, int lane, int G, const float* x, const float* ctx, const float* MOD, const float* norm_g,
                                         const bf16* SK, const float* gate_b, bf16* HB, unsigned char* HB8, float* GATES) {
    LAS float* hrow = (LAS float*)(lds + wave * 8192); LAS float* part = (LAS float*)(lds + 65536);
    bf16x8 Bh[8][2], Bl[8][2]; SK_LOAD(Bh, SK); SK_LOAD(Bl, SK + 65536);
    f32x4 v[8];
    { const int row = blockIdx.x * 8 + wave; const float* xr = row < NLAT ? x + (size_t)row * DM : ctx + (size_t)(row - NLAT) * DM;
#pragma unroll
      for (int j = 0; j < 8; ++j) v[j] = *(const f32x4*)(xr + 4 * (lane + 64 * j)); }
    for (int it = blockIdx.x; it < NTOK / 8; it += G) {
        const int row = it * 8 + wave;
        const float* shift = MOD + (size_t)(row < NLAT ? (row >> 11) : 4) * 12288; const float* scale = shift + 2048;
        float ss = 0.f;
#pragma unroll
        for (int j = 0; j < 8; ++j) ss += (v[j][0] * v[j][0] + v[j][1] * v[j][1]) + (v[j][2] * v[j][2] + v[j][3] * v[j][3]);
        const float rstd = 1.0f / sqrtf(wave_sum(ss) * (1.0f / DM) + EPS);
#pragma unroll
        for (int j = 0; j < 8; ++j) { const int col = 4 * (lane + 64 * j);
            const f32x4 g = *(const f32x4*)(norm_g + col), sc = *(const f32x4*)(scale + col), sh = *(const f32x4*)(shift + col);
            const f32x4 h = (v[j] * rstd) * g * (sc + 1.0f) + sh;
            v2u o; o.x = cvt_pk_bf16(h[0], h[1]); o.y = cvt_pk_bf16(h[2], h[3]); *(v2u*)(HB + (size_t)row * DM + col) = o;
            *(unsigned*)(HB8 + (size_t)row * DM + col) = pg8::pk4_fp8(h[0] * pg8::F8_SA, h[1] * pg8::F8_SA, h[2] * pg8::F8_SA, h[3] * pg8::F8_SA);
            *(LAS f32x4*)(hrow + col) = h; }
        if (it + G < NTOK / 8) { const int rown = (it + G) * 8 + wave; const float* xr = rown < NLAT ? x + (size_t)rown * DM : ctx + (size_t)(rown - NLAT) * DM;
#pragma unroll
            for (int j = 0; j < 8; ++j) v[j] = *(const f32x4*)(xr + 4 * (lane + 64 * j)); }
        __syncthreads();
        skinny_mfma_r<true>((const LAS float*)lds, Bh, Bl, nullptr, part, wave, lane);
        __syncthreads();
        if (tid < 256) { float s = 0.f;
#pragma unroll
            for (int w = 0; w < 8; ++w) s += part[w * 256 + tid];
            GATES[(size_t)(it * 8) * 32 + tid] = s + gate_b[tid & 31]; }
    }
}

__device__ __forceinline__ void p3_phase(int wave, int lane, int G, const bf16* Z, const float* conv_w, const float* conv_b, const float* sgu_norm_g, bf16* QC, bf16* KC, bf16* SVN,
                                         const float* GATES, float* SCN, float* BEND, float* GMAX) {
    const int gw = blockIdx.x * NWAVES + wave, NGW = G * NWAVES;
    for (int task = gw; task < 64 * NCH; task += NGW) { const int bhd = task / NCH, bi = task - bhd * NCH, dir = bhd & 1, bh = bhd >> 1, b = bh >> 3, h = bh & 7;
        const size_t row0 = bi < 2 ? (size_t)NLAT + b * TCX + bi * 128 : (size_t)b * TL + (bi - 2) * 128;
        float* sp = SCN + (size_t)task * 384; float b_end, gmax;
        gate_scan(GATES, row0, (2 * dir) * 8 + h, (2 * dir + 1) * 8 + h, dir, lane, sp, sp + 128, sp + 256, b_end, gmax);
        const int c = dir == 0 ? bi : (bi < 2 ? 1 - bi : 19 - bi);
        if (lane == 0 && c < 17) { BEND[bhd * 17 + c] = b_end; GMAX[bhd * 17 + c] = gmax; } }
    for (int item = gw; item < NTOK; item += NGW) {
        const int rb = item >> 2, seg = item & 3, row0 = rb * 4, c0 = seg * 512 + lane * 8;
        const int t0 = row0 < NLAT ? (row0 & (TL - 1)) : ((row0 - NLAT) & (TCX - 1)), len = row0 < NLAT ? TL : TCX;
        v4u zr[8];
#pragma unroll
        for (int k = 0; k < 8; ++k) { const int tt = t0 + k - 2; zr[k] = (v4u){0u, 0u, 0u, 0u};
            if (tt >= 0 && tt < len) zr[k] = *(const v4u*)(Z + (size_t)(row0 + k - 2) * ZW + c0); }
        f32x4 w0[5], w1[5];
#pragma unroll
        for (int tau = 0; tau < 5; ++tau) { w0[tau] = *(const f32x4*)(conv_w + tau * 2048 + c0); w1[tau] = *(const f32x4*)(conv_w + tau * 2048 + c0 + 4); }
        const f32x4 b0 = *(const f32x4*)(conv_b + c0), b1 = *(const f32x4*)(conv_b + c0 + 4);
        const float qs = c0 < 1024 ? 0.08838834764831845f : 1.0f;
#pragma unroll
        for (int o = 0; o < 4; ++o) { float acc[8] = {b0[0], b0[1], b0[2], b0[3], b1[0], b1[1], b1[2], b1[3]};
#pragma unroll
            for (int tau = 0; tau < 5; ++tau) { const v4u z = zr[o + tau];
                acc[0] += w0[tau][0] * bf_lo(z.x); acc[1] += w0[tau][1] * bf_hi(z.x); acc[2] += w0[tau][2] * bf_lo(z.y); acc[3] += w0[tau][3] * bf_hi(z.y);
                acc[4] += w1[tau][0] * bf_lo(z.z); acc[5] += w1[tau][1] * bf_hi(z.z); acc[6] += w1[tau][2] * bf_lo(z.w); acc[7] += w1[tau][3] * bf_hi(z.w); }
#pragma unroll
            for (int i = 0; i < 8; ++i) acc[i] = siluf_(acc[i]) * qs;
            v4u ov; ov.x = cvt_pk_bf16(acc[0], acc[1]); ov.y = cvt_pk_bf16(acc[2], acc[3]); ov.z = cvt_pk_bf16(acc[4], acc[5]); ov.w = cvt_pk_bf16(acc[6], acc[7]);
            bf16* dst = c0 < 1024 ? QC + (size_t)(row0 + o) * 1024 + c0 : KC + (size_t)(row0 + o) * 1024 + (c0 - 1024);
            *(v4u*)dst = ov; }
    }
    for (int row = gw; row < NLAT; row += NGW) {
        float v[32]; float ss = 0.f;
#pragma unroll
        for (int j = 0; j < 4; ++j) { const v4u z = *(const v4u*)(Z + (size_t)row * ZW + ZS + 8 * lane + 512 * j);
            v[8 * j + 0] = gelu_tanh(bf_lo(z.x)); v[8 * j + 1] = gelu_tanh(bf_hi(z.x)); v[8 * j + 2] = gelu_tanh(bf_lo(z.y)); v[8 * j + 3] = gelu_tanh(bf_hi(z.y));
            v[8 * j + 4] = gelu_tanh(bf_lo(z.z)); v[8 * j + 5] = gelu_tanh(bf_hi(z.z)); v[8 * j + 6] = gelu_tanh(bf_lo(z.w)); v[8 * j + 7] = gelu_tanh(bf_hi(z.w)); }
#pragma unroll
        for (int i = 0; i < 32; ++i) ss += v[i] * v[i];
        const float rstd = 1.0f / sqrtf(wave_sum(ss) * (1.0f / DM) + EPS);
#pragma unroll
        for (int j = 0; j < 4; ++j) { const int col = 8 * lane + 512 * j; const f32x4 g0 = *(const f32x4*)(sgu_norm_g + col), g1 = *(const f32x4*)(sgu_norm_g + col + 4);
            v4u o; o.x = cvt_pk_bf16(v[8 * j] * rstd * g0[0], v[8 * j + 1] * rstd * g0[1]); o.y = cvt_pk_bf16(v[8 * j + 2] * rstd * g0[2], v[8 * j + 3] * rstd * g0[3]);
            o.z = cvt_pk_bf16(v[8 * j + 4] * rstd * g1[0], v[8 * j + 5] * rstd * g1[1]); o.w = cvt_pk_bf16(v[8 * j + 6] * rstd * g1[2], v[8 * j + 7] * rstd * g1[3]);
            *(v4u*)(SVN + (size_t)row * DM + col) = o; }
    }
}

constexpr int L_V0 = 0, L_V1 = 32768, L_K = 65536, L_SC = 98304, L_CB = 106496;
constexpr int N_M1 = 64 * 17, N_SGU = 512;
__device__ __forceinline__ void p4_phase(LAS unsigned char* lds, int tid_, int wave, int lane_, int G, const bf16* Z, const bf16* KC, const bf16* SVN, const float* SCN,
                                         const float* sgu_w, const float* sgu_b, bf16* DC, const float* GMAX, bf16* CM, int ufirst, int ustep) {
    v4u pk[4], pv[8]; f32x4 pa[2];
#define P4_ISSUE(U) do { const int u_ = (U); int t_ = tid_; asm volatile("" : "+v"(t_)); \
        if (u_ < N_M1) { const int bhd_ = u_ / 17, c_ = u_ - bhd_ * 17, dir_ = bhd_ & 1, bh_ = bhd_ >> 1, b_ = bh_ >> 3, h_ = bh_ & 7; \
            const bool ic_ = c_ < 2; const int blk_ = dir_ == 0 ? (ic_ ? c_ : c_ - 2) : (ic_ ? 1 - c_ : 17 - c_); \
            const size_t r0_ = ic_ ? (size_t)NLAT + b_ * TCX + blk_ * 128 : (size_t)b_ * TL + blk_ * 128; \
            const float* sp_ = SCN + (size_t)(bhd_ * NCH + (ic_ ? blk_ : blk_ + 2)) * 384; \
            _Pragma("unroll") for (int i = 0; i < 4; ++i) { const int id = t_ + NTHR * i; pk[i] = *(const v4u*)(KC + (r0_ + (id >> 4)) * 1024 + h_ * QKD + 8 * (id & 15)); pa[0][i] = sp_[128 + (id >> 4)]; } \
            pa[1][0] = GMAX[bhd_ * 17 + c_]; \
            _Pragma("unroll") for (int i = 0; i < 8; ++i) { const int id = t_ + NTHR * (i & 3); pv[i] = *(const v4u*)(Z + (r0_ + (id >> 4)) * ZW + ZV + h_ * VD + 128 * (i >> 2) + 8 * (id & 15)); } \
        } else { const int u2_ = u_ - N_M1, b_ = u2_ >> 7, n_ = (u2_ >> 3) & 15, grp_ = u2_ & 7; const size_t r0_ = (size_t)b_ * TL + n_ * 128; \
            _Pragma("unroll") for (int i = 0; i < 8; ++i) { const int id = t_ + NTHR * (i & 3); pv[i] = *(const v4u*)(SVN + (r0_ + (id >> 4)) * DM + grp_ * 256 + 128 * (i >> 2) + 8 * (id & 15)); } \
            } } while (0)
    int u = ufirst;
    if (u < N_M1 + N_SGU) P4_ISSUE(u);
    for (; u < N_M1 + N_SGU; u += ustep) {
        int tid = tid_; asm volatile("" : "+v"(tid)); const int lane = tid & 63; const unsigned g = lane >> 4, l15 = lane & 15;
        const bool m1 = u < N_M1;
        TR_NAT_OFFS(xn0, xn1, lane)
#pragma unroll
        for (int i = 0; i < 8; ++i) { const int id = tid + NTHR * (i & 3); *(LAS v4u*)(lds + ((i >> 2) ? L_V1 : L_V0) + img_off(id >> 4, id & 15)) = pv[i]; }
        bf16x8 Af[4]; v2u uw[16];
        if (m1) { const float gmax = pa[1][0];
#pragma unroll
            for (int i = 0; i < 4; ++i) { const int id = tid + NTHR * i, row = id >> 4, ch = id & 15; const float sw = __expf(pa[0][i] - gmax); const v4u v = pk[i]; v4u o;
                o.x = cvt_pk_bf16(bf_lo(v.x) * sw, bf_hi(v.x) * sw); o.y = cvt_pk_bf16(bf_lo(v.y) * sw, bf_hi(v.y) * sw); o.z = cvt_pk_bf16(bf_lo(v.z) * sw, bf_hi(v.z) * sw); o.w = cvt_pk_bf16(bf_lo(v.w) * sw, bf_hi(v.w) * sw);
                *(LAS v4u*)(lds + L_K + img_off(row, ch)) = o; }
        }
        __syncthreads();
        f32x4 af32[8]; float zb_ = 0.f;
        if (!m1) { const int u2 = u - N_M1, b = u2 >> 7, n = (u2 >> 3) & 15, grp = u2 & 7;
            const float* src = sgu_w + (size_t)grp * 16384 + (size_t)(16 * wave + l15) * 128 + 8 * g;
#pragma unroll
            for (int ks = 0; ks < 4; ++ks) { af32[2 * ks] = *(const f32x4*)(src + 32 * ks); af32[2 * ks + 1] = *(const f32x4*)(src + 32 * ks + 4); }
            const bf16* up = Z + ((size_t)b * TL + n * 128 + 16 * wave + l15) * ZW + ZU + grp * 256 + 4 * g;
#pragma unroll
            for (int et = 0; et < 16; ++et) uw[et] = *(const v2u*)(up + 16 * et);
            zb_ = sgu_b[grp * 128 + 16 * wave + l15]; }
        if (u + ustep < N_M1 + N_SGU) P4_ISSUE(u + ustep);
        if (!m1) {
#pragma unroll
            for (int ks = 0; ks < 4; ++ks) { const f32x4 a = af32[2 * ks], b2 = af32[2 * ks + 1];
                const v4u p = {cvt_pk_bf16(a[0], a[1]), cvt_pk_bf16(a[2], a[3]), cvt_pk_bf16(b2[0], b2[1]), cvt_pk_bf16(b2[2], b2[3])}; Af[ks] = __builtin_bit_cast(bf16x8, p); } }
        if (m1) {
            const int bhd = u / 17, c = u - bhd * 17;
#pragma unroll
            for (int ks = 0; ks < 4; ++ks) Af[ks] = tr_frag(lds + L_K, 32 * ks + 8 * g, 32 * ks + 8 * g + 4, wave, lane);
            f32x4 acc[17];
#pragma unroll
            for (int et = 0; et < 17; ++et) acc[et] = (f32x4){0.f, 0.f, 0.f, 0.f};
#pragma unroll
            for (int et = 0; et < 16; ++et) { LAS unsigned char* img = lds + ((et >> 3) ? L_V1 : L_V0);
#pragma unroll
                for (int ks = 0; ks < 4; ++ks) { const bf16x8 Bf = tr_frag2(img + 8192 * ks, xn0[et & 7], xn1[et & 7]); acc[et] = MFMA16(Af[ks], Bf, acc[et]); } }
            { const short one = l15 == 0 ? (short)0x3F80 : (short)0; const bf16x8 Bo = {one, one, one, one, one, one, one, one};
#pragma unroll
                for (int ks = 0; ks < 4; ++ks) acc[16] = MFMA16(Af[ks], Bo, acc[16]); }
            bf16* dst = DC + ((size_t)bhd * 17 + c) * (CROWS * 128) + 16 * wave + 4 * g;
#pragma unroll
            for (int et = 0; et < 16; ++et) { v2u o; o.x = cvt_pk_bf16(acc[et][0], acc[et][1]); o.y = cvt_pk_bf16(acc[et][2], acc[et][3]); *(v2u*)(dst + (size_t)(16 * et + l15) * 128) = o; }
            if (l15 == 0) { v2u o; o.x = cvt_pk_bf16(acc[16][0], acc[16][1]); o.y = cvt_pk_bf16(acc[16][2], acc[16][3]); *(v2u*)(dst + (size_t)256 * 128) = o; }
        } else {
            const int u2 = u - N_M1, b = u2 >> 7, n = (u2 >> 3) & 15, grp = u2 & 7; const size_t row0 = (size_t)b * TL + n * 128;
            f32x4 acc[16];
#pragma unroll
            for (int et = 0; et < 16; ++et) { acc[et] = (f32x4){0.f, 0.f, 0.f, 0.f}; LAS unsigned char* img = lds + ((et >> 3) ? L_V1 : L_V0);
#pragma unroll
                for (int ks = 0; ks < 4; ++ks) { const bf16x8 Bf = tr_frag2(img + 8192 * ks, xn0[et & 7], xn1[et & 7]); acc[et] = MFMA16(Bf, Af[ks], acc[et]); } }
            { const int t = 16 * wave + l15; const float zb = zb_; const size_t row = row0 + t;
#pragma unroll
              for (int ep = 0; ep < 8; ++ep) { v2u XY[2];
#pragma unroll
                  for (int q = 0; q < 2; ++q) { const int et = 2 * ep + q; const v2u w2 = uw[et];
                      const float o0 = gelu_tanh(bf_lo(w2.x)) * (acc[et][0] + zb), o1 = gelu_tanh(bf_hi(w2.x)) * (acc[et][1] + zb), o2 = gelu_tanh(bf_lo(w2.y)) * (acc[et][2] + zb), o3 = gelu_tanh(bf_hi(w2.y)) * (acc[et][3] + zb);
                      XY[q].x = cvt_pk_bf16(o0, o1); XY[q].y = cvt_pk_bf16(o2, o3); }
                  *(v4u*)(CM + row * DM + grp * 256 + 16 * (2 * ep + (g & 1)) + 8 * (g >> 1)) = pair16(XY[0], XY[1]); } }
        }
        __syncthreads();
    }
#undef P4_ISSUE
}

__device__ __forceinline__ void p4_chain(LAS unsigned char* lds, int tid_, int wave, const bf16* Z, const bf16* KC, const float* SCN, const float* BEND, const float* GMAX, bf16* CS, float* MST) {
    const int bhd = blockIdx.x >> 1, eh = blockIdx.x & 1, dir = bhd & 1, bh = bhd >> 1, b = bh >> 3, h = bh & 7;
    v4u pk[4], pv[4]; f32x4 pg;
#define CH_ISSUE(C_) do { const int c_ = (C_); int t_ = tid_; asm volatile("" : "+v"(t_)); const bool ic_ = c_ < 2; const int blk_ = dir == 0 ? (ic_ ? c_ : c_ - 2) : (ic_ ? 1 - c_ : 17 - c_); \
        const size_t r0_ = ic_ ? (size_t)NLAT + b * TCX + blk_ * 128 : (size_t)b * TL + blk_ * 128; const float* sp_ = SCN + (size_t)(bhd * NCH + (ic_ ? blk_ : blk_ + 2)) * 384; \
        _Pragma("unroll") for (int i = 0; i < 4; ++i) { const int id = t_ + NTHR * i; pk[i] = *(const v4u*)(KC + (r0_ + (id >> 4)) * 1024 + h * QKD + 8 * (id & 15)); pg[i] = sp_[128 + (id >> 4)]; \
            pv[i] = *(const v4u*)(Z + (r0_ + (id >> 4)) * ZW + ZV + h * VD + 128 * eh + 8 * (id & 15)); } } while (0)
    f32x4 C[9];
#pragma unroll
    for (int et = 0; et < 9; ++et) C[et] = (f32x4){0.f, 0.f, 0.f, 0.f};
    float m = 0.f;
    CH_ISSUE(0);
    LAS float* gsc = (LAS float*)(lds + L_SC);
    if (tid_ < 17) { gsc[tid_] = GMAX[bhd * 17 + tid_]; gsc[32 + tid_] = BEND[bhd * 17 + tid_]; }
    __syncthreads();
#pragma unroll 1
    for (int c = 0; c < 17; ++c) {
        int tid = tid_; asm volatile("" : "+v"(tid)); const int lane = tid & 63; const unsigned g = lane >> 4, l15 = lane & 15;
        TR_NAT_OFFS(xn0, xn1, lane)
        const float gm = gsc[c], be = gsc[32 + c], mx = fmaxf(m, gm), al = __expf(m - mx);
#pragma unroll
        for (int i = 0; i < 4; ++i) { const int id = tid + NTHR * i, row = id >> 4, ch = id & 15; *(LAS v4u*)(lds + L_V0 + img_off(row, ch)) = pv[i];
            const float sw = __expf(pg[i] - mx); const v4u v = pk[i]; v4u o;
            o.x = cvt_pk_bf16(bf_lo(v.x) * sw, bf_hi(v.x) * sw); o.y = cvt_pk_bf16(bf_lo(v.y) * sw, bf_hi(v.y) * sw); o.z = cvt_pk_bf16(bf_lo(v.z) * sw, bf_hi(v.z) * sw); o.w = cvt_pk_bf16(bf_lo(v.w) * sw, bf_hi(v.w) * sw);
            *(LAS v4u*)(lds + L_K + img_off(row, ch)) = o; }
        __syncthreads();
        if (c + 1 < 17) CH_ISSUE(c + 1);
#pragma unroll
        for (int et = 0; et < 9; ++et) C[et] = C[et] * al;
        bf16x8 Af[4];
#pragma unroll
        for (int ks = 0; ks < 4; ++ks) Af[ks] = tr_frag(lds + L_K, 32 * ks + 8 * g, 32 * ks + 8 * g + 4, wave, lane);
#pragma unroll
        for (int et = 0; et < 8; ++et)
#pragma unroll
            for (int ks = 0; ks < 4; ++ks) { const bf16x8 Bf = tr_frag2(lds + L_V0 + 8192 * ks, xn0[et], xn1[et]); C[et] = MFMA16(Af[ks], Bf, C[et]); }
        if (eh == 0) { const short one = l15 == 0 ? (short)0x3F80 : (short)0; const bf16x8 Bo = {one, one, one, one, one, one, one, one};
#pragma unroll
            for (int ks = 0; ks < 4; ++ks) C[8] = MFMA16(Af[ks], Bo, C[8]); }
        m = be + mx;
        if (c >= 1) { bf16* dst = CS + ((size_t)bhd * 16 + (c - 1)) * (CROWS * 128) + 16 * wave + 4 * g;
            bf16* dst2 = CS + ((size_t)bhd * 16 + (c - 1)) * (CROWS * 128) + (size_t)(128 * eh + 16 * (g & 1) + l15) * 128 + 16 * wave + 8 * (g >> 1);
#pragma unroll
            for (int ep = 0; ep < 4; ++ep) { v2u X, Y; X.x = cvt_pk_bf16(C[2 * ep][0], C[2 * ep][1]); X.y = cvt_pk_bf16(C[2 * ep][2], C[2 * ep][3]); Y.x = cvt_pk_bf16(C[2 * ep + 1][0], C[2 * ep + 1][1]); Y.y = cvt_pk_bf16(C[2 * ep + 1][2], C[2 * ep + 1][3]);
                *(v4u*)(dst2 + (size_t)(32 * ep) * 128) = pair16(X, Y); }
            if (eh == 0 && l15 == 0) { v2u o; o.x = cvt_pk_bf16(C[8][0], C[8][1]); o.y = cvt_pk_bf16(C[8][2], C[8][3]); *(v2u*)(dst + (size_t)256 * 128) = o; }
            if (eh == 0 && tid == 0) MST[bhd * 18 + c + 1] = m; }
        __syncthreads();
    }
#undef CH_ISSUE
}

__device__ __forceinline__ void p5_scan(int tid, int G, const bf16* DC, const float* BEND, const float* GMAX, bf16* CS, float* MST) {
    constexpr int QPB = 257 * 128 / 4;
    for (int idx = blockIdx.x * NTHR + tid; idx < 64 * QPB; idx += G * NTHR) {
        const int bhd = idx / QPB, q = idx - bhd * QPB;
        f32x4 C = {0.f, 0.f, 0.f, 0.f}; float m = 0.f;
#pragma unroll
        for (int c = 0; c < 17; ++c) {
            const float gm = GMAX[bhd * 17 + c], be = BEND[bhd * 17 + c], mx = fmaxf(m, gm), al = __expf(m - mx), bt = __expf(gm - mx);
            const v2u dw = *(const v2u*)(DC + ((size_t)bhd * 17 + c) * (CROWS * 128) + 4 * q); const f32x4 d = {bf_lo(dw.x), bf_hi(dw.x), bf_lo(dw.y), bf_hi(dw.y)};
            C = C * al + d * bt; m = be + mx;
            if (c >= 1) { v2u o; o.x = cvt_pk_bf16(C[0], C[1]); o.y = cvt_pk_bf16(C[2], C[3]);
                *(v2u*)(CS + ((size_t)bhd * 16 + (c - 1)) * (CROWS * 128) + 4 * q) = o; if (q == 0) MST[bhd * 18 + c + 1] = m; }
        }
    }
}

__device__ __forceinline__ void p6_phase(LAS unsigned char* lds, int tid, int wave, int lane_, int G, const bf16* Z, const bf16* QC, const bf16* KC, const float* SCN,
                                         const bf16* CS, const float* MST, const float* mnorm_g, bf16* RO) {
    for (int u = blockIdx.x; u < 512; u += G) {
        int lane = lane_; asm volatile("" : "+v"(lane)); const unsigned g = lane >> 4, l15 = lane & 15;
        const int bh = u >> 4, jb = u & 15, b = bh >> 3, h = bh & 7; const size_t row0 = (size_t)b * TL + jb * 128;
        load_tile128(lds + L_K, KC + row0 * 1024 + h * QKD, 1024, tid);
        load_tile128(lds + L_V0, Z + row0 * ZW + ZV + h * VD, ZW, tid);
        load_tile128(lds + L_V1, Z + row0 * ZW + ZV + h * VD + 128, ZW, tid);
        bf16x8 Qf[4];
#pragma unroll
        for (int ks = 0; ks < 4; ++ks) Qf[ks] = *(const bf16x8*)(QC + (row0 + 16 * wave + l15) * 1024 + h * QKD + 32 * ks + 8 * g);
        { LAS float* scr = (LAS float*)(lds + L_SC);
          for (int i = tid; i < 2 * 385; i += NTHR) { const int d = i >= 385 ? 1 : 0, j = i - 385 * d, bhd2 = bh * 2 + d, c = d ? 17 - jb : 2 + jb;
              scr[512 * d + j] = j < 384 ? SCN[(size_t)(bhd2 * NCH + 2 + jb) * 384 + j] : MST[bhd2 * 18 + c]; }
          if (tid < VD) scr[1024 + tid] = mnorm_g[h * VD + tid]; }
        __syncthreads();
        f32x4 hsum[16]; v2u ow[16];
#pragma unroll
        for (int et = 0; et < 16; ++et) { hsum[et] = (f32x4){0.f, 0.f, 0.f, 0.f}; ow[et] = (v2u){0u, 0u}; }
#pragma unroll 1
        for (int dir = 0; dir < 2; ++dir) {
            int lane = lane_; asm volatile("" : "+v"(lane));
            const unsigned g = lane >> 4, l15 = lane & 15;
            TR_PERM_OFFS(xp, lane)
            const int c = dir ? 17 - jb : 2 + jb; const bf16* cs = CS + ((size_t)(bh * 2 + dir) * 16 + (c - 2)) * (CROWS * 128);
            const LAS float* sp = (const LAS float*)(lds + L_SC) + 512 * dir; const LAS float* gg = sp + 128; const float mc = sp[384];
            const int tS = 16 * wave + l15; const float MtS = fmaxf(mc, sp[256 + tS]);
            unsigned pw[16];
#pragma unroll
            for (int st = 0; st < 8; ++st) { f32x4 aS = {0.f, 0.f, 0.f, 0.f};
#pragma unroll
                for (int ks = 0; ks < 4; ++ks) { const bf16x8 Kf = *(const LAS bf16x8*)(lds + L_K + img_off(16 * st + l15, 4 * ks + g)); aS = MFMA16(Kf, Qf[ks], aS); }
                float pv[4]; const f32x4 gs = *(const LAS f32x4*)(gg + 16 * st + 4 * g);
#pragma unroll
                for (int r = 0; r < 4; ++r) { const int s = 16 * st + 4 * g + r; const bool ok = dir ? (s >= tS) : (s <= tS); const float ev = __expf(fminf(gs[r] - MtS, 0.f)); pv[r] = ok ? aS[r] * ev : 0.f; }
                pw[2 * st] = cvt_pk_bf16(pv[0], pv[1]); pw[2 * st + 1] = cvt_pk_bf16(pv[2], pv[3]); asm volatile("" ::: "memory"); }
            bf16x8 Pf[4];
#pragma unroll
            for (int ks = 0; ks < 4; ++ks) { const v4u t4 = {pw[4 * ks], pw[4 * ks + 1], pw[4 * ks + 2], pw[4 * ks + 3]}; Pf[ks] = __builtin_bit_cast(bf16x8, t4); }
            const float wiT = __expf(mc - MtS), flT = __expf(-(sp[tS] + MtS));
            const short one = l15 == 0 ? (short)0x3F80 : (short)0; const bf16x8 Bo = {one, one, one, one, one, one, one, one};
            float inv;
            { f32x4 ad = {0.f, 0.f, 0.f, 0.f};
#pragma unroll
              for (int ks = 0; ks < 4; ++ks) { bf16x8 Cf = *(const bf16x8*)(cs + (size_t)256 * 128 + 32 * ks + 8 * g); if (l15 != 0) Cf = (bf16x8){0, 0, 0, 0, 0, 0, 0, 0}; ad = MFMA16(Cf, Qf[ks], ad); }
              ad[0] *= wiT;
#pragma unroll
              for (int ks = 0; ks < 4; ++ks) ad = MFMA16(Bo, Pf[ks], ad);
              const float den = __shfl(ad[0], lane & 15); inv = 1.0f / fmaxf(fabsf(den), flT); }
            if (dir == 1) {
                const bf16* op = Z + (row0 + 16 * wave + l15) * ZW + ZO + h * VD + 4 * g;
#pragma unroll
                for (int et = 0; et < 16; ++et) ow[et] = *(const v2u*)(op + 16 * et); }
            { v4u cr[2];
#pragma unroll
              for (int i = 0; i < 2; ++i) { const int id = tid + NTHR * i; cr[i] = *(const v4u*)(cs + (size_t)(id >> 4) * 128 + 8 * (id & 15)); }
#pragma unroll
              for (int i = 0; i < 2; ++i) { const int id = tid + NTHR * i; *(LAS v4u*)(lds + L_CB + img_off(id >> 4, id & 15)) = cr[i]; }
#pragma unroll
              for (int gq = 0; gq < 4; ++gq) {
                LAS unsigned char* cb = lds + L_CB + (gq & 1) * 16384;
                __syncthreads();
                if (gq < 3) {
#pragma unroll
                    for (int i = 0; i < 2; ++i) { const int id = tid + NTHR * i; cr[i] = *(const v4u*)(cs + (size_t)(64 * (gq + 1) + (id >> 4)) * 128 + 8 * (id & 15)); } }
                f32x4 acc[4];
#pragma unroll
                for (int i = 0; i < 4; ++i) { acc[i] = (f32x4){0.f, 0.f, 0.f, 0.f};
#pragma unroll
                    for (int ks = 0; ks < 4; ++ks) { const bf16x8 Cf = *(const LAS bf16x8*)(cb + img_off(16 * i + l15, 4 * ks + g)); acc[i] = MFMA16(Cf, Qf[ks], acc[i]); } }
#pragma unroll
                for (int i = 0; i < 4; ++i) acc[i] = acc[i] * wiT;
                { LAS unsigned char* img = lds + ((gq >> 1) ? L_V1 : L_V0);
#pragma unroll
                  for (int i = 0; i < 4; ++i) {
#pragma unroll
                    for (int ks = 0; ks < 4; ++ks) { const bf16x8 Vf = tr_frag2(img + 8192 * ks, xp[4 * (gq & 1) + i], xp[4 * (gq & 1) + i] + 4096u); acc[i] = MFMA16(Vf, Pf[ks], acc[i]); } } }
#pragma unroll
                for (int i = 0; i < 4; ++i) hsum[4 * gq + i] += acc[i] * inv;
                if (gq < 3) {
#pragma unroll
                    for (int i = 0; i < 2; ++i) { const int id = tid + NTHR * i; *(LAS v4u*)(lds + L_CB + ((gq + 1) & 1) * 16384 + img_off(id >> 4, id & 15)) = cr[i]; } }
              } }
        }
        { float ss = 0.f;
#pragma unroll
          for (int et = 0; et < 16; ++et) ss += (hsum[et][0] * hsum[et][0] + hsum[et][1] * hsum[et][1]) + (hsum[et][2] * hsum[et][2] + hsum[et][3] * hsum[et][3]);
          ss += __shfl_xor(ss, 16); ss += __shfl_xor(ss, 32);
          const float rstd = 1.0f / sqrtf(ss * (1.0f / VD) + EPS); const size_t row = row0 + 16 * wave + l15;
#pragma unroll
          for (int ep = 0; ep < 8; ++ep) { v2u XY[2];
#pragma unroll
              for (int q = 0; q < 2; ++q) { const int et = 2 * ep + q; const int col = h * VD + 16 * et + 4 * g;
                  const v2u o2 = ow[et]; const f32x4 gn = *(const LAS f32x4*)((const LAS float*)(lds + L_SC) + 1024 + 16 * et + 4 * g);
                  const float v0 = hsum[et][0] * rstd * gn[0] * sigmoidf_(bf_lo(o2.x)), v1 = hsum[et][1] * rstd * gn[1] * sigmoidf_(bf_hi(o2.x));
                  const float v2 = hsum[et][2] * rstd * gn[2] * sigmoidf_(bf_lo(o2.y)), v3 = hsum[et][3] * rstd * gn[3] * sigmoidf_(bf_hi(o2.y));
                  XY[q].x = cvt_pk_bf16(v0, v1); XY[q].y = cvt_pk_bf16(v2, v3); }
              *(v4u*)(RO + row * DM + h * VD + 16 * (2 * ep + (g & 1)) + 8 * (g >> 1)) = pair16(XY[0], XY[1]); } }
        __syncthreads();
    }
}

__device__ __forceinline__ void p9_phase(LAS unsigned char* lds, int wave, int lane, int G, const float* X1, const float* MOD, const float* norm_g, const bf16* SK, const float* router_b,
                                         unsigned* cnt, unsigned char* XG, int* RE, int* RR, float* RG) {
    LAS float* hrow = (LAS float*)(lds + wave * 8192); LAS float* part = (LAS float*)(lds + 65536);
    bf16x8 Bh[8][2]; SK_LOAD(Bh, SK + 2 * 65536);
    f32x4 vn[8];
    { const float* xr = X1 + (size_t)(blockIdx.x * 8 + wave) * DM;
#pragma unroll
      for (int j = 0; j < 8; ++j) vn[j] = *(const f32x4*)(xr + 4 * (lane + 64 * j)); }
    for (int it = blockIdx.x; it < NLAT / 8; it += G) {
        const int row = it * 8 + wave;
        const float* shift = MOD + (size_t)(row >> 11) * 12288 + 3 * 2048; const float* scale = shift + 2048;
        f32x4 v[8]; float ss = 0.f;
#pragma unroll
        for (int j = 0; j < 8; ++j) { v[j] = vn[j]; ss += (v[j][0] * v[j][0] + v[j][1] * v[j][1]) + (v[j][2] * v[j][2] + v[j][3] * v[j][3]); }
        const float rstd = 1.0f / sqrtf(wave_sum(ss) * (1.0f / DM) + EPS);
#pragma unroll
        for (int j = 0; j < 8; ++j) { const int col = 4 * (lane + 64 * j);
            const f32x4 g = *(const f32x4*)(norm_g + col), sc = *(const f32x4*)(scale + col), sh = *(const f32x4*)(shift + col);
            v[j] = (v[j] * rstd) * g * (sc + 1.0f) + sh; *(LAS f32x4*)(hrow + col) = v[j]; }
        if (it + G < NLAT / 8) { const float* xr = X1 + (size_t)((it + G) * 8 + wave) * DM;
#pragma unroll
            for (int j = 0; j < 8; ++j) vn[j] = *(const f32x4*)(xr + 4 * (lane + 64 * j)); }
        __syncthreads();
        skinny_mfma_r<false>((const LAS float*)lds, Bh, Bh, SK + 3 * 65536, part, wave, lane);
        __syncthreads();
        float val = router_b[lane & 31];
#pragma unroll
        for (int w = 0; w < 8; ++w) val += part[w * 256 + wave * 32 + (lane & 31)];
        float sv[4]; int si[4];
#pragma unroll
        for (int k = 0; k < 4; ++k) { float bv = val; int bi = lane & 31;
#pragma unroll
            for (int o = 16; o >= 1; o >>= 1) { const float ov = __shfl_xor(bv, o); const int oi = __shfl_xor(bi, o); const bool take = (ov > bv) || (ov == bv && oi < bi); bv = take ? ov : bv; bi = take ? oi : bi; }
            sv[k] = bv; si[k] = __builtin_amdgcn_readfirstlane(bi); if ((lane & 31) == bi) val = -3.0e38f; }
        const float e1 = __expf(sv[1] - sv[0]), e2 = __expf(sv[2] - sv[0]), e3 = __expf(sv[3] - sv[0]), inv = 1.0f / (1.0f + e1 + e2 + e3);
        const float gk[4] = {inv, e1 * inv, e2 * inv, e3 * inv};
        unsigned rank = 0;
        if (lane < 4) rank = __hip_atomic_fetch_add(cnt + (lane == 0 ? si[0] : lane == 1 ? si[1] : lane == 2 ? si[2] : si[3]), 1u, RLX_AGENT);
#pragma unroll
        for (int k = 0; k < 4; ++k) { const unsigned rk = (unsigned)__builtin_amdgcn_readlane((int)rank, k);
            unsigned char* dst = XG + ((size_t)si[k] * 8192 + rk) * DM;
#pragma unroll
            for (int j = 0; j < 8; ++j) *(unsigned*)(dst + 4 * (lane + 64 * j)) = pg8::pk4_fp8(v[j][0] * pg8::F8_SA, v[j][1] * pg8::F8_SA, v[j][2] * pg8::F8_SA, v[j][3] * pg8::F8_SA);
            if (lane == 0) { RE[row * 4 + k] = si[k]; RR[row * 4 + k] = (int)rk; RG[row * 4 + k] = gk[k]; } }
    }
}
__device__ __forceinline__ void moe_prefix(LAS int* pref, const unsigned* cnt, int tid) {
    if (tid == 0) { int s = 0; for (int e = 0; e < 32; ++e) { const unsigned ce = __hip_atomic_load(cnt + e, RLX_AGENT); pref[e] = s; pref[33 + e] = (int)ce; s += (int)((ce + 255u) >> 8); } pref[32] = s; }
    __syncthreads();
}
__device__ __forceinline__ void p12_phase(const LAS int* pref, int wave, int lane_, int G, const float* X1, const float* MOD, const bf16* Y2, const int* RE, const int* RR, const float* RG, const float* final_g, float* out) {
    const int gw = blockIdx.x * NWAVES + wave, NGW = G * NWAVES;
    int en[4], rn[4]; float gn[4];
    if (gw < NLAT) {
#pragma unroll
        for (int k = 0; k < 4; ++k) { en[k] = RE[gw * 4 + k]; rn[k] = RR[gw * 4 + k]; gn[k] = RG[gw * 4 + k]; } }
    for (int row = gw; row < NLAT; row += NGW) {
        int lane = lane_; asm volatile("" : "+v"(lane));
        const float* xr = X1 + (size_t)row * DM + 4 * lane; f32x4 xv[8]; v2u yv[4][8]; float gt[4];
#pragma unroll
        for (int k = 0; k < 4; ++k) { gt[k] = gn[k]; const bf16* src = Y2 + ((size_t)pref[en[k]] * 256 + rn[k]) * DM + 4 * lane;
#pragma unroll
            for (int j = 0; j < 8; ++j) yv[k][j] = __builtin_nontemporal_load((const v2u*)(src + 256 * j)); }
#pragma unroll
        for (int j = 0; j < 8; ++j) xv[j] = __builtin_nontemporal_load((const f32x4*)(xr + 256 * j));
        if (row + NGW < NLAT) { const int r2 = row + NGW;
#pragma unroll
            for (int k = 0; k < 4; ++k) { en[k] = RE[r2 * 4 + k]; rn[k] = RR[r2 * 4 + k]; gn[k] = RG[r2 * 4 + k]; } }
        const float* g5 = MOD + (size_t)(row >> 11) * 12288 + 5 * 2048; float ss = 0.f;
#pragma unroll
        for (int j = 0; j < 8; ++j) { f32x4 ys = {0.f, 0.f, 0.f, 0.f};
#pragma unroll
            for (int k = 0; k < 4; ++k) { const v2u y = yv[k][j]; ys[0] += gt[k] * bf_lo(y.x); ys[1] += gt[k] * bf_hi(y.x); ys[2] += gt[k] * bf_lo(y.y); ys[3] += gt[k] * bf_hi(y.y); }
            const int col = 4 * (lane + 64 * j); const f32x4 x2 = xv[j] + *(const f32x4*)(g5 + col) * ys; xv[j] = x2;
            ss += (x2[0] * x2[0] + x2[1] * x2[1]) + (x2[2] * x2[2] + x2[3] * x2[3]); }
        const float rstd = 1.0f / sqrtf(wave_sum(ss) * (1.0f / DM) + EPS);
#pragma unroll
        for (int j = 0; j < 8; ++j) { const int col = 4 * (lane + 64 * j); __builtin_nontemporal_store(xv[j] * rstd * *(const f32x4*)(final_g + col), (f32x4*)(out + (size_t)row * DM + col)); }
    }
}

#define XB_TMO      128
#define XB_XCNT(j)  (256  + 64 * (j))
#define XB_XSUB(j)  (1280 + 64 * (j))
#define XB_XGEN(j)  (2304 + 64 * (j))
#define XB_TOP      3328
#define XB_TOPGEN   3392
#define XCD_BAR_WORDS 3456
#define XB_SPIN_CAP (1u << 18)

__device__ __forceinline__ unsigned xb_ld(unsigned* p)              { return __hip_atomic_load(p, __ATOMIC_RELAXED, __HIP_MEMORY_SCOPE_AGENT); }
__device__ __forceinline__ unsigned xb_add(unsigned* p, unsigned v) { return __hip_atomic_fetch_add(p, v, __ATOMIC_RELAXED, __HIP_MEMORY_SCOPE_AGENT); }
__device__ __forceinline__ unsigned xb_xcc_id() { return (unsigned)__builtin_amdgcn_s_getreg((3 << 11) | 20) & 0xFu; }
#define XB_SPIN(cond, bar) do { unsigned _sp = 0; while (cond) { __builtin_amdgcn_s_sleep(1); \
    if ((++_sp & 255u) == 0u) { if (xb_ld(&(bar)[XB_TMO])) break; if (_sp > XB_SPIN_CAP) { atomicAdd(&(bar)[XB_TMO], 1u); break; } } } } while (0)

struct XcdBarrier {
    unsigned* bar; unsigned x;
    volatile LAS unsigned* st;
};

__device__ __forceinline__ XcdBarrier xcd_barrier_post(unsigned* bar, volatile LAS unsigned* st) {
    XcdBarrier b; b.bar = bar; b.x = xb_xcc_id(); b.st = st;
    if (threadIdx.x == 0) (void)xb_add(&bar[XB_XCNT(b.x)], 1u);
    return b;
}
__device__ __forceinline__ void xcd_barrier_complete(unsigned* bar, unsigned x, unsigned& nloc, unsigned& nx) {
    const unsigned G = gridDim.x * gridDim.y * gridDim.z;
    unsigned sum, cnt, mine, sp = 0u;
    for (;;) {
        sum = 0u; cnt = 0u; mine = 0u;
#pragma unroll
        for (unsigned j = 0; j < 16; ++j) { const unsigned c = xb_ld(&bar[XB_XCNT(j)]); sum += c; cnt += (c > 0u) ? 1u : 0u; mine = (j == x) ? c : mine; }
        if (sum == G) break;
        __builtin_amdgcn_s_sleep(1);
        if ((++sp & 255u) == 0u) { if (xb_ld(&bar[XB_TMO])) break; if (sp > XB_SPIN_CAP) { atomicAdd(&bar[XB_TMO], 1u); break; } }
    }
    nloc = mine > 0u ? mine : 1u; nx = cnt > 0u ? cnt : 1u;
}

__device__ __forceinline__ void xcd_barrier(const XcdBarrier& b) {
    asm volatile("s_waitcnt vmcnt(0)" ::: "memory");
    __syncthreads();
    if (threadIdx.x == 0) {
        unsigned* bar = b.bar;
        __builtin_amdgcn_s_waitcnt(0);
        unsigned nloc = b.st[0], nx = b.st[1];
        if (nloc == 0u) { xcd_barrier_complete(bar, b.x, nloc, nx); b.st[0] = nloc; b.st[1] = nx; }
        const unsigned old = xb_add(&bar[XB_XSUB(b.x)], 1u);
        const unsigned gen = old / nloc;
        if (old + 1u == (gen + 1u) * nloc) {
            __builtin_amdgcn_fence(__ATOMIC_RELEASE, "agent");
            asm volatile("s_waitcnt vmcnt(0)" ::: "memory");
            const unsigned og = xb_add(&bar[XB_TOP], 1u);
            const unsigned tg = og / nx;
            if (og + 1u == (tg + 1u) * nx) xb_add(&bar[XB_TOPGEN], 1u);
            else XB_SPIN(xb_ld(&bar[XB_TOPGEN]) == tg, bar);
            __builtin_amdgcn_fence(__ATOMIC_ACQUIRE, "agent");
            xb_add(&bar[XB_XGEN(b.x)], 1u);
            asm volatile("s_waitcnt vmcnt(0)" ::: "memory");
        } else {
            XB_SPIN(xb_ld(&bar[XB_XGEN(b.x)]) == gen, bar);
            __builtin_amdgcn_fence(__ATOMIC_ACQUIRE, "agent");
            asm volatile("s_waitcnt vmcnt(0)" ::: "memory");
        }
    }
    __syncthreads();
}

struct Args { const float* in[26]; float* out; unsigned char* ws; int ph_lo, ph_hi; };
__global__ void __launch_bounds__(NTHR, 2) mk_fwd(Args args) {
    extern __shared__ __attribute__((aligned(16))) unsigned char lds_raw[];
    LAS unsigned char* lds = (LAS unsigned char*)lds_raw;
    const int tid = threadIdx.x, lane = tid & 63, wave = __builtin_amdgcn_readfirstlane(tid >> 6), G = gridDim.x;
    unsigned char* ws = args.ws;
    gu32* ctl = (gu32*)(ws + WS_CTL);
    for (int u = tid; u < (LDS_BYTES - LDSCTL_OFF) / 4; u += NTHR) ((LAS unsigned*)(lds + LDSCTL_OFF))[u] = 0u;
    __syncthreads();
    volatile LAS unsigned* MISC = (volatile LAS unsigned*)(lds + MISC_OFF);
    XcdBarrier bar; bar.bar = (unsigned*)(ctl + CW_BAR); bar.x = 0; bar.st = nullptr;
    if (N_LAUNCHES == 1) bar = xcd_barrier_post((unsigned*)(ctl + CW_BAR), MISC + 8);
#define GRID_BAR() do { if (N_LAUNCHES == 1) xcd_barrier(bar); } while (0)
    const int lo = args.ph_lo, hi = args.ph_hi;
#ifdef ONLY_PHASE
#define IN(k) ((k) == ONLY_PHASE && lo <= (k) && (k) < hi)
#else
#define IN(k) (lo <= (k) && (k) < hi)
#endif
#define BOTH(k) (IN(k) && IN((k) + 1))
#ifndef REP_MASK
#define REP_MASK 0
#endif
#define NREP(k) ((((REP_MASK) >> (k)) & 1) ? 2 : 1)
#define INP(i) (args.in[i])
#define WSF(off) ((float*)(ws + (off)))
#define WSB(off) ((bf16*)(ws + (off)))
#define WSI(off) ((int*)(ws + (off)))
    unsigned* cnt = (unsigned*)(ctl + CW_CNT);
    LAS int* pref = (LAS int*)(lds + PREF_OFF);
    const int n_conv_p0 = I_WIN + 3 * I_P;
#define x_in INP(0)
#define cvec INP(1)
#define ctx INP(2)
#define c_ctx INP(3)
#define mod_w INP(4)
#define mod_b INP(5)
#define norm1_g INP(6)
#define norm2_g INP(7)
#define w_in INP(8)
#define gate_b INP(9)
#define conv_w INP(10)
#define conv_b INP(11)
#define mnorm_g INP(12)
#define sgu_norm_g INP(13)
#define sgu_w INP(14)
#define sgu_b INP(15)
#define proj_a INP(16)
#define proj_b INP(17)
#define w_out INP(18)
#define router_w INP(19)
#define router_b INP(20)
#define exp_w1 INP(21)
#define exp_b1 INP(22)
#define exp_w2 INP(23)
#define exp_b2 INP(24)
#define final_g INP(25)
#define MOD WSF(WS_MOD)
#define GATES WSF(WS_GATES)
#define BEND WSF(WS_SCAL)
#define GMAX (WSF(WS_SCAL) + 64 * 17)
#define MST (WSF(WS_SCAL) + 2 * 64 * 17)
#define RE WSI(WS_ROUTE)
#define RR (WSI(WS_ROUTE) + NLAT * 4)
#define RG (WSF(WS_ROUTE) + 2 * NLAT * 4)
#define WINT WSB(WS_WINT)
#define SKW WSB(WS_SK)
#define SCN WSF(WS_SCN)
#define PAT WSB(WS_PAT)
#define PBT WSB(WS_PBT)
#define WOT WSB(WS_WOT)
#define W1T WSB(WS_W1T)
#define W1T8 ((unsigned char*)(ws + WS_W1T))
#define HB8M ((unsigned char*)(ws + WS_HB8))
#define WG8M ((unsigned char*)(ws + WS_WG8))
#define W2T8 ((unsigned char*)(ws + WS_W2T))
#define XG8 ((unsigned char*)(ws + WS_XG))
#define ACT8 ((unsigned char*)(ws + WS_ACT))
#define W2T WSB(WS_W2T)
#define HB WSB(WS_HB)
#define Z WSB(WS_Z)
#define QC WSB(WS_QC)
#define KC WSB(WS_KC)
#define SVN WSB(WS_SVN)
#define DC WSB(WS_DC)
#define CS WSB(WS_CS)
#define RO WSB(WS_RO)
#define CM WSB(WS_CM)
#define YB WSB(WS_YB)
#define MRG WSB(WS_MRG)
#define X1 WSF(WS_X1)
#define ACT WSB(WS_ACT)
#define Y2 WSB(WS_Y2)
#define XG WSB(WS_XG)

    if (IN(0)) for (int rep_ = 0; rep_ < NREP(0); ++rep_) { p0_phase(lds, tid, G, cvec, c_ctx, mod_w, mod_b, MOD, w_in, proj_a, proj_b, w_out, exp_w1, exp_w2, router_w, WINT, PAT, PBT, WOT, W1T, W2T, SKW, n_conv_p0);
        cvt_run8(lds, tid, I_W1 + I_W2 + (int)blockIdx.x, G, I_W1 + I_W2 + I_GATE8, exp_w1, exp_w2, w_in, W1T8, W2T8, WG8M); if (BOTH(0) || rep_ + 1 < NREP(0)) GRID_BAR(); }
    if (IN(1)) for (int rep_ = 0; rep_ < NREP(1); ++rep_) { p1_phase(lds, tid, wave, lane, G, x_in, ctx, MOD, norm1_g, SKW, gate_b, HB, HB8M, GATES); if (BOTH(1) || rep_ + 1 < NREP(1)) GRID_BAR(); }
    if (IN(2)) for (int rep_ = 0; rep_ < NREP(2); ++rep_) {
        if ((int)blockIdx.x >= G - (G == 256 ? N_CONVERTERS : G))
            cvt_run8(lds, tid, (int)blockIdx.x - (G - (G == 256 ? N_CONVERTERS : G)), (G == 256 ? N_CONVERTERS : G), I_W1 + I_W2, exp_w1, exp_w2, w_in, W1T8, W2T8, WG8M);
        { pg8::Gemm g{(const bf16*)HB8M, (const bf16*)WG8M, NTOK, 12288, DM}; pg8::DynOrder S{(unsigned*)(ctl + CW_Q2), (LAS int*)(lds + PREF_OFF + 808), (int)(blockIdx.x & 7), 48, 8, 0}; pg8::EpiGate8 E{Z, ZW};
          pg8::gemm_phase8<pg8::EpiGate8, pg8::DynOrder, true, true>(lds, g, S, E); }
        { pg8::Gemm g{HB, WINT, NLAT, ZW, DM}; pg8::DynOrder S{(unsigned*)(ctl + CW_Q), (LAS int*)(lds + PREF_OFF + 800), (int)(blockIdx.x & 7), 8, 0, 24}; pg8::EpiBf16 E{Z, ZW, nullptr, ZW / 256};
          pg8::gemm_phase<pg8::EpiBf16, pg8::DynOrder, true, true>(lds, g, S, E); }
        if (BOTH(2) || rep_ + 1 < NREP(2)) GRID_BAR();
    }
    if (IN(3)) for (int rep_ = 0; rep_ < NREP(3); ++rep_) { p3_phase(wave, lane, G, Z, conv_w, conv_b, sgu_norm_g, QC, KC, SVN, GATES, SCN, BEND, GMAX); if (BOTH(3) || rep_ + 1 < NREP(3)) GRID_BAR(); }
    if (IN(4)) for (int rep_ = 0; rep_ < NREP(4); ++rep_) { if (G == 256) { if ((int)blockIdx.x < 128) p4_chain(lds, tid, wave, Z, KC, SCN, BEND, GMAX, CS, MST); else p4_phase(lds, tid, wave, lane, G, Z, KC, SVN, SCN, sgu_w, sgu_b, DC, GMAX, CM, N_M1 + (int)blockIdx.x - 128, 128); }
        else p4_phase(lds, tid, wave, lane, G, Z, KC, SVN, SCN, sgu_w, sgu_b, DC, GMAX, CM, (int)blockIdx.x, G);
        if (BOTH(4) || rep_ + 1 < NREP(4)) GRID_BAR(); }
    if (IN(5)) for (int rep_ = 0; rep_ < NREP(5); ++rep_) {
        if (G != 256) { p5_scan(tid, G, DC, BEND, GMAX, CS, MST);
          if (BOTH(5) || rep_ + 1 < NREP(5)) GRID_BAR(); }
    }
    if (IN(6)) for (int rep_ = 0; rep_ < NREP(6); ++rep_) { p6_phase(lds, tid, wave, lane, G, Z, QC, KC, SCN, CS, MST, mnorm_g, RO); if (BOTH(6) || rep_ + 1 < NREP(6)) GRID_BAR(); }
    if (IN(7)) for (int rep_ = 0; rep_ < NREP(7); ++rep_) {
        pg8::Gemm g{RO, PAT, NLAT, DM, DM}; pg8::PairOrder S; S.S.init(NLAT, DM, G, (int)blockIdx.x); S.dM = NLAT / 256; S.dN = DM / 256; pg8::EpiMerge2 E{MRG, Z, ZW, ZGA, ZGB};
        pg8::gemm_phase<pg8::EpiMerge2, pg8::PairOrder, true, true>(lds, g, S, E);
        if (BOTH(7) || rep_ + 1 < NREP(7)) GRID_BAR();
    }
    if (IN(8)) for (int rep_ = 0; rep_ < NREP(8); ++rep_) {
        pg8::Gemm g{MRG, WOT, NLAT, DM, DM}; pg8::StaticOrder S; S.init(NLAT, DM, G, (int)blockIdx.x); pg8::EpiX1 E{X1, x_in, MOD};
        pg8::gemm_phase<pg8::EpiX1, pg8::StaticOrder, true, true>(lds, g, S, E);
        if (BOTH(8) || rep_ + 1 < NREP(8)) GRID_BAR();
    }
    if (IN(9)) for (int rep_ = 0; rep_ < NREP(9); ++rep_) { p9_phase(lds, wave, lane, G, X1, MOD, norm2_g, SKW, router_b, cnt, XG8, RE, RR, RG); if (BOTH(9) || rep_ + 1 < NREP(9)) GRID_BAR(); }
    if (IN(10)) for (int rep_ = 0; rep_ < NREP(10); ++rep_) {
        moe_prefix(pref, cnt, tid);
        pg8::Gemm g{(const bf16*)XG8, (const bf16*)W1T8, 0, 0, DM}; pg8::MoeDyn S{pref, 16, 1, (unsigned*)(ctl + CW_Q3), (LAS int*)(lds + PREF_OFF + 816), (int)(blockIdx.x & 7)}; pg8::EpiSwiglu8 E{ACT8, exp_b1};
        pg8::gemm_phase8<pg8::EpiSwiglu8, pg8::MoeDyn, true, true, true>(lds, g, S, E);
        if (BOTH(10) || rep_ + 1 < NREP(10)) GRID_BAR();
    }
    if (IN(11)) for (int rep_ = 0; rep_ < NREP(11); ++rep_) {
        moe_prefix(pref, cnt, tid);
        pg8::Gemm g{(const bf16*)ACT8, (const bf16*)W2T8, 0, 0, DEXP}; pg8::MoeDyn S{pref, 8, 0, (unsigned*)(ctl + CW_Q4), (LAS int*)(lds + PREF_OFF + 824), (int)(blockIdx.x & 7)}; pg8::EpiY2f8 E{Y2, exp_b2};
        pg8::gemm_phase8<pg8::EpiY2f8, pg8::MoeDyn, true, true, true>(lds, g, S, E);
        if (BOTH(11) || rep_ + 1 < NREP(11)) GRID_BAR();
    }
    if (IN(12)) for (int rep_ = 0; rep_ < NREP(12); ++rep_) { moe_prefix(pref, cnt, tid); p12_phase(pref, wave, lane, G, X1, MOD, Y2, RE, RR, RG, final_g, args.out); if (rep_ + 1 < NREP(12)) GRID_BAR(); }
#undef IN
#undef BOTH
}

extern "C" void kernel_launch(void* const* d_in, const int* in_sizes, int n_in, void* d_out, int out_size, void* d_ws, size_t ws_size, hipStream_t stream) {
    static int grid = 0;
    if (grid == 0) {
        if (n_in != 26 || out_size != NLAT * DM || ws_size < WS_END) { fprintf(stderr, "kernel_launch: unexpected shapes (n_in %d, out %d, ws %zu)\n", n_in, out_size, ws_size); grid = -1; return; }
        int dev = 0, cus = 0;
        if (hipGetDevice(&dev) != hipSuccess || hipDeviceGetAttribute(&cus, hipDeviceAttributeMultiprocessorCount, dev) != hipSuccess) { grid = -1; return; }
        if (hipFuncSetAttribute((const void*)mk_fwd, hipFuncAttributeMaxDynamicSharedMemorySize, LDS_BYTES) != hipSuccess) { fprintf(stderr, "kernel_launch: hipFuncSetAttribute failed\n"); grid = -1; return; }
        int per_cu = 0;
        if (hipOccupancyMaxActiveBlocksPerMultiprocessor(&per_cu, (const void*)mk_fwd, NTHR, LDS_BYTES) != hipSuccess || per_cu < 1) fprintf(stderr, "kernel_launch: occupancy query reports %d\n", per_cu);
        (void)hipGetLastError();
        grid = cus;
    }
    if (grid < 0) return;
    if (hipMemsetAsync((char*)d_ws + WS_CTL, 0, CTL_ZERO_BYTES, stream) != hipSuccess) return;
    Args a{};
    for (int i = 0; i < 26; ++i) a.in[i] = (const float*)d_in[i];
    a.out = (float*)d_out; a.ws = (unsigned char*)d_ws;
    for (int li = 0; li < N_LAUNCHES; ++li) {
        a.ph_lo = (N_LAUNCHES == 1) ? 0 : li; a.ph_hi = (N_LAUNCHES == 1) ? N_PHASES : li + 1;
        hipLaunchKernelGGL(mk_fwd, dim3(grid), dim3(NTHR), LDS_BYTES, stream, a);
        const hipError_t le = hipPeekAtLastError();
        if (le != hipSuccess) { fprintf(stderr, "kernel_launch: launch %d failed: %s\n", li, hipGetErrorName(le)); break; }
    }
}
```

```cpp
#include <hip/hip_runtime.h>
#include <cstdio>
#include <cstdint>
#ifndef MK_N_LAUNCHES
#define MK_N_LAUNCHES 1
#endif
namespace pg8 {
#define PG8_LAS __attribute__((address_space(3)))
typedef unsigned short bf16_t;
typedef short bf16x8 __attribute__((ext_vector_type(8)));
typedef float f32x4 __attribute__((ext_vector_type(4)));
typedef unsigned u32x4 __attribute__((ext_vector_type(4)));
typedef int i32x4 __attribute__((ext_vector_type(4)));
typedef int i32x8 __attribute__((ext_vector_type(8)));
constexpr int BM = 256, BK = 64, HALF = 128, HTB = HALF * BK * 2  , STAGE_BYTES = 8 * HTB, NXCD = 8, WGM = 8;

__host__ __device__ __forceinline__ int lds_byte(int r, int c) { const int st = (r >> 4) * 2 + (c >> 5), rr = r & 15, cc = c & 31, ob = rr * 64 + cc * 2; return st * 1024 + (ob ^ (((ob >> 9) & 1) << 5)); }
__host__ __device__ __forceinline__ void stage_rc(int b, int& R, int& C) { const int st = b / 1024, sb = b % 1024, swz = sb ^ (((sb >> 9) & 1) << 5); R = (st >> 1) * 16 + swz / 64; C = (st & 1) * 32 + (swz % 64) / 2; }
__host__ __device__ __forceinline__ int perm32(int rho) { const int n = rho >> 4, i = rho & 15; return 8 * (i >> 2) + 4 * n + (i & 3); }

struct Unit { int pm, pn, po, hf; };
struct Gemm { const bf16_t* A; const bf16_t* Bt; int M, N, K; };

struct StaticOrder {
    int nM, nN, nwg, G, c;
    __host__ __device__ void init(int M, int N, int G_, int c_) { nM = M / BM; nN = N / BM; nwg = nM * nN; G = G_; c = c_; }
    __host__ __device__ bool next(int i, Unit& u) const {
        const long L = (long)i * G + c; if (L >= nwg) return false;
        int wgid = (int)L; { const int q = nwg / NXCD, r = nwg % NXCD, xcd = wgid % NXCD, off = wgid / NXCD; wgid = (xcd < r ? xcd * (q + 1) : r * (q + 1) + (xcd - r) * q) + off; }
        const int nig = WGM * nN, gid = wgid / nig, fm = gid * WGM, gsz = (nM - fm) < WGM ? (nM - fm) : WGM;
        u.pm = fm + ((wgid % nig) % gsz); u.pn = (wgid % nig) / gsz; u.po = u.pm; u.hf = 0; return true;
    }
    __device__ __forceinline__ void a_ready(const Unit&) const {}
    __device__ __forceinline__ void done(const Unit&) const {}
};
struct PairOrder {
    StaticOrder S; int dM, dN;
    __device__ __forceinline__ bool next(int i, Unit& u) const { Unit b; if (!S.next(i >> 1, b)) return false; const int k = i & 1; u.pm = b.pm + dM * k; u.pn = b.pn + dN * k; u.po = b.po; u.hf = k; return true; }
    __device__ __forceinline__ void a_ready(const Unit&) const {}
    __device__ __forceinline__ void done(const Unit&) const {}
};
struct DynOrder {
    unsigned* q; PG8_LAS int* slot; int xcd, nN, ctx8, pn0;
    __device__ __forceinline__ bool next(int i, Unit& u) const {
        if (threadIdx.x == 0) { int id = -1;
            unsigned v = __hip_atomic_fetch_add(q + 64 * xcd, 1u, __ATOMIC_RELAXED, __HIP_MEMORY_SCOPE_AGENT);
            const unsigned per = (unsigned)(4 * nN + ctx8);
            if (v < per) id = xcd * (int)per + (int)v;
            else {
#pragma unroll 1
                for (int k = 1; k < 8 && id < 0; ++k) { const int x = (xcd + k) & 7;
                    if (__hip_atomic_load(q + 64 * x, __ATOMIC_RELAXED, __HIP_MEMORY_SCOPE_AGENT) < per) { v = __hip_atomic_fetch_add(q + 64 * x, 1u, __ATOMIC_RELAXED, __HIP_MEMORY_SCOPE_AGENT); if (v < per) id = x * (int)per + (int)v; } } }
            slot[i & 1] = id; asm volatile("s_waitcnt lgkmcnt(0)" ::: "memory"); }
        asm volatile("" ::: "memory"); __builtin_amdgcn_s_barrier(); asm volatile("" ::: "memory");
        const int id = __builtin_amdgcn_readfirstlane(slot[i & 1]); if (id < 0) return false;
        const int per = 4 * nN + ctx8, nl = 4 * nN, x = id / per, v = id - x * per;
        if (v < nl) { const int wgid = x * nl + v, nig = WGM * nN, gid = wgid / nig; u.pm = gid * WGM + ((wgid % nig) % WGM); u.pn = pn0 + (wgid % nig) / WGM; }
        else { const int j = x * 8 + (v - nl); u.pm = 32 + (j & 3); u.pn = j >> 2; }
        u.po = u.pm; u.hf = 0; return true;
    }
    __device__ __forceinline__ void a_ready(const Unit&) const {}
    __device__ __forceinline__ void done(const Unit&) const {}
};
struct MoeOrder {
    const PG8_LAS int* pref; int nN, G, c, a_sparse;
    __device__ __forceinline__ bool next(int i, Unit& u) const {
        const int L = i * G + c, total = pref[32]; if (L >= total * nN) return false;
        const int mt = L / nN, nt = L - mt * nN; int e = 0;
        for (int k = 1; k < 32; ++k) e += (pref[k] <= mt) ? 1 : 0;
        u.pm = a_sparse ? e * 32 + (mt - pref[e]) : mt; u.pn = e * nN + nt; u.po = mt; u.hf = (pref[33 + e] - 256 * (mt - pref[e]) <= 128) ? 1 : 0; return true;
    }
    __device__ __forceinline__ void a_ready(const Unit&) const {}
    __device__ __forceinline__ void done(const Unit&) const {}
};

struct MoeDyn {
    const PG8_LAS int* pref; int nN, a_sparse; unsigned* q; PG8_LAS int* slot; int xcd;
    __device__ __forceinline__ bool next(int i, Unit& u) const {
        if (threadIdx.x == 0) { int id = -1; const unsigned per = (unsigned)((pref[4 * xcd + 4] - pref[4 * xcd]) * nN);
            unsigned v = __hip_atomic_fetch_add(q + 64 * xcd, 1u, __ATOMIC_RELAXED, __HIP_MEMORY_SCOPE_AGENT);
            if (v < per) id = (xcd << 16) | (int)v;
            else {
#pragma unroll 1
                for (int j = 1; j < 8 && id < 0; ++j) { const int x = (xcd + j) & 7; const unsigned perx = (unsigned)((pref[4 * x + 4] - pref[4 * x]) * nN);
                    if (__hip_atomic_load(q + 64 * x, __ATOMIC_RELAXED, __HIP_MEMORY_SCOPE_AGENT) < perx) { v = __hip_atomic_fetch_add(q + 64 * x, 1u, __ATOMIC_RELAXED, __HIP_MEMORY_SCOPE_AGENT); if (v < perx) id = (x << 16) | (int)v; } } }
            slot[i & 1] = id; asm volatile("s_waitcnt lgkmcnt(0)" ::: "memory"); }
        asm volatile("" ::: "memory"); __builtin_amdgcn_s_barrier(); asm volatile("" ::: "memory");
        const int id = __builtin_amdgcn_readfirstlane(slot[i & 1]); if (id < 0) return false;
        int v = id & 0xffff, e = 4 * (id >> 16);
#pragma unroll
        for (int j = 0; j < 3; ++j) { const int ue = (pref[e + 1] - pref[e]) * nN; if (v >= ue) { v -= ue; ++e; } }
        const int T = pref[e + 1] - pref[e], blk = 8 * T, nb = v / blk, r2 = v - nb * blk, mtl = r2 >> 3, nt = nb * 8 + (r2 & 7), mt = pref[e] + mtl;
        u.pm = a_sparse ? e * 32 + mtl : mt; u.pn = e * nN + nt; u.po = mt; u.hf = (pref[33 + e] - 256 * mtl <= 128) ? 1 : 0; return true;
    }
    __device__ __forceinline__ void a_ready(const Unit&) const {}
    __device__ __forceinline__ void done(const Unit&) const {}
};

__device__ __forceinline__ unsigned cvt_pk_bf16(float lo, float hi) { unsigned r; asm volatile("v_cvt_pk_bf16_f32 %0, %1, %2" : "=v"(r) : "v"(lo), "v"(hi)); return r; }
__device__ __forceinline__ float bf_lo(unsigned w) { return __uint_as_float(w << 16); }
__device__ __forceinline__ float bf_hi(unsigned w) { return __uint_as_float(w & 0xffff0000u); }
__device__ __forceinline__ unsigned pk4_fp8(float a, float b, float c, float d) {
    a = fminf(fmaxf(a, -448.f), 448.f); b = fminf(fmaxf(b, -448.f), 448.f); c = fminf(fmaxf(c, -448.f), 448.f); d = fminf(fmaxf(d, -448.f), 448.f);
    int p = __builtin_amdgcn_cvt_pk_fp8_f32(a, b, 0, false); p = __builtin_amdgcn_cvt_pk_fp8_f32(c, d, p, true); return (unsigned)p; }
__device__ __forceinline__ unsigned pk4_fp8_nc(float a, float b, float c, float d) { int p = __builtin_amdgcn_cvt_pk_fp8_f32(a, b, 0, false); p = __builtin_amdgcn_cvt_pk_fp8_f32(c, d, p, true); return (unsigned)p; }
constexpr float F8_SA = 16.0f, F8_SW = 512.0f, F8_SC = 4.0f, F8_SY = 16.0f, F8_SG = 16.0f;
__device__ __forceinline__ float sigmoidf_(float x) { return __builtin_amdgcn_rcpf(1.0f + __expf(-x)); }

struct EpiBf16 {
    static constexpr bool PERM = true, AFTER_DRAIN = false, CHAIN = false;
    bf16_t* O; int ldc; const float* bias; int ncolt;
    __device__ __forceinline__ void operator()(const f32x4 (&acc)[2][2][4][2], const Unit& u, int wr, int wc, int fr, int fq) const {
        const int row0 = u.po * BM + wr * 64 + fr; const int colt = (u.pn % ncolt) * BM;
        const int col0 = colt + wc * 32 + 8 * fq, bcol0 = u.pn * BM + wc * 32 + 8 * fq;
        f32x4 bv[2][2];
#pragma unroll
        for (int bj = 0; bj < 2; ++bj)
#pragma unroll
            for (int n = 0; n < 2; ++n) bv[bj][n] = bias ? *(const f32x4*)(bias + bcol0 + bj * HALF + 4 * n) : (f32x4){0.f, 0.f, 0.f, 0.f};
#pragma unroll
        for (int ai = 0; ai < 2; ++ai)
#pragma unroll
            for (int m = 0; m < 4; ++m) { bf16_t* rowp = O + (size_t)(row0 + ai * HALF + m * 16) * ldc + col0;
#pragma unroll
                for (int bj = 0; bj < 2; ++bj) { const f32x4 v0 = acc[ai][bj][m][0] + bv[bj][0], v1 = acc[ai][bj][m][1] + bv[bj][1];
                    u32x4 w; w.x = cvt_pk_bf16(v0[0], v0[1]); w.y = cvt_pk_bf16(v0[2], v0[3]); w.z = cvt_pk_bf16(v1[0], v1[1]); w.w = cvt_pk_bf16(v1[2], v1[3]);
                    __builtin_nontemporal_store(w, (u32x4*)(rowp + bj * HALF)); } }
    }
};
struct EpiSwiglu8 {
    static constexpr bool PERM = true, AFTER_DRAIN = false, LDS_BIAS = true;
    unsigned char* O; const float* b1;
    __device__ __forceinline__ void stage_bias(const Unit& u, PG8_LAS unsigned char* dst, int lane) const {
        const int e = u.pn >> 4, nt = u.pn & 15; const float* src = b1 + (size_t)e * 4096 + nt * 128 + (lane < 32 ? 4 * lane : 2048 + 4 * (lane - 32));
        __builtin_amdgcn_global_load_lds((const unsigned*)src, (PG8_LAS unsigned*)dst, 16, 0, 0); }
    __device__ __forceinline__ void operator()(const f32x4 (&acc)[2][2][4][2], const Unit& u, int wr, int wc, int fr, int fq, const PG8_LAS unsigned char* bias) const {
        const int nt = u.pn & 15; const int row0 = u.po * BM + wr * 64 + fr; constexpr float us = 1.0f / (F8_SA * F8_SW);
        const PG8_LAS float* bg = (const PG8_LAS float*)bias + wc * 32 + 8 * fq; const PG8_LAS float* bl = bg + 128;
        unsigned char* obase = O + (size_t)(row0 + (fq & 1) * 16) * 2048 + nt * 128 + wc * 32 + 16 * (fq >> 1);
#pragma unroll
        for (int ai = 0; ai < 2; ++ai) { if (ai == 1 && u.hf) break;
#pragma unroll
            for (int mp = 0; mp < 2; ++mp) { unsigned w[2][2];
#pragma unroll
                for (int mm = 0; mm < 2; ++mm)
#pragma unroll
                    for (int n = 0; n < 2; ++n) { const int m = 2 * mp + mm; const f32x4 gv = acc[ai][0][m][n] * us + *(const PG8_LAS f32x4*)(bg + 4 * n), lv = acc[ai][1][m][n] * us + *(const PG8_LAS f32x4*)(bl + 4 * n);
                        float o[4];
#pragma unroll
                        for (int i = 0; i < 4; ++i) { const float ga = fminf(gv[i], 7.0f), la = __builtin_amdgcn_fmed3f(lv[i], -7.0f, 7.0f);
                            o[i] = (ga * __builtin_amdgcn_rcpf(1.0f + __builtin_amdgcn_exp2f(ga * (-1.702f * 1.4426950408889634f)))) * __builtin_fmaf(la, F8_SC, F8_SC); }
                        w[mm][n] = pk4_fp8_nc(o[0], o[1], o[2], o[3]); }
                const auto r0 = __builtin_amdgcn_permlane16_swap(w[0][0], w[1][0], false, false), r1 = __builtin_amdgcn_permlane16_swap(w[0][1], w[1][1], false, false);
                const u32x4 ww = {r0[0], r1[0], r0[1], r1[1]};
                *(u32x4*)(obase + (size_t)(ai * HALF + mp * 32) * 2048) = ww; } }
    }
};
struct EpiY2f8 {
    static constexpr bool PERM = true, AFTER_DRAIN = false, LDS_BIAS = true;
    unsigned char* O; const float* bias;
    __device__ __forceinline__ void stage_bias(const Unit& u, PG8_LAS unsigned char* dst, int lane) const {
        __builtin_amdgcn_global_load_lds((const unsigned*)(bias + (size_t)u.pn * BM + 4 * lane), (PG8_LAS unsigned*)dst, 16, 0, 0); }
    __device__ __forceinline__ void operator()(const f32x4 (&acc)[2][2][4][2], const Unit& u, int wr, int wc, int fr, int fq, const PG8_LAS unsigned char* lb) const {
        const int row0 = u.po * BM + wr * 64 + fr; constexpr float us = F8_SY / (F8_SC * F8_SW);
        f32x4 bv[2][2];
#pragma unroll
        for (int bj = 0; bj < 2; ++bj)
#pragma unroll
            for (int n = 0; n < 2; ++n) bv[bj][n] = *(const PG8_LAS f32x4*)((const PG8_LAS float*)lb + wc * 32 + 8 * fq + bj * HALF + 4 * n) * F8_SY;
        unsigned char* obase = O + (size_t)(row0 + (fq & 1) * 16) * 2048 + (u.pn & 7) * BM + wc * 32 + 16 * (fq >> 1);
#pragma unroll
        for (int ai = 0; ai < 2; ++ai) { if (ai == 1 && u.hf) break;
#pragma unroll
            for (int mp = 0; mp < 2; ++mp)
#pragma unroll
                for (int bj = 0; bj < 2; ++bj) { unsigned w[2][2];
#pragma unroll
                    for (int mm = 0; mm < 2; ++mm)
#pragma unroll
                        for (int n = 0; n < 2; ++n) { const f32x4 v = acc[ai][bj][2 * mp + mm][n] * us + bv[bj][n]; w[mm][n] = pk4_fp8(v[0], v[1], v[2], v[3]); }
                    const auto r0 = __builtin_amdgcn_permlane16_swap(w[0][0], w[1][0], false, false), r1 = __builtin_amdgcn_permlane16_swap(w[0][1], w[1][1], false, false);
                    const u32x4 ww = {r0[0], r1[0], r0[1], r1[1]};
                    *(u32x4*)(obase + (size_t)(ai * HALF + mp * 32) * 2048 + bj * HALF) = ww; } }
    }
};
struct EpiGate8 {
    static constexpr bool PERM = true, AFTER_DRAIN = false, LDS_BIAS = false;
    bf16_t* O; int ldc; unsigned char* G8; unsigned char* O8;
    __device__ __forceinline__ void operator()(const f32x4 (&acc)[2][2][4][2], const Unit& u, int wr, int wc, int fr, int fq) const {
        const int row0 = u.po * BM + wr * 64 + fr, col0 = (u.pn < 24 ? u.pn : u.pn + 8) * BM + wc * 32 + 8 * fq; constexpr float us = 1.0f / (F8_SA * F8_SW);
        if (u.pn >= 32 || (u.pn >> 3) == 2) {
            constexpr float ug = F8_SG / (F8_SA * F8_SW); const bool mg = u.pn >= 32; const size_t ldg = mg ? 4096 : 2048;
            unsigned char* obase = (mg ? G8 : O8) + (size_t)(row0 + (fq & 1) * 16) * ldg + (mg ? u.pn - 32 : u.pn - 16) * BM + wc * 32 + 16 * (fq >> 1);
#pragma unroll
            for (int ai = 0; ai < 2; ++ai)
#pragma unroll
                for (int mp = 0; mp < 2; ++mp)
#pragma unroll
                    for (int bj = 0; bj < 2; ++bj) { unsigned w[2][2];
#pragma unroll
                        for (int mm = 0; mm < 2; ++mm)
#pragma unroll
                            for (int n = 0; n < 2; ++n) { const f32x4 v = acc[ai][bj][2 * mp + mm][n] * ug; w[mm][n] = pk4_fp8(v[0], v[1], v[2], v[3]); }
                        const auto r0 = __builtin_amdgcn_permlane16_swap(w[0][0], w[1][0], false, false), r1 = __builtin_amdgcn_permlane16_swap(w[0][1], w[1][1], false, false);
                        const u32x4 ww = {r0[0], r1[0], r0[1], r1[1]};
                        *(u32x4*)(obase + (size_t)(ai * HALF + mp * 32) * ldg + bj * HALF) = ww; }
            return; }
#pragma unroll
        for (int ai = 0; ai < 2; ++ai)
#pragma unroll
            for (int m = 0; m < 4; ++m) { bf16_t* rowp = O + (size_t)(row0 + ai * HALF + m * 16) * ldc + col0;
#pragma unroll
                for (int bj = 0; bj < 2; ++bj) { const f32x4 v0 = acc[ai][bj][m][0] * us, v1 = acc[ai][bj][m][1] * us;
                    u32x4 w; w.x = cvt_pk_bf16(v0[0], v0[1]); w.y = cvt_pk_bf16(v0[2], v0[3]); w.z = cvt_pk_bf16(v1[0], v1[1]); w.w = cvt_pk_bf16(v1[2], v1[3]);
                    __builtin_nontemporal_store(w, (u32x4*)(rowp + bj * HALF)); } }
    }
};
struct EpiF32 {
    static constexpr bool PERM = false, AFTER_DRAIN = false;
    float* C; int ldc;
    __device__ __forceinline__ void operator()(const f32x4 (&acc)[2][2][4][2], const Unit& u, int wr, int wc, int fr, int fq) const {
        const int row0 = u.po * BM + wr * 64 + fr, col0 = u.pn * BM + wc * 32 + 4 * fq;
#pragma unroll
        for (int ai = 0; ai < 2; ++ai)
#pragma unroll
            for (int m = 0; m < 4; ++m) { float* rowp = C + (size_t)(row0 + ai * HALF + m * 16) * ldc + col0;
#pragma unroll
                for (int bj = 0; bj < 2; ++bj)
#pragma unroll
                    for (int n = 0; n < 2; ++n) *(f32x4*)(rowp + bj * HALF + n * 16) = acc[ai][bj][m][n]; }
    }
};
struct EpiMerge {
    static constexpr bool PERM = true, AFTER_DRAIN = false;
    bf16_t* O; const bf16_t* Z; int ldz, ga_off, gb_off; const bf16_t* YB;
    __device__ __forceinline__ void operator()(const f32x4 (&acc)[2][2][4][2], const Unit& u, int wr, int wc, int fr, int fq) const {
        const int row0 = u.po * BM + wr * 64 + fr, col0 = u.pn * BM + wc * 32 + 8 * fq;
#pragma unroll
        for (int ai = 0; ai < 2; ++ai)
#pragma unroll
            for (int m = 0; m < 4; ++m) { const size_t row = (size_t)(row0 + ai * HALF + m * 16);
#pragma unroll
                for (int bj = 0; bj < 2; ++bj) { const int col = col0 + bj * HALF;
                    const u32x4 ga = *(const u32x4*)(Z + row * ldz + ga_off + col), gb = *(const u32x4*)(Z + row * ldz + gb_off + col);
                    const u32x4 yw = *(const u32x4*)(YB + row * 2048 + col); const f32x4 y0 = {bf_lo(yw.x), bf_hi(yw.x), bf_lo(yw.y), bf_hi(yw.y)}, y1 = {bf_lo(yw.z), bf_hi(yw.z), bf_lo(yw.w), bf_hi(yw.w)};
                    const f32x4 a0 = acc[ai][bj][m][0], a1 = acc[ai][bj][m][1];
                    float o[8];
                    o[0] = sigmoidf_(bf_lo(ga.x)) * a0[0] + sigmoidf_(bf_lo(gb.x)) * y0[0]; o[1] = sigmoidf_(bf_hi(ga.x)) * a0[1] + sigmoidf_(bf_hi(gb.x)) * y0[1];
                    o[2] = sigmoidf_(bf_lo(ga.y)) * a0[2] + sigmoidf_(bf_lo(gb.y)) * y0[2]; o[3] = sigmoidf_(bf_hi(ga.y)) * a0[3] + sigmoidf_(bf_hi(gb.y)) * y0[3];
                    o[4] = sigmoidf_(bf_lo(ga.z)) * a1[0] + sigmoidf_(bf_lo(gb.z)) * y1[0]; o[5] = sigmoidf_(bf_hi(ga.z)) * a1[1] + sigmoidf_(bf_hi(gb.z)) * y1[1];
                    o[6] = sigmoidf_(bf_lo(ga.w)) * a1[2] + sigmoidf_(bf_lo(gb.w)) * y1[2]; o[7] = sigmoidf_(bf_hi(ga.w)) * a1[3] + sigmoidf_(bf_hi(gb.w)) * y1[3];
                    u32x4 w; w.x = cvt_pk_bf16(o[0], o[1]); w.y = cvt_pk_bf16(o[2], o[3]); w.z = cvt_pk_bf16(o[4], o[5]); w.w = cvt_pk_bf16(o[6], o[7]);
                    *(u32x4*)(O + row * 2048 + col) = w; } }
    }
};
struct EpiMerge2 {
    static constexpr bool PERM = true, AFTER_DRAIN = false, CHAIN = true;
    bf16_t* O; const unsigned char* G8;
    __device__ __forceinline__ void mid(f32x4 (&acc)[2][2][4][2], const Unit& u, int wr, int wc, int fr, int fq) const {
        const int row0 = u.po * BM + wr * 64 + fr, col0 = (u.pn & 7) * BM + wc * 32 + 8 * fq;
#pragma unroll
        for (int ai = 0; ai < 2; ++ai)
#pragma unroll
            for (int m = 0; m < 4; ++m) { const size_t row = (size_t)(row0 + ai * HALF + m * 16);
#pragma unroll
                for (int bj = 0; bj < 2; ++bj) { const int col = col0 + bj * HALF;
                    typedef unsigned u32x2 __attribute__((ext_vector_type(2)));
                    const u32x2 ga = *(const u32x2*)(G8 + row * 4096 + col), gb = *(const u32x2*)(G8 + row * 4096 + 2048 + col);
                    float a8[8], b8[8]; { const auto t0 = __builtin_amdgcn_cvt_pk_f32_fp8((int)ga.x, false), t1 = __builtin_amdgcn_cvt_pk_f32_fp8((int)ga.x, true), t2 = __builtin_amdgcn_cvt_pk_f32_fp8((int)ga.y, false), t3 = __builtin_amdgcn_cvt_pk_f32_fp8((int)ga.y, true);
                        a8[0] = t0[0]; a8[1] = t0[1]; a8[2] = t1[0]; a8[3] = t1[1]; a8[4] = t2[0]; a8[5] = t2[1]; a8[6] = t3[0]; a8[7] = t3[1]; }
                    { const auto t0 = __builtin_amdgcn_cvt_pk_f32_fp8((int)gb.x, false), t1 = __builtin_amdgcn_cvt_pk_f32_fp8((int)gb.x, true), t2 = __builtin_amdgcn_cvt_pk_f32_fp8((int)gb.y, false), t3 = __builtin_amdgcn_cvt_pk_f32_fp8((int)gb.y, true);
                        b8[0] = t0[0]; b8[1] = t0[1]; b8[2] = t1[0]; b8[3] = t1[1]; b8[4] = t2[0]; b8[5] = t2[1]; b8[6] = t3[0]; b8[7] = t3[1]; }
                    float r[8];
#pragma unroll
                    for (int i = 0; i < 8; ++i) r[i] = (1.0f + __expf(b8[i] * (-1.0f / F8_SG))) * __builtin_amdgcn_rcpf(1.0f + __expf(a8[i] * (-1.0f / F8_SG)));
                    acc[ai][bj][m][0] = acc[ai][bj][m][0] * (f32x4){r[0], r[1], r[2], r[3]}; acc[ai][bj][m][1] = acc[ai][bj][m][1] * (f32x4){r[4], r[5], r[6], r[7]}; } }
    }
    __device__ __forceinline__ void operator()(const f32x4 (&acc)[2][2][4][2], const Unit& u, int wr, int wc, int fr, int fq) const {
        const int row0 = u.po * BM + wr * 64 + fr, col0 = (u.pn & 7) * BM + wc * 32 + 8 * fq;
#pragma unroll
        for (int ai = 0; ai < 2; ++ai)
#pragma unroll
            for (int m = 0; m < 4; ++m) { const size_t row = (size_t)(row0 + ai * HALF + m * 16);
#pragma unroll
                for (int bj = 0; bj < 2; ++bj) { const int col = col0 + bj * HALF;
                    typedef unsigned u32x2 __attribute__((ext_vector_type(2)));
                    const u32x2 gb = *(const u32x2*)(G8 + row * 4096 + 2048 + col);
                    const f32x4 a0 = acc[ai][bj][m][0], a1 = acc[ai][bj][m][1];
                    const auto t0 = __builtin_amdgcn_cvt_pk_f32_fp8((int)gb.x, false), t1 = __builtin_amdgcn_cvt_pk_f32_fp8((int)gb.x, true), t2 = __builtin_amdgcn_cvt_pk_f32_fp8((int)gb.y, false), t3 = __builtin_amdgcn_cvt_pk_f32_fp8((int)gb.y, true);
                    float o[8];
                    o[0] = sigmoidf_(t0[0] * (1.0f / F8_SG)) * a0[0]; o[1] = sigmoidf_(t0[1] * (1.0f / F8_SG)) * a0[1]; o[2] = sigmoidf_(t1[0] * (1.0f / F8_SG)) * a0[2]; o[3] = sigmoidf_(t1[1] * (1.0f / F8_SG)) * a0[3];
                    o[4] = sigmoidf_(t2[0] * (1.0f / F8_SG)) * a1[0]; o[5] = sigmoidf_(t2[1] * (1.0f / F8_SG)) * a1[1]; o[6] = sigmoidf_(t3[0] * (1.0f / F8_SG)) * a1[2]; o[7] = sigmoidf_(t3[1] * (1.0f / F8_SG)) * a1[3];
                    u32x4 w; w.x = cvt_pk_bf16(o[0], o[1]); w.y = cvt_pk_bf16(o[2], o[3]); w.z = cvt_pk_bf16(o[4], o[5]); w.w = cvt_pk_bf16(o[6], o[7]);
                    *(u32x4*)(O + row * 2048 + col) = w; } }
    }
};
struct EpiD {
    static constexpr bool PERM = true, AFTER_DRAIN = false, CHAIN = false;
    bf16_t* O; const float* mod;
    __device__ __forceinline__ void operator()(const f32x4 (&acc)[2][2][4][2], const Unit& u, int wr, int wc, int fr, int fq) const {
        const int row0 = u.po * BM + wr * 64 + fr, col0 = u.pn * BM + wc * 32 + 8 * fq;
        const float* mg = mod + (size_t)((u.po * BM) >> 11) * 12288 + 2 * 2048 + col0;
        f32x4 gv[2][2];
#pragma unroll
        for (int bj = 0; bj < 2; ++bj)
#pragma unroll
            for (int n = 0; n < 2; ++n) gv[bj][n] = *(const f32x4*)(mg + bj * HALF + 4 * n);
#pragma unroll
        for (int ai = 0; ai < 2; ++ai)
#pragma unroll
            for (int m = 0; m < 4; ++m) { bf16_t* rowp = O + (size_t)(row0 + ai * HALF + m * 16) * 2048 + col0;
#pragma unroll
                for (int bj = 0; bj < 2; ++bj) { const f32x4 v0 = acc[ai][bj][m][0] * gv[bj][0], v1 = acc[ai][bj][m][1] * gv[bj][1];
                    u32x4 w; w.x = cvt_pk_bf16(v0[0], v0[1]); w.y = cvt_pk_bf16(v0[2], v0[3]); w.z = cvt_pk_bf16(v1[0], v1[1]); w.w = cvt_pk_bf16(v1[2], v1[3]);
                    *(u32x4*)(rowp + bj * HALF) = w; } }
    }
};
struct EpiX1 {
    static constexpr bool PERM = false, AFTER_DRAIN = false, CHAIN = false;
    float* X1; const float* X; const float* mod;
    __device__ __forceinline__ void operator()(const f32x4 (&acc)[2][2][4][2], const Unit& u, int wr, int wc, int fr, int fq) const {
        const int row0 = u.po * BM + wr * 64 + fr, col0 = u.pn * BM + wc * 32 + 4 * fq;
        const float* mg = mod + (size_t)((u.po * BM) >> 11) * 12288 + 2 * 2048;
#pragma unroll
        for (int bj = 0; bj < 2; ++bj)
#pragma unroll
            for (int n = 0; n < 2; ++n) { const int col = col0 + bj * HALF + n * 16; const f32x4 g = *(const f32x4*)(mg + col);
#pragma unroll
                for (int ai = 0; ai < 2; ++ai)
#pragma unroll
                    for (int m = 0; m < 4; ++m) { const size_t off = (size_t)(row0 + ai * HALF + m * 16) * 2048 + col;
                        *(f32x4*)(X1 + off) = *(const f32x4*)(X + off) + g * acc[ai][bj][m][n]; } }
    }
};
struct EpiSwiglu {
    static constexpr bool PERM = true, AFTER_DRAIN = false;
    bf16_t* O; const float* b1;
    __device__ __forceinline__ void operator()(const f32x4 (&acc)[2][2][4][2], const Unit& u, int wr, int wc, int fr, int fq) const {
        const int e = u.pn >> 4, nt = u.pn & 15; const int row0 = u.po * BM + wr * 64 + fr, j0 = nt * 128 + wc * 32 + 8 * fq;
        const float* bg = b1 + (size_t)e * 4096 + j0; const float* bl = bg + 2048;
#pragma unroll
        for (int ai = 0; ai < 2; ++ai)
#pragma unroll
            for (int m = 0; m < 4; ++m) { const size_t row = (size_t)(row0 + ai * HALF + m * 16);
                asm volatile("" ::: "memory");
#pragma unroll
                for (int n = 0; n < 2; ++n) { const f32x4 gv = acc[ai][0][m][n] + *(const f32x4*)(bg + 4 * n), lv = acc[ai][1][m][n] + *(const f32x4*)(bl + 4 * n);
                    float o[4];
#pragma unroll
                    for (int i = 0; i < 4; ++i) { const float ga = fminf(gv[i], 7.0f), la = fminf(fmaxf(lv[i], -7.0f), 7.0f); o[i] = ga * sigmoidf_(1.702f * ga) * (la + 1.0f); }
                    typedef unsigned u32x2 __attribute__((ext_vector_type(2))); u32x2 w; w.x = cvt_pk_bf16(o[0], o[1]); w.y = cvt_pk_bf16(o[2], o[3]);
                    *(u32x2*)(O + row * 2048 + j0 + 4 * n) = w; } }
    }
};

template <class Epi, class Sched, bool ALIGN_EPI = false, bool SP2 = false, bool HALFSKIP = false>
__device__ __forceinline__ void gemm_phase(PG8_LAS unsigned char* lds, const Gemm g, const Sched& S, const Epi& E) {
    const int tid = threadIdx.x, wid = __builtin_amdgcn_readfirstlane(tid >> 6), lane = tid & 63, wr = wid >> 2, wc = wid & 3, fr = lane & 15, fq = lane >> 4;
    const int K = g.K, nt = K / BK;
    unsigned voffA[2], voffB[2];
#pragma unroll
    for (int i = 0; i < 2; ++i) { int R, C; stage_rc(tid * 16 + i * 8192, R, C); const int Rb = Epi::PERM ? ((R & ~31) + perm32(R & 31)) : R;
        voffA[i] = (unsigned)(R * K + C) * 2u; voffB[i] = (unsigned)(Rb * K + C) * 2u; }
    const size_t kstep = (size_t)(BK * 2);
    const size_t hstep = (size_t)HALF * K * 2;
    const size_t tstep = 2 * hstep;
    const unsigned ldsw = (unsigned)wid * 1024u;
    const int aoff = lds_byte(wr * 64 + fr, fq * 8), boff = lds_byte(wc * 32 + fr, fq * 8);
#define PG8_SA(b, h) (((b) * 2 + (h)) * HTB)
#define PG8_SB(b, h) ((4 + (b) * 2 + (h)) * HTB)
#define PG8_STAGE(bufoff, gbase, voff) do { _Pragma("unroll") for (int _i = 0; _i < 2; ++_i) \
        __builtin_amdgcn_global_load_lds((const unsigned*)((const char*)(gbase) + (voff)[_i]), (PG8_LAS unsigned*)(lds + (bufoff) + ldsw + _i * 8192), 16, 0, 0); } while (0)
#define PG8_LDA(dst, b, h) do { _Pragma("unroll") for (int m = 0; m < 4; ++m) _Pragma("unroll") for (int k = 0; k < 2; ++k) dst[m][k] = *(const PG8_LAS bf16x8*)(lds + PG8_SA(b, h) + aoff + m * 2048 + k * 1024); } while (0)
#define PG8_LDB(dst, b, h) do { _Pragma("unroll") for (int n = 0; n < 2; ++n) _Pragma("unroll") for (int k = 0; k < 2; ++k) dst[n][k] = *(const PG8_LAS bf16x8*)(lds + PG8_SB(b, h) + boff + n * 2048 + k * 1024); } while (0)
#define PG8_MMA(ai, bj, At, Bt) do { __builtin_amdgcn_s_setprio(1); _Pragma("unroll") for (int m = 0; m < 4; ++m) _Pragma("unroll") for (int n = 0; n < 2; ++n) _Pragma("unroll") for (int k = 0; k < 2; ++k) \
        acc[ai][bj][m][n] = __builtin_amdgcn_mfma_f32_16x16x32_bf16(Bt[n][k], At[m][k], acc[ai][bj][m][n], 0, 0, 0); __builtin_amdgcn_s_setprio(0); } while (0)
#define PG8_WAIT_V(n) asm volatile("s_waitcnt vmcnt(" #n ")" ::: "memory")
#define PG8_WAIT_L(n) asm volatile("s_waitcnt lgkmcnt(" #n ")" ::: "memory")
#define PG8_BAR __builtin_amdgcn_s_barrier()
#define PG8_SCHED __builtin_amdgcn_sched_barrier(0)
    Unit cur, nxt; int ui = 0;
    if (!S.next(0, cur)) return;
    f32x4 acc[2][2][4][2];
#pragma unroll
    for (int a = 0; a < 2; ++a)
#pragma unroll
        for (int b = 0; b < 2; ++b)
#pragma unroll
            for (int m = 0; m < 4; ++m)
#pragma unroll
                for (int n = 0; n < 2; ++n) acc[a][b][m][n] = (f32x4){0.f, 0.f, 0.f, 0.f};
    bf16x8 At[4][2], B0[2][2], B1[2][2];
    const char* cA = (const char*)g.A + (size_t)cur.pm * tstep; const char* cB = (const char*)g.Bt + (size_t)cur.pn * tstep;
    S.a_ready(cur);
    if constexpr (SP2) {
        PG8_STAGE(PG8_SB(0, 0), cB, voffB); PG8_STAGE(PG8_SB(0, 1), cB + hstep, voffB); PG8_STAGE(PG8_SA(0, 0), cA, voffA); PG8_STAGE(PG8_SA(0, 1), cA + hstep, voffA);
        if (wr == 1) PG8_BAR;
        PG8_WAIT_V(2); PG8_BAR;
        PG8_STAGE(PG8_SB(1, 0), cB + kstep, voffB); PG8_STAGE(PG8_SA(1, 0), cA + kstep, voffA); PG8_STAGE(PG8_SB(1, 1), cB + hstep + kstep, voffB);
        PG8_WAIT_V(6); PG8_BAR;
    } else {
        PG8_STAGE(PG8_SB(0, 0), cB, voffB); PG8_STAGE(PG8_SA(0, 0), cA, voffA); PG8_STAGE(PG8_SB(0, 1), cB + hstep, voffB); PG8_STAGE(PG8_SA(0, 1), cA + hstep, voffA);
        if (wr == 1) PG8_BAR;
        PG8_WAIT_V(4); PG8_BAR;
        PG8_STAGE(PG8_SB(1, 0), cB + kstep, voffB); PG8_STAGE(PG8_SA(1, 0), cA + kstep, voffA); PG8_STAGE(PG8_SB(1, 1), cB + hstep + kstep, voffB);
        PG8_WAIT_V(6); PG8_BAR;
    }
    for (;;) {
        const bool has_next = S.next(ui + 1, nxt);
        const char* nA = has_next ? (const char*)g.A + (size_t)nxt.pm * tstep : cA; const char* nB = has_next ? (const char*)g.Bt + (size_t)nxt.pn * tstep : cB;
        for (int t = 0; t < nt; t += 2) {
            const bool last = (t == nt - 2);
            const char* a1 = cA + (size_t)(t + 1) * kstep;
            const char* a2 = last ? nA : cA + (size_t)(t + 2) * kstep; const char* b2 = last ? nB : cB + (size_t)(t + 2) * kstep;
            const char* a3 = a2 + kstep; const char* b3 = b2 + kstep;
            if (last && has_next) S.a_ready(nxt);
            if constexpr (SP2) {
            PG8_LDB(B0, 0, 0); PG8_LDB(B1, 0, 1); PG8_SCHED; PG8_LDA(At, 0, 0); PG8_STAGE(PG8_SA(1, 1), a1 + hstep, voffA);
            PG8_WAIT_V(8); PG8_WAIT_L(0); PG8_BAR; PG8_MMA(0, 0, At, B0); PG8_MMA(0, 1, At, B1); PG8_BAR; PG8_SCHED;
            PG8_LDA(At, 0, 1); PG8_STAGE(PG8_SB(0, 0), b2, voffB); PG8_STAGE(PG8_SB(0, 1), b2 + hstep, voffB); PG8_STAGE(PG8_SA(0, 0), a2, voffA);
            PG8_WAIT_V(8); PG8_WAIT_L(0); PG8_BAR; if (!(HALFSKIP && cur.hf)) { PG8_MMA(1, 0, At, B0); PG8_MMA(1, 1, At, B1); } PG8_BAR; PG8_SCHED;
            PG8_LDB(B0, 1, 0); PG8_LDB(B1, 1, 1); PG8_SCHED; PG8_LDA(At, 1, 0); PG8_STAGE(PG8_SA(0, 1), a2 + hstep, voffA);
            PG8_WAIT_V(8); PG8_WAIT_L(0); PG8_BAR; PG8_MMA(0, 0, At, B0); PG8_MMA(0, 1, At, B1); PG8_BAR; PG8_SCHED;
            PG8_LDA(At, 1, 1); PG8_STAGE(PG8_SB(1, 0), b3, voffB); PG8_STAGE(PG8_SB(1, 1), b3 + hstep, voffB); PG8_STAGE(PG8_SA(1, 0), a3, voffA);
            PG8_WAIT_V(8); PG8_WAIT_L(0); PG8_BAR; if (!(HALFSKIP && cur.hf)) { PG8_MMA(1, 0, At, B0); PG8_MMA(1, 1, At, B1); } PG8_BAR; PG8_SCHED;
            } else {
            PG8_LDB(B0, 0, 0); PG8_SCHED; PG8_LDA(At, 0, 0); PG8_STAGE(PG8_SA(1, 1), a1 + hstep, voffA);
            PG8_WAIT_L(8); PG8_BAR; PG8_WAIT_L(0); PG8_MMA(0, 0, At, B0); PG8_BAR; PG8_SCHED;
            PG8_LDB(B1, 0, 1); PG8_STAGE(PG8_SB(0, 0), b2, voffB);
            PG8_BAR; PG8_WAIT_L(0); PG8_MMA(0, 1, At, B1); PG8_BAR;
            PG8_LDA(At, 0, 1); PG8_STAGE(PG8_SA(0, 0), a2, voffA);
            PG8_BAR; PG8_WAIT_L(0); PG8_MMA(1, 0, At, B0); PG8_BAR; PG8_SCHED;
            PG8_STAGE(PG8_SB(0, 1), b2 + hstep, voffB);
            PG8_WAIT_V(6); PG8_BAR; PG8_MMA(1, 1, At, B1); PG8_BAR;
            PG8_LDB(B0, 1, 0); PG8_SCHED; PG8_LDA(At, 1, 0); PG8_STAGE(PG8_SA(0, 1), a2 + hstep, voffA);
            PG8_WAIT_L(8); PG8_BAR; PG8_WAIT_L(0); PG8_MMA(0, 0, At, B0); PG8_BAR; PG8_SCHED;
            PG8_LDB(B1, 1, 1); PG8_STAGE(PG8_SB(1, 0), b3, voffB);
            PG8_BAR; PG8_WAIT_L(0); PG8_MMA(0, 1, At, B1); PG8_BAR;
            PG8_LDA(At, 1, 1); PG8_STAGE(PG8_SA(1, 0), a3, voffA);
            PG8_BAR; PG8_WAIT_L(0); PG8_MMA(1, 0, At, B0); PG8_BAR; PG8_SCHED;
            PG8_STAGE(PG8_SB(1, 1), b3 + hstep, voffB);
            PG8_WAIT_V(6); PG8_BAR; PG8_MMA(1, 1, At, B1); PG8_BAR;
            }
        }
        if constexpr (ALIGN_EPI) { if (wr == 0) PG8_BAR; }
        if constexpr (Epi::CHAIN) { if (cur.hf == 0) E.mid(acc, cur, wr, wc, fr, fq); else E(acc, cur, wr, wc, fr, fq); }
        else if constexpr (!Epi::AFTER_DRAIN) { E(acc, cur, wr, wc, fr, fq); S.done(cur); }
        if (!has_next) break;
        bool keep = false; if constexpr (Epi::CHAIN) keep = cur.hf == 0;
        if (!keep) {
#pragma unroll
        for (int a = 0; a < 2; ++a)
#pragma unroll
            for (int b = 0; b < 2; ++b)
#pragma unroll
                for (int m = 0; m < 4; ++m)
#pragma unroll
                    for (int n = 0; n < 2; ++n) acc[a][b][m][n] = (f32x4){0.f, 0.f, 0.f, 0.f};
        }
        cur = nxt; cA = nA; cB = nB; ++ui;
        if constexpr (ALIGN_EPI) { if (wr == 1) PG8_BAR; }
    }
    PG8_WAIT_V(0);
    if constexpr (!ALIGN_EPI) { if (wr == 0) PG8_BAR; }
    PG8_BAR;
    if constexpr (Epi::AFTER_DRAIN) { E.fused(acc, cur, wr, wc, fr, fq, lds, wid, lane); S.done(cur); }
#undef PG8_SA
#undef PG8_SB
#undef PG8_STAGE
#undef PG8_LDA
#undef PG8_LDB
#undef PG8_MMA
#undef PG8_WAIT_V
#undef PG8_WAIT_L
#undef PG8_BAR
#undef PG8_SCHED
}
template <class Epi, class Sched, bool ALIGN_EPI = false, bool SP2 = false, bool HALFSKIP = false>
__device__ __forceinline__ void gemm_phase8(PG8_LAS unsigned char* lds, const Gemm g, const Sched& S, const Epi& E) {
    const int tid = threadIdx.x, wid = __builtin_amdgcn_readfirstlane(tid >> 6), lane = tid & 63, wr = wid >> 2, wc = wid & 3, fr = lane & 15, fq = lane >> 4;
    const int K = g.K, nt = K / 128;
    unsigned voffA[2], voffB[2];
#pragma unroll
    for (int i = 0; i < 2; ++i) { int R, C; stage_rc(tid * 16 + i * 8192, R, C); const int Rb = Epi::PERM ? ((R & ~31) + perm32(R & 31)) : R;
        voffA[i] = (unsigned)(R * K + 2 * C); voffB[i] = (unsigned)(Rb * K + 2 * C); }
    const size_t kstep = (size_t)(BK * 2);
    const size_t hstep = (size_t)HALF * K;
    const size_t tstep = 2 * hstep;
    const unsigned ldsw = (unsigned)wid * 1024u;
    const int aoff = lds_byte(wr * 64 + fr, fq * 8), boff = lds_byte(wc * 32 + fr, fq * 8);
#define PG8_SA(b, h) (((b) * 2 + (h)) * HTB)
#define PG8_SB(b, h) ((4 + (b) * 2 + (h)) * HTB)
#define PG8_STAGE(bufoff, gbase, voff) do { _Pragma("unroll") for (int _i = 0; _i < 2; ++_i) \
        __builtin_amdgcn_global_load_lds((const unsigned*)((const char*)(gbase) + (voff)[_i]), (PG8_LAS unsigned*)(lds + (bufoff) + ldsw + _i * 8192), 16, 0, 0); } while (0)
#define PG8_LDA(dst, b, h) do { _Pragma("unroll") for (int m = 0; m < 4; ++m) { const i32x4 lo_ = *(const PG8_LAS i32x4*)(lds + PG8_SA(b, h) + aoff + m * 2048), hi_ = *(const PG8_LAS i32x4*)(lds + PG8_SA(b, h) + aoff + m * 2048 + 1024); dst[m] = __builtin_shufflevector(lo_, hi_, 0, 1, 2, 3, 4, 5, 6, 7); } } while (0)
#define PG8_LDB(dst, b, h) do { _Pragma("unroll") for (int n = 0; n < 2; ++n) { const i32x4 lo_ = *(const PG8_LAS i32x4*)(lds + PG8_SB(b, h) + boff + n * 2048), hi_ = *(const PG8_LAS i32x4*)(lds + PG8_SB(b, h) + boff + n * 2048 + 1024); dst[n] = __builtin_shufflevector(lo_, hi_, 0, 1, 2, 3, 4, 5, 6, 7); } } while (0)
#define PG8_MMA(ai, bj, At, Bt) do { __builtin_amdgcn_s_setprio(1); _Pragma("unroll") for (int m = 0; m < 4; ++m) _Pragma("unroll") for (int n = 0; n < 2; ++n) \
        asm volatile("v_mfma_scale_f32_16x16x128_f8f6f4 %0, %1, %2, %0, %3, %3 op_sel_hi:[0,0,0]" : "+v"(acc[ai][bj][m][n]) : "v"(Bt[n]), "v"(At[m]), "v"(sc127)); __builtin_amdgcn_s_setprio(0); } while (0)
#define PG8_WAIT_V(n) asm volatile("s_waitcnt vmcnt(" #n ")" ::: "memory")
#define PG8_WAIT_L(n) asm volatile("s_waitcnt lgkmcnt(" #n ")" ::: "memory")
#define PG8_BAR __builtin_amdgcn_s_barrier()
#define PG8_SCHED __builtin_amdgcn_sched_barrier(0)
    Unit cur, nxt; int ui = 0;
    if (!S.next(0, cur)) return;
    f32x4 acc[2][2][4][2];
#pragma unroll
    for (int a = 0; a < 2; ++a)
#pragma unroll
        for (int b = 0; b < 2; ++b)
#pragma unroll
            for (int m = 0; m < 4; ++m)
#pragma unroll
                for (int n = 0; n < 2; ++n) acc[a][b][m][n] = (f32x4){0.f, 0.f, 0.f, 0.f};
    i32x8 At[4], B0[2], B1[2]; const int sc127 = 127;
    const char* cA = (const char*)g.A + (size_t)cur.pm * tstep; const char* cB = (const char*)g.Bt + (size_t)cur.pn * tstep;
    S.a_ready(cur);
    constexpr int BIAS_OFF = 8 * HTB;
    if constexpr (Epi::LDS_BIAS) { if (wid == 0) E.stage_bias(cur, lds + BIAS_OFF, lane); }
    if constexpr (SP2) {
        PG8_STAGE(PG8_SB(0, 0), cB, voffB); PG8_STAGE(PG8_SB(0, 1), cB + hstep, voffB); PG8_STAGE(PG8_SA(0, 0), cA, voffA); PG8_STAGE(PG8_SA(0, 1), cA + hstep, voffA);
        if (wr == 1) PG8_BAR;
        PG8_WAIT_V(2); PG8_BAR;
        PG8_STAGE(PG8_SB(1, 0), cB + kstep, voffB); PG8_STAGE(PG8_SA(1, 0), cA + kstep, voffA); PG8_STAGE(PG8_SB(1, 1), cB + hstep + kstep, voffB);
        PG8_WAIT_V(6); PG8_BAR;
    } else {
        PG8_STAGE(PG8_SB(0, 0), cB, voffB); PG8_STAGE(PG8_SA(0, 0), cA, voffA); PG8_STAGE(PG8_SB(0, 1), cB + hstep, voffB); PG8_STAGE(PG8_SA(0, 1), cA + hstep, voffA);
        if (wr == 1) PG8_BAR;
        PG8_WAIT_V(4); PG8_BAR;
        PG8_STAGE(PG8_SB(1, 0), cB + kstep, voffB); PG8_STAGE(PG8_SA(1, 0), cA + kstep, voffA); PG8_STAGE(PG8_SB(1, 1), cB + hstep + kstep, voffB);
        PG8_WAIT_V(6); PG8_BAR;
    }
    for (;;) {
        const bool has_next = S.next(ui + 1, nxt);
        const char* nA = has_next ? (const char*)g.A + (size_t)nxt.pm * tstep : cA; const char* nB = has_next ? (const char*)g.Bt + (size_t)nxt.pn * tstep : cB;
        for (int t = 0; t < nt; t += 2) {
            const bool last = (t == nt - 2);
            const char* a1 = cA + (size_t)(t + 1) * kstep;
            const char* a2 = last ? nA : cA + (size_t)(t + 2) * kstep; const char* b2 = last ? nB : cB + (size_t)(t + 2) * kstep;
            const char* a3 = a2 + kstep; const char* b3 = b2 + kstep;
            if (last && has_next) S.a_ready(nxt);
            if constexpr (SP2) {
            PG8_LDB(B0, 0, 0); PG8_LDB(B1, 0, 1); PG8_SCHED; PG8_LDA(At, 0, 0); PG8_STAGE(PG8_SA(1, 1), a1 + hstep, voffA);
            PG8_WAIT_V(8); PG8_WAIT_L(0); PG8_BAR; PG8_MMA(0, 0, At, B0); PG8_MMA(0, 1, At, B1); PG8_BAR; PG8_SCHED;
            if (!(HALFSKIP && cur.hf)) PG8_LDA(At, 0, 1); PG8_STAGE(PG8_SB(0, 0), b2, voffB); PG8_STAGE(PG8_SB(0, 1), b2 + hstep, voffB); PG8_STAGE(PG8_SA(0, 0), a2, voffA);
            PG8_WAIT_V(8); PG8_WAIT_L(0); PG8_BAR; if (!(HALFSKIP && cur.hf)) { PG8_MMA(1, 0, At, B0); PG8_MMA(1, 1, At, B1); } PG8_BAR; PG8_SCHED;
            PG8_LDB(B0, 1, 0); PG8_LDB(B1, 1, 1); PG8_SCHED; PG8_LDA(At, 1, 0); PG8_STAGE(PG8_SA(0, 1), a2 + hstep, voffA);
            PG8_WAIT_V(8); PG8_WAIT_L(0); PG8_BAR; PG8_MMA(0, 0, At, B0); PG8_MMA(0, 1, At, B1); PG8_BAR; PG8_SCHED;
            if (!(HALFSKIP && cur.hf)) PG8_LDA(At, 1, 1); PG8_STAGE(PG8_SB(1, 0), b3, voffB); PG8_STAGE(PG8_SB(1, 1), b3 + hstep, voffB); PG8_STAGE(PG8_SA(1, 0), a3, voffA);
            PG8_WAIT_V(8); PG8_WAIT_L(0); PG8_BAR; if (!(HALFSKIP && cur.hf)) { PG8_MMA(1, 0, At, B0); PG8_MMA(1, 1, At, B1); } PG8_BAR; PG8_SCHED;
            } else {
            PG8_LDB(B0, 0, 0); PG8_SCHED; PG8_LDA(At, 0, 0); PG8_STAGE(PG8_SA(1, 1), a1 + hstep, voffA);
            PG8_WAIT_L(8); PG8_BAR; PG8_WAIT_L(0); PG8_MMA(0, 0, At, B0); PG8_BAR; PG8_SCHED;
            PG8_LDB(B1, 0, 1); PG8_STAGE(PG8_SB(0, 0), b2, voffB);
            PG8_BAR; PG8_WAIT_L(0); PG8_MMA(0, 1, At, B1); PG8_BAR;
            PG8_LDA(At, 0, 1); PG8_STAGE(PG8_SA(0, 0), a2, voffA);
            PG8_BAR; PG8_WAIT_L(0); PG8_MMA(1, 0, At, B0); PG8_BAR; PG8_SCHED;
            PG8_STAGE(PG8_SB(0, 1), b2 + hstep, voffB);
            PG8_WAIT_V(6); PG8_BAR; PG8_MMA(1, 1, At, B1); PG8_BAR;
            PG8_LDB(B0, 1, 0); PG8_SCHED; PG8_LDA(At, 1, 0); PG8_STAGE(PG8_SA(0, 1), a2 + hstep, voffA);
            PG8_WAIT_L(8); PG8_BAR; PG8_WAIT_L(0); PG8_MMA(0, 0, At, B0); PG8_BAR; PG8_SCHED;
            PG8_LDB(B1, 1, 1); PG8_STAGE(PG8_SB(1, 0), b3, voffB);
            PG8_BAR; PG8_WAIT_L(0); PG8_MMA(0, 1, At, B1); PG8_BAR;
            PG8_LDA(At, 1, 1); PG8_STAGE(PG8_SA(1, 0), a3, voffA);
            PG8_BAR; PG8_WAIT_L(0); PG8_MMA(1, 0, At, B0); PG8_BAR; PG8_SCHED;
            PG8_STAGE(PG8_SB(1, 1), b3 + hstep, voffB);
            PG8_WAIT_V(6); PG8_BAR; PG8_MMA(1, 1, At, B1); PG8_BAR;
            }
        }
        if constexpr (ALIGN_EPI) { if (wr == 0) PG8_BAR; }
        if constexpr (!Epi::AFTER_DRAIN) { if constexpr (Epi::LDS_BIAS) E(acc, cur, wr, wc, fr, fq, lds + BIAS_OFF + (ui & 1) * 1024); else E(acc, cur, wr, wc, fr, fq); S.done(cur); }
        if (!has_next) break;
#pragma unroll
        for (int a = 0; a < 2; ++a)
#pragma unroll
            for (int b = 0; b < 2; ++b)
#pragma unroll
                for (int m = 0; m < 4; ++m)
#pragma unroll
                    for (int n = 0; n < 2; ++n) acc[a][b][m][n] = (f32x4){0.f, 0.f, 0.f, 0.f};
        cur = nxt; cA = nA; cB = nB; ++ui;
        if constexpr (Epi::LDS_BIAS) { if (wid == 0) E.stage_bias(cur, lds + BIAS_OFF + (ui & 1) * 1024, lane); }
        if constexpr (ALIGN_EPI) { if (wr == 1) PG8_BAR; }
    }
    PG8_WAIT_V(0);
    if constexpr (!ALIGN_EPI) { if (wr == 0) PG8_BAR; }
    PG8_BAR;
    if constexpr (Epi::AFTER_DRAIN) { E.fused(acc, cur, wr, wc, fr, fq, lds, wid, lane); S.done(cur); }
#undef PG8_SA
#undef PG8_SB
#undef PG8_STAGE
#undef PG8_LDA
#undef PG8_LDB
#undef PG8_MMA
#undef PG8_WAIT_V
#undef PG8_WAIT_L
#undef PG8_BAR
#undef PG8_SCHED
}
}

constexpr int NWAVES = 8, NTHR = 512;
constexpr int N_LAUNCHES = MK_N_LAUNCHES;
constexpr int N_PHASES = 13;
constexpr int DM = 2048, NB = 4, TL = 2048, NLAT = NB * TL, TCX = 256, NCTX = NB * TCX, NTOK = NLAT + NCTX;
constexpr int NH = 8, QKD = 128, VD = 256, INC = 14368, ZW = 14336;
constexpr int ZQ = 0, ZK = 1024, ZV = 2048, ZO = 4096, ZU = 6144, ZS = 8192, ZGA = 10240, ZGB = 12288;
constexpr int NEXP = 32, DEXP = 2048, NCH = 18  , CROWS = 272  ;
constexpr float EPS = 1e-6f;

constexpr size_t MiB = 1u << 20;
constexpr size_t WS_CTL = 0, CTL_ZERO_BYTES = 64 * 1024;
constexpr size_t WS_MOD = 1 * MiB;
constexpr size_t WS_GATES = 2 * MiB;
constexpr size_t WS_SCAL = 4 * MiB;
constexpr size_t WS_ROUTE = 5 * MiB;
constexpr size_t WS_SCN = 2996 * MiB;
constexpr size_t WS_SK = 6 * MiB;
constexpr size_t WS_WINT = 8 * MiB;
constexpr size_t WS_PAT = 64 * MiB, WS_PBT = 72 * MiB, WS_WOT = 80 * MiB;
constexpr size_t WS_W1T = 88 * MiB;
constexpr size_t WS_W2T = 600 * MiB;
constexpr size_t WS_HB = 856 * MiB;
constexpr size_t WS_Z = 892 * MiB;
constexpr size_t WS_QC = 1144 * MiB, WS_KC = 1162 * MiB;
constexpr size_t WS_SVN = 1180 * MiB;
constexpr size_t WS_DC = 1212 * MiB;
constexpr size_t WS_CS = 1360 * MiB;
constexpr size_t WS_RO = 1428 * MiB;
constexpr size_t WS_CM = 1460 * MiB;
constexpr size_t WS_YB = 1492 * MiB;
constexpr size_t WS_MRG = 1556 * MiB;
constexpr size_t WS_X1 = 1588 * MiB;
constexpr size_t WS_ACT = 1652 * MiB;
constexpr size_t WS_Y2 = 1812 * MiB;
constexpr size_t WS_XG = 1972 * MiB;
constexpr size_t WS_HB8 = 2998 * MiB;
constexpr size_t WS_WG8 = 3016 * MiB;
constexpr size_t WS_ZG8 = 3040 * MiB;
constexpr size_t WS_ZO8 = 3076 * MiB;
constexpr size_t WS_END = 3096 * MiB;
static_assert(WS_CM == WS_RO + (size_t)NLAT * DM * 2 && WS_PBT == WS_PAT + (size_t)DM * DM * 2, "P7's chained units address [RO ; CM] and [proj_a^T ; proj_b^T] as one matrix each");
static_assert(WS_DC + (size_t)64 * 17 * CROWS * 128 * 2 <= WS_CS && WS_CS + (size_t)64 * 16 * CROWS * 128 * 2 <= WS_RO && WS_Z + (size_t)NTOK * ZW * 2 <= WS_QC, "ws map");
constexpr int CW_Q3 = 3584, CW_Q4 = 8192;
constexpr int CW_Q2 = 3072;
constexpr int CW_Q = 2048;
constexpr int CW_CNT = 64;
constexpr int CW_BAR = 4096;
constexpr int RING_BYTES = 131072;
constexpr int LDS_BYTES = 147456;
constexpr int LDSCTL_OFF = LDS_BYTES - 2048, MISC_OFF = LDSCTL_OFF + 320, PREF_OFF = LDSCTL_OFF + 1024;

#define GAS __attribute__((address_space(1)))
#define LAS __attribute__((address_space(3)))
typedef unsigned short bf16;
typedef unsigned v4u __attribute__((ext_vector_type(4)));
typedef unsigned v2u __attribute__((ext_vector_type(2)));
typedef float f32x4 __attribute__((ext_vector_type(4)));
typedef short bf16x8 __attribute__((ext_vector_type(8)));
typedef short s16x4 __attribute__((ext_vector_type(4)));
typedef GAS unsigned gu32;
#define RLX_AGENT __ATOMIC_RELAXED, __HIP_MEMORY_SCOPE_AGENT
#define LDS_WAIT() asm volatile("s_waitcnt lgkmcnt(0)" ::: "memory")
#define VM_WAIT() asm volatile("s_waitcnt vmcnt(0)" ::: "memory")
using pg8::cvt_pk_bf16; using pg8::bf_lo; using pg8::bf_hi; using pg8::sigmoidf_;


__device__ __forceinline__ float wave_sum(float v) {
#pragma unroll
    for (int o = 1; o < 64; o <<= 1) v += __shfl_xor(v, o);
    return v;
}
__device__ __forceinline__ float siluf_(float x) { return x * __builtin_amdgcn_rcpf(1.0f + __expf(-x)); }
__device__ __forceinline__ float gelu_tanh(float x) { const float u = 0.7978845608028654f * (x + 0.044715f * x * x * x); return x * __builtin_amdgcn_rcpf(1.0f + __expf(-2.0f * u)); }
__device__ __forceinline__ float logsigf_(float f) { return fminf(f, 0.f) - log1pf(expf(-fabsf(f))); }
__device__ __forceinline__ unsigned img_off(unsigned row, unsigned ch) { return 256u * row + 16u * (ch ^ (((row & 3u) << 2) | ((row >> 2) & 3u))); }
__device__ __forceinline__ s16x4 tr_read(LAS unsigned char* p) { return __builtin_amdgcn_ds_read_tr16_b64_v4i16((LAS s16x4*)p); }
__device__ __forceinline__ bf16x8 tr_frag(LAS unsigned char* img, unsigned r0, unsigned r1, unsigned c, int lane) {
    const unsigned q = (lane & 15) >> 2, p = lane & 3;
    const s16x4 lo = tr_read(img + img_off(r0 + q, 2 * c + (p >> 1)) + 8 * (p & 1));
    const s16x4 hi = tr_read(img + img_off(r1 + q, 2 * c + (p >> 1)) + 8 * (p & 1));
    bf16x8 r; r[0] = lo[0]; r[1] = lo[1]; r[2] = lo[2]; r[3] = lo[3]; r[4] = hi[0]; r[5] = hi[1]; r[6] = hi[2]; r[7] = hi[3]; return r;
}
__device__ __forceinline__ bf16x8 tr_frag2(LAS unsigned char* base, unsigned x0, unsigned x1) {
    const s16x4 lo = tr_read(base + x0), hi = tr_read(base + x1);
    bf16x8 r; r[0] = lo[0]; r[1] = lo[1]; r[2] = lo[2]; r[3] = lo[3]; r[4] = hi[0]; r[5] = hi[1]; r[6] = hi[2]; r[7] = hi[3]; return r;
}
#define TR_NAT_OFFS(xn0, xn1, lane) unsigned xn0[8], xn1[8]; { const unsigned g_ = (lane) >> 4, q_ = ((lane) & 15) >> 2, p_ = (lane) & 3; \
    _Pragma("unroll") for (int c_ = 0; c_ < 8; ++c_) { xn0[c_] = 256u * (8 * g_ + q_) + 16u * ((2 * c_ + (p_ >> 1)) ^ ((q_ << 2) | ((2 * g_) & 3))) + 8u * (p_ & 1); \
                                                       xn1[c_] = 256u * (8 * g_ + 4 + q_) + 16u * ((2 * c_ + (p_ >> 1)) ^ ((q_ << 2) | ((2 * g_ + 1) & 3))) + 8u * (p_ & 1); } }
#define TR_PERM_OFFS(xp, lane) unsigned xp[8]; { const unsigned g_ = (lane) >> 4, q_ = ((lane) & 15) >> 2, p_ = (lane) & 3; \
    _Pragma("unroll") for (int c_ = 0; c_ < 8; ++c_) xp[c_] = 256u * (4 * g_ + q_) + 16u * ((2 * c_ + (p_ >> 1)) ^ ((q_ << 2) | g_)) + 8u * (p_ & 1); }
__device__ __forceinline__ void load_tile128(LAS unsigned char* img, const bf16* src, size_t ld, int tid) {
#pragma unroll
    for (int i = 0; i < 4; ++i) { const int id = tid + NTHR * i, row = id >> 4, ch = id & 15;
        const v4u v = *(const v4u*)(src + (size_t)row * ld + 8 * ch); *(LAS v4u*)(img + img_off(row, ch)) = v; }
}
__device__ __forceinline__ void load_tile128_scaled(LAS unsigned char* img, const bf16* src, size_t ld, const LAS float* w, int tid) {
#pragma unroll
    for (int i = 0; i < 4; ++i) { const int id = tid + NTHR * i, row = id >> 4, ch = id & 15; const float s = w[row];
        const v4u v = *(const v4u*)(src + (size_t)row * ld + 8 * ch); v4u o;
        o.x = cvt_pk_bf16(bf_lo(v.x) * s, bf_hi(v.x) * s); o.y = cvt_pk_bf16(bf_lo(v.y) * s, bf_hi(v.y) * s); o.z = cvt_pk_bf16(bf_lo(v.z) * s, bf_hi(v.z) * s); o.w = cvt_pk_bf16(bf_lo(v.w) * s, bf_hi(v.w) * s);
        *(LAS v4u*)(img + img_off(row, ch)) = o; }
}
__device__ __forceinline__ void gate_scan(const float* G, size_t row0, int col_i, int col_f, int dir, int lane, float* bc, float* gg, float* pmx, float& b_end, float& gmax) {
    const int j0 = dir ? 127 - 2 * lane : 2 * lane, j1 = dir ? 126 - 2 * lane : 2 * lane + 1;
    const float f0 = G[(row0 + j0) * 32 + col_f], f1 = G[(row0 + j1) * 32 + col_f], i0 = G[(row0 + j0) * 32 + col_i], i1 = G[(row0 + j1) * 32 + col_i];
    const float lf0 = logsigf_(f0), lf1 = logsigf_(f1), s = lf0 + lf1; float incl = s;
#pragma unroll
    for (int o = 1; o < 64; o <<= 1) { const float t = __shfl_up(incl, o); if (lane >= o) incl += t; }
    const float b0 = (incl - s) + lf0, b1 = incl, g0 = i0 - b0, g1 = i1 - b1;
    float mincl = fmaxf(g0, g1);
#pragma unroll
    for (int o = 1; o < 64; o <<= 1) { const float t = __shfl_up(mincl, o); if (lane >= o) mincl = fmaxf(mincl, t); }
    float mexcl = __shfl_up(mincl, 1); if (lane == 0) mexcl = -3.0e38f;
    bc[j0] = b0; bc[j1] = b1; gg[j0] = g0; gg[j1] = g1; pmx[j0] = fmaxf(mexcl, g0); pmx[j1] = mincl;
    b_end = __shfl(incl, 63); gmax = __shfl(mincl, 63);
}
#define MFMA16(a, b, c) __builtin_amdgcn_mfma_f32_16x16x32_bf16((a), (b), (c), 0, 0, 0)

__device__ __forceinline__ v4u pair16(v2u X, v2u Y) {
    const auto r0 = __builtin_amdgcn_permlane16_swap(X.x, Y.x, false, false), r1 = __builtin_amdgcn_permlane16_swap(X.y, Y.y, false, false);
    v4u o; o.x = r0[0]; o.y = r1[0]; o.z = r0[1]; o.w = r1[1]; return o; }

struct CvtItem { const float* src; size_t ldw; bf16* dst; };
constexpr int N_CONVERTERS = 144;
constexpr int N_CONV_DEFER = 1440;
constexpr int I_GEMV = 192, I_WIN = 16 * 8, I_GATE8 = 16 * 48, I_P = 16 * 8, I_W1 = 32 * 16 * 16, I_W2 = 32 * 16 * 8, I_TOTAL = I_GEMV + I_WIN + 3 * I_P + I_W1 + I_W2;
__device__ __forceinline__ CvtItem cvt_decode(int r, int tid, const float* w_in, const float* proj_a, const float* proj_b, const float* w_out, const float* exp_w1, const float* exp_w2,
                                              bf16* WINT, bf16* PAT, bf16* PBT, bf16* WOT, bf16* W1T, bf16* W2T) {
    const int n4 = tid & 63, kg = tid >> 6; const float* W; size_t ldw, ca, cb, drow; int kt; bf16* WT;
    if (r < I_WIN) { kt = r / 8; const int nt = 24 + r % 8; W = w_in; ldw = INC; ca = (size_t)256 * nt + 32; cb = ca + 128; WT = WINT; drow = (size_t)256 * nt; }
    else if ((r -= I_WIN) < 3 * I_P) { const int m = r / I_P, q = r % I_P; kt = q / 8; const int nt = q % 8; W = m == 0 ? proj_a : (m == 1 ? proj_b : w_out); ldw = 2048; ca = (size_t)256 * nt; cb = ca + 128; WT = m == 0 ? PAT : (m == 1 ? PBT : WOT); drow = (size_t)256 * nt; }
    else if ((r -= 3 * I_P) < I_W1) { const int e = r / 256, q = r % 256; kt = q / 16; const int nt = q % 16; W = exp_w1 + (size_t)e * 2048 * 4096; ldw = 4096; ca = (size_t)128 * nt; cb = 2048 + ca; WT = W1T; drow = (size_t)e * 4096 + 256 * nt; }
    else { r -= I_W1; const int e = r / 128, q = r % 128; kt = q / 8; const int nt = q % 8; W = exp_w2 + (size_t)e * 2048 * 2048; ldw = 2048; ca = (size_t)256 * nt; cb = ca + 128; WT = W2T; drow = (size_t)e * 2048 + 256 * nt; }
    CvtItem it; it.ldw = ldw; it.src = W + (size_t)(128 * kt + 8 * kg) * ldw + (n4 < 32 ? ca + 4 * n4 : cb + 4 * (n4 - 32)); it.dst = WT + drow * 2048 + 128 * kt; return it;
}
__device__ __forceinline__ void cvt_run(LAS unsigned char* lds, int tid, int it, int stride, int end, const float* w_in, const float* proj_a, const float* proj_b, const float* w_out, const float* exp_w1, const float* exp_w2,
                                        bf16* WINT, bf16* PAT, bf16* PBT, bf16* WOT, bf16* W1T, bf16* W2T) {
    const int n4 = tid & 63, kg = tid >> 6;
    f32x4 v[16]; CvtItem cur;
    bool have = it < end;
    if (have) { cur = cvt_decode(it - I_GEMV, tid, w_in, proj_a, proj_b, w_out, exp_w1, exp_w2, WINT, PAT, PBT, WOT, W1T, W2T);
#pragma unroll
        for (int i = 0; i < 16; ++i) v[i] = __builtin_nontemporal_load((const f32x4*)(cur.src + (size_t)((i >> 3) * 64 + (i & 7)) * cur.ldw)); }
    while (have) {
#pragma unroll
        for (int hf = 0; hf < 2; ++hf)
#pragma unroll
            for (int j = 0; j < 4; ++j) { v4u o; o.x = cvt_pk_bf16(v[8 * hf + 0][j], v[8 * hf + 1][j]); o.y = cvt_pk_bf16(v[8 * hf + 2][j], v[8 * hf + 3][j]); o.z = cvt_pk_bf16(v[8 * hf + 4][j], v[8 * hf + 5][j]); o.w = cvt_pk_bf16(v[8 * hf + 6][j], v[8 * hf + 7][j]);
                *(LAS v4u*)(lds + img_off(4 * n4 + j, 8 * hf + kg)) = o; }
        __syncthreads();
        bf16* dst = cur.dst;
        it += stride; have = it < end;
        if (have) { cur = cvt_decode(it - I_GEMV, tid, w_in, proj_a, proj_b, w_out, exp_w1, exp_w2, WINT, PAT, PBT, WOT, W1T, W2T);
#pragma unroll
            for (int i = 0; i < 16; ++i) v[i] = __builtin_nontemporal_load((const f32x4*)(cur.src + (size_t)((i >> 3) * 64 + (i & 7)) * cur.ldw)); }
#pragma unroll
        for (int i = 0; i < 8; ++i) { const int id = tid + NTHR * i, row = id >> 4, ch = id & 15; const v4u o = *(const LAS v4u*)(lds + img_off(row, ch)); __builtin_nontemporal_store(o, (v4u*)(dst + (size_t)row * 2048 + 8 * ch)); }
        __syncthreads();
    }
}
__device__ __forceinline__ void cvt_run8(LAS unsigned char* lds, int tid, int r, int stride, int end, const float* exp_w1, const float* exp_w2, const float* w_in, unsigned char* W1T8, unsigned char* W2T8, unsigned char* WG8) {
    const int n4 = tid & 63, kg = tid >> 6;
    f32x4 v[16]; const float* src = nullptr; size_t ldw = 0; unsigned char* dst = nullptr;
#define CVT8_DECODE(R) do { int q_ = (R); const float* W_; size_t ca_, cb_, drow_; int kt_; unsigned char* WT_; \
        if (q_ < I_W1) { const int e = q_ / 256, qq = q_ % 256; kt_ = qq / 16; const int nt = qq % 16; W_ = exp_w1 + (size_t)e * 2048 * 4096; ldw = 4096; ca_ = (size_t)128 * nt; cb_ = 2048 + ca_; WT_ = W1T8; drow_ = (size_t)e * 4096 + 256 * nt; } \
        else if (q_ < I_W1 + I_W2) { q_ -= I_W1; const int e = q_ / 128, qq = q_ % 128; kt_ = qq / 8; const int nt = qq % 8; W_ = exp_w2 + (size_t)e * 2048 * 2048; ldw = 2048; ca_ = (size_t)256 * nt; cb_ = ca_ + 128; WT_ = W2T8; drow_ = (size_t)e * 2048 + 256 * nt; } \
        else { q_ -= I_W1 + I_W2; kt_ = q_ / 48; const int ft = q_ % 48, zt = ft < 24 ? ft : ft + 8; W_ = w_in; ldw = INC; ca_ = (size_t)256 * zt + (zt >= 16 ? 32 : 0); cb_ = ca_ + 128; WT_ = WG8; drow_ = (size_t)256 * ft; } \
        src = W_ + (size_t)(128 * kt_ + 8 * kg) * ldw + (n4 < 32 ? ca_ + 4 * n4 : cb_ + 4 * (n4 - 32)); dst = WT_ + drow_ * 2048 + 128 * kt_; \
        _Pragma("unroll") for (int i = 0; i < 16; ++i) v[i] = __builtin_nontemporal_load((const f32x4*)(src + (size_t)((i >> 3) * 64 + (i & 7)) * ldw)); } while (0)
    bool have = r < end;
    if (have) CVT8_DECODE(r);
    while (have) {
#pragma unroll
        for (int hf = 0; hf < 2; ++hf)
#pragma unroll
            for (int j = 0; j < 4; ++j) { const int row = 4 * n4 + j, p8 = 8 * hf + kg; v2u o;
                o.x = pg8::pk4_fp8(v[8 * hf + 0][j] * pg8::F8_SW, v[8 * hf + 1][j] * pg8::F8_SW, v[8 * hf + 2][j] * pg8::F8_SW, v[8 * hf + 3][j] * pg8::F8_SW);
                o.y = pg8::pk4_fp8(v[8 * hf + 4][j] * pg8::F8_SW, v[8 * hf + 5][j] * pg8::F8_SW, v[8 * hf + 6][j] * pg8::F8_SW, v[8 * hf + 7][j] * pg8::F8_SW);
                *(LAS v2u*)(lds + row * 128 + 16 * ((p8 >> 1) ^ ((row >> 2) & 7)) + 8 * (p8 & 1)) = o; }
        __syncthreads();
        unsigned char* d0 = dst;
        r += stride; have = r < end;
        if (have) CVT8_DECODE(r);
#pragma unroll
        for (int i = 0; i < 4; ++i) { const int id = tid + NTHR * i, row = id >> 3, ch = id & 7; const v4u o = *(const LAS v4u*)(lds + row * 128 + 16 * (ch ^ ((row >> 2) & 7)));
            __builtin_nontemporal_store(o, (v4u*)(d0 + (size_t)row * 2048 + 16 * ch)); }
        __syncthreads();
    }
#undef CVT8_DECODE
}
__device__ __forceinline__ void p0_phase(LAS unsigned char* lds, int tid, int G, const float* c, const float* c_ctx, const float* mod_w, const float* mod_b, float* MOD,
                                         const float* w_in, const float* proj_a, const float* proj_b, const float* w_out, const float* exp_w1, const float* exp_w2, const float* router_w,
                                         bf16* WINT, bf16* PAT, bf16* PBT, bf16* WOT, bf16* W1T, bf16* W2T, bf16* SK, int n_conv_p0) {
    LAS float* sc = (LAS float*)lds;
    LAS float* red = (LAS float*)(lds + 40960);
    int it = blockIdx.x;
    if (it < I_GEMV) {
        for (int i = tid; i < 5 * 2048; i += NTHR) { const float x = i < 4 * 2048 ? c[i] : c_ctx[i - 4 * 2048]; sc[i] = siluf_(x); }
        __syncthreads();
        for (; it < I_GEMV; it += G) {
            const int j0 = 64 * it, c4 = tid & 15, kg = tid >> 4;
            f32x4 a0 = {0.f, 0.f, 0.f, 0.f}, a1 = a0, a2 = a0, a3 = a0, a4 = a0;
            const float* wp = mod_w + (size_t)kg * 12288 + j0 + 4 * c4;
#pragma unroll 8
            for (int k = kg; k < 2048; k += 32) { const f32x4 w = *(const f32x4*)wp; wp += (size_t)32 * 12288;
                a0 += w * sc[k]; a1 += w * sc[2048 + k]; a2 += w * sc[4096 + k]; a3 += w * sc[6144 + k]; a4 += w * sc[8192 + k]; }
            *(LAS f32x4*)(red + (kg * 5 + 0) * 64 + 4 * c4) = a0; *(LAS f32x4*)(red + (kg * 5 + 1) * 64 + 4 * c4) = a1; *(LAS f32x4*)(red + (kg * 5 + 2) * 64 + 4 * c4) = a2;
            *(LAS f32x4*)(red + (kg * 5 + 3) * 64 + 4 * c4) = a3; *(LAS f32x4*)(red + (kg * 5 + 4) * 64 + 4 * c4) = a4;
            __syncthreads();
            if (tid < 320) { const int rr = tid >> 6, j = tid & 63; float s = 0.f;
#pragma unroll 8
                for (int g = 0; g < 32; ++g) s += red[(g * 5 + rr) * 64 + j];
                MOD[rr * 12288 + j0 + j] = s + mod_b[j0 + j]; }
            __syncthreads();
        }
    } else {
        for (int i = (it - I_GEMV) * NTHR + tid; i < 2 * 32 * 2048; i += (G - I_GEMV) * NTHR) { const int m = i >> 16, n = (i >> 11) & 31, k = i & 2047;
            const float w = m == 0 ? w_in[(size_t)k * INC + 4096 + n] : router_w[k * 32 + n];
            const unsigned hi = cvt_pk_bf16(w, 0.f) & 0xffffu; const unsigned lo = cvt_pk_bf16(w - __uint_as_float(hi << 16), 0.f) & 0xffffu;
            SK[(size_t)(2 * m) * 65536 + n * 2048 + k] = (bf16)hi; SK[(size_t)(2 * m + 1) * 65536 + n * 2048 + k] = (bf16)lo; }
    }
    cvt_run(lds, tid, it, G, I_GEMV + n_conv_p0, w_in, proj_a, proj_b, w_out, exp_w1, exp_w2, WINT, PAT, PBT, WOT, W1T, W2T);
}

__device__ __forceinline__ void skinny_mfma(const LAS float* hrow, const bf16* WT_hi, const bf16* WT_lo, LAS float* part, int wave, int lane) {
    const int g = lane >> 4, l15 = lane & 15;
    f32x4 acc0 = {0.f, 0.f, 0.f, 0.f}, acc1 = acc0;
#pragma unroll
    for (int ks = 0; ks < 8; ++ks) { const int kb = 256 * wave + 32 * ks + 8 * g;
        f32x4 a0 = {0.f, 0.f, 0.f, 0.f}, a1 = a0;
        if (l15 < 8) { a0 = *(const LAS f32x4*)(hrow + l15 * 2048 + kb); a1 = *(const LAS f32x4*)(hrow + l15 * 2048 + kb + 4); }
        v4u hi, lo;
        hi.x = cvt_pk_bf16(a0[0], a0[1]); hi.y = cvt_pk_bf16(a0[2], a0[3]); hi.z = cvt_pk_bf16(a1[0], a1[1]); hi.w = cvt_pk_bf16(a1[2], a1[3]);
        lo.x = cvt_pk_bf16(a0[0] - bf_lo(hi.x), a0[1] - bf_hi(hi.x)); lo.y = cvt_pk_bf16(a0[2] - bf_lo(hi.y), a0[3] - bf_hi(hi.y));
        lo.z = cvt_pk_bf16(a1[0] - bf_lo(hi.z), a1[1] - bf_hi(hi.z)); lo.w = cvt_pk_bf16(a1[2] - bf_lo(hi.w), a1[3] - bf_hi(hi.w));
        const bf16x8 Ah = __builtin_bit_cast(bf16x8, hi), Al = __builtin_bit_cast(bf16x8, lo);
        const bf16x8 b0h = *(const bf16x8*)(WT_hi + (size_t)l15 * 2048 + kb), b0l = *(const bf16x8*)(WT_lo + (size_t)l15 * 2048 + kb);
        const bf16x8 b1h = *(const bf16x8*)(WT_hi + (size_t)(16 + l15) * 2048 + kb), b1l = *(const bf16x8*)(WT_lo + (size_t)(16 + l15) * 2048 + kb);
        acc0 = MFMA16(Ah, b0h, acc0); acc0 = MFMA16(Ah, b0l, acc0); acc0 = MFMA16(Al, b0h, acc0);
        acc1 = MFMA16(Ah, b1h, acc1); acc1 = MFMA16(Ah, b1l, acc1); acc1 = MFMA16(Al, b1h, acc1); }
    if (g < 2) {
#pragma unroll
        for (int r = 0; r < 4; ++r) { part[wave * 256 + (4 * g + r) * 32 + l15] = acc0[r]; part[wave * 256 + (4 * g + r) * 32 + 16 + l15] = acc1[r]; } }
}

template <bool LOREG>
__device__ __forceinline__ void skinny_mfma_r(const LAS float* hrow, const bf16x8 (&Bh)[8][2], const bf16x8 (&Bl)[8][2], const bf16* WT_lo, LAS float* part, int wave, int lane) {
    const int g = lane >> 4, l15 = lane & 15;
    f32x4 acc0 = {0.f, 0.f, 0.f, 0.f}, acc1 = acc0;
#pragma unroll
    for (int ks = 0; ks < 8; ++ks) { const int kb = 256 * wave + 32 * ks + 8 * g;
        f32x4 a0 = {0.f, 0.f, 0.f, 0.f}, a1 = a0;
        if (l15 < 8) { a0 = *(const LAS f32x4*)(hrow + l15 * 2048 + kb); a1 = *(const LAS f32x4*)(hrow + l15 * 2048 + kb + 4); }
        v4u hi, lo;
        hi.x = cvt_pk_bf16(a0[0], a0[1]); hi.y = cvt_pk_bf16(a0[2], a0[3]); hi.z = cvt_pk_bf16(a1[0], a1[1]); hi.w = cvt_pk_bf16(a1[2], a1[3]);
        lo.x = cvt_pk_bf16(a0[0] - bf_lo(hi.x), a0[1] - bf_hi(hi.x)); lo.y = cvt_pk_bf16(a0[2] - bf_lo(hi.y), a0[3] - bf_hi(hi.y));
        lo.z = cvt_pk_bf16(a1[0] - bf_lo(hi.z), a1[1] - bf_hi(hi.z)); lo.w = cvt_pk_bf16(a1[2] - bf_lo(hi.w), a1[3] - bf_hi(hi.w));
        const bf16x8 Ah = __builtin_bit_cast(bf16x8, hi), Al = __builtin_bit_cast(bf16x8, lo);
        bf16x8 b0l, b1l;
        if constexpr (LOREG) { b0l = Bl[ks][0]; b1l = Bl[ks][1]; }
        else { b0l = *(const bf16x8*)(WT_lo + (size_t)l15 * 2048 + kb); b1l = *(const bf16x8*)(WT_lo + (size_t)(16 + l15) * 2048 + kb); }
        acc0 = MFMA16(Ah, Bh[ks][0], acc0); acc0 = MFMA16(Ah, b0l, acc0); acc0 = MFMA16(Al, Bh[ks][0], acc0);
        acc1 = MFMA16(Ah, Bh[ks][1], acc1); acc1 = MFMA16(Ah, b1l, acc1); acc1 = MFMA16(Al, Bh[ks][1], acc1); }
    if (g < 2) {
#pragma unroll
        for (int r = 0; r < 4; ++r) { part[wave * 256 + (4 * g + r) * 32 + l15] = acc0[r]; part[wave * 256 + (4 * g + r) * 32 + 16 + l15] = acc1[r]; } }
}
#define SK_LOAD(B, BASE) do { _Pragma("unroll") for (int ks_ = 0; ks_ < 8; ++ks_) _Pragma("unroll") for (int n_ = 0; n_ < 2; ++n_) \
        B[ks_][n_] = *(const bf16x8*)((BASE) + (size_t)(16 * n_ + (lane & 15)) * 2048 + 256 * wave + 32 * ks_ + 8 * (lane >> 4)); } while (0)

__device__ __forceinline__ void p1_phase(LAS unsigned char* lds, int tid, int wave, int lane, int G, const float* x, const float* ctx, const float* MOD, const float* norm_g,
                                         const bf16* SK, const float* gate_b, bf16* HB, unsigned char* HB8, float* GATES) {
    LAS float* hrow = (LAS float*)(lds + wave * 8192); LAS float* part = (LAS float*)(lds + 65536);
    bf16x8 Bh[8][2], Bl[8][2]; SK_LOAD(Bh, SK); SK_LOAD(Bl, SK + 65536);
    f32x4 v[8];
    { const int row = blockIdx.x * 8 + wave; const float* xr = row < NLAT ? x + (size_t)row * DM : ctx + (size_t)(row - NLAT) * DM;
#pragma unroll
      for (int j = 0; j < 8; ++j) v[j] = *(const f32x4*)(xr + 4 * (lane + 64 * j)); }
    for (int it = blockIdx.x; it < NTOK / 8; it += G) {
        const int row = it * 8 + wave;
        const float* shift = MOD + (size_t)(row < NLAT ? (row >> 11) : 4) * 12288; const float* scale = shift + 2048;
        float ss = 0.f;
#pragma unroll
        for (int j = 0; j < 8; ++j) ss += (v[j][0] * v[j][0] + v[j][1] * v[j][1]) + (v[j][2] * v[j][2] + v[j][3] * v[j][3]);
        const float rstd = 1.0f / sqrtf(wave_sum(ss) * (1.0f / DM) + EPS);
#pragma unroll
        for (int j = 0; j < 8; ++j) { const int col = 4 * (lane + 64 * j);
            const f32x4 g = *(const f32x4*)(norm_g + col), sc = *(const f32x4*)(scale + col), sh = *(const f32x4*)(shift + col);
            const f32x4 h = (v[j] * rstd) * g * (sc + 1.0f) + sh;
            if (row < NLAT) { v2u o; o.x = cvt_pk_bf16(h[0], h[1]); o.y = cvt_pk_bf16(h[2], h[3]); *(v2u*)(HB + (size_t)row * DM + col) = o; }
            *(unsigned*)(HB8 + (size_t)row * DM + col) = pg8::pk4_fp8(h[0] * pg8::F8_SA, h[1] * pg8::F8_SA, h[2] * pg8::F8_SA, h[3] * pg8::F8_SA);
            *(LAS f32x4*)(hrow + col) = h; }
        if (it + G < NTOK / 8) { const int rown = (it + G) * 8 + wave; const float* xr = rown < NLAT ? x + (size_t)rown * DM : ctx + (size_t)(rown - NLAT) * DM;
#pragma unroll
            for (int j = 0; j < 8; ++j) v[j] = *(const f32x4*)(xr + 4 * (lane + 64 * j)); }
        __syncthreads();
        skinny_mfma_r<true>((const LAS float*)lds, Bh, Bl, nullptr, part, wave, lane);
        __syncthreads();
        if (tid < 256) { float s = 0.f;
#pragma unroll
            for (int w = 0; w < 8; ++w) s += part[w * 256 + tid];
            GATES[(size_t)(it * 8) * 32 + tid] = s + gate_b[tid & 31]; }
    }
}

__device__ __forceinline__ void p3_conv(int gw, int NGW, int nrb, int segbase, int lane, const bf16* Z, const float* conv_w, const float* conv_b, bf16* QC, bf16* KC) {
    for (int item = gw; item < 2 * nrb; item += NGW) {
        const int rb = item >> 1, seg = segbase + (item & 1), row0 = rb * 4, c0 = seg * 512 + lane * 8;
        const int t0 = row0 < NLAT ? (row0 & (TL - 1)) : ((row0 - NLAT) & (TCX - 1)), len = row0 < NLAT ? TL : TCX;
        v4u zr[8];
#pragma unroll
        for (int k = 0; k < 8; ++k) { const int tt = t0 + k - 2; zr[k] = (v4u){0u, 0u, 0u, 0u};
            if (tt >= 0 && tt < len) zr[k] = *(const v4u*)(Z + (size_t)(row0 + k - 2) * ZW + c0); }
        f32x4 w0[5], w1[5];
#pragma unroll
        for (int tau = 0; tau < 5; ++tau) { w0[tau] = *(const f32x4*)(conv_w + tau * 2048 + c0); w1[tau] = *(const f32x4*)(conv_w + tau * 2048 + c0 + 4); }
        const f32x4 b0 = *(const f32x4*)(conv_b + c0), b1 = *(const f32x4*)(conv_b + c0 + 4);
        const float qs = c0 < 1024 ? 0.08838834764831845f : 1.0f;
#pragma unroll
        for (int o = 0; o < 4; ++o) { float acc[8] = {b0[0], b0[1], b0[2], b0[3], b1[0], b1[1], b1[2], b1[3]};
#pragma unroll
            for (int tau = 0; tau < 5; ++tau) { const v4u z = zr[o + tau];
                acc[0] += w0[tau][0] * bf_lo(z.x); acc[1] += w0[tau][1] * bf_hi(z.x); acc[2] += w0[tau][2] * bf_lo(z.y); acc[3] += w0[tau][3] * bf_hi(z.y);
                acc[4] += w1[tau][0] * bf_lo(z.z); acc[5] += w1[tau][1] * bf_hi(z.z); acc[6] += w1[tau][2] * bf_lo(z.w); acc[7] += w1[tau][3] * bf_hi(z.w); }
#pragma unroll
            for (int i = 0; i < 8; ++i) acc[i] = siluf_(acc[i]) * qs;
            v4u ov; ov.x = cvt_pk_bf16(acc[0], acc[1]); ov.y = cvt_pk_bf16(acc[2], acc[3]); ov.z = cvt_pk_bf16(acc[4], acc[5]); ov.w = cvt_pk_bf16(acc[6], acc[7]);
            bf16* dst = c0 < 1024 ? QC + (size_t)(row0 + o) * 1024 + c0 : KC + (size_t)(row0 + o) * 1024 + (c0 - 1024);
            *(v4u*)dst = ov; }
    }
}
__device__ __forceinline__ void p3_phase(int wave, int lane, int G, const bf16* Z, const float* conv_w, const float* conv_b, const float* sgu_norm_g, bf16* QC, bf16* KC, bf16* SVN,
                                         const float* GATES, float* SCN, float* BEND, float* GMAX) {
    const int gw = blockIdx.x * NWAVES + wave, NGW = G * NWAVES;
    for (int task = gw; task < 64 * NCH; task += NGW) { const int bhd = task / NCH, bi = task - bhd * NCH, dir = bhd & 1, bh = bhd >> 1, b = bh >> 3, h = bh & 7;
        const size_t row0 = bi < 2 ? (size_t)NLAT + b * TCX + bi * 128 : (size_t)b * TL + (bi - 2) * 128;
        float* sp = SCN + (size_t)task * 384; float b_end, gmax;
        gate_scan(GATES, row0, (2 * dir) * 8 + h, (2 * dir + 1) * 8 + h, dir, lane, sp, sp + 128, sp + 256, b_end, gmax);
        const int c = dir == 0 ? bi : (bi < 2 ? 1 - bi : 19 - bi);
        if (lane == 0 && c < 17) { BEND[bhd * 17 + c] = b_end; GMAX[bhd * 17 + c] = gmax; } }
    if (G == 256) p3_conv(NGW - 1 - gw, NGW, NTOK / 4, 2, lane, Z, conv_w, conv_b, QC, KC);
    else { p3_conv(gw, NGW, NTOK / 4, 0, lane, Z, conv_w, conv_b, QC, KC); p3_conv(gw, NGW, NTOK / 4, 2, lane, Z, conv_w, conv_b, QC, KC); }
    for (int row = gw; row < NLAT; row += NGW) {
        float v[32]; float ss = 0.f;
#pragma unroll
        for (int j = 0; j < 4; ++j) { const v4u z = *(const v4u*)(Z + (size_t)row * ZW + ZS + 8 * lane + 512 * j);
            v[8 * j + 0] = gelu_tanh(bf_lo(z.x)); v[8 * j + 1] = gelu_tanh(bf_hi(z.x)); v[8 * j + 2] = gelu_tanh(bf_lo(z.y)); v[8 * j + 3] = gelu_tanh(bf_hi(z.y));
            v[8 * j + 4] = gelu_tanh(bf_lo(z.z)); v[8 * j + 5] = gelu_tanh(bf_hi(z.z)); v[8 * j + 6] = gelu_tanh(bf_lo(z.w)); v[8 * j + 7] = gelu_tanh(bf_hi(z.w)); }
#pragma unroll
        for (int i = 0; i < 32; ++i) ss += v[i] * v[i];
        const float rstd = 1.0f / sqrtf(wave_sum(ss) * (1.0f / DM) + EPS);
#pragma unroll
        for (int j = 0; j < 4; ++j) { const int col = 8 * lane + 512 * j; const f32x4 g0 = *(const f32x4*)(sgu_norm_g + col), g1 = *(const f32x4*)(sgu_norm_g + col + 4);
            v4u o; o.x = cvt_pk_bf16(v[8 * j] * rstd * g0[0], v[8 * j + 1] * rstd * g0[1]); o.y = cvt_pk_bf16(v[8 * j + 2] * rstd * g0[2], v[8 * j + 3] * rstd * g0[3]);
            o.z = cvt_pk_bf16(v[8 * j + 4] * rstd * g1[0], v[8 * j + 5] * rstd * g1[1]); o.w = cvt_pk_bf16(v[8 * j + 6] * rstd * g1[2], v[8 * j + 7] * rstd * g1[3]);
            *(v4u*)(SVN + (size_t)row * DM + col) = o; }
    }
}

constexpr int L_V0 = 0, L_V1 = 32768, L_K = 65536, L_SC = 98304, L_CB = 106496;
constexpr int N_M1 = 64 * 17, N_SGU = 512;
__device__ __forceinline__ void p4_phase(LAS unsigned char* lds, int tid_, int wave, int lane_, int G, const bf16* Z, const bf16* KC, const bf16* SVN, const float* SCN,
                                         const float* sgu_w, const float* sgu_b, bf16* DC, const float* GMAX, bf16* CM, int ufirst, int ustep) {
    v4u pk[4], pv[8]; f32x4 pa[2];
#define P4_ISSUE(U) do { const int u_ = (U); int t_ = tid_; asm volatile("" : "+v"(t_)); \
        if (u_ < N_M1) { const int bhd_ = u_ / 17, c_ = u_ - bhd_ * 17, dir_ = bhd_ & 1, bh_ = bhd_ >> 1, b_ = bh_ >> 3, h_ = bh_ & 7; \
            const bool ic_ = c_ < 2; const int blk_ = dir_ == 0 ? (ic_ ? c_ : c_ - 2) : (ic_ ? 1 - c_ : 17 - c_); \
            const size_t r0_ = ic_ ? (size_t)NLAT + b_ * TCX + blk_ * 128 : (size_t)b_ * TL + blk_ * 128; \
            const float* sp_ = SCN + (size_t)(bhd_ * NCH + (ic_ ? blk_ : blk_ + 2)) * 384; \
            _Pragma("unroll") for (int i = 0; i < 4; ++i) { const int id = t_ + NTHR * i; pk[i] = *(const v4u*)(KC + (r0_ + (id >> 4)) * 1024 + h_ * QKD + 8 * (id & 15)); pa[0][i] = sp_[128 + (id >> 4)]; } \
            pa[1][0] = GMAX[bhd_ * 17 + c_]; \
            _Pragma("unroll") for (int i = 0; i < 8; ++i) { const int id = t_ + NTHR * (i & 3); pv[i] = *(const v4u*)(Z + (r0_ + (id >> 4)) * ZW + ZV + h_ * VD + 128 * (i >> 2) + 8 * (id & 15)); } \
        } else { const int u2_ = u_ - N_M1, b_ = u2_ >> 7, n_ = (u2_ >> 3) & 15, grp_ = u2_ & 7; const size_t r0_ = (size_t)b_ * TL + n_ * 128; \
            _Pragma("unroll") for (int i = 0; i < 8; ++i) { const int id = t_ + NTHR * (i & 3); pv[i] = *(const v4u*)(SVN + (r0_ + (id >> 4)) * DM + grp_ * 256 + 128 * (i >> 2) + 8 * (id & 15)); } \
            } } while (0)
    int u = ufirst;
    if (u < N_M1 + N_SGU) P4_ISSUE(u);
    for (; u < N_M1 + N_SGU; u += ustep) {
        int tid = tid_; asm volatile("" : "+v"(tid)); const int lane = tid & 63; const unsigned g = lane >> 4, l15 = lane & 15;
        const bool m1 = u < N_M1;
        TR_NAT_OFFS(xn0, xn1, lane)
#pragma unroll
        for (int i = 0; i < 8; ++i) { const int id = tid + NTHR * (i & 3); *(LAS v4u*)(lds + ((i >> 2) ? L_V1 : L_V0) + img_off(id >> 4, id & 15)) = pv[i]; }
        bf16x8 Af[4]; v2u uw[16];
        if (m1) { const float gmax = pa[1][0];
#pragma unroll
            for (int i = 0; i < 4; ++i) { const int id = tid + NTHR * i, row = id >> 4, ch = id & 15; const float sw = __expf(pa[0][i] - gmax); const v4u v = pk[i]; v4u o;
                o.x = cvt_pk_bf16(bf_lo(v.x) * sw, bf_hi(v.x) * sw); o.y = cvt_pk_bf16(bf_lo(v.y) * sw, bf_hi(v.y) * sw); o.z = cvt_pk_bf16(bf_lo(v.z) * sw, bf_hi(v.z) * sw); o.w = cvt_pk_bf16(bf_lo(v.w) * sw, bf_hi(v.w) * sw);
                *(LAS v4u*)(lds + L_K + img_off(row, ch)) = o; }
        }
        __syncthreads();
        f32x4 af32[8]; float zb_ = 0.f;
        if (!m1) { const int u2 = u - N_M1, b = u2 >> 7, n = (u2 >> 3) & 15, grp = u2 & 7;
            const float* src = sgu_w + (size_t)grp * 16384 + (size_t)(16 * wave + l15) * 128 + 8 * g;
#pragma unroll
            for (int ks = 0; ks < 4; ++ks) { af32[2 * ks] = *(const f32x4*)(src + 32 * ks); af32[2 * ks + 1] = *(const f32x4*)(src + 32 * ks + 4); }
            const bf16* up = Z + ((size_t)b * TL + n * 128 + 16 * wave + l15) * ZW + ZU + grp * 256 + 4 * g;
#pragma unroll
            for (int et = 0; et < 16; ++et) uw[et] = *(const v2u*)(up + 16 * et);
            zb_ = sgu_b[grp * 128 + 16 * wave + l15]; }
        if (u + ustep < N_M1 + N_SGU) P4_ISSUE(u + ustep);
        if (!m1) {
#pragma unroll
            for (int ks = 0; ks < 4; ++ks) { const f32x4 a = af32[2 * ks], b2 = af32[2 * ks + 1];
                const v4u p = {cvt_pk_bf16(a[0], a[1]), cvt_pk_bf16(a[2], a[3]), cvt_pk_bf16(b2[0], b2[1]), cvt_pk_bf16(b2[2], b2[3])}; Af[ks] = __builtin_bit_cast(bf16x8, p); } }
        if (m1) {
            const int bhd = u / 17, c = u - bhd * 17;
#pragma unroll
            for (int ks = 0; ks < 4; ++ks) Af[ks] = tr_frag(lds + L_K, 32 * ks + 8 * g, 32 * ks + 8 * g + 4, wave, lane);
            f32x4 acc[17];
#pragma unroll
            for (int et = 0; et < 17; ++et) acc[et] = (f32x4){0.f, 0.f, 0.f, 0.f};
#pragma unroll
            for (int et = 0; et < 16; ++et) { LAS unsigned char* img = lds + ((et >> 3) ? L_V1 : L_V0);
#pragma unroll
                for (int ks = 0; ks < 4; ++ks) { const bf16x8 Bf = tr_frag2(img + 8192 * ks, xn0[et & 7], xn1[et & 7]); acc[et] = MFMA16(Af[ks], Bf, acc[et]); } }
            { const short one = l15 == 0 ? (short)0x3F80 : (short)0; const bf16x8 Bo = {one, one, one, one, one, one, one, one};
#pragma unroll
                for (int ks = 0; ks < 4; ++ks) acc[16] = MFMA16(Af[ks], Bo, acc[16]); }
            bf16* dst = DC + ((size_t)bhd * 17 + c) * (CROWS * 128) + 16 * wave + 4 * g;
#pragma unroll
            for (int et = 0; et < 16; ++et) { v2u o; o.x = cvt_pk_bf16(acc[et][0], acc[et][1]); o.y = cvt_pk_bf16(acc[et][2], acc[et][3]); *(v2u*)(dst + (size_t)(16 * et + l15) * 128) = o; }
            if (l15 == 0) { v2u o; o.x = cvt_pk_bf16(acc[16][0], acc[16][1]); o.y = cvt_pk_bf16(acc[16][2], acc[16][3]); *(v2u*)(dst + (size_t)256 * 128) = o; }
        } else {
            const int u2 = u - N_M1, b = u2 >> 7, n = (u2 >> 3) & 15, grp = u2 & 7; const size_t row0 = (size_t)b * TL + n * 128;
            f32x4 acc[16];
#pragma unroll
            for (int et = 0; et < 16; ++et) { acc[et] = (f32x4){0.f, 0.f, 0.f, 0.f}; LAS unsigned char* img = lds + ((et >> 3) ? L_V1 : L_V0);
#pragma unroll
                for (int ks = 0; ks < 4; ++ks) { const bf16x8 Bf = tr_frag2(img + 8192 * ks, xn0[et & 7], xn1[et & 7]); acc[et] = MFMA16(Bf, Af[ks], acc[et]); } }
            { const int t = 16 * wave + l15; const float zb = zb_; const size_t row = row0 + t;
#pragma unroll
              for (int ep = 0; ep < 8; ++ep) { v2u XY[2];
#pragma unroll
                  for (int q = 0; q < 2; ++q) { const int et = 2 * ep + q; const v2u w2 = uw[et];
                      const float o0 = gelu_tanh(bf_lo(w2.x)) * (acc[et][0] + zb), o1 = gelu_tanh(bf_hi(w2.x)) * (acc[et][1] + zb), o2 = gelu_tanh(bf_lo(w2.y)) * (acc[et][2] + zb), o3 = gelu_tanh(bf_hi(w2.y)) * (acc[et][3] + zb);
                      XY[q].x = cvt_pk_bf16(o0, o1); XY[q].y = cvt_pk_bf16(o2, o3); }
                  *(v4u*)(CM + row * DM + grp * 256 + 16 * (2 * ep + (g & 1)) + 8 * (g >> 1)) = pair16(XY[0], XY[1]); } }
        }
        __syncthreads();
    }
#undef P4_ISSUE
}

__device__ __forceinline__ void p4_chain(LAS unsigned char* lds, int tid_, int wave, const bf16* Z, const bf16* KC, const float* SCN, const float* BEND, const float* GMAX, bf16* CS, float* MST) {
    const int bhd = ((int)blockIdx.x & 7) | (((int)blockIdx.x >> 4) << 3), eh = ((int)blockIdx.x >> 3) & 1, dir = bhd & 1, bh = bhd >> 1, b = bh >> 3, h = bh & 7;
    v4u pk[4], pv[4]; f32x4 pg;
#define CH_ISSUE(C_) do { const int c_ = (C_); int t_ = tid_; asm volatile("" : "+v"(t_)); const bool ic_ = c_ < 2; const int blk_ = dir == 0 ? (ic_ ? c_ : c_ - 2) : (ic_ ? 1 - c_ : 17 - c_); \
        const size_t r0_ = ic_ ? (size_t)NLAT + b * TCX + blk_ * 128 : (size_t)b * TL + blk_ * 128; const float* sp_ = SCN + (size_t)(bhd * NCH + (ic_ ? blk_ : blk_ + 2)) * 384; \
        _Pragma("unroll") for (int i = 0; i < 4; ++i) { const int id = t_ + NTHR * i; pk[i] = *(const v4u*)(KC + (r0_ + (id >> 4)) * 1024 + h * QKD + 8 * (id & 15)); pg[i] = sp_[128 + (id >> 4)]; \
            pv[i] = *(const v4u*)(Z + (r0_ + (id >> 4)) * ZW + ZV + h * VD + 128 * eh + 8 * (id & 15)); } } while (0)
#define CH_STAGE(P, MX) do { int t_ = tid_; asm volatile("" : "+v"(t_)); LAS unsigned char* vb_ = lds + ((P) ? L_V1 : L_V0); LAS unsigned char* kb_ = lds + ((P) ? L_CB : L_K); \
        _Pragma("unroll") for (int i = 0; i < 4; ++i) { const int id = t_ + NTHR * i, row = id >> 4, ch = id & 15; *(LAS v4u*)(vb_ + img_off(row, ch)) = pv[i]; \
            const float sw = __expf(pg[i] - (MX)); const v4u v = pk[i]; v4u o; \
            o.x = cvt_pk_bf16(bf_lo(v.x) * sw, bf_hi(v.x) * sw); o.y = cvt_pk_bf16(bf_lo(v.y) * sw, bf_hi(v.y) * sw); o.z = cvt_pk_bf16(bf_lo(v.z) * sw, bf_hi(v.z) * sw); o.w = cvt_pk_bf16(bf_lo(v.w) * sw, bf_hi(v.w) * sw); \
            *(LAS v4u*)(kb_ + img_off(row, ch)) = o; } } while (0)
    f32x4 C[9];
#pragma unroll
    for (int et = 0; et < 9; ++et) C[et] = (f32x4){0.f, 0.f, 0.f, 0.f};
    CH_ISSUE(0);
    LAS float* gsc = (LAS float*)(lds + L_SC);
    if (tid_ < 17) { gsc[tid_] = GMAX[bhd * 17 + tid_]; gsc[32 + tid_] = BEND[bhd * 17 + tid_]; }
    __syncthreads();
    float m = 0.f, mx = fmaxf(m, gsc[0]);
    CH_STAGE(0, mx);
    CH_ISSUE(1);
    __syncthreads();
#pragma unroll 1
    for (int c = 0; c < 17; ++c) {
        int tid = tid_; asm volatile("" : "+v"(tid)); const int lane = tid & 63; const unsigned g = lane >> 4, l15 = lane & 15;
        TR_NAT_OFFS(xn0, xn1, lane)
        const float al = __expf(m - mx), mn = gsc[32 + c] + mx;
        LAS unsigned char* vb = lds + ((c & 1) ? L_V1 : L_V0); LAS unsigned char* kb = lds + ((c & 1) ? L_CB : L_K);
        if (c + 1 < 17) { const float mxn = fmaxf(mn, gsc[c + 1]);
            if (c & 1) CH_STAGE(0, mxn); else CH_STAGE(1, mxn);
            if (c + 2 < 17) CH_ISSUE(c + 2); }
#pragma unroll
        for (int et = 0; et < 9; ++et) C[et] = C[et] * al;
        bf16x8 Af[4];
#pragma unroll
        for (int ks = 0; ks < 4; ++ks) Af[ks] = tr_frag(kb, 32 * ks + 8 * g, 32 * ks + 8 * g + 4, wave, lane);
#pragma unroll
        for (int et = 0; et < 8; ++et)
#pragma unroll
            for (int ks = 0; ks < 4; ++ks) { const bf16x8 Bf = tr_frag2(vb + 8192 * ks, xn0[et], xn1[et]); C[et] = MFMA16(Af[ks], Bf, C[et]); }
        if (eh == 0) { const short one = l15 == 0 ? (short)0x3F80 : (short)0; const bf16x8 Bo = {one, one, one, one, one, one, one, one};
#pragma unroll
            for (int ks = 0; ks < 4; ++ks) C[8] = MFMA16(Af[ks], Bo, C[8]); }
        m = mn; mx = fmaxf(mn, c + 1 < 17 ? gsc[c + 1] : mn);
        if (c >= 1) { bf16* dst = CS + ((size_t)bhd * 16 + (c - 1)) * (CROWS * 128) + 16 * wave + 4 * g;
            bf16* dst2 = CS + ((size_t)bhd * 16 + (c - 1)) * (CROWS * 128) + (size_t)(128 * eh + 16 * (g & 1) + l15) * 128 + 16 * wave + 8 * (g >> 1);
#pragma unroll
            for (int ep = 0; ep < 4; ++ep) { v2u X, Y; X.x = cvt_pk_bf16(C[2 * ep][0], C[2 * ep][1]); X.y = cvt_pk_bf16(C[2 * ep][2], C[2 * ep][3]); Y.x = cvt_pk_bf16(C[2 * ep + 1][0], C[2 * ep + 1][1]); Y.y = cvt_pk_bf16(C[2 * ep + 1][2], C[2 * ep + 1][3]);
                *(v4u*)(dst2 + (size_t)(32 * ep) * 128) = pair16(X, Y); }
            if (eh == 0 && l15 == 0) { v2u o; o.x = cvt_pk_bf16(C[8][0], C[8][1]); o.y = cvt_pk_bf16(C[8][2], C[8][3]); *(v2u*)(dst + (size_t)256 * 128) = o; }
            if (eh == 0 && tid == 0) MST[bhd * 18 + c + 1] = m; }
        __syncthreads();
    }
#undef CH_STAGE
#undef CH_ISSUE
}

__device__ __forceinline__ void p5_scan(int tid, int G, const bf16* DC, const float* BEND, const float* GMAX, bf16* CS, float* MST) {
    constexpr int QPB = 257 * 128 / 4;
    for (int idx = blockIdx.x * NTHR + tid; idx < 64 * QPB; idx += G * NTHR) {
        const int bhd = idx / QPB, q = idx - bhd * QPB;
        f32x4 C = {0.f, 0.f, 0.f, 0.f}; float m = 0.f;
#pragma unroll
        for (int c = 0; c < 17; ++c) {
            const float gm = GMAX[bhd * 17 + c], be = BEND[bhd * 17 + c], mx = fmaxf(m, gm), al = __expf(m - mx), bt = __expf(gm - mx);
            const v2u dw = *(const v2u*)(DC + ((size_t)bhd * 17 + c) * (CROWS * 128) + 4 * q); const f32x4 d = {bf_lo(dw.x), bf_hi(dw.x), bf_lo(dw.y), bf_hi(dw.y)};
            C = C * al + d * bt; m = be + mx;
            if (c >= 1) { v2u o; o.x = cvt_pk_bf16(C[0], C[1]); o.y = cvt_pk_bf16(C[2], C[3]);
                *(v2u*)(CS + ((size_t)bhd * 16 + (c - 1)) * (CROWS * 128) + 4 * q) = o; if (q == 0) MST[bhd * 18 + c + 1] = m; }
        }
    }
}

__device__ __forceinline__ void p6_phase(LAS unsigned char* lds, int tid, int wave, int lane_, int G, const bf16* Z, const bf16* QC, const bf16* KC, const float* SCN,
                                         const bf16* CS, const float* MST, const float* mnorm_g, bf16* RO, const unsigned char* O8) {
    for (int u = blockIdx.x; u < 512; u += G) {
        int lane = lane_; asm volatile("" : "+v"(lane)); const unsigned g = lane >> 4, l15 = lane & 15;
        const int bh = u >> 4, jb = u & 15, b = bh >> 3, h = bh & 7; const size_t row0 = (size_t)b * TL + jb * 128;
        load_tile128(lds + L_K, KC + row0 * 1024 + h * QKD, 1024, tid);
        load_tile128(lds + L_V0, Z + row0 * ZW + ZV + h * VD, ZW, tid);
        load_tile128(lds + L_V1, Z + row0 * ZW + ZV + h * VD + 128, ZW, tid);
        bf16x8 Qf[4];
#pragma unroll
        for (int ks = 0; ks < 4; ++ks) Qf[ks] = *(const bf16x8*)(QC + (row0 + 16 * wave + l15) * 1024 + h * QKD + 32 * ks + 8 * g);
        { LAS float* scr = (LAS float*)(lds + L_SC);
          for (int i = tid; i < 2 * 385; i += NTHR) { const int d = i >= 385 ? 1 : 0, j = i - 385 * d, bhd2 = bh * 2 + d, c = d ? 17 - jb : 2 + jb;
              scr[512 * d + j] = j < 384 ? SCN[(size_t)(bhd2 * NCH + 2 + jb) * 384 + j] : MST[bhd2 * 18 + c]; }
          if (tid < VD) scr[1024 + tid] = mnorm_g[h * VD + tid]; }
        __syncthreads();
        f32x4 hsum[16]; unsigned ow[16];
#pragma unroll
        for (int et = 0; et < 16; ++et) { hsum[et] = (f32x4){0.f, 0.f, 0.f, 0.f}; ow[et] = 0u; }
#pragma unroll 1
        for (int dir = 0; dir < 2; ++dir) {
            int lane = lane_; asm volatile("" : "+v"(lane));
            const unsigned g = lane >> 4, l15 = lane & 15;
            TR_PERM_OFFS(xp, lane)
            const int c = dir ? 17 - jb : 2 + jb; const bf16* cs = CS + ((size_t)(bh * 2 + dir) * 16 + (c - 2)) * (CROWS * 128);
            const LAS float* sp = (const LAS float*)(lds + L_SC) + 512 * dir; const LAS float* gg = sp + 128; const float mc = sp[384];
            v4u cr[2][2];
#pragma unroll
            for (int q2 = 0; q2 < 2; ++q2)
#pragma unroll
                for (int i = 0; i < 2; ++i) { const int id = tid + NTHR * i; cr[q2][i] = *(const v4u*)(cs + (size_t)(64 * q2 + (id >> 4)) * 128 + 8 * (id & 15)); }
            const int tS = 16 * wave + l15; const float MtS = fmaxf(mc, sp[256 + tS]);
            unsigned pw[16];
#pragma unroll
            for (int st = 0; st < 8; ++st) { f32x4 aS = {0.f, 0.f, 0.f, 0.f};
#pragma unroll
                for (int ks = 0; ks < 4; ++ks) { const bf16x8 Kf = *(const LAS bf16x8*)(lds + L_K + img_off(16 * st + l15, 4 * ks + g)); aS = MFMA16(Kf, Qf[ks], aS); }
                float pv[4]; const f32x4 gs = *(const LAS f32x4*)(gg + 16 * st + 4 * g);
#pragma unroll
                for (int r = 0; r < 4; ++r) { const int s = 16 * st + 4 * g + r; const bool ok = dir ? (s >= tS) : (s <= tS); const float ev = __expf(fminf(gs[r] - MtS, 0.f)); pv[r] = ok ? aS[r] * ev : 0.f; }
                pw[2 * st] = cvt_pk_bf16(pv[0], pv[1]); pw[2 * st + 1] = cvt_pk_bf16(pv[2], pv[3]); asm volatile("" ::: "memory"); }
            bf16x8 Pf[4];
#pragma unroll
            for (int ks = 0; ks < 4; ++ks) { const v4u t4 = {pw[4 * ks], pw[4 * ks + 1], pw[4 * ks + 2], pw[4 * ks + 3]}; Pf[ks] = __builtin_bit_cast(bf16x8, t4); }
            const float wiT = __expf(mc - MtS), flT = __expf(-(sp[tS] + MtS));
            const short one = l15 == 0 ? (short)0x3F80 : (short)0; const bf16x8 Bo = {one, one, one, one, one, one, one, one};
            float inv;
            { f32x4 ad = {0.f, 0.f, 0.f, 0.f};
#pragma unroll
              for (int ks = 0; ks < 4; ++ks) { bf16x8 Cf = *(const bf16x8*)(cs + (size_t)256 * 128 + 32 * ks + 8 * g); if (l15 != 0) Cf = (bf16x8){0, 0, 0, 0, 0, 0, 0, 0}; ad = MFMA16(Cf, Qf[ks], ad); }
              ad[0] *= wiT;
#pragma unroll
              for (int ks = 0; ks < 4; ++ks) ad = MFMA16(Bo, Pf[ks], ad);
              const float den = __shfl(ad[0], lane & 15); inv = 1.0f / fmaxf(fabsf(den), flT); }
            if (dir == 1) {
                const unsigned char* op = O8 + (row0 + 16 * wave + l15) * 2048 + h * VD + 4 * g;
#pragma unroll
                for (int et = 0; et < 16; ++et) ow[et] = *(const unsigned*)(op + 16 * et); }
            {
#pragma unroll
              for (int i = 0; i < 2; ++i) { const int id = tid + NTHR * i; *(LAS v4u*)(lds + L_CB + img_off(id >> 4, id & 15)) = cr[0][i]; }
#pragma unroll
              for (int gq = 0; gq < 4; ++gq) {
                LAS unsigned char* cb = lds + L_CB + (gq & 1) * 16384;
                __syncthreads();
                if (gq < 2) {
#pragma unroll
                    for (int i = 0; i < 2; ++i) { const int id = tid + NTHR * i; cr[gq & 1][i] = *(const v4u*)(cs + (size_t)(64 * (gq + 2) + (id >> 4)) * 128 + 8 * (id & 15)); } }
                f32x4 acc[4];
#pragma unroll
                for (int i = 0; i < 4; ++i) { acc[i] = (f32x4){0.f, 0.f, 0.f, 0.f};
#pragma unroll
                    for (int ks = 0; ks < 4; ++ks) { const bf16x8 Cf = *(const LAS bf16x8*)(cb + img_off(16 * i + l15, 4 * ks + g)); acc[i] = MFMA16(Cf, Qf[ks], acc[i]); } }
#pragma unroll
                for (int i = 0; i < 4; ++i) acc[i] = acc[i] * wiT;
                { LAS unsigned char* img = lds + ((gq >> 1) ? L_V1 : L_V0);
#pragma unroll
                  for (int i = 0; i < 4; ++i) {
#pragma unroll
                    for (int ks = 0; ks < 4; ++ks) { const bf16x8 Vf = tr_frag2(img + 8192 * ks, xp[4 * (gq & 1) + i], xp[4 * (gq & 1) + i] + 4096u); acc[i] = MFMA16(Vf, Pf[ks], acc[i]); } } }
#pragma unroll
                for (int i = 0; i < 4; ++i) hsum[4 * gq + i] += acc[i] * inv;
                if (gq < 3) {
#pragma unroll
                    for (int i = 0; i < 2; ++i) { const int id = tid + NTHR * i; *(LAS v4u*)(lds + L_CB + ((gq + 1) & 1) * 16384 + img_off(id >> 4, id & 15)) = cr[(gq + 1) & 1][i]; } }
              } }
        }
        { float ss = 0.f;
#pragma unroll
          for (int et = 0; et < 16; ++et) ss += (hsum[et][0] * hsum[et][0] + hsum[et][1] * hsum[et][1]) + (hsum[et][2] * hsum[et][2] + hsum[et][3] * hsum[et][3]);
          ss += __shfl_xor(ss, 16); ss += __shfl_xor(ss, 32);
          const float rstd = 1.0f / sqrtf(ss * (1.0f / VD) + EPS); const size_t row = row0 + 16 * wave + l15;
#pragma unroll
          for (int ep = 0; ep < 8; ++ep) { v2u XY[2];
#pragma unroll
              for (int q = 0; q < 2; ++q) { const int et = 2 * ep + q; const int col = h * VD + 16 * et + 4 * g;
                  const auto ol = __builtin_amdgcn_cvt_pk_f32_fp8((int)ow[et], false), oh = __builtin_amdgcn_cvt_pk_f32_fp8((int)ow[et], true); const f32x4 gn = *(const LAS f32x4*)((const LAS float*)(lds + L_SC) + 1024 + 16 * et + 4 * g);
                  const float v0 = hsum[et][0] * rstd * gn[0] * sigmoidf_(ol[0] * (1.0f / pg8::F8_SG)), v1 = hsum[et][1] * rstd * gn[1] * sigmoidf_(ol[1] * (1.0f / pg8::F8_SG));
                  const float v2 = hsum[et][2] * rstd * gn[2] * sigmoidf_(oh[0] * (1.0f / pg8::F8_SG)), v3 = hsum[et][3] * rstd * gn[3] * sigmoidf_(oh[1] * (1.0f / pg8::F8_SG));
                  XY[q].x = cvt_pk_bf16(v0, v1); XY[q].y = cvt_pk_bf16(v2, v3); }
              *(v4u*)(RO + row * DM + h * VD + 16 * (2 * ep + (g & 1)) + 8 * (g >> 1)) = pair16(XY[0], XY[1]); } }
        __syncthreads();
    }
}

__device__ __forceinline__ void p9_phase(LAS unsigned char* lds, int wave, int lane, int G, const float* Xin, const bf16* D, const float* MOD, const float* norm_g, const bf16* SK, const float* router_b,
                                         unsigned* cnt, unsigned char* XG, int* RE, int* RR, float* RG) {
    LAS float* hrow = (LAS float*)(lds + wave * 8192); LAS float* part = (LAS float*)(lds + 65536);
    bf16x8 Bh[8][2]; SK_LOAD(Bh, SK + 2 * 65536);
    f32x4 vn[8]; v2u dn[8];
    { const float* xr = Xin + (size_t)(blockIdx.x * 8 + wave) * DM; const bf16* dr = D + (size_t)(blockIdx.x * 8 + wave) * DM;
#pragma unroll
      for (int j = 0; j < 8; ++j) { vn[j] = *(const f32x4*)(xr + 4 * (lane + 64 * j)); dn[j] = *(const v2u*)(dr + 4 * (lane + 64 * j)); } }
    for (int it = blockIdx.x; it < NLAT / 8; it += G) {
        const int row = it * 8 + wave;
        const float* shift = MOD + (size_t)(row >> 11) * 12288 + 3 * 2048; const float* scale = shift + 2048;
        f32x4 v[8]; float ss = 0.f;
#pragma unroll
        for (int j = 0; j < 8; ++j) { const v2u d = dn[j]; v[j] = vn[j] + (f32x4){bf_lo(d.x), bf_hi(d.x), bf_lo(d.y), bf_hi(d.y)}; ss += (v[j][0] * v[j][0] + v[j][1] * v[j][1]) + (v[j][2] * v[j][2] + v[j][3] * v[j][3]); }
        const float rstd = 1.0f / sqrtf(wave_sum(ss) * (1.0f / DM) + EPS);
#pragma unroll
        for (int j = 0; j < 8; ++j) { const int col = 4 * (lane + 64 * j);
            const f32x4 g = *(const f32x4*)(norm_g + col), sc = *(const f32x4*)(scale + col), sh = *(const f32x4*)(shift + col);
            v[j] = (v[j] * rstd) * g * (sc + 1.0f) + sh; *(LAS f32x4*)(hrow + col) = v[j]; }
        if (it + G < NLAT / 8) { const float* xr = Xin + (size_t)((it + G) * 8 + wave) * DM; const bf16* dr = D + (size_t)((it + G) * 8 + wave) * DM;
#pragma unroll
            for (int j = 0; j < 8; ++j) { vn[j] = *(const f32x4*)(xr + 4 * (lane + 64 * j)); dn[j] = *(const v2u*)(dr + 4 * (lane + 64 * j)); } }
        __syncthreads();
        skinny_mfma_r<false>((const LAS float*)lds, Bh, Bh, SK + 3 * 65536, part, wave, lane);
        __syncthreads();
        float val = router_b[lane & 31];
#pragma unroll
        for (int w = 0; w < 8; ++w) val += part[w * 256 + wave * 32 + (lane & 31)];
        float sv[4]; int si[4];
#pragma unroll
        for (int k = 0; k < 4; ++k) { float bv = val; int bi = lane & 31;
#pragma unroll
            for (int o = 16; o >= 1; o >>= 1) { const float ov = __shfl_xor(bv, o); const int oi = __shfl_xor(bi, o); const bool take = (ov > bv) || (ov == bv && oi < bi); bv = take ? ov : bv; bi = take ? oi : bi; }
            sv[k] = bv; si[k] = __builtin_amdgcn_readfirstlane(bi); if ((lane & 31) == bi) val = -3.0e38f; }
        const float e1 = __expf(sv[1] - sv[0]), e2 = __expf(sv[2] - sv[0]), e3 = __expf(sv[3] - sv[0]), inv = 1.0f / (1.0f + e1 + e2 + e3);
        const float gk[4] = {inv, e1 * inv, e2 * inv, e3 * inv};
        unsigned rank = 0;
        if (lane < 4) rank = __hip_atomic_fetch_add(cnt + (lane == 0 ? si[0] : lane == 1 ? si[1] : lane == 2 ? si[2] : si[3]), 1u, RLX_AGENT);
        v4u pk[2];
#pragma unroll
        for (int c2 = 0; c2 < 2; ++c2) { const LAS float* hp = hrow + 16 * (lane + 64 * c2); const f32x4 a = *(const LAS f32x4*)hp, b = *(const LAS f32x4*)(hp + 4), c = *(const LAS f32x4*)(hp + 8), d = *(const LAS f32x4*)(hp + 12);
            pk[c2].x = pg8::pk4_fp8(a[0] * pg8::F8_SA, a[1] * pg8::F8_SA, a[2] * pg8::F8_SA, a[3] * pg8::F8_SA); pk[c2].y = pg8::pk4_fp8(b[0] * pg8::F8_SA, b[1] * pg8::F8_SA, b[2] * pg8::F8_SA, b[3] * pg8::F8_SA);
            pk[c2].z = pg8::pk4_fp8(c[0] * pg8::F8_SA, c[1] * pg8::F8_SA, c[2] * pg8::F8_SA, c[3] * pg8::F8_SA); pk[c2].w = pg8::pk4_fp8(d[0] * pg8::F8_SA, d[1] * pg8::F8_SA, d[2] * pg8::F8_SA, d[3] * pg8::F8_SA); }
#pragma unroll
        for (int k = 0; k < 4; ++k) { const unsigned rk = (unsigned)__builtin_amdgcn_readlane((int)rank, k);
            unsigned char* dst = XG + ((size_t)si[k] * 8192 + rk) * DM;
#pragma unroll
            for (int c2 = 0; c2 < 2; ++c2) *(v4u*)(dst + 16 * (lane + 64 * c2)) = pk[c2];
            if (lane == 0) { RE[row * 4 + k] = si[k]; RR[row * 4 + k] = (int)rk; RG[row * 4 + k] = gk[k]; } }
    }
}
__device__ __forceinline__ void moe_prefix(LAS int* pref, const unsigned* cnt, int tid) {
    if (tid < 64) { const int e = tid & 31; const unsigned ce = __hip_atomic_load(cnt + e, RLX_AGENT); const int tl = (int)((ce + 255u) >> 8); int inc = tl;
#pragma unroll
        for (int o = 1; o < 32; o <<= 1) { const int t = __shfl_up(inc, o, 32); if (e >= o) inc += t; }
        if (tid < 32) { pref[e] = inc - tl; pref[33 + e] = (int)ce; if (e == 31) pref[32] = inc; } }
    __syncthreads();
}
__device__ __forceinline__ void p12_phase(const LAS int* pref, int wave, int lane_, int G, const float* Xin, const bf16* D, const float* MOD, const unsigned char* Y2, const int* RE, const int* RR, const float* RG, const float* final_g, float* out) {
    const int gw = blockIdx.x * NWAVES + wave, NGW = G * NWAVES;
    int en[4], rn[4]; float gn[4];
    if (gw < NLAT) {
#pragma unroll
        for (int k = 0; k < 4; ++k) { en[k] = RE[gw * 4 + k]; rn[k] = RR[gw * 4 + k]; gn[k] = RG[gw * 4 + k]; } }
    for (int row = gw; row < NLAT; row += NGW) {
        int lane = lane_; asm volatile("" : "+v"(lane));
        const float* xr = Xin + (size_t)row * DM + 4 * lane; const bf16* dr = D + (size_t)row * DM + 4 * lane; f32x4 xv[8]; v2u dv[8]; unsigned yv[4][8]; float gt[4];
#pragma unroll
        for (int k = 0; k < 4; ++k) { gt[k] = gn[k] * (1.0f / pg8::F8_SY); const unsigned char* src = Y2 + ((size_t)pref[en[k]] * 256 + rn[k]) * DM + 4 * lane;
#pragma unroll
            for (int j = 0; j < 8; ++j) yv[k][j] = __builtin_nontemporal_load((const unsigned*)(src + 256 * j)); }
#pragma unroll
        for (int j = 0; j < 8; ++j) { xv[j] = __builtin_nontemporal_load((const f32x4*)(xr + 256 * j)); dv[j] = __builtin_nontemporal_load((const v2u*)(dr + 256 * j)); }
        if (row + NGW < NLAT) { const int r2 = row + NGW;
#pragma unroll
            for (int k = 0; k < 4; ++k) { en[k] = RE[r2 * 4 + k]; rn[k] = RR[r2 * 4 + k]; gn[k] = RG[r2 * 4 + k]; } }
        const float* g5 = MOD + (size_t)(row >> 11) * 12288 + 5 * 2048; float ss = 0.f;
#pragma unroll
        for (int j = 0; j < 8; ++j) { f32x4 ys = {0.f, 0.f, 0.f, 0.f};
#pragma unroll
            for (int k = 0; k < 4; ++k) { const auto lo = __builtin_amdgcn_cvt_pk_f32_fp8((int)yv[k][j], false), hi = __builtin_amdgcn_cvt_pk_f32_fp8((int)yv[k][j], true);
                ys[0] += gt[k] * lo[0]; ys[1] += gt[k] * lo[1]; ys[2] += gt[k] * hi[0]; ys[3] += gt[k] * hi[1]; }
            const int col = 4 * (lane + 64 * j); const v2u d = dv[j]; const f32x4 x2 = (xv[j] + (f32x4){bf_lo(d.x), bf_hi(d.x), bf_lo(d.y), bf_hi(d.y)}) + *(const f32x4*)(g5 + col) * ys; xv[j] = x2;
            ss += (x2[0] * x2[0] + x2[1] * x2[1]) + (x2[2] * x2[2] + x2[3] * x2[3]); }
        const float rstd = 1.0f / sqrtf(wave_sum(ss) * (1.0f / DM) + EPS);
#pragma unroll
        for (int j = 0; j < 8; ++j) { const int col = 4 * (lane + 64 * j); __builtin_nontemporal_store(xv[j] * rstd * *(const f32x4*)(final_g + col), (f32x4*)(out + (size_t)row * DM + col)); }
    }
}

#define XB_TMO      128
#define XB_XCNT(j)  (256  + 64 * (j))
#define XB_XSUB(j)  (1280 + 64 * (j))
#define XB_XGEN(j)  (2304 + 64 * (j))
#define XB_TOP      3328
#define XB_TOPGEN   3392
#define XCD_BAR_WORDS 3456
#define XB_SPIN_CAP (1u << 18)

__device__ __forceinline__ unsigned xb_ld(unsigned* p)              { return __hip_atomic_load(p, __ATOMIC_RELAXED, __HIP_MEMORY_SCOPE_AGENT); }
__device__ __forceinline__ unsigned xb_add(unsigned* p, unsigned v) { return __hip_atomic_fetch_add(p, v, __ATOMIC_RELAXED, __HIP_MEMORY_SCOPE_AGENT); }
__device__ __forceinline__ unsigned xb_xcc_id() { return (unsigned)__builtin_amdgcn_s_getreg((3 << 11) | 20) & 0xFu; }
#define XB_SPIN(cond, bar) do { unsigned _sp = 0; while (cond) { __builtin_amdgcn_s_sleep(1); \
    if ((++_sp & 255u) == 0u) { if (xb_ld(&(bar)[XB_TMO])) break; if (_sp > XB_SPIN_CAP) { atomicAdd(&(bar)[XB_TMO], 1u); break; } } } } while (0)

struct XcdBarrier {
    unsigned* bar; unsigned x;
    volatile LAS unsigned* st;
};

__device__ __forceinline__ XcdBarrier xcd_barrier_post(unsigned* bar, volatile LAS unsigned* st) {
    XcdBarrier b; b.bar = bar; b.x = xb_xcc_id(); b.st = st;
    if (threadIdx.x == 0) (void)xb_add(&bar[XB_XCNT(b.x)], 1u);
    return b;
}
__device__ __forceinline__ void xcd_barrier_complete(unsigned* bar, unsigned x, unsigned& nloc, unsigned& nx) {
    const unsigned G = gridDim.x * gridDim.y * gridDim.z;
    unsigned sum, cnt, mine, sp = 0u;
    for (;;) {
        sum = 0u; cnt = 0u; mine = 0u;
#pragma unroll
        for (unsigned j = 0; j < 16; ++j) { const unsigned c = xb_ld(&bar[XB_XCNT(j)]); sum += c; cnt += (c > 0u) ? 1u : 0u; mine = (j == x) ? c : mine; }
        if (sum == G) break;
        __builtin_amdgcn_s_sleep(1);
        if ((++sp & 255u) == 0u) { if (xb_ld(&bar[XB_TMO])) break; if (sp > XB_SPIN_CAP) { atomicAdd(&bar[XB_TMO], 1u); break; } }
    }
    nloc = mine > 0u ? mine : 1u; nx = cnt > 0u ? cnt : 1u;
}

__device__ __forceinline__ void xcd_barrier(const XcdBarrier& b) {
    asm volatile("s_waitcnt vmcnt(0)" ::: "memory");
    __syncthreads();
    if (threadIdx.x == 0) {
        unsigned* bar = b.bar;
        __builtin_amdgcn_s_waitcnt(0);
        unsigned nloc = b.st[0], nx = b.st[1];
        if (nloc == 0u) { xcd_barrier_complete(bar, b.x, nloc, nx); b.st[0] = nloc; b.st[1] = nx; }
        const unsigned old = xb_add(&bar[XB_XSUB(b.x)], 1u);
        const unsigned gen = old / nloc;
        if (old + 1u == (gen + 1u) * nloc) {
            __builtin_amdgcn_fence(__ATOMIC_RELEASE, "agent");
            asm volatile("s_waitcnt vmcnt(0)" ::: "memory");
            const unsigned og = xb_add(&bar[XB_TOP], 1u);
            const unsigned tg = og / nx;
            if (og + 1u == (tg + 1u) * nx) xb_add(&bar[XB_TOPGEN], 1u);
            else XB_SPIN(xb_ld(&bar[XB_TOPGEN]) == tg, bar);
            __builtin_amdgcn_fence(__ATOMIC_ACQUIRE, "agent");
            xb_add(&bar[XB_XGEN(b.x)], 1u);
            asm volatile("s_waitcnt vmcnt(0)" ::: "memory");
        } else {
            XB_SPIN(xb_ld(&bar[XB_XGEN(b.x)]) == gen, bar);
            __builtin_amdgcn_fence(__ATOMIC_ACQUIRE, "agent");
            asm volatile("s_waitcnt vmcnt(0)" ::: "memory");
        }
    }
    __syncthreads();
}

struct Args { const float* in[26]; float* out; unsigned char* ws; int ph_lo, ph_hi; };
__global__ void __launch_bounds__(NTHR, 2) mk_fwd(Args args) {
    extern __shared__ __attribute__((aligned(16))) unsigned char lds_raw[];
    LAS unsigned char* lds = (LAS unsigned char*)lds_raw;
    const int tid = threadIdx.x, lane = tid & 63, wave = __builtin_amdgcn_readfirstlane(tid >> 6), G = gridDim.x;
    unsigned char* ws = args.ws;
    gu32* ctl = (gu32*)(ws + WS_CTL);
    for (int u = tid; u < (LDS_BYTES - LDSCTL_OFF) / 4; u += NTHR) ((LAS unsigned*)(lds + LDSCTL_OFF))[u] = 0u;
    __syncthreads();
    volatile LAS unsigned* MISC = (volatile LAS unsigned*)(lds + MISC_OFF);
    XcdBarrier bar; bar.bar = (unsigned*)(ctl + CW_BAR); bar.x = 0; bar.st = nullptr;
    if (N_LAUNCHES == 1) bar = xcd_barrier_post((unsigned*)(ctl + CW_BAR), MISC + 8);
#define GRID_BAR() do { if (N_LAUNCHES == 1) xcd_barrier(bar); } while (0)
    const int lo = args.ph_lo, hi = args.ph_hi;
#ifdef ONLY_PHASE
#define IN(k) ((k) == ONLY_PHASE && lo <= (k) && (k) < hi)
#else
#define IN(k) (lo <= (k) && (k) < hi)
#endif
#define BOTH(k) (IN(k) && IN((k) + 1))
#ifndef REP_MASK
#define REP_MASK 0
#endif
#define NREP(k) ((((REP_MASK) >> (k)) & 1) ? 2 : 1)
#define INP(i) (args.in[i])
#define WSF(off) ((float*)(ws + (off)))
#define WSB(off) ((bf16*)(ws + (off)))
#define WSI(off) ((int*)(ws + (off)))
    unsigned* cnt = (unsigned*)(ctl + CW_CNT);
    LAS int* pref = (LAS int*)(lds + PREF_OFF);
    const int n_conv_p0 = I_WIN + 3 * I_P;
#define x_in INP(0)
#define cvec INP(1)
#define ctx INP(2)
#define c_ctx INP(3)
#define mod_w INP(4)
#define mod_b INP(5)
#define norm1_g INP(6)
#define norm2_g INP(7)
#define w_in INP(8)
#define gate_b INP(9)
#define conv_w INP(10)
#define conv_b INP(11)
#define mnorm_g INP(12)
#define sgu_norm_g INP(13)
#define sgu_w INP(14)
#define sgu_b INP(15)
#define proj_a INP(16)
#define proj_b INP(17)
#define w_out INP(18)
#define router_w INP(19)
#define router_b INP(20)
#define exp_w1 INP(21)
#define exp_b1 INP(22)
#define exp_w2 INP(23)
#define exp_b2 INP(24)
#define final_g INP(25)
#define MOD WSF(WS_MOD)
#define GATES WSF(WS_GATES)
#define BEND WSF(WS_SCAL)
#define GMAX (WSF(WS_SCAL) + 64 * 17)
#define MST (WSF(WS_SCAL) + 2 * 64 * 17)
#define RE WSI(WS_ROUTE)
#define RR (WSI(WS_ROUTE) + NLAT * 4)
#define RG (WSF(WS_ROUTE) + 2 * NLAT * 4)
#define WINT WSB(WS_WINT)
#define SKW WSB(WS_SK)
#define SCN WSF(WS_SCN)
#define PAT WSB(WS_PAT)
#define PBT WSB(WS_PBT)
#define WOT WSB(WS_WOT)
#define W1T WSB(WS_W1T)
#define W1T8 ((unsigned char*)(ws + WS_W1T))
#define HB8M ((unsigned char*)(ws + WS_HB8))
#define WG8M ((unsigned char*)(ws + WS_WG8))
#define W2T8 ((unsigned char*)(ws + WS_W2T))
#define XG8 ((unsigned char*)(ws + WS_XG))
#define ACT8 ((unsigned char*)(ws + WS_ACT))
#define W2T WSB(WS_W2T)
#define HB WSB(WS_HB)
#define Z WSB(WS_Z)
#define QC WSB(WS_QC)
#define KC WSB(WS_KC)
#define SVN WSB(WS_SVN)
#define DC WSB(WS_DC)
#define CS WSB(WS_CS)
#define RO WSB(WS_RO)
#define CM WSB(WS_CM)
#define YB WSB(WS_YB)
#define MRG WSB(WS_MRG)
#define X1 WSF(WS_X1)
#define ACT WSB(WS_ACT)
#define Y2 WSB(WS_Y2)
#define XG WSB(WS_XG)

    if (IN(0)) for (int rep_ = 0; rep_ < NREP(0); ++rep_) { p0_phase(lds, tid, G, cvec, c_ctx, mod_w, mod_b, MOD, w_in, proj_a, proj_b, w_out, exp_w1, exp_w2, router_w, WINT, PAT, PBT, WOT, W1T, W2T, SKW, n_conv_p0);
        cvt_run8(lds, tid, I_W1 + I_W2 + (int)blockIdx.x, G, I_W1 + I_W2 + I_GATE8, exp_w1, exp_w2, w_in, W1T8, W2T8, WG8M); if (BOTH(0) || rep_ + 1 < NREP(0)) GRID_BAR(); }
    if (IN(1)) for (int rep_ = 0; rep_ < NREP(1); ++rep_) { p1_phase(lds, tid, wave, lane, G, x_in, ctx, MOD, norm1_g, SKW, gate_b, HB, HB8M, GATES); if (BOTH(1) || rep_ + 1 < NREP(1)) GRID_BAR(); }
    if (IN(2)) for (int rep_ = 0; rep_ < NREP(2); ++rep_) {
        if ((int)blockIdx.x >= G - (G == 256 ? N_CONVERTERS : G))
            cvt_run8(lds, tid, (int)blockIdx.x - (G - (G == 256 ? N_CONVERTERS : G)), (G == 256 ? N_CONVERTERS : G), I_W1 + I_W2, exp_w1, exp_w2, w_in, W1T8, W2T8, WG8M);
        { pg8::Gemm g{(const bf16*)HB8M, (const bf16*)WG8M, NTOK, 12288, DM}; pg8::DynOrder S{(unsigned*)(ctl + CW_Q2), (LAS int*)(lds + PREF_OFF + 808), (int)(blockIdx.x & 7), 48, 8, 0}; pg8::EpiGate8 E{Z, ZW, ws + WS_ZG8, ws + WS_ZO8};
          pg8::gemm_phase8<pg8::EpiGate8, pg8::DynOrder, true, true>(lds, g, S, E); }
        { pg8::Gemm g{HB, WINT, NLAT, ZW, DM}; pg8::DynOrder S{(unsigned*)(ctl + CW_Q), (LAS int*)(lds + PREF_OFF + 800), (int)(blockIdx.x & 7), 8, 0, 24}; pg8::EpiBf16 E{Z, ZW, nullptr, ZW / 256};
          pg8::gemm_phase<pg8::EpiBf16, pg8::DynOrder, true, true>(lds, g, S, E); }
        if (BOTH(2) || rep_ + 1 < NREP(2)) GRID_BAR();
    }
    if (IN(3)) for (int rep_ = 0; rep_ < NREP(3); ++rep_) { p3_phase(wave, lane, G, Z, conv_w, conv_b, sgu_norm_g, QC, KC, SVN, GATES, SCN, BEND, GMAX); if (BOTH(3) || rep_ + 1 < NREP(3)) GRID_BAR(); }
    if (IN(4)) for (int rep_ = 0; rep_ < NREP(4); ++rep_) { if (G == 256) { if ((int)blockIdx.x < 128) p4_chain(lds, tid, wave, Z, KC, SCN, BEND, GMAX, CS, MST); else { p4_phase(lds, tid, wave, lane, G, Z, KC, SVN, SCN, sgu_w, sgu_b, DC, GMAX, CM, N_M1 + (int)blockIdx.x - 128, 128); p3_conv(((int)blockIdx.x - 128) * NWAVES + wave, 128 * NWAVES, NLAT / 4, 0, lane, Z, conv_w, conv_b, QC, KC); } }
        else p4_phase(lds, tid, wave, lane, G, Z, KC, SVN, SCN, sgu_w, sgu_b, DC, GMAX, CM, (int)blockIdx.x, G);
        if (BOTH(4) || rep_ + 1 < NREP(4)) GRID_BAR(); }
    if (IN(5)) for (int rep_ = 0; rep_ < NREP(5); ++rep_) {
        if (G != 256) { p5_scan(tid, G, DC, BEND, GMAX, CS, MST);
          if (BOTH(5) || rep_ + 1 < NREP(5)) GRID_BAR(); }
    }
    if (IN(6)) for (int rep_ = 0; rep_ < NREP(6); ++rep_) { p6_phase(lds, tid, wave, lane, G, Z, QC, KC, SCN, CS, MST, mnorm_g, RO, ws + WS_ZO8); if (BOTH(6) || rep_ + 1 < NREP(6)) GRID_BAR(); }
    if (IN(7)) for (int rep_ = 0; rep_ < NREP(7); ++rep_) {
        pg8::Gemm g{RO, PAT, NLAT, DM, DM}; pg8::PairOrder S; S.S.init(NLAT, DM, G, (int)blockIdx.x); S.dM = NLAT / 256; S.dN = DM / 256; pg8::EpiMerge2 E{MRG, ws + WS_ZG8};
        pg8::gemm_phase<pg8::EpiMerge2, pg8::PairOrder, true, true>(lds, g, S, E);
        if (BOTH(7) || rep_ + 1 < NREP(7)) GRID_BAR();
    }
    if (IN(8)) for (int rep_ = 0; rep_ < NREP(8); ++rep_) {
        pg8::Gemm g{MRG, WOT, NLAT, DM, DM}; pg8::StaticOrder S; S.init(NLAT, DM, G, (int)blockIdx.x); pg8::EpiD E{(bf16*)X1, MOD};
        pg8::gemm_phase<pg8::EpiD, pg8::StaticOrder, true, true>(lds, g, S, E);
        if (BOTH(8) || rep_ + 1 < NREP(8)) GRID_BAR();
    }
    if (IN(9)) for (int rep_ = 0; rep_ < NREP(9); ++rep_) { p9_phase(lds, wave, lane, G, x_in, (const bf16*)X1, MOD, norm2_g, SKW, router_b, cnt, XG8, RE, RR, RG); if (BOTH(9) || rep_ + 1 < NREP(9)) GRID_BAR(); }
    if (IN(10)) for (int rep_ = 0; rep_ < NREP(10); ++rep_) {
        moe_prefix(pref, cnt, tid);
        pg8::Gemm g{(const bf16*)XG8, (const bf16*)W1T8, 0, 0, DM}; pg8::MoeDyn S{pref, 16, 1, (unsigned*)(ctl + CW_Q3), (LAS int*)(lds + PREF_OFF + 816), (int)(blockIdx.x & 7)}; pg8::EpiSwiglu8 E{ACT8, exp_b1};
        pg8::gemm_phase8<pg8::EpiSwiglu8, pg8::MoeDyn, true, true, true>(lds, g, S, E);
        if (BOTH(10) || rep_ + 1 < NREP(10)) GRID_BAR();
    }
    if (IN(11)) for (int rep_ = 0; rep_ < NREP(11); ++rep_) {
        if (!IN(10)) moe_prefix(pref, cnt, tid);
        pg8::Gemm g{(const bf16*)ACT8, (const bf16*)W2T8, 0, 0, DEXP}; pg8::MoeDyn S{pref, 8, 0, (unsigned*)(ctl + CW_Q4), (LAS int*)(lds + PREF_OFF + 824), (int)(blockIdx.x & 7)}; pg8::EpiY2f8 E{(unsigned char*)Y2, exp_b2};
        pg8::gemm_phase8<pg8::EpiY2f8, pg8::MoeDyn, true, true, true>(lds, g, S, E);
        if (BOTH(11) || rep_ + 1 < NREP(11)) GRID_BAR();
    }
    if (IN(12)) for (int rep_ = 0; rep_ < NREP(12); ++rep_) { if (!IN(10)) moe_prefix(pref, cnt, tid); p12_phase(pref, wave, lane, G, x_in, (const bf16*)X1, MOD, (const unsigned char*)Y2, RE, RR, RG, final_g, args.out); if (rep_ + 1 < NREP(12)) GRID_BAR(); }
#undef IN
#undef BOTH
}

extern "C" void kernel_launch(void* const* d_in, const int* in_sizes, int n_in, void* d_out, int out_size, void* d_ws, size_t ws_size, hipStream_t stream) {
    static int grid = 0;
    if (grid == 0) {
        if (n_in != 26 || out_size != NLAT * DM || ws_size < WS_END) { fprintf(stderr, "kernel_launch: unexpected shapes (n_in %d, out %d, ws %zu)\n", n_in, out_size, ws_size); grid = -1; return; }
        int dev = 0, cus = 0;
        if (hipGetDevice(&dev) != hipSuccess || hipDeviceGetAttribute(&cus, hipDeviceAttributeMultiprocessorCount, dev) != hipSuccess) { grid = -1; return; }
        if (hipFuncSetAttribute((const void*)mk_fwd, hipFuncAttributeMaxDynamicSharedMemorySize, LDS_BYTES) != hipSuccess) { fprintf(stderr, "kernel_launch: hipFuncSetAttribute failed\n"); grid = -1; return; }
        int per_cu = 0;
        if (hipOccupancyMaxActiveBlocksPerMultiprocessor(&per_cu, (const void*)mk_fwd, NTHR, LDS_BYTES) != hipSuccess || per_cu < 1) fprintf(stderr, "kernel_launch: occupancy query reports %d\n", per_cu);
        (void)hipGetLastError();
        grid = cus;
    }
    if (grid < 0) return;
    if (hipMemsetAsync((char*)d_ws + WS_CTL, 0, CTL_ZERO_BYTES, stream) != hipSuccess) return;
    Args a{};
    for (int i = 0; i < 26; ++i) a.in[i] = (const float*)d_in[i];
    a.out = (float*)d_out; a.ws = (unsigned char*)d_ws;
    for (int li = 0; li < N_LAUNCHES; ++li) {
        a.ph_lo = (N_LAUNCHES == 1) ? 0 : li; a.ph_hi = (N_LAUNCHES == 1) ? N_PHASES : li + 1;
        hipLaunchKernelGGL(mk_fwd, dim3(grid), dim3(NTHR), LDS_BYTES, stream, a);
        const hipError_t le = hipPeekAtLastError();
        if (le != hipSuccess) { fprintf(stderr, "kernel_launch: launch %d failed: %s\n", li, hipGetErrorName(le)); break; }
    }
}
```
